# Optimizing an MI355X kernel written in HIP

```python
import math
import jax
import jax.numpy as jnp
from jax import lax
import numpy as np

D_MODEL = 1024
BATCH = 16
SEQ = 2048
DEPTH = 1

HEAD_DIM = 64
ATTN_GROUPS = ((128, 1), (512, 4), (2048, 16))
HEADS_PER_GROUP = 8
N_ATTN_HEADS = HEADS_PER_GROUP * len(ATTN_GROUPS)
ATTN_WIDTH = N_ATTN_HEADS * HEAD_DIM
ATTN_OUT_WIDTH = HEADS_PER_GROUP * HEAD_DIM
BLOCK = 128
NUM_BUCKETS = 32
MAX_DISTANCE = 2048

D_INNER = 2 * D_MODEL
SSM_HEAD_DIM = 64
N_SSM_HEADS = D_INNER // SSM_HEAD_DIM
N_SSM_GROUPS = 4
D_STATE = 128
CONV_WIDTH = 4
CHUNK = 128
CONV_DIM = D_INNER + 2 * N_SSM_GROUPS * D_STATE

N_BRANCHES = 2
SPLIT_POINTS = (ATTN_WIDTH, 2 * ATTN_WIDTH, 3 * ATTN_WIDTH,
                3 * ATTN_WIDTH + D_INNER,
                3 * ATTN_WIDTH + D_INNER + CONV_DIM,
                3 * ATTN_WIDTH + D_INNER + CONV_DIM + N_SSM_HEADS)
IN_PROJ_WIDTH = 3 * ATTN_WIDTH + D_INNER + CONV_DIM + N_SSM_HEADS + N_BRANCHES * D_MODEL

N_EXPERTS = 32
TOP_K = 4
D_EXPERT = D_MODEL
SWIGLU_LIMIT = 7.0
SWIGLU_ALPHA = 1.702
MOE_BLOCK = 128

EPS = 1e-5

kernel_name = 'hybrid_dilated_attn_ssd_moe'


def rmsnorm(x, w):
    xf = x.astype(jnp.float32)
    y = xf * lax.rsqrt(jnp.mean(xf * xf, axis=-1, keepdims=True) + EPS)
    return (y * w.astype(jnp.float32)).astype(x.dtype)


def t5_bucket(dist):
    max_exact = NUM_BUCKETS // 2
    nf = jnp.maximum(dist, max_exact).astype(jnp.float32)
    large = max_exact + (jnp.log(nf / max_exact) / math.log(MAX_DISTANCE / max_exact)
                         * (NUM_BUCKETS - max_exact)).astype(jnp.int32)
    large = jnp.minimum(large, NUM_BUCKETS - 1)
    return jnp.where(dist < max_exact, dist, large)


def dilated_window_attention(q, k, v, bias_table, window, dilation):
    b, s, h, hd = q.shape
    span = dilation * BLOCK
    s_pad = -(-s // span) * span
    sub_len = s_pad // dilation
    nb = sub_len // BLOCK
    w_sub = window // dilation

    def to_sub(t):
        t = jnp.pad(t.astype(jnp.float32), ((0, 0), (0, s_pad - s), (0, 0), (0, 0)))
        t = t.reshape(b, sub_len, dilation, h, hd).transpose(0, 2, 1, 3, 4)
        return t.reshape(b * dilation, nb, BLOCK, h, hd)

    def with_prev(t):
        prev = jnp.pad(t, ((0, 0), (1, 0), (0, 0), (0, 0), (0, 0)))[:, :-1]
        return jnp.concatenate([prev, t], axis=2)

    qb = to_sub(q)
    kc = with_prev(to_sub(k))
    vc = with_prev(to_sub(v))
    logits = jnp.einsum('znqhd,znkhd->znhqk', qb, kc) * (hd ** -0.5)
    q_idx = jnp.arange(BLOCK)[:, None]
    k_idx = jnp.arange(2 * BLOCK)[None, :]
    delta = q_idx + BLOCK - k_idx
    in_band = (delta >= 0) & (delta <= w_sub)
    has_prev = (jnp.arange(nb)[:, None, None] > 0) | (k_idx >= BLOCK)[None]
    valid = in_band[None] & has_prev
    bucket = t5_bucket(jnp.clip(delta, 0, w_sub) * dilation)
    bias = jnp.transpose(bias_table.astype(jnp.float32)[bucket], (2, 0, 1))
    logits = jnp.where(valid[None, :, None], logits + bias[None, None], -jnp.inf)
    m = jnp.max(logits, axis=-1, keepdims=True)
    p = jnp.exp(logits - m)
    denom = jnp.sum(p, axis=-1, keepdims=True)
    lse = (m + jnp.log(denom))[..., 0]
    out = jnp.einsum('znhqk,znkhd->znqhd', p / denom, vc)
    out = out.reshape(b, dilation, sub_len, h, hd).transpose(0, 2, 1, 3, 4).reshape(b, s_pad, h, hd)[:, :s]
    lse = lse.transpose(0, 1, 3, 2).reshape(b, dilation, sub_len, h).transpose(0, 2, 1, 3).reshape(b, s_pad, h)[:, :s]
    return out, lse


def causal_depthwise_conv(u, w, bias):
    c = u.shape[-1]
    out = lax.conv_general_dilated(u, w[:, None, :].astype(u.dtype), window_strides=(1,),
                                   padding=[(CONV_WIDTH - 1, 0)],
                                   dimension_numbers=('NWC', 'WIO', 'NWC'),
                                   feature_group_count=c)
    return out + bias.astype(u.dtype)


def ssd_chunked(xs, dt, a, bm, cm):
    b, s, h, p = xs.shape
    g, n = bm.shape[2], bm.shape[3]
    r = h // g
    nc = s // CHUNK
    x_d = (xs * dt[..., None]).reshape(b, nc, CHUNK, g, r, p)
    a_d = jnp.moveaxis((dt * a).reshape(b, nc, CHUNK, g, r), 2, -1)
    a_cs = jnp.cumsum(a_d, axis=-1)
    bc = bm.reshape(b, nc, CHUNK, g, n)
    cc = cm.reshape(b, nc, CHUNK, g, n)
    tril = jnp.tril(jnp.ones((CHUNK, CHUNK), dtype=bool))
    seg = a_cs[..., :, None] - a_cs[..., None, :]
    decay_in = jnp.exp(jnp.where(tril, seg, -jnp.inf))
    cb = jnp.einsum('bclgn,bcsgn->bcgls', cc, bc)
    y_diag = jnp.einsum('bcgrls,bcsgrp->bclgrp', cb[:, :, :, None] * decay_in, x_d)
    decay_states = jnp.exp(a_cs[..., -1:] - a_cs)
    states = jnp.einsum('bclgn,bcgrl,bclgrp->bcgrpn', bc, decay_states, x_d)
    chunk_decay = jnp.exp(a_cs[..., -1])

    def step(carry, inp):
        st, dec = inp
        return carry * dec[..., None, None] + st, carry

    init = jnp.zeros((b, g, r, p, n), jnp.float32)
    _, prev = lax.scan(step, init, (jnp.moveaxis(states, 1, 0), jnp.moveaxis(chunk_decay, 1, 0)))
    prev = jnp.moveaxis(prev, 0, 1)
    y_off = jnp.einsum('bclgn,bcgrpn,bcgrl->bclgrp', cc, prev, jnp.exp(a_cs))
    return (y_diag + y_off).reshape(b, s, h, p)


def hybrid_mixer(h, w_in, rel_bias, w_branch_attn, conv_w, conv_b, dt_bias, a_log, d_skip,
                 ssm_norm_w, w_branch_ssm, gate_bias, w_out):
    b, s, _ = h.shape
    f32 = jnp.float32
    proj = h @ w_in
    q, k, v, z, xbc, dt_raw, gate_logits = jnp.split(proj, SPLIT_POINTS, axis=-1)

    q = q.reshape(b, s, N_ATTN_HEADS, HEAD_DIM)
    k = k.reshape(b, s, N_ATTN_HEADS, HEAD_DIM)
    v = v.reshape(b, s, N_ATTN_HEADS, HEAD_DIM)
    outs, lses = [], []
    for gi, (window, dilation) in enumerate(ATTN_GROUPS):
        hs = slice(gi * HEADS_PER_GROUP, (gi + 1) * HEADS_PER_GROUP)
        o, l = dilated_window_attention(q[:, :, hs], k[:, :, hs], v[:, :, hs], rel_bias[:, hs], window, dilation)
        outs.append(o)
        lses.append(l)
    mix_w = jax.nn.softmax(jnp.stack(lses, axis=0), axis=0)
    attn = jnp.sum(mix_w[..., None] * jnp.stack(outs, axis=0), axis=0).reshape(b, s, ATTN_OUT_WIDTH)
    y_attn = attn.astype(h.dtype) @ w_branch_attn

    xbc = jax.nn.silu(causal_depthwise_conv(xbc, conv_w, conv_b))
    xs, bm, cm = jnp.split(xbc, [D_INNER, D_INNER + N_SSM_GROUPS * D_STATE], axis=-1)
    xs = xs.reshape(b, s, N_SSM_HEADS, SSM_HEAD_DIM).astype(f32)
    bm = bm.reshape(b, s, N_SSM_GROUPS, D_STATE).astype(f32)
    cm = cm.reshape(b, s, N_SSM_GROUPS, D_STATE).astype(f32)
    dt = jax.nn.softplus(dt_raw.astype(f32) + dt_bias.astype(f32))
    a = -jnp.exp(a_log.astype(f32))
    y = ssd_chunked(xs, dt, a, bm, cm) + d_skip.astype(f32)[:, None] * xs
    y = y.reshape(b, s, D_INNER) * jax.nn.silu(z.astype(f32))
    yg = y.reshape(b, s, N_SSM_GROUPS, D_INNER // N_SSM_GROUPS)
    yg = yg * lax.rsqrt(jnp.mean(yg * yg, axis=-1, keepdims=True) + EPS)
    y = yg.reshape(b, s, D_INNER) * ssm_norm_w.astype(f32)
    y_ssm = y.astype(h.dtype) @ w_branch_ssm

    gates = jax.nn.sigmoid((gate_logits + gate_bias).astype(f32)).reshape(b, s, N_BRANCHES, D_MODEL)
    merged = gates[..., 0, :] * y_attn.astype(f32) + gates[..., 1, :] * y_ssm.astype(f32)
    return merged.astype(h.dtype) @ w_out


def clamped_swiglu(hid):
    x_glu = jnp.minimum(hid[..., ::2], SWIGLU_LIMIT)
    x_lin = jnp.clip(hid[..., 1::2], -SWIGLU_LIMIT, SWIGLU_LIMIT)
    return x_glu * jax.nn.sigmoid(SWIGLU_ALPHA * x_glu) * (x_lin + 1.0)


def moe_ffn(h, router_w, router_b, w1, b1, w2, b2):
    b, s, d = h.shape
    t_n = b * s
    tok = h.reshape(t_n, d)
    logits = (tok @ router_w + router_b).astype(jnp.float32)
    top_val, top_idx = lax.top_k(logits, TOP_K)
    weights = jax.nn.softmax(top_val, axis=-1)
    n_assign = t_n * TOP_K
    flat_e = top_idx.reshape(n_assign)
    flat_tok = jnp.arange(n_assign, dtype=jnp.int32) // TOP_K
    flat_w = weights.reshape(n_assign)
    order = jnp.argsort(flat_e)
    se, stok, sw = flat_e[order], flat_tok[order], flat_w[order]
    counts = jnp.bincount(flat_e, length=N_EXPERTS)
    padded = (counts + MOE_BLOCK - 1) // MOE_BLOCK * MOE_BLOCK
    start = jnp.cumsum(counts) - counts
    pend = jnp.cumsum(padded)
    pstart = pend - padded
    dest = pstart[se] + jnp.arange(n_assign, dtype=jnp.int32) - start[se]
    cap = n_assign + N_EXPERTS * MOE_BLOCK
    n_blocks = cap // MOE_BLOCK
    buf = jnp.zeros((cap, d), h.dtype).at[dest].set(tok[stok])
    block_e = jnp.minimum(jnp.searchsorted(pend, jnp.arange(n_blocks) * MOE_BLOCK, side='right'), N_EXPERTS - 1)

    def expert_block(args):
        xb, e = args
        hid = xb @ w1[e] + b1[e]
        return clamped_swiglu(hid) @ w2[e] + b2[e]

    ybuf = lax.map(expert_block, (buf.reshape(n_blocks, MOE_BLOCK, d), block_e)).reshape(cap, d)
    y = ybuf[dest] * sw[:, None].astype(ybuf.dtype)
    out = jax.ops.segment_sum(y, stok, num_segments=t_n)
    return out.reshape(b, s, d)


def setup_inputs(seed: int = 0) -> dict:
    key = jax.random.key(seed)
    ks = jax.random.split(key, 24)
    f32 = jnp.float32

    def nrm(k, shape, scale):
        return jax.random.normal(k, shape, f32) * scale

    dt0 = jnp.exp(jax.random.uniform(ks[6], (DEPTH, N_SSM_HEADS), f32, math.log(1e-3), math.log(1e-1)))
    return {
        'x': nrm(ks[0], (BATCH, SEQ, D_MODEL), 1.0),
        'w_in': nrm(ks[1], (DEPTH, D_MODEL, IN_PROJ_WIDTH), D_MODEL ** -0.5),
        'rel_bias': nrm(ks[2], (NUM_BUCKETS, N_ATTN_HEADS), 0.5),
        'w_branch_attn': nrm(ks[3], (DEPTH, ATTN_OUT_WIDTH, D_MODEL), ATTN_OUT_WIDTH ** -0.5),
        'conv_w': nrm(ks[4], (DEPTH, CONV_WIDTH, CONV_DIM), CONV_WIDTH ** -0.5),
        'conv_b': nrm(ks[5], (DEPTH, CONV_DIM), 0.02),
        'dt_bias': dt0 + jnp.log(-jnp.expm1(-dt0)),
        'a_log': jnp.log(jax.random.uniform(ks[7], (DEPTH, N_SSM_HEADS), f32, 1.0, 16.0)),
        'd_skip': 1.0 + nrm(ks[8], (DEPTH, N_SSM_HEADS), 0.1),
        'ssm_norm_w': 1.0 + nrm(ks[9], (DEPTH, D_INNER), 0.1),
        'w_branch_ssm': nrm(ks[10], (DEPTH, D_INNER, D_MODEL), D_INNER ** -0.5),
        'gate_bias': nrm(ks[11], (DEPTH, N_BRANCHES * D_MODEL), 0.1),
        'w_out': nrm(ks[12], (DEPTH, D_MODEL, D_MODEL), D_MODEL ** -0.5),
        'norm_mix': 1.0 + nrm(ks[13], (DEPTH, D_MODEL), 0.1),
        'norm_ffn': 1.0 + nrm(ks[14], (DEPTH, D_MODEL), 0.1),
        'router_w': nrm(ks[15], (DEPTH, D_MODEL, N_EXPERTS), D_MODEL ** -0.5),
        'router_b': nrm(ks[16], (DEPTH, N_EXPERTS), 0.01),
        'w1': nrm(ks[17], (DEPTH, N_EXPERTS, D_MODEL, 2 * D_EXPERT), D_MODEL ** -0.5),
        'b1': nrm(ks[18], (DEPTH, N_EXPERTS, 2 * D_EXPERT), 0.01),
        'w2': nrm(ks[19], (DEPTH, N_EXPERTS, D_EXPERT, D_MODEL), D_EXPERT ** -0.5),
        'b2': nrm(ks[20], (DEPTH, N_EXPERTS, D_MODEL), 0.01),
        'norm_final': 1.0 + nrm(ks[21], (D_MODEL,), 0.1),
    }


def reference(x, w_in, rel_bias, w_branch_attn, conv_w, conv_b, dt_bias, a_log, d_skip, ssm_norm_w,
              w_branch_ssm, gate_bias, w_out, norm_mix, norm_ffn, router_w, router_b, w1, b1, w2, b2,
              norm_final):
    for l in range(DEPTH):
        h = rmsnorm(x, norm_mix[l])
        x = x + hybrid_mixer(h, w_in[l], rel_bias, w_branch_attn[l], conv_w[l], conv_b[l], dt_bias[l],
                             a_log[l], d_skip[l], ssm_norm_w[l], w_branch_ssm[l], gate_bias[l], w_out[l])
        h = rmsnorm(x, norm_ffn[l])
        x = x + moe_ffn(h, router_w[l], router_b[l], w1[l], b1[l], w2[l], b2[l])
    return rmsnorm(x, norm_final)
```

```cpp
#include <hip/hip_runtime.h>
#include <cstdio>
#include <cstdint>

#ifndef MK_FUSED
#define MK_FUSED 0
#endif

#define GAS __attribute__((address_space(1)))
#define LAS __attribute__((address_space(3)))
typedef unsigned short bf16;
typedef float f32x4 __attribute__((ext_vector_type(4)));
typedef unsigned u32x4 __attribute__((ext_vector_type(4)));
typedef unsigned u32x2 __attribute__((ext_vector_type(2)));
typedef GAS unsigned gu32;

constexpr int BATCH = 16, SEQ = 2048, D = 1024, T = BATCH * SEQ;
constexpr int NPROJ = 11808;
constexpr int AW = 1536;
constexpr int DI = 2048;
constexpr int CONVD = 3072;
constexpr int NH_SSM = 32, NG_SSM = 4, DSTATE = 128;
constexpr int NEXP = 32, TOPK = 4, NASSIGN = T * TOPK;
constexpr int MOE_PAD = 256;
constexpr int CAP = NASSIGN + NEXP * MOE_PAD;
constexpr int NT256 = CAP / 256;
constexpr float EPS = 1e-5f;
constexpr int C_Q = 0, C_K = 1536, C_V = 3072, C_Z = 4608, C_XBC = 6656, C_DT = 9728, C_GATE = 9760;

constexpr size_t MiB = 1u << 20;
constexpr size_t WS_CTL = 0, CTL_ZERO_BYTES = 1 * MiB;
constexpr size_t WS_SMALL = 1 * MiB;
constexpr size_t WS_XN = 34 * MiB;
constexpr size_t WS_Q = 98 * MiB, WS_K = 194 * MiB, WS_V = 290 * MiB;
constexpr size_t WS_Z = 386 * MiB;
constexpr size_t WS_XBC = 514 * MiB;
constexpr size_t WS_GATE = 706 * MiB;
constexpr size_t WS_DT = 834 * MiB;
constexpr size_t WS_ATTN = 838 * MiB;
constexpr size_t WS_M0 = 870 * MiB;
constexpr size_t WS_CONV = WS_K;
constexpr size_t WS_YZ = WS_XBC;
constexpr size_t WS_YN = WS_Z;
constexpr size_t WS_MERGED = WS_XN;
constexpr size_t WS_XN2 = WS_Q;
constexpr size_t WS_TOPI = 162 * MiB;
constexpr size_t WS_TOPW = 163 * MiB;
constexpr size_t WS_SLOT = 164 * MiB;
constexpr size_t WS_ROWMAP = 165 * MiB;
constexpr size_t WS_ACT = 386 * MiB;
constexpr size_t WS_YB = 658 * MiB;
constexpr size_t WS_END = 1024 * MiB;
constexpr int CW_TMO = 0;
constexpr int CW_BAR = 4096;
constexpr int CW_CNT = 16384;
constexpr int CW_CUR = 16384 + 64 * 32;

constexpr int NWAVES = 8, NTHREADS = 512;
constexpr int LDS_BYTES = 147456;
constexpr int MISC_OFF = 131072 + 320;

constexpr int NPHASE = 14;

__device__ __forceinline__ unsigned f2bf(float f) { unsigned u = __builtin_bit_cast(unsigned, f); return (u + 0x7fffu + ((u >> 16) & 1u)) >> 16; }
__device__ __forceinline__ unsigned pk2(float lo, float hi) { return f2bf(lo) | (f2bf(hi) << 16); }
__device__ __forceinline__ float bflo(unsigned u) { return __builtin_bit_cast(float, u << 16); }
__device__ __forceinline__ float bfhi(unsigned u) { return __builtin_bit_cast(float, u & 0xffff0000u); }
__device__ __forceinline__ float bf2f(bf16 b) { return __builtin_bit_cast(float, (unsigned)b << 16); }
__device__ __forceinline__ float wave_sum(float v) {
#pragma unroll
    for (int o = 1; o < 64; o <<= 1) v += __shfl_xor(v, o);
    return v;
}
__device__ __forceinline__ float sigmoidf_(float x) { return 1.f / (1.f + __expf(-x)); }
__device__ __forceinline__ float siluf_(float x) { return x / (1.f + __expf(-x)); }
__device__ __forceinline__ float softplusf_(float x) { return fmaxf(x, 0.f) + log1pf(__expf(-fabsf(x))); }

#define XB_TMO      128
#define XB_XCNT(j)  (256  + 64 * (j))
#define XB_XSUB(j)  (1280 + 64 * (j))
#define XB_XGEN(j)  (2304 + 64 * (j))
#define XB_TOP      3328
#define XB_TOPGEN   3392
#define XCD_BAR_WORDS 3456
#define XB_SPIN_CAP (1u << 18)
__device__ __forceinline__ unsigned xb_ld(unsigned* p)              { return __hip_atomic_load(p, __ATOMIC_RELAXED, __HIP_MEMORY_SCOPE_AGENT); }
__device__ __forceinline__ unsigned xb_add(unsigned* p, unsigned v) { return __hip_atomic_fetch_add(p, v, __ATOMIC_RELAXED, __HIP_MEMORY_SCOPE_AGENT); }
__device__ __forceinline__ unsigned xb_xcc_id() { return (unsigned)__builtin_amdgcn_s_getreg((3 << 11) | 20) & 0xFu; }
#define XB_SPIN(cond, bar) do { unsigned _sp = 0; while (cond) { __builtin_amdgcn_s_sleep(1); \
    if ((++_sp & 255u) == 0u) { if (xb_ld(&(bar)[XB_TMO])) break; if (_sp > XB_SPIN_CAP) { atomicAdd(&(bar)[XB_TMO], 1u); break; } } } } while (0)
struct XcdBarrier { unsigned* bar; unsigned x; volatile LAS unsigned* st; };
__device__ __forceinline__ XcdBarrier xcd_barrier_post(unsigned* bar, volatile LAS unsigned* st) {
    XcdBarrier b; b.bar = bar; b.x = xb_xcc_id(); b.st = st;
    if (threadIdx.x == 0) (void)xb_add(&bar[XB_XCNT(b.x)], 1u);
    return b;
}
__device__ __forceinline__ void xcd_barrier_complete(unsigned* bar, unsigned x, unsigned& nloc, unsigned& nx) {
    const unsigned G = gridDim.x * gridDim.y * gridDim.z;
    unsigned sum, cnt, mine, sp = 0u;
    for (;;) {
        sum = 0u; cnt = 0u; mine = 0u;
#pragma unroll
        for (unsigned j = 0; j < 16; ++j) { const unsigned c = xb_ld(&bar[XB_XCNT(j)]); sum += c; cnt += (c > 0u) ? 1u : 0u; mine = (j == x) ? c : mine; }
        if (sum == G) break;
        __builtin_amdgcn_s_sleep(1);
        if ((++sp & 255u) == 0u) { if (xb_ld(&bar[XB_TMO])) break; if (sp > XB_SPIN_CAP) { atomicAdd(&bar[XB_TMO], 1u); break; } }
    }
    nloc = mine > 0u ? mine : 1u; nx = cnt > 0u ? cnt : 1u;
}
__device__ __forceinline__ void xcd_barrier(const XcdBarrier& b) {
    asm volatile("s_waitcnt vmcnt(0)" ::: "memory");
    __syncthreads();
    if (threadIdx.x == 0) {
        unsigned* bar = b.bar;
        __builtin_amdgcn_s_waitcnt(0);
        unsigned nloc = b.st[0], nx = b.st[1];
        if (nloc == 0u) { xcd_barrier_complete(bar, b.x, nloc, nx); b.st[0] = nloc; b.st[1] = nx; }
        const unsigned old = xb_add(&bar[XB_XSUB(b.x)], 1u);
        const unsigned gen = old / nloc;
        if (old + 1u == (gen + 1u) * nloc) {
            __builtin_amdgcn_fence(__ATOMIC_RELEASE, "agent");
            asm volatile("s_waitcnt vmcnt(0)" ::: "memory");
            const unsigned og = xb_add(&bar[XB_TOP], 1u);
            const unsigned tg = og / nx;
            if (og + 1u == (tg + 1u) * nx) xb_add(&bar[XB_TOPGEN], 1u);
            else XB_SPIN(xb_ld(&bar[XB_TOPGEN]) == tg, bar);
            __builtin_amdgcn_fence(__ATOMIC_ACQUIRE, "agent");
            xb_add(&bar[XB_XGEN(b.x)], 1u);
            asm volatile("s_waitcnt vmcnt(0)" ::: "memory");
        } else {
            XB_SPIN(xb_ld(&bar[XB_XGEN(b.x)]) == gen, bar);
            __builtin_amdgcn_fence(__ATOMIC_ACQUIRE, "agent");
            asm volatile("s_waitcnt vmcnt(0)" ::: "memory");
        }
    }
    __syncthreads();
}

struct Args { const float* in[22]; float* out; unsigned char* ws; int ph_lo, ph_hi, li, pad; };

struct Frame {
    LAS unsigned char* lds;
    int tid, lane, wave, blk, nblk;
    const float *x, *w_in, *rel_bias, *w_ba, *conv_w, *conv_b, *dt_bias, *a_log, *d_skip, *ssm_norm_w, *w_bs, *gate_bias, *w_out,
                *norm_mix, *norm_ffn, *router_w, *router_b, *w1, *b1, *w2, *b2, *norm_final;
    float* out; unsigned char* ws; gu32* ctl;
};

template <class Epi>
__device__ __forceinline__ void gemm_naive(Frame& F, int nMt, int N, int K, const bf16* A, int lda, const int* rowmap,
                                           const float* B, int ldb, const int* texp, size_t estride, const Epi& epi) {
    LAS float* As = (LAS float*)F.lds;
    LAS float* Bs = As + 16 * 132;
    const int tid = F.tid, tx = tid & 31, ty = tid >> 5;
    const int nNt = (N + 127) / 128;
    const int ar = tid >> 2, ak = (tid & 3) * 4;
    const int bk = tid >> 5, bn = (tid & 31) * 4;
    for (int tile = F.blk; tile < nMt * nNt; tile += F.nblk) {
        const int mt = tile / nNt, nt = tile % nNt;
        int e = 0;
        if (texp) { e = texp[mt >> 1]; if (e < 0) continue; }
        const float* Bp = B + (size_t)e * estride;
        float acc[8][4];
#pragma unroll
        for (int i = 0; i < 8; ++i)
#pragma unroll
            for (int j = 0; j < 4; ++j) acc[i][j] = 0.f;
        int grow = mt * 128 + ar; if (rowmap) grow = rowmap[grow];
        const bf16* ap = A + (size_t)(grow < 0 ? 0 : grow) * lda + ak;
        const bool aok = grow >= 0;
        const int gcol = nt * 128 + bn;
        const bool bok = gcol < N;
        for (int k0 = 0; k0 < K; k0 += 16) {
            u32x2 av = (u32x2){0u, 0u};
            if (aok) av = *(const u32x2*)(ap + k0);
            f32x4 bv = (f32x4){0.f, 0.f, 0.f, 0.f};
            if (bok) bv = *(const f32x4*)(Bp + (size_t)(k0 + bk) * ldb + gcol);
            __syncthreads();
            As[(ak + 0) * 132 + ar] = bflo(av.x); As[(ak + 1) * 132 + ar] = bfhi(av.x);
            As[(ak + 2) * 132 + ar] = bflo(av.y); As[(ak + 3) * 132 + ar] = bfhi(av.y);
            *(LAS f32x4*)&Bs[bk * 132 + bn] = bv;
            __syncthreads();
#pragma unroll
            for (int k = 0; k < 16; ++k) {
                const f32x4 a0 = *(const LAS f32x4*)&As[k * 132 + ty * 8], a1 = *(const LAS f32x4*)&As[k * 132 + ty * 8 + 4];
                const f32x4 b = *(const LAS f32x4*)&Bs[k * 132 + tx * 4];
                const float a[8] = {a0.x, a0.y, a0.z, a0.w, a1.x, a1.y, a1.z, a1.w};
                const float bb[4] = {b.x, b.y, b.z, b.w};
#pragma unroll
                for (int i = 0; i < 8; ++i)
#pragma unroll
                    for (int j = 0; j < 4; ++j) acc[i][j] = fmaf(a[i], bb[j], acc[i][j]);
            }
        }
        const int col0 = nt * 128 + tx * 4;
        if (col0 < N) {
#pragma unroll
            for (int i = 0; i < 8; ++i) epi(mt * 128 + ty * 8 + i, col0, (f32x4){acc[i][0], acc[i][1], acc[i][2], acc[i][3]}, e);
        }
    }
    __syncthreads();
}

__device__ __forceinline__ void st_bf4(bf16* p, f32x4 v) { u32x2 w; w.x = pk2(v.x, v.y); w.y = pk2(v.z, v.w); *(u32x2*)p = w; }

struct EpiInProj {
    unsigned char* ws; const float* dt_bias; const float* gate_bias;
    __device__ __forceinline__ void operator()(int row, int col, f32x4 v, int) const {
        if (col < C_K)        st_bf4((bf16*)(ws + WS_Q) + (size_t)row * AW + (col - C_Q), v);
        else if (col < C_V)   st_bf4((bf16*)(ws + WS_K) + (size_t)row * AW + (col - C_K), v);
        else if (col < C_Z)   st_bf4((bf16*)(ws + WS_V) + (size_t)row * AW + (col - C_V), v);
        else if (col < C_XBC) st_bf4((bf16*)(ws + WS_Z) + (size_t)row * DI + (col - C_Z), v);
        else if (col < C_DT)  st_bf4((bf16*)(ws + WS_XBC) + (size_t)row * CONVD + (col - C_XBC), v);
        else if (col < C_GATE) { const int c = col - C_DT; f32x4 o;
            o.x = softplusf_(v.x + dt_bias[c]); o.y = softplusf_(v.y + dt_bias[c + 1]); o.z = softplusf_(v.z + dt_bias[c + 2]); o.w = softplusf_(v.w + dt_bias[c + 3]);
            *(f32x4*)((float*)(ws + WS_DT) + (size_t)row * 32 + c) = o; }
        else { const int c = col - C_GATE; f32x4 o;
            o.x = sigmoidf_(v.x + gate_bias[c]); o.y = sigmoidf_(v.y + gate_bias[c + 1]); o.z = sigmoidf_(v.z + gate_bias[c + 2]); o.w = sigmoidf_(v.w + gate_bias[c + 3]);
            st_bf4((bf16*)(ws + WS_GATE) + (size_t)row * 2048 + c, o); }
    }
};
struct EpiM0 {
    unsigned char* ws;
    __device__ __forceinline__ void operator()(int row, int col, f32x4 v, int) const {
        const u32x2 g = *(const u32x2*)((const bf16*)(ws + WS_GATE) + (size_t)row * 2048 + col);
        f32x4 o; o.x = v.x * bflo(g.x); o.y = v.y * bfhi(g.x); o.z = v.z * bflo(g.y); o.w = v.w * bfhi(g.y);
        *(f32x4*)((float*)(ws + WS_M0) + (size_t)row * D + col) = o;
    }
};
struct EpiMerged {
    unsigned char* ws;
    __device__ __forceinline__ void operator()(int row, int col, f32x4 v, int) const {
        const u32x2 g = *(const u32x2*)((const bf16*)(ws + WS_GATE) + (size_t)row * 2048 + 1024 + col);
        const f32x4 m = *(const f32x4*)((const float*)(ws + WS_M0) + (size_t)row * D + col);
        f32x4 o; o.x = m.x + v.x * bflo(g.x); o.y = m.y + v.y * bfhi(g.x); o.z = m.z + v.z * bflo(g.y); o.w = m.w + v.w * bfhi(g.y);
        st_bf4((bf16*)(ws + WS_MERGED) + (size_t)row * D + col, o);
    }
};
struct EpiX1 {
    const float* x; float* out;
    __device__ __forceinline__ void operator()(int row, int col, f32x4 v, int) const {
        const f32x4 xv = *(const f32x4*)(x + (size_t)row * D + col);
        *(f32x4*)(out + (size_t)row * D + col) = xv + v;
    }
};
__device__ __forceinline__ float swiglu_(float g, float l) {
    g = fminf(g, 7.f); l = fminf(fmaxf(l, -7.f), 7.f);
    return g * sigmoidf_(1.702f * g) * (l + 1.f);
}
struct EpiMoe1 {
    unsigned char* ws; const float* b1;
    __device__ __forceinline__ void operator()(int row, int col, f32x4 v, int e) const {
        const f32x4 b = *(const f32x4*)(b1 + (size_t)e * 2048 + col);
        const float o0 = swiglu_(v.x + b.x, v.y + b.y), o1 = swiglu_(v.z + b.z, v.w + b.w);
        *(unsigned*)((bf16*)(ws + WS_ACT) + (size_t)row * 1024 + (col >> 1)) = pk2(o0, o1);
    }
};
struct EpiMoe2 {
    unsigned char* ws; const float* b2;
    __device__ __forceinline__ void operator()(int row, int col, f32x4 v, int e) const {
        const f32x4 b = *(const f32x4*)(b2 + (size_t)e * 1024 + col);
        st_bf4((bf16*)(ws + WS_YB) + (size_t)row * 1024 + col, v + b);
    }
};

__device__ __forceinline__ void p_rmsnorm_in(Frame& F) {
    const int gw = F.blk * NWAVES + F.wave, NGW = F.nblk * NWAVES;
    bf16* XN = (bf16*)(F.ws + WS_XN);
    for (int m = gw; m < T; m += NGW) {
        const f32x4* xr = (const f32x4*)(F.x + (size_t)m * D) + F.lane;
        const f32x4* wr = (const f32x4*)F.norm_mix + F.lane;
        f32x4 v[4]; float s = 0.f;
#pragma unroll
        for (int j = 0; j < 4; ++j) { v[j] = xr[64 * j]; s += (v[j].x * v[j].x + v[j].y * v[j].y) + (v[j].z * v[j].z + v[j].w * v[j].w); }
        const float rstd = 1.f / sqrtf(wave_sum(s) * (1.f / D) + EPS);
#pragma unroll
        for (int j = 0; j < 4; ++j) { const f32x4 w = wr[64 * j]; const f32x4 o = v[j] * rstd * w; st_bf4(XN + (size_t)m * D + (F.lane + 64 * j) * 4, o); }
    }
}

__device__ __forceinline__ int t5_bucket_dev(int dist) {
    if (dist < 16) return dist;
    int l = 16 + (int)(logf((float)dist / 16.f) / logf(128.f) * 16.f);
    return l < 31 ? l : 31;
}
__device__ __forceinline__ void p_attn_naive(Frame& F) {
    LAS float* btab = (LAS float*)F.lds;
    for (int i = F.tid; i < 3 * 129 * 8; i += NTHREADS) {
        const int g = i / (129 * 8), j = (i >> 3) % 129, hg = i & 7;
        const int dil = g == 0 ? 1 : (g == 1 ? 4 : 16);
        btab[i] = F.rel_bias[t5_bucket_dev(j * dil) * 24 + g * 8 + hg];
    }
    __syncthreads();
    const bf16* Qb = (const bf16*)(F.ws + WS_Q); const bf16* Kb = (const bf16*)(F.ws + WS_K); const bf16* Vb = (const bf16*)(F.ws + WS_V);
    bf16* AT = (bf16*)(F.ws + WS_ATTN);
    for (int idx = F.blk * NTHREADS + F.tid; idx < T * 8; idx += F.nblk * NTHREADS) {
        const int hg = idx & 7, row = idx >> 3, t = row & (SEQ - 1);
        float m = -INFINITY, den = 0.f;
        float acc[64];
#pragma unroll
        for (int i = 0; i < 64; ++i) acc[i] = 0.f;
        for (int g = 0; g < 3; ++g) {
            const int dil = g == 0 ? 1 : (g == 1 ? 4 : 16);
            const int head = g * 8 + hg;
            float q[64];
            { const u32x4* qp = (const u32x4*)(Qb + (size_t)row * AW + head * 64);
#pragma unroll
              for (int c = 0; c < 8; ++c) { const u32x4 w = qp[c]; q[8 * c + 0] = bflo(w.x); q[8 * c + 1] = bfhi(w.x); q[8 * c + 2] = bflo(w.y); q[8 * c + 3] = bfhi(w.y);
                  q[8 * c + 4] = bflo(w.z); q[8 * c + 5] = bfhi(w.z); q[8 * c + 6] = bflo(w.w); q[8 * c + 7] = bfhi(w.w); } }
            for (int j = 0; j <= 128; ++j) {
                const int kt = t - j * dil; if (kt < 0) break;
                const size_t krow = (size_t)(row - j * dil);
                const u32x4* kp = (const u32x4*)(Kb + krow * AW + head * 64);
                float s = 0.f;
#pragma unroll
                for (int c = 0; c < 8; ++c) { const u32x4 w = kp[c];
                    s += q[8 * c + 0] * bflo(w.x) + q[8 * c + 1] * bfhi(w.x) + q[8 * c + 2] * bflo(w.y) + q[8 * c + 3] * bfhi(w.y)
                       + q[8 * c + 4] * bflo(w.z) + q[8 * c + 5] * bfhi(w.z) + q[8 * c + 6] * bflo(w.w) + q[8 * c + 7] * bfhi(w.w); }
                s = s * 0.125f + btab[(g * 129 + j) * 8 + hg];
                const float mn = fmaxf(m, s), sc = __expf(m - mn), p = __expf(s - mn);
                m = mn; den = den * sc + p;
                const u32x4* vp = (const u32x4*)(Vb + krow * AW + head * 64);
#pragma unroll
                for (int c = 0; c < 8; ++c) { const u32x4 w = vp[c];
                    acc[8 * c + 0] = acc[8 * c + 0] * sc + p * bflo(w.x); acc[8 * c + 1] = acc[8 * c + 1] * sc + p * bfhi(w.x);
                    acc[8 * c + 2] = acc[8 * c + 2] * sc + p * bflo(w.y); acc[8 * c + 3] = acc[8 * c + 3] * sc + p * bfhi(w.y);
                    acc[8 * c + 4] = acc[8 * c + 4] * sc + p * bflo(w.z); acc[8 * c + 5] = acc[8 * c + 5] * sc + p * bfhi(w.z);
                    acc[8 * c + 6] = acc[8 * c + 6] * sc + p * bflo(w.w); acc[8 * c + 7] = acc[8 * c + 7] * sc + p * bfhi(w.w); }
            }
        }
        const float inv = 1.f / den;
        u32x4* op = (u32x4*)(AT + (size_t)row * 512 + hg * 64);
#pragma unroll
        for (int c = 0; c < 8; ++c) { u32x4 w; w.x = pk2(acc[8 * c] * inv, acc[8 * c + 1] * inv); w.y = pk2(acc[8 * c + 2] * inv, acc[8 * c + 3] * inv);
            w.z = pk2(acc[8 * c + 4] * inv, acc[8 * c + 5] * inv); w.w = pk2(acc[8 * c + 6] * inv, acc[8 * c + 7] * inv); op[c] = w; }
    }
    __syncthreads();
}

__device__ __forceinline__ void p_conv(Frame& F) {
    const bf16* X = (const bf16*)(F.ws + WS_XBC); bf16* O = (bf16*)(F.ws + WS_CONV);
    const int total = T * (CONVD / 8);
    for (int idx = F.blk * NTHREADS + F.tid; idx < total; idx += F.nblk * NTHREADS) {
        const int row = idx / (CONVD / 8), c0 = (idx % (CONVD / 8)) * 8, t = row & (SEQ - 1);
        float a[8];
#pragma unroll
        for (int i = 0; i < 8; ++i) a[i] = F.conv_b[c0 + i];
#pragma unroll
        for (int w = 0; w < 4; ++w) {
            const int tt = t + w - 3; if (tt < 0) continue;
            const u32x4 u = *(const u32x4*)(X + (size_t)(row + w - 3) * CONVD + c0);
            const float* cw = F.conv_w + (size_t)w * CONVD + c0;
            a[0] += cw[0] * bflo(u.x); a[1] += cw[1] * bfhi(u.x); a[2] += cw[2] * bflo(u.y); a[3] += cw[3] * bfhi(u.y);
            a[4] += cw[4] * bflo(u.z); a[5] += cw[5] * bfhi(u.z); a[6] += cw[6] * bflo(u.w); a[7] += cw[7] * bfhi(u.w);
        }
        u32x4 o; o.x = pk2(siluf_(a[0]), siluf_(a[1])); o.y = pk2(siluf_(a[2]), siluf_(a[3])); o.z = pk2(siluf_(a[4]), siluf_(a[5])); o.w = pk2(siluf_(a[6]), siluf_(a[7]));
        *(u32x4*)(O + (size_t)row * CONVD + c0) = o;
    }
}

__device__ __forceinline__ void p_ssd_naive(Frame& F) {
    const bf16* CV = (const bf16*)(F.ws + WS_CONV); const float* DT = (const float*)(F.ws + WS_DT); const bf16* Z = (const bf16*)(F.ws + WS_Z);
    bf16* YZ = (bf16*)(F.ws + WS_YZ);
    const int t256 = F.tid & 255, p = t256 >> 2, q = t256 & 3;
    for (int unit = F.blk * 2 + (F.tid >> 8); unit < BATCH * NH_SSM; unit += F.nblk * 2) {
        const int b = unit / NH_SSM, h = unit % NH_SSM, g = h / 8;
        const float a = -__expf(F.a_log[h]), dsk = F.d_skip[h];
        float st[32];
#pragma unroll
        for (int i = 0; i < 32; ++i) st[i] = 0.f;
        for (int t = 0; t < SEQ; ++t) {
            const size_t row = (size_t)b * SEQ + t;
            const float dt = DT[row * 32 + h];
            const float dA = __expf(dt * a);
            const float xv = bf2f(CV[row * CONVD + h * 64 + p]);
            const float dtx = dt * xv;
            const u32x4* bp = (const u32x4*)(CV + row * CONVD + 2048 + g * 128 + q * 32);
            const u32x4* cp = (const u32x4*)(CV + row * CONVD + 2560 + g * 128 + q * 32);
            float yp = 0.f;
#pragma unroll
            for (int c = 0; c < 4; ++c) {
                const u32x4 bw = bp[c], cw = cp[c];
                const float bv[8] = {bflo(bw.x), bfhi(bw.x), bflo(bw.y), bfhi(bw.y), bflo(bw.z), bfhi(bw.z), bflo(bw.w), bfhi(bw.w)};
                const float cv[8] = {bflo(cw.x), bfhi(cw.x), bflo(cw.y), bfhi(cw.y), bflo(cw.z), bfhi(cw.z), bflo(cw.w), bfhi(cw.w)};
#pragma unroll
                for (int i = 0; i < 8; ++i) { st[8 * c + i] = st[8 * c + i] * dA + dtx * bv[i]; yp += cv[i] * st[8 * c + i]; }
            }
            yp += __shfl_xor(yp, 1); yp += __shfl_xor(yp, 2);
            if (q == 0) {
                const float y = yp + dsk * xv;
                const float z = bf2f(Z[row * DI + h * 64 + p]);
                YZ[row * DI + h * 64 + p] = (bf16)f2bf(y * siluf_(z));
            }
        }
    }
}

__device__ __forceinline__ void p_ypost(Frame& F) {
    const int gw = F.blk * NWAVES + F.wave, NGW = F.nblk * NWAVES;
    const bf16* YZ = (const bf16*)(F.ws + WS_YZ); bf16* YN = (bf16*)(F.ws + WS_YN);
    for (int m = gw; m < T; m += NGW) {
#pragma unroll
        for (int g = 0; g < 4; ++g) {
            const int c0 = g * 512 + F.lane * 8;
            const u32x4 w = *(const u32x4*)(YZ + (size_t)m * DI + c0);
            float v[8] = {bflo(w.x), bfhi(w.x), bflo(w.y), bfhi(w.y), bflo(w.z), bfhi(w.z), bflo(w.w), bfhi(w.w)};
            float s = 0.f;
#pragma unroll
            for (int i = 0; i < 8; ++i) s += v[i] * v[i];
            const float rstd = 1.f / sqrtf(wave_sum(s) * (1.f / 512.f) + EPS);
            const float* nw = F.ssm_norm_w + c0;
            u32x4 o; o.x = pk2(v[0] * rstd * nw[0], v[1] * rstd * nw[1]); o.y = pk2(v[2] * rstd * nw[2], v[3] * rstd * nw[3]);
            o.z = pk2(v[4] * rstd * nw[4], v[5] * rstd * nw[5]); o.w = pk2(v[6] * rstd * nw[6], v[7] * rstd * nw[7]);
            *(u32x4*)(YN + (size_t)m * DI + c0) = o;
        }
    }
}

__device__ __forceinline__ void p_router(Frame& F) {
    LAS int* hist = (LAS int*)F.lds;
    if (F.tid < 32) hist[F.tid] = 0;
    __syncthreads();
    int* ROWMAP = (int*)(F.ws + WS_ROWMAP);
    for (int i = F.blk * NTHREADS + F.tid; i < CAP; i += F.nblk * NTHREADS) ROWMAP[i] = -1;
    const int gw = F.blk * NWAVES + F.wave, NGW = F.nblk * NWAVES;
    bf16* XN2 = (bf16*)(F.ws + WS_XN2); int* TOPI = (int*)(F.ws + WS_TOPI); float* TOPW = (float*)(F.ws + WS_TOPW);
    for (int m = gw; m < T; m += NGW) {
        const f32x4* xr = (const f32x4*)(F.out + (size_t)m * D) + F.lane;
        const f32x4* wr = (const f32x4*)F.norm_ffn + F.lane;
        f32x4 v[4]; float s = 0.f;
#pragma unroll
        for (int j = 0; j < 4; ++j) { v[j] = xr[64 * j]; s += (v[j].x * v[j].x + v[j].y * v[j].y) + (v[j].z * v[j].z + v[j].w * v[j].w); }
        const float rstd = 1.f / sqrtf(wave_sum(s) * (1.f / D) + EPS);
        float lg[32];
#pragma unroll
        for (int e = 0; e < 32; ++e) lg[e] = 0.f;
#pragma unroll
        for (int j = 0; j < 4; ++j) {
            v[j] = v[j] * rstd * wr[64 * j];
            st_bf4(XN2 + (size_t)m * D + (F.lane + 64 * j) * 4, v[j]);
            const float hv[4] = {v[j].x, v[j].y, v[j].z, v[j].w};
#pragma unroll
            for (int i = 0; i < 4; ++i) {
                const f32x4* rw = (const f32x4*)(F.router_w + (size_t)((F.lane + 64 * j) * 4 + i) * 32);
#pragma unroll
                for (int c = 0; c < 8; ++c) { const f32x4 w = rw[c]; lg[4 * c] += hv[i] * w.x; lg[4 * c + 1] += hv[i] * w.y; lg[4 * c + 2] += hv[i] * w.z; lg[4 * c + 3] += hv[i] * w.w; }
            }
        }
#pragma unroll
        for (int e = 0; e < 32; ++e) lg[e] = wave_sum(lg[e]) + F.router_b[e];
        int bi[4]; float bv[4];
#pragma unroll
        for (int k = 0; k < 4; ++k) {
            float best = -INFINITY; int be = 0;
#pragma unroll
            for (int e = 0; e < 32; ++e) if (lg[e] > best) { best = lg[e]; be = e; }
            bi[k] = be; bv[k] = best;
#pragma unroll
            for (int e = 0; e < 32; ++e) if (e == be) lg[e] = -INFINITY;
        }
        const float e0 = 1.f, e1 = __expf(bv[1] - bv[0]), e2 = __expf(bv[2] - bv[0]), e3 = __expf(bv[3] - bv[0]);
        const float inv = 1.f / (e0 + e1 + e2 + e3);
        if (F.lane == 0) {
            *(int4*)(TOPI + (size_t)m * 4) = make_int4(bi[0], bi[1], bi[2], bi[3]);
            *(f32x4*)(TOPW + (size_t)m * 4) = (f32x4){e0 * inv, e1 * inv, e2 * inv, e3 * inv};
            atomicAdd((int*)&hist[bi[0]], 1); atomicAdd((int*)&hist[bi[1]], 1); atomicAdd((int*)&hist[bi[2]], 1); atomicAdd((int*)&hist[bi[3]], 1);
        }
    }
    __syncthreads();
    if (F.tid < 32) atomicAdd((unsigned*)(F.ctl + CW_CNT + 64 * F.tid), (unsigned)hist[F.tid]);
    __syncthreads();
}

__device__ __forceinline__ void p_slots(Frame& F) {
    LAS int* hist = (LAS int*)F.lds;
    LAS int* base = hist + 32;
    LAS int* pst = hist + 64;
    if (F.tid == 0) {
        int acc = 0;
        for (int e = 0; e < 32; ++e) { const int c = (int)__hip_atomic_load((unsigned*)(F.ctl + CW_CNT + 64 * e), __ATOMIC_RELAXED, __HIP_MEMORY_SCOPE_AGENT); pst[e] = acc; acc += (c + MOE_PAD - 1) / MOE_PAD * MOE_PAD; }
        pst[32] = acc;
    }
    __syncthreads();
    if (F.blk == 0) {
        int* TEXP = (int*)(F.ws + WS_SMALL);
        for (int i = F.tid; i < NT256; i += NTHREADS) { const int r = i * 256; int e = -1;
            for (int k = 0; k < 32; ++k) if (r >= pst[k] && r < pst[k + 1]) e = k;
            TEXP[i] = e; }
    }
    const int* TOPI = (const int*)(F.ws + WS_TOPI); int* SLOT = (int*)(F.ws + WS_SLOT); int* ROWMAP = (int*)(F.ws + WS_ROWMAP);
    for (int c = F.blk; c < T / 128; c += F.nblk) {
        if (F.tid < 32) hist[F.tid] = 0;
        __syncthreads();
        const int ai = c * 512 + F.tid;
        const int e = TOPI[ai];
        const int lr = atomicAdd((int*)&hist[e], 1);
        __syncthreads();
        if (F.tid < 32) base[F.tid] = (int)atomicAdd((unsigned*)(F.ctl + CW_CUR + 64 * F.tid), (unsigned)hist[F.tid]);
        __syncthreads();
        const int slot = pst[e] + base[e] + lr;
        SLOT[ai] = slot; ROWMAP[slot] = ai >> 2;
        __syncthreads();
    }
}

__device__ __forceinline__ void p_final(Frame& F) {
    const int gw = F.blk * NWAVES + F.wave, NGW = F.nblk * NWAVES;
    const int* SLOT = (const int*)(F.ws + WS_SLOT); const float* TOPW = (const float*)(F.ws + WS_TOPW); const bf16* YB = (const bf16*)(F.ws + WS_YB);
    for (int m = gw; m < T; m += NGW) {
        f32x4* xr = (f32x4*)(F.out + (size_t)m * D) + F.lane;
        const f32x4* wr = (const f32x4*)F.norm_final + F.lane;
        f32x4 v[4];
#pragma unroll
        for (int j = 0; j < 4; ++j) v[j] = xr[64 * j];
#pragma unroll
        for (int k = 0; k < 4; ++k) {
            const int sl = SLOT[m * 4 + k]; const float w = TOPW[m * 4 + k];
#pragma unroll
            for (int j = 0; j < 4; ++j) { const u32x2 y = *(const u32x2*)(YB + (size_t)sl * 1024 + (F.lane + 64 * j) * 4);
                v[j].x += w * bflo(y.x); v[j].y += w * bfhi(y.x); v[j].z += w * bflo(y.y); v[j].w += w * bfhi(y.y); }
        }
        float s = 0.f;
#pragma unroll
        for (int j = 0; j < 4; ++j) s += (v[j].x * v[j].x + v[j].y * v[j].y) + (v[j].z * v[j].z + v[j].w * v[j].w);
        const float rstd = 1.f / sqrtf(wave_sum(s) * (1.f / D) + EPS);
#pragma unroll
        for (int j = 0; j < 4; ++j) xr[64 * j] = v[j] * rstd * wr[64 * j];
    }
}

__global__ void __launch_bounds__(NTHREADS, 2) fwd(Args args) {
    extern __shared__ __attribute__((aligned(16))) unsigned char lds_raw[];
    Frame F;
    F.lds = (LAS unsigned char*)lds_raw;
    F.tid = threadIdx.x; F.lane = F.tid & 63; F.wave = __builtin_amdgcn_readfirstlane(F.tid >> 6);
    F.blk = blockIdx.x; F.nblk = gridDim.x;
    F.x = args.in[0]; F.w_in = args.in[1]; F.rel_bias = args.in[2]; F.w_ba = args.in[3]; F.conv_w = args.in[4]; F.conv_b = args.in[5];
    F.dt_bias = args.in[6]; F.a_log = args.in[7]; F.d_skip = args.in[8]; F.ssm_norm_w = args.in[9]; F.w_bs = args.in[10]; F.gate_bias = args.in[11];
    F.w_out = args.in[12]; F.norm_mix = args.in[13]; F.norm_ffn = args.in[14]; F.router_w = args.in[15]; F.router_b = args.in[16];
    F.w1 = args.in[17]; F.b1 = args.in[18]; F.w2 = args.in[19]; F.b2 = args.in[20]; F.norm_final = args.in[21];
    F.out = args.out; F.ws = args.ws; F.ctl = (gu32*)(args.ws + WS_CTL);
    volatile LAS unsigned* MISC = (volatile LAS unsigned*)(F.lds + MISC_OFF);
    if (F.tid < 32) MISC[F.tid] = 0u;
    __syncthreads();
    XcdBarrier bar; bar.bar = (unsigned*)(F.ctl + CW_BAR); bar.x = 0; bar.st = nullptr;
#if MK_FUSED
    bar = xcd_barrier_post((unsigned*)(F.ctl + CW_BAR), MISC + 8);
#define GRID_BAR() xcd_barrier(bar)
#else
#define GRID_BAR() do { } while (0)
#endif
    const int lo = args.ph_lo, hi = args.ph_hi;
#define IN(k) (lo <= (k) && (k) < hi)
#define SEAM(k) do { if (IN(k) && IN((k) + 1)) GRID_BAR(); } while (0)
    unsigned char* ws = F.ws;

    if (IN(0)) { p_rmsnorm_in(F); } SEAM(0);
    if (IN(1)) { EpiInProj E{ws, F.dt_bias, F.gate_bias}; gemm_naive(F, T / 128, NPROJ, D, (const bf16*)(ws + WS_XN), D, nullptr, F.w_in, NPROJ, nullptr, 0, E); } SEAM(1);
    if (IN(2)) { p_attn_naive(F); } SEAM(2);
    if (IN(3)) { p_conv(F); } SEAM(3);
    if (IN(4)) { p_ssd_naive(F); } SEAM(4);
    if (IN(5)) { p_ypost(F); } SEAM(5);
    if (IN(6)) { EpiM0 E{ws}; gemm_naive(F, T / 128, D, 512, (const bf16*)(ws + WS_ATTN), 512, nullptr, F.w_ba, D, nullptr, 0, E); } SEAM(6);
    if (IN(7)) { EpiMerged E{ws}; gemm_naive(F, T / 128, D, DI, (const bf16*)(ws + WS_YN), DI, nullptr, F.w_bs, D, nullptr, 0, E); } SEAM(7);
    if (IN(8)) { EpiX1 E{F.x, F.out}; gemm_naive(F, T / 128, D, D, (const bf16*)(ws + WS_MERGED), D, nullptr, F.w_out, D, nullptr, 0, E); } SEAM(8);
    if (IN(9)) { p_router(F); } SEAM(9);
    if (IN(10)) { p_slots(F); } SEAM(10);
    if (IN(11)) { EpiMoe1 E{ws, F.b1}; gemm_naive(F, CAP / 128, 2048, D, (const bf16*)(ws + WS_XN2), D, (const int*)(ws + WS_ROWMAP), F.w1, 2048, (const int*)(ws + WS_SMALL), (size_t)1024 * 2048, E); } SEAM(11);
    if (IN(12)) { EpiMoe2 E{ws, F.b2}; gemm_naive(F, CAP / 128, 1024, 1024, (const bf16*)(ws + WS_ACT), 1024, nullptr, F.w2, 1024, (const int*)(ws + WS_SMALL), (size_t)1024 * 1024, E); } SEAM(12);
    if (IN(13)) { p_final(F); }
#undef IN
#undef SEAM
}

extern "C" void kernel_launch(void* const* d_in, const int* in_sizes, int n_in, void* d_out, int out_size, void* d_ws, size_t ws_size, hipStream_t stream) {
    static int grid = 0;
    if (grid == 0) {
        if (n_in != 22 || out_size != T * D || ws_size < WS_END) { fprintf(stderr, "kernel_launch: unexpected shapes: n_in %d out %d ws %zu\n", n_in, out_size, ws_size); grid = -1; return; }
        int dev = 0, cus = 0, per_cu = 0;
        if (hipGetDevice(&dev) != hipSuccess || hipDeviceGetAttribute(&cus, hipDeviceAttributeMultiprocessorCount, dev) != hipSuccess) { grid = -1; return; }
        if (hipFuncSetAttribute((const void*)fwd, hipFuncAttributeMaxDynamicSharedMemorySize, LDS_BYTES) != hipSuccess) { fprintf(stderr, "kernel_launch: hipFuncSetAttribute failed\n"); grid = -1; return; }
        if (hipOccupancyMaxActiveBlocksPerMultiprocessor(&per_cu, (const void*)fwd, NTHREADS, LDS_BYTES) != hipSuccess || per_cu < 1) fprintf(stderr, "kernel_launch: occupancy query says %d\n", per_cu);
        (void)hipGetLastError();
        grid = cus;
    }
    if (grid < 0) return;
    (void)hipMemsetAsync((char*)d_ws + WS_CTL, 0, CTL_ZERO_BYTES, stream);
    Args a{};
    for (int i = 0; i < 22; ++i) a.in[i] = (const float*)d_in[i];
    a.out = (float*)d_out; a.ws = (unsigned char*)d_ws;
#if MK_FUSED
    a.ph_lo = 0; a.ph_hi = NPHASE; a.li = 0;
    hipLaunchKernelGGL(fwd, dim3(grid), dim3(NTHREADS), LDS_BYTES, stream, a);
#else
    for (int p = 0; p < NPHASE; ++p) { a.ph_lo = p; a.ph_hi = p + 1; a.li = p; hipLaunchKernelGGL(fwd, dim3(grid), dim3(NTHREADS), LDS_BYTES, stream, a); }
#endif
}
```

```cpp
#include <hip/hip_runtime.h>
#include <cstdio>
#include <cstdint>

#ifndef MK_FUSED
#define MK_FUSED 1
#endif

#define GAS __attribute__((address_space(1)))
#define LAS __attribute__((address_space(3)))
typedef unsigned short bf16;
typedef float f32x4 __attribute__((ext_vector_type(4)));
typedef unsigned u32x4 __attribute__((ext_vector_type(4)));
typedef unsigned u32x2 __attribute__((ext_vector_type(2)));
typedef GAS unsigned gu32;

constexpr int BATCH = 16, SEQ = 2048, D = 1024, T = BATCH * SEQ;
constexpr int NPROJ = 11808;
constexpr int AW = 1536;
constexpr int DI = 2048;
constexpr int CONVD = 3072;
constexpr int NH_SSM = 32, NG_SSM = 4, DSTATE = 128;
constexpr int NEXP = 32, TOPK = 4, NASSIGN = T * TOPK;
constexpr int MOE_PAD = 256;
constexpr int CAP = NASSIGN + NEXP * MOE_PAD;
constexpr int NT256 = CAP / 256;
constexpr float EPS = 1e-5f;
constexpr int C_Q = 0, C_K = 1536, C_V = 3072, C_Z = 4608, C_XBC = 6656, C_DT = 9728, C_GATE = 9760;

constexpr size_t MiB = 1u << 20;
constexpr size_t WS_CTL = 0, CTL_ZERO_BYTES = 1 * MiB;
constexpr size_t WS_SMALL = 1 * MiB;
constexpr size_t WS_XN = 34 * MiB;
constexpr size_t WS_Q = 98 * MiB, WS_K = 194 * MiB, WS_V = 290 * MiB;
constexpr size_t WS_Z = 386 * MiB;
constexpr size_t WS_XBC = 514 * MiB;
constexpr size_t WS_GATE = 706 * MiB;
constexpr size_t WS_DT = 834 * MiB;
constexpr size_t WS_ATTN = 838 * MiB;
constexpr size_t WS_M0 = 870 * MiB;
constexpr size_t WS_CONV = WS_K;
constexpr size_t WS_YZ = WS_XBC;
constexpr size_t WS_YN = WS_Z;
constexpr size_t WS_MERGED = WS_XN;
constexpr size_t WS_XN2 = WS_Q;
constexpr size_t WS_TOPI = 162 * MiB;
constexpr size_t WS_TOPW = 163 * MiB;
constexpr size_t WS_SLOT = 164 * MiB;
constexpr size_t WS_ROWMAP = 165 * MiB;
constexpr size_t WS_ACT = 386 * MiB;
constexpr size_t WS_YB = 658 * MiB;
constexpr size_t WS_END = 1024 * MiB;
constexpr int CW_TMO = 0;
constexpr int CW_BAR = 4096;
constexpr int CW_CNT = 16384;
constexpr int CW_CUR = 16384 + 64 * 32;

constexpr int NWAVES = 8, NTHREADS = 512;
constexpr int LDS_BYTES = 147456;
constexpr int MISC_OFF = 131072 + 320;

constexpr int NPHASE = 14;

__device__ __forceinline__ unsigned f2bf(float f) { unsigned u = __builtin_bit_cast(unsigned, f); return (u + 0x7fffu + ((u >> 16) & 1u)) >> 16; }
__device__ __forceinline__ unsigned pk2(float lo, float hi) { return f2bf(lo) | (f2bf(hi) << 16); }
__device__ __forceinline__ float bflo(unsigned u) { return __builtin_bit_cast(float, u << 16); }
__device__ __forceinline__ float bfhi(unsigned u) { return __builtin_bit_cast(float, u & 0xffff0000u); }
__device__ __forceinline__ float bf2f(bf16 b) { return __builtin_bit_cast(float, (unsigned)b << 16); }
__device__ __forceinline__ float wave_sum(float v) {
#pragma unroll
    for (int o = 1; o < 64; o <<= 1) v += __shfl_xor(v, o);
    return v;
}
__device__ __forceinline__ float sigmoidf_(float x) { return 1.f / (1.f + __expf(-x)); }
__device__ __forceinline__ float siluf_(float x) { return x / (1.f + __expf(-x)); }
__device__ __forceinline__ float softplusf_(float x) { return fmaxf(x, 0.f) + log1pf(__expf(-fabsf(x))); }

#define XB_TMO      128
#define XB_XCNT(j)  (256  + 64 * (j))
#define XB_XSUB(j)  (1280 + 64 * (j))
#define XB_XGEN(j)  (2304 + 64 * (j))
#define XB_TOP      3328
#define XB_TOPGEN   3392
#define XCD_BAR_WORDS 3456
#define XB_SPIN_CAP (1u << 18)
__device__ __forceinline__ unsigned xb_ld(unsigned* p)              { return __hip_atomic_load(p, __ATOMIC_RELAXED, __HIP_MEMORY_SCOPE_AGENT); }
__device__ __forceinline__ unsigned xb_add(unsigned* p, unsigned v) { return __hip_atomic_fetch_add(p, v, __ATOMIC_RELAXED, __HIP_MEMORY_SCOPE_AGENT); }
__device__ __forceinline__ unsigned xb_xcc_id() { return (unsigned)__builtin_amdgcn_s_getreg((3 << 11) | 20) & 0xFu; }
#define XB_SPIN(cond, bar) do { unsigned _sp = 0; while (cond) { __builtin_amdgcn_s_sleep(1); \
    if ((++_sp & 255u) == 0u) { if (xb_ld(&(bar)[XB_TMO])) break; if (_sp > XB_SPIN_CAP) { atomicAdd(&(bar)[XB_TMO], 1u); break; } } } } while (0)
struct XcdBarrier { unsigned* bar; unsigned x; volatile LAS unsigned* st; };
__device__ __forceinline__ XcdBarrier xcd_barrier_post(unsigned* bar, volatile LAS unsigned* st) {
    XcdBarrier b; b.bar = bar; b.x = xb_xcc_id(); b.st = st;
    if (threadIdx.x == 0) (void)xb_add(&bar[XB_XCNT(b.x)], 1u);
    return b;
}
__device__ __forceinline__ void xcd_barrier_complete(unsigned* bar, unsigned x, unsigned& nloc, unsigned& nx) {
    const unsigned G = gridDim.x * gridDim.y * gridDim.z;
    unsigned sum, cnt, mine, sp = 0u;
    for (;;) {
        sum = 0u; cnt = 0u; mine = 0u;
#pragma unroll
        for (unsigned j = 0; j < 16; ++j) { const unsigned c = xb_ld(&bar[XB_XCNT(j)]); sum += c; cnt += (c > 0u) ? 1u : 0u; mine = (j == x) ? c : mine; }
        if (sum == G) break;
        __builtin_amdgcn_s_sleep(1);
        if ((++sp & 255u) == 0u) { if (xb_ld(&bar[XB_TMO])) break; if (sp > XB_SPIN_CAP) { atomicAdd(&bar[XB_TMO], 1u); break; } }
    }
    nloc = mine > 0u ? mine : 1u; nx = cnt > 0u ? cnt : 1u;
}
__device__ __forceinline__ void xcd_barrier(const XcdBarrier& b) {
    asm volatile("s_waitcnt vmcnt(0)" ::: "memory");
    __syncthreads();
    if (threadIdx.x == 0) {
        unsigned* bar = b.bar;
        __builtin_amdgcn_s_waitcnt(0);
        unsigned nloc = b.st[0], nx = b.st[1];
        if (nloc == 0u) { xcd_barrier_complete(bar, b.x, nloc, nx); b.st[0] = nloc; b.st[1] = nx; }
        const unsigned old = xb_add(&bar[XB_XSUB(b.x)], 1u);
        const unsigned gen = old / nloc;
        if (old + 1u == (gen + 1u) * nloc) {
            __builtin_amdgcn_fence(__ATOMIC_RELEASE, "agent");
            asm volatile("s_waitcnt vmcnt(0)" ::: "memory");
            const unsigned og = xb_add(&bar[XB_TOP], 1u);
            const unsigned tg = og / nx;
            if (og + 1u == (tg + 1u) * nx) xb_add(&bar[XB_TOPGEN], 1u);
            else XB_SPIN(xb_ld(&bar[XB_TOPGEN]) == tg, bar);
            __builtin_amdgcn_fence(__ATOMIC_ACQUIRE, "agent");
            xb_add(&bar[XB_XGEN(b.x)], 1u);
            asm volatile("s_waitcnt vmcnt(0)" ::: "memory");
        } else {
            XB_SPIN(xb_ld(&bar[XB_XGEN(b.x)]) == gen, bar);
            __builtin_amdgcn_fence(__ATOMIC_ACQUIRE, "agent");
            asm volatile("s_waitcnt vmcnt(0)" ::: "memory");
        }
    }
    __syncthreads();
}

struct Args { const float* in[22]; float* out; unsigned char* ws; int ph_lo, ph_hi, li, pad; };

struct Frame {
    LAS unsigned char* lds;
    int tid, lane, wave, blk, nblk;
    const float *x, *w_in, *rel_bias, *w_ba, *conv_w, *conv_b, *dt_bias, *a_log, *d_skip, *ssm_norm_w, *w_bs, *gate_bias, *w_out,
                *norm_mix, *norm_ffn, *router_w, *router_b, *w1, *b1, *w2, *b2, *norm_final;
    float* out; unsigned char* ws; gu32* ctl;
};

template <class Epi>
__device__ __forceinline__ void gemm_naive(Frame& F, int nMt, int N, int K, const bf16* A, int lda, const int* rowmap,
                                           const float* B, int ldb, const int* texp, size_t estride, const Epi& epi) {
    LAS float* As = (LAS float*)F.lds;
    LAS float* Bs = As + 16 * 132;
    const int tid = F.tid, tx = tid & 31, ty = tid >> 5;
    const int nNt = (N + 127) / 128;
    const int ar = tid >> 2, ak = (tid & 3) * 4;
    const int bk = tid >> 5, bn = (tid & 31) * 4;
    for (int tile = F.blk; tile < nMt * nNt; tile += F.nblk) {
        const int mt = tile / nNt, nt = tile % nNt;
        int e = 0;
        if (texp) { e = texp[mt >> 1]; if (e < 0) continue; }
        const float* Bp = B + (size_t)e * estride;
        float acc[8][4];
#pragma unroll
        for (int i = 0; i < 8; ++i)
#pragma unroll
            for (int j = 0; j < 4; ++j) acc[i][j] = 0.f;
        int grow = mt * 128 + ar; if (rowmap) grow = rowmap[grow];
        const bf16* ap = A + (size_t)(grow < 0 ? 0 : grow) * lda + ak;
        const bool aok = grow >= 0;
        const int gcol = nt * 128 + bn;
        const bool bok = gcol < N;
        for (int k0 = 0; k0 < K; k0 += 16) {
            u32x2 av = (u32x2){0u, 0u};
            if (aok) av = *(const u32x2*)(ap + k0);
            f32x4 bv = (f32x4){0.f, 0.f, 0.f, 0.f};
            if (bok) bv = *(const f32x4*)(Bp + (size_t)(k0 + bk) * ldb + gcol);
            __syncthreads();
            As[(ak + 0) * 132 + ar] = bflo(av.x); As[(ak + 1) * 132 + ar] = bfhi(av.x);
            As[(ak + 2) * 132 + ar] = bflo(av.y); As[(ak + 3) * 132 + ar] = bfhi(av.y);
            *(LAS f32x4*)&Bs[bk * 132 + bn] = bv;
            __syncthreads();
#pragma unroll
            for (int k = 0; k < 16; ++k) {
                const f32x4 a0 = *(const LAS f32x4*)&As[k * 132 + ty * 8], a1 = *(const LAS f32x4*)&As[k * 132 + ty * 8 + 4];
                const f32x4 b = *(const LAS f32x4*)&Bs[k * 132 + tx * 4];
                const float a[8] = {a0.x, a0.y, a0.z, a0.w, a1.x, a1.y, a1.z, a1.w};
                const float bb[4] = {b.x, b.y, b.z, b.w};
#pragma unroll
                for (int i = 0; i < 8; ++i)
#pragma unroll
                    for (int j = 0; j < 4; ++j) acc[i][j] = fmaf(a[i], bb[j], acc[i][j]);
            }
        }
        const int col0 = nt * 128 + tx * 4;
        if (col0 < N) {
#pragma unroll
            for (int i = 0; i < 8; ++i) epi(mt * 128 + ty * 8 + i, col0, (f32x4){acc[i][0], acc[i][1], acc[i][2], acc[i][3]}, e);
        }
    }
    __syncthreads();
}

__device__ __forceinline__ void st_bf4(bf16* p, f32x4 v) { u32x2 w; w.x = pk2(v.x, v.y); w.y = pk2(v.z, v.w); *(u32x2*)p = w; }

struct EpiInProj {
    unsigned char* ws; const float* dt_bias; const float* gate_bias;
    __device__ __forceinline__ void operator()(int row, int col, f32x4 v, int) const {
        if (col < C_K)        st_bf4((bf16*)(ws + WS_Q) + (size_t)row * AW + (col - C_Q), v);
        else if (col < C_V)   st_bf4((bf16*)(ws + WS_K) + (size_t)row * AW + (col - C_K), v);
        else if (col < C_Z)   st_bf4((bf16*)(ws + WS_V) + (size_t)row * AW + (col - C_V), v);
        else if (col < C_XBC) st_bf4((bf16*)(ws + WS_Z) + (size_t)row * DI + (col - C_Z), v);
        else if (col < C_DT)  st_bf4((bf16*)(ws + WS_XBC) + (size_t)row * CONVD + (col - C_XBC), v);
        else if (col < C_GATE) { const int c = col - C_DT; f32x4 o;
            o.x = softplusf_(v.x + dt_bias[c]); o.y = softplusf_(v.y + dt_bias[c + 1]); o.z = softplusf_(v.z + dt_bias[c + 2]); o.w = softplusf_(v.w + dt_bias[c + 3]);
            *(f32x4*)((float*)(ws + WS_DT) + (size_t)row * 32 + c) = o; }
        else { const int c = col - C_GATE; f32x4 o;
            o.x = sigmoidf_(v.x + gate_bias[c]); o.y = sigmoidf_(v.y + gate_bias[c + 1]); o.z = sigmoidf_(v.z + gate_bias[c + 2]); o.w = sigmoidf_(v.w + gate_bias[c + 3]);
            st_bf4((bf16*)(ws + WS_GATE) + (size_t)row * 2048 + c, o); }
    }
};
struct EpiM0 {
    unsigned char* ws;
    __device__ __forceinline__ void operator()(int row, int col, f32x4 v, int) const {
        const u32x2 g = *(const u32x2*)((const bf16*)(ws + WS_GATE) + (size_t)row * 2048 + col);
        f32x4 o; o.x = v.x * bflo(g.x); o.y = v.y * bfhi(g.x); o.z = v.z * bflo(g.y); o.w = v.w * bfhi(g.y);
        *(f32x4*)((float*)(ws + WS_M0) + (size_t)row * D + col) = o;
    }
};
struct EpiMerged {
    unsigned char* ws;
    __device__ __forceinline__ void operator()(int row, int col, f32x4 v, int) const {
        const u32x2 g = *(const u32x2*)((const bf16*)(ws + WS_GATE) + (size_t)row * 2048 + 1024 + col);
        const f32x4 m = *(const f32x4*)((const float*)(ws + WS_M0) + (size_t)row * D + col);
        f32x4 o; o.x = m.x + v.x * bflo(g.x); o.y = m.y + v.y * bfhi(g.x); o.z = m.z + v.z * bflo(g.y); o.w = m.w + v.w * bfhi(g.y);
        st_bf4((bf16*)(ws + WS_MERGED) + (size_t)row * D + col, o);
    }
};
struct EpiX1 {
    const float* x; float* out;
    __device__ __forceinline__ void operator()(int row, int col, f32x4 v, int) const {
        const f32x4 xv = *(const f32x4*)(x + (size_t)row * D + col);
        *(f32x4*)(out + (size_t)row * D + col) = xv + v;
    }
};
__device__ __forceinline__ float swiglu_(float g, float l) {
    g = fminf(g, 7.f); l = fminf(fmaxf(l, -7.f), 7.f);
    return g * sigmoidf_(1.702f * g) * (l + 1.f);
}
struct EpiMoe1 {
    unsigned char* ws; const float* b1;
    __device__ __forceinline__ void operator()(int row, int col, f32x4 v, int e) const {
        const f32x4 b = *(const f32x4*)(b1 + (size_t)e * 2048 + col);
        const float o0 = swiglu_(v.x + b.x, v.y + b.y), o1 = swiglu_(v.z + b.z, v.w + b.w);
        *(unsigned*)((bf16*)(ws + WS_ACT) + (size_t)row * 1024 + (col >> 1)) = pk2(o0, o1);
    }
};
struct EpiMoe2 {
    unsigned char* ws; const float* b2;
    __device__ __forceinline__ void operator()(int row, int col, f32x4 v, int e) const {
        const f32x4 b = *(const f32x4*)(b2 + (size_t)e * 1024 + col);
        st_bf4((bf16*)(ws + WS_YB) + (size_t)row * 1024 + col, v + b);
    }
};

__device__ __forceinline__ void p_rmsnorm_in(Frame& F) {
    const int gw = F.blk * NWAVES + F.wave, NGW = F.nblk * NWAVES;
    bf16* XN = (bf16*)(F.ws + WS_XN);
    for (int m = gw; m < T; m += NGW) {
        const f32x4* xr = (const f32x4*)(F.x + (size_t)m * D) + F.lane;
        const f32x4* wr = (const f32x4*)F.norm_mix + F.lane;
        f32x4 v[4]; float s = 0.f;
#pragma unroll
        for (int j = 0; j < 4; ++j) { v[j] = xr[64 * j]; s += (v[j].x * v[j].x + v[j].y * v[j].y) + (v[j].z * v[j].z + v[j].w * v[j].w); }
        const float rstd = 1.f / sqrtf(wave_sum(s) * (1.f / D) + EPS);
#pragma unroll
        for (int j = 0; j < 4; ++j) { const f32x4 w = wr[64 * j]; const f32x4 o = v[j] * rstd * w; st_bf4(XN + (size_t)m * D + (F.lane + 64 * j) * 4, o); }
    }
}

__device__ __forceinline__ int t5_bucket_dev(int dist) {
    if (dist < 16) return dist;
    int l = 16 + (int)(logf((float)dist / 16.f) / logf(128.f) * 16.f);
    return l < 31 ? l : 31;
}
__device__ __forceinline__ void p_attn_naive(Frame& F) {
    LAS float* btab = (LAS float*)F.lds;
    for (int i = F.tid; i < 3 * 129 * 8; i += NTHREADS) {
        const int g = i / (129 * 8), j = (i >> 3) % 129, hg = i & 7;
        const int dil = g == 0 ? 1 : (g == 1 ? 4 : 16);
        btab[i] = F.rel_bias[t5_bucket_dev(j * dil) * 24 + g * 8 + hg];
    }
    __syncthreads();
    const bf16* Qb = (const bf16*)(F.ws + WS_Q); const bf16* Kb = (const bf16*)(F.ws + WS_K); const bf16* Vb = (const bf16*)(F.ws + WS_V);
    bf16* AT = (bf16*)(F.ws + WS_ATTN);
    for (int idx = F.blk * NTHREADS + F.tid; idx < T * 8; idx += F.nblk * NTHREADS) {
        const int hg = idx & 7, row = idx >> 3, t = row & (SEQ - 1);
        float m = -INFINITY, den = 0.f;
        float acc[64];
#pragma unroll
        for (int i = 0; i < 64; ++i) acc[i] = 0.f;
        for (int g = 0; g < 3; ++g) {
            const int dil = g == 0 ? 1 : (g == 1 ? 4 : 16);
            const int head = g * 8 + hg;
            float q[64];
            { const u32x4* qp = (const u32x4*)(Qb + (size_t)row * AW + head * 64);
#pragma unroll
              for (int c = 0; c < 8; ++c) { const u32x4 w = qp[c]; q[8 * c + 0] = bflo(w.x); q[8 * c + 1] = bfhi(w.x); q[8 * c + 2] = bflo(w.y); q[8 * c + 3] = bfhi(w.y);
                  q[8 * c + 4] = bflo(w.z); q[8 * c + 5] = bfhi(w.z); q[8 * c + 6] = bflo(w.w); q[8 * c + 7] = bfhi(w.w); } }
            for (int j = 0; j <= 128; ++j) {
                const int kt = t - j * dil; if (kt < 0) break;
                const size_t krow = (size_t)(row - j * dil);
                const u32x4* kp = (const u32x4*)(Kb + krow * AW + head * 64);
                float s = 0.f;
#pragma unroll
                for (int c = 0; c < 8; ++c) { const u32x4 w = kp[c];
                    s += q[8 * c + 0] * bflo(w.x) + q[8 * c + 1] * bfhi(w.x) + q[8 * c + 2] * bflo(w.y) + q[8 * c + 3] * bfhi(w.y)
                       + q[8 * c + 4] * bflo(w.z) + q[8 * c + 5] * bfhi(w.z) + q[8 * c + 6] * bflo(w.w) + q[8 * c + 7] * bfhi(w.w); }
                s = s * 0.125f + btab[(g * 129 + j) * 8 + hg];
                const float mn = fmaxf(m, s), sc = __expf(m - mn), p = __expf(s - mn);
                m = mn; den = den * sc + p;
                const u32x4* vp = (const u32x4*)(Vb + krow * AW + head * 64);
#pragma unroll
                for (int c = 0; c < 8; ++c) { const u32x4 w = vp[c];
                    acc[8 * c + 0] = acc[8 * c + 0] * sc + p * bflo(w.x); acc[8 * c + 1] = acc[8 * c + 1] * sc + p * bfhi(w.x);
                    acc[8 * c + 2] = acc[8 * c + 2] * sc + p * bflo(w.y); acc[8 * c + 3] = acc[8 * c + 3] * sc + p * bfhi(w.y);
                    acc[8 * c + 4] = acc[8 * c + 4] * sc + p * bflo(w.z); acc[8 * c + 5] = acc[8 * c + 5] * sc + p * bfhi(w.z);
                    acc[8 * c + 6] = acc[8 * c + 6] * sc + p * bflo(w.w); acc[8 * c + 7] = acc[8 * c + 7] * sc + p * bfhi(w.w); }
            }
        }
        const float inv = 1.f / den;
        u32x4* op = (u32x4*)(AT + (size_t)row * 512 + hg * 64);
#pragma unroll
        for (int c = 0; c < 8; ++c) { u32x4 w; w.x = pk2(acc[8 * c] * inv, acc[8 * c + 1] * inv); w.y = pk2(acc[8 * c + 2] * inv, acc[8 * c + 3] * inv);
            w.z = pk2(acc[8 * c + 4] * inv, acc[8 * c + 5] * inv); w.w = pk2(acc[8 * c + 6] * inv, acc[8 * c + 7] * inv); op[c] = w; }
    }
    __syncthreads();
}

__device__ __forceinline__ void p_conv(Frame& F) {
    const bf16* X = (const bf16*)(F.ws + WS_XBC); bf16* O = (bf16*)(F.ws + WS_CONV);
    const int total = T * (CONVD / 8);
    for (int idx = F.blk * NTHREADS + F.tid; idx < total; idx += F.nblk * NTHREADS) {
        const int row = idx / (CONVD / 8), c0 = (idx % (CONVD / 8)) * 8, t = row & (SEQ - 1);
        float a[8];
#pragma unroll
        for (int i = 0; i < 8; ++i) a[i] = F.conv_b[c0 + i];
#pragma unroll
        for (int w = 0; w < 4; ++w) {
            const int tt = t + w - 3; if (tt < 0) continue;
            const u32x4 u = *(const u32x4*)(X + (size_t)(row + w - 3) * CONVD + c0);
            const float* cw = F.conv_w + (size_t)w * CONVD + c0;
            a[0] += cw[0] * bflo(u.x); a[1] += cw[1] * bfhi(u.x); a[2] += cw[2] * bflo(u.y); a[3] += cw[3] * bfhi(u.y);
            a[4] += cw[4] * bflo(u.z); a[5] += cw[5] * bfhi(u.z); a[6] += cw[6] * bflo(u.w); a[7] += cw[7] * bfhi(u.w);
        }
        u32x4 o; o.x = pk2(siluf_(a[0]), siluf_(a[1])); o.y = pk2(siluf_(a[2]), siluf_(a[3])); o.z = pk2(siluf_(a[4]), siluf_(a[5])); o.w = pk2(siluf_(a[6]), siluf_(a[7]));
        *(u32x4*)(O + (size_t)row * CONVD + c0) = o;
    }
}

__device__ __forceinline__ void p_ssd_naive(Frame& F) {
    const bf16* CV = (const bf16*)(F.ws + WS_CONV); const float* DT = (const float*)(F.ws + WS_DT); const bf16* Z = (const bf16*)(F.ws + WS_Z);
    bf16* YZ = (bf16*)(F.ws + WS_YZ);
    const int t256 = F.tid & 255, p = t256 >> 2, q = t256 & 3;
    for (int unit = F.blk * 2 + (F.tid >> 8); unit < BATCH * NH_SSM; unit += F.nblk * 2) {
        const int b = unit / NH_SSM, h = unit % NH_SSM, g = h / 8;
        const float a = -__expf(F.a_log[h]), dsk = F.d_skip[h];
        float st[32];
#pragma unroll
        for (int i = 0; i < 32; ++i) st[i] = 0.f;
        for (int t = 0; t < SEQ; ++t) {
            const size_t row = (size_t)b * SEQ + t;
            const float dt = DT[row * 32 + h];
            const float dA = __expf(dt * a);
            const float xv = bf2f(CV[row * CONVD + h * 64 + p]);
            const float dtx = dt * xv;
            const u32x4* bp = (const u32x4*)(CV + row * CONVD + 2048 + g * 128 + q * 32);
            const u32x4* cp = (const u32x4*)(CV + row * CONVD + 2560 + g * 128 + q * 32);
            float yp = 0.f;
#pragma unroll
            for (int c = 0; c < 4; ++c) {
                const u32x4 bw = bp[c], cw = cp[c];
                const float bv[8] = {bflo(bw.x), bfhi(bw.x), bflo(bw.y), bfhi(bw.y), bflo(bw.z), bfhi(bw.z), bflo(bw.w), bfhi(bw.w)};
                const float cv[8] = {bflo(cw.x), bfhi(cw.x), bflo(cw.y), bfhi(cw.y), bflo(cw.z), bfhi(cw.z), bflo(cw.w), bfhi(cw.w)};
#pragma unroll
                for (int i = 0; i < 8; ++i) { st[8 * c + i] = st[8 * c + i] * dA + dtx * bv[i]; yp += cv[i] * st[8 * c + i]; }
            }
            yp += __shfl_xor(yp, 1); yp += __shfl_xor(yp, 2);
            if (q == 0) {
                const float y = yp + dsk * xv;
                const float z = bf2f(Z[row * DI + h * 64 + p]);
                YZ[row * DI + h * 64 + p] = (bf16)f2bf(y * siluf_(z));
            }
        }
    }
}

__device__ __forceinline__ void p_ypost(Frame& F) {
    const int gw = F.blk * NWAVES + F.wave, NGW = F.nblk * NWAVES;
    const bf16* YZ = (const bf16*)(F.ws + WS_YZ); bf16* YN = (bf16*)(F.ws + WS_YN);
    for (int m = gw; m < T; m += NGW) {
#pragma unroll
        for (int g = 0; g < 4; ++g) {
            const int c0 = g * 512 + F.lane * 8;
            const u32x4 w = *(const u32x4*)(YZ + (size_t)m * DI + c0);
            float v[8] = {bflo(w.x), bfhi(w.x), bflo(w.y), bfhi(w.y), bflo(w.z), bfhi(w.z), bflo(w.w), bfhi(w.w)};
            float s = 0.f;
#pragma unroll
            for (int i = 0; i < 8; ++i) s += v[i] * v[i];
            const float rstd = 1.f / sqrtf(wave_sum(s) * (1.f / 512.f) + EPS);
            const float* nw = F.ssm_norm_w + c0;
            u32x4 o; o.x = pk2(v[0] * rstd * nw[0], v[1] * rstd * nw[1]); o.y = pk2(v[2] * rstd * nw[2], v[3] * rstd * nw[3]);
            o.z = pk2(v[4] * rstd * nw[4], v[5] * rstd * nw[5]); o.w = pk2(v[6] * rstd * nw[6], v[7] * rstd * nw[7]);
            *(u32x4*)(YN + (size_t)m * DI + c0) = o;
        }
    }
}

__device__ __forceinline__ void p_router(Frame& F) {
    LAS int* hist = (LAS int*)F.lds;
    if (F.tid < 32) hist[F.tid] = 0;
    __syncthreads();
    int* ROWMAP = (int*)(F.ws + WS_ROWMAP);
    for (int i = F.blk * NTHREADS + F.tid; i < CAP; i += F.nblk * NTHREADS) ROWMAP[i] = -1;
    const int gw = F.blk * NWAVES + F.wave, NGW = F.nblk * NWAVES;
    bf16* XN2 = (bf16*)(F.ws + WS_XN2); int* TOPI = (int*)(F.ws + WS_TOPI); float* TOPW = (float*)(F.ws + WS_TOPW);
    for (int m = gw; m < T; m += NGW) {
        const f32x4* xr = (const f32x4*)(F.out + (size_t)m * D) + F.lane;
        const f32x4* wr = (const f32x4*)F.norm_ffn + F.lane;
        f32x4 v[4]; float s = 0.f;
#pragma unroll
        for (int j = 0; j < 4; ++j) { v[j] = xr[64 * j]; s += (v[j].x * v[j].x + v[j].y * v[j].y) + (v[j].z * v[j].z + v[j].w * v[j].w); }
        const float rstd = 1.f / sqrtf(wave_sum(s) * (1.f / D) + EPS);
        float lg[32];
#pragma unroll
        for (int e = 0; e < 32; ++e) lg[e] = 0.f;
#pragma unroll
        for (int j = 0; j < 4; ++j) {
            v[j] = v[j] * rstd * wr[64 * j];
            st_bf4(XN2 + (size_t)m * D + (F.lane + 64 * j) * 4, v[j]);
            const float hv[4] = {v[j].x, v[j].y, v[j].z, v[j].w};
#pragma unroll
            for (int i = 0; i < 4; ++i) {
                const f32x4* rw = (const f32x4*)(F.router_w + (size_t)((F.lane + 64 * j) * 4 + i) * 32);
#pragma unroll
                for (int c = 0; c < 8; ++c) { const f32x4 w = rw[c]; lg[4 * c] += hv[i] * w.x; lg[4 * c + 1] += hv[i] * w.y; lg[4 * c + 2] += hv[i] * w.z; lg[4 * c + 3] += hv[i] * w.w; }
            }
        }
#pragma unroll
        for (int e = 0; e < 32; ++e) lg[e] = wave_sum(lg[e]) + F.router_b[e];
        int bi[4]; float bv[4];
#pragma unroll
        for (int k = 0; k < 4; ++k) {
            float best = -INFINITY; int be = 0;
#pragma unroll
            for (int e = 0; e < 32; ++e) if (lg[e] > best) { best = lg[e]; be = e; }
            bi[k] = be; bv[k] = best;
#pragma unroll
            for (int e = 0; e < 32; ++e) if (e == be) lg[e] = -INFINITY;
        }
        const float e0 = 1.f, e1 = __expf(bv[1] - bv[0]), e2 = __expf(bv[2] - bv[0]), e3 = __expf(bv[3] - bv[0]);
        const float inv = 1.f / (e0 + e1 + e2 + e3);
        if (F.lane == 0) {
            *(int4*)(TOPI + (size_t)m * 4) = make_int4(bi[0], bi[1], bi[2], bi[3]);
            *(f32x4*)(TOPW + (size_t)m * 4) = (f32x4){e0 * inv, e1 * inv, e2 * inv, e3 * inv};
            atomicAdd((int*)&hist[bi[0]], 1); atomicAdd((int*)&hist[bi[1]], 1); atomicAdd((int*)&hist[bi[2]], 1); atomicAdd((int*)&hist[bi[3]], 1);
        }
    }
    __syncthreads();
    if (F.tid < 32) atomicAdd((unsigned*)(F.ctl + CW_CNT + 64 * F.tid), (unsigned)hist[F.tid]);
    __syncthreads();
}

__device__ __forceinline__ void p_slots(Frame& F) {
    LAS int* hist = (LAS int*)F.lds;
    LAS int* base = hist + 32;
    LAS int* pst = hist + 64;
    if (F.tid == 0) {
        int acc = 0;
        for (int e = 0; e < 32; ++e) { const int c = (int)__hip_atomic_load((unsigned*)(F.ctl + CW_CNT + 64 * e), __ATOMIC_RELAXED, __HIP_MEMORY_SCOPE_AGENT); pst[e] = acc; acc += (c + MOE_PAD - 1) / MOE_PAD * MOE_PAD; }
        pst[32] = acc;
    }
    __syncthreads();
    if (F.blk == 0) {
        int* TEXP = (int*)(F.ws + WS_SMALL);
        for (int i = F.tid; i < NT256; i += NTHREADS) { const int r = i * 256; int e = -1;
            for (int k = 0; k < 32; ++k) if (r >= pst[k] && r < pst[k + 1]) e = k;
            TEXP[i] = e; }
    }
    const int* TOPI = (const int*)(F.ws + WS_TOPI); int* SLOT = (int*)(F.ws + WS_SLOT); int* ROWMAP = (int*)(F.ws + WS_ROWMAP);
    for (int c = F.blk; c < T / 128; c += F.nblk) {
        if (F.tid < 32) hist[F.tid] = 0;
        __syncthreads();
        const int ai = c * 512 + F.tid;
        const int e = TOPI[ai];
        const int lr = atomicAdd((int*)&hist[e], 1);
        __syncthreads();
        if (F.tid < 32) base[F.tid] = (int)atomicAdd((unsigned*)(F.ctl + CW_CUR + 64 * F.tid), (unsigned)hist[F.tid]);
        __syncthreads();
        const int slot = pst[e] + base[e] + lr;
        SLOT[ai] = slot; ROWMAP[slot] = ai >> 2;
        __syncthreads();
    }
}

__device__ __forceinline__ void p_final(Frame& F) {
    const int gw = F.blk * NWAVES + F.wave, NGW = F.nblk * NWAVES;
    const int* SLOT = (const int*)(F.ws + WS_SLOT); const float* TOPW = (const float*)(F.ws + WS_TOPW); const bf16* YB = (const bf16*)(F.ws + WS_YB);
    for (int m = gw; m < T; m += NGW) {
        f32x4* xr = (f32x4*)(F.out + (size_t)m * D) + F.lane;
        const f32x4* wr = (const f32x4*)F.norm_final + F.lane;
        f32x4 v[4];
#pragma unroll
        for (int j = 0; j < 4; ++j) v[j] = xr[64 * j];
#pragma unroll
        for (int k = 0; k < 4; ++k) {
            const int sl = SLOT[m * 4 + k]; const float w = TOPW[m * 4 + k];
#pragma unroll
            for (int j = 0; j < 4; ++j) { const u32x2 y = *(const u32x2*)(YB + (size_t)sl * 1024 + (F.lane + 64 * j) * 4);
                v[j].x += w * bflo(y.x); v[j].y += w * bfhi(y.x); v[j].z += w * bflo(y.y); v[j].w += w * bfhi(y.y); }
        }
        float s = 0.f;
#pragma unroll
        for (int j = 0; j < 4; ++j) s += (v[j].x * v[j].x + v[j].y * v[j].y) + (v[j].z * v[j].z + v[j].w * v[j].w);
        const float rstd = 1.f / sqrtf(wave_sum(s) * (1.f / D) + EPS);
#pragma unroll
        for (int j = 0; j < 4; ++j) xr[64 * j] = v[j] * rstd * wr[64 * j];
    }
}

__global__ void __launch_bounds__(NTHREADS, 2) fwd(Args args) {
    extern __shared__ __attribute__((aligned(16))) unsigned char lds_raw[];
    Frame F;
    F.lds = (LAS unsigned char*)lds_raw;
    F.tid = threadIdx.x; F.lane = F.tid & 63; F.wave = __builtin_amdgcn_readfirstlane(F.tid >> 6);
    F.blk = blockIdx.x; F.nblk = gridDim.x;
    F.x = args.in[0]; F.w_in = args.in[1]; F.rel_bias = args.in[2]; F.w_ba = args.in[3]; F.conv_w = args.in[4]; F.conv_b = args.in[5];
    F.dt_bias = args.in[6]; F.a_log = args.in[7]; F.d_skip = args.in[8]; F.ssm_norm_w = args.in[9]; F.w_bs = args.in[10]; F.gate_bias = args.in[11];
    F.w_out = args.in[12]; F.norm_mix = args.in[13]; F.norm_ffn = args.in[14]; F.router_w = args.in[15]; F.router_b = args.in[16];
    F.w1 = args.in[17]; F.b1 = args.in[18]; F.w2 = args.in[19]; F.b2 = args.in[20]; F.norm_final = args.in[21];
    F.out = args.out; F.ws = args.ws; F.ctl = (gu32*)(args.ws + WS_CTL);
    volatile LAS unsigned* MISC = (volatile LAS unsigned*)(F.lds + MISC_OFF);
    if (F.tid < 32) MISC[F.tid] = 0u;
    __syncthreads();
    XcdBarrier bar; bar.bar = (unsigned*)(F.ctl + CW_BAR); bar.x = 0; bar.st = nullptr;
#if MK_FUSED
    bar = xcd_barrier_post((unsigned*)(F.ctl + CW_BAR), MISC + 8);
#define GRID_BAR() xcd_barrier(bar)
#else
#define GRID_BAR() do { } while (0)
#endif
    const int lo = args.ph_lo, hi = args.ph_hi;
#define IN(k) (lo <= (k) && (k) < hi)
#define SEAM(k) do { if (IN(k) && IN((k) + 1)) GRID_BAR(); } while (0)
    unsigned char* ws = F.ws;

    if (IN(0)) { p_rmsnorm_in(F); } SEAM(0);
    if (IN(1)) { EpiInProj E{ws, F.dt_bias, F.gate_bias}; gemm_naive(F, T / 128, NPROJ, D, (const bf16*)(ws + WS_XN), D, nullptr, F.w_in, NPROJ, nullptr, 0, E); } SEAM(1);
    if (IN(2)) { p_attn_naive(F); } SEAM(2);
    if (IN(3)) { p_conv(F); } SEAM(3);
    if (IN(4)) { p_ssd_naive(F); } SEAM(4);
    if (IN(5)) { p_ypost(F); } SEAM(5);
    if (IN(6)) { EpiM0 E{ws}; gemm_naive(F, T / 128, D, 512, (const bf16*)(ws + WS_ATTN), 512, nullptr, F.w_ba, D, nullptr, 0, E); } SEAM(6);
    if (IN(7)) { EpiMerged E{ws}; gemm_naive(F, T / 128, D, DI, (const bf16*)(ws + WS_YN), DI, nullptr, F.w_bs, D, nullptr, 0, E); } SEAM(7);
    if (IN(8)) { EpiX1 E{F.x, F.out}; gemm_naive(F, T / 128, D, D, (const bf16*)(ws + WS_MERGED), D, nullptr, F.w_out, D, nullptr, 0, E); } SEAM(8);
    if (IN(9)) { p_router(F); } SEAM(9);
    if (IN(10)) { p_slots(F); } SEAM(10);
    if (IN(11)) { EpiMoe1 E{ws, F.b1}; gemm_naive(F, CAP / 128, 2048, D, (const bf16*)(ws + WS_XN2), D, (const int*)(ws + WS_ROWMAP), F.w1, 2048, (const int*)(ws + WS_SMALL), (size_t)1024 * 2048, E); } SEAM(11);
    if (IN(12)) { EpiMoe2 E{ws, F.b2}; gemm_naive(F, CAP / 128, 1024, 1024, (const bf16*)(ws + WS_ACT), 1024, nullptr, F.w2, 1024, (const int*)(ws + WS_SMALL), (size_t)1024 * 1024, E); } SEAM(12);
    if (IN(13)) { p_final(F); }
#undef IN
#undef SEAM
}

extern "C" void kernel_launch(void* const* d_in, const int* in_sizes, int n_in, void* d_out, int out_size, void* d_ws, size_t ws_size, hipStream_t stream) {
    static int grid = 0;
    if (grid == 0) {
        if (n_in != 22 || out_size != T * D || ws_size < WS_END) { fprintf(stderr, "kernel_launch: unexpected shapes: n_in %d out %d ws %zu\n", n_in, out_size, ws_size); grid = -1; return; }
        int dev = 0, cus = 0, per_cu = 0;
        if (hipGetDevice(&dev) != hipSuccess || hipDeviceGetAttribute(&cus, hipDeviceAttributeMultiprocessorCount, dev) != hipSuccess) { grid = -1; return; }
        if (hipFuncSetAttribute((const void*)fwd, hipFuncAttributeMaxDynamicSharedMemorySize, LDS_BYTES) != hipSuccess) { fprintf(stderr, "kernel_launch: hipFuncSetAttribute failed\n"); grid = -1; return; }
        if (hipOccupancyMaxActiveBlocksPerMultiprocessor(&per_cu, (const void*)fwd, NTHREADS, LDS_BYTES) != hipSuccess || per_cu < 1) fprintf(stderr, "kernel_launch: occupancy query says %d\n", per_cu);
        (void)hipGetLastError();
        grid = cus;
    }
    if (grid < 0) return;
    (void)hipMemsetAsync((char*)d_ws + WS_CTL, 0, CTL_ZERO_BYTES, stream);
    Args a{};
    for (int i = 0; i < 22; ++i) a.in[i] = (const float*)d_in[i];
    a.out = (float*)d_out; a.ws = (unsigned char*)d_ws;
#if MK_FUSED
    a.ph_lo = 0; a.ph_hi = NPHASE; a.li = 0;
    hipLaunchKernelGGL(fwd, dim3(grid), dim3(NTHREADS), LDS_BYTES, stream, a);
#else
    for (int p = 0; p < NPHASE; ++p) { a.ph_lo = p; a.ph_hi = p + 1; a.li = p; hipLaunchKernelGGL(fwd, dim3(grid), dim3(NTHREADS), LDS_BYTES, stream, a); }
#endif
}
```

```cpp
#include <hip/hip_runtime.h>
#include <cstdio>
#include <cstdint>

#ifndef MK_FUSED
#define MK_FUSED 1
#endif

#ifndef FG_INPROJ
#define FG_INPROJ 1
#endif
#ifndef FG_MIX
#define FG_MIX 1
#endif
#ifndef FG_MOE
#define FG_MOE 1
#endif
#define GAS __attribute__((address_space(1)))
#define LAS __attribute__((address_space(3)))
typedef unsigned short bf16;
typedef float f32x4 __attribute__((ext_vector_type(4)));
typedef unsigned u32x4 __attribute__((ext_vector_type(4)));
typedef unsigned u32x2 __attribute__((ext_vector_type(2)));
typedef GAS unsigned gu32;

constexpr int BATCH = 16, SEQ = 2048, D = 1024, T = BATCH * SEQ;
constexpr int NPROJ = 11808;
constexpr int AW = 1536;
constexpr int DI = 2048;
constexpr int CONVD = 3072;
constexpr int NH_SSM = 32, NG_SSM = 4, DSTATE = 128;
constexpr int NEXP = 32, TOPK = 4, NASSIGN = T * TOPK;
constexpr int MOE_PAD = 256;
constexpr int CAP = NASSIGN + NEXP * MOE_PAD;
constexpr int NT256 = CAP / 256;
constexpr float EPS = 1e-5f;
constexpr int C_Q = 0, C_K = 1536, C_V = 3072, C_Z = 4608, C_XBC = 6656, C_DT = 9728, C_GATE = 9760;

constexpr size_t MiB = 1u << 20;
constexpr size_t WS_CTL = 0, CTL_ZERO_BYTES = 1 * MiB;
constexpr size_t WS_SMALL = 1 * MiB;
constexpr size_t WS_XN = 34 * MiB;
constexpr size_t WS_Q = 98 * MiB, WS_K = 194 * MiB, WS_V = 290 * MiB;
constexpr size_t WS_Z = 386 * MiB;
constexpr size_t WS_XBC = 514 * MiB;
constexpr size_t WS_GATE = 706 * MiB;
constexpr size_t WS_DT = 834 * MiB;
constexpr size_t WS_ATTN = 838 * MiB;
constexpr size_t WS_M0 = 870 * MiB;
constexpr size_t WS_CONV = WS_K;
constexpr size_t WS_YZ = WS_XBC;
constexpr size_t WS_YN = WS_Z;
constexpr size_t WS_MERGED = WS_XN;
constexpr size_t WS_XN2 = WS_Q;
constexpr size_t WS_TOPI = 162 * MiB;
constexpr size_t WS_TOPW = 163 * MiB;
constexpr size_t WS_SLOT = 164 * MiB;
constexpr size_t WS_ROWMAP = 165 * MiB;
constexpr size_t WS_ACT = 386 * MiB;
constexpr size_t WS_YB = 658 * MiB;
constexpr size_t WS_WIN_T = 2 * MiB;
constexpr size_t WS_WBA_T = 26 * MiB;
constexpr size_t WS_WBS_T = 27 * MiB;
constexpr size_t WS_WOUT_T = 31 * MiB;
constexpr size_t WS_W1T = 194 * MiB;
constexpr size_t WS_W2T = 322 * MiB;
constexpr int NPROJ_PAD = 12032;
constexpr size_t WS_END = 1024 * MiB;
constexpr int CW_TMO = 0;
constexpr int CW_BAR = 4096;
constexpr int CW_CNT = 16384;
constexpr int CW_CUR = 16384 + 64 * 32;

constexpr int NWAVES = 8, NTHREADS = 512;
constexpr int LDS_BYTES = 147456;
constexpr int MISC_OFF = 131072 + 320;

constexpr int NPHASE = 14;

__device__ __forceinline__ unsigned f2bf(float f) { unsigned u = __builtin_bit_cast(unsigned, f); return (u + 0x7fffu + ((u >> 16) & 1u)) >> 16; }
__device__ __forceinline__ unsigned pk2(float lo, float hi) { return f2bf(lo) | (f2bf(hi) << 16); }
__device__ __forceinline__ float bflo(unsigned u) { return __builtin_bit_cast(float, u << 16); }
__device__ __forceinline__ float bfhi(unsigned u) { return __builtin_bit_cast(float, u & 0xffff0000u); }
__device__ __forceinline__ float bf2f(bf16 b) { return __builtin_bit_cast(float, (unsigned)b << 16); }
__device__ __forceinline__ float wave_sum(float v) {
#pragma unroll
    for (int o = 1; o < 64; o <<= 1) v += __shfl_xor(v, o);
    return v;
}
__device__ __forceinline__ float sigmoidf_(float x) { return 1.f / (1.f + __expf(-x)); }
__device__ __forceinline__ float siluf_(float x) { return x / (1.f + __expf(-x)); }
__device__ __forceinline__ float softplusf_(float x) { return fmaxf(x, 0.f) + log1pf(__expf(-fabsf(x))); }

#define XB_TMO      128
#define XB_XCNT(j)  (256  + 64 * (j))
#define XB_XSUB(j)  (1280 + 64 * (j))
#define XB_XGEN(j)  (2304 + 64 * (j))
#define XB_TOP      3328
#define XB_TOPGEN   3392
#define XCD_BAR_WORDS 3456
#define XB_SPIN_CAP (1u << 18)
__device__ __forceinline__ unsigned xb_ld(unsigned* p)              { return __hip_atomic_load(p, __ATOMIC_RELAXED, __HIP_MEMORY_SCOPE_AGENT); }
__device__ __forceinline__ unsigned xb_add(unsigned* p, unsigned v) { return __hip_atomic_fetch_add(p, v, __ATOMIC_RELAXED, __HIP_MEMORY_SCOPE_AGENT); }
__device__ __forceinline__ unsigned xb_xcc_id() { return (unsigned)__builtin_amdgcn_s_getreg((3 << 11) | 20) & 0xFu; }
#define XB_SPIN(cond, bar) do { unsigned _sp = 0; while (cond) { __builtin_amdgcn_s_sleep(1); \
    if ((++_sp & 255u) == 0u) { if (xb_ld(&(bar)[XB_TMO])) break; if (_sp > XB_SPIN_CAP) { atomicAdd(&(bar)[XB_TMO], 1u); break; } } } } while (0)
struct XcdBarrier { unsigned* bar; unsigned x; volatile LAS unsigned* st; };
__device__ __forceinline__ XcdBarrier xcd_barrier_post(unsigned* bar, volatile LAS unsigned* st) {
    XcdBarrier b; b.bar = bar; b.x = xb_xcc_id(); b.st = st;
    if (threadIdx.x == 0) (void)xb_add(&bar[XB_XCNT(b.x)], 1u);
    return b;
}
__device__ __forceinline__ void xcd_barrier_complete(unsigned* bar, unsigned x, unsigned& nloc, unsigned& nx) {
    const unsigned G = gridDim.x * gridDim.y * gridDim.z;
    unsigned sum, cnt, mine, sp = 0u;
    for (;;) {
        sum = 0u; cnt = 0u; mine = 0u;
#pragma unroll
        for (unsigned j = 0; j < 16; ++j) { const unsigned c = xb_ld(&bar[XB_XCNT(j)]); sum += c; cnt += (c > 0u) ? 1u : 0u; mine = (j == x) ? c : mine; }
        if (sum == G) break;
        __builtin_amdgcn_s_sleep(1);
        if ((++sp & 255u) == 0u) { if (xb_ld(&bar[XB_TMO])) break; if (sp > XB_SPIN_CAP) { atomicAdd(&bar[XB_TMO], 1u); break; } }
    }
    nloc = mine > 0u ? mine : 1u; nx = cnt > 0u ? cnt : 1u;
}
__device__ __forceinline__ void xcd_barrier(const XcdBarrier& b) {
    asm volatile("s_waitcnt vmcnt(0)" ::: "memory");
    __syncthreads();
    if (threadIdx.x == 0) {
        unsigned* bar = b.bar;
        __builtin_amdgcn_s_waitcnt(0);
        unsigned nloc = b.st[0], nx = b.st[1];
        if (nloc == 0u) { xcd_barrier_complete(bar, b.x, nloc, nx); b.st[0] = nloc; b.st[1] = nx; }
        const unsigned old = xb_add(&bar[XB_XSUB(b.x)], 1u);
        const unsigned gen = old / nloc;
        if (old + 1u == (gen + 1u) * nloc) {
            __builtin_amdgcn_fence(__ATOMIC_RELEASE, "agent");
            asm volatile("s_waitcnt vmcnt(0)" ::: "memory");
            const unsigned og = xb_add(&bar[XB_TOP], 1u);
            const unsigned tg = og / nx;
            if (og + 1u == (tg + 1u) * nx) xb_add(&bar[XB_TOPGEN], 1u);
            else XB_SPIN(xb_ld(&bar[XB_TOPGEN]) == tg, bar);
            __builtin_amdgcn_fence(__ATOMIC_ACQUIRE, "agent");
            xb_add(&bar[XB_XGEN(b.x)], 1u);
            asm volatile("s_waitcnt vmcnt(0)" ::: "memory");
        } else {
            XB_SPIN(xb_ld(&bar[XB_XGEN(b.x)]) == gen, bar);
            __builtin_amdgcn_fence(__ATOMIC_ACQUIRE, "agent");
            asm volatile("s_waitcnt vmcnt(0)" ::: "memory");
        }
    }
    __syncthreads();
}

struct Args { const float* in[22]; float* out; unsigned char* ws; int ph_lo, ph_hi, li, pad; };

struct Frame {
    LAS unsigned char* lds;
    int tid, lane, wave, blk, nblk;
    const float *x, *w_in, *rel_bias, *w_ba, *conv_w, *conv_b, *dt_bias, *a_log, *d_skip, *ssm_norm_w, *w_bs, *gate_bias, *w_out,
                *norm_mix, *norm_ffn, *router_w, *router_b, *w1, *b1, *w2, *b2, *norm_final;
    float* out; unsigned char* ws; gu32* ctl;
};

template <class Epi>
__device__ __forceinline__ void gemm_naive(Frame& F, int nMt, int N, int K, const bf16* A, int lda, const int* rowmap,
                                           const float* B, int ldb, const int* texp, size_t estride, const Epi& epi) {
    LAS float* As = (LAS float*)F.lds;
    LAS float* Bs = As + 16 * 132;
    const int tid = F.tid, tx = tid & 31, ty = tid >> 5;
    const int nNt = (N + 127) / 128;
    const int ar = tid >> 2, ak = (tid & 3) * 4;
    const int bk = tid >> 5, bn = (tid & 31) * 4;
    for (int tile = F.blk; tile < nMt * nNt; tile += F.nblk) {
        const int mt = tile / nNt, nt = tile % nNt;
        int e = 0;
        if (texp) { e = texp[mt >> 1]; if (e < 0) continue; }
        const float* Bp = B + (size_t)e * estride;
        float acc[8][4];
#pragma unroll
        for (int i = 0; i < 8; ++i)
#pragma unroll
            for (int j = 0; j < 4; ++j) acc[i][j] = 0.f;
        int grow = mt * 128 + ar; if (rowmap) grow = rowmap[grow];
        const bf16* ap = A + (size_t)(grow < 0 ? 0 : grow) * lda + ak;
        const bool aok = grow >= 0;
        const int gcol = nt * 128 + bn;
        const bool bok = gcol < N;
        for (int k0 = 0; k0 < K; k0 += 16) {
            u32x2 av = (u32x2){0u, 0u};
            if (aok) av = *(const u32x2*)(ap + k0);
            f32x4 bv = (f32x4){0.f, 0.f, 0.f, 0.f};
            if (bok) bv = *(const f32x4*)(Bp + (size_t)(k0 + bk) * ldb + gcol);
            __syncthreads();
            As[(ak + 0) * 132 + ar] = bflo(av.x); As[(ak + 1) * 132 + ar] = bfhi(av.x);
            As[(ak + 2) * 132 + ar] = bflo(av.y); As[(ak + 3) * 132 + ar] = bfhi(av.y);
            *(LAS f32x4*)&Bs[bk * 132 + bn] = bv;
            __syncthreads();
#pragma unroll
            for (int k = 0; k < 16; ++k) {
                const f32x4 a0 = *(const LAS f32x4*)&As[k * 132 + ty * 8], a1 = *(const LAS f32x4*)&As[k * 132 + ty * 8 + 4];
                const f32x4 b = *(const LAS f32x4*)&Bs[k * 132 + tx * 4];
                const float a[8] = {a0.x, a0.y, a0.z, a0.w, a1.x, a1.y, a1.z, a1.w};
                const float bb[4] = {b.x, b.y, b.z, b.w};
#pragma unroll
                for (int i = 0; i < 8; ++i)
#pragma unroll
                    for (int j = 0; j < 4; ++j) acc[i][j] = fmaf(a[i], bb[j], acc[i][j]);
            }
        }
        const int col0 = nt * 128 + tx * 4;
        if (col0 < N) {
#pragma unroll
            for (int i = 0; i < 8; ++i) epi(mt * 128 + ty * 8 + i, col0, (f32x4){acc[i][0], acc[i][1], acc[i][2], acc[i][3]}, e);
        }
    }
    __syncthreads();
}

__device__ __forceinline__ void st_bf4(bf16* p, f32x4 v) { u32x2 w; w.x = pk2(v.x, v.y); w.y = pk2(v.z, v.w); *(u32x2*)p = w; }

struct EpiInProj {
    unsigned char* ws; const float* dt_bias; const float* gate_bias;
    __device__ __forceinline__ void operator()(int row, int col, f32x4 v, int) const {
        if (col < C_K)        st_bf4((bf16*)(ws + WS_Q) + (size_t)row * AW + (col - C_Q), v);
        else if (col < C_V)   st_bf4((bf16*)(ws + WS_K) + (size_t)row * AW + (col - C_K), v);
        else if (col < C_Z)   st_bf4((bf16*)(ws + WS_V) + (size_t)row * AW + (col - C_V), v);
        else if (col < C_XBC) st_bf4((bf16*)(ws + WS_Z) + (size_t)row * DI + (col - C_Z), v);
        else if (col < C_DT)  st_bf4((bf16*)(ws + WS_XBC) + (size_t)row * CONVD + (col - C_XBC), v);
        else if (col < C_GATE) { const int c = col - C_DT; f32x4 o;
            o.x = softplusf_(v.x + dt_bias[c]); o.y = softplusf_(v.y + dt_bias[c + 1]); o.z = softplusf_(v.z + dt_bias[c + 2]); o.w = softplusf_(v.w + dt_bias[c + 3]);
            *(f32x4*)((float*)(ws + WS_DT) + (size_t)row * 32 + c) = o; }
        else { const int c = col - C_GATE; f32x4 o;
            o.x = sigmoidf_(v.x + gate_bias[c]); o.y = sigmoidf_(v.y + gate_bias[c + 1]); o.z = sigmoidf_(v.z + gate_bias[c + 2]); o.w = sigmoidf_(v.w + gate_bias[c + 3]);
            st_bf4((bf16*)(ws + WS_GATE) + (size_t)row * 2048 + c, o); }
    }
};
struct EpiM0 {
    unsigned char* ws;
    __device__ __forceinline__ void operator()(int row, int col, f32x4 v, int) const {
        const u32x2 g = *(const u32x2*)((const bf16*)(ws + WS_GATE) + (size_t)row * 2048 + col);
        f32x4 o; o.x = v.x * bflo(g.x); o.y = v.y * bfhi(g.x); o.z = v.z * bflo(g.y); o.w = v.w * bfhi(g.y);
        *(f32x4*)((float*)(ws + WS_M0) + (size_t)row * D + col) = o;
    }
};
struct EpiMerged {
    unsigned char* ws;
    __device__ __forceinline__ void operator()(int row, int col, f32x4 v, int) const {
        const u32x2 g = *(const u32x2*)((const bf16*)(ws + WS_GATE) + (size_t)row * 2048 + 1024 + col);
        const f32x4 m = *(const f32x4*)((const float*)(ws + WS_M0) + (size_t)row * D + col);
        f32x4 o; o.x = m.x + v.x * bflo(g.x); o.y = m.y + v.y * bfhi(g.x); o.z = m.z + v.z * bflo(g.y); o.w = m.w + v.w * bfhi(g.y);
        st_bf4((bf16*)(ws + WS_MERGED) + (size_t)row * D + col, o);
    }
};
struct EpiX1 {
    const float* x; float* out;
    __device__ __forceinline__ void operator()(int row, int col, f32x4 v, int) const {
        const f32x4 xv = *(const f32x4*)(x + (size_t)row * D + col);
        *(f32x4*)(out + (size_t)row * D + col) = xv + v;
    }
};
__device__ __forceinline__ float swiglu_(float g, float l) {
    g = fminf(g, 7.f); l = fminf(fmaxf(l, -7.f), 7.f);
    return g * sigmoidf_(1.702f * g) * (l + 1.f);
}
struct EpiMoe1 {
    unsigned char* ws; const float* b1;
    __device__ __forceinline__ void operator()(int row, int col, f32x4 v, int e) const {
        const f32x4 b = *(const f32x4*)(b1 + (size_t)e * 2048 + col);
        const float o0 = swiglu_(v.x + b.x, v.y + b.y), o1 = swiglu_(v.z + b.z, v.w + b.w);
        *(unsigned*)((bf16*)(ws + WS_ACT) + (size_t)row * 1024 + (col >> 1)) = pk2(o0, o1);
    }
};
struct EpiMoe2 {
    unsigned char* ws; const float* b2;
    __device__ __forceinline__ void operator()(int row, int col, f32x4 v, int e) const {
        const f32x4 b = *(const f32x4*)(b2 + (size_t)e * 1024 + col);
        st_bf4((bf16*)(ws + WS_YB) + (size_t)row * 1024 + col, v + b);
    }
};

namespace pg8 {
typedef short bf16x8 __attribute__((ext_vector_type(8)));
constexpr int BM = 256, BK = 64, HALF = 128, HTB = HALF * BK * 2, STAGE_BYTES = 8 * HTB, NXCD = 8, WGM = 8;
__host__ __device__ __forceinline__ int lds_byte(int r, int c) { const int st = (r >> 4) * 2 + (c >> 5), rr = r & 15, cc = c & 31, ob = rr * 64 + cc * 2; return st * 1024 + (ob ^ (((ob >> 9) & 1) << 5)); }
__host__ __device__ __forceinline__ void stage_rc(int b, int& R, int& C) { const int st = b / 1024, sb = b % 1024, swz = sb ^ (((sb >> 9) & 1) << 5); R = (st >> 1) * 16 + swz / 64; C = (st & 1) * 32 + (swz % 64) / 2; }
__host__ __device__ __forceinline__ int perm32(int rho) { const int n = rho >> 4, i = rho & 15; return 8 * (i >> 2) + 4 * n + (i & 3); }
struct Unit { int pm, pn; };
struct Gemm { const bf16* A; const bf16* Bt; int M, N, K; };
struct StaticOrder {
    int nM, nN, nwg, G, c;
    __host__ __device__ void init(int M, int N, int G_, int c_) { nM = M / BM; nN = N / BM; nwg = nM * nN; G = G_; c = c_; }
    __host__ __device__ bool next(int i, Unit& u) const {
        const long L = (long)i * G + c; if (L >= nwg) return false;
        int wgid = (int)L; { const int q = nwg / NXCD, r = nwg % NXCD, xcd = wgid % NXCD, off = wgid / NXCD; wgid = (xcd < r ? xcd * (q + 1) : r * (q + 1) + (xcd - r) * q) + off; }
        const int nig = WGM * nN, gid = wgid / nig, fm = gid * WGM, gsz = (nM - fm) < WGM ? (nM - fm) : WGM;
        u.pm = fm + ((wgid % nig) % gsz); u.pn = (wgid % nig) / gsz; return true;
    }
    __device__ __forceinline__ void a_ready(const Unit&) const {}
    __device__ __forceinline__ void done(const Unit&) const {}
};
struct MoeOrder {
    int nwg, nN, G, c;
    __device__ void init(int ntile, int nN_, int G_, int c_) { nN = nN_; nwg = ntile * nN_; G = G_; c = c_; }
    __device__ bool next(int i, Unit& u) const { const long L = (long)i * G + c; if (L >= nwg) return false; u.pm = (int)L / nN; u.pn = (int)L % nN; return true; }
    __device__ __forceinline__ void a_ready(const Unit&) const {}
    __device__ __forceinline__ void done(const Unit&) const {}
};
__device__ __forceinline__ unsigned cvt_pk_bf16(float lo, float hi) { unsigned r; asm volatile("v_cvt_pk_bf16_f32 %0, %1, %2" : "=v"(r) : "v"(lo), "v"(hi)); return r; }

template <class Epi, class Sched, bool ALIGN_EPI, bool GATHER, bool EXPERT>
__device__ __forceinline__ void gemm_phase(LAS unsigned char* lds, const Gemm g, const Sched& S, const Epi& E, const int* rowmap, const int* texp, size_t bstride) {
    const int tid = threadIdx.x, wid = __builtin_amdgcn_readfirstlane(tid >> 6), lane = tid & 63, wr = wid >> 2, wc = wid & 3, fr = lane & 15, fq = lane >> 4;
    const int K = g.K, nt = K / BK;
    unsigned voffA[2], voffB[2]; int RA[2]; unsigned CAb[2];
#pragma unroll
    for (int i = 0; i < 2; ++i) { int R, C; stage_rc(tid * 16 + i * 8192, R, C); const int Rb = Epi::PERM ? ((R & ~31) + perm32(R & 31)) : R;
        voffA[i] = (unsigned)(R * K + C) * 2u; voffB[i] = (unsigned)(Rb * K + C) * 2u; RA[i] = R; CAb[i] = (unsigned)C * 2u; }
    const size_t kstep = (size_t)(BK * 2);
    const size_t hstep = (size_t)HALF * K * 2;
    const size_t tstep = 2 * hstep;
    const size_t ahs = GATHER ? 0 : hstep;
    const unsigned ldsw = (unsigned)wid * 1024u;
    const int aoff = lds_byte(wr * 64 + fr, fq * 8), boff = lds_byte(wc * 32 + fr, fq * 8);
#define PG8_SA(b, h) (((b) * 2 + (h)) * HTB)
#define PG8_SB(b, h) ((4 + (b) * 2 + (h)) * HTB)
#define PG8_STAGE(bufoff, gbase, voff) do { _Pragma("unroll") for (int _i = 0; _i < 2; ++_i) \
        __builtin_amdgcn_global_load_lds((const unsigned*)((const char*)(gbase) + (voff)[_i]), (LAS unsigned*)(lds + (bufoff) + ldsw + _i * 8192), 16, 0, 0); } while (0)
#define PG8_LDA(dst, b, h) do { _Pragma("unroll") for (int m = 0; m < 4; ++m) _Pragma("unroll") for (int k = 0; k < 2; ++k) dst[m][k] = *(const LAS bf16x8*)(lds + PG8_SA(b, h) + aoff + m * 2048 + k * 1024); } while (0)
#define PG8_LDB(dst, b, h) do { _Pragma("unroll") for (int n = 0; n < 2; ++n) _Pragma("unroll") for (int k = 0; k < 2; ++k) dst[n][k] = *(const LAS bf16x8*)(lds + PG8_SB(b, h) + boff + n * 2048 + k * 1024); } while (0)
#define PG8_MMA(ai, bj, At, Bt) do { __builtin_amdgcn_s_setprio(1); _Pragma("unroll") for (int m = 0; m < 4; ++m) _Pragma("unroll") for (int n = 0; n < 2; ++n) _Pragma("unroll") for (int k = 0; k < 2; ++k) \
        acc[ai][bj][m][n] = __builtin_amdgcn_mfma_f32_16x16x32_bf16(Bt[n][k], At[m][k], acc[ai][bj][m][n], 0, 0, 0); __builtin_amdgcn_s_setprio(0); } while (0)
#define PG8_WAIT_V(n) asm volatile("s_waitcnt vmcnt(" #n ")" ::: "memory")
#define PG8_WAIT_L(n) asm volatile("s_waitcnt lgkmcnt(" #n ")" ::: "memory")
#define PG8_BAR __builtin_amdgcn_s_barrier()
#define PG8_SCHED __builtin_amdgcn_sched_barrier(0)
#define PG8_ROWS(u, v) do { _Pragma("unroll") for (int _h = 0; _h < 2; ++_h) _Pragma("unroll") for (int _i = 0; _i < 2; ++_i) { int _r = rowmap[(u).pm * BM + _h * HALF + RA[_i]]; _r = _r < 0 ? 0 : _r; \
        v[_h][_i] = (unsigned)_r * (unsigned)(K * 2) + CAb[_i]; } } while (0)
#define PG8_BPTR(u) ((const char*)g.Bt + (EXPERT ? (size_t)texp[(u).pm] * bstride : (size_t)0) + (size_t)(u).pn * tstep)
#define PG8_APTR(u) ((const char*)g.A + (GATHER ? (size_t)0 : (size_t)(u).pm * tstep))
    Unit cur, nxt; int ui = 0;
    if (!S.next(0, cur)) return;
    f32x4 acc[2][2][4][2];
#pragma unroll
    for (int a = 0; a < 2; ++a)
#pragma unroll
        for (int b = 0; b < 2; ++b)
#pragma unroll
            for (int m = 0; m < 4; ++m)
#pragma unroll
                for (int n = 0; n < 2; ++n) acc[a][b][m][n] = (f32x4){0.f, 0.f, 0.f, 0.f};
    bf16x8 At[4][2], B0[2][2], B1[2][2];
    unsigned cv[2][2], nv[2][2];
    if constexpr (GATHER) { PG8_ROWS(cur, cv); } else { cv[0][0] = voffA[0]; cv[0][1] = voffA[1]; cv[1][0] = voffA[0]; cv[1][1] = voffA[1]; }
#pragma unroll
    for (int h = 0; h < 2; ++h) { nv[h][0] = cv[h][0]; nv[h][1] = cv[h][1]; }
    const char* cA = PG8_APTR(cur); const char* cB = PG8_BPTR(cur);
    S.a_ready(cur);
    PG8_STAGE(PG8_SB(0, 0), cB, voffB); PG8_STAGE(PG8_SB(0, 1), cB + hstep, voffB); PG8_STAGE(PG8_SA(0, 0), cA, cv[0]); PG8_STAGE(PG8_SA(0, 1), cA + ahs, cv[1]);
    if (wr == 1) PG8_BAR;
    PG8_WAIT_V(2); PG8_BAR;
    PG8_STAGE(PG8_SB(1, 0), cB + kstep, voffB); PG8_STAGE(PG8_SA(1, 0), cA + kstep, cv[0]); PG8_STAGE(PG8_SB(1, 1), cB + hstep + kstep, voffB);
    PG8_WAIT_V(6); PG8_BAR;
    for (;;) {
        const bool has_next = S.next(ui + 1, nxt);
        const char* nA = has_next ? PG8_APTR(nxt) : cA; const char* nB = has_next ? PG8_BPTR(nxt) : cB;
        if constexpr (GATHER) { if (has_next) { PG8_ROWS(nxt, nv); } }
        for (int t = 0; t < nt; t += 2) {
            const bool last = (t == nt - 2);
            const char* a1 = cA + (size_t)(t + 1) * kstep;
            const char* a2 = last ? nA : cA + (size_t)(t + 2) * kstep; const char* b2 = last ? nB : cB + (size_t)(t + 2) * kstep;
            const char* a3 = a2 + kstep; const char* b3 = b2 + kstep;
            unsigned s0[2], s1[2];
            s0[0] = last ? nv[0][0] : cv[0][0]; s0[1] = last ? nv[0][1] : cv[0][1]; s1[0] = last ? nv[1][0] : cv[1][0]; s1[1] = last ? nv[1][1] : cv[1][1];
            if (last && has_next) S.a_ready(nxt);
            PG8_LDB(B0, 0, 0); PG8_LDB(B1, 0, 1); PG8_SCHED; PG8_LDA(At, 0, 0); PG8_STAGE(PG8_SA(1, 1), a1 + ahs, cv[1]);
            PG8_WAIT_V(8); PG8_WAIT_L(0); PG8_BAR; PG8_MMA(0, 0, At, B0); PG8_MMA(0, 1, At, B1); PG8_BAR; PG8_SCHED;
            PG8_LDA(At, 0, 1); PG8_STAGE(PG8_SB(0, 0), b2, voffB); PG8_STAGE(PG8_SB(0, 1), b2 + hstep, voffB); PG8_STAGE(PG8_SA(0, 0), a2, s0);
            PG8_WAIT_V(8); PG8_WAIT_L(0); PG8_BAR; PG8_MMA(1, 0, At, B0); PG8_MMA(1, 1, At, B1); PG8_BAR; PG8_SCHED;
            PG8_LDB(B0, 1, 0); PG8_LDB(B1, 1, 1); PG8_SCHED; PG8_LDA(At, 1, 0); PG8_STAGE(PG8_SA(0, 1), a2 + ahs, s1);
            PG8_WAIT_V(8); PG8_WAIT_L(0); PG8_BAR; PG8_MMA(0, 0, At, B0); PG8_MMA(0, 1, At, B1); PG8_BAR; PG8_SCHED;
            PG8_LDA(At, 1, 1); PG8_STAGE(PG8_SB(1, 0), b3, voffB); PG8_STAGE(PG8_SB(1, 1), b3 + hstep, voffB); PG8_STAGE(PG8_SA(1, 0), a3, s0);
            PG8_WAIT_V(8); PG8_WAIT_L(0); PG8_BAR; PG8_MMA(1, 0, At, B0); PG8_MMA(1, 1, At, B1); PG8_BAR; PG8_SCHED;
        }
        if constexpr (ALIGN_EPI) { if (wr == 0) PG8_BAR; }
        E(acc, cur, wr, wc, fr, fq); S.done(cur);
        if (!has_next) break;
#pragma unroll
        for (int a = 0; a < 2; ++a)
#pragma unroll
            for (int b = 0; b < 2; ++b)
#pragma unroll
                for (int m = 0; m < 4; ++m)
#pragma unroll
                    for (int n = 0; n < 2; ++n) acc[a][b][m][n] = (f32x4){0.f, 0.f, 0.f, 0.f};
        cur = nxt; cA = nA; cB = nB; ++ui;
#pragma unroll
        for (int h = 0; h < 2; ++h) { cv[h][0] = nv[h][0]; cv[h][1] = nv[h][1]; }
        if constexpr (ALIGN_EPI) { if (wr == 1) PG8_BAR; }
    }
    PG8_WAIT_V(0);
    if constexpr (!ALIGN_EPI) { if (wr == 0) PG8_BAR; }
    PG8_BAR;
#undef PG8_SA
#undef PG8_SB
#undef PG8_STAGE
#undef PG8_LDA
#undef PG8_LDB
#undef PG8_MMA
#undef PG8_WAIT_V
#undef PG8_WAIT_L
#undef PG8_BAR
#undef PG8_SCHED
#undef PG8_ROWS
#undef PG8_BPTR
#undef PG8_APTR
}

struct EpiInProjF {
    static constexpr bool PERM = true;
    unsigned char* ws; const float* dt_bias; const float* gate_bias;
    __device__ __forceinline__ void operator()(const f32x4 (&acc)[2][2][4][2], const Unit& u, int wr, int wc, int fr, int fq) const {
        const int pn = u.pn, row0 = u.pm * BM + wr * 64 + fr, c8 = wc * 32 + 8 * fq;
        if (pn < 46) {
            bf16* base; int ldc, ct; const bool gate = pn >= 38;
            if (pn < 6) { base = (bf16*)(ws + WS_Q); ldc = AW; ct = pn * 256; }
            else if (pn < 12) { base = (bf16*)(ws + WS_K); ldc = AW; ct = (pn - 6) * 256; }
            else if (pn < 18) { base = (bf16*)(ws + WS_V); ldc = AW; ct = (pn - 12) * 256; }
            else if (pn < 26) { base = (bf16*)(ws + WS_Z); ldc = DI; ct = (pn - 18) * 256; }
            else if (pn < 38) { base = (bf16*)(ws + WS_XBC); ldc = CONVD; ct = (pn - 26) * 256; }
            else { base = (bf16*)(ws + WS_GATE); ldc = 2048; ct = (pn - 38) * 256; }
            f32x4 gb[2][2];
#pragma unroll
            for (int bj = 0; bj < 2; ++bj)
#pragma unroll
                for (int n = 0; n < 2; ++n) gb[bj][n] = gate ? *(const f32x4*)(gate_bias + ct + c8 + bj * HALF + 4 * n) : (f32x4){0.f, 0.f, 0.f, 0.f};
#pragma unroll
            for (int ai = 0; ai < 2; ++ai)
#pragma unroll
                for (int m = 0; m < 4; ++m) { bf16* rowp = base + (size_t)(row0 + ai * HALF + m * 16) * ldc + ct + c8;
#pragma unroll
                    for (int bj = 0; bj < 2; ++bj) { f32x4 v0 = acc[ai][bj][m][0], v1 = acc[ai][bj][m][1];
                        if (gate) { v0 = v0 + gb[bj][0]; v1 = v1 + gb[bj][1];
                            v0 = (f32x4){sigmoidf_(v0.x), sigmoidf_(v0.y), sigmoidf_(v0.z), sigmoidf_(v0.w)}; v1 = (f32x4){sigmoidf_(v1.x), sigmoidf_(v1.y), sigmoidf_(v1.z), sigmoidf_(v1.w)}; }
                        u32x4 w; w.x = cvt_pk_bf16(v0.x, v0.y); w.y = cvt_pk_bf16(v0.z, v0.w); w.z = cvt_pk_bf16(v1.x, v1.y); w.w = cvt_pk_bf16(v1.z, v1.w);
                        *(u32x4*)(rowp + bj * HALF) = w; } }
        } else if (wc == 0) {
            const f32x4 b0 = *(const f32x4*)(dt_bias + c8), b1 = *(const f32x4*)(dt_bias + c8 + 4);
#pragma unroll
            for (int ai = 0; ai < 2; ++ai)
#pragma unroll
                for (int m = 0; m < 4; ++m) { float* rowp = (float*)(ws + WS_DT) + (size_t)(row0 + ai * HALF + m * 16) * 32 + c8;
                    const f32x4 v0 = acc[ai][0][m][0] + b0, v1 = acc[ai][0][m][1] + b1;
                    *(f32x4*)rowp = (f32x4){softplusf_(v0.x), softplusf_(v0.y), softplusf_(v0.z), softplusf_(v0.w)};
                    *(f32x4*)(rowp + 4) = (f32x4){softplusf_(v1.x), softplusf_(v1.y), softplusf_(v1.z), softplusf_(v1.w)}; }
        }
    }
};
struct EpiM0F {
    static constexpr bool PERM = false;
    unsigned char* ws;
    __device__ __forceinline__ void operator()(const f32x4 (&acc)[2][2][4][2], const Unit& u, int wr, int wc, int fr, int fq) const {
        const int row0 = u.pm * BM + wr * 64 + fr, col0 = u.pn * BM + wc * 32 + 4 * fq;
#pragma unroll
        for (int ai = 0; ai < 2; ++ai)
#pragma unroll
            for (int m = 0; m < 4; ++m) { const size_t r = (size_t)(row0 + ai * HALF + m * 16);
#pragma unroll
                for (int bj = 0; bj < 2; ++bj)
#pragma unroll
                    for (int n = 0; n < 2; ++n) { const int c = col0 + bj * HALF + n * 16;
                        const u32x2 gg = *(const u32x2*)((const bf16*)(ws + WS_GATE) + r * 2048 + c); const f32x4 v = acc[ai][bj][m][n];
                        *(f32x4*)((float*)(ws + WS_M0) + r * D + c) = (f32x4){v.x * bflo(gg.x), v.y * bfhi(gg.x), v.z * bflo(gg.y), v.w * bfhi(gg.y)}; } }
    }
};
struct EpiMergedF {
    static constexpr bool PERM = true;
    unsigned char* ws;
    __device__ __forceinline__ void operator()(const f32x4 (&acc)[2][2][4][2], const Unit& u, int wr, int wc, int fr, int fq) const {
        const int row0 = u.pm * BM + wr * 64 + fr, col0 = u.pn * BM + wc * 32 + 8 * fq;
#pragma unroll
        for (int ai = 0; ai < 2; ++ai)
#pragma unroll
            for (int m = 0; m < 4; ++m) { const size_t r = (size_t)(row0 + ai * HALF + m * 16);
#pragma unroll
                for (int bj = 0; bj < 2; ++bj) { const int c = col0 + bj * HALF;
                    const u32x4 gg = *(const u32x4*)((const bf16*)(ws + WS_GATE) + r * 2048 + 1024 + c);
                    const f32x4 m0 = *(const f32x4*)((const float*)(ws + WS_M0) + r * D + c), m1 = *(const f32x4*)((const float*)(ws + WS_M0) + r * D + c + 4);
                    const f32x4 v0 = acc[ai][bj][m][0], v1 = acc[ai][bj][m][1];
                    u32x4 w; w.x = cvt_pk_bf16(m0.x + v0.x * bflo(gg.x), m0.y + v0.y * bfhi(gg.x)); w.y = cvt_pk_bf16(m0.z + v0.z * bflo(gg.y), m0.w + v0.w * bfhi(gg.y));
                    w.z = cvt_pk_bf16(m1.x + v1.x * bflo(gg.z), m1.y + v1.y * bfhi(gg.z)); w.w = cvt_pk_bf16(m1.z + v1.z * bflo(gg.w), m1.w + v1.w * bfhi(gg.w));
                    *(u32x4*)((bf16*)(ws + WS_MERGED) + r * D + c) = w; } }
    }
};
struct EpiX1F {
    static constexpr bool PERM = false;
    const float* x; float* out;
    __device__ __forceinline__ void operator()(const f32x4 (&acc)[2][2][4][2], const Unit& u, int wr, int wc, int fr, int fq) const {
        const int row0 = u.pm * BM + wr * 64 + fr, col0 = u.pn * BM + wc * 32 + 4 * fq;
#pragma unroll
        for (int ai = 0; ai < 2; ++ai)
#pragma unroll
            for (int m = 0; m < 4; ++m) { const size_t r = (size_t)(row0 + ai * HALF + m * 16);
#pragma unroll
                for (int bj = 0; bj < 2; ++bj)
#pragma unroll
                    for (int n = 0; n < 2; ++n) { const int c = col0 + bj * HALF + n * 16;
                        *(f32x4*)(out + r * D + c) = *(const f32x4*)(x + r * D + c) + acc[ai][bj][m][n]; } }
    }
};
struct EpiMoe1F {
    static constexpr bool PERM = true;
    unsigned char* ws; const float* b1; const int* texp;
    __device__ __forceinline__ void operator()(const f32x4 (&acc)[2][2][4][2], const Unit& u, int wr, int wc, int fr, int fq) const {
        const int e = texp[u.pm];
        const int row0 = u.pm * BM + wr * 64 + fr, col0 = u.pn * BM + wc * 32 + 8 * fq;
        f32x4 bv[2][2];
#pragma unroll
        for (int bj = 0; bj < 2; ++bj)
#pragma unroll
            for (int n = 0; n < 2; ++n) bv[bj][n] = *(const f32x4*)(b1 + (size_t)e * 2048 + col0 + bj * HALF + 4 * n);
#pragma unroll
        for (int ai = 0; ai < 2; ++ai)
#pragma unroll
            for (int m = 0; m < 4; ++m) { const size_t r = (size_t)(row0 + ai * HALF + m * 16);
#pragma unroll
                for (int bj = 0; bj < 2; ++bj) { const f32x4 v0 = acc[ai][bj][m][0] + bv[bj][0], v1 = acc[ai][bj][m][1] + bv[bj][1];
                    u32x2 w; w.x = cvt_pk_bf16(swiglu_(v0.x, v0.y), swiglu_(v0.z, v0.w)); w.y = cvt_pk_bf16(swiglu_(v1.x, v1.y), swiglu_(v1.z, v1.w));
                    *(u32x2*)((bf16*)(ws + WS_ACT) + r * 1024 + ((col0 + bj * HALF) >> 1)) = w; } }
    }
};
struct EpiMoe2F {
    static constexpr bool PERM = true;
    unsigned char* ws; const float* b2; const int* texp;
    __device__ __forceinline__ void operator()(const f32x4 (&acc)[2][2][4][2], const Unit& u, int wr, int wc, int fr, int fq) const {
        const int e = texp[u.pm];
        const int row0 = u.pm * BM + wr * 64 + fr, col0 = u.pn * BM + wc * 32 + 8 * fq;
        f32x4 bv[2][2];
#pragma unroll
        for (int bj = 0; bj < 2; ++bj)
#pragma unroll
            for (int n = 0; n < 2; ++n) bv[bj][n] = *(const f32x4*)(b2 + (size_t)e * 1024 + col0 + bj * HALF + 4 * n);
#pragma unroll
        for (int ai = 0; ai < 2; ++ai)
#pragma unroll
            for (int m = 0; m < 4; ++m) { const size_t r = (size_t)(row0 + ai * HALF + m * 16);
#pragma unroll
                for (int bj = 0; bj < 2; ++bj) { const f32x4 v0 = acc[ai][bj][m][0] + bv[bj][0], v1 = acc[ai][bj][m][1] + bv[bj][1];
                    u32x4 w; w.x = cvt_pk_bf16(v0.x, v0.y); w.y = cvt_pk_bf16(v0.z, v0.w); w.z = cvt_pk_bf16(v1.x, v1.y); w.w = cvt_pk_bf16(v1.z, v1.w);
                    *(u32x4*)((bf16*)(ws + WS_YB) + r * 1024 + col0 + bj * HALF) = w; } }
    }
};
}

__device__ __forceinline__ void transpose_item(const float* W, int K, int N, bf16* WT, int k0, int n0, int drow0, LAS float* scr, int lane) {
#pragma unroll 8
    for (int i = 0; i < 32; ++i) { const int kk = 2 * i + (lane >> 5); scr[kk * 33 + (lane & 31)] = W[(size_t)(k0 + kk) * N + n0 + (lane & 31)]; }
    asm volatile("s_waitcnt lgkmcnt(0)" ::: "memory");
    const int c = lane & 7;
#pragma unroll
    for (int j = 0; j < 4; ++j) { const int n = (lane >> 3) + 8 * j; const LAS float* s = scr + (8 * c) * 33 + n;
        u32x4 o; o.x = pk2(s[0 * 33], s[1 * 33]); o.y = pk2(s[2 * 33], s[3 * 33]); o.z = pk2(s[4 * 33], s[5 * 33]); o.w = pk2(s[6 * 33], s[7 * 33]);
        *(u32x4*)(WT + (size_t)(drow0 + n) * K + k0 + 8 * c) = o; }
    asm volatile("s_waitcnt lgkmcnt(0)" ::: "memory");
}
__device__ __forceinline__ int inproj_row_of_col(int n0) { return n0 < C_DT ? n0 : (n0 < C_GATE ? n0 - C_DT + 11776 : n0 - 32); }
__device__ __forceinline__ void p_convert_small(Frame& F) {
    LAS float* scr = (LAS float*)(F.lds + F.wave * 16384);
    const int gw = F.blk * NWAVES + F.wave, NGW = F.nblk * NWAVES;
    constexpr int I_IN = 16 * (NPROJ / 32), I_BA = 8 * 32, I_BS = 32 * 32, I_OUT = 16 * 32, NIT = I_IN + I_BA + I_BS + I_OUT;
    for (int it = gw; it < NIT; it += NGW) {
        int r = it;
        if (r < I_IN) { const int nb = r % (NPROJ / 32), kb = r / (NPROJ / 32); transpose_item(F.w_in, D, NPROJ, (bf16*)(F.ws + WS_WIN_T), 64 * kb, 32 * nb, inproj_row_of_col(32 * nb), scr, F.lane); continue; } r -= I_IN;
        if (r < I_BA) { const int nb = r % 32, kb = r / 32; transpose_item(F.w_ba, 512, D, (bf16*)(F.ws + WS_WBA_T), 64 * kb, 32 * nb, 32 * nb, scr, F.lane); continue; } r -= I_BA;
        if (r < I_BS) { const int nb = r % 32, kb = r / 32; transpose_item(F.w_bs, DI, D, (bf16*)(F.ws + WS_WBS_T), 64 * kb, 32 * nb, 32 * nb, scr, F.lane); continue; } r -= I_BS;
        { const int nb = r % 32, kb = r / 32; transpose_item(F.w_out, D, D, (bf16*)(F.ws + WS_WOUT_T), 64 * kb, 32 * nb, 32 * nb, scr, F.lane); }
    }
    u32x4* z = (u32x4*)((bf16*)(F.ws + WS_WIN_T) + (size_t)11808 * D);
    for (int i = F.blk * NTHREADS + F.tid; i < 224 * D * 2 / 16; i += F.nblk * NTHREADS) z[i] = (u32x4){0u, 0u, 0u, 0u};
}
__device__ __forceinline__ void p_convert_moe(Frame& F) {
    LAS float* scr = (LAS float*)(F.lds + F.wave * 16384);
    const int gw = F.blk * NWAVES + F.wave, NGW = F.nblk * NWAVES;
    constexpr int I_1 = 16 * 64, I_2 = 16 * 32, NIT = NEXP * (I_1 + I_2);
    for (int it = gw; it < NIT; it += NGW) {
        const int e = it / (I_1 + I_2); int r = it % (I_1 + I_2);
        if (r < I_1) { const int nb = r % 64, kb = r / 64; transpose_item(F.w1 + (size_t)e * 1024 * 2048, 1024, 2048, (bf16*)(F.ws + WS_W1T) + (size_t)e * 2048 * 1024, 64 * kb, 32 * nb, 32 * nb, scr, F.lane); }
        else { r -= I_1; const int nb = r % 32, kb = r / 32; transpose_item(F.w2 + (size_t)e * 1024 * 1024, 1024, 1024, (bf16*)(F.ws + WS_W2T) + (size_t)e * 1024 * 1024, 64 * kb, 32 * nb, 32 * nb, scr, F.lane); }
    }
}

__device__ __forceinline__ void p_rmsnorm_in(Frame& F) {
    const int gw = F.blk * NWAVES + F.wave, NGW = F.nblk * NWAVES;
    bf16* XN = (bf16*)(F.ws + WS_XN);
    for (int m = gw; m < T; m += NGW) {
        const f32x4* xr = (const f32x4*)(F.x + (size_t)m * D) + F.lane;
        const f32x4* wr = (const f32x4*)F.norm_mix + F.lane;
        f32x4 v[4]; float s = 0.f;
#pragma unroll
        for (int j = 0; j < 4; ++j) { v[j] = xr[64 * j]; s += (v[j].x * v[j].x + v[j].y * v[j].y) + (v[j].z * v[j].z + v[j].w * v[j].w); }
        const float rstd = 1.f / sqrtf(wave_sum(s) * (1.f / D) + EPS);
#pragma unroll
        for (int j = 0; j < 4; ++j) { const f32x4 w = wr[64 * j]; const f32x4 o = v[j] * rstd * w; st_bf4(XN + (size_t)m * D + (F.lane + 64 * j) * 4, o); }
    }
}

__device__ __forceinline__ int t5_bucket_dev(int dist) {
    if (dist < 16) return dist;
    int l = 16 + (int)(logf((float)dist / 16.f) / logf(128.f) * 16.f);
    return l < 31 ? l : 31;
}
__device__ __forceinline__ void p_attn_naive(Frame& F) {
    LAS float* btab = (LAS float*)F.lds;
    for (int i = F.tid; i < 3 * 129 * 8; i += NTHREADS) {
        const int g = i / (129 * 8), j = (i >> 3) % 129, hg = i & 7;
        const int dil = g == 0 ? 1 : (g == 1 ? 4 : 16);
        btab[i] = F.rel_bias[t5_bucket_dev(j * dil) * 24 + g * 8 + hg];
    }
    __syncthreads();
    const bf16* Qb = (const bf16*)(F.ws + WS_Q); const bf16* Kb = (const bf16*)(F.ws + WS_K); const bf16* Vb = (const bf16*)(F.ws + WS_V);
    bf16* AT = (bf16*)(F.ws + WS_ATTN);
    for (int idx = F.blk * NTHREADS + F.tid; idx < T * 8; idx += F.nblk * NTHREADS) {
        const int hg = idx & 7, row = idx >> 3, t = row & (SEQ - 1);
        float m = -INFINITY, den = 0.f;
        float acc[64];
#pragma unroll
        for (int i = 0; i < 64; ++i) acc[i] = 0.f;
        for (int g = 0; g < 3; ++g) {
            const int dil = g == 0 ? 1 : (g == 1 ? 4 : 16);
            const int head = g * 8 + hg;
            float q[64];
            { const u32x4* qp = (const u32x4*)(Qb + (size_t)row * AW + head * 64);
#pragma unroll
              for (int c = 0; c < 8; ++c) { const u32x4 w = qp[c]; q[8 * c + 0] = bflo(w.x); q[8 * c + 1] = bfhi(w.x); q[8 * c + 2] = bflo(w.y); q[8 * c + 3] = bfhi(w.y);
                  q[8 * c + 4] = bflo(w.z); q[8 * c + 5] = bfhi(w.z); q[8 * c + 6] = bflo(w.w); q[8 * c + 7] = bfhi(w.w); } }
            for (int j = 0; j <= 128; ++j) {
                const int kt = t - j * dil; if (kt < 0) break;
                const size_t krow = (size_t)(row - j * dil);
                const u32x4* kp = (const u32x4*)(Kb + krow * AW + head * 64);
                float s = 0.f;
#pragma unroll
                for (int c = 0; c < 8; ++c) { const u32x4 w = kp[c];
                    s += q[8 * c + 0] * bflo(w.x) + q[8 * c + 1] * bfhi(w.x) + q[8 * c + 2] * bflo(w.y) + q[8 * c + 3] * bfhi(w.y)
                       + q[8 * c + 4] * bflo(w.z) + q[8 * c + 5] * bfhi(w.z) + q[8 * c + 6] * bflo(w.w) + q[8 * c + 7] * bfhi(w.w); }
                s = s * 0.125f + btab[(g * 129 + j) * 8 + hg];
                const float mn = fmaxf(m, s), sc = __expf(m - mn), p = __expf(s - mn);
                m = mn; den = den * sc + p;
                const u32x4* vp = (const u32x4*)(Vb + krow * AW + head * 64);
#pragma unroll
                for (int c = 0; c < 8; ++c) { const u32x4 w = vp[c];
                    acc[8 * c + 0] = acc[8 * c + 0] * sc + p * bflo(w.x); acc[8 * c + 1] = acc[8 * c + 1] * sc + p * bfhi(w.x);
                    acc[8 * c + 2] = acc[8 * c + 2] * sc + p * bflo(w.y); acc[8 * c + 3] = acc[8 * c + 3] * sc + p * bfhi(w.y);
                    acc[8 * c + 4] = acc[8 * c + 4] * sc + p * bflo(w.z); acc[8 * c + 5] = acc[8 * c + 5] * sc + p * bfhi(w.z);
                    acc[8 * c + 6] = acc[8 * c + 6] * sc + p * bflo(w.w); acc[8 * c + 7] = acc[8 * c + 7] * sc + p * bfhi(w.w); }
            }
        }
        const float inv = 1.f / den;
        u32x4* op = (u32x4*)(AT + (size_t)row * 512 + hg * 64);
#pragma unroll
        for (int c = 0; c < 8; ++c) { u32x4 w; w.x = pk2(acc[8 * c] * inv, acc[8 * c + 1] * inv); w.y = pk2(acc[8 * c + 2] * inv, acc[8 * c + 3] * inv);
            w.z = pk2(acc[8 * c + 4] * inv, acc[8 * c + 5] * inv); w.w = pk2(acc[8 * c + 6] * inv, acc[8 * c + 7] * inv); op[c] = w; }
    }
    __syncthreads();
}

__device__ __forceinline__ void p_conv(Frame& F) {
    const bf16* X = (const bf16*)(F.ws + WS_XBC); bf16* O = (bf16*)(F.ws + WS_CONV);
    const int total = T * (CONVD / 8);
    for (int idx = F.blk * NTHREADS + F.tid; idx < total; idx += F.nblk * NTHREADS) {
        const int row = idx / (CONVD / 8), c0 = (idx % (CONVD / 8)) * 8, t = row & (SEQ - 1);
        float a[8];
#pragma unroll
        for (int i = 0; i < 8; ++i) a[i] = F.conv_b[c0 + i];
#pragma unroll
        for (int w = 0; w < 4; ++w) {
            const int tt = t + w - 3; if (tt < 0) continue;
            const u32x4 u = *(const u32x4*)(X + (size_t)(row + w - 3) * CONVD + c0);
            const float* cw = F.conv_w + (size_t)w * CONVD + c0;
            a[0] += cw[0] * bflo(u.x); a[1] += cw[1] * bfhi(u.x); a[2] += cw[2] * bflo(u.y); a[3] += cw[3] * bfhi(u.y);
            a[4] += cw[4] * bflo(u.z); a[5] += cw[5] * bfhi(u.z); a[6] += cw[6] * bflo(u.w); a[7] += cw[7] * bfhi(u.w);
        }
        u32x4 o; o.x = pk2(siluf_(a[0]), siluf_(a[1])); o.y = pk2(siluf_(a[2]), siluf_(a[3])); o.z = pk2(siluf_(a[4]), siluf_(a[5])); o.w = pk2(siluf_(a[6]), siluf_(a[7]));
        *(u32x4*)(O + (size_t)row * CONVD + c0) = o;
    }
}

__device__ __forceinline__ void p_ssd_naive(Frame& F) {
    const bf16* CV = (const bf16*)(F.ws + WS_CONV); const float* DT = (const float*)(F.ws + WS_DT); const bf16* Z = (const bf16*)(F.ws + WS_Z);
    bf16* YZ = (bf16*)(F.ws + WS_YZ);
    const int t256 = F.tid & 255, p = t256 >> 2, q = t256 & 3;
    for (int unit = F.blk * 2 + (F.tid >> 8); unit < BATCH * NH_SSM; unit += F.nblk * 2) {
        const int b = unit / NH_SSM, h = unit % NH_SSM, g = h / 8;
        const float a = -__expf(F.a_log[h]), dsk = F.d_skip[h];
        float st[32];
#pragma unroll
        for (int i = 0; i < 32; ++i) st[i] = 0.f;
        for (int t = 0; t < SEQ; ++t) {
            const size_t row = (size_t)b * SEQ + t;
            const float dt = DT[row * 32 + h];
            const float dA = __expf(dt * a);
            const float xv = bf2f(CV[row * CONVD + h * 64 + p]);
            const float dtx = dt * xv;
            const u32x4* bp = (const u32x4*)(CV + row * CONVD + 2048 + g * 128 + q * 32);
            const u32x4* cp = (const u32x4*)(CV + row * CONVD + 2560 + g * 128 + q * 32);
            float yp = 0.f;
#pragma unroll
            for (int c = 0; c < 4; ++c) {
                const u32x4 bw = bp[c], cw = cp[c];
                const float bv[8] = {bflo(bw.x), bfhi(bw.x), bflo(bw.y), bfhi(bw.y), bflo(bw.z), bfhi(bw.z), bflo(bw.w), bfhi(bw.w)};
                const float cv[8] = {bflo(cw.x), bfhi(cw.x), bflo(cw.y), bfhi(cw.y), bflo(cw.z), bfhi(cw.z), bflo(cw.w), bfhi(cw.w)};
#pragma unroll
                for (int i = 0; i < 8; ++i) { st[8 * c + i] = st[8 * c + i] * dA + dtx * bv[i]; yp += cv[i] * st[8 * c + i]; }
            }
            yp += __shfl_xor(yp, 1); yp += __shfl_xor(yp, 2);
            if (q == 0) {
                const float y = yp + dsk * xv;
                const float z = bf2f(Z[row * DI + h * 64 + p]);
                YZ[row * DI + h * 64 + p] = (bf16)f2bf(y * siluf_(z));
            }
        }
    }
}

__device__ __forceinline__ void p_ypost(Frame& F) {
    const int gw = F.blk * NWAVES + F.wave, NGW = F.nblk * NWAVES;
    const bf16* YZ = (const bf16*)(F.ws + WS_YZ); bf16* YN = (bf16*)(F.ws + WS_YN);
    for (int m = gw; m < T; m += NGW) {
#pragma unroll
        for (int g = 0; g < 4; ++g) {
            const int c0 = g * 512 + F.lane * 8;
            const u32x4 w = *(const u32x4*)(YZ + (size_t)m * DI + c0);
            float v[8] = {bflo(w.x), bfhi(w.x), bflo(w.y), bfhi(w.y), bflo(w.z), bfhi(w.z), bflo(w.w), bfhi(w.w)};
            float s = 0.f;
#pragma unroll
            for (int i = 0; i < 8; ++i) s += v[i] * v[i];
            const float rstd = 1.f / sqrtf(wave_sum(s) * (1.f / 512.f) + EPS);
            const float* nw = F.ssm_norm_w + c0;
            u32x4 o; o.x = pk2(v[0] * rstd * nw[0], v[1] * rstd * nw[1]); o.y = pk2(v[2] * rstd * nw[2], v[3] * rstd * nw[3]);
            o.z = pk2(v[4] * rstd * nw[4], v[5] * rstd * nw[5]); o.w = pk2(v[6] * rstd * nw[6], v[7] * rstd * nw[7]);
            *(u32x4*)(YN + (size_t)m * DI + c0) = o;
        }
    }
}

__device__ __forceinline__ void p_router(Frame& F) {
    LAS int* hist = (LAS int*)F.lds;
    if (F.tid < 32) hist[F.tid] = 0;
    __syncthreads();
    int* ROWMAP = (int*)(F.ws + WS_ROWMAP);
    for (int i = F.blk * NTHREADS + F.tid; i < CAP; i += F.nblk * NTHREADS) ROWMAP[i] = -1;
    const int gw = F.blk * NWAVES + F.wave, NGW = F.nblk * NWAVES;
    bf16* XN2 = (bf16*)(F.ws + WS_XN2); int* TOPI = (int*)(F.ws + WS_TOPI); float* TOPW = (float*)(F.ws + WS_TOPW);
    for (int m = gw; m < T; m += NGW) {
        const f32x4* xr = (const f32x4*)(F.out + (size_t)m * D) + F.lane;
        const f32x4* wr = (const f32x4*)F.norm_ffn + F.lane;
        f32x4 v[4]; float s = 0.f;
#pragma unroll
        for (int j = 0; j < 4; ++j) { v[j] = xr[64 * j]; s += (v[j].x * v[j].x + v[j].y * v[j].y) + (v[j].z * v[j].z + v[j].w * v[j].w); }
        const float rstd = 1.f / sqrtf(wave_sum(s) * (1.f / D) + EPS);
        float lg[32];
#pragma unroll
        for (int e = 0; e < 32; ++e) lg[e] = 0.f;
#pragma unroll
        for (int j = 0; j < 4; ++j) {
            v[j] = v[j] * rstd * wr[64 * j];
            st_bf4(XN2 + (size_t)m * D + (F.lane + 64 * j) * 4, v[j]);
            const float hv[4] = {v[j].x, v[j].y, v[j].z, v[j].w};
#pragma unroll
            for (int i = 0; i < 4; ++i) {
                const f32x4* rw = (const f32x4*)(F.router_w + (size_t)((F.lane + 64 * j) * 4 + i) * 32);
#pragma unroll
                for (int c = 0; c < 8; ++c) { const f32x4 w = rw[c]; lg[4 * c] += hv[i] * w.x; lg[4 * c + 1] += hv[i] * w.y; lg[4 * c + 2] += hv[i] * w.z; lg[4 * c + 3] += hv[i] * w.w; }
            }
        }
#pragma unroll
        for (int e = 0; e < 32; ++e) lg[e] = wave_sum(lg[e]) + F.router_b[e];
        int bi[4]; float bv[4];
#pragma unroll
        for (int k = 0; k < 4; ++k) {
            float best = -INFINITY; int be = 0;
#pragma unroll
            for (int e = 0; e < 32; ++e) if (lg[e] > best) { best = lg[e]; be = e; }
            bi[k] = be; bv[k] = best;
#pragma unroll
            for (int e = 0; e < 32; ++e) if (e == be) lg[e] = -INFINITY;
        }
        const float e0 = 1.f, e1 = __expf(bv[1] - bv[0]), e2 = __expf(bv[2] - bv[0]), e3 = __expf(bv[3] - bv[0]);
        const float inv = 1.f / (e0 + e1 + e2 + e3);
        if (F.lane == 0) {
            *(int4*)(TOPI + (size_t)m * 4) = make_int4(bi[0], bi[1], bi[2], bi[3]);
            *(f32x4*)(TOPW + (size_t)m * 4) = (f32x4){e0 * inv, e1 * inv, e2 * inv, e3 * inv};
            atomicAdd((int*)&hist[bi[0]], 1); atomicAdd((int*)&hist[bi[1]], 1); atomicAdd((int*)&hist[bi[2]], 1); atomicAdd((int*)&hist[bi[3]], 1);
        }
    }
    __syncthreads();
    if (F.tid < 32) atomicAdd((unsigned*)(F.ctl + CW_CNT + 64 * F.tid), (unsigned)hist[F.tid]);
    __syncthreads();
}

__device__ __forceinline__ void p_slots(Frame& F) {
    LAS int* hist = (LAS int*)F.lds;
    LAS int* base = hist + 32;
    LAS int* pst = hist + 64;
    if (F.tid == 0) {
        int acc = 0;
        for (int e = 0; e < 32; ++e) { const int c = (int)__hip_atomic_load((unsigned*)(F.ctl + CW_CNT + 64 * e), __ATOMIC_RELAXED, __HIP_MEMORY_SCOPE_AGENT); pst[e] = acc; acc += (c + MOE_PAD - 1) / MOE_PAD * MOE_PAD; }
        pst[32] = acc;
    }
    __syncthreads();
    if (F.blk == 0) {
        int* TEXP = (int*)(F.ws + WS_SMALL);
        for (int i = F.tid; i < NT256; i += NTHREADS) { const int r = i * 256; int e = -1;
            for (int k = 0; k < 32; ++k) if (r >= pst[k] && r < pst[k + 1]) e = k;
            TEXP[i] = e; }
        if (F.tid == 0) TEXP[1024] = pst[32] / 256;
    }
    const int* TOPI = (const int*)(F.ws + WS_TOPI); int* SLOT = (int*)(F.ws + WS_SLOT); int* ROWMAP = (int*)(F.ws + WS_ROWMAP);
    for (int c = F.blk; c < T / 128; c += F.nblk) {
        if (F.tid < 32) hist[F.tid] = 0;
        __syncthreads();
        const int ai = c * 512 + F.tid;
        const int e = TOPI[ai];
        const int lr = atomicAdd((int*)&hist[e], 1);
        __syncthreads();
        if (F.tid < 32) base[F.tid] = (int)atomicAdd((unsigned*)(F.ctl + CW_CUR + 64 * F.tid), (unsigned)hist[F.tid]);
        __syncthreads();
        const int slot = pst[e] + base[e] + lr;
        SLOT[ai] = slot; ROWMAP[slot] = ai >> 2;
        __syncthreads();
    }
}

__device__ __forceinline__ void p_final(Frame& F) {
    const int gw = F.blk * NWAVES + F.wave, NGW = F.nblk * NWAVES;
    const int* SLOT = (const int*)(F.ws + WS_SLOT); const float* TOPW = (const float*)(F.ws + WS_TOPW); const bf16* YB = (const bf16*)(F.ws + WS_YB);
    for (int m = gw; m < T; m += NGW) {
        f32x4* xr = (f32x4*)(F.out + (size_t)m * D) + F.lane;
        const f32x4* wr = (const f32x4*)F.norm_final + F.lane;
        f32x4 v[4];
#pragma unroll
        for (int j = 0; j < 4; ++j) v[j] = xr[64 * j];
#pragma unroll
        for (int k = 0; k < 4; ++k) {
            const int sl = SLOT[m * 4 + k]; const float w = TOPW[m * 4 + k];
#pragma unroll
            for (int j = 0; j < 4; ++j) { const u32x2 y = *(const u32x2*)(YB + (size_t)sl * 1024 + (F.lane + 64 * j) * 4);
                v[j].x += w * bflo(y.x); v[j].y += w * bfhi(y.x); v[j].z += w * bflo(y.y); v[j].w += w * bfhi(y.y); }
        }
        float s = 0.f;
#pragma unroll
        for (int j = 0; j < 4; ++j) s += (v[j].x * v[j].x + v[j].y * v[j].y) + (v[j].z * v[j].z + v[j].w * v[j].w);
        const float rstd = 1.f / sqrtf(wave_sum(s) * (1.f / D) + EPS);
#pragma unroll
        for (int j = 0; j < 4; ++j) xr[64 * j] = v[j] * rstd * wr[64 * j];
    }
}

__global__ void __launch_bounds__(NTHREADS, 2) fwd(Args args) {
    extern __shared__ __attribute__((aligned(16))) unsigned char lds_raw[];
    Frame F;
    F.lds = (LAS unsigned char*)lds_raw;
    F.tid = threadIdx.x; F.lane = F.tid & 63; F.wave = __builtin_amdgcn_readfirstlane(F.tid >> 6);
    F.blk = blockIdx.x; F.nblk = gridDim.x;
    F.x = args.in[0]; F.w_in = args.in[1]; F.rel_bias = args.in[2]; F.w_ba = args.in[3]; F.conv_w = args.in[4]; F.conv_b = args.in[5];
    F.dt_bias = args.in[6]; F.a_log = args.in[7]; F.d_skip = args.in[8]; F.ssm_norm_w = args.in[9]; F.w_bs = args.in[10]; F.gate_bias = args.in[11];
    F.w_out = args.in[12]; F.norm_mix = args.in[13]; F.norm_ffn = args.in[14]; F.router_w = args.in[15]; F.router_b = args.in[16];
    F.w1 = args.in[17]; F.b1 = args.in[18]; F.w2 = args.in[19]; F.b2 = args.in[20]; F.norm_final = args.in[21];
    F.out = args.out; F.ws = args.ws; F.ctl = (gu32*)(args.ws + WS_CTL);
    volatile LAS unsigned* MISC = (volatile LAS unsigned*)(F.lds + MISC_OFF);
    if (F.tid < 32) MISC[F.tid] = 0u;
    __syncthreads();
    XcdBarrier bar; bar.bar = (unsigned*)(F.ctl + CW_BAR); bar.x = 0; bar.st = nullptr;
#if MK_FUSED
    bar = xcd_barrier_post((unsigned*)(F.ctl + CW_BAR), MISC + 8);
#define GRID_BAR() xcd_barrier(bar)
#else
#define GRID_BAR() do { } while (0)
#endif
    const int lo = args.ph_lo, hi = args.ph_hi;
#define IN(k) (lo <= (k) && (k) < hi)
#define SEAM(k) do { if (IN(k) && IN((k) + 1)) GRID_BAR(); } while (0)
    unsigned char* ws = F.ws;

    if (IN(0)) { p_rmsnorm_in(F); p_convert_small(F); } SEAM(0);
    if (IN(1)) {
#if FG_INPROJ
        pg8::Gemm g{(const bf16*)(ws + WS_XN), (const bf16*)(ws + WS_WIN_T), T, NPROJ_PAD, D}; pg8::StaticOrder S; S.init(T, NPROJ_PAD, F.nblk, F.blk);
        pg8::EpiInProjF E{ws, F.dt_bias, F.gate_bias};
        pg8::gemm_phase<pg8::EpiInProjF, pg8::StaticOrder, true, false, false>(F.lds, g, S, E, nullptr, nullptr, 0);
#else
        EpiInProj E{ws, F.dt_bias, F.gate_bias}; gemm_naive(F, T / 128, NPROJ, D, (const bf16*)(ws + WS_XN), D, nullptr, F.w_in, NPROJ, nullptr, 0, E);
#endif
    } SEAM(1);
    if (IN(2)) { p_attn_naive(F); } SEAM(2);
    if (IN(3)) { p_conv(F); } SEAM(3);
    if (IN(4)) { p_ssd_naive(F); } SEAM(4);
    if (IN(5)) { p_ypost(F); p_convert_moe(F); } SEAM(5);
    if (IN(6)) {
#if FG_MIX
        pg8::Gemm g{(const bf16*)(ws + WS_ATTN), (const bf16*)(ws + WS_WBA_T), T, D, 512}; pg8::StaticOrder S; S.init(T, D, F.nblk, F.blk);
        pg8::EpiM0F E{ws};
        pg8::gemm_phase<pg8::EpiM0F, pg8::StaticOrder, true, false, false>(F.lds, g, S, E, nullptr, nullptr, 0);
#else
        EpiM0 E{ws}; gemm_naive(F, T / 128, D, 512, (const bf16*)(ws + WS_ATTN), 512, nullptr, F.w_ba, D, nullptr, 0, E);
#endif
    } SEAM(6);
    if (IN(7)) {
#if FG_MIX
        pg8::Gemm g{(const bf16*)(ws + WS_YN), (const bf16*)(ws + WS_WBS_T), T, D, DI}; pg8::StaticOrder S; S.init(T, D, F.nblk, F.blk);
        pg8::EpiMergedF E{ws};
        pg8::gemm_phase<pg8::EpiMergedF, pg8::StaticOrder, true, false, false>(F.lds, g, S, E, nullptr, nullptr, 0);
#else
        EpiMerged E{ws}; gemm_naive(F, T / 128, D, DI, (const bf16*)(ws + WS_YN), DI, nullptr, F.w_bs, D, nullptr, 0, E);
#endif
    } SEAM(7);
    if (IN(8)) {
#if FG_MIX
        pg8::Gemm g{(const bf16*)(ws + WS_MERGED), (const bf16*)(ws + WS_WOUT_T), T, D, D}; pg8::StaticOrder S; S.init(T, D, F.nblk, F.blk);
        pg8::EpiX1F E{F.x, F.out};
        pg8::gemm_phase<pg8::EpiX1F, pg8::StaticOrder, true, false, false>(F.lds, g, S, E, nullptr, nullptr, 0);
#else
        EpiX1 E{F.x, F.out}; gemm_naive(F, T / 128, D, D, (const bf16*)(ws + WS_MERGED), D, nullptr, F.w_out, D, nullptr, 0, E);
#endif
    } SEAM(8);
    if (IN(9)) { p_router(F); } SEAM(9);
    if (IN(10)) { p_slots(F); } SEAM(10);
    if (IN(11)) {
#if FG_MOE
        const int* texp = (const int*)(ws + WS_SMALL); const int ntile = texp[1024];
        pg8::Gemm g{(const bf16*)(ws + WS_XN2), (const bf16*)(ws + WS_W1T), CAP, 2048, D}; pg8::MoeOrder S; S.init(ntile, 8, F.nblk, F.blk);
        pg8::EpiMoe1F E{ws, F.b1, texp};
        pg8::gemm_phase<pg8::EpiMoe1F, pg8::MoeOrder, true, true, true>(F.lds, g, S, E, (const int*)(ws + WS_ROWMAP), texp, (size_t)2048 * 1024 * 2);
#else
        EpiMoe1 E{ws, F.b1}; gemm_naive(F, CAP / 128, 2048, D, (const bf16*)(ws + WS_XN2), D, (const int*)(ws + WS_ROWMAP), F.w1, 2048, (const int*)(ws + WS_SMALL), (size_t)1024 * 2048, E);
#endif
    } SEAM(11);
    if (IN(12)) {
#if FG_MOE
        const int* texp = (const int*)(ws + WS_SMALL); const int ntile = texp[1024];
        pg8::Gemm g{(const bf16*)(ws + WS_ACT), (const bf16*)(ws + WS_W2T), CAP, 1024, 1024}; pg8::MoeOrder S; S.init(ntile, 4, F.nblk, F.blk);
        pg8::EpiMoe2F E{ws, F.b2, texp};
        pg8::gemm_phase<pg8::EpiMoe2F, pg8::MoeOrder, true, false, true>(F.lds, g, S, E, nullptr, texp, (size_t)1024 * 1024 * 2);
#else
        EpiMoe2 E{ws, F.b2}; gemm_naive(F, CAP / 128, 1024, 1024, (const bf16*)(ws + WS_ACT), 1024, nullptr, F.w2, 1024, (const int*)(ws + WS_SMALL), (size_t)1024 * 1024, E);
#endif
    } SEAM(12);
    if (IN(13)) { p_final(F); }
#undef IN
#undef SEAM
}

extern "C" void kernel_launch(void* const* d_in, const int* in_sizes, int n_in, void* d_out, int out_size, void* d_ws, size_t ws_size, hipStream_t stream) {
    static int grid = 0;
    if (grid == 0) {
        if (n_in != 22 || out_size != T * D || ws_size < WS_END) { fprintf(stderr, "kernel_launch: unexpected shapes: n_in %d out %d ws %zu\n", n_in, out_size, ws_size); grid = -1; return; }
        int dev = 0, cus = 0, per_cu = 0;
        if (hipGetDevice(&dev) != hipSuccess || hipDeviceGetAttribute(&cus, hipDeviceAttributeMultiprocessorCount, dev) != hipSuccess) { grid = -1; return; }
        if (hipFuncSetAttribute((const void*)fwd, hipFuncAttributeMaxDynamicSharedMemorySize, LDS_BYTES) != hipSuccess) { fprintf(stderr, "kernel_launch: hipFuncSetAttribute failed\n"); grid = -1; return; }
        if (hipOccupancyMaxActiveBlocksPerMultiprocessor(&per_cu, (const void*)fwd, NTHREADS, LDS_BYTES) != hipSuccess || per_cu < 1) fprintf(stderr, "kernel_launch: occupancy query says %d\n", per_cu);
        (void)hipGetLastError();
        grid = cus;
    }
    if (grid < 0) return;
    (void)hipMemsetAsync((char*)d_ws + WS_CTL, 0, CTL_ZERO_BYTES, stream);
    Args a{};
    for (int i = 0; i < 22; ++i) a.in[i] = (const float*)d_in[i];
    a.out = (float*)d_out; a.ws = (unsigned char*)d_ws;
#if MK_FUSED
    a.ph_lo = 0; a.ph_hi = NPHASE; a.li = 0;
    hipLaunchKernelGGL(fwd, dim3(grid), dim3(NTHREADS), LDS_BYTES, stream, a);
#else
    for (int p = 0; p < NPHASE; ++p) { a.ph_lo = p; a.ph_hi = p + 1; a.li = p; hipLaunchKernelGGL(fwd, dim3(grid), dim3(NTHREADS), LDS_BYTES, stream, a); }
#endif
}
```

```cpp
#include <hip/hip_runtime.h>
#include <cstdio>
#include <cstdint>

#ifndef MK_FUSED
#define MK_FUSED 1
#endif

#ifndef FG_INPROJ
#define FG_INPROJ 1
#endif
#ifndef FA_ATTN
#define FA_ATTN 1
#endif
#ifndef FG_MIX
#define FG_MIX 1
#endif
#ifndef FG_MOE
#define FG_MOE 1
#endif
#define GAS __attribute__((address_space(1)))
#define LAS __attribute__((address_space(3)))
typedef unsigned short bf16;
typedef float f32x4 __attribute__((ext_vector_type(4)));
typedef unsigned u32x4 __attribute__((ext_vector_type(4)));
typedef unsigned u32x2 __attribute__((ext_vector_type(2)));
typedef GAS unsigned gu32;

constexpr int BATCH = 16, SEQ = 2048, D = 1024, T = BATCH * SEQ;
constexpr int NPROJ = 11808;
constexpr int AW = 1536;
constexpr int DI = 2048;
constexpr int CONVD = 3072;
constexpr int NH_SSM = 32, NG_SSM = 4, DSTATE = 128;
constexpr int NEXP = 32, TOPK = 4, NASSIGN = T * TOPK;
constexpr int MOE_PAD = 256;
constexpr int CAP = NASSIGN + NEXP * MOE_PAD;
constexpr int NT256 = CAP / 256;
constexpr float EPS = 1e-5f;
constexpr int C_Q = 0, C_K = 1536, C_V = 3072, C_Z = 4608, C_XBC = 6656, C_DT = 9728, C_GATE = 9760;

constexpr size_t MiB = 1u << 20;
constexpr size_t WS_CTL = 0, CTL_ZERO_BYTES = 1 * MiB;
constexpr size_t WS_SMALL = 1 * MiB;
constexpr size_t WS_XN = 34 * MiB;
constexpr size_t WS_Q = 98 * MiB, WS_K = 194 * MiB, WS_V = 290 * MiB;
constexpr size_t WS_Z = 386 * MiB;
constexpr size_t WS_XBC = 514 * MiB;
constexpr size_t WS_GATE = 706 * MiB;
constexpr size_t WS_DT = 834 * MiB;
constexpr size_t WS_ATTN = 838 * MiB;
constexpr size_t WS_M0 = 870 * MiB;
constexpr size_t WS_CONV = WS_K;
constexpr size_t WS_YZ = WS_XBC;
constexpr size_t WS_YN = WS_Z;
constexpr size_t WS_MERGED = WS_XN;
constexpr size_t WS_XN2 = WS_Q;
constexpr size_t WS_TOPI = 162 * MiB;
constexpr size_t WS_TOPW = 163 * MiB;
constexpr size_t WS_SLOT = 164 * MiB;
constexpr size_t WS_ROWMAP = 165 * MiB;
constexpr size_t WS_ACT = 386 * MiB;
constexpr size_t WS_YB = 658 * MiB;
constexpr size_t WS_WIN_T = 2 * MiB;
constexpr size_t WS_WBA_T = 26 * MiB;
constexpr size_t WS_WBS_T = 27 * MiB;
constexpr size_t WS_WOUT_T = 31 * MiB;
constexpr size_t WS_W1T = 194 * MiB;
constexpr size_t WS_W2T = 322 * MiB;
constexpr int NPROJ_PAD = 12032;
constexpr size_t WS_OUTG = 870 * MiB;
constexpr size_t WS_LSE = 966 * MiB;
constexpr size_t WS_END = 1024 * MiB;
constexpr int CW_TMO = 0;
constexpr int CW_BAR = 4096;
constexpr int CW_CNT = 16384;
constexpr int CW_CUR = 16384 + 64 * 32;

constexpr int NWAVES = 8, NTHREADS = 512;
constexpr int LDS_BYTES = 147456;
constexpr int MISC_OFF = LDS_BYTES - 256;

constexpr int NPHASE = 14;

__device__ __forceinline__ unsigned f2bf(float f) { unsigned u = __builtin_bit_cast(unsigned, f); return (u + 0x7fffu + ((u >> 16) & 1u)) >> 16; }
__device__ __forceinline__ unsigned pk2(float lo, float hi) { return f2bf(lo) | (f2bf(hi) << 16); }
__device__ __forceinline__ float bflo(unsigned u) { return __builtin_bit_cast(float, u << 16); }
__device__ __forceinline__ float bfhi(unsigned u) { return __builtin_bit_cast(float, u & 0xffff0000u); }
__device__ __forceinline__ float bf2f(bf16 b) { return __builtin_bit_cast(float, (unsigned)b << 16); }
__device__ __forceinline__ float wave_sum(float v) {
#pragma unroll
    for (int o = 1; o < 64; o <<= 1) v += __shfl_xor(v, o);
    return v;
}
__device__ __forceinline__ float sigmoidf_(float x) { return 1.f / (1.f + __expf(-x)); }
__device__ __forceinline__ float siluf_(float x) { return x / (1.f + __expf(-x)); }
__device__ __forceinline__ float softplusf_(float x) { return fmaxf(x, 0.f) + log1pf(__expf(-fabsf(x))); }

#define XB_TMO      128
#define XB_XCNT(j)  (256  + 64 * (j))
#define XB_XSUB(j)  (1280 + 64 * (j))
#define XB_XGEN(j)  (2304 + 64 * (j))
#define XB_TOP      3328
#define XB_TOPGEN   3392
#define XCD_BAR_WORDS 3456
#define XB_SPIN_CAP (1u << 18)
__device__ __forceinline__ unsigned xb_ld(unsigned* p)              { return __hip_atomic_load(p, __ATOMIC_RELAXED, __HIP_MEMORY_SCOPE_AGENT); }
__device__ __forceinline__ unsigned xb_add(unsigned* p, unsigned v) { return __hip_atomic_fetch_add(p, v, __ATOMIC_RELAXED, __HIP_MEMORY_SCOPE_AGENT); }
__device__ __forceinline__ unsigned xb_xcc_id() { return (unsigned)__builtin_amdgcn_s_getreg((3 << 11) | 20) & 0xFu; }
#define XB_SPIN(cond, bar) do { unsigned _sp = 0; while (cond) { __builtin_amdgcn_s_sleep(1); \
    if ((++_sp & 255u) == 0u) { if (xb_ld(&(bar)[XB_TMO])) break; if (_sp > XB_SPIN_CAP) { atomicAdd(&(bar)[XB_TMO], 1u); break; } } } } while (0)
struct XcdBarrier { unsigned* bar; unsigned x; volatile LAS unsigned* st; };
__device__ __forceinline__ XcdBarrier xcd_barrier_post(unsigned* bar, volatile LAS unsigned* st) {
    XcdBarrier b; b.bar = bar; b.x = xb_xcc_id(); b.st = st;
    if (threadIdx.x == 0) (void)xb_add(&bar[XB_XCNT(b.x)], 1u);
    return b;
}
__device__ __forceinline__ void xcd_barrier_complete(unsigned* bar, unsigned x, unsigned& nloc, unsigned& nx) {
    const unsigned G = gridDim.x * gridDim.y * gridDim.z;
    unsigned sum, cnt, mine, sp = 0u;
    for (;;) {
        sum = 0u; cnt = 0u; mine = 0u;
#pragma unroll
        for (unsigned j = 0; j < 16; ++j) { const unsigned c = xb_ld(&bar[XB_XCNT(j)]); sum += c; cnt += (c > 0u) ? 1u : 0u; mine = (j == x) ? c : mine; }
        if (sum == G) break;
        __builtin_amdgcn_s_sleep(1);
        if ((++sp & 255u) == 0u) { if (xb_ld(&bar[XB_TMO])) break; if (sp > XB_SPIN_CAP) { atomicAdd(&bar[XB_TMO], 1u); break; } }
    }
    nloc = mine > 0u ? mine : 1u; nx = cnt > 0u ? cnt : 1u;
}
__device__ __forceinline__ void xcd_barrier(const XcdBarrier& b) {
    asm volatile("s_waitcnt vmcnt(0)" ::: "memory");
    __syncthreads();
    if (threadIdx.x == 0) {
        unsigned* bar = b.bar;
        __builtin_amdgcn_s_waitcnt(0);
        unsigned nloc = b.st[0], nx = b.st[1];
        if (nloc == 0u) { xcd_barrier_complete(bar, b.x, nloc, nx); b.st[0] = nloc; b.st[1] = nx; }
        const unsigned old = xb_add(&bar[XB_XSUB(b.x)], 1u);
        const unsigned gen = old / nloc;
        if (old + 1u == (gen + 1u) * nloc) {
            __builtin_amdgcn_fence(__ATOMIC_RELEASE, "agent");
            asm volatile("s_waitcnt vmcnt(0)" ::: "memory");
            const unsigned og = xb_add(&bar[XB_TOP], 1u);
            const unsigned tg = og / nx;
            if (og + 1u == (tg + 1u) * nx) xb_add(&bar[XB_TOPGEN], 1u);
            else XB_SPIN(xb_ld(&bar[XB_TOPGEN]) == tg, bar);
            __builtin_amdgcn_fence(__ATOMIC_ACQUIRE, "agent");
            xb_add(&bar[XB_XGEN(b.x)], 1u);
            asm volatile("s_waitcnt vmcnt(0)" ::: "memory");
        } else {
            XB_SPIN(xb_ld(&bar[XB_XGEN(b.x)]) == gen, bar);
            __builtin_amdgcn_fence(__ATOMIC_ACQUIRE, "agent");
            asm volatile("s_waitcnt vmcnt(0)" ::: "memory");
        }
    }
    __syncthreads();
}

struct Args { const float* in[22]; float* out; unsigned char* ws; int ph_lo, ph_hi, li, pad; };

struct Frame {
    LAS unsigned char* lds;
    int tid, lane, wave, blk, nblk;
    const float *x, *w_in, *rel_bias, *w_ba, *conv_w, *conv_b, *dt_bias, *a_log, *d_skip, *ssm_norm_w, *w_bs, *gate_bias, *w_out,
                *norm_mix, *norm_ffn, *router_w, *router_b, *w1, *b1, *w2, *b2, *norm_final;
    float* out; unsigned char* ws; gu32* ctl;
};

template <class Epi>
__device__ __forceinline__ void gemm_naive(Frame& F, int nMt, int N, int K, const bf16* A, int lda, const int* rowmap,
                                           const float* B, int ldb, const int* texp, size_t estride, const Epi& epi) {
    LAS float* As = (LAS float*)F.lds;
    LAS float* Bs = As + 16 * 132;
    const int tid = F.tid, tx = tid & 31, ty = tid >> 5;
    const int nNt = (N + 127) / 128;
    const int ar = tid >> 2, ak = (tid & 3) * 4;
    const int bk = tid >> 5, bn = (tid & 31) * 4;
    for (int tile = F.blk; tile < nMt * nNt; tile += F.nblk) {
        const int mt = tile / nNt, nt = tile % nNt;
        int e = 0;
        if (texp) { e = texp[mt >> 1]; if (e < 0) continue; }
        const float* Bp = B + (size_t)e * estride;
        float acc[8][4];
#pragma unroll
        for (int i = 0; i < 8; ++i)
#pragma unroll
            for (int j = 0; j < 4; ++j) acc[i][j] = 0.f;
        int grow = mt * 128 + ar; if (rowmap) grow = rowmap[grow];
        const bf16* ap = A + (size_t)(grow < 0 ? 0 : grow) * lda + ak;
        const bool aok = grow >= 0;
        const int gcol = nt * 128 + bn;
        const bool bok = gcol < N;
        for (int k0 = 0; k0 < K; k0 += 16) {
            u32x2 av = (u32x2){0u, 0u};
            if (aok) av = *(const u32x2*)(ap + k0);
            f32x4 bv = (f32x4){0.f, 0.f, 0.f, 0.f};
            if (bok) bv = *(const f32x4*)(Bp + (size_t)(k0 + bk) * ldb + gcol);
            __syncthreads();
            As[(ak + 0) * 132 + ar] = bflo(av.x); As[(ak + 1) * 132 + ar] = bfhi(av.x);
            As[(ak + 2) * 132 + ar] = bflo(av.y); As[(ak + 3) * 132 + ar] = bfhi(av.y);
            *(LAS f32x4*)&Bs[bk * 132 + bn] = bv;
            __syncthreads();
#pragma unroll
            for (int k = 0; k < 16; ++k) {
                const f32x4 a0 = *(const LAS f32x4*)&As[k * 132 + ty * 8], a1 = *(const LAS f32x4*)&As[k * 132 + ty * 8 + 4];
                const f32x4 b = *(const LAS f32x4*)&Bs[k * 132 + tx * 4];
                const float a[8] = {a0.x, a0.y, a0.z, a0.w, a1.x, a1.y, a1.z, a1.w};
                const float bb[4] = {b.x, b.y, b.z, b.w};
#pragma unroll
                for (int i = 0; i < 8; ++i)
#pragma unroll
                    for (int j = 0; j < 4; ++j) acc[i][j] = fmaf(a[i], bb[j], acc[i][j]);
            }
        }
        const int col0 = nt * 128 + tx * 4;
        if (col0 < N) {
#pragma unroll
            for (int i = 0; i < 8; ++i) epi(mt * 128 + ty * 8 + i, col0, (f32x4){acc[i][0], acc[i][1], acc[i][2], acc[i][3]}, e);
        }
    }
    __syncthreads();
}

__device__ __forceinline__ void st_bf4(bf16* p, f32x4 v) { u32x2 w; w.x = pk2(v.x, v.y); w.y = pk2(v.z, v.w); *(u32x2*)p = w; }

struct EpiInProj {
    unsigned char* ws; const float* dt_bias; const float* gate_bias;
    __device__ __forceinline__ void operator()(int row, int col, f32x4 v, int) const {
        if (col < C_K)        st_bf4((bf16*)(ws + WS_Q) + (size_t)row * AW + (col - C_Q), v);
        else if (col < C_V)   st_bf4((bf16*)(ws + WS_K) + (size_t)row * AW + (col - C_K), v);
        else if (col < C_Z)   st_bf4((bf16*)(ws + WS_V) + (size_t)row * AW + (col - C_V), v);
        else if (col < C_XBC) st_bf4((bf16*)(ws + WS_Z) + (size_t)row * DI + (col - C_Z), v);
        else if (col < C_DT)  st_bf4((bf16*)(ws + WS_XBC) + (size_t)row * CONVD + (col - C_XBC), v);
        else if (col < C_GATE) { const int c = col - C_DT; f32x4 o;
            o.x = softplusf_(v.x + dt_bias[c]); o.y = softplusf_(v.y + dt_bias[c + 1]); o.z = softplusf_(v.z + dt_bias[c + 2]); o.w = softplusf_(v.w + dt_bias[c + 3]);
            *(f32x4*)((float*)(ws + WS_DT) + (size_t)row * 32 + c) = o; }
        else { const int c = col - C_GATE; f32x4 o;
            o.x = sigmoidf_(v.x + gate_bias[c]); o.y = sigmoidf_(v.y + gate_bias[c + 1]); o.z = sigmoidf_(v.z + gate_bias[c + 2]); o.w = sigmoidf_(v.w + gate_bias[c + 3]);
            st_bf4((bf16*)(ws + WS_GATE) + (size_t)row * 2048 + c, o); }
    }
};
struct EpiM0 {
    unsigned char* ws;
    __device__ __forceinline__ void operator()(int row, int col, f32x4 v, int) const {
        const u32x2 g = *(const u32x2*)((const bf16*)(ws + WS_GATE) + (size_t)row * 2048 + col);
        f32x4 o; o.x = v.x * bflo(g.x); o.y = v.y * bfhi(g.x); o.z = v.z * bflo(g.y); o.w = v.w * bfhi(g.y);
        *(f32x4*)((float*)(ws + WS_M0) + (size_t)row * D + col) = o;
    }
};
struct EpiMerged {
    unsigned char* ws;
    __device__ __forceinline__ void operator()(int row, int col, f32x4 v, int) const {
        const u32x2 g = *(const u32x2*)((const bf16*)(ws + WS_GATE) + (size_t)row * 2048 + 1024 + col);
        const f32x4 m = *(const f32x4*)((const float*)(ws + WS_M0) + (size_t)row * D + col);
        f32x4 o; o.x = m.x + v.x * bflo(g.x); o.y = m.y + v.y * bfhi(g.x); o.z = m.z + v.z * bflo(g.y); o.w = m.w + v.w * bfhi(g.y);
        st_bf4((bf16*)(ws + WS_MERGED) + (size_t)row * D + col, o);
    }
};
struct EpiX1 {
    const float* x; float* out;
    __device__ __forceinline__ void operator()(int row, int col, f32x4 v, int) const {
        const f32x4 xv = *(const f32x4*)(x + (size_t)row * D + col);
        *(f32x4*)(out + (size_t)row * D + col) = xv + v;
    }
};
__device__ __forceinline__ float swiglu_(float g, float l) {
    g = fminf(g, 7.f); l = fminf(fmaxf(l, -7.f), 7.f);
    return g * sigmoidf_(1.702f * g) * (l + 1.f);
}
struct EpiMoe1 {
    unsigned char* ws; const float* b1;
    __device__ __forceinline__ void operator()(int row, int col, f32x4 v, int e) const {
        const f32x4 b = *(const f32x4*)(b1 + (size_t)e * 2048 + col);
        const float o0 = swiglu_(v.x + b.x, v.y + b.y), o1 = swiglu_(v.z + b.z, v.w + b.w);
        *(unsigned*)((bf16*)(ws + WS_ACT) + (size_t)row * 1024 + (col >> 1)) = pk2(o0, o1);
    }
};
struct EpiMoe2 {
    unsigned char* ws; const float* b2;
    __device__ __forceinline__ void operator()(int row, int col, f32x4 v, int e) const {
        const f32x4 b = *(const f32x4*)(b2 + (size_t)e * 1024 + col);
        st_bf4((bf16*)(ws + WS_YB) + (size_t)row * 1024 + col, v + b);
    }
};

namespace pg8 {
typedef short bf16x8 __attribute__((ext_vector_type(8)));
constexpr int BM = 256, BK = 64, HALF = 128, HTB = HALF * BK * 2, STAGE_BYTES = 8 * HTB, NXCD = 8, WGM = 8;
__host__ __device__ __forceinline__ int lds_byte(int r, int c) { const int st = (r >> 4) * 2 + (c >> 5), rr = r & 15, cc = c & 31, ob = rr * 64 + cc * 2; return st * 1024 + (ob ^ (((ob >> 9) & 1) << 5)); }
__host__ __device__ __forceinline__ void stage_rc(int b, int& R, int& C) { const int st = b / 1024, sb = b % 1024, swz = sb ^ (((sb >> 9) & 1) << 5); R = (st >> 1) * 16 + swz / 64; C = (st & 1) * 32 + (swz % 64) / 2; }
__host__ __device__ __forceinline__ int perm32(int rho) { const int n = rho >> 4, i = rho & 15; return 8 * (i >> 2) + 4 * n + (i & 3); }
struct Unit { int pm, pn; };
struct Gemm { const bf16* A; const bf16* Bt; int M, N, K; };
struct StaticOrder {
    int nM, nN, nwg, G, c;
    __host__ __device__ void init(int M, int N, int G_, int c_) { nM = M / BM; nN = N / BM; nwg = nM * nN; G = G_; c = c_; }
    __host__ __device__ bool next(int i, Unit& u) const {
        const long L = (long)i * G + c; if (L >= nwg) return false;
        int wgid = (int)L; { const int q = nwg / NXCD, r = nwg % NXCD, xcd = wgid % NXCD, off = wgid / NXCD; wgid = (xcd < r ? xcd * (q + 1) : r * (q + 1) + (xcd - r) * q) + off; }
        const int nig = WGM * nN, gid = wgid / nig, fm = gid * WGM, gsz = (nM - fm) < WGM ? (nM - fm) : WGM;
        u.pm = fm + ((wgid % nig) % gsz); u.pn = (wgid % nig) / gsz; return true;
    }
    __device__ __forceinline__ void a_ready(const Unit&) const {}
    __device__ __forceinline__ void done(const Unit&) const {}
};
struct MoeOrder {
    int nwg, nN, G, c;
    __device__ void init(int ntile, int nN_, int G_, int c_) { nN = nN_; nwg = ntile * nN_; G = G_; c = c_; }
    __device__ bool next(int i, Unit& u) const { const long L = (long)i * G + c; if (L >= nwg) return false; u.pm = (int)L / nN; u.pn = (int)L % nN; return true; }
    __device__ __forceinline__ void a_ready(const Unit&) const {}
    __device__ __forceinline__ void done(const Unit&) const {}
};
__device__ __forceinline__ unsigned cvt_pk_bf16(float lo, float hi) { unsigned r; asm volatile("v_cvt_pk_bf16_f32 %0, %1, %2" : "=v"(r) : "v"(lo), "v"(hi)); return r; }

template <class Epi, class Sched, bool ALIGN_EPI, bool GATHER, bool EXPERT>
__device__ __forceinline__ void gemm_phase(LAS unsigned char* lds, const Gemm g, const Sched& S, const Epi& E, const int* rowmap, const int* texp, size_t bstride) {
    const int tid = threadIdx.x, wid = __builtin_amdgcn_readfirstlane(tid >> 6), lane = tid & 63, wr = wid >> 2, wc = wid & 3, fr = lane & 15, fq = lane >> 4;
    const int K = g.K, nt = K / BK;
    unsigned voffA[2], voffB[2]; int RA[2]; unsigned CAb[2];
#pragma unroll
    for (int i = 0; i < 2; ++i) { int R, C; stage_rc(tid * 16 + i * 8192, R, C); const int Rb = Epi::PERM ? ((R & ~31) + perm32(R & 31)) : R;
        voffA[i] = (unsigned)(R * K + C) * 2u; voffB[i] = (unsigned)(Rb * K + C) * 2u; RA[i] = R; CAb[i] = (unsigned)C * 2u; }
    const size_t kstep = (size_t)(BK * 2);
    const size_t hstep = (size_t)HALF * K * 2;
    const size_t tstep = 2 * hstep;
    const size_t ahs = GATHER ? 0 : hstep;
    const unsigned ldsw = (unsigned)wid * 1024u;
    const int aoff = lds_byte(wr * 64 + fr, fq * 8), boff = lds_byte(wc * 32 + fr, fq * 8);
#define PG8_SA(b, h) (((b) * 2 + (h)) * HTB)
#define PG8_SB(b, h) ((4 + (b) * 2 + (h)) * HTB)
#define PG8_STAGE(bufoff, gbase, voff) do { _Pragma("unroll") for (int _i = 0; _i < 2; ++_i) \
        __builtin_amdgcn_global_load_lds((const unsigned*)((const char*)(gbase) + (voff)[_i]), (LAS unsigned*)(lds + (bufoff) + ldsw + _i * 8192), 16, 0, 0); } while (0)
#define PG8_LDA(dst, b, h) do { _Pragma("unroll") for (int m = 0; m < 4; ++m) _Pragma("unroll") for (int k = 0; k < 2; ++k) dst[m][k] = *(const LAS bf16x8*)(lds + PG8_SA(b, h) + aoff + m * 2048 + k * 1024); } while (0)
#define PG8_LDB(dst, b, h) do { _Pragma("unroll") for (int n = 0; n < 2; ++n) _Pragma("unroll") for (int k = 0; k < 2; ++k) dst[n][k] = *(const LAS bf16x8*)(lds + PG8_SB(b, h) + boff + n * 2048 + k * 1024); } while (0)
#define PG8_MMA(ai, bj, At, Bt) do { __builtin_amdgcn_s_setprio(1); _Pragma("unroll") for (int m = 0; m < 4; ++m) _Pragma("unroll") for (int n = 0; n < 2; ++n) _Pragma("unroll") for (int k = 0; k < 2; ++k) \
        acc[ai][bj][m][n] = __builtin_amdgcn_mfma_f32_16x16x32_bf16(Bt[n][k], At[m][k], acc[ai][bj][m][n], 0, 0, 0); __builtin_amdgcn_s_setprio(0); } while (0)
#define PG8_WAIT_V(n) asm volatile("s_waitcnt vmcnt(" #n ")" ::: "memory")
#define PG8_WAIT_L(n) asm volatile("s_waitcnt lgkmcnt(" #n ")" ::: "memory")
#define PG8_BAR __builtin_amdgcn_s_barrier()
#define PG8_SCHED __builtin_amdgcn_sched_barrier(0)
#define PG8_ROWS(u, v) do { _Pragma("unroll") for (int _h = 0; _h < 2; ++_h) _Pragma("unroll") for (int _i = 0; _i < 2; ++_i) { int _r = rowmap[(u).pm * BM + _h * HALF + RA[_i]]; _r = _r < 0 ? 0 : _r; \
        v[_h][_i] = (unsigned)_r * (unsigned)(K * 2) + CAb[_i]; } } while (0)
#define PG8_BPTR(u) ((const char*)g.Bt + (EXPERT ? (size_t)texp[(u).pm] * bstride : (size_t)0) + (size_t)(u).pn * tstep)
#define PG8_APTR(u) ((const char*)g.A + (GATHER ? (size_t)0 : (size_t)(u).pm * tstep))
    Unit cur, nxt; int ui = 0;
    if (!S.next(0, cur)) return;
    f32x4 acc[2][2][4][2];
#pragma unroll
    for (int a = 0; a < 2; ++a)
#pragma unroll
        for (int b = 0; b < 2; ++b)
#pragma unroll
            for (int m = 0; m < 4; ++m)
#pragma unroll
                for (int n = 0; n < 2; ++n) acc[a][b][m][n] = (f32x4){0.f, 0.f, 0.f, 0.f};
    bf16x8 At[4][2], B0[2][2], B1[2][2];
    unsigned cv[2][2], nv[2][2];
    if constexpr (GATHER) { PG8_ROWS(cur, cv); } else { cv[0][0] = voffA[0]; cv[0][1] = voffA[1]; cv[1][0] = voffA[0]; cv[1][1] = voffA[1]; }
#pragma unroll
    for (int h = 0; h < 2; ++h) { nv[h][0] = cv[h][0]; nv[h][1] = cv[h][1]; }
    const char* cA = PG8_APTR(cur); const char* cB = PG8_BPTR(cur);
    S.a_ready(cur);
    PG8_STAGE(PG8_SB(0, 0), cB, voffB); PG8_STAGE(PG8_SB(0, 1), cB + hstep, voffB); PG8_STAGE(PG8_SA(0, 0), cA, cv[0]); PG8_STAGE(PG8_SA(0, 1), cA + ahs, cv[1]);
    if (wr == 1) PG8_BAR;
    PG8_WAIT_V(2); PG8_BAR;
    PG8_STAGE(PG8_SB(1, 0), cB + kstep, voffB); PG8_STAGE(PG8_SA(1, 0), cA + kstep, cv[0]); PG8_STAGE(PG8_SB(1, 1), cB + hstep + kstep, voffB);
    PG8_WAIT_V(6); PG8_BAR;
    for (;;) {
        const bool has_next = S.next(ui + 1, nxt);
        const char* nA = has_next ? PG8_APTR(nxt) : cA; const char* nB = has_next ? PG8_BPTR(nxt) : cB;
        if constexpr (GATHER) { if (has_next) { PG8_ROWS(nxt, nv); } }
        for (int t = 0; t < nt; t += 2) {
            const bool last = (t == nt - 2);
            const char* a1 = cA + (size_t)(t + 1) * kstep;
            const char* a2 = last ? nA : cA + (size_t)(t + 2) * kstep; const char* b2 = last ? nB : cB + (size_t)(t + 2) * kstep;
            const char* a3 = a2 + kstep; const char* b3 = b2 + kstep;
            unsigned s0[2], s1[2];
            s0[0] = last ? nv[0][0] : cv[0][0]; s0[1] = last ? nv[0][1] : cv[0][1]; s1[0] = last ? nv[1][0] : cv[1][0]; s1[1] = last ? nv[1][1] : cv[1][1];
            if (last && has_next) S.a_ready(nxt);
            PG8_LDB(B0, 0, 0); PG8_LDB(B1, 0, 1); PG8_SCHED; PG8_LDA(At, 0, 0); PG8_STAGE(PG8_SA(1, 1), a1 + ahs, cv[1]);
            PG8_WAIT_V(8); PG8_WAIT_L(0); PG8_BAR; PG8_MMA(0, 0, At, B0); PG8_MMA(0, 1, At, B1); PG8_BAR; PG8_SCHED;
            PG8_LDA(At, 0, 1); PG8_STAGE(PG8_SB(0, 0), b2, voffB); PG8_STAGE(PG8_SB(0, 1), b2 + hstep, voffB); PG8_STAGE(PG8_SA(0, 0), a2, s0);
            PG8_WAIT_V(8); PG8_WAIT_L(0); PG8_BAR; PG8_MMA(1, 0, At, B0); PG8_MMA(1, 1, At, B1); PG8_BAR; PG8_SCHED;
            PG8_LDB(B0, 1, 0); PG8_LDB(B1, 1, 1); PG8_SCHED; PG8_LDA(At, 1, 0); PG8_STAGE(PG8_SA(0, 1), a2 + ahs, s1);
            PG8_WAIT_V(8); PG8_WAIT_L(0); PG8_BAR; PG8_MMA(0, 0, At, B0); PG8_MMA(0, 1, At, B1); PG8_BAR; PG8_SCHED;
            PG8_LDA(At, 1, 1); PG8_STAGE(PG8_SB(1, 0), b3, voffB); PG8_STAGE(PG8_SB(1, 1), b3 + hstep, voffB); PG8_STAGE(PG8_SA(1, 0), a3, s0);
            PG8_WAIT_V(8); PG8_WAIT_L(0); PG8_BAR; PG8_MMA(1, 0, At, B0); PG8_MMA(1, 1, At, B1); PG8_BAR; PG8_SCHED;
        }
        if constexpr (ALIGN_EPI) { if (wr == 0) PG8_BAR; }
        E(acc, cur, wr, wc, fr, fq); S.done(cur);
        if (!has_next) break;
#pragma unroll
        for (int a = 0; a < 2; ++a)
#pragma unroll
            for (int b = 0; b < 2; ++b)
#pragma unroll
                for (int m = 0; m < 4; ++m)
#pragma unroll
                    for (int n = 0; n < 2; ++n) acc[a][b][m][n] = (f32x4){0.f, 0.f, 0.f, 0.f};
        cur = nxt; cA = nA; cB = nB; ++ui;
#pragma unroll
        for (int h = 0; h < 2; ++h) { cv[h][0] = nv[h][0]; cv[h][1] = nv[h][1]; }
        if constexpr (ALIGN_EPI) { if (wr == 1) PG8_BAR; }
    }
    PG8_WAIT_V(0);
    if constexpr (!ALIGN_EPI) { if (wr == 0) PG8_BAR; }
    PG8_BAR;
#undef PG8_SA
#undef PG8_SB
#undef PG8_STAGE
#undef PG8_LDA
#undef PG8_LDB
#undef PG8_MMA
#undef PG8_WAIT_V
#undef PG8_WAIT_L
#undef PG8_BAR
#undef PG8_SCHED
#undef PG8_ROWS
#undef PG8_BPTR
#undef PG8_APTR
}

struct EpiInProjF {
    static constexpr bool PERM = true;
    unsigned char* ws; const float* dt_bias; const float* gate_bias;
    __device__ __forceinline__ void operator()(const f32x4 (&acc)[2][2][4][2], const Unit& u, int wr, int wc, int fr, int fq) const {
        const int pn = u.pn, row0 = u.pm * BM + wr * 64 + fr, c8 = wc * 32 + 8 * fq;
        if (pn < 46) {
            bf16* base; int ldc, ct; const bool gate = pn >= 38;
            if (pn < 6) { base = (bf16*)(ws + WS_Q); ldc = AW; ct = pn * 256; }
            else if (pn < 12) { base = (bf16*)(ws + WS_K); ldc = AW; ct = (pn - 6) * 256; }
            else if (pn < 18) { base = (bf16*)(ws + WS_V); ldc = AW; ct = (pn - 12) * 256; }
            else if (pn < 26) { base = (bf16*)(ws + WS_Z); ldc = DI; ct = (pn - 18) * 256; }
            else if (pn < 38) { base = (bf16*)(ws + WS_XBC); ldc = CONVD; ct = (pn - 26) * 256; }
            else { base = (bf16*)(ws + WS_GATE); ldc = 2048; ct = (pn - 38) * 256; }
            f32x4 gb[2][2];
#pragma unroll
            for (int bj = 0; bj < 2; ++bj)
#pragma unroll
                for (int n = 0; n < 2; ++n) gb[bj][n] = gate ? *(const f32x4*)(gate_bias + ct + c8 + bj * HALF + 4 * n) : (f32x4){0.f, 0.f, 0.f, 0.f};
#pragma unroll
            for (int ai = 0; ai < 2; ++ai)
#pragma unroll
                for (int m = 0; m < 4; ++m) { bf16* rowp = base + (size_t)(row0 + ai * HALF + m * 16) * ldc + ct + c8;
#pragma unroll
                    for (int bj = 0; bj < 2; ++bj) { f32x4 v0 = acc[ai][bj][m][0], v1 = acc[ai][bj][m][1];
                        if (gate) { v0 = v0 + gb[bj][0]; v1 = v1 + gb[bj][1];
                            v0 = (f32x4){sigmoidf_(v0.x), sigmoidf_(v0.y), sigmoidf_(v0.z), sigmoidf_(v0.w)}; v1 = (f32x4){sigmoidf_(v1.x), sigmoidf_(v1.y), sigmoidf_(v1.z), sigmoidf_(v1.w)}; }
                        u32x4 w; w.x = cvt_pk_bf16(v0.x, v0.y); w.y = cvt_pk_bf16(v0.z, v0.w); w.z = cvt_pk_bf16(v1.x, v1.y); w.w = cvt_pk_bf16(v1.z, v1.w);
                        *(u32x4*)(rowp + bj * HALF) = w; } }
        } else if (wc == 0) {
            const f32x4 b0 = *(const f32x4*)(dt_bias + c8), b1 = *(const f32x4*)(dt_bias + c8 + 4);
#pragma unroll
            for (int ai = 0; ai < 2; ++ai)
#pragma unroll
                for (int m = 0; m < 4; ++m) { float* rowp = (float*)(ws + WS_DT) + (size_t)(row0 + ai * HALF + m * 16) * 32 + c8;
                    const f32x4 v0 = acc[ai][0][m][0] + b0, v1 = acc[ai][0][m][1] + b1;
                    *(f32x4*)rowp = (f32x4){softplusf_(v0.x), softplusf_(v0.y), softplusf_(v0.z), softplusf_(v0.w)};
                    *(f32x4*)(rowp + 4) = (f32x4){softplusf_(v1.x), softplusf_(v1.y), softplusf_(v1.z), softplusf_(v1.w)}; }
        }
    }
};
struct EpiM0F {
    static constexpr bool PERM = false;
    unsigned char* ws;
    __device__ __forceinline__ void operator()(const f32x4 (&acc)[2][2][4][2], const Unit& u, int wr, int wc, int fr, int fq) const {
        const int row0 = u.pm * BM + wr * 64 + fr, col0 = u.pn * BM + wc * 32 + 4 * fq;
#pragma unroll
        for (int ai = 0; ai < 2; ++ai)
#pragma unroll
            for (int m = 0; m < 4; ++m) { const size_t r = (size_t)(row0 + ai * HALF + m * 16);
#pragma unroll
                for (int bj = 0; bj < 2; ++bj)
#pragma unroll
                    for (int n = 0; n < 2; ++n) { const int c = col0 + bj * HALF + n * 16;
                        const u32x2 gg = *(const u32x2*)((const bf16*)(ws + WS_GATE) + r * 2048 + c); const f32x4 v = acc[ai][bj][m][n];
                        *(f32x4*)((float*)(ws + WS_M0) + r * D + c) = (f32x4){v.x * bflo(gg.x), v.y * bfhi(gg.x), v.z * bflo(gg.y), v.w * bfhi(gg.y)}; } }
    }
};
struct EpiMergedF {
    static constexpr bool PERM = true;
    unsigned char* ws;
    __device__ __forceinline__ void operator()(const f32x4 (&acc)[2][2][4][2], const Unit& u, int wr, int wc, int fr, int fq) const {
        const int row0 = u.pm * BM + wr * 64 + fr, col0 = u.pn * BM + wc * 32 + 8 * fq;
#pragma unroll
        for (int ai = 0; ai < 2; ++ai)
#pragma unroll
            for (int m = 0; m < 4; ++m) { const size_t r = (size_t)(row0 + ai * HALF + m * 16);
#pragma unroll
                for (int bj = 0; bj < 2; ++bj) { const int c = col0 + bj * HALF;
                    const u32x4 gg = *(const u32x4*)((const bf16*)(ws + WS_GATE) + r * 2048 + 1024 + c);
                    const f32x4 m0 = *(const f32x4*)((const float*)(ws + WS_M0) + r * D + c), m1 = *(const f32x4*)((const float*)(ws + WS_M0) + r * D + c + 4);
                    const f32x4 v0 = acc[ai][bj][m][0], v1 = acc[ai][bj][m][1];
                    u32x4 w; w.x = cvt_pk_bf16(m0.x + v0.x * bflo(gg.x), m0.y + v0.y * bfhi(gg.x)); w.y = cvt_pk_bf16(m0.z + v0.z * bflo(gg.y), m0.w + v0.w * bfhi(gg.y));
                    w.z = cvt_pk_bf16(m1.x + v1.x * bflo(gg.z), m1.y + v1.y * bfhi(gg.z)); w.w = cvt_pk_bf16(m1.z + v1.z * bflo(gg.w), m1.w + v1.w * bfhi(gg.w));
                    *(u32x4*)((bf16*)(ws + WS_MERGED) + r * D + c) = w; } }
    }
};
struct EpiX1F {
    static constexpr bool PERM = false;
    const float* x; float* out;
    __device__ __forceinline__ void operator()(const f32x4 (&acc)[2][2][4][2], const Unit& u, int wr, int wc, int fr, int fq) const {
        const int row0 = u.pm * BM + wr * 64 + fr, col0 = u.pn * BM + wc * 32 + 4 * fq;
#pragma unroll
        for (int ai = 0; ai < 2; ++ai)
#pragma unroll
            for (int m = 0; m < 4; ++m) { const size_t r = (size_t)(row0 + ai * HALF + m * 16);
#pragma unroll
                for (int bj = 0; bj < 2; ++bj)
#pragma unroll
                    for (int n = 0; n < 2; ++n) { const int c = col0 + bj * HALF + n * 16;
                        *(f32x4*)(out + r * D + c) = *(const f32x4*)(x + r * D + c) + acc[ai][bj][m][n]; } }
    }
};
struct EpiMoe1F {
    static constexpr bool PERM = true;
    unsigned char* ws; const float* b1; const int* texp;
    __device__ __forceinline__ void operator()(const f32x4 (&acc)[2][2][4][2], const Unit& u, int wr, int wc, int fr, int fq) const {
        const int e = texp[u.pm];
        const int row0 = u.pm * BM + wr * 64 + fr, col0 = u.pn * BM + wc * 32 + 8 * fq;
        f32x4 bv[2][2];
#pragma unroll
        for (int bj = 0; bj < 2; ++bj)
#pragma unroll
            for (int n = 0; n < 2; ++n) bv[bj][n] = *(const f32x4*)(b1 + (size_t)e * 2048 + col0 + bj * HALF + 4 * n);
#pragma unroll
        for (int ai = 0; ai < 2; ++ai)
#pragma unroll
            for (int m = 0; m < 4; ++m) { const size_t r = (size_t)(row0 + ai * HALF + m * 16);
#pragma unroll
                for (int bj = 0; bj < 2; ++bj) { const f32x4 v0 = acc[ai][bj][m][0] + bv[bj][0], v1 = acc[ai][bj][m][1] + bv[bj][1];
                    u32x2 w; w.x = cvt_pk_bf16(swiglu_(v0.x, v0.y), swiglu_(v0.z, v0.w)); w.y = cvt_pk_bf16(swiglu_(v1.x, v1.y), swiglu_(v1.z, v1.w));
                    *(u32x2*)((bf16*)(ws + WS_ACT) + r * 1024 + ((col0 + bj * HALF) >> 1)) = w; } }
    }
};
struct EpiMoe2F {
    static constexpr bool PERM = true;
    unsigned char* ws; const float* b2; const int* texp;
    __device__ __forceinline__ void operator()(const f32x4 (&acc)[2][2][4][2], const Unit& u, int wr, int wc, int fr, int fq) const {
        const int e = texp[u.pm];
        const int row0 = u.pm * BM + wr * 64 + fr, col0 = u.pn * BM + wc * 32 + 8 * fq;
        f32x4 bv[2][2];
#pragma unroll
        for (int bj = 0; bj < 2; ++bj)
#pragma unroll
            for (int n = 0; n < 2; ++n) bv[bj][n] = *(const f32x4*)(b2 + (size_t)e * 1024 + col0 + bj * HALF + 4 * n);
#pragma unroll
        for (int ai = 0; ai < 2; ++ai)
#pragma unroll
            for (int m = 0; m < 4; ++m) { const size_t r = (size_t)(row0 + ai * HALF + m * 16);
#pragma unroll
                for (int bj = 0; bj < 2; ++bj) { const f32x4 v0 = acc[ai][bj][m][0] + bv[bj][0], v1 = acc[ai][bj][m][1] + bv[bj][1];
                    u32x4 w; w.x = cvt_pk_bf16(v0.x, v0.y); w.y = cvt_pk_bf16(v0.z, v0.w); w.z = cvt_pk_bf16(v1.x, v1.y); w.w = cvt_pk_bf16(v1.z, v1.w);
                    *(u32x4*)((bf16*)(ws + WS_YB) + r * 1024 + col0 + bj * HALF) = w; } }
    }
};
}

__device__ __forceinline__ void transpose_item(const float* W, int K, int N, bf16* WT, int k0, int n0, int drow0, LAS float* scr, int lane) {
#pragma unroll 8
    for (int i = 0; i < 32; ++i) { const int kk = 2 * i + (lane >> 5); scr[kk * 33 + (lane & 31)] = W[(size_t)(k0 + kk) * N + n0 + (lane & 31)]; }
    asm volatile("s_waitcnt lgkmcnt(0)" ::: "memory");
    const int c = lane & 7;
#pragma unroll
    for (int j = 0; j < 4; ++j) { const int n = (lane >> 3) + 8 * j; const LAS float* s = scr + (8 * c) * 33 + n;
        u32x4 o; o.x = pk2(s[0 * 33], s[1 * 33]); o.y = pk2(s[2 * 33], s[3 * 33]); o.z = pk2(s[4 * 33], s[5 * 33]); o.w = pk2(s[6 * 33], s[7 * 33]);
        *(u32x4*)(WT + (size_t)(drow0 + n) * K + k0 + 8 * c) = o; }
    asm volatile("s_waitcnt lgkmcnt(0)" ::: "memory");
}
__device__ __forceinline__ int inproj_row_of_col(int n0) { return n0 < C_DT ? n0 : (n0 < C_GATE ? n0 - C_DT + 11776 : n0 - 32); }
__device__ __forceinline__ void p_convert_small(Frame& F) {
    LAS float* scr = (LAS float*)(F.lds + F.wave * 16384);
    const int gw = F.blk * NWAVES + F.wave, NGW = F.nblk * NWAVES;
    constexpr int I_IN = 16 * (NPROJ / 32), I_BA = 8 * 32, I_BS = 32 * 32, I_OUT = 16 * 32, NIT = I_IN + I_BA + I_BS + I_OUT;
    for (int it = gw; it < NIT; it += NGW) {
        int r = it;
        if (r < I_IN) { const int nb = r % (NPROJ / 32), kb = r / (NPROJ / 32); transpose_item(F.w_in, D, NPROJ, (bf16*)(F.ws + WS_WIN_T), 64 * kb, 32 * nb, inproj_row_of_col(32 * nb), scr, F.lane); continue; } r -= I_IN;
        if (r < I_BA) { const int nb = r % 32, kb = r / 32; transpose_item(F.w_ba, 512, D, (bf16*)(F.ws + WS_WBA_T), 64 * kb, 32 * nb, 32 * nb, scr, F.lane); continue; } r -= I_BA;
        if (r < I_BS) { const int nb = r % 32, kb = r / 32; transpose_item(F.w_bs, DI, D, (bf16*)(F.ws + WS_WBS_T), 64 * kb, 32 * nb, 32 * nb, scr, F.lane); continue; } r -= I_BS;
        { const int nb = r % 32, kb = r / 32; transpose_item(F.w_out, D, D, (bf16*)(F.ws + WS_WOUT_T), 64 * kb, 32 * nb, 32 * nb, scr, F.lane); }
    }
    u32x4* z = (u32x4*)((bf16*)(F.ws + WS_WIN_T) + (size_t)11808 * D);
    for (int i = F.blk * NTHREADS + F.tid; i < 224 * D * 2 / 16; i += F.nblk * NTHREADS) z[i] = (u32x4){0u, 0u, 0u, 0u};
}
__device__ __forceinline__ void p_convert_moe(Frame& F) {
    LAS float* scr = (LAS float*)(F.lds + F.wave * 16384);
    const int gw = F.blk * NWAVES + F.wave, NGW = F.nblk * NWAVES;
    constexpr int I_1 = 16 * 64, I_2 = 16 * 32, NIT = NEXP * (I_1 + I_2);
    for (int it = gw; it < NIT; it += NGW) {
        const int e = it / (I_1 + I_2); int r = it % (I_1 + I_2);
        if (r < I_1) { const int nb = r % 64, kb = r / 64; transpose_item(F.w1 + (size_t)e * 1024 * 2048, 1024, 2048, (bf16*)(F.ws + WS_W1T) + (size_t)e * 2048 * 1024, 64 * kb, 32 * nb, 32 * nb, scr, F.lane); }
        else { r -= I_1; const int nb = r % 32, kb = r / 32; transpose_item(F.w2 + (size_t)e * 1024 * 1024, 1024, 1024, (bf16*)(F.ws + WS_W2T) + (size_t)e * 1024 * 1024, 64 * kb, 32 * nb, 32 * nb, scr, F.lane); }
    }
}

__device__ __forceinline__ void p_rmsnorm_in(Frame& F) {
    const int gw = F.blk * NWAVES + F.wave, NGW = F.nblk * NWAVES;
    bf16* XN = (bf16*)(F.ws + WS_XN);
    for (int m = gw; m < T; m += NGW) {
        const f32x4* xr = (const f32x4*)(F.x + (size_t)m * D) + F.lane;
        const f32x4* wr = (const f32x4*)F.norm_mix + F.lane;
        f32x4 v[4]; float s = 0.f;
#pragma unroll
        for (int j = 0; j < 4; ++j) { v[j] = xr[64 * j]; s += (v[j].x * v[j].x + v[j].y * v[j].y) + (v[j].z * v[j].z + v[j].w * v[j].w); }
        const float rstd = 1.f / sqrtf(wave_sum(s) * (1.f / D) + EPS);
#pragma unroll
        for (int j = 0; j < 4; ++j) { const f32x4 w = wr[64 * j]; const f32x4 o = v[j] * rstd * w; st_bf4(XN + (size_t)m * D + (F.lane + 64 * j) * 4, o); }
    }
}

__device__ __forceinline__ int t5_bucket_dev(int dist) {
    if (dist < 16) return dist;
    int l = 16 + (int)(logf((float)dist / 16.f) / logf(128.f) * 16.f);
    return l < 31 ? l : 31;
}
__device__ __forceinline__ void p_attn_naive(Frame& F) {
    LAS float* btab = (LAS float*)F.lds;
    for (int i = F.tid; i < 3 * 129 * 8; i += NTHREADS) {
        const int g = i / (129 * 8), j = (i >> 3) % 129, hg = i & 7;
        const int dil = g == 0 ? 1 : (g == 1 ? 4 : 16);
        btab[i] = F.rel_bias[t5_bucket_dev(j * dil) * 24 + g * 8 + hg];
    }
    __syncthreads();
    const bf16* Qb = (const bf16*)(F.ws + WS_Q); const bf16* Kb = (const bf16*)(F.ws + WS_K); const bf16* Vb = (const bf16*)(F.ws + WS_V);
    bf16* AT = (bf16*)(F.ws + WS_ATTN);
    for (int idx = F.blk * NTHREADS + F.tid; idx < T * 8; idx += F.nblk * NTHREADS) {
        const int hg = idx & 7, row = idx >> 3, t = row & (SEQ - 1);
        float m = -INFINITY, den = 0.f;
        float acc[64];
#pragma unroll
        for (int i = 0; i < 64; ++i) acc[i] = 0.f;
        for (int g = 0; g < 3; ++g) {
            const int dil = g == 0 ? 1 : (g == 1 ? 4 : 16);
            const int head = g * 8 + hg;
            float q[64];
            { const u32x4* qp = (const u32x4*)(Qb + (size_t)row * AW + head * 64);
#pragma unroll
              for (int c = 0; c < 8; ++c) { const u32x4 w = qp[c]; q[8 * c + 0] = bflo(w.x); q[8 * c + 1] = bfhi(w.x); q[8 * c + 2] = bflo(w.y); q[8 * c + 3] = bfhi(w.y);
                  q[8 * c + 4] = bflo(w.z); q[8 * c + 5] = bfhi(w.z); q[8 * c + 6] = bflo(w.w); q[8 * c + 7] = bfhi(w.w); } }
            for (int j = 0; j <= 128; ++j) {
                const int kt = t - j * dil; if (kt < 0) break;
                const size_t krow = (size_t)(row - j * dil);
                const u32x4* kp = (const u32x4*)(Kb + krow * AW + head * 64);
                float s = 0.f;
#pragma unroll
                for (int c = 0; c < 8; ++c) { const u32x4 w = kp[c];
                    s += q[8 * c + 0] * bflo(w.x) + q[8 * c + 1] * bfhi(w.x) + q[8 * c + 2] * bflo(w.y) + q[8 * c + 3] * bfhi(w.y)
                       + q[8 * c + 4] * bflo(w.z) + q[8 * c + 5] * bfhi(w.z) + q[8 * c + 6] * bflo(w.w) + q[8 * c + 7] * bfhi(w.w); }
                s = s * 0.125f + btab[(g * 129 + j) * 8 + hg];
                const float mn = fmaxf(m, s), sc = __expf(m - mn), p = __expf(s - mn);
                m = mn; den = den * sc + p;
                const u32x4* vp = (const u32x4*)(Vb + krow * AW + head * 64);
#pragma unroll
                for (int c = 0; c < 8; ++c) { const u32x4 w = vp[c];
                    acc[8 * c + 0] = acc[8 * c + 0] * sc + p * bflo(w.x); acc[8 * c + 1] = acc[8 * c + 1] * sc + p * bfhi(w.x);
                    acc[8 * c + 2] = acc[8 * c + 2] * sc + p * bflo(w.y); acc[8 * c + 3] = acc[8 * c + 3] * sc + p * bfhi(w.y);
                    acc[8 * c + 4] = acc[8 * c + 4] * sc + p * bflo(w.z); acc[8 * c + 5] = acc[8 * c + 5] * sc + p * bfhi(w.z);
                    acc[8 * c + 6] = acc[8 * c + 6] * sc + p * bflo(w.w); acc[8 * c + 7] = acc[8 * c + 7] * sc + p * bfhi(w.w); }
            }
        }
        const float inv = 1.f / den;
        u32x4* op = (u32x4*)(AT + (size_t)row * 512 + hg * 64);
#pragma unroll
        for (int c = 0; c < 8; ++c) { u32x4 w; w.x = pk2(acc[8 * c] * inv, acc[8 * c + 1] * inv); w.y = pk2(acc[8 * c + 2] * inv, acc[8 * c + 3] * inv);
            w.z = pk2(acc[8 * c + 4] * inv, acc[8 * c + 5] * inv); w.w = pk2(acc[8 * c + 6] * inv, acc[8 * c + 7] * inv); op[c] = w; }
    }
    __syncthreads();
}

typedef short bf16x8_t __attribute__((ext_vector_type(8)));
typedef short s16x4_t __attribute__((ext_vector_type(4)));
typedef float f32x16 __attribute__((ext_vector_type(16)));
__device__ __forceinline__ int crow_(int reg, int h) { return (reg & 3) + 8 * (reg >> 2) + 4 * h; }
__device__ __forceinline__ s16x4_t tr_read_(const LAS unsigned char* p) { return __builtin_bit_cast(s16x4_t, __builtin_amdgcn_ds_read_tr16_b64_v4i16((LAS s16x4_t*)p)); }
constexpr int ATT_HALF_BYTES = 66560;
__device__ __forceinline__ void p_attn_fast(Frame& F) {
    const int half = F.wave >> 2, qb = F.wave & 3, th = F.tid & 255, lane = F.lane, r = lane & 31, h = lane >> 5;
    LAS unsigned char* base = F.lds + half * ATT_HALF_BYTES;
    LAS unsigned char* Kimg = base; LAS unsigned char* Vimg = base + 32768; LAS float* btab = (LAS float*)(base + 65536);
    const bf16* Qb = (const bf16*)(F.ws + WS_Q); const bf16* Kb = (const bf16*)(F.ws + WS_K); const bf16* Vb = (const bf16*)(F.ws + WS_V);
    bf16* OUTG = (bf16*)(F.ws + WS_OUTG); float* LSE = (float*)(F.ws + WS_LSE);
    constexpr int NUNIT = BATCH * 24 * 16;
    for (int pair = F.blk; pair < NUNIT / 2; pair += F.nblk) {
        const int u = pair * 2 + half;
        const int zn = u & 15, head = (u >> 4) % 24, b = u / (16 * 24);
        const int g = head >> 3, hg = head & 7;
        const int dil = g == 0 ? 1 : (g == 1 ? 4 : 16), nb = 16 / dil;
        const int z = zn / nb, n = zn % nb;
        const size_t rowb = (size_t)b * SEQ;
        __syncthreads();
#pragma unroll
        for (int i = 0; i < 8; ++i) {
            const int piece = th + 256 * i, kw = piece >> 3, ch = piece & 7;
            const int p = (n - 1) * 128 + kw;
            u32x4 kv = (u32x4){0u, 0u, 0u, 0u}, vv = (u32x4){0u, 0u, 0u, 0u};
            if (p >= 0) { const size_t row = rowb + (size_t)p * dil + z; kv = *(const u32x4*)(Kb + row * AW + head * 64 + ch * 8); vv = *(const u32x4*)(Vb + row * AW + head * 64 + ch * 8); }
            const int off = kw * 128 + ((ch ^ (kw & 7)) << 4);
            *(LAS u32x4*)(Kimg + off) = kv; *(LAS u32x4*)(Vimg + off) = vv;
        }
        if (th < 129) btab[th] = F.rel_bias[t5_bucket_dev(th * dil) * 24 + head];
        bf16x8_t qf[4];
        { const size_t qrow = rowb + (size_t)(n * 128 + 32 * qb + r) * dil + z;
#pragma unroll
          for (int dd = 0; dd < 4; ++dd) qf[dd] = *(const bf16x8_t*)(Qb + qrow * AW + head * 64 + 16 * dd + 8 * h); }
        __syncthreads();
        f32x16 sc[5];
#pragma unroll
        for (int kb = 0; kb < 5; ++kb) {
            f32x16 a = {0.f, 0.f, 0.f, 0.f, 0.f, 0.f, 0.f, 0.f, 0.f, 0.f, 0.f, 0.f, 0.f, 0.f, 0.f, 0.f};
            const int krow0 = 32 * (qb + kb) + r;
#pragma unroll
            for (int dd = 0; dd < 4; ++dd) {
                const bf16x8_t kf = *(const LAS bf16x8_t*)(Kimg + krow0 * 128 + (((2 * dd + h) ^ (r & 7)) << 4));
                a = __builtin_amdgcn_mfma_f32_32x32x16_bf16(kf, qf[dd], a, 0, 0, 0);
            }
            sc[kb] = a;
        }
        float m = -INFINITY;
#pragma unroll
        for (int kb = 0; kb < 5; ++kb)
#pragma unroll
            for (int i = 0; i < 16; ++i) {
                const int c = crow_(i, h);
                const int delta = 128 + r - 32 * kb - c;
                bool valid = (kb == 0) ? (r <= c) : ((kb == 4) ? (c <= r) : true);
                if (n == 0 && (32 * (qb + kb) + c) < 128) valid = false;
                const int dcl = delta < 0 ? 0 : (delta > 128 ? 128 : delta);
                const float s = valid ? (sc[kb][i] * 0.125f + btab[dcl]) : -INFINITY;
                sc[kb][i] = s; m = fmaxf(m, s);
            }
        m = fmaxf(m, __shfl_xor(m, 32));
        float den = 0.f;
#pragma unroll
        for (int kb = 0; kb < 5; ++kb)
#pragma unroll
            for (int i = 0; i < 16; ++i) { const float p = __expf(sc[kb][i] - m); sc[kb][i] = p; den += p; }
        den += __shfl_xor(den, 32);
        const float inv = 1.f / den;
        if (h == 0) LSE[((size_t)g * T + rowb + (size_t)(n * 128 + 32 * qb + r) * dil + z) * 8 + hg] = m + __logf(den);
        f32x16 o[2];
        o[0] = (f32x16){0.f, 0.f, 0.f, 0.f, 0.f, 0.f, 0.f, 0.f, 0.f, 0.f, 0.f, 0.f, 0.f, 0.f, 0.f, 0.f}; o[1] = o[0];
        const int q4 = (lane & 15) >> 2, blk16 = (lane >> 4) & 1, p4 = lane & 3;
#pragma unroll
        for (int kb = 0; kb < 5; ++kb)
#pragma unroll
            for (int s = 0; s < 2; ++s) {
                u32x4 pw;
                pw.x = pk2(sc[kb][8 * s + 0] * inv, sc[kb][8 * s + 1] * inv); pw.y = pk2(sc[kb][8 * s + 2] * inv, sc[kb][8 * s + 3] * inv);
                pw.z = pk2(sc[kb][8 * s + 4] * inv, sc[kb][8 * s + 5] * inv); pw.w = pk2(sc[kb][8 * s + 6] * inv, sc[kb][8 * s + 7] * inv);
                const bf16x8_t pa = __builtin_bit_cast(bf16x8_t, pw);
                const int row_lo = 32 * (qb + kb) + 16 * s + 4 * h + q4, row_hi = row_lo + 8;
#pragma unroll
                for (int db = 0; db < 2; ++db) {
                    const int chunk = 4 * db + 2 * blk16 + (p4 >> 1), sub = (p4 & 1) * 8;
                    const s16x4_t lo = tr_read_(Vimg + row_lo * 128 + ((chunk ^ (row_lo & 7)) << 4) + sub);
                    const s16x4_t hi = tr_read_(Vimg + row_hi * 128 + ((chunk ^ (row_hi & 7)) << 4) + sub);
                    const bf16x8_t vf = (bf16x8_t){lo[0], lo[1], lo[2], lo[3], hi[0], hi[1], hi[2], hi[3]};
                    o[db] = __builtin_amdgcn_mfma_f32_32x32x16_bf16(pa, vf, o[db], 0, 0, 0);
                }
            }
#pragma unroll
        for (int i = 0; i < 16; ++i) {
            const size_t row = rowb + (size_t)(n * 128 + 32 * qb + crow_(i, h)) * dil + z;
            bf16* op = OUTG + ((size_t)g * T + row) * 512 + hg * 64 + r;
            op[0] = (bf16)f2bf(o[0][i]); op[32] = (bf16)f2bf(o[1][i]);
        }
    }
    __syncthreads();
}
__device__ __forceinline__ void p_attn_merge(Frame& F) {
    const bf16* OUTG = (const bf16*)(F.ws + WS_OUTG); const float* LSE = (const float*)(F.ws + WS_LSE); bf16* AT = (bf16*)(F.ws + WS_ATTN);
    for (int idx = F.blk * NTHREADS + F.tid; idx < T * 64; idx += F.nblk * NTHREADS) {
        const int row = idx >> 6, c8 = (idx & 63) * 8, hg = c8 >> 6;
        const float l0 = LSE[((size_t)0 * T + row) * 8 + hg], l1 = LSE[((size_t)1 * T + row) * 8 + hg], l2 = LSE[((size_t)2 * T + row) * 8 + hg];
        const float mx = fmaxf(l0, fmaxf(l1, l2)), e0 = __expf(l0 - mx), e1 = __expf(l1 - mx), e2 = __expf(l2 - mx), inv = 1.f / (e0 + e1 + e2);
        const float w[3] = {e0 * inv, e1 * inv, e2 * inv};
        float a[8] = {0.f, 0.f, 0.f, 0.f, 0.f, 0.f, 0.f, 0.f};
#pragma unroll
        for (int g = 0; g < 3; ++g) { const u32x4 v = *(const u32x4*)(OUTG + ((size_t)g * T + row) * 512 + c8);
            a[0] += w[g] * bflo(v.x); a[1] += w[g] * bfhi(v.x); a[2] += w[g] * bflo(v.y); a[3] += w[g] * bfhi(v.y);
            a[4] += w[g] * bflo(v.z); a[5] += w[g] * bfhi(v.z); a[6] += w[g] * bflo(v.w); a[7] += w[g] * bfhi(v.w); }
        u32x4 o; o.x = pk2(a[0], a[1]); o.y = pk2(a[2], a[3]); o.z = pk2(a[4], a[5]); o.w = pk2(a[6], a[7]);
        *(u32x4*)(AT + (size_t)row * 512 + c8) = o;
    }
}

__device__ __forceinline__ void p_conv(Frame& F) {
    const bf16* X = (const bf16*)(F.ws + WS_XBC); bf16* O = (bf16*)(F.ws + WS_CONV);
    const int total = T * (CONVD / 8);
    for (int idx = F.blk * NTHREADS + F.tid; idx < total; idx += F.nblk * NTHREADS) {
        const int row = idx / (CONVD / 8), c0 = (idx % (CONVD / 8)) * 8, t = row & (SEQ - 1);
        float a[8];
#pragma unroll
        for (int i = 0; i < 8; ++i) a[i] = F.conv_b[c0 + i];
#pragma unroll
        for (int w = 0; w < 4; ++w) {
            const int tt = t + w - 3; if (tt < 0) continue;
            const u32x4 u = *(const u32x4*)(X + (size_t)(row + w - 3) * CONVD + c0);
            const float* cw = F.conv_w + (size_t)w * CONVD + c0;
            a[0] += cw[0] * bflo(u.x); a[1] += cw[1] * bfhi(u.x); a[2] += cw[2] * bflo(u.y); a[3] += cw[3] * bfhi(u.y);
            a[4] += cw[4] * bflo(u.z); a[5] += cw[5] * bfhi(u.z); a[6] += cw[6] * bflo(u.w); a[7] += cw[7] * bfhi(u.w);
        }
        u32x4 o; o.x = pk2(siluf_(a[0]), siluf_(a[1])); o.y = pk2(siluf_(a[2]), siluf_(a[3])); o.z = pk2(siluf_(a[4]), siluf_(a[5])); o.w = pk2(siluf_(a[6]), siluf_(a[7]));
        *(u32x4*)(O + (size_t)row * CONVD + c0) = o;
    }
}

__device__ __forceinline__ void p_ssd_naive(Frame& F) {
    const bf16* CV = (const bf16*)(F.ws + WS_CONV); const float* DT = (const float*)(F.ws + WS_DT); const bf16* Z = (const bf16*)(F.ws + WS_Z);
    bf16* YZ = (bf16*)(F.ws + WS_YZ);
    const int t256 = F.tid & 255, p = t256 >> 2, q = t256 & 3;
    for (int unit = F.blk * 2 + (F.tid >> 8); unit < BATCH * NH_SSM; unit += F.nblk * 2) {
        const int b = unit / NH_SSM, h = unit % NH_SSM, g = h / 8;
        const float a = -__expf(F.a_log[h]), dsk = F.d_skip[h];
        float st[32];
#pragma unroll
        for (int i = 0; i < 32; ++i) st[i] = 0.f;
        for (int t = 0; t < SEQ; ++t) {
            const size_t row = (size_t)b * SEQ + t;
            const float dt = DT[row * 32 + h];
            const float dA = __expf(dt * a);
            const float xv = bf2f(CV[row * CONVD + h * 64 + p]);
            const float dtx = dt * xv;
            const u32x4* bp = (const u32x4*)(CV + row * CONVD + 2048 + g * 128 + q * 32);
            const u32x4* cp = (const u32x4*)(CV + row * CONVD + 2560 + g * 128 + q * 32);
            float yp = 0.f;
#pragma unroll
            for (int c = 0; c < 4; ++c) {
                const u32x4 bw = bp[c], cw = cp[c];
                const float bv[8] = {bflo(bw.x), bfhi(bw.x), bflo(bw.y), bfhi(bw.y), bflo(bw.z), bfhi(bw.z), bflo(bw.w), bfhi(bw.w)};
                const float cv[8] = {bflo(cw.x), bfhi(cw.x), bflo(cw.y), bfhi(cw.y), bflo(cw.z), bfhi(cw.z), bflo(cw.w), bfhi(cw.w)};
#pragma unroll
                for (int i = 0; i < 8; ++i) { st[8 * c + i] = st[8 * c + i] * dA + dtx * bv[i]; yp += cv[i] * st[8 * c + i]; }
            }
            yp += __shfl_xor(yp, 1); yp += __shfl_xor(yp, 2);
            if (q == 0) {
                const float y = yp + dsk * xv;
                const float z = bf2f(Z[row * DI + h * 64 + p]);
                YZ[row * DI + h * 64 + p] = (bf16)f2bf(y * siluf_(z));
            }
        }
    }
}

__device__ __forceinline__ void p_ypost(Frame& F) {
    const int gw = F.blk * NWAVES + F.wave, NGW = F.nblk * NWAVES;
    const bf16* YZ = (const bf16*)(F.ws + WS_YZ); bf16* YN = (bf16*)(F.ws + WS_YN);
    for (int m = gw; m < T; m += NGW) {
#pragma unroll
        for (int g = 0; g < 4; ++g) {
            const int c0 = g * 512 + F.lane * 8;
            const u32x4 w = *(const u32x4*)(YZ + (size_t)m * DI + c0);
            float v[8] = {bflo(w.x), bfhi(w.x), bflo(w.y), bfhi(w.y), bflo(w.z), bfhi(w.z), bflo(w.w), bfhi(w.w)};
            float s = 0.f;
#pragma unroll
            for (int i = 0; i < 8; ++i) s += v[i] * v[i];
            const float rstd = 1.f / sqrtf(wave_sum(s) * (1.f / 512.f) + EPS);
            const float* nw = F.ssm_norm_w + c0;
            u32x4 o; o.x = pk2(v[0] * rstd * nw[0], v[1] * rstd * nw[1]); o.y = pk2(v[2] * rstd * nw[2], v[3] * rstd * nw[3]);
            o.z = pk2(v[4] * rstd * nw[4], v[5] * rstd * nw[5]); o.w = pk2(v[6] * rstd * nw[6], v[7] * rstd * nw[7]);
            *(u32x4*)(YN + (size_t)m * DI + c0) = o;
        }
    }
}

__device__ __forceinline__ void p_router(Frame& F) {
    LAS int* hist = (LAS int*)F.lds;
    if (F.tid < 32) hist[F.tid] = 0;
    __syncthreads();
    int* ROWMAP = (int*)(F.ws + WS_ROWMAP);
    for (int i = F.blk * NTHREADS + F.tid; i < CAP; i += F.nblk * NTHREADS) ROWMAP[i] = -1;
    const int gw = F.blk * NWAVES + F.wave, NGW = F.nblk * NWAVES;
    bf16* XN2 = (bf16*)(F.ws + WS_XN2); int* TOPI = (int*)(F.ws + WS_TOPI); float* TOPW = (float*)(F.ws + WS_TOPW);
    for (int m = gw; m < T; m += NGW) {
        const f32x4* xr = (const f32x4*)(F.out + (size_t)m * D) + F.lane;
        const f32x4* wr = (const f32x4*)F.norm_ffn + F.lane;
        f32x4 v[4]; float s = 0.f;
#pragma unroll
        for (int j = 0; j < 4; ++j) { v[j] = xr[64 * j]; s += (v[j].x * v[j].x + v[j].y * v[j].y) + (v[j].z * v[j].z + v[j].w * v[j].w); }
        const float rstd = 1.f / sqrtf(wave_sum(s) * (1.f / D) + EPS);
        float lg[32];
#pragma unroll
        for (int e = 0; e < 32; ++e) lg[e] = 0.f;
#pragma unroll
        for (int j = 0; j < 4; ++j) {
            v[j] = v[j] * rstd * wr[64 * j];
            st_bf4(XN2 + (size_t)m * D + (F.lane + 64 * j) * 4, v[j]);
            const float hv[4] = {v[j].x, v[j].y, v[j].z, v[j].w};
#pragma unroll
            for (int i = 0; i < 4; ++i) {
                const f32x4* rw = (const f32x4*)(F.router_w + (size_t)((F.lane + 64 * j) * 4 + i) * 32);
#pragma unroll
                for (int c = 0; c < 8; ++c) { const f32x4 w = rw[c]; lg[4 * c] += hv[i] * w.x; lg[4 * c + 1] += hv[i] * w.y; lg[4 * c + 2] += hv[i] * w.z; lg[4 * c + 3] += hv[i] * w.w; }
            }
        }
#pragma unroll
        for (int e = 0; e < 32; ++e) lg[e] = wave_sum(lg[e]) + F.router_b[e];
        int bi[4]; float bv[4];
#pragma unroll
        for (int k = 0; k < 4; ++k) {
            float best = -INFINITY; int be = 0;
#pragma unroll
            for (int e = 0; e < 32; ++e) if (lg[e] > best) { best = lg[e]; be = e; }
            bi[k] = be; bv[k] = best;
#pragma unroll
            for (int e = 0; e < 32; ++e) if (e == be) lg[e] = -INFINITY;
        }
        const float e0 = 1.f, e1 = __expf(bv[1] - bv[0]), e2 = __expf(bv[2] - bv[0]), e3 = __expf(bv[3] - bv[0]);
        const float inv = 1.f / (e0 + e1 + e2 + e3);
        if (F.lane == 0) {
            *(int4*)(TOPI + (size_t)m * 4) = make_int4(bi[0], bi[1], bi[2], bi[3]);
            *(f32x4*)(TOPW + (size_t)m * 4) = (f32x4){e0 * inv, e1 * inv, e2 * inv, e3 * inv};
            atomicAdd((int*)&hist[bi[0]], 1); atomicAdd((int*)&hist[bi[1]], 1); atomicAdd((int*)&hist[bi[2]], 1); atomicAdd((int*)&hist[bi[3]], 1);
        }
    }
    __syncthreads();
    if (F.tid < 32) atomicAdd((unsigned*)(F.ctl + CW_CNT + 64 * F.tid), (unsigned)hist[F.tid]);
    __syncthreads();
}

__device__ __forceinline__ void p_slots(Frame& F) {
    LAS int* hist = (LAS int*)F.lds;
    LAS int* base = hist + 32;
    LAS int* pst = hist + 64;
    if (F.tid == 0) {
        int acc = 0;
        for (int e = 0; e < 32; ++e) { const int c = (int)__hip_atomic_load((unsigned*)(F.ctl + CW_CNT + 64 * e), __ATOMIC_RELAXED, __HIP_MEMORY_SCOPE_AGENT); pst[e] = acc; acc += (c + MOE_PAD - 1) / MOE_PAD * MOE_PAD; }
        pst[32] = acc;
    }
    __syncthreads();
    if (F.blk == 0) {
        int* TEXP = (int*)(F.ws + WS_SMALL);
        for (int i = F.tid; i < NT256; i += NTHREADS) { const int r = i * 256; int e = -1;
            for (int k = 0; k < 32; ++k) if (r >= pst[k] && r < pst[k + 1]) e = k;
            TEXP[i] = e; }
        if (F.tid == 0) TEXP[1024] = pst[32] / 256;
    }
    const int* TOPI = (const int*)(F.ws + WS_TOPI); int* SLOT = (int*)(F.ws + WS_SLOT); int* ROWMAP = (int*)(F.ws + WS_ROWMAP);
    for (int c = F.blk; c < T / 128; c += F.nblk) {
        if (F.tid < 32) hist[F.tid] = 0;
        __syncthreads();
        const int ai = c * 512 + F.tid;
        const int e = TOPI[ai];
        const int lr = atomicAdd((int*)&hist[e], 1);
        __syncthreads();
        if (F.tid < 32) base[F.tid] = (int)atomicAdd((unsigned*)(F.ctl + CW_CUR + 64 * F.tid), (unsigned)hist[F.tid]);
        __syncthreads();
        const int slot = pst[e] + base[e] + lr;
        SLOT[ai] = slot; ROWMAP[slot] = ai >> 2;
        __syncthreads();
    }
}

__device__ __forceinline__ void p_final(Frame& F) {
    const int gw = F.blk * NWAVES + F.wave, NGW = F.nblk * NWAVES;
    const int* SLOT = (const int*)(F.ws + WS_SLOT); const float* TOPW = (const float*)(F.ws + WS_TOPW); const bf16* YB = (const bf16*)(F.ws + WS_YB);
    for (int m = gw; m < T; m += NGW) {
        f32x4* xr = (f32x4*)(F.out + (size_t)m * D) + F.lane;
        const f32x4* wr = (const f32x4*)F.norm_final + F.lane;
        f32x4 v[4];
#pragma unroll
        for (int j = 0; j < 4; ++j) v[j] = xr[64 * j];
#pragma unroll
        for (int k = 0; k < 4; ++k) {
            const int sl = SLOT[m * 4 + k]; const float w = TOPW[m * 4 + k];
#pragma unroll
            for (int j = 0; j < 4; ++j) { const u32x2 y = *(const u32x2*)(YB + (size_t)sl * 1024 + (F.lane + 64 * j) * 4);
                v[j].x += w * bflo(y.x); v[j].y += w * bfhi(y.x); v[j].z += w * bflo(y.y); v[j].w += w * bfhi(y.y); }
        }
        float s = 0.f;
#pragma unroll
        for (int j = 0; j < 4; ++j) s += (v[j].x * v[j].x + v[j].y * v[j].y) + (v[j].z * v[j].z + v[j].w * v[j].w);
        const float rstd = 1.f / sqrtf(wave_sum(s) * (1.f / D) + EPS);
#pragma unroll
        for (int j = 0; j < 4; ++j) xr[64 * j] = v[j] * rstd * wr[64 * j];
    }
}

__global__ void __launch_bounds__(NTHREADS, 2) fwd(Args args) {
    extern __shared__ __attribute__((aligned(16))) unsigned char lds_raw[];
    Frame F;
    F.lds = (LAS unsigned char*)lds_raw;
    F.tid = threadIdx.x; F.lane = F.tid & 63; F.wave = __builtin_amdgcn_readfirstlane(F.tid >> 6);
    F.blk = blockIdx.x; F.nblk = gridDim.x;
    F.x = args.in[0]; F.w_in = args.in[1]; F.rel_bias = args.in[2]; F.w_ba = args.in[3]; F.conv_w = args.in[4]; F.conv_b = args.in[5];
    F.dt_bias = args.in[6]; F.a_log = args.in[7]; F.d_skip = args.in[8]; F.ssm_norm_w = args.in[9]; F.w_bs = args.in[10]; F.gate_bias = args.in[11];
    F.w_out = args.in[12]; F.norm_mix = args.in[13]; F.norm_ffn = args.in[14]; F.router_w = args.in[15]; F.router_b = args.in[16];
    F.w1 = args.in[17]; F.b1 = args.in[18]; F.w2 = args.in[19]; F.b2 = args.in[20]; F.norm_final = args.in[21];
    F.out = args.out; F.ws = args.ws; F.ctl = (gu32*)(args.ws + WS_CTL);
    volatile LAS unsigned* MISC = (volatile LAS unsigned*)(F.lds + MISC_OFF);
    if (F.tid < 32) MISC[F.tid] = 0u;
    __syncthreads();
    XcdBarrier bar; bar.bar = (unsigned*)(F.ctl + CW_BAR); bar.x = 0; bar.st = nullptr;
#if MK_FUSED
    bar = xcd_barrier_post((unsigned*)(F.ctl + CW_BAR), MISC + 8);
#define GRID_BAR() xcd_barrier(bar)
#else
#define GRID_BAR() do { } while (0)
#endif
    const int lo = args.ph_lo, hi = args.ph_hi;
#define IN(k) (lo <= (k) && (k) < hi)
#define SEAM(k) do { if (IN(k) && IN((k) + 1)) GRID_BAR(); } while (0)
    unsigned char* ws = F.ws;

    if (IN(0)) { p_rmsnorm_in(F); p_convert_small(F); } SEAM(0);
    if (IN(1)) {
#if FG_INPROJ
        pg8::Gemm g{(const bf16*)(ws + WS_XN), (const bf16*)(ws + WS_WIN_T), T, NPROJ_PAD, D}; pg8::StaticOrder S; S.init(T, NPROJ_PAD, F.nblk, F.blk);
        pg8::EpiInProjF E{ws, F.dt_bias, F.gate_bias};
        pg8::gemm_phase<pg8::EpiInProjF, pg8::StaticOrder, true, false, false>(F.lds, g, S, E, nullptr, nullptr, 0);
#else
        EpiInProj E{ws, F.dt_bias, F.gate_bias}; gemm_naive(F, T / 128, NPROJ, D, (const bf16*)(ws + WS_XN), D, nullptr, F.w_in, NPROJ, nullptr, 0, E);
#endif
    } SEAM(1);
#if FA_ATTN
    if (IN(2)) { p_attn_fast(F); } SEAM(2);
    if (IN(3)) { p_attn_merge(F); p_conv(F); } SEAM(3);
#else
    if (IN(2)) { p_attn_naive(F); } SEAM(2);
    if (IN(3)) { p_conv(F); } SEAM(3);
#endif
    if (IN(4)) { p_ssd_naive(F); } SEAM(4);
    if (IN(5)) { p_ypost(F); p_convert_moe(F); } SEAM(5);
    if (IN(6)) {
#if FG_MIX
        pg8::Gemm g{(const bf16*)(ws + WS_ATTN), (const bf16*)(ws + WS_WBA_T), T, D, 512}; pg8::StaticOrder S; S.init(T, D, F.nblk, F.blk);
        pg8::EpiM0F E{ws};
        pg8::gemm_phase<pg8::EpiM0F, pg8::StaticOrder, true, false, false>(F.lds, g, S, E, nullptr, nullptr, 0);
#else
        EpiM0 E{ws}; gemm_naive(F, T / 128, D, 512, (const bf16*)(ws + WS_ATTN), 512, nullptr, F.w_ba, D, nullptr, 0, E);
#endif
    } SEAM(6);
    if (IN(7)) {
#if FG_MIX
        pg8::Gemm g{(const bf16*)(ws + WS_YN), (const bf16*)(ws + WS_WBS_T), T, D, DI}; pg8::StaticOrder S; S.init(T, D, F.nblk, F.blk);
        pg8::EpiMergedF E{ws};
        pg8::gemm_phase<pg8::EpiMergedF, pg8::StaticOrder, true, false, false>(F.lds, g, S, E, nullptr, nullptr, 0);
#else
        EpiMerged E{ws}; gemm_naive(F, T / 128, D, DI, (const bf16*)(ws + WS_YN), DI, nullptr, F.w_bs, D, nullptr, 0, E);
#endif
    } SEAM(7);
    if (IN(8)) {
#if FG_MIX
        pg8::Gemm g{(const bf16*)(ws + WS_MERGED), (const bf16*)(ws + WS_WOUT_T), T, D, D}; pg8::StaticOrder S; S.init(T, D, F.nblk, F.blk);
        pg8::EpiX1F E{F.x, F.out};
        pg8::gemm_phase<pg8::EpiX1F, pg8::StaticOrder, true, false, false>(F.lds, g, S, E, nullptr, nullptr, 0);
#else
        EpiX1 E{F.x, F.out}; gemm_naive(F, T / 128, D, D, (const bf16*)(ws + WS_MERGED), D, nullptr, F.w_out, D, nullptr, 0, E);
#endif
    } SEAM(8);
    if (IN(9)) { p_router(F); } SEAM(9);
    if (IN(10)) { p_slots(F); } SEAM(10);
    if (IN(11)) {
#if FG_MOE
        const int* texp = (const int*)(ws + WS_SMALL); const int ntile = texp[1024];
        pg8::Gemm g{(const bf16*)(ws + WS_XN2), (const bf16*)(ws + WS_W1T), CAP, 2048, D}; pg8::MoeOrder S; S.init(ntile, 8, F.nblk, F.blk);
        pg8::EpiMoe1F E{ws, F.b1, texp};
        pg8::gemm_phase<pg8::EpiMoe1F, pg8::MoeOrder, true, true, true>(F.lds, g, S, E, (const int*)(ws + WS_ROWMAP), texp, (size_t)2048 * 1024 * 2);
#else
        EpiMoe1 E{ws, F.b1}; gemm_naive(F, CAP / 128, 2048, D, (const bf16*)(ws + WS_XN2), D, (const int*)(ws + WS_ROWMAP), F.w1, 2048, (const int*)(ws + WS_SMALL), (size_t)1024 * 2048, E);
#endif
    } SEAM(11);
    if (IN(12)) {
#if FG_MOE
        const int* texp = (const int*)(ws + WS_SMALL); const int ntile = texp[1024];
        pg8::Gemm g{(const bf16*)(ws + WS_ACT), (const bf16*)(ws + WS_W2T), CAP, 1024, 1024}; pg8::MoeOrder S; S.init(ntile, 4, F.nblk, F.blk);
        pg8::EpiMoe2F E{ws, F.b2, texp};
        pg8::gemm_phase<pg8::EpiMoe2F, pg8::MoeOrder, true, false, true>(F.lds, g, S, E, nullptr, texp, (size_t)1024 * 1024 * 2);
#else
        EpiMoe2 E{ws, F.b2}; gemm_naive(F, CAP / 128, 1024, 1024, (const bf16*)(ws + WS_ACT), 1024, nullptr, F.w2, 1024, (const int*)(ws + WS_SMALL), (size_t)1024 * 1024, E);
#endif
    } SEAM(12);
    if (IN(13)) { p_final(F); }
#undef IN
#undef SEAM
}

extern "C" void kernel_launch(void* const* d_in, const int* in_sizes, int n_in, void* d_out, int out_size, void* d_ws, size_t ws_size, hipStream_t stream) {
    static int grid = 0;
    if (grid == 0) {
        if (n_in != 22 || out_size != T * D || ws_size < WS_END) { fprintf(stderr, "kernel_launch: unexpected shapes: n_in %d out %d ws %zu\n", n_in, out_size, ws_size); grid = -1; return; }
        int dev = 0, cus = 0, per_cu = 0;
        if (hipGetDevice(&dev) != hipSuccess || hipDeviceGetAttribute(&cus, hipDeviceAttributeMultiprocessorCount, dev) != hipSuccess) { grid = -1; return; }
        if (hipFuncSetAttribute((const void*)fwd, hipFuncAttributeMaxDynamicSharedMemorySize, LDS_BYTES) != hipSuccess) { fprintf(stderr, "kernel_launch: hipFuncSetAttribute failed\n"); grid = -1; return; }
        if (hipOccupancyMaxActiveBlocksPerMultiprocessor(&per_cu, (const void*)fwd, NTHREADS, LDS_BYTES) != hipSuccess || per_cu < 1) fprintf(stderr, "kernel_launch: occupancy query says %d\n", per_cu);
        (void)hipGetLastError();
        grid = cus;
    }
    if (grid < 0) return;
    (void)hipMemsetAsync((char*)d_ws + WS_CTL, 0, CTL_ZERO_BYTES, stream);
    Args a{};
    for (int i = 0; i < 22; ++i) a.in[i] = (const float*)d_in[i];
    a.out = (float*)d_out; a.ws = (unsigned char*)d_ws;
#if MK_FUSED
    a.ph_lo = 0; a.ph_hi = NPHASE; a.li = 0;
    hipLaunchKernelGGL(fwd, dim3(grid), dim3(NTHREADS), LDS_BYTES, stream, a);
#else
    for (int p = 0; p < NPHASE; ++p) { a.ph_lo = p; a.ph_hi = p + 1; a.li = p; hipLaunchKernelGGL(fwd, dim3(grid), dim3(NTHREADS), LDS_BYTES, stream, a); }
#endif
}
```

```cpp
#include <hip/hip_runtime.h>
#include <cstdio>
#include <cstdint>

#ifndef MK_FUSED
#define MK_FUSED 1
#endif

#ifndef FG_INPROJ
#define FG_INPROJ 1
#endif
#ifndef FA_ATTN
#define FA_ATTN 1
#endif
#ifndef FS_SSD
#define FS_SSD 1
#endif
#ifndef FG_MIX
#define FG_MIX 1
#endif
#ifndef FG_MOE
#define FG_MOE 1
#endif
#define GAS __attribute__((address_space(1)))
#define LAS __attribute__((address_space(3)))
typedef unsigned short bf16;
typedef float f32x4 __attribute__((ext_vector_type(4)));
typedef unsigned u32x4 __attribute__((ext_vector_type(4)));
typedef unsigned u32x2 __attribute__((ext_vector_type(2)));
typedef GAS unsigned gu32;

constexpr int BATCH = 16, SEQ = 2048, D = 1024, T = BATCH * SEQ;
constexpr int NPROJ = 11808;
constexpr int AW = 1536;
constexpr int DI = 2048;
constexpr int CONVD = 3072;
constexpr int NH_SSM = 32, NG_SSM = 4, DSTATE = 128;
constexpr int NEXP = 32, TOPK = 4, NASSIGN = T * TOPK;
constexpr int MOE_PAD = 256;
constexpr int CAP = NASSIGN + NEXP * MOE_PAD;
constexpr int NT256 = CAP / 256;
constexpr float EPS = 1e-5f;
constexpr int C_Q = 0, C_K = 1536, C_V = 3072, C_Z = 4608, C_XBC = 6656, C_DT = 9728, C_GATE = 9760;

constexpr size_t MiB = 1u << 20;
constexpr size_t WS_CTL = 0, CTL_ZERO_BYTES = 1 * MiB;
constexpr size_t WS_SMALL = 1 * MiB;
constexpr size_t WS_XN = 34 * MiB;
constexpr size_t WS_Q = 98 * MiB, WS_K = 194 * MiB, WS_V = 290 * MiB;
constexpr size_t WS_Z = 386 * MiB;
constexpr size_t WS_XBC = 514 * MiB;
constexpr size_t WS_GATE = 706 * MiB;
constexpr size_t WS_DT = 834 * MiB;
constexpr size_t WS_ATTN = 838 * MiB;
constexpr size_t WS_M0 = 870 * MiB;
constexpr size_t WS_CONV = WS_K;
constexpr size_t WS_YZ = WS_XBC;
constexpr size_t WS_YN = WS_Z;
constexpr size_t WS_MERGED = WS_XN;
constexpr size_t WS_XN2 = WS_Q;
constexpr size_t WS_TOPI = 162 * MiB;
constexpr size_t WS_TOPW = 163 * MiB;
constexpr size_t WS_SLOT = 164 * MiB;
constexpr size_t WS_ROWMAP = 165 * MiB;
constexpr size_t WS_ACT = 386 * MiB;
constexpr size_t WS_YB = 658 * MiB;
constexpr size_t WS_WIN_T = 2 * MiB;
constexpr size_t WS_WBA_T = 26 * MiB;
constexpr size_t WS_WBS_T = 27 * MiB;
constexpr size_t WS_WOUT_T = 31 * MiB;
constexpr size_t WS_W1T = 194 * MiB;
constexpr size_t WS_W2T = 322 * MiB;
constexpr int NPROJ_PAD = 12032;
constexpr size_t WS_OUTG = 870 * MiB;
constexpr size_t WS_LSE = 966 * MiB;
constexpr size_t WS_END = 1024 * MiB;
constexpr int CW_TMO = 0;
constexpr int CW_BAR = 4096;
constexpr int CW_CNT = 16384;
constexpr int CW_CUR = 16384 + 64 * 32;

constexpr int NWAVES = 8, NTHREADS = 512;
constexpr int LDS_BYTES = 147456;
constexpr int MISC_OFF = LDS_BYTES - 256;

constexpr int NPHASE = 14;

__device__ __forceinline__ unsigned f2bf(float f) { unsigned u = __builtin_bit_cast(unsigned, f); return (u + 0x7fffu + ((u >> 16) & 1u)) >> 16; }
__device__ __forceinline__ unsigned pk2(float lo, float hi) { return f2bf(lo) | (f2bf(hi) << 16); }
__device__ __forceinline__ float bflo(unsigned u) { return __builtin_bit_cast(float, u << 16); }
__device__ __forceinline__ float bfhi(unsigned u) { return __builtin_bit_cast(float, u & 0xffff0000u); }
__device__ __forceinline__ float bf2f(bf16 b) { return __builtin_bit_cast(float, (unsigned)b << 16); }
__device__ __forceinline__ float wave_sum(float v) {
#pragma unroll
    for (int o = 1; o < 64; o <<= 1) v += __shfl_xor(v, o);
    return v;
}
__device__ __forceinline__ float sigmoidf_(float x) { return 1.f / (1.f + __expf(-x)); }
__device__ __forceinline__ float siluf_(float x) { return x / (1.f + __expf(-x)); }
__device__ __forceinline__ float softplusf_(float x) { return fmaxf(x, 0.f) + log1pf(__expf(-fabsf(x))); }

#define XB_TMO      128
#define XB_XCNT(j)  (256  + 64 * (j))
#define XB_XSUB(j)  (1280 + 64 * (j))
#define XB_XGEN(j)  (2304 + 64 * (j))
#define XB_TOP      3328
#define XB_TOPGEN   3392
#define XCD_BAR_WORDS 3456
#define XB_SPIN_CAP (1u << 18)
__device__ __forceinline__ unsigned xb_ld(unsigned* p)              { return __hip_atomic_load(p, __ATOMIC_RELAXED, __HIP_MEMORY_SCOPE_AGENT); }
__device__ __forceinline__ unsigned xb_add(unsigned* p, unsigned v) { return __hip_atomic_fetch_add(p, v, __ATOMIC_RELAXED, __HIP_MEMORY_SCOPE_AGENT); }
__device__ __forceinline__ unsigned xb_xcc_id() { return (unsigned)__builtin_amdgcn_s_getreg((3 << 11) | 20) & 0xFu; }
#define XB_SPIN(cond, bar) do { unsigned _sp = 0; while (cond) { __builtin_amdgcn_s_sleep(1); \
    if ((++_sp & 255u) == 0u) { if (xb_ld(&(bar)[XB_TMO])) break; if (_sp > XB_SPIN_CAP) { atomicAdd(&(bar)[XB_TMO], 1u); break; } } } } while (0)
struct XcdBarrier { unsigned* bar; unsigned x; volatile LAS unsigned* st; };
__device__ __forceinline__ XcdBarrier xcd_barrier_post(unsigned* bar, volatile LAS unsigned* st) {
    XcdBarrier b; b.bar = bar; b.x = xb_xcc_id(); b.st = st;
    if (threadIdx.x == 0) (void)xb_add(&bar[XB_XCNT(b.x)], 1u);
    return b;
}
__device__ __forceinline__ void xcd_barrier_complete(unsigned* bar, unsigned x, unsigned& nloc, unsigned& nx) {
    const unsigned G = gridDim.x * gridDim.y * gridDim.z;
    unsigned sum, cnt, mine, sp = 0u;
    for (;;) {
        sum = 0u; cnt = 0u; mine = 0u;
#pragma unroll
        for (unsigned j = 0; j < 16; ++j) { const unsigned c = xb_ld(&bar[XB_XCNT(j)]); sum += c; cnt += (c > 0u) ? 1u : 0u; mine = (j == x) ? c : mine; }
        if (sum == G) break;
        __builtin_amdgcn_s_sleep(1);
        if ((++sp & 255u) == 0u) { if (xb_ld(&bar[XB_TMO])) break; if (sp > XB_SPIN_CAP) { atomicAdd(&bar[XB_TMO], 1u); break; } }
    }
    nloc = mine > 0u ? mine : 1u; nx = cnt > 0u ? cnt : 1u;
}
__device__ __forceinline__ void xcd_barrier(const XcdBarrier& b) {
    asm volatile("s_waitcnt vmcnt(0)" ::: "memory");
    __syncthreads();
    if (threadIdx.x == 0) {
        unsigned* bar = b.bar;
        __builtin_amdgcn_s_waitcnt(0);
        unsigned nloc = b.st[0], nx = b.st[1];
        if (nloc == 0u) { xcd_barrier_complete(bar, b.x, nloc, nx); b.st[0] = nloc; b.st[1] = nx; }
        const unsigned old = xb_add(&bar[XB_XSUB(b.x)], 1u);
        const unsigned gen = old / nloc;
        if (old + 1u == (gen + 1u) * nloc) {
            __builtin_amdgcn_fence(__ATOMIC_RELEASE, "agent");
            asm volatile("s_waitcnt vmcnt(0)" ::: "memory");
            const unsigned og = xb_add(&bar[XB_TOP], 1u);
            const unsigned tg = og / nx;
            if (og + 1u == (tg + 1u) * nx) xb_add(&bar[XB_TOPGEN], 1u);
            else XB_SPIN(xb_ld(&bar[XB_TOPGEN]) == tg, bar);
            __builtin_amdgcn_fence(__ATOMIC_ACQUIRE, "agent");
            xb_add(&bar[XB_XGEN(b.x)], 1u);
            asm volatile("s_waitcnt vmcnt(0)" ::: "memory");
        } else {
            XB_SPIN(xb_ld(&bar[XB_XGEN(b.x)]) == gen, bar);
            __builtin_amdgcn_fence(__ATOMIC_ACQUIRE, "agent");
            asm volatile("s_waitcnt vmcnt(0)" ::: "memory");
        }
    }
    __syncthreads();
}

struct Args { const float* in[22]; float* out; unsigned char* ws; int ph_lo, ph_hi, li, pad; };

struct Frame {
    LAS unsigned char* lds;
    int tid, lane, wave, blk, nblk;
    const float *x, *w_in, *rel_bias, *w_ba, *conv_w, *conv_b, *dt_bias, *a_log, *d_skip, *ssm_norm_w, *w_bs, *gate_bias, *w_out,
                *norm_mix, *norm_ffn, *router_w, *router_b, *w1, *b1, *w2, *b2, *norm_final;
    float* out; unsigned char* ws; gu32* ctl;
};

template <class Epi>
__device__ __forceinline__ void gemm_naive(Frame& F, int nMt, int N, int K, const bf16* A, int lda, const int* rowmap,
                                           const float* B, int ldb, const int* texp, size_t estride, const Epi& epi) {
    LAS float* As = (LAS float*)F.lds;
    LAS float* Bs = As + 16 * 132;
    const int tid = F.tid, tx = tid & 31, ty = tid >> 5;
    const int nNt = (N + 127) / 128;
    const int ar = tid >> 2, ak = (tid & 3) * 4;
    const int bk = tid >> 5, bn = (tid & 31) * 4;
    for (int tile = F.blk; tile < nMt * nNt; tile += F.nblk) {
        const int mt = tile / nNt, nt = tile % nNt;
        int e = 0;
        if (texp) { e = texp[mt >> 1]; if (e < 0) continue; }
        const float* Bp = B + (size_t)e * estride;
        float acc[8][4];
#pragma unroll
        for (int i = 0; i < 8; ++i)
#pragma unroll
            for (int j = 0; j < 4; ++j) acc[i][j] = 0.f;
        int grow = mt * 128 + ar; if (rowmap) grow = rowmap[grow];
        const bf16* ap = A + (size_t)(grow < 0 ? 0 : grow) * lda + ak;
        const bool aok = grow >= 0;
        const int gcol = nt * 128 + bn;
        const bool bok = gcol < N;
        for (int k0 = 0; k0 < K; k0 += 16) {
            u32x2 av = (u32x2){0u, 0u};
            if (aok) av = *(const u32x2*)(ap + k0);
            f32x4 bv = (f32x4){0.f, 0.f, 0.f, 0.f};
            if (bok) bv = *(const f32x4*)(Bp + (size_t)(k0 + bk) * ldb + gcol);
            __syncthreads();
            As[(ak + 0) * 132 + ar] = bflo(av.x); As[(ak + 1) * 132 + ar] = bfhi(av.x);
            As[(ak + 2) * 132 + ar] = bflo(av.y); As[(ak + 3) * 132 + ar] = bfhi(av.y);
            *(LAS f32x4*)&Bs[bk * 132 + bn] = bv;
            __syncthreads();
#pragma unroll
            for (int k = 0; k < 16; ++k) {
                const f32x4 a0 = *(const LAS f32x4*)&As[k * 132 + ty * 8], a1 = *(const LAS f32x4*)&As[k * 132 + ty * 8 + 4];
                const f32x4 b = *(const LAS f32x4*)&Bs[k * 132 + tx * 4];
                const float a[8] = {a0.x, a0.y, a0.z, a0.w, a1.x, a1.y, a1.z, a1.w};
                const float bb[4] = {b.x, b.y, b.z, b.w};
#pragma unroll
                for (int i = 0; i < 8; ++i)
#pragma unroll
                    for (int j = 0; j < 4; ++j) acc[i][j] = fmaf(a[i], bb[j], acc[i][j]);
            }
        }
        const int col0 = nt * 128 + tx * 4;
        if (col0 < N) {
#pragma unroll
            for (int i = 0; i < 8; ++i) epi(mt * 128 + ty * 8 + i, col0, (f32x4){acc[i][0], acc[i][1], acc[i][2], acc[i][3]}, e);
        }
    }
    __syncthreads();
}

__device__ __forceinline__ void st_bf4(bf16* p, f32x4 v) { u32x2 w; w.x = pk2(v.x, v.y); w.y = pk2(v.z, v.w); *(u32x2*)p = w; }

struct EpiInProj {
    unsigned char* ws; const float* dt_bias; const float* gate_bias;
    __device__ __forceinline__ void operator()(int row, int col, f32x4 v, int) const {
        if (col < C_K)        st_bf4((bf16*)(ws + WS_Q) + (size_t)row * AW + (col - C_Q), v);
        else if (col < C_V)   st_bf4((bf16*)(ws + WS_K) + (size_t)row * AW + (col - C_K), v);
        else if (col < C_Z)   st_bf4((bf16*)(ws + WS_V) + (size_t)row * AW + (col - C_V), v);
        else if (col < C_XBC) st_bf4((bf16*)(ws + WS_Z) + (size_t)row * DI + (col - C_Z), v);
        else if (col < C_DT)  st_bf4((bf16*)(ws + WS_XBC) + (size_t)row * CONVD + (col - C_XBC), v);
        else if (col < C_GATE) { const int c = col - C_DT; f32x4 o;
            o.x = softplusf_(v.x + dt_bias[c]); o.y = softplusf_(v.y + dt_bias[c + 1]); o.z = softplusf_(v.z + dt_bias[c + 2]); o.w = softplusf_(v.w + dt_bias[c + 3]);
            *(f32x4*)((float*)(ws + WS_DT) + (size_t)row * 32 + c) = o; }
        else { const int c = col - C_GATE; f32x4 o;
            o.x = sigmoidf_(v.x + gate_bias[c]); o.y = sigmoidf_(v.y + gate_bias[c + 1]); o.z = sigmoidf_(v.z + gate_bias[c + 2]); o.w = sigmoidf_(v.w + gate_bias[c + 3]);
            st_bf4((bf16*)(ws + WS_GATE) + (size_t)row * 2048 + c, o); }
    }
};
struct EpiM0 {
    unsigned char* ws;
    __device__ __forceinline__ void operator()(int row, int col, f32x4 v, int) const {
        const u32x2 g = *(const u32x2*)((const bf16*)(ws + WS_GATE) + (size_t)row * 2048 + col);
        f32x4 o; o.x = v.x * bflo(g.x); o.y = v.y * bfhi(g.x); o.z = v.z * bflo(g.y); o.w = v.w * bfhi(g.y);
        *(f32x4*)((float*)(ws + WS_M0) + (size_t)row * D + col) = o;
    }
};
struct EpiMerged {
    unsigned char* ws;
    __device__ __forceinline__ void operator()(int row, int col, f32x4 v, int) const {
        const u32x2 g = *(const u32x2*)((const bf16*)(ws + WS_GATE) + (size_t)row * 2048 + 1024 + col);
        const f32x4 m = *(const f32x4*)((const float*)(ws + WS_M0) + (size_t)row * D + col);
        f32x4 o; o.x = m.x + v.x * bflo(g.x); o.y = m.y + v.y * bfhi(g.x); o.z = m.z + v.z * bflo(g.y); o.w = m.w + v.w * bfhi(g.y);
        st_bf4((bf16*)(ws + WS_MERGED) + (size_t)row * D + col, o);
    }
};
struct EpiX1 {
    const float* x; float* out;
    __device__ __forceinline__ void operator()(int row, int col, f32x4 v, int) const {
        const f32x4 xv = *(const f32x4*)(x + (size_t)row * D + col);
        *(f32x4*)(out + (size_t)row * D + col) = xv + v;
    }
};
__device__ __forceinline__ float swiglu_(float g, float l) {
    g = fminf(g, 7.f); l = fminf(fmaxf(l, -7.f), 7.f);
    return g * sigmoidf_(1.702f * g) * (l + 1.f);
}
struct EpiMoe1 {
    unsigned char* ws; const float* b1;
    __device__ __forceinline__ void operator()(int row, int col, f32x4 v, int e) const {
        const f32x4 b = *(const f32x4*)(b1 + (size_t)e * 2048 + col);
        const float o0 = swiglu_(v.x + b.x, v.y + b.y), o1 = swiglu_(v.z + b.z, v.w + b.w);
        *(unsigned*)((bf16*)(ws + WS_ACT) + (size_t)row * 1024 + (col >> 1)) = pk2(o0, o1);
    }
};
struct EpiMoe2 {
    unsigned char* ws; const float* b2;
    __device__ __forceinline__ void operator()(int row, int col, f32x4 v, int e) const {
        const f32x4 b = *(const f32x4*)(b2 + (size_t)e * 1024 + col);
        st_bf4((bf16*)(ws + WS_YB) + (size_t)row * 1024 + col, v + b);
    }
};

namespace pg8 {
typedef short bf16x8 __attribute__((ext_vector_type(8)));
constexpr int BM = 256, BK = 64, HALF = 128, HTB = HALF * BK * 2, STAGE_BYTES = 8 * HTB, NXCD = 8, WGM = 8;
__host__ __device__ __forceinline__ int lds_byte(int r, int c) { const int st = (r >> 4) * 2 + (c >> 5), rr = r & 15, cc = c & 31, ob = rr * 64 + cc * 2; return st * 1024 + (ob ^ (((ob >> 9) & 1) << 5)); }
__host__ __device__ __forceinline__ void stage_rc(int b, int& R, int& C) { const int st = b / 1024, sb = b % 1024, swz = sb ^ (((sb >> 9) & 1) << 5); R = (st >> 1) * 16 + swz / 64; C = (st & 1) * 32 + (swz % 64) / 2; }
__host__ __device__ __forceinline__ int perm32(int rho) { const int n = rho >> 4, i = rho & 15; return 8 * (i >> 2) + 4 * n + (i & 3); }
struct Unit { int pm, pn; };
struct Gemm { const bf16* A; const bf16* Bt; int M, N, K; };
struct StaticOrder {
    int nM, nN, nwg, G, c;
    __host__ __device__ void init(int M, int N, int G_, int c_) { nM = M / BM; nN = N / BM; nwg = nM * nN; G = G_; c = c_; }
    __host__ __device__ bool next(int i, Unit& u) const {
        const long L = (long)i * G + c; if (L >= nwg) return false;
        int wgid = (int)L; { const int q = nwg / NXCD, r = nwg % NXCD, xcd = wgid % NXCD, off = wgid / NXCD; wgid = (xcd < r ? xcd * (q + 1) : r * (q + 1) + (xcd - r) * q) + off; }
        const int nig = WGM * nN, gid = wgid / nig, fm = gid * WGM, gsz = (nM - fm) < WGM ? (nM - fm) : WGM;
        u.pm = fm + ((wgid % nig) % gsz); u.pn = (wgid % nig) / gsz; return true;
    }
    __device__ __forceinline__ void a_ready(const Unit&) const {}
    __device__ __forceinline__ void done(const Unit&) const {}
};
struct MoeOrder {
    int nwg, nN, G, c;
    __device__ void init(int ntile, int nN_, int G_, int c_) { nN = nN_; nwg = ntile * nN_; G = G_; c = c_; }
    __device__ bool next(int i, Unit& u) const { const long L = (long)i * G + c; if (L >= nwg) return false; u.pm = (int)L / nN; u.pn = (int)L % nN; return true; }
    __device__ __forceinline__ void a_ready(const Unit&) const {}
    __device__ __forceinline__ void done(const Unit&) const {}
};
__device__ __forceinline__ unsigned cvt_pk_bf16(float lo, float hi) { unsigned r; asm volatile("v_cvt_pk_bf16_f32 %0, %1, %2" : "=v"(r) : "v"(lo), "v"(hi)); return r; }

template <class Epi, class Sched, bool ALIGN_EPI, bool GATHER, bool EXPERT>
__device__ __forceinline__ void gemm_phase(LAS unsigned char* lds, const Gemm g, const Sched& S, const Epi& E, const int* rowmap, const int* texp, size_t bstride) {
    const int tid = threadIdx.x, wid = __builtin_amdgcn_readfirstlane(tid >> 6), lane = tid & 63, wr = wid >> 2, wc = wid & 3, fr = lane & 15, fq = lane >> 4;
    const int K = g.K, nt = K / BK;
    unsigned voffA[2], voffB[2]; int RA[2]; unsigned CAb[2];
#pragma unroll
    for (int i = 0; i < 2; ++i) { int R, C; stage_rc(tid * 16 + i * 8192, R, C); const int Rb = Epi::PERM ? ((R & ~31) + perm32(R & 31)) : R;
        voffA[i] = (unsigned)(R * K + C) * 2u; voffB[i] = (unsigned)(Rb * K + C) * 2u; RA[i] = R; CAb[i] = (unsigned)C * 2u; }
    const size_t kstep = (size_t)(BK * 2);
    const size_t hstep = (size_t)HALF * K * 2;
    const size_t tstep = 2 * hstep;
    const size_t ahs = GATHER ? 0 : hstep;
    const unsigned ldsw = (unsigned)wid * 1024u;
    const int aoff = lds_byte(wr * 64 + fr, fq * 8), boff = lds_byte(wc * 32 + fr, fq * 8);
#define PG8_SA(b, h) (((b) * 2 + (h)) * HTB)
#define PG8_SB(b, h) ((4 + (b) * 2 + (h)) * HTB)
#define PG8_STAGE(bufoff, gbase, voff) do { _Pragma("unroll") for (int _i = 0; _i < 2; ++_i) \
        __builtin_amdgcn_global_load_lds((const unsigned*)((const char*)(gbase) + (voff)[_i]), (LAS unsigned*)(lds + (bufoff) + ldsw + _i * 8192), 16, 0, 0); } while (0)
#define PG8_LDA(dst, b, h) do { _Pragma("unroll") for (int m = 0; m < 4; ++m) _Pragma("unroll") for (int k = 0; k < 2; ++k) dst[m][k] = *(const LAS bf16x8*)(lds + PG8_SA(b, h) + aoff + m * 2048 + k * 1024); } while (0)
#define PG8_LDB(dst, b, h) do { _Pragma("unroll") for (int n = 0; n < 2; ++n) _Pragma("unroll") for (int k = 0; k < 2; ++k) dst[n][k] = *(const LAS bf16x8*)(lds + PG8_SB(b, h) + boff + n * 2048 + k * 1024); } while (0)
#define PG8_MMA(ai, bj, At, Bt) do { __builtin_amdgcn_s_setprio(1); _Pragma("unroll") for (int m = 0; m < 4; ++m) _Pragma("unroll") for (int n = 0; n < 2; ++n) _Pragma("unroll") for (int k = 0; k < 2; ++k) \
        acc[ai][bj][m][n] = __builtin_amdgcn_mfma_f32_16x16x32_bf16(Bt[n][k], At[m][k], acc[ai][bj][m][n], 0, 0, 0); __builtin_amdgcn_s_setprio(0); } while (0)
#define PG8_WAIT_V(n) asm volatile("s_waitcnt vmcnt(" #n ")" ::: "memory")
#define PG8_WAIT_L(n) asm volatile("s_waitcnt lgkmcnt(" #n ")" ::: "memory")
#define PG8_BAR __builtin_amdgcn_s_barrier()
#define PG8_SCHED __builtin_amdgcn_sched_barrier(0)
#define PG8_ROWS(u, v) do { _Pragma("unroll") for (int _h = 0; _h < 2; ++_h) _Pragma("unroll") for (int _i = 0; _i < 2; ++_i) { int _r = rowmap[(u).pm * BM + _h * HALF + RA[_i]]; _r = _r < 0 ? 0 : _r; \
        v[_h][_i] = (unsigned)_r * (unsigned)(K * 2) + CAb[_i]; } } while (0)
#define PG8_BPTR(u) ((const char*)g.Bt + (EXPERT ? (size_t)texp[(u).pm] * bstride : (size_t)0) + (size_t)(u).pn * tstep)
#define PG8_APTR(u) ((const char*)g.A + (GATHER ? (size_t)0 : (size_t)(u).pm * tstep))
    Unit cur, nxt; int ui = 0;
    if (!S.next(0, cur)) return;
    f32x4 acc[2][2][4][2];
#pragma unroll
    for (int a = 0; a < 2; ++a)
#pragma unroll
        for (int b = 0; b < 2; ++b)
#pragma unroll
            for (int m = 0; m < 4; ++m)
#pragma unroll
                for (int n = 0; n < 2; ++n) acc[a][b][m][n] = (f32x4){0.f, 0.f, 0.f, 0.f};
    bf16x8 At[4][2], B0[2][2], B1[2][2];
    unsigned cv[2][2], nv[2][2];
    if constexpr (GATHER) { PG8_ROWS(cur, cv); } else { cv[0][0] = voffA[0]; cv[0][1] = voffA[1]; cv[1][0] = voffA[0]; cv[1][1] = voffA[1]; }
#pragma unroll
    for (int h = 0; h < 2; ++h) { nv[h][0] = cv[h][0]; nv[h][1] = cv[h][1]; }
    const char* cA = PG8_APTR(cur); const char* cB = PG8_BPTR(cur);
    S.a_ready(cur);
    PG8_STAGE(PG8_SB(0, 0), cB, voffB); PG8_STAGE(PG8_SB(0, 1), cB + hstep, voffB); PG8_STAGE(PG8_SA(0, 0), cA, cv[0]); PG8_STAGE(PG8_SA(0, 1), cA + ahs, cv[1]);
    if (wr == 1) PG8_BAR;
    PG8_WAIT_V(2); PG8_BAR;
    PG8_STAGE(PG8_SB(1, 0), cB + kstep, voffB); PG8_STAGE(PG8_SA(1, 0), cA + kstep, cv[0]); PG8_STAGE(PG8_SB(1, 1), cB + hstep + kstep, voffB);
    PG8_WAIT_V(6); PG8_BAR;
    for (;;) {
        const bool has_next = S.next(ui + 1, nxt);
        const char* nA = has_next ? PG8_APTR(nxt) : cA; const char* nB = has_next ? PG8_BPTR(nxt) : cB;
        if constexpr (GATHER) { if (has_next) { PG8_ROWS(nxt, nv); } }
        for (int t = 0; t < nt; t += 2) {
            const bool last = (t == nt - 2);
            const char* a1 = cA + (size_t)(t + 1) * kstep;
            const char* a2 = last ? nA : cA + (size_t)(t + 2) * kstep; const char* b2 = last ? nB : cB + (size_t)(t + 2) * kstep;
            const char* a3 = a2 + kstep; const char* b3 = b2 + kstep;
            unsigned s0[2], s1[2];
            s0[0] = last ? nv[0][0] : cv[0][0]; s0[1] = last ? nv[0][1] : cv[0][1]; s1[0] = last ? nv[1][0] : cv[1][0]; s1[1] = last ? nv[1][1] : cv[1][1];
            if (last && has_next) S.a_ready(nxt);
            PG8_LDB(B0, 0, 0); PG8_LDB(B1, 0, 1); PG8_SCHED; PG8_LDA(At, 0, 0); PG8_STAGE(PG8_SA(1, 1), a1 + ahs, cv[1]);
            PG8_WAIT_V(8); PG8_WAIT_L(0); PG8_BAR; PG8_MMA(0, 0, At, B0); PG8_MMA(0, 1, At, B1); PG8_BAR; PG8_SCHED;
            PG8_LDA(At, 0, 1); PG8_STAGE(PG8_SB(0, 0), b2, voffB); PG8_STAGE(PG8_SB(0, 1), b2 + hstep, voffB); PG8_STAGE(PG8_SA(0, 0), a2, s0);
            PG8_WAIT_V(8); PG8_WAIT_L(0); PG8_BAR; PG8_MMA(1, 0, At, B0); PG8_MMA(1, 1, At, B1); PG8_BAR; PG8_SCHED;
            PG8_LDB(B0, 1, 0); PG8_LDB(B1, 1, 1); PG8_SCHED; PG8_LDA(At, 1, 0); PG8_STAGE(PG8_SA(0, 1), a2 + ahs, s1);
            PG8_WAIT_V(8); PG8_WAIT_L(0); PG8_BAR; PG8_MMA(0, 0, At, B0); PG8_MMA(0, 1, At, B1); PG8_BAR; PG8_SCHED;
            PG8_LDA(At, 1, 1); PG8_STAGE(PG8_SB(1, 0), b3, voffB); PG8_STAGE(PG8_SB(1, 1), b3 + hstep, voffB); PG8_STAGE(PG8_SA(1, 0), a3, s0);
            PG8_WAIT_V(8); PG8_WAIT_L(0); PG8_BAR; PG8_MMA(1, 0, At, B0); PG8_MMA(1, 1, At, B1); PG8_BAR; PG8_SCHED;
        }
        if constexpr (ALIGN_EPI) { if (wr == 0) PG8_BAR; }
        E(acc, cur, wr, wc, fr, fq); S.done(cur);
        if (!has_next) break;
#pragma unroll
        for (int a = 0; a < 2; ++a)
#pragma unroll
            for (int b = 0; b < 2; ++b)
#pragma unroll
                for (int m = 0; m < 4; ++m)
#pragma unroll
                    for (int n = 0; n < 2; ++n) acc[a][b][m][n] = (f32x4){0.f, 0.f, 0.f, 0.f};
        cur = nxt; cA = nA; cB = nB; ++ui;
#pragma unroll
        for (int h = 0; h < 2; ++h) { cv[h][0] = nv[h][0]; cv[h][1] = nv[h][1]; }
        if constexpr (ALIGN_EPI) { if (wr == 1) PG8_BAR; }
    }
    PG8_WAIT_V(0);
    if constexpr (!ALIGN_EPI) { if (wr == 0) PG8_BAR; }
    PG8_BAR;
#undef PG8_SA
#undef PG8_SB
#undef PG8_STAGE
#undef PG8_LDA
#undef PG8_LDB
#undef PG8_MMA
#undef PG8_WAIT_V
#undef PG8_WAIT_L
#undef PG8_BAR
#undef PG8_SCHED
#undef PG8_ROWS
#undef PG8_BPTR
#undef PG8_APTR
}

struct EpiInProjF {
    static constexpr bool PERM = true;
    unsigned char* ws; const float* dt_bias; const float* gate_bias;
    __device__ __forceinline__ void operator()(const f32x4 (&acc)[2][2][4][2], const Unit& u, int wr, int wc, int fr, int fq) const {
        const int pn = u.pn, row0 = u.pm * BM + wr * 64 + fr, c8 = wc * 32 + 8 * fq;
        if (pn < 46) {
            bf16* base; int ldc, ct; const bool gate = pn >= 38;
            if (pn < 6) { base = (bf16*)(ws + WS_Q); ldc = AW; ct = pn * 256; }
            else if (pn < 12) { base = (bf16*)(ws + WS_K); ldc = AW; ct = (pn - 6) * 256; }
            else if (pn < 18) { base = (bf16*)(ws + WS_V); ldc = AW; ct = (pn - 12) * 256; }
            else if (pn < 26) { base = (bf16*)(ws + WS_Z); ldc = DI; ct = (pn - 18) * 256; }
            else if (pn < 38) { base = (bf16*)(ws + WS_XBC); ldc = CONVD; ct = (pn - 26) * 256; }
            else { base = (bf16*)(ws + WS_GATE); ldc = 2048; ct = (pn - 38) * 256; }
            f32x4 gb[2][2];
#pragma unroll
            for (int bj = 0; bj < 2; ++bj)
#pragma unroll
                for (int n = 0; n < 2; ++n) gb[bj][n] = gate ? *(const f32x4*)(gate_bias + ct + c8 + bj * HALF + 4 * n) : (f32x4){0.f, 0.f, 0.f, 0.f};
#pragma unroll
            for (int ai = 0; ai < 2; ++ai)
#pragma unroll
                for (int m = 0; m < 4; ++m) { bf16* rowp = base + (size_t)(row0 + ai * HALF + m * 16) * ldc + ct + c8;
#pragma unroll
                    for (int bj = 0; bj < 2; ++bj) { f32x4 v0 = acc[ai][bj][m][0], v1 = acc[ai][bj][m][1];
                        if (gate) { v0 = v0 + gb[bj][0]; v1 = v1 + gb[bj][1];
                            v0 = (f32x4){sigmoidf_(v0.x), sigmoidf_(v0.y), sigmoidf_(v0.z), sigmoidf_(v0.w)}; v1 = (f32x4){sigmoidf_(v1.x), sigmoidf_(v1.y), sigmoidf_(v1.z), sigmoidf_(v1.w)}; }
                        u32x4 w; w.x = cvt_pk_bf16(v0.x, v0.y); w.y = cvt_pk_bf16(v0.z, v0.w); w.z = cvt_pk_bf16(v1.x, v1.y); w.w = cvt_pk_bf16(v1.z, v1.w);
                        *(u32x4*)(rowp + bj * HALF) = w; } }
        } else if (wc == 0) {
            const f32x4 b0 = *(const f32x4*)(dt_bias + c8), b1 = *(const f32x4*)(dt_bias + c8 + 4);
#pragma unroll
            for (int ai = 0; ai < 2; ++ai)
#pragma unroll
                for (int m = 0; m < 4; ++m) { float* rowp = (float*)(ws + WS_DT) + (size_t)(row0 + ai * HALF + m * 16) * 32 + c8;
                    const f32x4 v0 = acc[ai][0][m][0] + b0, v1 = acc[ai][0][m][1] + b1;
                    *(f32x4*)rowp = (f32x4){softplusf_(v0.x), softplusf_(v0.y), softplusf_(v0.z), softplusf_(v0.w)};
                    *(f32x4*)(rowp + 4) = (f32x4){softplusf_(v1.x), softplusf_(v1.y), softplusf_(v1.z), softplusf_(v1.w)}; }
        }
    }
};
struct EpiM0F {
    static constexpr bool PERM = false;
    unsigned char* ws;
    __device__ __forceinline__ void operator()(const f32x4 (&acc)[2][2][4][2], const Unit& u, int wr, int wc, int fr, int fq) const {
        const int row0 = u.pm * BM + wr * 64 + fr, col0 = u.pn * BM + wc * 32 + 4 * fq;
#pragma unroll
        for (int ai = 0; ai < 2; ++ai)
#pragma unroll
            for (int m = 0; m < 4; ++m) { const size_t r = (size_t)(row0 + ai * HALF + m * 16);
#pragma unroll
                for (int bj = 0; bj < 2; ++bj)
#pragma unroll
                    for (int n = 0; n < 2; ++n) { const int c = col0 + bj * HALF + n * 16;
                        const u32x2 gg = *(const u32x2*)((const bf16*)(ws + WS_GATE) + r * 2048 + c); const f32x4 v = acc[ai][bj][m][n];
                        *(f32x4*)((float*)(ws + WS_M0) + r * D + c) = (f32x4){v.x * bflo(gg.x), v.y * bfhi(gg.x), v.z * bflo(gg.y), v.w * bfhi(gg.y)}; } }
    }
};
struct EpiMergedF {
    static constexpr bool PERM = true;
    unsigned char* ws;
    __device__ __forceinline__ void operator()(const f32x4 (&acc)[2][2][4][2], const Unit& u, int wr, int wc, int fr, int fq) const {
        const int row0 = u.pm * BM + wr * 64 + fr, col0 = u.pn * BM + wc * 32 + 8 * fq;
#pragma unroll
        for (int ai = 0; ai < 2; ++ai)
#pragma unroll
            for (int m = 0; m < 4; ++m) { const size_t r = (size_t)(row0 + ai * HALF + m * 16);
#pragma unroll
                for (int bj = 0; bj < 2; ++bj) { const int c = col0 + bj * HALF;
                    const u32x4 gg = *(const u32x4*)((const bf16*)(ws + WS_GATE) + r * 2048 + 1024 + c);
                    const f32x4 m0 = *(const f32x4*)((const float*)(ws + WS_M0) + r * D + c), m1 = *(const f32x4*)((const float*)(ws + WS_M0) + r * D + c + 4);
                    const f32x4 v0 = acc[ai][bj][m][0], v1 = acc[ai][bj][m][1];
                    u32x4 w; w.x = cvt_pk_bf16(m0.x + v0.x * bflo(gg.x), m0.y + v0.y * bfhi(gg.x)); w.y = cvt_pk_bf16(m0.z + v0.z * bflo(gg.y), m0.w + v0.w * bfhi(gg.y));
                    w.z = cvt_pk_bf16(m1.x + v1.x * bflo(gg.z), m1.y + v1.y * bfhi(gg.z)); w.w = cvt_pk_bf16(m1.z + v1.z * bflo(gg.w), m1.w + v1.w * bfhi(gg.w));
                    *(u32x4*)((bf16*)(ws + WS_MERGED) + r * D + c) = w; } }
    }
};
struct EpiX1F {
    static constexpr bool PERM = false;
    const float* x; float* out;
    __device__ __forceinline__ void operator()(const f32x4 (&acc)[2][2][4][2], const Unit& u, int wr, int wc, int fr, int fq) const {
        const int row0 = u.pm * BM + wr * 64 + fr, col0 = u.pn * BM + wc * 32 + 4 * fq;
#pragma unroll
        for (int ai = 0; ai < 2; ++ai)
#pragma unroll
            for (int m = 0; m < 4; ++m) { const size_t r = (size_t)(row0 + ai * HALF + m * 16);
#pragma unroll
                for (int bj = 0; bj < 2; ++bj)
#pragma unroll
                    for (int n = 0; n < 2; ++n) { const int c = col0 + bj * HALF + n * 16;
                        *(f32x4*)(out + r * D + c) = *(const f32x4*)(x + r * D + c) + acc[ai][bj][m][n]; } }
    }
};
struct EpiMoe1F {
    static constexpr bool PERM = true;
    unsigned char* ws; const float* b1; const int* texp;
    __device__ __forceinline__ void operator()(const f32x4 (&acc)[2][2][4][2], const Unit& u, int wr, int wc, int fr, int fq) const {
        const int e = texp[u.pm];
        const int row0 = u.pm * BM + wr * 64 + fr, col0 = u.pn * BM + wc * 32 + 8 * fq;
        f32x4 bv[2][2];
#pragma unroll
        for (int bj = 0; bj < 2; ++bj)
#pragma unroll
            for (int n = 0; n < 2; ++n) bv[bj][n] = *(const f32x4*)(b1 + (size_t)e * 2048 + col0 + bj * HALF + 4 * n);
#pragma unroll
        for (int ai = 0; ai < 2; ++ai)
#pragma unroll
            for (int m = 0; m < 4; ++m) { const size_t r = (size_t)(row0 + ai * HALF + m * 16);
#pragma unroll
                for (int bj = 0; bj < 2; ++bj) { const f32x4 v0 = acc[ai][bj][m][0] + bv[bj][0], v1 = acc[ai][bj][m][1] + bv[bj][1];
                    u32x2 w; w.x = cvt_pk_bf16(swiglu_(v0.x, v0.y), swiglu_(v0.z, v0.w)); w.y = cvt_pk_bf16(swiglu_(v1.x, v1.y), swiglu_(v1.z, v1.w));
                    *(u32x2*)((bf16*)(ws + WS_ACT) + r * 1024 + ((col0 + bj * HALF) >> 1)) = w; } }
    }
};
struct EpiMoe2F {
    static constexpr bool PERM = true;
    unsigned char* ws; const float* b2; const int* texp;
    __device__ __forceinline__ void operator()(const f32x4 (&acc)[2][2][4][2], const Unit& u, int wr, int wc, int fr, int fq) const {
        const int e = texp[u.pm];
        const int row0 = u.pm * BM + wr * 64 + fr, col0 = u.pn * BM + wc * 32 + 8 * fq;
        f32x4 bv[2][2];
#pragma unroll
        for (int bj = 0; bj < 2; ++bj)
#pragma unroll
            for (int n = 0; n < 2; ++n) bv[bj][n] = *(const f32x4*)(b2 + (size_t)e * 1024 + col0 + bj * HALF + 4 * n);
#pragma unroll
        for (int ai = 0; ai < 2; ++ai)
#pragma unroll
            for (int m = 0; m < 4; ++m) { const size_t r = (size_t)(row0 + ai * HALF + m * 16);
#pragma unroll
                for (int bj = 0; bj < 2; ++bj) { const f32x4 v0 = acc[ai][bj][m][0] + bv[bj][0], v1 = acc[ai][bj][m][1] + bv[bj][1];
                    u32x4 w; w.x = cvt_pk_bf16(v0.x, v0.y); w.y = cvt_pk_bf16(v0.z, v0.w); w.z = cvt_pk_bf16(v1.x, v1.y); w.w = cvt_pk_bf16(v1.z, v1.w);
                    *(u32x4*)((bf16*)(ws + WS_YB) + r * 1024 + col0 + bj * HALF) = w; } }
    }
};
}

__device__ __forceinline__ void transpose_item(const float* W, int K, int N, bf16* WT, int k0, int n0, int drow0, LAS float* scr, int lane) {
#pragma unroll 8
    for (int i = 0; i < 32; ++i) { const int kk = 2 * i + (lane >> 5); scr[kk * 33 + (lane & 31)] = W[(size_t)(k0 + kk) * N + n0 + (lane & 31)]; }
    asm volatile("s_waitcnt lgkmcnt(0)" ::: "memory");
    const int c = lane & 7;
#pragma unroll
    for (int j = 0; j < 4; ++j) { const int n = (lane >> 3) + 8 * j; const LAS float* s = scr + (8 * c) * 33 + n;
        u32x4 o; o.x = pk2(s[0 * 33], s[1 * 33]); o.y = pk2(s[2 * 33], s[3 * 33]); o.z = pk2(s[4 * 33], s[5 * 33]); o.w = pk2(s[6 * 33], s[7 * 33]);
        *(u32x4*)(WT + (size_t)(drow0 + n) * K + k0 + 8 * c) = o; }
    asm volatile("s_waitcnt lgkmcnt(0)" ::: "memory");
}
__device__ __forceinline__ int inproj_row_of_col(int n0) { return n0 < C_DT ? n0 : (n0 < C_GATE ? n0 - C_DT + 11776 : n0 - 32); }
__device__ __forceinline__ void p_convert_small(Frame& F) {
    LAS float* scr = (LAS float*)(F.lds + F.wave * 16384);
    const int gw = F.blk * NWAVES + F.wave, NGW = F.nblk * NWAVES;
    constexpr int I_IN = 16 * (NPROJ / 32), I_BA = 8 * 32, I_BS = 32 * 32, I_OUT = 16 * 32, NIT = I_IN + I_BA + I_BS + I_OUT;
    for (int it = gw; it < NIT; it += NGW) {
        int r = it;
        if (r < I_IN) { const int nb = r % (NPROJ / 32), kb = r / (NPROJ / 32); transpose_item(F.w_in, D, NPROJ, (bf16*)(F.ws + WS_WIN_T), 64 * kb, 32 * nb, inproj_row_of_col(32 * nb), scr, F.lane); continue; } r -= I_IN;
        if (r < I_BA) { const int nb = r % 32, kb = r / 32; transpose_item(F.w_ba, 512, D, (bf16*)(F.ws + WS_WBA_T), 64 * kb, 32 * nb, 32 * nb, scr, F.lane); continue; } r -= I_BA;
        if (r < I_BS) { const int nb = r % 32, kb = r / 32; transpose_item(F.w_bs, DI, D, (bf16*)(F.ws + WS_WBS_T), 64 * kb, 32 * nb, 32 * nb, scr, F.lane); continue; } r -= I_BS;
        { const int nb = r % 32, kb = r / 32; transpose_item(F.w_out, D, D, (bf16*)(F.ws + WS_WOUT_T), 64 * kb, 32 * nb, 32 * nb, scr, F.lane); }
    }
    u32x4* z = (u32x4*)((bf16*)(F.ws + WS_WIN_T) + (size_t)11808 * D);
    for (int i = F.blk * NTHREADS + F.tid; i < 224 * D * 2 / 16; i += F.nblk * NTHREADS) z[i] = (u32x4){0u, 0u, 0u, 0u};
}
__device__ __forceinline__ void p_convert_moe(Frame& F) {
    LAS float* scr = (LAS float*)(F.lds + F.wave * 16384);
    const int gw = F.blk * NWAVES + F.wave, NGW = F.nblk * NWAVES;
    constexpr int I_1 = 16 * 64, I_2 = 16 * 32, NIT = NEXP * (I_1 + I_2);
    for (int it = gw; it < NIT; it += NGW) {
        const int e = it / (I_1 + I_2); int r = it % (I_1 + I_2);
        if (r < I_1) { const int nb = r % 64, kb = r / 64; transpose_item(F.w1 + (size_t)e * 1024 * 2048, 1024, 2048, (bf16*)(F.ws + WS_W1T) + (size_t)e * 2048 * 1024, 64 * kb, 32 * nb, 32 * nb, scr, F.lane); }
        else { r -= I_1; const int nb = r % 32, kb = r / 32; transpose_item(F.w2 + (size_t)e * 1024 * 1024, 1024, 1024, (bf16*)(F.ws + WS_W2T) + (size_t)e * 1024 * 1024, 64 * kb, 32 * nb, 32 * nb, scr, F.lane); }
    }
}

__device__ __forceinline__ void p_rmsnorm_in(Frame& F) {
    const int gw = F.blk * NWAVES + F.wave, NGW = F.nblk * NWAVES;
    bf16* XN = (bf16*)(F.ws + WS_XN);
    for (int m = gw; m < T; m += NGW) {
        const f32x4* xr = (const f32x4*)(F.x + (size_t)m * D) + F.lane;
        const f32x4* wr = (const f32x4*)F.norm_mix + F.lane;
        f32x4 v[4]; float s = 0.f;
#pragma unroll
        for (int j = 0; j < 4; ++j) { v[j] = xr[64 * j]; s += (v[j].x * v[j].x + v[j].y * v[j].y) + (v[j].z * v[j].z + v[j].w * v[j].w); }
        const float rstd = 1.f / sqrtf(wave_sum(s) * (1.f / D) + EPS);
#pragma unroll
        for (int j = 0; j < 4; ++j) { const f32x4 w = wr[64 * j]; const f32x4 o = v[j] * rstd * w; st_bf4(XN + (size_t)m * D + (F.lane + 64 * j) * 4, o); }
    }
}

__device__ __forceinline__ int t5_bucket_dev(int dist) {
    if (dist < 16) return dist;
    int l = 16 + (int)(logf((float)dist / 16.f) / logf(128.f) * 16.f);
    return l < 31 ? l : 31;
}
__device__ __forceinline__ void p_attn_naive(Frame& F) {
    LAS float* btab = (LAS float*)F.lds;
    for (int i = F.tid; i < 3 * 129 * 8; i += NTHREADS) {
        const int g = i / (129 * 8), j = (i >> 3) % 129, hg = i & 7;
        const int dil = g == 0 ? 1 : (g == 1 ? 4 : 16);
        btab[i] = F.rel_bias[t5_bucket_dev(j * dil) * 24 + g * 8 + hg];
    }
    __syncthreads();
    const bf16* Qb = (const bf16*)(F.ws + WS_Q); const bf16* Kb = (const bf16*)(F.ws + WS_K); const bf16* Vb = (const bf16*)(F.ws + WS_V);
    bf16* AT = (bf16*)(F.ws + WS_ATTN);
    for (int idx = F.blk * NTHREADS + F.tid; idx < T * 8; idx += F.nblk * NTHREADS) {
        const int hg = idx & 7, row = idx >> 3, t = row & (SEQ - 1);
        float m = -INFINITY, den = 0.f;
        float acc[64];
#pragma unroll
        for (int i = 0; i < 64; ++i) acc[i] = 0.f;
        for (int g = 0; g < 3; ++g) {
            const int dil = g == 0 ? 1 : (g == 1 ? 4 : 16);
            const int head = g * 8 + hg;
            float q[64];
            { const u32x4* qp = (const u32x4*)(Qb + (size_t)row * AW + head * 64);
#pragma unroll
              for (int c = 0; c < 8; ++c) { const u32x4 w = qp[c]; q[8 * c + 0] = bflo(w.x); q[8 * c + 1] = bfhi(w.x); q[8 * c + 2] = bflo(w.y); q[8 * c + 3] = bfhi(w.y);
                  q[8 * c + 4] = bflo(w.z); q[8 * c + 5] = bfhi(w.z); q[8 * c + 6] = bflo(w.w); q[8 * c + 7] = bfhi(w.w); } }
            for (int j = 0; j <= 128; ++j) {
                const int kt = t - j * dil; if (kt < 0) break;
                const size_t krow = (size_t)(row - j * dil);
                const u32x4* kp = (const u32x4*)(Kb + krow * AW + head * 64);
                float s = 0.f;
#pragma unroll
                for (int c = 0; c < 8; ++c) { const u32x4 w = kp[c];
                    s += q[8 * c + 0] * bflo(w.x) + q[8 * c + 1] * bfhi(w.x) + q[8 * c + 2] * bflo(w.y) + q[8 * c + 3] * bfhi(w.y)
                       + q[8 * c + 4] * bflo(w.z) + q[8 * c + 5] * bfhi(w.z) + q[8 * c + 6] * bflo(w.w) + q[8 * c + 7] * bfhi(w.w); }
                s = s * 0.125f + btab[(g * 129 + j) * 8 + hg];
                const float mn = fmaxf(m, s), sc = __expf(m - mn), p = __expf(s - mn);
                m = mn; den = den * sc + p;
                const u32x4* vp = (const u32x4*)(Vb + krow * AW + head * 64);
#pragma unroll
                for (int c = 0; c < 8; ++c) { const u32x4 w = vp[c];
                    acc[8 * c + 0] = acc[8 * c + 0] * sc + p * bflo(w.x); acc[8 * c + 1] = acc[8 * c + 1] * sc + p * bfhi(w.x);
                    acc[8 * c + 2] = acc[8 * c + 2] * sc + p * bflo(w.y); acc[8 * c + 3] = acc[8 * c + 3] * sc + p * bfhi(w.y);
                    acc[8 * c + 4] = acc[8 * c + 4] * sc + p * bflo(w.z); acc[8 * c + 5] = acc[8 * c + 5] * sc + p * bfhi(w.z);
                    acc[8 * c + 6] = acc[8 * c + 6] * sc + p * bflo(w.w); acc[8 * c + 7] = acc[8 * c + 7] * sc + p * bfhi(w.w); }
            }
        }
        const float inv = 1.f / den;
        u32x4* op = (u32x4*)(AT + (size_t)row * 512 + hg * 64);
#pragma unroll
        for (int c = 0; c < 8; ++c) { u32x4 w; w.x = pk2(acc[8 * c] * inv, acc[8 * c + 1] * inv); w.y = pk2(acc[8 * c + 2] * inv, acc[8 * c + 3] * inv);
            w.z = pk2(acc[8 * c + 4] * inv, acc[8 * c + 5] * inv); w.w = pk2(acc[8 * c + 6] * inv, acc[8 * c + 7] * inv); op[c] = w; }
    }
    __syncthreads();
}

typedef short bf16x8_t __attribute__((ext_vector_type(8)));
typedef short s16x4_t __attribute__((ext_vector_type(4)));
typedef float f32x16 __attribute__((ext_vector_type(16)));
__device__ __forceinline__ int crow_(int reg, int h) { return (reg & 3) + 8 * (reg >> 2) + 4 * h; }
__device__ __forceinline__ s16x4_t tr_read_(const LAS unsigned char* p) { return __builtin_bit_cast(s16x4_t, __builtin_amdgcn_ds_read_tr16_b64_v4i16((LAS s16x4_t*)p)); }
constexpr int ATT_HALF_BYTES = 66560;
__device__ __forceinline__ void p_attn_fast(Frame& F) {
    const int half = F.wave >> 2, qb = F.wave & 3, th = F.tid & 255, lane = F.lane, r = lane & 31, h = lane >> 5;
    LAS unsigned char* base = F.lds + half * ATT_HALF_BYTES;
    LAS unsigned char* Kimg = base; LAS unsigned char* Vimg = base + 32768; LAS float* btab = (LAS float*)(base + 65536);
    const bf16* Qb = (const bf16*)(F.ws + WS_Q); const bf16* Kb = (const bf16*)(F.ws + WS_K); const bf16* Vb = (const bf16*)(F.ws + WS_V);
    bf16* OUTG = (bf16*)(F.ws + WS_OUTG); float* LSE = (float*)(F.ws + WS_LSE);
    constexpr int NUNIT = BATCH * 24 * 16;
    for (int pair = F.blk; pair < NUNIT / 2; pair += F.nblk) {
        const int u = pair * 2 + half;
        const int zn = u & 15, head = (u >> 4) % 24, b = u / (16 * 24);
        const int g = head >> 3, hg = head & 7;
        const int dil = g == 0 ? 1 : (g == 1 ? 4 : 16), nb = 16 / dil;
        const int z = zn / nb, n = zn % nb;
        const size_t rowb = (size_t)b * SEQ;
        __syncthreads();
#pragma unroll
        for (int i = 0; i < 8; ++i) {
            const int piece = th + 256 * i, kw = piece >> 3, ch = piece & 7;
            const int p = (n - 1) * 128 + kw;
            u32x4 kv = (u32x4){0u, 0u, 0u, 0u}, vv = (u32x4){0u, 0u, 0u, 0u};
            if (p >= 0) { const size_t row = rowb + (size_t)p * dil + z; kv = *(const u32x4*)(Kb + row * AW + head * 64 + ch * 8); vv = *(const u32x4*)(Vb + row * AW + head * 64 + ch * 8); }
            const int off = kw * 128 + ((ch ^ (kw & 7)) << 4);
            *(LAS u32x4*)(Kimg + off) = kv; *(LAS u32x4*)(Vimg + off) = vv;
        }
        if (th < 129) btab[th] = F.rel_bias[t5_bucket_dev(th * dil) * 24 + head];
        bf16x8_t qf[4];
        { const size_t qrow = rowb + (size_t)(n * 128 + 32 * qb + r) * dil + z;
#pragma unroll
          for (int dd = 0; dd < 4; ++dd) qf[dd] = *(const bf16x8_t*)(Qb + qrow * AW + head * 64 + 16 * dd + 8 * h); }
        __syncthreads();
        f32x16 sc[5];
#pragma unroll
        for (int kb = 0; kb < 5; ++kb) {
            f32x16 a = {0.f, 0.f, 0.f, 0.f, 0.f, 0.f, 0.f, 0.f, 0.f, 0.f, 0.f, 0.f, 0.f, 0.f, 0.f, 0.f};
            const int krow0 = 32 * (qb + kb) + r;
#pragma unroll
            for (int dd = 0; dd < 4; ++dd) {
                const bf16x8_t kf = *(const LAS bf16x8_t*)(Kimg + krow0 * 128 + (((2 * dd + h) ^ (r & 7)) << 4));
                a = __builtin_amdgcn_mfma_f32_32x32x16_bf16(kf, qf[dd], a, 0, 0, 0);
            }
            sc[kb] = a;
        }
        float m = -INFINITY;
#pragma unroll
        for (int kb = 0; kb < 5; ++kb)
#pragma unroll
            for (int i = 0; i < 16; ++i) {
                const int c = crow_(i, h);
                const int delta = 128 + r - 32 * kb - c;
                bool valid = (kb == 0) ? (r <= c) : ((kb == 4) ? (c <= r) : true);
                if (n == 0 && (32 * (qb + kb) + c) < 128) valid = false;
                const int dcl = delta < 0 ? 0 : (delta > 128 ? 128 : delta);
                const float s = valid ? (sc[kb][i] * 0.125f + btab[dcl]) : -INFINITY;
                sc[kb][i] = s; m = fmaxf(m, s);
            }
        m = fmaxf(m, __shfl_xor(m, 32));
        float den = 0.f;
#pragma unroll
        for (int kb = 0; kb < 5; ++kb)
#pragma unroll
            for (int i = 0; i < 16; ++i) { const float p = __expf(sc[kb][i] - m); sc[kb][i] = p; den += p; }
        den += __shfl_xor(den, 32);
        const float inv = 1.f / den;
        if (h == 0) LSE[((size_t)g * T + rowb + (size_t)(n * 128 + 32 * qb + r) * dil + z) * 8 + hg] = m + __logf(den);
        f32x16 o[2];
        o[0] = (f32x16){0.f, 0.f, 0.f, 0.f, 0.f, 0.f, 0.f, 0.f, 0.f, 0.f, 0.f, 0.f, 0.f, 0.f, 0.f, 0.f}; o[1] = o[0];
        const int q4 = (lane & 15) >> 2, blk16 = (lane >> 4) & 1, p4 = lane & 3;
#pragma unroll
        for (int kb = 0; kb < 5; ++kb)
#pragma unroll
            for (int s = 0; s < 2; ++s) {
                u32x4 pw;
                pw.x = pk2(sc[kb][8 * s + 0] * inv, sc[kb][8 * s + 1] * inv); pw.y = pk2(sc[kb][8 * s + 2] * inv, sc[kb][8 * s + 3] * inv);
                pw.z = pk2(sc[kb][8 * s + 4] * inv, sc[kb][8 * s + 5] * inv); pw.w = pk2(sc[kb][8 * s + 6] * inv, sc[kb][8 * s + 7] * inv);
                const bf16x8_t pa = __builtin_bit_cast(bf16x8_t, pw);
                const int row_lo = 32 * (qb + kb) + 16 * s + 4 * h + q4, row_hi = row_lo + 8;
#pragma unroll
                for (int db = 0; db < 2; ++db) {
                    const int chunk = 4 * db + 2 * blk16 + (p4 >> 1), sub = (p4 & 1) * 8;
                    const s16x4_t lo = tr_read_(Vimg + row_lo * 128 + ((chunk ^ (row_lo & 7)) << 4) + sub);
                    const s16x4_t hi = tr_read_(Vimg + row_hi * 128 + ((chunk ^ (row_hi & 7)) << 4) + sub);
                    const bf16x8_t vf = (bf16x8_t){lo[0], lo[1], lo[2], lo[3], hi[0], hi[1], hi[2], hi[3]};
                    o[db] = __builtin_amdgcn_mfma_f32_32x32x16_bf16(pa, vf, o[db], 0, 0, 0);
                }
            }
#pragma unroll
        for (int i = 0; i < 16; ++i) {
            const size_t row = rowb + (size_t)(n * 128 + 32 * qb + crow_(i, h)) * dil + z;
            bf16* op = OUTG + ((size_t)g * T + row) * 512 + hg * 64 + r;
            op[0] = (bf16)f2bf(o[0][i]); op[32] = (bf16)f2bf(o[1][i]);
        }
    }
    __syncthreads();
}
__device__ __forceinline__ void p_attn_merge(Frame& F) {
    const bf16* OUTG = (const bf16*)(F.ws + WS_OUTG); const float* LSE = (const float*)(F.ws + WS_LSE); bf16* AT = (bf16*)(F.ws + WS_ATTN);
    for (int idx = F.blk * NTHREADS + F.tid; idx < T * 64; idx += F.nblk * NTHREADS) {
        const int row = idx >> 6, c8 = (idx & 63) * 8, hg = c8 >> 6;
        const float l0 = LSE[((size_t)0 * T + row) * 8 + hg], l1 = LSE[((size_t)1 * T + row) * 8 + hg], l2 = LSE[((size_t)2 * T + row) * 8 + hg];
        const float mx = fmaxf(l0, fmaxf(l1, l2)), e0 = __expf(l0 - mx), e1 = __expf(l1 - mx), e2 = __expf(l2 - mx), inv = 1.f / (e0 + e1 + e2);
        const float w[3] = {e0 * inv, e1 * inv, e2 * inv};
        float a[8] = {0.f, 0.f, 0.f, 0.f, 0.f, 0.f, 0.f, 0.f};
#pragma unroll
        for (int g = 0; g < 3; ++g) { const u32x4 v = *(const u32x4*)(OUTG + ((size_t)g * T + row) * 512 + c8);
            a[0] += w[g] * bflo(v.x); a[1] += w[g] * bfhi(v.x); a[2] += w[g] * bflo(v.y); a[3] += w[g] * bfhi(v.y);
            a[4] += w[g] * bflo(v.z); a[5] += w[g] * bfhi(v.z); a[6] += w[g] * bflo(v.w); a[7] += w[g] * bfhi(v.w); }
        u32x4 o; o.x = pk2(a[0], a[1]); o.y = pk2(a[2], a[3]); o.z = pk2(a[4], a[5]); o.w = pk2(a[6], a[7]);
        *(u32x4*)(AT + (size_t)row * 512 + c8) = o;
    }
}

__device__ __forceinline__ void p_conv(Frame& F) {
    const bf16* X = (const bf16*)(F.ws + WS_XBC); bf16* O = (bf16*)(F.ws + WS_CONV);
    const int total = T * (CONVD / 8);
    for (int idx = F.blk * NTHREADS + F.tid; idx < total; idx += F.nblk * NTHREADS) {
        const int row = idx / (CONVD / 8), c0 = (idx % (CONVD / 8)) * 8, t = row & (SEQ - 1);
        float a[8];
#pragma unroll
        for (int i = 0; i < 8; ++i) a[i] = F.conv_b[c0 + i];
#pragma unroll
        for (int w = 0; w < 4; ++w) {
            const int tt = t + w - 3; if (tt < 0) continue;
            const u32x4 u = *(const u32x4*)(X + (size_t)(row + w - 3) * CONVD + c0);
            const float* cw = F.conv_w + (size_t)w * CONVD + c0;
            a[0] += cw[0] * bflo(u.x); a[1] += cw[1] * bfhi(u.x); a[2] += cw[2] * bflo(u.y); a[3] += cw[3] * bfhi(u.y);
            a[4] += cw[4] * bflo(u.z); a[5] += cw[5] * bfhi(u.z); a[6] += cw[6] * bflo(u.w); a[7] += cw[7] * bfhi(u.w);
        }
        u32x4 o; o.x = pk2(siluf_(a[0]), siluf_(a[1])); o.y = pk2(siluf_(a[2]), siluf_(a[3])); o.z = pk2(siluf_(a[4]), siluf_(a[5])); o.w = pk2(siluf_(a[6]), siluf_(a[7]));
        *(u32x4*)(O + (size_t)row * CONVD + c0) = o;
    }
}

__device__ __forceinline__ void p_ssd_naive(Frame& F) {
    const bf16* CV = (const bf16*)(F.ws + WS_CONV); const float* DT = (const float*)(F.ws + WS_DT); const bf16* Z = (const bf16*)(F.ws + WS_Z);
    bf16* YZ = (bf16*)(F.ws + WS_YZ);
    const int t256 = F.tid & 255, p = t256 >> 2, q = t256 & 3;
    for (int unit = F.blk * 2 + (F.tid >> 8); unit < BATCH * NH_SSM; unit += F.nblk * 2) {
        const int b = unit / NH_SSM, h = unit % NH_SSM, g = h / 8;
        const float a = -__expf(F.a_log[h]), dsk = F.d_skip[h];
        float st[32];
#pragma unroll
        for (int i = 0; i < 32; ++i) st[i] = 0.f;
        for (int t = 0; t < SEQ; ++t) {
            const size_t row = (size_t)b * SEQ + t;
            const float dt = DT[row * 32 + h];
            const float dA = __expf(dt * a);
            const float xv = bf2f(CV[row * CONVD + h * 64 + p]);
            const float dtx = dt * xv;
            const u32x4* bp = (const u32x4*)(CV + row * CONVD + 2048 + g * 128 + q * 32);
            const u32x4* cp = (const u32x4*)(CV + row * CONVD + 2560 + g * 128 + q * 32);
            float yp = 0.f;
#pragma unroll
            for (int c = 0; c < 4; ++c) {
                const u32x4 bw = bp[c], cw = cp[c];
                const float bv[8] = {bflo(bw.x), bfhi(bw.x), bflo(bw.y), bfhi(bw.y), bflo(bw.z), bfhi(bw.z), bflo(bw.w), bfhi(bw.w)};
                const float cv[8] = {bflo(cw.x), bfhi(cw.x), bflo(cw.y), bfhi(cw.y), bflo(cw.z), bfhi(cw.z), bflo(cw.w), bfhi(cw.w)};
#pragma unroll
                for (int i = 0; i < 8; ++i) { st[8 * c + i] = st[8 * c + i] * dA + dtx * bv[i]; yp += cv[i] * st[8 * c + i]; }
            }
            yp += __shfl_xor(yp, 1); yp += __shfl_xor(yp, 2);
            if (q == 0) {
                const float y = yp + dsk * xv;
                const float z = bf2f(Z[row * DI + h * 64 + p]);
                YZ[row * DI + h * 64 + p] = (bf16)f2bf(y * siluf_(z));
            }
        }
    }
}

__device__ __forceinline__ int swz256(int row, int chunk) { return row * 272 + (chunk << 4); }
__device__ __forceinline__ int swz128(int row, int chunk) { return row * 144 + (chunk << 4); }
__device__ __forceinline__ void p_ssd_fast(Frame& F) {
    const int lane = F.lane, r = lane & 31, hh = lane >> 5, lb = F.wave & 3, pb = F.wave >> 2, tid = F.tid;
    LAS unsigned char* Bimg = F.lds; LAS unsigned char* Cimg = F.lds + 34816; LAS unsigned char* Ximg = F.lds + 69632; LAS unsigned char* Xwimg = F.lds + 88064;
    LAS unsigned char* Simg = F.lds + 106496; LAS float* acs = (LAS float*)(F.lds + 123904); LAS float* dtv = (LAS float*)(F.lds + 124416);
    const bf16* CV = (const bf16*)(F.ws + WS_CONV); const float* DT = (const float*)(F.ws + WS_DT); bf16* Y = (bf16*)(F.ws + WS_YZ);
    const int q4 = (lane & 15) >> 2, blk16 = (lane >> 4) & 1, p4 = lane & 3;
    const f32x16 zero16 = {0.f, 0.f, 0.f, 0.f, 0.f, 0.f, 0.f, 0.f, 0.f, 0.f, 0.f, 0.f, 0.f, 0.f, 0.f, 0.f};
    for (int unit = F.blk; unit < BATCH * NH_SSM; unit += F.nblk) {
        const int b = unit / NH_SSM, h = unit % NH_SSM, g = h >> 3;
        const float a = -__expf(F.a_log[h]);
        f32x16 st = zero16;
        u32x4 rb[4], rc[4], rx[2]; float d0, d1;
#define SSD_LOAD(c) do { const size_t row0_ = (size_t)b * SEQ + (size_t)(c) * 128; \
            _Pragma("unroll") for (int i = 0; i < 4; ++i) { const int piece = tid + 512 * i, row = piece >> 4, ch = piece & 15; \
                rb[i] = *(const u32x4*)(CV + (row0_ + row) * CONVD + 2048 + g * 128 + ch * 8); rc[i] = *(const u32x4*)(CV + (row0_ + row) * CONVD + 2560 + g * 128 + ch * 8); } \
            _Pragma("unroll") for (int i = 0; i < 2; ++i) { const int piece = tid + 512 * i, row = piece >> 3, ch = piece & 7; rx[i] = *(const u32x4*)(CV + (row0_ + row) * CONVD + h * 64 + ch * 8); } \
            d0 = DT[(row0_ + lane) * 32 + h]; d1 = DT[(row0_ + 64 + lane) * 32 + h]; } while (0)
        SSD_LOAD(0);
        for (int c = 0; c < 16; ++c) {
            const size_t row0 = (size_t)b * SEQ + (size_t)c * 128;
            float x0 = d0 * a, x1 = d1 * a;
#pragma unroll
            for (int o = 1; o < 64; o <<= 1) { const float t0 = __shfl_up(x0, o), t1 = __shfl_up(x1, o); if (lane >= o) { x0 += t0; x1 += t1; } }
            x1 += __shfl(x0, 63);
            const float total = __shfl(x1, 63);
            __syncthreads();
            acs[lane] = x0; acs[64 + lane] = x1; dtv[lane] = d0; dtv[64 + lane] = d1;
#pragma unroll
            for (int i = 0; i < 4; ++i) { const int piece = tid + 512 * i, row = piece >> 4, ch = piece & 15;
                *(LAS u32x4*)(Bimg + swz256(row, ch)) = rb[i]; *(LAS u32x4*)(Cimg + swz256(row, ch)) = rc[i]; }
#pragma unroll
            for (int i = 0; i < 2; ++i) { const int piece = tid + 512 * i, row = piece >> 3, ch = piece & 7;
                const float w = __expf(total - acs[row]) * dtv[row];
                const u32x4 v = rx[i]; u32x4 o;
                o.x = pk2(bflo(v.x) * w, bfhi(v.x) * w); o.y = pk2(bflo(v.y) * w, bfhi(v.y) * w); o.z = pk2(bflo(v.z) * w, bfhi(v.z) * w); o.w = pk2(bflo(v.w) * w, bfhi(v.w) * w);
                *(LAS u32x4*)(Ximg + swz128(row, ch)) = v; *(LAS u32x4*)(Xwimg + swz128(row, ch)) = o; }
#pragma unroll
            for (int g4 = 0; g4 < 4; ++g4) { u32x2 w2; w2.x = pk2(st[4 * g4], st[4 * g4 + 1]); w2.y = pk2(st[4 * g4 + 2], st[4 * g4 + 3]);
                *(LAS u32x2*)(Simg + swz256(32 * pb + r, 4 * lb + g4) + 8 * hh) = w2; }
            __syncthreads();
            bf16x8_t cf[8];
#pragma unroll
            for (int kk = 0; kk < 8; ++kk) cf[kk] = *(const LAS bf16x8_t*)(Cimg + swz256(32 * lb + r, 2 * kk + hh));
            const float acs_l = acs[32 * lb + r];
            f32x16 yd = zero16;
            for (int sb = 0; sb <= lb; ++sb) {
                f32x16 gt = zero16;
#pragma unroll
                for (int kk = 0; kk < 8; ++kk) { const bf16x8_t bfm = *(const LAS bf16x8_t*)(Bimg + swz256(32 * sb + r, 2 * kk + hh)); gt = __builtin_amdgcn_mfma_f32_32x32x16_bf16(bfm, cf[kk], gt, 0, 0, 0); }
#pragma unroll
                for (int i = 0; i < 16; ++i) { const int s = 32 * sb + crow_(i, hh), l = 32 * lb + r;
                    const float e = __expf(fminf(acs_l - acs[s], 0.f)) * dtv[s];
                    gt[i] = (s <= l) ? gt[i] * e : 0.f; }
#pragma unroll
                for (int q = 0; q < 2; ++q) {
                    u32x4 pw; pw.x = pk2(gt[8 * q], gt[8 * q + 1]); pw.y = pk2(gt[8 * q + 2], gt[8 * q + 3]); pw.z = pk2(gt[8 * q + 4], gt[8 * q + 5]); pw.w = pk2(gt[8 * q + 6], gt[8 * q + 7]);
                    const bf16x8_t pa = __builtin_bit_cast(bf16x8_t, pw);
                    const int row_lo = 32 * sb + 16 * q + 4 * hh + q4, row_hi = row_lo + 8, chunk = 4 * pb + 2 * blk16 + (p4 >> 1), sub = (p4 & 1) * 8;
                    const s16x4_t lo = tr_read_(Ximg + swz128(row_lo, chunk) + sub), hi = tr_read_(Ximg + swz128(row_hi, chunk) + sub);
                    const bf16x8_t xf = (bf16x8_t){lo[0], lo[1], lo[2], lo[3], hi[0], hi[1], hi[2], hi[3]};
                    yd = __builtin_amdgcn_mfma_f32_32x32x16_bf16(pa, xf, yd, 0, 0, 0);
                }
            }
            f32x16 yo = zero16;
#pragma unroll
            for (int kk = 0; kk < 8; ++kk) { const bf16x8_t sf = *(const LAS bf16x8_t*)(Simg + swz256(32 * pb + r, 2 * kk + hh)); yo = __builtin_amdgcn_mfma_f32_32x32x16_bf16(cf[kk], sf, yo, 0, 0, 0); }
#pragma unroll
            for (int i = 0; i < 16; ++i) { const int l = 32 * lb + crow_(i, hh);
                const float y = yd[i] + __expf(acs[l]) * yo[i];
                Y[(row0 + l) * DI + h * 64 + 32 * pb + r] = (bf16)f2bf(y); }
            if (c + 1 < 16) SSD_LOAD(c + 1);
            const float cd = __expf(total);
#pragma unroll
            for (int i = 0; i < 16; ++i) st[i] *= cd;
#pragma unroll
            for (int kk = 0; kk < 8; ++kk) {
                const int row_lo = 16 * kk + 4 * hh + q4, row_hi = row_lo + 8, sub = (p4 & 1) * 8;
                const int chb = 4 * lb + 2 * blk16 + (p4 >> 1), chx = 4 * pb + 2 * blk16 + (p4 >> 1);
                const s16x4_t blo = tr_read_(Bimg + swz256(row_lo, chb) + sub), bhi = tr_read_(Bimg + swz256(row_hi, chb) + sub);
                const s16x4_t xlo = tr_read_(Xwimg + swz128(row_lo, chx) + sub), xhi = tr_read_(Xwimg + swz128(row_hi, chx) + sub);
                const bf16x8_t af = (bf16x8_t){blo[0], blo[1], blo[2], blo[3], bhi[0], bhi[1], bhi[2], bhi[3]};
                const bf16x8_t xf = (bf16x8_t){xlo[0], xlo[1], xlo[2], xlo[3], xhi[0], xhi[1], xhi[2], xhi[3]};
                st = __builtin_amdgcn_mfma_f32_32x32x16_bf16(af, xf, st, 0, 0, 0);
            }
        }
#undef SSD_LOAD
    }
    __syncthreads();
}
__device__ __forceinline__ void p_ypost2(Frame& F) {
    const int gw = F.blk * NWAVES + F.wave, NGW = F.nblk * NWAVES;
    const bf16* Y = (const bf16*)(F.ws + WS_YZ); const bf16* CV = (const bf16*)(F.ws + WS_CONV); const bf16* Z = (const bf16*)(F.ws + WS_Z); bf16* YN = (bf16*)(F.ws + WS_YN);
    for (int m = gw; m < T; m += NGW) {
#pragma unroll
        for (int g = 0; g < 4; ++g) {
            const int c0 = g * 512 + F.lane * 8;
            const float dsk = F.d_skip[c0 >> 6];
            const u32x4 yw = *(const u32x4*)(Y + (size_t)m * DI + c0), xw = *(const u32x4*)(CV + (size_t)m * CONVD + c0), zw = *(const u32x4*)(Z + (size_t)m * DI + c0);
            const float yv[8] = {bflo(yw.x), bfhi(yw.x), bflo(yw.y), bfhi(yw.y), bflo(yw.z), bfhi(yw.z), bflo(yw.w), bfhi(yw.w)};
            const float xv[8] = {bflo(xw.x), bfhi(xw.x), bflo(xw.y), bfhi(xw.y), bflo(xw.z), bfhi(xw.z), bflo(xw.w), bfhi(xw.w)};
            const float zv[8] = {bflo(zw.x), bfhi(zw.x), bflo(zw.y), bfhi(zw.y), bflo(zw.z), bfhi(zw.z), bflo(zw.w), bfhi(zw.w)};
            float v[8]; float s = 0.f;
#pragma unroll
            for (int i = 0; i < 8; ++i) { v[i] = (yv[i] + dsk * xv[i]) * siluf_(zv[i]); s += v[i] * v[i]; }
            const float rstd = 1.f / sqrtf(wave_sum(s) * (1.f / 512.f) + EPS);
            const float* nw = F.ssm_norm_w + c0;
            u32x4 o; o.x = pk2(v[0] * rstd * nw[0], v[1] * rstd * nw[1]); o.y = pk2(v[2] * rstd * nw[2], v[3] * rstd * nw[3]);
            o.z = pk2(v[4] * rstd * nw[4], v[5] * rstd * nw[5]); o.w = pk2(v[6] * rstd * nw[6], v[7] * rstd * nw[7]);
            *(u32x4*)(YN + (size_t)m * DI + c0) = o;
        }
    }
}

__device__ __forceinline__ void p_ypost(Frame& F) {
    const int gw = F.blk * NWAVES + F.wave, NGW = F.nblk * NWAVES;
    const bf16* YZ = (const bf16*)(F.ws + WS_YZ); bf16* YN = (bf16*)(F.ws + WS_YN);
    for (int m = gw; m < T; m += NGW) {
#pragma unroll
        for (int g = 0; g < 4; ++g) {
            const int c0 = g * 512 + F.lane * 8;
            const u32x4 w = *(const u32x4*)(YZ + (size_t)m * DI + c0);
            float v[8] = {bflo(w.x), bfhi(w.x), bflo(w.y), bfhi(w.y), bflo(w.z), bfhi(w.z), bflo(w.w), bfhi(w.w)};
            float s = 0.f;
#pragma unroll
            for (int i = 0; i < 8; ++i) s += v[i] * v[i];
            const float rstd = 1.f / sqrtf(wave_sum(s) * (1.f / 512.f) + EPS);
            const float* nw = F.ssm_norm_w + c0;
            u32x4 o; o.x = pk2(v[0] * rstd * nw[0], v[1] * rstd * nw[1]); o.y = pk2(v[2] * rstd * nw[2], v[3] * rstd * nw[3]);
            o.z = pk2(v[4] * rstd * nw[4], v[5] * rstd * nw[5]); o.w = pk2(v[6] * rstd * nw[6], v[7] * rstd * nw[7]);
            *(u32x4*)(YN + (size_t)m * DI + c0) = o;
        }
    }
}

__device__ __forceinline__ void p_router(Frame& F) {
    LAS int* hist = (LAS int*)F.lds;
    if (F.tid < 32) hist[F.tid] = 0;
    __syncthreads();
    int* ROWMAP = (int*)(F.ws + WS_ROWMAP);
    for (int i = F.blk * NTHREADS + F.tid; i < CAP; i += F.nblk * NTHREADS) ROWMAP[i] = -1;
    const int gw = F.blk * NWAVES + F.wave, NGW = F.nblk * NWAVES;
    bf16* XN2 = (bf16*)(F.ws + WS_XN2); int* TOPI = (int*)(F.ws + WS_TOPI); float* TOPW = (float*)(F.ws + WS_TOPW);
    for (int m = gw; m < T; m += NGW) {
        const f32x4* xr = (const f32x4*)(F.out + (size_t)m * D) + F.lane;
        const f32x4* wr = (const f32x4*)F.norm_ffn + F.lane;
        f32x4 v[4]; float s = 0.f;
#pragma unroll
        for (int j = 0; j < 4; ++j) { v[j] = xr[64 * j]; s += (v[j].x * v[j].x + v[j].y * v[j].y) + (v[j].z * v[j].z + v[j].w * v[j].w); }
        const float rstd = 1.f / sqrtf(wave_sum(s) * (1.f / D) + EPS);
        float lg[32];
#pragma unroll
        for (int e = 0; e < 32; ++e) lg[e] = 0.f;
#pragma unroll
        for (int j = 0; j < 4; ++j) {
            v[j] = v[j] * rstd * wr[64 * j];
            st_bf4(XN2 + (size_t)m * D + (F.lane + 64 * j) * 4, v[j]);
            const float hv[4] = {v[j].x, v[j].y, v[j].z, v[j].w};
#pragma unroll
            for (int i = 0; i < 4; ++i) {
                const f32x4* rw = (const f32x4*)(F.router_w + (size_t)((F.lane + 64 * j) * 4 + i) * 32);
#pragma unroll
                for (int c = 0; c < 8; ++c) { const f32x4 w = rw[c]; lg[4 * c] += hv[i] * w.x; lg[4 * c + 1] += hv[i] * w.y; lg[4 * c + 2] += hv[i] * w.z; lg[4 * c + 3] += hv[i] * w.w; }
            }
        }
#pragma unroll
        for (int e = 0; e < 32; ++e) lg[e] = wave_sum(lg[e]) + F.router_b[e];
        int bi[4]; float bv[4];
#pragma unroll
        for (int k = 0; k < 4; ++k) {
            float best = -INFINITY; int be = 0;
#pragma unroll
            for (int e = 0; e < 32; ++e) if (lg[e] > best) { best = lg[e]; be = e; }
            bi[k] = be; bv[k] = best;
#pragma unroll
            for (int e = 0; e < 32; ++e) if (e == be) lg[e] = -INFINITY;
        }
        const float e0 = 1.f, e1 = __expf(bv[1] - bv[0]), e2 = __expf(bv[2] - bv[0]), e3 = __expf(bv[3] - bv[0]);
        const float inv = 1.f / (e0 + e1 + e2 + e3);
        if (F.lane == 0) {
            *(int4*)(TOPI + (size_t)m * 4) = make_int4(bi[0], bi[1], bi[2], bi[3]);
            *(f32x4*)(TOPW + (size_t)m * 4) = (f32x4){e0 * inv, e1 * inv, e2 * inv, e3 * inv};
            atomicAdd((int*)&hist[bi[0]], 1); atomicAdd((int*)&hist[bi[1]], 1); atomicAdd((int*)&hist[bi[2]], 1); atomicAdd((int*)&hist[bi[3]], 1);
        }
    }
    __syncthreads();
    if (F.tid < 32) atomicAdd((unsigned*)(F.ctl + CW_CNT + 64 * F.tid), (unsigned)hist[F.tid]);
    __syncthreads();
}

__device__ __forceinline__ void p_slots(Frame& F) {
    LAS int* hist = (LAS int*)F.lds;
    LAS int* base = hist + 32;
    LAS int* pst = hist + 64;
    if (F.tid == 0) {
        int acc = 0;
        for (int e = 0; e < 32; ++e) { const int c = (int)__hip_atomic_load((unsigned*)(F.ctl + CW_CNT + 64 * e), __ATOMIC_RELAXED, __HIP_MEMORY_SCOPE_AGENT); pst[e] = acc; acc += (c + MOE_PAD - 1) / MOE_PAD * MOE_PAD; }
        pst[32] = acc;
    }
    __syncthreads();
    if (F.blk == 0) {
        int* TEXP = (int*)(F.ws + WS_SMALL);
        for (int i = F.tid; i < NT256; i += NTHREADS) { const int r = i * 256; int e = -1;
            for (int k = 0; k < 32; ++k) if (r >= pst[k] && r < pst[k + 1]) e = k;
            TEXP[i] = e; }
        if (F.tid == 0) TEXP[1024] = pst[32] / 256;
    }
    const int* TOPI = (const int*)(F.ws + WS_TOPI); int* SLOT = (int*)(F.ws + WS_SLOT); int* ROWMAP = (int*)(F.ws + WS_ROWMAP);
    for (int c = F.blk; c < T / 128; c += F.nblk) {
        if (F.tid < 32) hist[F.tid] = 0;
        __syncthreads();
        const int ai = c * 512 + F.tid;
        const int e = TOPI[ai];
        const int lr = atomicAdd((int*)&hist[e], 1);
        __syncthreads();
        if (F.tid < 32) base[F.tid] = (int)atomicAdd((unsigned*)(F.ctl + CW_CUR + 64 * F.tid), (unsigned)hist[F.tid]);
        __syncthreads();
        const int slot = pst[e] + base[e] + lr;
        SLOT[ai] = slot; ROWMAP[slot] = ai >> 2;
        __syncthreads();
    }
}

__device__ __forceinline__ void p_final(Frame& F) {
    const int gw = F.blk * NWAVES + F.wave, NGW = F.nblk * NWAVES;
    const int* SLOT = (const int*)(F.ws + WS_SLOT); const float* TOPW = (const float*)(F.ws + WS_TOPW); const bf16* YB = (const bf16*)(F.ws + WS_YB);
    for (int m = gw; m < T; m += NGW) {
        f32x4* xr = (f32x4*)(F.out + (size_t)m * D) + F.lane;
        const f32x4* wr = (const f32x4*)F.norm_final + F.lane;
        f32x4 v[4];
#pragma unroll
        for (int j = 0; j < 4; ++j) v[j] = xr[64 * j];
#pragma unroll
        for (int k = 0; k < 4; ++k) {
            const int sl = SLOT[m * 4 + k]; const float w = TOPW[m * 4 + k];
#pragma unroll
            for (int j = 0; j < 4; ++j) { const u32x2 y = *(const u32x2*)(YB + (size_t)sl * 1024 + (F.lane + 64 * j) * 4);
                v[j].x += w * bflo(y.x); v[j].y += w * bfhi(y.x); v[j].z += w * bflo(y.y); v[j].w += w * bfhi(y.y); }
        }
        float s = 0.f;
#pragma unroll
        for (int j = 0; j < 4; ++j) s += (v[j].x * v[j].x + v[j].y * v[j].y) + (v[j].z * v[j].z + v[j].w * v[j].w);
        const float rstd = 1.f / sqrtf(wave_sum(s) * (1.f / D) + EPS);
#pragma unroll
        for (int j = 0; j < 4; ++j) xr[64 * j] = v[j] * rstd * wr[64 * j];
    }
}

__global__ void __launch_bounds__(NTHREADS, 2) fwd(Args args) {
    extern __shared__ __attribute__((aligned(16))) unsigned char lds_raw[];
    Frame F;
    F.lds = (LAS unsigned char*)lds_raw;
    F.tid = threadIdx.x; F.lane = F.tid & 63; F.wave = __builtin_amdgcn_readfirstlane(F.tid >> 6);
    F.blk = blockIdx.x; F.nblk = gridDim.x;
    F.x = args.in[0]; F.w_in = args.in[1]; F.rel_bias = args.in[2]; F.w_ba = args.in[3]; F.conv_w = args.in[4]; F.conv_b = args.in[5];
    F.dt_bias = args.in[6]; F.a_log = args.in[7]; F.d_skip = args.in[8]; F.ssm_norm_w = args.in[9]; F.w_bs = args.in[10]; F.gate_bias = args.in[11];
    F.w_out = args.in[12]; F.norm_mix = args.in[13]; F.norm_ffn = args.in[14]; F.router_w = args.in[15]; F.router_b = args.in[16];
    F.w1 = args.in[17]; F.b1 = args.in[18]; F.w2 = args.in[19]; F.b2 = args.in[20]; F.norm_final = args.in[21];
    F.out = args.out; F.ws = args.ws; F.ctl = (gu32*)(args.ws + WS_CTL);
    volatile LAS unsigned* MISC = (volatile LAS unsigned*)(F.lds + MISC_OFF);
    if (F.tid < 32) MISC[F.tid] = 0u;
    __syncthreads();
    XcdBarrier bar; bar.bar = (unsigned*)(F.ctl + CW_BAR); bar.x = 0; bar.st = nullptr;
#if MK_FUSED
    bar = xcd_barrier_post((unsigned*)(F.ctl + CW_BAR), MISC + 8);
#define GRID_BAR() xcd_barrier(bar)
#else
#define GRID_BAR() do { } while (0)
#endif
    const int lo = args.ph_lo, hi = args.ph_hi;
#define IN(k) (lo <= (k) && (k) < hi)
#define SEAM(k) do { if (IN(k) && IN((k) + 1)) GRID_BAR(); } while (0)
    unsigned char* ws = F.ws;

    if (IN(0)) { p_rmsnorm_in(F); p_convert_small(F); } SEAM(0);
    if (IN(1)) {
#if FG_INPROJ
        pg8::Gemm g{(const bf16*)(ws + WS_XN), (const bf16*)(ws + WS_WIN_T), T, NPROJ_PAD, D}; pg8::StaticOrder S; S.init(T, NPROJ_PAD, F.nblk, F.blk);
        pg8::EpiInProjF E{ws, F.dt_bias, F.gate_bias};
        pg8::gemm_phase<pg8::EpiInProjF, pg8::StaticOrder, true, false, false>(F.lds, g, S, E, nullptr, nullptr, 0);
#else
        EpiInProj E{ws, F.dt_bias, F.gate_bias}; gemm_naive(F, T / 128, NPROJ, D, (const bf16*)(ws + WS_XN), D, nullptr, F.w_in, NPROJ, nullptr, 0, E);
#endif
    } SEAM(1);
#if FA_ATTN
    if (IN(2)) { p_attn_fast(F); } SEAM(2);
    if (IN(3)) { p_attn_merge(F); p_conv(F); } SEAM(3);
#else
    if (IN(2)) { p_attn_naive(F); } SEAM(2);
    if (IN(3)) { p_conv(F); } SEAM(3);
#endif
#if FS_SSD
    if (IN(4)) { p_ssd_fast(F); } SEAM(4);
    if (IN(5)) { p_ypost2(F); p_convert_moe(F); } SEAM(5);
#else
    if (IN(4)) { p_ssd_naive(F); } SEAM(4);
    if (IN(5)) { p_ypost(F); p_convert_moe(F); } SEAM(5);
#endif
    if (IN(6)) {
#if FG_MIX
        pg8::Gemm g{(const bf16*)(ws + WS_ATTN), (const bf16*)(ws + WS_WBA_T), T, D, 512}; pg8::StaticOrder S; S.init(T, D, F.nblk, F.blk);
        pg8::EpiM0F E{ws};
        pg8::gemm_phase<pg8::EpiM0F, pg8::StaticOrder, true, false, false>(F.lds, g, S, E, nullptr, nullptr, 0);
#else
        EpiM0 E{ws}; gemm_naive(F, T / 128, D, 512, (const bf16*)(ws + WS_ATTN), 512, nullptr, F.w_ba, D, nullptr, 0, E);
#endif
    } SEAM(6);
    if (IN(7)) {
#if FG_MIX
        pg8::Gemm g{(const bf16*)(ws + WS_YN), (const bf16*)(ws + WS_WBS_T), T, D, DI}; pg8::StaticOrder S; S.init(T, D, F.nblk, F.blk);
        pg8::EpiMergedF E{ws};
        pg8::gemm_phase<pg8::EpiMergedF, pg8::StaticOrder, true, false, false>(F.lds, g, S, E, nullptr, nullptr, 0);
#else
        EpiMerged E{ws}; gemm_naive(F, T / 128, D, DI, (const bf16*)(ws + WS_YN), DI, nullptr, F.w_bs, D, nullptr, 0, E);
#endif
    } SEAM(7);
    if (IN(8)) {
#if FG_MIX
        pg8::Gemm g{(const bf16*)(ws + WS_MERGED), (const bf16*)(ws + WS_WOUT_T), T, D, D}; pg8::StaticOrder S; S.init(T, D, F.nblk, F.blk);
        pg8::EpiX1F E{F.x, F.out};
        pg8::gemm_phase<pg8::EpiX1F, pg8::StaticOrder, true, false, false>(F.lds, g, S, E, nullptr, nullptr, 0);
#else
        EpiX1 E{F.x, F.out}; gemm_naive(F, T / 128, D, D, (const bf16*)(ws + WS_MERGED), D, nullptr, F.w_out, D, nullptr, 0, E);
#endif
    } SEAM(8);
    if (IN(9)) { p_router(F); } SEAM(9);
    if (IN(10)) { p_slots(F); } SEAM(10);
    if (IN(11)) {
#if FG_MOE
        const int* texp = (const int*)(ws + WS_SMALL); const int ntile = texp[1024];
        pg8::Gemm g{(const bf16*)(ws + WS_XN2), (const bf16*)(ws + WS_W1T), CAP, 2048, D}; pg8::MoeOrder S; S.init(ntile, 8, F.nblk, F.blk);
        pg8::EpiMoe1F E{ws, F.b1, texp};
        pg8::gemm_phase<pg8::EpiMoe1F, pg8::MoeOrder, true, true, true>(F.lds, g, S, E, (const int*)(ws + WS_ROWMAP), texp, (size_t)2048 * 1024 * 2);
#else
        EpiMoe1 E{ws, F.b1}; gemm_naive(F, CAP / 128, 2048, D, (const bf16*)(ws + WS_XN2), D, (const int*)(ws + WS_ROWMAP), F.w1, 2048, (const int*)(ws + WS_SMALL), (size_t)1024 * 2048, E);
#endif
    } SEAM(11);
    if (IN(12)) {
#if FG_MOE
        const int* texp = (const int*)(ws + WS_SMALL); const int ntile = texp[1024];
        pg8::Gemm g{(const bf16*)(ws + WS_ACT), (const bf16*)(ws + WS_W2T), CAP, 1024, 1024}; pg8::MoeOrder S; S.init(ntile, 4, F.nblk, F.blk);
        pg8::EpiMoe2F E{ws, F.b2, texp};
        pg8::gemm_phase<pg8::EpiMoe2F, pg8::MoeOrder, true, false, true>(F.lds, g, S, E, nullptr, texp, (size_t)1024 * 1024 * 2);
#else
        EpiMoe2 E{ws, F.b2}; gemm_naive(F, CAP / 128, 1024, 1024, (const bf16*)(ws + WS_ACT), 1024, nullptr, F.w2, 1024, (const int*)(ws + WS_SMALL), (size_t)1024 * 1024, E);
#endif
    } SEAM(12);
    if (IN(13)) { p_final(F); }
#undef IN
#undef SEAM
}

extern "C" void kernel_launch(void* const* d_in, const int* in_sizes, int n_in, void* d_out, int out_size, void* d_ws, size_t ws_size, hipStream_t stream) {
    static int grid = 0;
    if (grid == 0) {
        if (n_in != 22 || out_size != T * D || ws_size < WS_END) { fprintf(stderr, "kernel_launch: unexpected shapes: n_in %d out %d ws %zu\n", n_in, out_size, ws_size); grid = -1; return; }
        int dev = 0, cus = 0, per_cu = 0;
        if (hipGetDevice(&dev) != hipSuccess || hipDeviceGetAttribute(&cus, hipDeviceAttributeMultiprocessorCount, dev) != hipSuccess) { grid = -1; return; }
        if (hipFuncSetAttribute((const void*)fwd, hipFuncAttributeMaxDynamicSharedMemorySize, LDS_BYTES) != hipSuccess) { fprintf(stderr, "kernel_launch: hipFuncSetAttribute failed\n"); grid = -1; return; }
        if (hipOccupancyMaxActiveBlocksPerMultiprocessor(&per_cu, (const void*)fwd, NTHREADS, LDS_BYTES) != hipSuccess || per_cu < 1) fprintf(stderr, "kernel_launch: occupancy query says %d\n", per_cu);
        (void)hipGetLastError();
        grid = cus;
    }
    if (grid < 0) return;
    (void)hipMemsetAsync((char*)d_ws + WS_CTL, 0, CTL_ZERO_BYTES, stream);
    Args a{};
    for (int i = 0; i < 22; ++i) a.in[i] = (const float*)d_in[i];
    a.out = (float*)d_out; a.ws = (unsigned char*)d_ws;
#if MK_FUSED
    a.ph_lo = 0; a.ph_hi = NPHASE; a.li = 0;
    hipLaunchKernelGGL(fwd, dim3(grid), dim3(NTHREADS), LDS_BYTES, stream, a);
#else
    for (int p = 0; p < NPHASE; ++p) { a.ph_lo = p; a.ph_hi = p + 1; a.li = p; hipLaunchKernelGGL(fwd, dim3(grid), dim3(NTHREADS), LDS_BYTES, stream, a); }
#endif
}
```

```cpp
#include <hip/hip_runtime.h>
#include <cstdio>
#include <cstdint>

#ifndef MK_FUSED
#define MK_FUSED 1
#endif

#ifndef FG_INPROJ
#define FG_INPROJ 1
#endif
#ifndef PROBE_DUP
#define PROBE_DUP (-1)
#endif
#ifndef STAGGER_TICKS
#define STAGGER_TICKS 0
#endif
#ifndef SSD_REP_A
#define SSD_REP_A 1
#endif
#ifndef SSD_REP_W
#define SSD_REP_W 1
#endif
#ifndef PROBE_TIME
#define PROBE_TIME (-1)
#endif
#ifndef PROBE_SEC
#define PROBE_SEC (-1)
#endif
#ifndef FA_ATTN
#define FA_ATTN 1
#endif
#ifndef FS_SSD
#define FS_SSD 1
#endif
#ifndef MOE_FP8
#define MOE_FP8 1
#endif
#ifndef QKV_FP8
#define QKV_FP8 1
#endif
#ifndef QKV_STORE_FP8
#define QKV_STORE_FP8 1
#endif
#ifndef TAILFILL
#define TAILFILL 1
#endif
#ifndef FG_MIX
#define FG_MIX 1
#endif
#ifndef FG_MOE
#define FG_MOE 1
#endif
#define GAS __attribute__((address_space(1)))
#define LAS __attribute__((address_space(3)))
typedef unsigned short bf16;
typedef float f32x4 __attribute__((ext_vector_type(4)));
typedef unsigned u32x4 __attribute__((ext_vector_type(4)));
typedef unsigned u32x2 __attribute__((ext_vector_type(2)));
typedef GAS unsigned gu32;

constexpr int BATCH = 16, SEQ = 2048, D = 1024, T = BATCH * SEQ;
constexpr int NPROJ = 11808;
constexpr int AW = 1536;
constexpr int DI = 2048;
constexpr int CONVD = 3072;
constexpr int NH_SSM = 32, NG_SSM = 4, DSTATE = 128;
constexpr int NEXP = 32, TOPK = 4, NASSIGN = T * TOPK;
constexpr int MOE_PAD = 256;
constexpr int CAP = NASSIGN + NEXP * MOE_PAD;
constexpr int NT256 = CAP / 256;
constexpr float EPS = 1e-5f;
constexpr int C_Q = 0, C_K = 1536, C_V = 3072, C_Z = 4608, C_XBC = 6656, C_DT = 9728, C_GATE = 9760;

constexpr size_t MiB = 1u << 20;
constexpr size_t WS_CTL = 0, CTL_ZERO_BYTES = 1 * MiB;
constexpr size_t WS_SMALL = 1 * MiB;
constexpr size_t WS_XN = 34 * MiB;
constexpr size_t WS_Q = 98 * MiB, WS_K = 194 * MiB, WS_V = 290 * MiB;
constexpr size_t WS_Z = 386 * MiB;
constexpr size_t WS_XBC = 514 * MiB;
constexpr size_t WS_GATE = 706 * MiB;
constexpr size_t WS_DT = 834 * MiB;
constexpr size_t WS_ATTN = 838 * MiB;
constexpr size_t WS_M0 = 870 * MiB;
constexpr size_t WS_CONV = WS_K;
constexpr size_t WS_YZ = WS_XBC;
constexpr size_t WS_YN = WS_Z;
constexpr size_t WS_MERGED = WS_XN;
constexpr size_t WS_XN2 = WS_Q;
constexpr size_t WS_TOPI = 162 * MiB;
constexpr size_t WS_TOPW = 163 * MiB;
constexpr size_t WS_SLOT = 164 * MiB;
constexpr size_t WS_ROWMAP = 165 * MiB;
constexpr size_t WS_ACT = 386 * MiB;
constexpr size_t WS_YB = 658 * MiB;
constexpr size_t WS_WIN_T = 2 * MiB;
constexpr size_t WS_WBA_T = 26 * MiB;
constexpr size_t WS_WBS_T = 27 * MiB;
constexpr size_t WS_WOUT_T = 31 * MiB;
constexpr size_t WS_W1T = 194 * MiB;
constexpr size_t WS_W2T = 322 * MiB;
constexpr int NPROJ_PAD = 12032;
constexpr size_t WS_OUTG = 870 * MiB;
constexpr size_t WS_LSE = 966 * MiB;
constexpr size_t WS_BT = 1 * MiB + 65536;
constexpr float FP8_ASCALE = 4.f, FP8_WSCALE = 64.f;
constexpr size_t WS_WRT = 1 * MiB + 131072;
constexpr size_t WS_XNQ = 870 * MiB;
constexpr size_t WS_WQKVQ = 998 * MiB;
constexpr size_t WS_END = 1024 * MiB;
constexpr int CW_TMO = 0;
constexpr int CW_BAR = 4096;
constexpr int CW_CNT = 16384;
constexpr int CW_CUR = 16384 + 64 * 32;

constexpr int NWAVES = 8, NTHREADS = 512;
constexpr int LDS_BYTES = 147456;
constexpr int MISC_OFF = LDS_BYTES - 256;

constexpr int NPHASE = 14;

__device__ __forceinline__ unsigned f2bf(float f) { unsigned u = __builtin_bit_cast(unsigned, f); return (u + 0x7fffu + ((u >> 16) & 1u)) >> 16; }

typedef float f32x2_t __attribute__((ext_vector_type(2))); typedef __bf16 bf16x2_t __attribute__((ext_vector_type(2)));
__device__ __forceinline__ unsigned cvtpk(float lo, float hi) { const f32x2_t v = {lo, hi}; const bf16x2_t b = __builtin_convertvector(v, bf16x2_t); return __builtin_bit_cast(unsigned, b); }
__device__ __forceinline__ unsigned pk2(float lo, float hi) { return cvtpk(lo, hi); }
__device__ __forceinline__ unsigned pk_fp8x4(float a, float b, float c, float d) { int w = __builtin_amdgcn_cvt_pk_fp8_f32(a, b, 0, false); w = __builtin_amdgcn_cvt_pk_fp8_f32(c, d, w, true); return (unsigned)w; }
__device__ __forceinline__ unsigned fp8x2_to_bf16x2(unsigned w, bool hi) { const f32x2_t f = hi ? __builtin_amdgcn_cvt_pk_f32_fp8((int)w, true) : __builtin_amdgcn_cvt_pk_f32_fp8((int)w, false); return cvtpk(f.x, f.y); }
__device__ __forceinline__ u32x4 fp8x8_to_bf16x8(unsigned lo, unsigned hi) { u32x4 o; o.x = fp8x2_to_bf16x2(lo, false); o.y = fp8x2_to_bf16x2(lo, true); o.z = fp8x2_to_bf16x2(hi, false); o.w = fp8x2_to_bf16x2(hi, true); return o; }
__device__ __forceinline__ float bflo(unsigned u) { return __builtin_bit_cast(float, u << 16); }
__device__ __forceinline__ float bfhi(unsigned u) { return __builtin_bit_cast(float, u & 0xffff0000u); }
__device__ __forceinline__ float bf2f(bf16 b) { return __builtin_bit_cast(float, (unsigned)b << 16); }
__device__ __forceinline__ float wave_sum(float v) {
#pragma unroll
    for (int o = 1; o < 64; o <<= 1) v += __shfl_xor(v, o);
    return v;
}
#define LDS_BARRIER() do { asm volatile("s_waitcnt lgkmcnt(0)" ::: "memory"); __builtin_amdgcn_s_barrier(); asm volatile("" ::: "memory"); } while (0)
__device__ __forceinline__ float sigmoidf_(float x) { return __builtin_amdgcn_rcpf(1.f + __expf(-x)); }
__device__ __forceinline__ float siluf_(float x) { return x * __builtin_amdgcn_rcpf(1.f + __expf(-x)); }
__device__ __forceinline__ float softplusf_(float x) { return fmaxf(x, 0.f) + __logf(1.f + __expf(-fabsf(x))); }

#define XB_TMO      128
#define XB_XCNT(j)  (256  + 64 * (j))
#define XB_XSUB(j)  (1280 + 64 * (j))
#define XB_XGEN(j)  (2304 + 64 * (j))
#define XB_TOP      3328
#define XB_TOPGEN   3392
#define XCD_BAR_WORDS 3456
#define XB_SPIN_CAP (1u << 18)
__device__ __forceinline__ unsigned xb_ld(unsigned* p)              { return __hip_atomic_load(p, __ATOMIC_RELAXED, __HIP_MEMORY_SCOPE_AGENT); }
__device__ __forceinline__ unsigned xb_add(unsigned* p, unsigned v) { return __hip_atomic_fetch_add(p, v, __ATOMIC_RELAXED, __HIP_MEMORY_SCOPE_AGENT); }
__device__ __forceinline__ unsigned xb_xcc_id() { return (unsigned)__builtin_amdgcn_s_getreg((3 << 11) | 20) & 0xFu; }
#define XB_SPIN(cond, bar) do { unsigned _sp = 0; while (cond) { __builtin_amdgcn_s_sleep(1); \
    if ((++_sp & 255u) == 0u) { if (xb_ld(&(bar)[XB_TMO])) break; if (_sp > XB_SPIN_CAP) { atomicAdd(&(bar)[XB_TMO], 1u); break; } } } } while (0)
struct XcdBarrier { unsigned* bar; unsigned x; volatile LAS unsigned* st; };
__device__ __forceinline__ XcdBarrier xcd_barrier_post(unsigned* bar, volatile LAS unsigned* st) {
    XcdBarrier b; b.bar = bar; b.x = xb_xcc_id(); b.st = st;
    if (threadIdx.x == 0) (void)xb_add(&bar[XB_XCNT(b.x)], 1u);
    return b;
}
__device__ __forceinline__ void xcd_barrier_complete(unsigned* bar, unsigned x, unsigned& nloc, unsigned& nx) {
    const unsigned G = gridDim.x * gridDim.y * gridDim.z;
    unsigned sum, cnt, mine, sp = 0u;
    for (;;) {
        sum = 0u; cnt = 0u; mine = 0u;
#pragma unroll
        for (unsigned j = 0; j < 16; ++j) { const unsigned c = xb_ld(&bar[XB_XCNT(j)]); sum += c; cnt += (c > 0u) ? 1u : 0u; mine = (j == x) ? c : mine; }
        if (sum == G) break;
        __builtin_amdgcn_s_sleep(1);
        if ((++sp & 255u) == 0u) { if (xb_ld(&bar[XB_TMO])) break; if (sp > XB_SPIN_CAP) { atomicAdd(&bar[XB_TMO], 1u); break; } }
    }
    nloc = mine > 0u ? mine : 1u; nx = cnt > 0u ? cnt : 1u;
}
__device__ __forceinline__ void xcd_barrier(const XcdBarrier& b) {
    asm volatile("s_waitcnt vmcnt(0)" ::: "memory");
    __syncthreads();
    if (threadIdx.x == 0) {
        unsigned* bar = b.bar;
        __builtin_amdgcn_s_waitcnt(0);
        unsigned nloc = b.st[0], nx = b.st[1];
        if (nloc == 0u) { xcd_barrier_complete(bar, b.x, nloc, nx); b.st[0] = nloc; b.st[1] = nx; }
        const unsigned old = xb_add(&bar[XB_XSUB(b.x)], 1u);
        const unsigned gen = old / nloc;
        if (old + 1u == (gen + 1u) * nloc) {
            __builtin_amdgcn_fence(__ATOMIC_RELEASE, "agent");
            asm volatile("s_waitcnt vmcnt(0)" ::: "memory");
            const unsigned og = xb_add(&bar[XB_TOP], 1u);
            const unsigned tg = og / nx;
            if (og + 1u == (tg + 1u) * nx) xb_add(&bar[XB_TOPGEN], 1u);
            else XB_SPIN(xb_ld(&bar[XB_TOPGEN]) == tg, bar);
            __builtin_amdgcn_fence(__ATOMIC_ACQUIRE, "agent");
            xb_add(&bar[XB_XGEN(b.x)], 1u);
            asm volatile("s_waitcnt vmcnt(0)" ::: "memory");
        } else {
            XB_SPIN(xb_ld(&bar[XB_XGEN(b.x)]) == gen, bar);
            __builtin_amdgcn_fence(__ATOMIC_ACQUIRE, "agent");
            asm volatile("s_waitcnt vmcnt(0)" ::: "memory");
        }
    }
    __syncthreads();
}

struct Args { const float* in[22]; float* out; unsigned char* ws; int ph_lo, ph_hi, li, pad; };

struct Frame {
    LAS unsigned char* lds;
    int tid, lane, wave, blk, nblk;
    const float *x, *w_in, *rel_bias, *w_ba, *conv_w, *conv_b, *dt_bias, *a_log, *d_skip, *ssm_norm_w, *w_bs, *gate_bias, *w_out,
                *norm_mix, *norm_ffn, *router_w, *router_b, *w1, *b1, *w2, *b2, *norm_final;
    float* out; unsigned char* ws; gu32* ctl;
};

template <class Epi>
__device__ __forceinline__ void gemm_naive(Frame& F, int nMt, int N, int K, const bf16* A, int lda, const int* rowmap,
                                           const float* B, int ldb, const int* texp, size_t estride, const Epi& epi) {
    LAS float* As = (LAS float*)F.lds;
    LAS float* Bs = As + 16 * 132;
    const int tid = ((int)threadIdx.x), tx = tid & 31, ty = tid >> 5;
    const int nNt = (N + 127) / 128;
    const int ar = tid >> 2, ak = (tid & 3) * 4;
    const int bk = tid >> 5, bn = (tid & 31) * 4;
    for (int tile = F.blk; tile < nMt * nNt; tile += F.nblk) {
        const int mt = tile / nNt, nt = tile % nNt;
        int e = 0;
        if (texp) { e = texp[mt >> 1]; if (e < 0) continue; }
        const float* Bp = B + (size_t)e * estride;
        float acc[8][4];
#pragma unroll
        for (int i = 0; i < 8; ++i)
#pragma unroll
            for (int j = 0; j < 4; ++j) acc[i][j] = 0.f;
        int grow = mt * 128 + ar; if (rowmap) grow = rowmap[grow];
        const bf16* ap = A + (size_t)(grow < 0 ? 0 : grow) * lda + ak;
        const bool aok = grow >= 0;
        const int gcol = nt * 128 + bn;
        const bool bok = gcol < N;
        for (int k0 = 0; k0 < K; k0 += 16) {
            u32x2 av = (u32x2){0u, 0u};
            if (aok) av = *(const u32x2*)(ap + k0);
            f32x4 bv = (f32x4){0.f, 0.f, 0.f, 0.f};
            if (bok) bv = *(const f32x4*)(Bp + (size_t)(k0 + bk) * ldb + gcol);
            __syncthreads();
            As[(ak + 0) * 132 + ar] = bflo(av.x); As[(ak + 1) * 132 + ar] = bfhi(av.x);
            As[(ak + 2) * 132 + ar] = bflo(av.y); As[(ak + 3) * 132 + ar] = bfhi(av.y);
            *(LAS f32x4*)&Bs[bk * 132 + bn] = bv;
            __syncthreads();
#pragma unroll
            for (int k = 0; k < 16; ++k) {
                const f32x4 a0 = *(const LAS f32x4*)&As[k * 132 + ty * 8], a1 = *(const LAS f32x4*)&As[k * 132 + ty * 8 + 4];
                const f32x4 b = *(const LAS f32x4*)&Bs[k * 132 + tx * 4];
                const float a[8] = {a0.x, a0.y, a0.z, a0.w, a1.x, a1.y, a1.z, a1.w};
                const float bb[4] = {b.x, b.y, b.z, b.w};
#pragma unroll
                for (int i = 0; i < 8; ++i)
#pragma unroll
                    for (int j = 0; j < 4; ++j) acc[i][j] = fmaf(a[i], bb[j], acc[i][j]);
            }
        }
        const int col0 = nt * 128 + tx * 4;
        if (col0 < N) {
#pragma unroll
            for (int i = 0; i < 8; ++i) epi(mt * 128 + ty * 8 + i, col0, (f32x4){acc[i][0], acc[i][1], acc[i][2], acc[i][3]}, e);
        }
    }
    __syncthreads();
}

__device__ __forceinline__ void st_bf4(bf16* p, f32x4 v) { u32x2 w; w.x = pk2(v.x, v.y); w.y = pk2(v.z, v.w); *(u32x2*)p = w; }

struct EpiInProj {
    unsigned char* ws; const float* dt_bias; const float* gate_bias;
    __device__ __forceinline__ void operator()(int row, int col, f32x4 v, int) const {
        if (col < C_K)        st_bf4((bf16*)(ws + WS_Q) + (size_t)row * AW + (col - C_Q), v);
        else if (col < C_V)   st_bf4((bf16*)(ws + WS_K) + (size_t)row * AW + (col - C_K), v);
        else if (col < C_Z)   st_bf4((bf16*)(ws + WS_V) + (size_t)row * AW + (col - C_V), v);
        else if (col < C_XBC) st_bf4((bf16*)(ws + WS_Z) + (size_t)row * DI + (col - C_Z), v);
        else if (col < C_DT)  st_bf4((bf16*)(ws + WS_XBC) + (size_t)row * CONVD + (col - C_XBC), v);
        else if (col < C_GATE) { const int c = col - C_DT; f32x4 o;
            o.x = softplusf_(v.x + dt_bias[c]); o.y = softplusf_(v.y + dt_bias[c + 1]); o.z = softplusf_(v.z + dt_bias[c + 2]); o.w = softplusf_(v.w + dt_bias[c + 3]);
            float* dp = (float*)(ws + WS_DT) + row; dp[(size_t)c * T] = o.x; dp[(size_t)(c + 1) * T] = o.y; dp[(size_t)(c + 2) * T] = o.z; dp[(size_t)(c + 3) * T] = o.w; }
        else { const int c = col - C_GATE; f32x4 o;
            o.x = sigmoidf_(v.x + gate_bias[c]); o.y = sigmoidf_(v.y + gate_bias[c + 1]); o.z = sigmoidf_(v.z + gate_bias[c + 2]); o.w = sigmoidf_(v.w + gate_bias[c + 3]);
            st_bf4((bf16*)(ws + WS_GATE) + (size_t)row * 2048 + c, o); }
    }
};
struct EpiM0 {
    unsigned char* ws;
    __device__ __forceinline__ void operator()(int row, int col, f32x4 v, int) const {
        const u32x2 g = *(const u32x2*)((const bf16*)(ws + WS_GATE) + (size_t)row * 2048 + col);
        f32x4 o; o.x = v.x * bflo(g.x); o.y = v.y * bfhi(g.x); o.z = v.z * bflo(g.y); o.w = v.w * bfhi(g.y);
        st_bf4((bf16*)(ws + WS_M0) + (size_t)row * D + col, o);
    }
};
struct EpiMerged {
    unsigned char* ws;
    __device__ __forceinline__ void operator()(int row, int col, f32x4 v, int) const {
        const u32x2 g = *(const u32x2*)((const bf16*)(ws + WS_GATE) + (size_t)row * 2048 + 1024 + col);
        const u32x2 mw = *(const u32x2*)((const bf16*)(ws + WS_M0) + (size_t)row * D + col); const f32x4 m = (f32x4){bflo(mw.x), bfhi(mw.x), bflo(mw.y), bfhi(mw.y)};
        f32x4 o; o.x = m.x + v.x * bflo(g.x); o.y = m.y + v.y * bfhi(g.x); o.z = m.z + v.z * bflo(g.y); o.w = m.w + v.w * bfhi(g.y);
        st_bf4((bf16*)(ws + WS_MERGED) + (size_t)row * D + col, o);
    }
};
struct EpiX1 {
    const float* x; float* out;
    __device__ __forceinline__ void operator()(int row, int col, f32x4 v, int) const {
        const f32x4 xv = *(const f32x4*)(x + (size_t)row * D + col);
        *(f32x4*)(out + (size_t)row * D + col) = xv + v;
    }
};
__device__ __forceinline__ float swiglu_(float g, float l) {
    g = fminf(g, 7.f); l = fminf(fmaxf(l, -7.f), 7.f);
    return g * sigmoidf_(1.702f * g) * (l + 1.f);
}
struct EpiMoe1 {
    unsigned char* ws; const float* b1;
    __device__ __forceinline__ void operator()(int row, int col, f32x4 v, int e) const {
        const f32x4 b = *(const f32x4*)(b1 + (size_t)e * 2048 + col);
        const float o0 = swiglu_(v.x + b.x, v.y + b.y), o1 = swiglu_(v.z + b.z, v.w + b.w);
        *(unsigned*)((bf16*)(ws + WS_ACT) + (size_t)row * 1024 + (col >> 1)) = pk2(o0, o1);
    }
};
struct EpiMoe2 {
    unsigned char* ws; const float* b2;
    __device__ __forceinline__ void operator()(int row, int col, f32x4 v, int e) const {
        const f32x4 b = *(const f32x4*)(b2 + (size_t)e * 1024 + col);
        st_bf4((bf16*)(ws + WS_YB) + (size_t)row * 1024 + col, v + b);
    }
};

namespace pg8 {
typedef short bf16x8 __attribute__((ext_vector_type(8)));
typedef long i64x2 __attribute__((ext_vector_type(2)));
constexpr int BM = 256, BK = 64, HALF = 128, HTB = HALF * BK * 2, STAGE_BYTES = 8 * HTB, NXCD = 8, WGM = 8;
__host__ __device__ __forceinline__ int lds_byte(int r, int c) { const int st = (r >> 4) * 2 + (c >> 5), rr = r & 15, cc = c & 31, ob = rr * 64 + cc * 2; return st * 1024 + (ob ^ (((ob >> 9) & 1) << 5)); }
__host__ __device__ __forceinline__ void stage_rc(int b, int& R, int& C) { const int st = b / 1024, sb = b % 1024, swz = sb ^ (((sb >> 9) & 1) << 5); R = (st >> 1) * 16 + swz / 64; C = (st & 1) * 32 + (swz % 64) / 2; }
__host__ __device__ __forceinline__ int perm32(int rho) { const int n = rho >> 4, i = rho & 15; return 8 * (i >> 2) + 4 * n + (i & 3); }
struct Unit { int pm, pn; };
struct Gemm { const bf16* A; const bf16* Bt; int M, N, K; };
struct StaticOrder {
    int nM, nN, nwg, G, c;
    __host__ __device__ void init(int M, int N, int G_, int c_) { nM = M / BM; nN = N / BM; nwg = nM * nN; G = G_; c = c_; }
    __host__ __device__ bool next(int i, Unit& u) const {
        const long L = (long)i * G + c; if (L >= nwg) return false;
        int wgid = (int)L; { const int q = nwg / NXCD, r = nwg % NXCD, xcd = wgid % NXCD, off = wgid / NXCD; wgid = (xcd < r ? xcd * (q + 1) : r * (q + 1) + (xcd - r) * q) + off; }
        const int nig = WGM * nN, gid = wgid / nig, fm = gid * WGM, gsz = (nM - fm) < WGM ? (nM - fm) : WGM;
        u.pm = fm + ((wgid % nig) % gsz); u.pn = (wgid % nig) / gsz; return true;
    }
    __device__ __forceinline__ void a_ready(const Unit&) const {}
    __device__ __forceinline__ void done(const Unit&) const {}
};
struct MoeOrder {
    int nwg, nN, G, c;
    __device__ void init(int ntile, int nN_, int G_, int c_) { nN = nN_; nwg = ntile * nN_; G = G_; c = c_; }
    __device__ bool next(int i, Unit& u) const { const long L = (long)i * G + c; if (L >= nwg) return false; u.pm = (int)L / nN; u.pn = (int)L % nN; return true; }
    __device__ __forceinline__ void a_ready(const Unit&) const {}
    __device__ __forceinline__ void done(const Unit&) const {}
};
__device__ __forceinline__ unsigned cvt_pk_bf16(float lo, float hi) { unsigned r; asm volatile("v_cvt_pk_bf16_f32 %0, %1, %2" : "=v"(r) : "v"(lo), "v"(hi)); return r; }

template <class Epi, class Sched, bool ALIGN_EPI, bool GATHER, bool EXPERT, bool FP8 = false>
__device__ __forceinline__ void gemm_phase(LAS unsigned char* lds, const Gemm g, const Sched& S, const Epi& E, const int* rowmap, const int* texp, size_t bstride) {
    const int tid = threadIdx.x, wid = __builtin_amdgcn_readfirstlane(tid >> 6), lane = tid & 63, wr = wid >> 2, wc = wid & 3, fr = lane & 15, fq = lane >> 4;
    const int K = g.K, nt = K / BK;
    unsigned voffA[2], voffB[2], voffB1[2]; int RA[2]; unsigned CAb[2];
#pragma unroll
    for (int i = 0; i < 2; ++i) { int R, C; stage_rc(tid * 16 + i * 8192, R, C); const int Rb = Epi::PERM ? ((R & ~31) + perm32(R & 31)) : R;
        voffA[i] = (unsigned)(R * K + C) * 2u; voffB[i] = (unsigned)(Rb * K + C) * 2u; voffB1[i] = voffB[i] + (unsigned)(HALF * K * 2); RA[i] = R; CAb[i] = (unsigned)C * 2u;
        if constexpr (Epi::WIDE) {
            voffB[i] = (unsigned)((64 * (R >> 5) + perm32(R & 31)) * K + C) * 2u; voffB1[i] = (unsigned)((64 * (R >> 5) + 32 + perm32(R & 31)) * K + C) * 2u; } }
    const size_t kstep = (size_t)(BK * 2);
    const size_t hstep = (size_t)HALF * K * 2;
    const size_t tstep = 2 * hstep;
    const size_t ahs = GATHER ? 0 : hstep;
    const unsigned ldsw = (unsigned)wid * 1024u;
    const int aoff = lds_byte(wr * 64 + fr, fq * 8), boff = lds_byte(wc * 32 + fr, fq * 8);
#define PG8_SA(b, h) (((b) * 2 + (h)) * HTB)
#define PG8_SB(b, h) ((4 + (b) * 2 + (h)) * HTB)
#define PG8_STAGE(bufoff, gbase, voff) do { _Pragma("unroll") for (int _i = 0; _i < 2; ++_i) \
        __builtin_amdgcn_global_load_lds((const unsigned*)((const char*)(gbase) + (voff)[_i]), (LAS unsigned*)(lds + (bufoff) + ldsw + _i * 8192), 16, 0, 0); } while (0)
#define PG8_LDA(dst, b, h) do { _Pragma("unroll") for (int m = 0; m < 4; ++m) _Pragma("unroll") for (int k = 0; k < 2; ++k) dst[m][k] = *(const LAS bf16x8*)(lds + PG8_SA(b, h) + aoff + m * 2048 + k * 1024); } while (0)
#define PG8_LDB(dst, b, h) do { _Pragma("unroll") for (int n = 0; n < 2; ++n) _Pragma("unroll") for (int k = 0; k < 2; ++k) dst[n][k] = *(const LAS bf16x8*)(lds + PG8_SB(b, h) + boff + n * 2048 + k * 1024); } while (0)
#define PG8_MMA(ai, bj, At, Bt) do { __builtin_amdgcn_s_setprio(1); _Pragma("unroll") for (int m = 0; m < 4; ++m) _Pragma("unroll") for (int n = 0; n < 2; ++n) _Pragma("unroll") for (int k = 0; k < 2; ++k) { \
        if constexpr (FP8) { const i64x2 b_ = __builtin_bit_cast(i64x2, Bt[n][k]), a_ = __builtin_bit_cast(i64x2, At[m][k]);     \
            acc[ai][bj][m][n] = __builtin_amdgcn_mfma_f32_16x16x32_fp8_fp8(b_[0], a_[0], acc[ai][bj][m][n], 0, 0, 0); acc[ai][bj][m][n] = __builtin_amdgcn_mfma_f32_16x16x32_fp8_fp8(b_[1], a_[1], acc[ai][bj][m][n], 0, 0, 0); } \
        else acc[ai][bj][m][n] = __builtin_amdgcn_mfma_f32_16x16x32_bf16(Bt[n][k], At[m][k], acc[ai][bj][m][n], 0, 0, 0); } __builtin_amdgcn_s_setprio(0); } while (0)
#define PG8_WAIT_V(n) asm volatile("s_waitcnt vmcnt(" #n ")" ::: "memory")
#define PG8_WAIT_L(n) asm volatile("s_waitcnt lgkmcnt(" #n ")" ::: "memory")
#define PG8_BAR __builtin_amdgcn_s_barrier()
#define PG8_SCHED __builtin_amdgcn_sched_barrier(0)
#define PG8_ROWS(u, v) do { _Pragma("unroll") for (int _h = 0; _h < 2; ++_h) _Pragma("unroll") for (int _i = 0; _i < 2; ++_i) { int _r = rowmap[(u).pm * BM + _h * HALF + RA[_i]]; _r = _r < 0 ? 0 : _r; \
        v[_h][_i] = (unsigned)_r * (unsigned)(K * 2) + CAb[_i]; } } while (0)
#define PG8_BPTR(u) ((const char*)g.Bt + (EXPERT ? (size_t)texp[(u).pm] * bstride : (size_t)0) + (size_t)(u).pn * tstep)
#define PG8_APTR(u) ((const char*)g.A + (GATHER ? (size_t)0 : (size_t)(u).pm * tstep))
    Unit cur, nxt; int ui = 0;
    if (!S.next(0, cur)) return;
    f32x4 acc[2][2][4][2];
#pragma unroll
    for (int a = 0; a < 2; ++a)
#pragma unroll
        for (int b = 0; b < 2; ++b)
#pragma unroll
            for (int m = 0; m < 4; ++m)
#pragma unroll
                for (int n = 0; n < 2; ++n) acc[a][b][m][n] = (f32x4){0.f, 0.f, 0.f, 0.f};
    bf16x8 At[4][2], B0[2][2], B1[2][2];
    unsigned cv[2][2], nv[2][2];
    if constexpr (GATHER) { PG8_ROWS(cur, cv); } else { cv[0][0] = voffA[0]; cv[0][1] = voffA[1]; cv[1][0] = voffA[0]; cv[1][1] = voffA[1]; }
#pragma unroll
    for (int h = 0; h < 2; ++h) { nv[h][0] = cv[h][0]; nv[h][1] = cv[h][1]; }
    const char* cA = PG8_APTR(cur); const char* cB = PG8_BPTR(cur);
    S.a_ready(cur);
    PG8_STAGE(PG8_SB(0, 0), cB, voffB); PG8_STAGE(PG8_SB(0, 1), cB, voffB1); PG8_STAGE(PG8_SA(0, 0), cA, cv[0]); PG8_STAGE(PG8_SA(0, 1), cA + ahs, cv[1]);
    if (wr == 1) PG8_BAR;
    PG8_WAIT_V(2); PG8_BAR;
    PG8_STAGE(PG8_SB(1, 0), cB + kstep, voffB); PG8_STAGE(PG8_SA(1, 0), cA + kstep, cv[0]); PG8_STAGE(PG8_SB(1, 1), cB + kstep, voffB1);
    PG8_WAIT_V(6); PG8_BAR;
    for (;;) {
        const bool has_next = S.next(ui + 1, nxt);
        const char* nA = has_next ? PG8_APTR(nxt) : cA; const char* nB = has_next ? PG8_BPTR(nxt) : cB;
        if constexpr (GATHER) { if (has_next) { PG8_ROWS(nxt, nv); } }
        for (int t = 0; t < nt; t += 2) {
            const bool last = (t == nt - 2);
            const char* a1 = cA + (size_t)(t + 1) * kstep;
            const char* a2 = last ? nA : cA + (size_t)(t + 2) * kstep; const char* b2 = last ? nB : cB + (size_t)(t + 2) * kstep;
            const char* a3 = a2 + kstep; const char* b3 = b2 + kstep;
            unsigned s0[2], s1[2];
            s0[0] = last ? nv[0][0] : cv[0][0]; s0[1] = last ? nv[0][1] : cv[0][1]; s1[0] = last ? nv[1][0] : cv[1][0]; s1[1] = last ? nv[1][1] : cv[1][1];
            if (last && has_next) S.a_ready(nxt);
            PG8_LDB(B0, 0, 0); PG8_LDB(B1, 0, 1); PG8_SCHED; PG8_LDA(At, 0, 0); PG8_STAGE(PG8_SA(1, 1), a1 + ahs, cv[1]);
            PG8_WAIT_V(8); PG8_WAIT_L(0); PG8_BAR; PG8_MMA(0, 0, At, B0); PG8_MMA(0, 1, At, B1); PG8_BAR; PG8_SCHED;
            PG8_LDA(At, 0, 1); PG8_STAGE(PG8_SB(0, 0), b2, voffB); PG8_STAGE(PG8_SB(0, 1), b2, voffB1); PG8_STAGE(PG8_SA(0, 0), a2, s0);
            PG8_WAIT_V(8); PG8_WAIT_L(0); PG8_BAR; PG8_MMA(1, 0, At, B0); PG8_MMA(1, 1, At, B1); PG8_BAR; PG8_SCHED;
            PG8_LDB(B0, 1, 0); PG8_LDB(B1, 1, 1); PG8_SCHED; PG8_LDA(At, 1, 0); PG8_STAGE(PG8_SA(0, 1), a2 + ahs, s1);
            PG8_WAIT_V(8); PG8_WAIT_L(0); PG8_BAR; PG8_MMA(0, 0, At, B0); PG8_MMA(0, 1, At, B1); PG8_BAR; PG8_SCHED;
            PG8_LDA(At, 1, 1); PG8_STAGE(PG8_SB(1, 0), b3, voffB); PG8_STAGE(PG8_SB(1, 1), b3, voffB1); PG8_STAGE(PG8_SA(1, 0), a3, s0);
            PG8_WAIT_V(8); PG8_WAIT_L(0); PG8_BAR; PG8_MMA(1, 0, At, B0); PG8_MMA(1, 1, At, B1); PG8_BAR; PG8_SCHED;
        }
        if constexpr (ALIGN_EPI) { if (wr == 0) PG8_BAR; }
        E(acc, cur, wr, wc, fr, fq); S.done(cur);
        if (!has_next) break;
#pragma unroll
        for (int a = 0; a < 2; ++a)
#pragma unroll
            for (int b = 0; b < 2; ++b)
#pragma unroll
                for (int m = 0; m < 4; ++m)
#pragma unroll
                    for (int n = 0; n < 2; ++n) acc[a][b][m][n] = (f32x4){0.f, 0.f, 0.f, 0.f};
        cur = nxt; cA = nA; cB = nB; ++ui;
#pragma unroll
        for (int h = 0; h < 2; ++h) { cv[h][0] = nv[h][0]; cv[h][1] = nv[h][1]; }
        if constexpr (ALIGN_EPI) { if (wr == 1) PG8_BAR; }
    }
    PG8_WAIT_V(0);
    if constexpr (!ALIGN_EPI) { if (wr == 0) PG8_BAR; }
    PG8_BAR;
#undef PG8_SA
#undef PG8_SB
#undef PG8_STAGE
#undef PG8_LDA
#undef PG8_LDB
#undef PG8_MMA
#undef PG8_WAIT_V
#undef PG8_WAIT_L
#undef PG8_BAR
#undef PG8_SCHED
#undef PG8_ROWS
#undef PG8_BPTR
#undef PG8_APTR
}

struct EpiInProjF {
    static constexpr bool PERM = true, WIDE = true;
    unsigned char* ws; const float* dt_bias; const float* gate_bias; int pm_mask; float ds; int pn_off;
    __device__ __forceinline__ void operator()(const f32x4 (&acc)[2][2][4][2], const Unit& u, int wr, int wc, int fr, int fq) const {
        const int pn = u.pn + pn_off, row0 = (u.pm & pm_mask) * BM + wr * 64 + fr, c8 = wc * 64 + 8 * fq;
        if (pn < 46) {
            bf16* base; int ldc, ct; const bool gate = pn >= 38;
            if (pn < 6) { base = (bf16*)(ws + WS_Q); ldc = AW; ct = pn * 256; }
            else if (pn < 12) { base = (bf16*)(ws + WS_K); ldc = AW; ct = (pn - 6) * 256; }
            else if (pn < 18) { base = (bf16*)(ws + WS_V); ldc = AW; ct = (pn - 12) * 256; }
            else if (pn < 26) { base = (bf16*)(ws + WS_Z); ldc = DI; ct = (pn - 18) * 256; }
            else if (pn < 38) { base = (bf16*)(ws + WS_XBC); ldc = CONVD; ct = (pn - 26) * 256; }
            else { base = (bf16*)(ws + WS_GATE); ldc = 2048; ct = (pn - 38) * 256; }
#if QKV_STORE_FP8
            if (pn < 18) {
                unsigned char* qb8 = ws + (pn < 6 ? WS_Q : (pn < 12 ? WS_K : WS_V));
#pragma unroll
                for (int ai = 0; ai < 2; ++ai)
#pragma unroll
                    for (int m = 0; m < 4; ++m) { unsigned char* rowp = qb8 + (size_t)(row0 + ai * HALF + m * 16) * AW + ct + c8;
#pragma unroll
                        for (int bj = 0; bj < 2; ++bj) { const f32x4 v0 = acc[ai][bj][m][0] * (ds * FP8_ASCALE), v1 = acc[ai][bj][m][1] * (ds * FP8_ASCALE);
                            u32x2 w; w.x = pk_fp8x4(v0.x, v0.y, v0.z, v0.w); w.y = pk_fp8x4(v1.x, v1.y, v1.z, v1.w);
                            __builtin_nontemporal_store(w, (u32x2*)(rowp + bj * 32)); } }
                return;
            }
#endif
            f32x4 gb[2][2];
#pragma unroll
            for (int bj = 0; bj < 2; ++bj)
#pragma unroll
                for (int n = 0; n < 2; ++n) gb[bj][n] = gate ? *(const f32x4*)(gate_bias + ct + c8 + bj * 32 + 4 * n) : (f32x4){0.f, 0.f, 0.f, 0.f};
            const int hi8 = fr >> 3;
#pragma unroll
            for (int ai = 0; ai < 2; ++ai)
#pragma unroll
                for (int m = 0; m < 4; ++m) { bf16* rowp = base + (size_t)(row0 - fr + (fr & 7) + ai * HALF + m * 16) * ldc + ct + wc * 64 + 32 * hi8 + 8 * fq;
                    u32x4 w[2];
#pragma unroll
                    for (int bj = 0; bj < 2; ++bj) { f32x4 v0 = acc[ai][bj][m][0] * ds, v1 = acc[ai][bj][m][1] * ds;
                        if (gate) { v0 = v0 + gb[bj][0]; v1 = v1 + gb[bj][1];
                            v0 = (f32x4){sigmoidf_(v0.x), sigmoidf_(v0.y), sigmoidf_(v0.z), sigmoidf_(v0.w)}; v1 = (f32x4){sigmoidf_(v1.x), sigmoidf_(v1.y), sigmoidf_(v1.z), sigmoidf_(v1.w)}; }
                        w[bj].x = cvt_pk_bf16(v0.x, v0.y); w[bj].y = cvt_pk_bf16(v0.z, v0.w); w[bj].z = cvt_pk_bf16(v1.x, v1.y); w[bj].w = cvt_pk_bf16(v1.z, v1.w); }
                    const u32x4 snd = hi8 ? w[0] : w[1]; u32x4 rcv;
                    rcv.x = (unsigned)__builtin_amdgcn_update_dpp(0, (int)snd.x, 0x128, 0xf, 0xf, false); rcv.y = (unsigned)__builtin_amdgcn_update_dpp(0, (int)snd.y, 0x128, 0xf, 0xf, false);
                    rcv.z = (unsigned)__builtin_amdgcn_update_dpp(0, (int)snd.z, 0x128, 0xf, 0xf, false); rcv.w = (unsigned)__builtin_amdgcn_update_dpp(0, (int)snd.w, 0x128, 0xf, 0xf, false);
                    const u32x4 p0 = hi8 ? rcv : w[0], p1 = hi8 ? w[1] : rcv;
                    __builtin_nontemporal_store(p0, (u32x4*)rowp); __builtin_nontemporal_store(p1, (u32x4*)(rowp + (size_t)8 * ldc)); }
        } else if (wc == 0) {
            const f32x4 b0 = *(const f32x4*)(dt_bias + c8), b1 = *(const f32x4*)(dt_bias + c8 + 4);
#pragma unroll
            for (int ai = 0; ai < 2; ++ai)
#pragma unroll
                for (int m = 0; m < 4; ++m) { float* dp = (float*)(ws + WS_DT) + (size_t)c8 * T + (row0 + ai * HALF + m * 16);
                    const f32x4 v0 = acc[ai][0][m][0] * ds + b0, v1 = acc[ai][0][m][1] * ds + b1;
                    dp[0] = softplusf_(v0.x); dp[(size_t)T] = softplusf_(v0.y); dp[(size_t)2 * T] = softplusf_(v0.z); dp[(size_t)3 * T] = softplusf_(v0.w);
                    dp[(size_t)4 * T] = softplusf_(v1.x); dp[(size_t)5 * T] = softplusf_(v1.y); dp[(size_t)6 * T] = softplusf_(v1.z); dp[(size_t)7 * T] = softplusf_(v1.w); }
        }
    }
};
struct EpiNullF {
    static constexpr bool PERM = true, WIDE = false;
    __device__ __forceinline__ void operator()(const f32x4 (&acc)[2][2][4][2], const Unit&, int, int, int, int) const {
#pragma unroll
        for (int ai = 0; ai < 2; ++ai)
#pragma unroll
            for (int m = 0; m < 4; ++m)
#pragma unroll
                for (int bj = 0; bj < 2; ++bj)
#pragma unroll
                    for (int n = 0; n < 2; ++n) asm volatile("" :: "v"(acc[ai][bj][m][n]));
    }
};
struct EpiM0F {
    static constexpr bool PERM = true, WIDE = false;
    unsigned char* ws;
    __device__ __forceinline__ void operator()(const f32x4 (&acc)[2][2][4][2], const Unit& u, int wr, int wc, int fr, int fq) const {
        const int row0 = u.pm * BM + wr * 64 + fr, col0 = u.pn * BM + wc * 32 + 8 * fq;
#pragma unroll
        for (int ai = 0; ai < 2; ++ai)
#pragma unroll
            for (int m = 0; m < 4; ++m) { const size_t r = (size_t)(row0 + ai * HALF + m * 16);
#pragma unroll
                for (int bj = 0; bj < 2; ++bj) { const int c = col0 + bj * HALF;
                    const u32x4 gg = *(const u32x4*)((const bf16*)(ws + WS_GATE) + r * 2048 + c);
                    const f32x4 v0 = acc[ai][bj][m][0], v1 = acc[ai][bj][m][1];
                    u32x4 w; w.x = cvt_pk_bf16(v0.x * bflo(gg.x), v0.y * bfhi(gg.x)); w.y = cvt_pk_bf16(v0.z * bflo(gg.y), v0.w * bfhi(gg.y));
                    w.z = cvt_pk_bf16(v1.x * bflo(gg.z), v1.y * bfhi(gg.z)); w.w = cvt_pk_bf16(v1.z * bflo(gg.w), v1.w * bfhi(gg.w));
                    *(u32x4*)((bf16*)(ws + WS_M0) + r * D + c) = w; } }
    }
};
struct EpiMergedF {
    static constexpr bool PERM = true, WIDE = false;
    unsigned char* ws;
    __device__ __forceinline__ void operator()(const f32x4 (&acc)[2][2][4][2], const Unit& u, int wr, int wc, int fr, int fq) const {
        const int row0 = u.pm * BM + wr * 64 + fr, col0 = u.pn * BM + wc * 32 + 8 * fq;
#pragma unroll
        for (int ai = 0; ai < 2; ++ai)
#pragma unroll
            for (int m = 0; m < 4; ++m) { const size_t r = (size_t)(row0 + ai * HALF + m * 16);
#pragma unroll
                for (int bj = 0; bj < 2; ++bj) { const int c = col0 + bj * HALF;
                    const u32x4 gg = *(const u32x4*)((const bf16*)(ws + WS_GATE) + r * 2048 + 1024 + c);
                    const u32x4 mm = *(const u32x4*)((const bf16*)(ws + WS_M0) + r * D + c);
                    const f32x4 m0 = (f32x4){bflo(mm.x), bfhi(mm.x), bflo(mm.y), bfhi(mm.y)}, m1 = (f32x4){bflo(mm.z), bfhi(mm.z), bflo(mm.w), bfhi(mm.w)};
                    const f32x4 v0 = acc[ai][bj][m][0], v1 = acc[ai][bj][m][1];
                    u32x4 w; w.x = cvt_pk_bf16(m0.x + v0.x * bflo(gg.x), m0.y + v0.y * bfhi(gg.x)); w.y = cvt_pk_bf16(m0.z + v0.z * bflo(gg.y), m0.w + v0.w * bfhi(gg.y));
                    w.z = cvt_pk_bf16(m1.x + v1.x * bflo(gg.z), m1.y + v1.y * bfhi(gg.z)); w.w = cvt_pk_bf16(m1.z + v1.z * bflo(gg.w), m1.w + v1.w * bfhi(gg.w));
                    *(u32x4*)((bf16*)(ws + WS_MERGED) + r * D + c) = w; } }
    }
};
struct EpiX1F {
    static constexpr bool PERM = false, WIDE = false;
    const float* x; float* out;
    __device__ __forceinline__ void operator()(const f32x4 (&acc)[2][2][4][2], const Unit& u, int wr, int wc, int fr, int fq) const {
        const int row0 = u.pm * BM + wr * 64 + fr, col0 = u.pn * BM + wc * 32 + 4 * fq;
#pragma unroll
        for (int ai = 0; ai < 2; ++ai)
#pragma unroll
            for (int m = 0; m < 4; ++m) { const size_t r = (size_t)(row0 + ai * HALF + m * 16);
#pragma unroll
                for (int bj = 0; bj < 2; ++bj)
#pragma unroll
                    for (int n = 0; n < 2; ++n) { const int c = col0 + bj * HALF + n * 16;
                        *(f32x4*)(out + r * D + c) = *(const f32x4*)(x + r * D + c) + acc[ai][bj][m][n]; } }
    }
};
struct EpiMoe1F {
    static constexpr bool PERM = true, WIDE = false;
    unsigned char* ws; const float* b1; const int* texp;
    __device__ __forceinline__ void operator()(const f32x4 (&acc)[2][2][4][2], const Unit& u, int wr, int wc, int fr, int fq) const {
        const int e = texp[u.pm];
        const int row0 = u.pm * BM + wr * 64 + fr, col0 = u.pn * BM + wc * 32 + 8 * fq;
        f32x4 bv[2][2];
#pragma unroll
        for (int bj = 0; bj < 2; ++bj)
#pragma unroll
            for (int n = 0; n < 2; ++n) bv[bj][n] = *(const f32x4*)(b1 + (size_t)e * 2048 + col0 + bj * HALF + 4 * n);
#pragma unroll
        for (int ai = 0; ai < 2; ++ai)
#pragma unroll
            for (int m = 0; m < 4; ++m) { const size_t r = (size_t)(row0 + ai * HALF + m * 16);
#pragma unroll
                for (int bj = 0; bj < 2; ++bj) { const f32x4 v0 = acc[ai][bj][m][0] + bv[bj][0], v1 = acc[ai][bj][m][1] + bv[bj][1];
                    u32x2 w; w.x = cvt_pk_bf16(swiglu_(v0.x, v0.y), swiglu_(v0.z, v0.w)); w.y = cvt_pk_bf16(swiglu_(v1.x, v1.y), swiglu_(v1.z, v1.w));
                    __builtin_nontemporal_store(w, (u32x2*)((bf16*)(ws + WS_ACT) + r * 1024 + ((col0 + bj * HALF) >> 1))); } }
    }
};
struct EpiMoe1Q {
    static constexpr bool PERM = true, WIDE = false;
    unsigned char* ws; const float* b1; const int* texp;
    __device__ __forceinline__ void operator()(const f32x4 (&acc)[2][2][4][2], const Unit& u, int wr, int wc, int fr, int fq) const {
        const int e = texp[u.pm];
        const int row0 = u.pm * BM + wr * 64 + fr, col0 = u.pn * BM + wc * 32 + 8 * fq;
        constexpr float DS = 1.f / (FP8_ASCALE * FP8_WSCALE);
        f32x4 bv[2][2];
#pragma unroll
        for (int bj = 0; bj < 2; ++bj)
#pragma unroll
            for (int n = 0; n < 2; ++n) bv[bj][n] = *(const f32x4*)(b1 + (size_t)e * 2048 + col0 + bj * HALF + 4 * n);
#pragma unroll
        for (int ai = 0; ai < 2; ++ai)
#pragma unroll
            for (int m = 0; m < 4; ++m) { const size_t r = (size_t)(row0 + ai * HALF + m * 16);
#pragma unroll
                for (int bj = 0; bj < 2; ++bj) { const f32x4 v0 = acc[ai][bj][m][0] * DS + bv[bj][0], v1 = acc[ai][bj][m][1] * DS + bv[bj][1];
                    const unsigned w = pk_fp8x4(FP8_ASCALE * swiglu_(v0.x, v0.y), FP8_ASCALE * swiglu_(v0.z, v0.w), FP8_ASCALE * swiglu_(v1.x, v1.y), FP8_ASCALE * swiglu_(v1.z, v1.w));
                    __builtin_nontemporal_store(w, (unsigned*)(ws + WS_ACT + r * 1024 + ((col0 + bj * HALF) >> 1))); } }
    }
};
struct EpiMoe2Q {
    static constexpr bool PERM = true, WIDE = false;
    unsigned char* ws; const float* b2; const int* texp;
    __device__ __forceinline__ void operator()(const f32x4 (&acc)[2][2][4][2], const Unit& u, int wr, int wc, int fr, int fq) const {
        const int e = texp[u.pm];
        const int row0 = u.pm * BM + wr * 64 + fr, col0 = u.pn * BM + wc * 32 + 8 * fq;
        constexpr float DS = 1.f / (FP8_ASCALE * FP8_WSCALE);
        f32x4 bv[2][2];
#pragma unroll
        for (int bj = 0; bj < 2; ++bj)
#pragma unroll
            for (int n = 0; n < 2; ++n) bv[bj][n] = *(const f32x4*)(b2 + (size_t)e * 1024 + col0 + bj * HALF + 4 * n);
#pragma unroll
        for (int ai = 0; ai < 2; ++ai)
#pragma unroll
            for (int m = 0; m < 4; ++m) { const size_t r = (size_t)(row0 + ai * HALF + m * 16);
#pragma unroll
                for (int bj = 0; bj < 2; ++bj) { const f32x4 v0 = acc[ai][bj][m][0] * DS + bv[bj][0], v1 = acc[ai][bj][m][1] * DS + bv[bj][1];
                    u32x4 w; w.x = cvt_pk_bf16(v0.x, v0.y); w.y = cvt_pk_bf16(v0.z, v0.w); w.z = cvt_pk_bf16(v1.x, v1.y); w.w = cvt_pk_bf16(v1.z, v1.w);
                    __builtin_nontemporal_store(w, (u32x4*)((bf16*)(ws + WS_YB) + r * 1024 + col0 + bj * HALF)); } }
    }
};
struct EpiMoe2F {
    static constexpr bool PERM = true, WIDE = false;
    unsigned char* ws; const float* b2; const int* texp;
    __device__ __forceinline__ void operator()(const f32x4 (&acc)[2][2][4][2], const Unit& u, int wr, int wc, int fr, int fq) const {
        const int e = texp[u.pm];
        const int row0 = u.pm * BM + wr * 64 + fr, col0 = u.pn * BM + wc * 32 + 8 * fq;
        f32x4 bv[2][2];
#pragma unroll
        for (int bj = 0; bj < 2; ++bj)
#pragma unroll
            for (int n = 0; n < 2; ++n) bv[bj][n] = *(const f32x4*)(b2 + (size_t)e * 1024 + col0 + bj * HALF + 4 * n);
#pragma unroll
        for (int ai = 0; ai < 2; ++ai)
#pragma unroll
            for (int m = 0; m < 4; ++m) { const size_t r = (size_t)(row0 + ai * HALF + m * 16);
#pragma unroll
                for (int bj = 0; bj < 2; ++bj) { const f32x4 v0 = acc[ai][bj][m][0] + bv[bj][0], v1 = acc[ai][bj][m][1] + bv[bj][1];
                    u32x4 w; w.x = cvt_pk_bf16(v0.x, v0.y); w.y = cvt_pk_bf16(v0.z, v0.w); w.z = cvt_pk_bf16(v1.x, v1.y); w.w = cvt_pk_bf16(v1.z, v1.w);
                    __builtin_nontemporal_store(w, (u32x4*)((bf16*)(ws + WS_YB) + r * 1024 + col0 + bj * HALF)); } }
    }
};
}

__device__ __forceinline__ int t5_bucket_dev(int dist) {
    if (dist < 16) return dist;
    int l = 16 + (int)(logf((float)dist / 16.f) / logf(128.f) * 16.f);
    return l < 31 ? l : 31;
}
__device__ __forceinline__ void transpose_item(const float* W, int K, int N, bf16* WT, int k0, int n0, int drow0, LAS float* scr, int lane) {
#pragma unroll 8
    for (int i = 0; i < 32; ++i) { const int kk = 2 * i + (lane >> 5); scr[kk * 33 + (lane & 31)] = __builtin_nontemporal_load(W + (size_t)(k0 + kk) * N + n0 + (lane & 31)); }
    asm volatile("s_waitcnt lgkmcnt(0)" ::: "memory");
    const int c = lane & 7;
#pragma unroll
    for (int j = 0; j < 4; ++j) { const int n = (lane >> 3) + 8 * j; const LAS float* s = scr + (8 * c) * 33 + n;
        u32x4 o; o.x = pk2(s[0 * 33], s[1 * 33]); o.y = pk2(s[2 * 33], s[3 * 33]); o.z = pk2(s[4 * 33], s[5 * 33]); o.w = pk2(s[6 * 33], s[7 * 33]);
        *(u32x4*)(WT + (size_t)(drow0 + n) * K + k0 + 8 * c) = o; }
    asm volatile("s_waitcnt lgkmcnt(0)" ::: "memory");
}
__device__ __forceinline__ void transpose_item_fp8(const float* W, int K, int N, unsigned char* WT, int k0, int n0, int drow0, float scale, LAS float* scr, int lane) {
#pragma unroll 8
    for (int i = 0; i < 64; ++i) { const int kk = 2 * i + (lane >> 5); scr[kk * 33 + (lane & 31)] = __builtin_nontemporal_load(W + (size_t)(k0 + kk) * N + n0 + (lane & 31)) * scale; }
    asm volatile("s_waitcnt lgkmcnt(0)" ::: "memory");
    const int c = lane & 7;
#pragma unroll
    for (int j = 0; j < 4; ++j) { const int n = (lane >> 3) + 8 * j; const LAS float* s = scr + (16 * c) * 33 + n;
        u32x4 o; o.x = pk_fp8x4(s[0 * 33], s[1 * 33], s[2 * 33], s[3 * 33]); o.y = pk_fp8x4(s[4 * 33], s[5 * 33], s[6 * 33], s[7 * 33]);
        o.z = pk_fp8x4(s[8 * 33], s[9 * 33], s[10 * 33], s[11 * 33]); o.w = pk_fp8x4(s[12 * 33], s[13 * 33], s[14 * 33], s[15 * 33]);
        *(u32x4*)(WT + (size_t)(drow0 + n) * K + k0 + 16 * c) = o; }
    asm volatile("s_waitcnt lgkmcnt(0)" ::: "memory");
}
__device__ __forceinline__ int inproj_row_of_col(int n0) { return n0 < C_DT ? n0 : (n0 < C_GATE ? n0 - C_DT + 11776 : n0 - 32); }
__device__ __forceinline__ void p_convert_small(Frame& F) {
    LAS float* scr = (LAS float*)(F.lds + F.wave * 16896);
    const int gw = F.blk * NWAVES + F.wave, NGW = F.nblk * NWAVES;
    constexpr int NBQ = QKV_FP8 ? C_Z / 32 : 0;
    constexpr int I_INQ = 8 * NBQ, I_IN = 16 * (NPROJ / 32 - NBQ), I_BA = 8 * 32, I_BS = 32 * 32, I_OUT = 16 * 32, NIT = I_INQ + I_IN + I_BA + I_BS + I_OUT;
    for (int it = gw; it < NIT; it += NGW) {
        int r = it;
        if (r < I_INQ) { const int nb = r % (NBQ ? NBQ : 1), kb = r / (NBQ ? NBQ : 1); transpose_item_fp8(F.w_in, D, NPROJ, F.ws + WS_WQKVQ, 128 * kb, 32 * nb, 32 * nb, FP8_WSCALE, scr, ((int)(threadIdx.x & 63u))); continue; } r -= I_INQ;
        if (r < I_IN) { const int nb = NBQ + r % (NPROJ / 32 - NBQ), kb = r / (NPROJ / 32 - NBQ); transpose_item(F.w_in, D, NPROJ, (bf16*)(F.ws + WS_WIN_T), 64 * kb, 32 * nb, inproj_row_of_col(32 * nb), scr, ((int)(threadIdx.x & 63u))); continue; } r -= I_IN;
        if (r < I_BA) { const int nb = r % 32, kb = r / 32; transpose_item(F.w_ba, 512, D, (bf16*)(F.ws + WS_WBA_T), 64 * kb, 32 * nb, 32 * nb, scr, ((int)(threadIdx.x & 63u))); continue; } r -= I_BA;
        if (r < I_BS) { const int nb = r % 32, kb = r / 32; transpose_item(F.w_bs, DI, D, (bf16*)(F.ws + WS_WBS_T), 64 * kb, 32 * nb, 32 * nb, scr, ((int)(threadIdx.x & 63u))); continue; } r -= I_BS;
        { const int nb = r % 32, kb = r / 32; transpose_item(F.w_out, D, D, (bf16*)(F.ws + WS_WOUT_T), 64 * kb, 32 * nb, 32 * nb, scr, ((int)(threadIdx.x & 63u))); }
    }
    for (int i = F.blk * NTHREADS + ((int)threadIdx.x); i < 24 * 192; i += F.nblk * NTHREADS) { const int head = i / 192, dl = i % 192 - 32, g = head >> 3, dil = g == 0 ? 1 : (g == 1 ? 4 : 16);
        ((float*)(F.ws + WS_BT))[i] = F.rel_bias[t5_bucket_dev((dl < 0 ? 0 : (dl > 128 ? 128 : dl)) * dil) * 24 + head] * 1.4426950408889634f; }
    for (int i = F.blk * NTHREADS + ((int)threadIdx.x); i < 32 * 1024; i += F.nblk * NTHREADS) ((float*)(F.ws + WS_WRT))[i] = F.norm_ffn[i >> 5] * F.router_w[i];
    u32x4* z = (u32x4*)((bf16*)(F.ws + WS_WIN_T) + (size_t)11808 * D);
    for (int i = F.blk * NTHREADS + ((int)threadIdx.x); i < 224 * D * 2 / 16; i += F.nblk * NTHREADS) z[i] = (u32x4){0u, 0u, 0u, 0u};
}
__device__ __forceinline__ void p_convert_moe_fp8(Frame& F) {
    LAS float* scr = (LAS float*)(F.lds + F.wave * 16896);
    const int gw = F.blk * NWAVES + F.wave, NGW = F.nblk * NWAVES;
    constexpr int I_1 = 8 * 64, I_2 = 8 * 32, NIT = NEXP * (I_1 + I_2);
    for (int it = gw; it < NIT; it += NGW) {
        const int e = it / (I_1 + I_2); int r = it % (I_1 + I_2);
        if (r < I_1) { const int nb = r % 64, kb = r / 64; transpose_item_fp8(F.w1 + (size_t)e * 1024 * 2048, 1024, 2048, F.ws + WS_W1T + (size_t)e * 2048 * 1024, 128 * kb, 32 * nb, 32 * nb, FP8_WSCALE, scr, ((int)(threadIdx.x & 63u))); }
        else { r -= I_1; const int nb = r % 32, kb = r / 32; transpose_item_fp8(F.w2 + (size_t)e * 1024 * 1024, 1024, 1024, F.ws + WS_W2T + (size_t)e * 1024 * 1024, 128 * kb, 32 * nb, 32 * nb, FP8_WSCALE, scr, ((int)(threadIdx.x & 63u))); }
    }
}
__device__ __forceinline__ void p_convert_moe(Frame& F) {
    LAS float* scr = (LAS float*)(F.lds + F.wave * 16384);
    const int gw = F.blk * NWAVES + F.wave, NGW = F.nblk * NWAVES;
    constexpr int I_1 = 16 * 64, I_2 = 16 * 32, NIT = NEXP * (I_1 + I_2);
    for (int it = gw; it < NIT; it += NGW) {
        const int e = it / (I_1 + I_2); int r = it % (I_1 + I_2);
        if (r < I_1) { const int nb = r % 64, kb = r / 64; transpose_item(F.w1 + (size_t)e * 1024 * 2048, 1024, 2048, (bf16*)(F.ws + WS_W1T) + (size_t)e * 2048 * 1024, 64 * kb, 32 * nb, 32 * nb, scr, ((int)(threadIdx.x & 63u))); }
        else { r -= I_1; const int nb = r % 32, kb = r / 32; transpose_item(F.w2 + (size_t)e * 1024 * 1024, 1024, 1024, (bf16*)(F.ws + WS_W2T) + (size_t)e * 1024 * 1024, 64 * kb, 32 * nb, 32 * nb, scr, ((int)(threadIdx.x & 63u))); }
    }
}

__device__ __forceinline__ void p_rmsnorm_in(Frame& F) {
    const int gw = F.blk * NWAVES + F.wave, NGW = F.nblk * NWAVES;
    bf16* XN = (bf16*)(F.ws + WS_XN);
    for (int m = gw; m < T; m += NGW) {
        const f32x4* xr = (const f32x4*)(F.x + (size_t)m * D) + ((int)(threadIdx.x & 63u));
        const f32x4* wr = (const f32x4*)F.norm_mix + ((int)(threadIdx.x & 63u));
        f32x4 v[4]; float s = 0.f;
#pragma unroll
        for (int j = 0; j < 4; ++j) { v[j] = __builtin_nontemporal_load(xr + 64 * j); s += (v[j].x * v[j].x + v[j].y * v[j].y) + (v[j].z * v[j].z + v[j].w * v[j].w); }
        const float rstd = 1.f / sqrtf(wave_sum(s) * (1.f / D) + EPS);
#pragma unroll
        for (int j = 0; j < 4; ++j) { const f32x4 w = wr[64 * j]; const f32x4 o = v[j] * rstd * w; st_bf4(XN + (size_t)m * D + (((int)(threadIdx.x & 63u)) + 64 * j) * 4, o);
#if QKV_FP8
            *(unsigned*)(F.ws + WS_XNQ + (size_t)m * D + (((int)(threadIdx.x & 63u)) + 64 * j) * 4) = pk_fp8x4(FP8_ASCALE * o.x, FP8_ASCALE * o.y, FP8_ASCALE * o.z, FP8_ASCALE * o.w);
#endif
        }
    }
}

__device__ __forceinline__ void p_attn_naive(Frame& F) {
    LAS float* btab = (LAS float*)F.lds;
    for (int i = ((int)threadIdx.x); i < 3 * 129 * 8; i += NTHREADS) {
        const int g = i / (129 * 8), j = (i >> 3) % 129, hg = i & 7;
        const int dil = g == 0 ? 1 : (g == 1 ? 4 : 16);
        btab[i] = F.rel_bias[t5_bucket_dev(j * dil) * 24 + g * 8 + hg];
    }
    __syncthreads();
    const bf16* Qb = (const bf16*)(F.ws + WS_Q); const bf16* Kb = (const bf16*)(F.ws + WS_K); const bf16* Vb = (const bf16*)(F.ws + WS_V);
    bf16* AT = (bf16*)(F.ws + WS_ATTN);
    for (int idx = F.blk * NTHREADS + ((int)threadIdx.x); idx < T * 8; idx += F.nblk * NTHREADS) {
        const int hg = idx & 7, row = idx >> 3, t = row & (SEQ - 1);
        float m = -INFINITY, den = 0.f;
        float acc[64];
#pragma unroll
        for (int i = 0; i < 64; ++i) acc[i] = 0.f;
        for (int g = 0; g < 3; ++g) {
            const int dil = g == 0 ? 1 : (g == 1 ? 4 : 16);
            const int head = g * 8 + hg;
            float q[64];
            { const u32x4* qp = (const u32x4*)(Qb + (size_t)row * AW + head * 64);
#pragma unroll
              for (int c = 0; c < 8; ++c) { const u32x4 w = qp[c]; q[8 * c + 0] = bflo(w.x); q[8 * c + 1] = bfhi(w.x); q[8 * c + 2] = bflo(w.y); q[8 * c + 3] = bfhi(w.y);
                  q[8 * c + 4] = bflo(w.z); q[8 * c + 5] = bfhi(w.z); q[8 * c + 6] = bflo(w.w); q[8 * c + 7] = bfhi(w.w); } }
            for (int j = 0; j <= 128; ++j) {
                const int kt = t - j * dil; if (kt < 0) break;
                const size_t krow = (size_t)(row - j * dil);
                const u32x4* kp = (const u32x4*)(Kb + krow * AW + head * 64);
                float s = 0.f;
#pragma unroll
                for (int c = 0; c < 8; ++c) { const u32x4 w = kp[c];
                    s += q[8 * c + 0] * bflo(w.x) + q[8 * c + 1] * bfhi(w.x) + q[8 * c + 2] * bflo(w.y) + q[8 * c + 3] * bfhi(w.y)
                       + q[8 * c + 4] * bflo(w.z) + q[8 * c + 5] * bfhi(w.z) + q[8 * c + 6] * bflo(w.w) + q[8 * c + 7] * bfhi(w.w); }
                s = s * 0.125f + btab[(g * 129 + j) * 8 + hg];
                const float mn = fmaxf(m, s), sc = __expf(m - mn), p = __expf(s - mn);
                m = mn; den = den * sc + p;
                const u32x4* vp = (const u32x4*)(Vb + krow * AW + head * 64);
#pragma unroll
                for (int c = 0; c < 8; ++c) { const u32x4 w = vp[c];
                    acc[8 * c + 0] = acc[8 * c + 0] * sc + p * bflo(w.x); acc[8 * c + 1] = acc[8 * c + 1] * sc + p * bfhi(w.x);
                    acc[8 * c + 2] = acc[8 * c + 2] * sc + p * bflo(w.y); acc[8 * c + 3] = acc[8 * c + 3] * sc + p * bfhi(w.y);
                    acc[8 * c + 4] = acc[8 * c + 4] * sc + p * bflo(w.z); acc[8 * c + 5] = acc[8 * c + 5] * sc + p * bfhi(w.z);
                    acc[8 * c + 6] = acc[8 * c + 6] * sc + p * bflo(w.w); acc[8 * c + 7] = acc[8 * c + 7] * sc + p * bfhi(w.w); }
            }
        }
        const float inv = 1.f / den;
        u32x4* op = (u32x4*)(AT + (size_t)row * 512 + hg * 64);
#pragma unroll
        for (int c = 0; c < 8; ++c) { u32x4 w; w.x = pk2(acc[8 * c] * inv, acc[8 * c + 1] * inv); w.y = pk2(acc[8 * c + 2] * inv, acc[8 * c + 3] * inv);
            w.z = pk2(acc[8 * c + 4] * inv, acc[8 * c + 5] * inv); w.w = pk2(acc[8 * c + 6] * inv, acc[8 * c + 7] * inv); op[c] = w; }
    }
    __syncthreads();
}

typedef short bf16x8_t __attribute__((ext_vector_type(8)));
typedef short s16x4_t __attribute__((ext_vector_type(4)));
typedef float f32x16 __attribute__((ext_vector_type(16)));
__device__ __forceinline__ int crow_(int reg, int h) { return (reg & 3) + 8 * (reg >> 2) + 4 * h; }
__device__ __forceinline__ s16x4_t tr_read_(const LAS unsigned char* p) { return __builtin_bit_cast(s16x4_t, __builtin_amdgcn_ds_read_tr16_b64_v4i16((LAS s16x4_t*)p)); }
constexpr int ATT_HALF_BYTES = 66560;
template <bool LOADKV = true, bool DOSTORE = true, bool DOMATH = true>
__device__ __forceinline__ void p_attn_fast(Frame& F) {
    const int half = F.wave >> 2, qb = F.wave & 3;
    const bf16* Qb = (const bf16*)(F.ws + WS_Q); const bf16* Kb = (const bf16*)(F.ws + WS_K); const bf16* Vb = (const bf16*)(F.ws + WS_V);
    bf16* OUTG = (bf16*)(F.ws + WS_OUTG); float* LSE = (float*)(F.ws + WS_LSE); const float* BT = (const float*)(F.ws + WS_BT);
    constexpr int NUNIT = BATCH * 24 * 16;
    constexpr float LOG2E = 1.4426950408889634f;
    constexpr float QKS = QKV_STORE_FP8 ? 1.f / (FP8_ASCALE * FP8_ASCALE) : 1.f, VS = QKV_STORE_FP8 ? 1.f / FP8_ASCALE : 1.f;
    const int nhw = F.nblk * 2;
    int per = (NUNIT + nhw - 1) / nhw, u0 = (F.blk * 2 + half) * per;
    if (TAILFILL && QKV_FP8 && F.nblk == 256) {
        if (F.blk < 128) { per = 10; u0 = (F.blk * 2 + half) * 10; } else { per = 14; u0 = 2560 + ((F.blk - 128) * 2 + half) * 14; } }
#if QKV_STORE_FP8
    const unsigned char* Q8 = F.ws + WS_Q; const unsigned char* K8 = F.ws + WS_K; const unsigned char* V8 = F.ws + WS_V; (void)Qb; (void)Kb; (void)Vb;
    u32x4 kreg[2], vreg[2]; float breg = 0.f;
#else
    u32x4 kreg[4], vreg[4]; float breg = 0.f;
#endif
#define ATT_DECODE(u_) const int zn = (u_) & 15, head = ((u_) >> 4) % 24, b = (u_) / (16 * 24); const int g = head >> 3, hg = head & 7; \
        const int dil = g == 0 ? 1 : (g == 1 ? 4 : 16), nb = 16 / dil; const int z = zn / nb, n = zn % nb; const size_t rowb = (size_t)b * SEQ; (void)hg; (void)rowb; (void)z; (void)n
#if QKV_STORE_FP8
#define ATT_LOADBLK(u_, blk_) do { ATT_DECODE(u_); const int th_ = ((int)threadIdx.x) & 255; \
        _Pragma("unroll") for (int i = 0; i < 2; ++i) { const int piece = th_ + 256 * i, kw = piece >> 2, c16 = piece & 3; const int p = (blk_) * 128 + kw; \
            kreg[i] = (u32x4){0u, 0u, 0u, 0u}; vreg[i] = (u32x4){0u, 0u, 0u, 0u}; \
            if (LOADKV && (u_) < NUNIT) { const size_t row = rowb + (size_t)p * dil + z; kreg[i] = *(const u32x4*)(K8 + row * AW + head * 64 + c16 * 16); vreg[i] = *(const u32x4*)(V8 + row * AW + head * 64 + c16 * 16); } } \
        if (th_ < 192 && (u_) < NUNIT) breg = BT[head * 192 + th_]; } while (0)
#define ATT_STOREBLK(slot_) do { _Pragma("unroll") for (int i = 0; i < 2; ++i) { const int piece = th + 256 * i, kw = piece >> 2, c16 = piece & 3; const int rb_ = ((slot_) * 128 + kw) * 128; \
            *(LAS u32x4*)(Kimg + rb_ + (((2 * c16) ^ (kw & 7)) << 4)) = fp8x8_to_bf16x8(kreg[i].x, kreg[i].y); *(LAS u32x4*)(Kimg + rb_ + (((2 * c16 + 1) ^ (kw & 7)) << 4)) = fp8x8_to_bf16x8(kreg[i].z, kreg[i].w); \
            *(LAS u32x4*)(Vimg + rb_ + (((2 * c16) ^ (kw & 7)) << 4)) = fp8x8_to_bf16x8(vreg[i].x, vreg[i].y); *(LAS u32x4*)(Vimg + rb_ + (((2 * c16 + 1) ^ (kw & 7)) << 4)) = fp8x8_to_bf16x8(vreg[i].z, vreg[i].w); } } while (0)
#else
#define ATT_LOADBLK(u_, blk_) do { ATT_DECODE(u_); const int th_ = ((int)threadIdx.x) & 255; \
        _Pragma("unroll") for (int i = 0; i < 4; ++i) { const int piece = th_ + 256 * i, kw = piece >> 3, ch = piece & 7; const int p = (blk_) * 128 + kw; \
            kreg[i] = (u32x4){0u, 0u, 0u, 0u}; vreg[i] = (u32x4){0u, 0u, 0u, 0u}; \
            if (LOADKV && (u_) < NUNIT) { const size_t row = rowb + (size_t)p * dil + z; kreg[i] = *(const u32x4*)(Kb + row * AW + head * 64 + ch * 8); vreg[i] = *(const u32x4*)(Vb + row * AW + head * 64 + ch * 8); } } \
        if (th_ < 192 && (u_) < NUNIT) breg = BT[head * 192 + th_]; } while (0)
#define ATT_STOREBLK(slot_) do { _Pragma("unroll") for (int i = 0; i < 4; ++i) { const int piece = th + 256 * i, kw = piece >> 3, ch = piece & 7; const int off = ((slot_) * 128 + kw) * 128 + ((ch ^ (kw & 7)) << 4); \
            *(LAS u32x4*)(Kimg + off) = kreg[i]; *(LAS u32x4*)(Vimg + off) = vreg[i]; } } while (0)
#endif
    {
        for (int i = ((int)threadIdx.x); i < 2 * ATT_HALF_BYTES / 16; i += NTHREADS) ((LAS u32x4*)F.lds)[i] = (u32x4){0u, 0u, 0u, 0u};
        __syncthreads();
        const int th = ((int)threadIdx.x) & 255;
        LAS unsigned char* base = F.lds + half * ATT_HALF_BYTES; LAS unsigned char* Kimg = base; LAS unsigned char* Vimg = base + 32768;
        if (u0 < NUNIT) { const int n0 = (u0 & 15) % (16 / ((((u0 >> 4) % 24) >> 3) == 0 ? 1 : ((((u0 >> 4) % 24) >> 3) == 1 ? 4 : 16)));
            if (n0 > 0) { ATT_LOADBLK(u0, n0 - 1); ATT_STOREBLK((n0 - 1) & 1); } }
        ATT_LOADBLK(u0, (u0 & 15) % (16 / ((((u0 >> 4) % 24) >> 3) == 0 ? 1 : ((((u0 >> 4) % 24) >> 3) == 1 ? 4 : 16))));
    }
    for (int it = 0; it < per; ++it) {
        const int u = u0 + it;
        const bool live = u < NUNIT;
        ATT_DECODE(live ? u : 0);
        unsigned opq_ = 0; asm volatile("" : "+s"(opq_));
        int tl_ = ((int)threadIdx.x); asm volatile("" : "+v"(tl_));
        const int th = tl_ & 255, lane = tl_ & 63, r = lane & 31, h = lane >> 5;
        LAS unsigned char* base = F.lds + half * ATT_HALF_BYTES + opq_;
        LAS unsigned char* Kimg = base; LAS unsigned char* Vimg = base + 32768; LAS float* btab = (LAS float*)(base + 65536);
        const int flip = ((n - 1) & 1) << 7;
        bf16x8_t qf[4];
        { const size_t qrow = rowb + (size_t)(n * 128 + 32 * qb + r) * dil + z;
#pragma unroll
#if QKV_STORE_FP8
          for (int dd = 0; dd < 4; ++dd) { const u32x2 q8 = *(const u32x2*)(Q8 + qrow * AW + head * 64 + 16 * dd + 8 * h); qf[dd] = __builtin_bit_cast(bf16x8_t, fp8x8_to_bf16x8(q8.x, q8.y)); } }
#else
          for (int dd = 0; dd < 4; ++dd) qf[dd] = *(const bf16x8_t*)(Qb + qrow * AW + head * 64 + 16 * dd + 8 * h); }
#endif
        LDS_BARRIER();
        ATT_STOREBLK(n & 1);
        if (th < 192) btab[th] = breg;
        LDS_BARRIER();
        if (it + 1 < per) { const int un = u + 1; ATT_LOADBLK(un, ((un) & 15) % (16 / ((((un >> 4) % 24) >> 3) == 0 ? 1 : ((((un >> 4) % 24) >> 3) == 1 ? 4 : 16)))); }
        if (!live) continue;
        f32x16 sc[5];
#pragma unroll
        for (int kb = 0; kb < 5; ++kb) {
            f32x16 a = {0.f, 0.f, 0.f, 0.f, 0.f, 0.f, 0.f, 0.f, 0.f, 0.f, 0.f, 0.f, 0.f, 0.f, 0.f, 0.f};
            const int krow0 = (32 * (qb + kb) + r) ^ flip;
#pragma unroll
            for (int dd = 0; dd < 4; ++dd) {
                const bf16x8_t kf = *(const LAS bf16x8_t*)(Kimg + krow0 * 128 + (((2 * dd + h) ^ (r & 7)) << 4));
                a = __builtin_amdgcn_mfma_f32_32x32x16_bf16(kf, qf[dd], a, 0, 0, 0);
            }
            sc[kb] = a;
        }
        float m = -INFINITY;
        const LAS float* const bl = btab + (r - 4 * h);
#pragma unroll
        for (int kb = 0; kb < 5; ++kb)
#pragma unroll
            for (int i = 0; i < 16; ++i) {
                const int cc = (i & 3) + 8 * (i >> 2);
                const float bias = bl[160 - 32 * kb - cc];
                float s = sc[kb][i] * (0.125f * LOG2E * QKS) + bias;
                const int c = cc + 4 * h;
                if (kb == 0) s = (r <= c && n != 0) ? s : -INFINITY;
                else if (kb == 4) s = (c <= r) ? s : -INFINITY;
                else s = (n == 0 && (32 * (qb + kb) + c) < 128) ? -INFINITY : s;
                sc[kb][i] = s; m = fmaxf(m, s);
            }
        m = fmaxf(m, __shfl_xor(m, 32));
        float den = 0.f;
#pragma unroll
        for (int kb = 0; kb < 5; ++kb)
#pragma unroll
            for (int i = 0; i < 16; ++i) { const float p = __builtin_amdgcn_exp2f(sc[kb][i] - m); sc[kb][i] = p; den += p; }
        den += __shfl_xor(den, 32);
        const float inv = VS / den;
        if (DOSTORE && h == 0) LSE[((size_t)g * T + rowb + (size_t)(n * 128 + 32 * qb + r) * dil + z) * 8 + hg] = (m + __builtin_amdgcn_logf(den)) * (1.f / LOG2E);
        f32x16 o[2];
        o[0] = (f32x16){0.f, 0.f, 0.f, 0.f, 0.f, 0.f, 0.f, 0.f, 0.f, 0.f, 0.f, 0.f, 0.f, 0.f, 0.f, 0.f}; o[1] = o[0];
        const int q4 = (lane & 15) >> 2, blk16 = (lane >> 4) & 1, p4 = lane & 3;
#pragma unroll
        for (int kb = 0; kb < 5; ++kb)
#pragma unroll
            for (int s = 0; s < 2; ++s) {
                u32x4 pw;
                pw.x = cvtpk(sc[kb][8 * s + 0] * inv, sc[kb][8 * s + 1] * inv); pw.y = cvtpk(sc[kb][8 * s + 2] * inv, sc[kb][8 * s + 3] * inv);
                pw.z = cvtpk(sc[kb][8 * s + 4] * inv, sc[kb][8 * s + 5] * inv); pw.w = cvtpk(sc[kb][8 * s + 6] * inv, sc[kb][8 * s + 7] * inv);
                const bf16x8_t pa = __builtin_bit_cast(bf16x8_t, pw);
                const int row_lo = (32 * (qb + kb) + 16 * s + 4 * h + q4) ^ flip, row_hi = row_lo + 8;
#pragma unroll
                for (int db = 0; db < 2; ++db) {
                    const int chunk = 4 * db + 2 * blk16 + (p4 >> 1), sub = (p4 & 1) * 8;
                    const s16x4_t lo = tr_read_(Vimg + row_lo * 128 + ((chunk ^ (row_lo & 7)) << 4) + sub);
                    const s16x4_t hi = tr_read_(Vimg + row_hi * 128 + ((chunk ^ (row_hi & 7)) << 4) + sub);
                    const bf16x8_t vf = (bf16x8_t){lo[0], lo[1], lo[2], lo[3], hi[0], hi[1], hi[2], hi[3]};
                    o[db] = __builtin_amdgcn_mfma_f32_32x32x16_bf16(pa, vf, o[db], 0, 0, 0);
                }
            }
#pragma unroll
        for (int i = 0; i < 16; ++i) {
            const size_t row = rowb + (size_t)(n * 128 + 32 * qb + crow_(i, h)) * dil + z;
            bf16* op = OUTG + ((size_t)g * T + row) * 512 + hg * 64 + r;
            const unsigned w = cvtpk(o[0][i], o[1][i]);
            if (DOSTORE) { op[0] = (bf16)(w & 0xffffu); op[32] = (bf16)(w >> 16); } else asm volatile("" :: "v"(w));
        }
    }
#undef ATT_DECODE
#undef ATT_LOADBLK
#undef ATT_STOREBLK
    __syncthreads();
}
__device__ __forceinline__ void p_attn_merge(Frame& F) {
    const bf16* OUTG = (const bf16*)(F.ws + WS_OUTG); const float* LSE = (const float*)(F.ws + WS_LSE); bf16* AT = (bf16*)(F.ws + WS_ATTN);
    for (int idx = F.blk * NTHREADS + ((int)threadIdx.x); idx < T * 64; idx += F.nblk * NTHREADS) {
        const int row = idx >> 6, c8 = (idx & 63) * 8, hg = c8 >> 6;
        const float l0 = LSE[((size_t)0 * T + row) * 8 + hg], l1 = LSE[((size_t)1 * T + row) * 8 + hg], l2 = LSE[((size_t)2 * T + row) * 8 + hg];
        const float mx = fmaxf(l0, fmaxf(l1, l2)), e0 = __expf(l0 - mx), e1 = __expf(l1 - mx), e2 = __expf(l2 - mx), inv = 1.f / (e0 + e1 + e2);
        const float w[3] = {e0 * inv, e1 * inv, e2 * inv};
        float a[8] = {0.f, 0.f, 0.f, 0.f, 0.f, 0.f, 0.f, 0.f};
#pragma unroll
        for (int g = 0; g < 3; ++g) { const u32x4 v = *(const u32x4*)(OUTG + ((size_t)g * T + row) * 512 + c8);
            a[0] += w[g] * bflo(v.x); a[1] += w[g] * bfhi(v.x); a[2] += w[g] * bflo(v.y); a[3] += w[g] * bfhi(v.y);
            a[4] += w[g] * bflo(v.z); a[5] += w[g] * bfhi(v.z); a[6] += w[g] * bflo(v.w); a[7] += w[g] * bfhi(v.w); }
        u32x4 o; o.x = pk2(a[0], a[1]); o.y = pk2(a[2], a[3]); o.z = pk2(a[4], a[5]); o.w = pk2(a[6], a[7]);
        *(u32x4*)(AT + (size_t)row * 512 + c8) = o;
    }
}

__device__ __forceinline__ void p_conv(Frame& F) {
    const bf16* X = (const bf16*)(F.ws + WS_XBC); bf16* O = (bf16*)(F.ws + WS_CONV);
    const int total = T * (CONVD / 8);
    for (int idx = F.blk * NTHREADS + ((int)threadIdx.x); idx < total; idx += F.nblk * NTHREADS) {
        const int row = idx / (CONVD / 8), c0 = (idx % (CONVD / 8)) * 8, t = row & (SEQ - 1);
        float a[8];
#pragma unroll
        for (int i = 0; i < 8; ++i) a[i] = F.conv_b[c0 + i];
#pragma unroll
        for (int w = 0; w < 4; ++w) {
            const int tt = t + w - 3; if (tt < 0) continue;
            const u32x4 u = *(const u32x4*)(X + (size_t)(row + w - 3) * CONVD + c0);
            const float* cw = F.conv_w + (size_t)w * CONVD + c0;
            a[0] += cw[0] * bflo(u.x); a[1] += cw[1] * bfhi(u.x); a[2] += cw[2] * bflo(u.y); a[3] += cw[3] * bfhi(u.y);
            a[4] += cw[4] * bflo(u.z); a[5] += cw[5] * bfhi(u.z); a[6] += cw[6] * bflo(u.w); a[7] += cw[7] * bfhi(u.w);
        }
        u32x4 o; o.x = pk2(siluf_(a[0]), siluf_(a[1])); o.y = pk2(siluf_(a[2]), siluf_(a[3])); o.z = pk2(siluf_(a[4]), siluf_(a[5])); o.w = pk2(siluf_(a[6]), siluf_(a[7]));
        *(u32x4*)(O + (size_t)row * CONVD + c0) = o;
    }
}

__device__ __forceinline__ void p_ssd_naive(Frame& F) {
    const bf16* CV = (const bf16*)(F.ws + WS_CONV); const float* DT = (const float*)(F.ws + WS_DT); const bf16* Z = (const bf16*)(F.ws + WS_Z);
    bf16* YZ = (bf16*)(F.ws + WS_YZ);
    const int t256 = ((int)threadIdx.x) & 255, p = t256 >> 2, q = t256 & 3;
    for (int unit = F.blk * 2 + (((int)threadIdx.x) >> 8); unit < BATCH * NH_SSM; unit += F.nblk * 2) {
        const int b = unit / NH_SSM, h = unit % NH_SSM, g = h / 8;
        const float a = -__expf(F.a_log[h]), dsk = F.d_skip[h];
        float st[32];
#pragma unroll
        for (int i = 0; i < 32; ++i) st[i] = 0.f;
        for (int t = 0; t < SEQ; ++t) {
            const size_t row = (size_t)b * SEQ + t;
            const float dt = DT[(size_t)h * T + row];
            const float dA = __expf(dt * a);
            const float xv = bf2f(CV[row * CONVD + h * 64 + p]);
            const float dtx = dt * xv;
            const u32x4* bp = (const u32x4*)(CV + row * CONVD + 2048 + g * 128 + q * 32);
            const u32x4* cp = (const u32x4*)(CV + row * CONVD + 2560 + g * 128 + q * 32);
            float yp = 0.f;
#pragma unroll
            for (int c = 0; c < 4; ++c) {
                const u32x4 bw = bp[c], cw = cp[c];
                const float bv[8] = {bflo(bw.x), bfhi(bw.x), bflo(bw.y), bfhi(bw.y), bflo(bw.z), bfhi(bw.z), bflo(bw.w), bfhi(bw.w)};
                const float cv[8] = {bflo(cw.x), bfhi(cw.x), bflo(cw.y), bfhi(cw.y), bflo(cw.z), bfhi(cw.z), bflo(cw.w), bfhi(cw.w)};
#pragma unroll
                for (int i = 0; i < 8; ++i) { st[8 * c + i] = st[8 * c + i] * dA + dtx * bv[i]; yp += cv[i] * st[8 * c + i]; }
            }
            yp += __shfl_xor(yp, 1); yp += __shfl_xor(yp, 2);
            if (q == 0) {
                const float y = yp + dsk * xv;
                const float z = bf2f(Z[row * DI + h * 64 + p]);
                YZ[row * DI + h * 64 + p] = (bf16)f2bf(y * siluf_(z));
            }
        }
    }
}

__device__ __forceinline__ int swz256(int row, int chunk) { return row * 272 + (chunk << 4); }
__device__ __forceinline__ int swz128(int row, int chunk) { return row * 144 + (chunk << 4); }
__device__ __forceinline__ void p_ssd_fast(Frame& F) {
    const int lane = ((int)(threadIdx.x & 63u)), r = lane & 31, hh = lane >> 5, lb = F.wave & 3, pb = F.wave >> 2, tid = ((int)threadIdx.x);
    LAS unsigned char* Bimg = F.lds; LAS unsigned char* Cimg = F.lds + 34816; LAS unsigned char* Ximg = F.lds + 69632; LAS unsigned char* Xwimg = F.lds + 88064;
    LAS unsigned char* Simg = F.lds + 106496; LAS float* acs = (LAS float*)(F.lds + 123904); LAS float* dtv = (LAS float*)(F.lds + 124416);
    const bf16* CV = (const bf16*)(F.ws + WS_CONV); const float* DT = (const float*)(F.ws + WS_DT); bf16* Y = (bf16*)(F.ws + WS_YZ);
    const int q4 = (lane & 15) >> 2, blk16 = (lane >> 4) & 1, p4 = lane & 3;
    const f32x16 zero16 = {0.f, 0.f, 0.f, 0.f, 0.f, 0.f, 0.f, 0.f, 0.f, 0.f, 0.f, 0.f, 0.f, 0.f, 0.f, 0.f};
    for (int unit = F.blk; unit < BATCH * NH_SSM; unit += F.nblk) {
        const int b = unit / NH_SSM, h = unit % NH_SSM, g = h >> 3;
        const float a = -__expf(F.a_log[h]);
        f32x16 st = zero16;
        u32x4 rb[4], rc[4], rx[2]; float d0, d1;
#define SSD_LOAD(c) do { const size_t row0_ = (size_t)b * SEQ + (size_t)(c) * 128; \
            _Pragma("unroll") for (int i = 0; i < 4; ++i) { const int piece = tid + 512 * i, row = piece >> 4, ch = piece & 15; \
                rb[i] = *(const u32x4*)(CV + (row0_ + row) * CONVD + 2048 + g * 128 + ch * 8); rc[i] = *(const u32x4*)(CV + (row0_ + row) * CONVD + 2560 + g * 128 + ch * 8); } \
            _Pragma("unroll") for (int i = 0; i < 2; ++i) { const int piece = tid + 512 * i, row = piece >> 3, ch = piece & 7; rx[i] = *(const u32x4*)(CV + (row0_ + row) * CONVD + h * 64 + ch * 8); } \
            d0 = DT[(size_t)h * T + row0_ + lane]; d1 = DT[(size_t)h * T + row0_ + 64 + lane]; } while (0)
        SSD_LOAD(0);
        for (int c = 0; c < 16; ++c) {
            const size_t row0 = (size_t)b * SEQ + (size_t)c * 128;
            float x0 = d0 * a, x1 = d1 * a;
#pragma unroll
            for (int o = 1; o < 64; o <<= 1) { const float t0 = __shfl_up(x0, o), t1 = __shfl_up(x1, o); if (lane >= o) { x0 += t0; x1 += t1; } }
            x1 += __shfl(x0, 63);
            const float total = __shfl(x1, 63);
            __syncthreads();
            acs[lane] = x0; acs[64 + lane] = x1; dtv[lane] = d0; dtv[64 + lane] = d1;
#pragma unroll
            for (int i = 0; i < 4; ++i) { const int piece = tid + 512 * i, row = piece >> 4, ch = piece & 15;
                *(LAS u32x4*)(Bimg + swz256(row, ch)) = rb[i]; *(LAS u32x4*)(Cimg + swz256(row, ch)) = rc[i]; }
#pragma unroll
            for (int i = 0; i < 2; ++i) { const int piece = tid + 512 * i, row = piece >> 3, ch = piece & 7;
                const float w = __expf(total - acs[row]) * dtv[row];
                const u32x4 v = rx[i]; u32x4 o;
                o.x = pk2(bflo(v.x) * w, bfhi(v.x) * w); o.y = pk2(bflo(v.y) * w, bfhi(v.y) * w); o.z = pk2(bflo(v.z) * w, bfhi(v.z) * w); o.w = pk2(bflo(v.w) * w, bfhi(v.w) * w);
                *(LAS u32x4*)(Ximg + swz128(row, ch)) = v; *(LAS u32x4*)(Xwimg + swz128(row, ch)) = o; }
#pragma unroll
            for (int g4 = 0; g4 < 4; ++g4) { u32x2 w2; w2.x = pk2(st[4 * g4], st[4 * g4 + 1]); w2.y = pk2(st[4 * g4 + 2], st[4 * g4 + 3]);
                *(LAS u32x2*)(Simg + swz256(32 * pb + r, 4 * lb + g4) + 8 * hh) = w2; }
            __syncthreads();
            bf16x8_t cf[8];
#pragma unroll
            for (int kk = 0; kk < 8; ++kk) cf[kk] = *(const LAS bf16x8_t*)(Cimg + swz256(32 * lb + r, 2 * kk + hh));
            const float acs_l = acs[32 * lb + r];
            f32x16 yd = zero16;
            for (int sb = 0; sb <= lb; ++sb) {
                f32x16 gt = zero16;
#pragma unroll
                for (int kk = 0; kk < 8; ++kk) { const bf16x8_t bfm = *(const LAS bf16x8_t*)(Bimg + swz256(32 * sb + r, 2 * kk + hh)); gt = __builtin_amdgcn_mfma_f32_32x32x16_bf16(bfm, cf[kk], gt, 0, 0, 0); }
#pragma unroll
                for (int i = 0; i < 16; ++i) { const int s = 32 * sb + crow_(i, hh), l = 32 * lb + r;
                    const float e = __expf(fminf(acs_l - acs[s], 0.f)) * dtv[s];
                    gt[i] = (s <= l) ? gt[i] * e : 0.f; }
#pragma unroll
                for (int q = 0; q < 2; ++q) {
                    u32x4 pw; pw.x = pk2(gt[8 * q], gt[8 * q + 1]); pw.y = pk2(gt[8 * q + 2], gt[8 * q + 3]); pw.z = pk2(gt[8 * q + 4], gt[8 * q + 5]); pw.w = pk2(gt[8 * q + 6], gt[8 * q + 7]);
                    const bf16x8_t pa = __builtin_bit_cast(bf16x8_t, pw);
                    const int row_lo = 32 * sb + 16 * q + 4 * hh + q4, row_hi = row_lo + 8, chunk = 4 * pb + 2 * blk16 + (p4 >> 1), sub = (p4 & 1) * 8;
                    const s16x4_t lo = tr_read_(Ximg + swz128(row_lo, chunk) + sub), hi = tr_read_(Ximg + swz128(row_hi, chunk) + sub);
                    const bf16x8_t xf = (bf16x8_t){lo[0], lo[1], lo[2], lo[3], hi[0], hi[1], hi[2], hi[3]};
                    yd = __builtin_amdgcn_mfma_f32_32x32x16_bf16(pa, xf, yd, 0, 0, 0);
                }
            }
            f32x16 yo = zero16;
#pragma unroll
            for (int kk = 0; kk < 8; ++kk) { const bf16x8_t sf = *(const LAS bf16x8_t*)(Simg + swz256(32 * pb + r, 2 * kk + hh)); yo = __builtin_amdgcn_mfma_f32_32x32x16_bf16(cf[kk], sf, yo, 0, 0, 0); }
#pragma unroll
            for (int i = 0; i < 16; ++i) { const int l = 32 * lb + crow_(i, hh);
                const float y = yd[i] + __expf(acs[l]) * yo[i];
                Y[(row0 + l) * DI + h * 64 + 32 * pb + r] = (bf16)f2bf(y); }
            if (c + 1 < 16) SSD_LOAD(c + 1);
            const float cd = __expf(total);
#pragma unroll
            for (int i = 0; i < 16; ++i) st[i] *= cd;
#pragma unroll
            for (int kk = 0; kk < 8; ++kk) {
                const int row_lo = 16 * kk + 4 * hh + q4, row_hi = row_lo + 8, sub = (p4 & 1) * 8;
                const int chb = 4 * lb + 2 * blk16 + (p4 >> 1), chx = 4 * pb + 2 * blk16 + (p4 >> 1);
                const s16x4_t blo = tr_read_(Bimg + swz256(row_lo, chb) + sub), bhi = tr_read_(Bimg + swz256(row_hi, chb) + sub);
                const s16x4_t xlo = tr_read_(Xwimg + swz128(row_lo, chx) + sub), xhi = tr_read_(Xwimg + swz128(row_hi, chx) + sub);
                const bf16x8_t af = (bf16x8_t){blo[0], blo[1], blo[2], blo[3], bhi[0], bhi[1], bhi[2], bhi[3]};
                const bf16x8_t xf = (bf16x8_t){xlo[0], xlo[1], xlo[2], xlo[3], xhi[0], xhi[1], xhi[2], xhi[3]};
                st = __builtin_amdgcn_mfma_f32_32x32x16_bf16(af, xf, st, 0, 0, 0);
            }
        }
#undef SSD_LOAD
    }
    __syncthreads();
}
__device__ __forceinline__ void p_ssd_fast2(Frame& F) {
    const int lane = ((int)(threadIdx.x & 63u)), r = lane & 31, hh = lane >> 5, pb = F.wave >> 2, nb = F.wave & 3, lb = pb ? 3 - nb : nb, tid = ((int)threadIdx.x);
#define SSD2_PTRS() unsigned opq_ = 0; asm volatile("" : "+s"(opq_)); \
    LAS unsigned char* const Bimg = F.lds + opq_; LAS unsigned char* const Cimg = Bimg + 34816; LAS unsigned char* const Ximg0 = Bimg + 69632; LAS unsigned char* const Simg0 = Bimg + 106496; \
    LAS float* const tab0 = (LAS float*)(Bimg + 141312); \
    const bf16* const CV = (const bf16*)(F.ws + WS_CONV + opq_); const float* const DT = (const float*)(F.ws + WS_DT + opq_); bf16* const Y = (bf16*)(F.ws + WS_YZ + opq_); \
    int tidl_ = ((int)threadIdx.x); asm volatile("" : "+v"(tidl_)); const int tid = tidl_, lane = tid & 63, r = lane & 31, hh = lane >> 5, q4 = (lane & 15) >> 2, blk16 = (lane >> 4) & 1, p4 = lane & 3; \
    (void)tid; (void)r; (void)hh; (void)q4; (void)blk16; (void)p4
    const int q4 = (lane & 15) >> 2, blk16 = (lane >> 4) & 1, p4 = lane & 3;
    const f32x16 zero16 = {0.f, 0.f, 0.f, 0.f, 0.f, 0.f, 0.f, 0.f, 0.f, 0.f, 0.f, 0.f, 0.f, 0.f, 0.f, 0.f};
    for (int unit = F.blk; unit < BATCH * NG_SSM * 4; unit += F.nblk) {
        const int b = unit >> 4, g = (unit >> 2) & 3, h0 = 8 * g + 2 * (unit & 3);
        const float a0 = -__expf(F.a_log[h0]), a1 = -__expf(F.a_log[h0 + 1]), dsk0 = F.d_skip[h0], dsk1 = F.d_skip[h0 + 1];
        f32x16 st[2]; st[0] = zero16; st[1] = zero16;
        u32x4 rb[4], rc[4], rx[2][2]; float d[2][2];
#define SSD2_LOAD(c) do { const size_t row0_ = (size_t)b * SEQ + (size_t)(c) * 128; \
            _Pragma("unroll") for (int i = 0; i < 4; ++i) { const int piece = tid + 512 * i, row = piece >> 4, ch = piece & 15; \
                rb[i] = *(const u32x4*)(CV + (row0_ + row) * CONVD + 2048 + g * 128 + ch * 8); rc[i] = *(const u32x4*)(CV + (row0_ + row) * CONVD + 2560 + g * 128 + ch * 8); } \
            _Pragma("unroll") for (int e = 0; e < 2; ++e) { \
                _Pragma("unroll") for (int i = 0; i < 2; ++i) { const int piece = tid + 512 * i, row = piece >> 3, ch = piece & 7; rx[e][i] = *(const u32x4*)(CV + (row0_ + row) * CONVD + (h0 + e) * 64 + ch * 8); } \
                d[e][0] = DT[(size_t)(h0 + e) * T + row0_ + lane]; d[e][1] = DT[(size_t)(h0 + e) * T + row0_ + 64 + lane]; } } while (0)
        { SSD2_PTRS(); SSD2_LOAD(0); }
        for (int c = 0; c < 16; ++c) {
            const size_t row0 = (size_t)b * SEQ + (size_t)c * 128;
            float x0[2], x1[2], total[2];
#pragma unroll
            for (int e = 0; e < 2; ++e) { const float a = e ? a1 : a0; x0[e] = d[e][0] * a; x1[e] = d[e][1] * a; }
#pragma unroll
            for (int o = 1; o < 64; o <<= 1) {
#pragma unroll
                for (int e = 0; e < 2; ++e) { const float t0 = __shfl_up(x0[e], o), t1 = __shfl_up(x1[e], o); if (lane >= o) { x0[e] += t0; x1[e] += t1; } } }
#pragma unroll
            for (int e = 0; e < 2; ++e) { x1[e] += __shfl(x0[e], 63); total[e] = __shfl(x1[e], 63); }
            LDS_BARRIER();
            for (int repw_ = 0; repw_ < SSD_REP_W; ++repw_) { SSD2_PTRS();
#pragma unroll
            for (int e = 0; e < 2; ++e) { LAS float* const tb = tab0 + 704 * e;
                tb[lane] = x0[e]; tb[64 + lane] = x1[e]; tb[128 + lane] = d[e][0]; tb[192 + lane] = d[e][1];
                tb[256 + lane] = __expf(total[e] - x0[e]) * d[e][0]; tb[320 + lane] = __expf(total[e] - x1[e]) * d[e][1];
                tb[384 + lane] = __expf(x0[e]); tb[448 + lane] = __expf(x1[e]);
                const float a32 = __shfl(x0[e], 32), a64 = __shfl(x1[e], 0), a96 = __shfl(x1[e], 32);
                if (lane < 32) { tb[512 + lane] = __expf(a32 - x0[e]) * d[e][0]; tb[512 + 96 + 64 + lane] = __expf(a96 - x1[e]) * d[e][1]; }
                tb[512 + 32 + lane] = __expf(a64 - x0[e]) * d[e][0]; tb[512 + 96 + lane] = __expf(a96 - x0[e]) * d[e][0]; }
#pragma unroll
            for (int i = 0; i < 4; ++i) { const int piece = tid + 512 * i, row = piece >> 4, ch = piece & 15;
                *(LAS u32x4*)(Bimg + swz256(row, ch)) = rb[i]; *(LAS u32x4*)(Cimg + swz256(row, ch)) = rc[i]; }
#pragma unroll
            for (int e = 0; e < 2; ++e) {
#pragma unroll
                for (int i = 0; i < 2; ++i) { const int piece = tid + 512 * i, row = piece >> 3, ch = piece & 7; *(LAS u32x4*)(Ximg0 + 18432 * e + swz128(row, ch)) = rx[e][i]; }
#pragma unroll
                for (int g4 = 0; g4 < 4; ++g4) { u32x2 w2; w2.x = cvtpk(st[e][4 * g4], st[e][4 * g4 + 1]); w2.y = cvtpk(st[e][4 * g4 + 2], st[e][4 * g4 + 3]);
                    *(LAS u32x2*)(Simg0 + 17408 * e + swz256(32 * pb + r, 4 * nb + g4) + 8 * hh) = w2; }
            }
            }
            LDS_BARRIER();
            { SSD2_PTRS(); if (c + 1 < 16) SSD2_LOAD(c + 1); }
            for (int repa_ = 0; repa_ < SSD_REP_A; ++repa_) { SSD2_PTRS();
            bf16x8_t cf[8];
#pragma unroll
            for (int kk = 0; kk < 8; ++kk) cf[kk] = *(const LAS bf16x8_t*)(Cimg + swz256(32 * lb + r, 2 * kk + hh));
            const float acs_l0 = tab0[32 * lb + r], acs_l1 = tab0[704 + 32 * lb + r];
            const float e1_0 = __expf(acs_l0 - tab0[32 * lb]), e1_1 = __expf(acs_l1 - tab0[704 + 32 * lb]);
            const int e2off = lb == 1 ? 0 : (lb == 2 ? 32 : 96);
            f32x16 yd[2]; yd[0] = zero16; yd[1] = zero16;
            for (int sb = 0; sb <= lb; ++sb) {
                f32x16 gt = zero16;
#pragma unroll
                for (int kk = 0; kk < 8; ++kk) { const bf16x8_t bfm = *(const LAS bf16x8_t*)(Bimg + swz256(32 * sb + r, 2 * kk + hh)); gt = __builtin_amdgcn_mfma_f32_32x32x16_bf16(bfm, cf[kk], gt, 0, 0, 0); }
#pragma unroll
                for (int e = 0; e < 2; ++e) {
                    const LAS float* const tb = tab0 + 704 * e;
                    float gv[16];
                    if (sb < lb) {
                        const float e1 = e ? e1_1 : e1_0;
#pragma unroll
                        for (int g4 = 0; g4 < 4; ++g4) { const f32x4 t = *(const LAS f32x4*)(tb + 512 + e2off + 32 * sb + 8 * g4 + 4 * hh);
                            gv[4 * g4] = gt[4 * g4] * (t.x * e1); gv[4 * g4 + 1] = gt[4 * g4 + 1] * (t.y * e1); gv[4 * g4 + 2] = gt[4 * g4 + 2] * (t.z * e1); gv[4 * g4 + 3] = gt[4 * g4 + 3] * (t.w * e1); }
                    } else {
                        const float acs_l = e ? acs_l1 : acs_l0;
#pragma unroll
                        for (int g4 = 0; g4 < 4; ++g4) { const f32x4 ta = *(const LAS f32x4*)(tb + 32 * sb + 8 * g4 + 4 * hh), td = *(const LAS f32x4*)(tb + 128 + 32 * sb + 8 * g4 + 4 * hh);
                            const float av[4] = {ta.x, ta.y, ta.z, ta.w}, dv[4] = {td.x, td.y, td.z, td.w};
#pragma unroll
                            for (int j = 0; j < 4; ++j) { const int sl = 8 * g4 + 4 * hh + j;
                                gv[4 * g4 + j] = (sl <= r) ? gt[4 * g4 + j] * (__expf(fminf(acs_l - av[j], 0.f)) * dv[j]) : 0.f; } }
                    }
#pragma unroll
                    for (int q = 0; q < 2; ++q) {
                        u32x4 pw; pw.x = cvtpk(gv[8 * q], gv[8 * q + 1]); pw.y = cvtpk(gv[8 * q + 2], gv[8 * q + 3]); pw.z = cvtpk(gv[8 * q + 4], gv[8 * q + 5]); pw.w = cvtpk(gv[8 * q + 6], gv[8 * q + 7]);
                        const bf16x8_t pa = __builtin_bit_cast(bf16x8_t, pw);
                        const int row_lo = 32 * sb + 16 * q + 4 * hh + q4, row_hi = row_lo + 8, chunk = 4 * pb + 2 * blk16 + (p4 >> 1), sub = (p4 & 1) * 8;
                        const s16x4_t lo = tr_read_(Ximg0 + 18432 * e + swz128(row_lo, chunk) + sub), hi = tr_read_(Ximg0 + 18432 * e + swz128(row_hi, chunk) + sub);
                        const bf16x8_t xf = (bf16x8_t){lo[0], lo[1], lo[2], lo[3], hi[0], hi[1], hi[2], hi[3]};
                        yd[e] = __builtin_amdgcn_mfma_f32_32x32x16_bf16(pa, xf, yd[e], 0, 0, 0);
                    }
                }
            }
#pragma unroll
            for (int e = 0; e < 2; ++e) {
                f32x16 yo = zero16;
#pragma unroll
                for (int kk = 0; kk < 8; ++kk) { const bf16x8_t sf = *(const LAS bf16x8_t*)(Simg0 + 17408 * e + swz256(32 * pb + r, 2 * kk + hh)); yo = __builtin_amdgcn_mfma_f32_32x32x16_bf16(cf[kk], sf, yo, 0, 0, 0); }
#pragma unroll
                for (int g4 = 0; g4 < 4; ++g4) { const f32x4 ea = *(const LAS f32x4*)(tab0 + 704 * e + 384 + 32 * lb + 8 * g4 + 4 * hh); const float eav[4] = {ea.x, ea.y, ea.z, ea.w};
                    const s16x4_t xs4 = tr_read_(Ximg0 + 18432 * e + swz128(32 * lb + 8 * g4 + 4 * hh + q4, 4 * pb + 2 * blk16 + (p4 >> 1)) + (p4 & 1) * 8);
#pragma unroll
                    for (int j = 0; j < 4; ++j) { const int i = 4 * g4 + j, l = 32 * lb + 8 * g4 + 4 * hh + j;
                        const float y = yd[e][i] + eav[j] * yo[i] + (e ? dsk1 : dsk0) * bf2f((bf16)xs4[j]);
                        Y[(row0 + l) * DI + (h0 + e) * 64 + 32 * pb + r] = (bf16)(cvtpk(y, y) & 0xffffu); } }
            }
            }
            { SSD2_PTRS();
            { const float cd0 = __expf(total[0]), cd1 = __expf(total[1]);
#pragma unroll
              for (int i = 0; i < 16; ++i) { st[0][i] *= cd0; st[1][i] *= cd1; } }
#pragma unroll
            for (int kk = 0; kk < 8; ++kk) {
                const int row_lo = 16 * kk + 4 * hh + q4, row_hi = row_lo + 8, sub = (p4 & 1) * 8;
                const int chb = 4 * nb + 2 * blk16 + (p4 >> 1), chx = 4 * pb + 2 * blk16 + (p4 >> 1);
                const s16x4_t blo = tr_read_(Bimg + swz256(row_lo, chb) + sub), bhi = tr_read_(Bimg + swz256(row_hi, chb) + sub);
                const bf16x8_t af = (bf16x8_t){blo[0], blo[1], blo[2], blo[3], bhi[0], bhi[1], bhi[2], bhi[3]};
#pragma unroll
                for (int e = 0; e < 2; ++e) {
                    const s16x4_t xlo = tr_read_(Ximg0 + 18432 * e + swz128(row_lo, chx) + sub), xhi = tr_read_(Ximg0 + 18432 * e + swz128(row_hi, chx) + sub);
                    const f32x4 wl = *(const LAS f32x4*)(tab0 + 704 * e + 256 + 16 * kk + 4 * hh), wh = *(const LAS f32x4*)(tab0 + 704 * e + 256 + 16 * kk + 8 + 4 * hh);
                    u32x4 pw;
                    pw.x = cvtpk(bf2f((bf16)xlo[0]) * wl.x, bf2f((bf16)xlo[1]) * wl.y); pw.y = cvtpk(bf2f((bf16)xlo[2]) * wl.z, bf2f((bf16)xlo[3]) * wl.w);
                    pw.z = cvtpk(bf2f((bf16)xhi[0]) * wh.x, bf2f((bf16)xhi[1]) * wh.y); pw.w = cvtpk(bf2f((bf16)xhi[2]) * wh.z, bf2f((bf16)xhi[3]) * wh.w);
                    st[e] = __builtin_amdgcn_mfma_f32_32x32x16_bf16(af, __builtin_bit_cast(bf16x8_t, pw), st[e], 0, 0, 0);
                }
            }
            }
        }
#undef SSD2_LOAD
#undef SSD2_PTRS
    }
    __syncthreads();
}

__device__ __forceinline__ void p_ypost2(Frame& F) {
    const int gw = F.blk * NWAVES + F.wave, NGW = F.nblk * NWAVES;
    const bf16* Y = (const bf16*)(F.ws + WS_YZ); const bf16* CV = (const bf16*)(F.ws + WS_CONV); const bf16* Z = (const bf16*)(F.ws + WS_Z); bf16* YN = (bf16*)(F.ws + WS_YN);
    for (int m = gw; m < T; m += NGW) {
#pragma unroll
        for (int g = 0; g < 4; ++g) {
            const int c0 = g * 512 + ((int)(threadIdx.x & 63u)) * 8;
            const u32x4 yw = __builtin_nontemporal_load((const u32x4*)(Y + (size_t)m * DI + c0)), zw = __builtin_nontemporal_load((const u32x4*)(Z + (size_t)m * DI + c0));
            const float yv[8] = {bflo(yw.x), bfhi(yw.x), bflo(yw.y), bfhi(yw.y), bflo(yw.z), bfhi(yw.z), bflo(yw.w), bfhi(yw.w)};
            const float zv[8] = {bflo(zw.x), bfhi(zw.x), bflo(zw.y), bfhi(zw.y), bflo(zw.z), bfhi(zw.z), bflo(zw.w), bfhi(zw.w)};
            float v[8]; float s = 0.f;
#pragma unroll
            for (int i = 0; i < 8; ++i) { v[i] = yv[i] * siluf_(zv[i]); s += v[i] * v[i]; }
            const float rstd = 1.f / sqrtf(wave_sum(s) * (1.f / 512.f) + EPS);
            const float* nw = F.ssm_norm_w + c0;
            u32x4 o; o.x = pk2(v[0] * rstd * nw[0], v[1] * rstd * nw[1]); o.y = pk2(v[2] * rstd * nw[2], v[3] * rstd * nw[3]);
            o.z = pk2(v[4] * rstd * nw[4], v[5] * rstd * nw[5]); o.w = pk2(v[6] * rstd * nw[6], v[7] * rstd * nw[7]);
            *(u32x4*)(YN + (size_t)m * DI + c0) = o;
        }
    }
}

__device__ __forceinline__ void p_ypost(Frame& F) {
    const int gw = F.blk * NWAVES + F.wave, NGW = F.nblk * NWAVES;
    const bf16* YZ = (const bf16*)(F.ws + WS_YZ); bf16* YN = (bf16*)(F.ws + WS_YN);
    for (int m = gw; m < T; m += NGW) {
#pragma unroll
        for (int g = 0; g < 4; ++g) {
            const int c0 = g * 512 + ((int)(threadIdx.x & 63u)) * 8;
            const u32x4 w = *(const u32x4*)(YZ + (size_t)m * DI + c0);
            float v[8] = {bflo(w.x), bfhi(w.x), bflo(w.y), bfhi(w.y), bflo(w.z), bfhi(w.z), bflo(w.w), bfhi(w.w)};
            float s = 0.f;
#pragma unroll
            for (int i = 0; i < 8; ++i) s += v[i] * v[i];
            const float rstd = 1.f / sqrtf(wave_sum(s) * (1.f / 512.f) + EPS);
            const float* nw = F.ssm_norm_w + c0;
            u32x4 o; o.x = pk2(v[0] * rstd * nw[0], v[1] * rstd * nw[1]); o.y = pk2(v[2] * rstd * nw[2], v[3] * rstd * nw[3]);
            o.z = pk2(v[4] * rstd * nw[4], v[5] * rstd * nw[5]); o.w = pk2(v[6] * rstd * nw[6], v[7] * rstd * nw[7]);
            *(u32x4*)(YN + (size_t)m * DI + c0) = o;
        }
    }
}

__device__ __forceinline__ void p_router(Frame& F) {
    LAS int* hist = (LAS int*)F.lds;
    if (((int)threadIdx.x) < 32) hist[((int)threadIdx.x)] = 0;
    __syncthreads();
    int* ROWMAP = (int*)(F.ws + WS_ROWMAP);
    for (int i = F.blk * NTHREADS + ((int)threadIdx.x); i < CAP; i += F.nblk * NTHREADS) ROWMAP[i] = -1;
    const int gw = F.blk * NWAVES + F.wave, NGW = F.nblk * NWAVES;
    bf16* XN2 = (bf16*)(F.ws + WS_XN2); int* TOPI = (int*)(F.ws + WS_TOPI); float* TOPW = (float*)(F.ws + WS_TOPW);
    for (int m = gw; m < T; m += NGW) {
        const f32x4* xr = (const f32x4*)(F.out + (size_t)m * D) + ((int)(threadIdx.x & 63u));
        const f32x4* wr = (const f32x4*)F.norm_ffn + ((int)(threadIdx.x & 63u));
        f32x4 v[4]; float s = 0.f;
#pragma unroll
        for (int j = 0; j < 4; ++j) { v[j] = xr[64 * j]; s += (v[j].x * v[j].x + v[j].y * v[j].y) + (v[j].z * v[j].z + v[j].w * v[j].w); }
        const float rstd = 1.f / sqrtf(wave_sum(s) * (1.f / D) + EPS);
        float lg[32];
#pragma unroll
        for (int e = 0; e < 32; ++e) lg[e] = 0.f;
#pragma unroll
        for (int j = 0; j < 4; ++j) {
            v[j] = v[j] * rstd * wr[64 * j];
            st_bf4(XN2 + (size_t)m * D + (((int)(threadIdx.x & 63u)) + 64 * j) * 4, v[j]);
            const float hv[4] = {v[j].x, v[j].y, v[j].z, v[j].w};
#pragma unroll
            for (int i = 0; i < 4; ++i) {
                const f32x4* rw = (const f32x4*)(F.router_w + (size_t)((((int)(threadIdx.x & 63u)) + 64 * j) * 4 + i) * 32);
#pragma unroll
                for (int c = 0; c < 8; ++c) { const f32x4 w = rw[c]; lg[4 * c] += hv[i] * w.x; lg[4 * c + 1] += hv[i] * w.y; lg[4 * c + 2] += hv[i] * w.z; lg[4 * c + 3] += hv[i] * w.w; }
            }
        }
#pragma unroll
        for (int e = 0; e < 32; ++e) lg[e] = wave_sum(lg[e]) + F.router_b[e];
        int bi[4]; float bv[4];
#pragma unroll
        for (int k = 0; k < 4; ++k) {
            float best = -INFINITY; int be = 0;
#pragma unroll
            for (int e = 0; e < 32; ++e) if (lg[e] > best) { best = lg[e]; be = e; }
            bi[k] = be; bv[k] = best;
#pragma unroll
            for (int e = 0; e < 32; ++e) if (e == be) lg[e] = -INFINITY;
        }
        const float e0 = 1.f, e1 = __expf(bv[1] - bv[0]), e2 = __expf(bv[2] - bv[0]), e3 = __expf(bv[3] - bv[0]);
        const float inv = 1.f / (e0 + e1 + e2 + e3);
        if (((int)(threadIdx.x & 63u)) == 0) {
            *(int4*)(TOPI + (size_t)m * 4) = make_int4(bi[0], bi[1], bi[2], bi[3]);
            *(f32x4*)(TOPW + (size_t)m * 4) = (f32x4){e0 * inv, e1 * inv, e2 * inv, e3 * inv};
            atomicAdd((int*)&hist[bi[0]], 1); atomicAdd((int*)&hist[bi[1]], 1); atomicAdd((int*)&hist[bi[2]], 1); atomicAdd((int*)&hist[bi[3]], 1);
        }
    }
    __syncthreads();
    if (((int)threadIdx.x) < 32) atomicAdd((unsigned*)(F.ctl + CW_CNT + 64 * ((int)threadIdx.x)), (unsigned)hist[((int)threadIdx.x)]);
    __syncthreads();
}

__device__ __forceinline__ void p_conv2(Frame& F) {
    const bf16* X = (const bf16*)(F.ws + WS_XBC); bf16* O = (bf16*)(F.ws + WS_CONV);
    constexpr int NCG = CONVD / 8, total = (T / 8) * NCG;
    for (int idx = F.blk * NTHREADS + ((int)threadIdx.x); idx < total; idx += F.nblk * NTHREADS) {
        const int cg = idx % NCG, tb = idx / NCG, c0 = cg * 8, row0 = tb * 8, t0 = row0 & (SEQ - 1);
        float cw[4][8], cb[8];
#pragma unroll
        for (int w = 0; w < 4; ++w) { const f32x4 a = *(const f32x4*)(F.conv_w + (size_t)w * CONVD + c0), b = *(const f32x4*)(F.conv_w + (size_t)w * CONVD + c0 + 4);
            cw[w][0] = a.x; cw[w][1] = a.y; cw[w][2] = a.z; cw[w][3] = a.w; cw[w][4] = b.x; cw[w][5] = b.y; cw[w][6] = b.z; cw[w][7] = b.w; }
        { const f32x4 a = *(const f32x4*)(F.conv_b + c0), b = *(const f32x4*)(F.conv_b + c0 + 4); cb[0] = a.x; cb[1] = a.y; cb[2] = a.z; cb[3] = a.w; cb[4] = b.x; cb[5] = b.y; cb[6] = b.z; cb[7] = b.w; }
        u32x4 raw[11];
#pragma unroll
        for (int i = 0; i < 11; ++i) { raw[i] = (u32x4){0u, 0u, 0u, 0u}; if (t0 + i - 3 >= 0) raw[i] = *(const u32x4*)(X + (size_t)(row0 + i - 3) * CONVD + c0); }
        float acc[8][8];
#pragma unroll
        for (int tt = 0; tt < 8; ++tt)
#pragma unroll
            for (int c = 0; c < 8; ++c) acc[tt][c] = cb[c];
#pragma unroll
        for (int i = 0; i < 11; ++i) {
            const float xv[8] = {bflo(raw[i].x), bfhi(raw[i].x), bflo(raw[i].y), bfhi(raw[i].y), bflo(raw[i].z), bfhi(raw[i].z), bflo(raw[i].w), bfhi(raw[i].w)};
#pragma unroll
            for (int w = 0; w < 4; ++w) { const int tt = i - w;
                if (tt >= 0 && tt < 8) {
#pragma unroll
                    for (int c = 0; c < 8; ++c) acc[tt][c] += cw[w][c] * xv[c]; } }
        }
#pragma unroll
        for (int tt = 0; tt < 8; ++tt) { u32x4 o; o.x = pk2(siluf_(acc[tt][0]), siluf_(acc[tt][1])); o.y = pk2(siluf_(acc[tt][2]), siluf_(acc[tt][3]));
            o.z = pk2(siluf_(acc[tt][4]), siluf_(acc[tt][5])); o.w = pk2(siluf_(acc[tt][6]), siluf_(acc[tt][7]));
            *(u32x4*)(O + (size_t)(row0 + tt) * CONVD + c0) = o; }
    }
}

__device__ __forceinline__ void p_router2(Frame& F) {
    LAS float* WrT = (LAS float*)F.lds;
    LAS int* hist = (LAS int*)(F.lds + 131072);
    if (((int)threadIdx.x) < 32) hist[((int)threadIdx.x)] = 0;
    for (int i = ((int)threadIdx.x); i < 1024 * 8; i += NTHREADS) { const int k = i >> 3, e4 = (i & 7) * 4; const f32x4 w = *(const f32x4*)(F.router_w + (size_t)k * 32 + e4);
        WrT[(e4 + 0) * 1024 + k] = w.x; WrT[(e4 + 1) * 1024 + k] = w.y; WrT[(e4 + 2) * 1024 + k] = w.z; WrT[(e4 + 3) * 1024 + k] = w.w; }
    int* ROWMAP = (int*)(F.ws + WS_ROWMAP);
    for (int i = F.blk * NTHREADS + ((int)threadIdx.x); i < CAP; i += F.nblk * NTHREADS) ROWMAP[i] = -1;
    __syncthreads();
    const int lane = ((int)(threadIdx.x & 63u)), gw = F.blk * NWAVES + F.wave, NGW = F.nblk * NWAVES;
    bf16* XN2 = (bf16*)(F.ws + WS_XN2); int* TOPI = (int*)(F.ws + WS_TOPI); float* TOPW = (float*)(F.ws + WS_TOPW);
    const float rb = F.router_b[lane >> 1];
    for (int mp = gw; mp < T / 2; mp += NGW) {
        f32x4 v[2][4];
#pragma unroll
        for (int j = 0; j < 2; ++j) {
            const int m = mp * 2 + j;
            const f32x4* xr = (const f32x4*)(F.out + (size_t)m * D) + lane; const f32x4* wr = (const f32x4*)F.norm_ffn + lane;
            float s = 0.f;
#pragma unroll
            for (int q = 0; q < 4; ++q) { v[j][q] = xr[64 * q]; s += (v[j][q].x * v[j][q].x + v[j][q].y * v[j][q].y) + (v[j][q].z * v[j][q].z + v[j][q].w * v[j][q].w); }
            const float rstd = 1.f / sqrtf(wave_sum(s) * (1.f / D) + EPS);
#pragma unroll
            for (int q = 0; q < 4; ++q) { v[j][q] = v[j][q] * rstd * wr[64 * q];
#if MOE_FP8
                *(unsigned*)((unsigned char*)XN2 + (size_t)m * D + (lane + 64 * q) * 4) = pk_fp8x4(FP8_ASCALE * v[j][q].x, FP8_ASCALE * v[j][q].y, FP8_ASCALE * v[j][q].z, FP8_ASCALE * v[j][q].w);
#else
                st_bf4(XN2 + (size_t)m * D + (lane + 64 * q) * 4, v[j][q]);
#endif
            }
        }
        float p0[32], p1[32];
        f32x2_t tv[4][4];
#pragma unroll
        for (int q = 0; q < 4; ++q) { tv[q][0] = (f32x2_t){v[0][q].x, v[1][q].x}; tv[q][1] = (f32x2_t){v[0][q].y, v[1][q].y}; tv[q][2] = (f32x2_t){v[0][q].z, v[1][q].z}; tv[q][3] = (f32x2_t){v[0][q].w, v[1][q].w}; }
#pragma unroll
        for (int e = 0; e < 32; ++e) {
            f32x2_t a = {0.f, 0.f};
#pragma unroll
            for (int q = 0; q < 4; ++q) { const f32x4 w = *(const LAS f32x4*)(WrT + e * 1024 + (lane + 64 * q) * 4);
                a = __builtin_elementwise_fma(tv[q][0], (f32x2_t){w.x, w.x}, a); a = __builtin_elementwise_fma(tv[q][1], (f32x2_t){w.y, w.y}, a);
                a = __builtin_elementwise_fma(tv[q][2], (f32x2_t){w.z, w.z}, a); a = __builtin_elementwise_fma(tv[q][3], (f32x2_t){w.w, w.w}, a); }
            p0[e] = a.x; p1[e] = a.y;
        }
#define RS_STEP(P, N, MASK) do { const bool up = (lane & (MASK)) != 0; _Pragma("unroll") for (int i = 0; i < (N); ++i) { const float mine = up ? P[(N) + i] : P[i], other = up ? P[i] : P[(N) + i]; P[i] = mine + __shfl_xor(other, (MASK)); } } while (0)
        RS_STEP(p0, 16, 32); RS_STEP(p0, 8, 16); RS_STEP(p0, 4, 8); RS_STEP(p0, 2, 4); RS_STEP(p0, 1, 2);
        RS_STEP(p1, 16, 32); RS_STEP(p1, 8, 16); RS_STEP(p1, 4, 8); RS_STEP(p1, 2, 4); RS_STEP(p1, 1, 2);
#undef RS_STEP
        float lg[2] = {p0[0] + __shfl_xor(p0[0], 1) + rb, p1[0] + __shfl_xor(p1[0], 1) + rb};
#pragma unroll
        for (int j = 0; j < 2; ++j) {
            const int m = mp * 2 + j; float val = lg[j]; int bi[4]; float bv[4];
#pragma unroll
            for (int k = 0; k < 4; ++k) {
                float mx = val;
#pragma unroll
                for (int o = 1; o < 64; o <<= 1) mx = fmaxf(mx, __shfl_xor(mx, o));
                const unsigned long long bal = __ballot(val == mx);
                const int e = (int)(__ffsll((long long)bal) - 1) >> 1;
                bi[k] = e; bv[k] = mx;
                if ((lane >> 1) == e) val = -INFINITY;
            }
            const float e1 = __expf(bv[1] - bv[0]), e2 = __expf(bv[2] - bv[0]), e3 = __expf(bv[3] - bv[0]);
            const float inv = 1.f / (1.f + e1 + e2 + e3);
            if (lane == 0) {
                *(int4*)(TOPI + (size_t)m * 4) = make_int4(bi[0], bi[1], bi[2], bi[3]);
                *(f32x4*)(TOPW + (size_t)m * 4) = (f32x4){inv, e1 * inv, e2 * inv, e3 * inv};
                atomicAdd((int*)&hist[bi[0]], 1); atomicAdd((int*)&hist[bi[1]], 1); atomicAdd((int*)&hist[bi[2]], 1); atomicAdd((int*)&hist[bi[3]], 1);
            }
        }
    }
    __syncthreads();
    if (((int)threadIdx.x) < 32) atomicAdd((unsigned*)(F.ctl + CW_CNT + 64 * ((int)threadIdx.x)), (unsigned)hist[((int)threadIdx.x)]);
    __syncthreads();
}

__device__ __forceinline__ void p_router3(Frame& F) {
    LAS float* XS = (LAS float*)F.lds; LAS float* PW = (LAS float*)(F.lds + 66048); LAS float* P = (LAS float*)(F.lds + 66048 + 33792); LAS int* hist = (LAS int*)(F.lds + 66048 + 33792 + 4224);
    if (((int)threadIdx.x) < 32) hist[((int)threadIdx.x)] = 0;
    int* ROWMAP = (int*)(F.ws + WS_ROWMAP);
    for (int i = F.blk * NTHREADS + ((int)threadIdx.x); i < CAP; i += F.nblk * NTHREADS) ROWMAP[i] = -1;
    const int lane = ((int)(threadIdx.x & 63u)), tid = (int)threadIdx.x;
    bf16* XN2 = (bf16*)(F.ws + WS_XN2); int* TOPI = (int*)(F.ws + WS_TOPI); float* TOPW = (float*)(F.ws + WS_TOPW); const float* W2 = (const float*)(F.ws + WS_WRT);
    const float rb32 = F.router_b[lane & 31];
    const f32x4* wr = (const f32x4*)F.norm_ffn + lane;
    for (int tile = F.blk; tile < T / 32; tile += F.nblk) {
        const int m0 = tile * 32;
        f32x16 acc = {0.f, 0.f, 0.f, 0.f, 0.f, 0.f, 0.f, 0.f, 0.f, 0.f, 0.f, 0.f, 0.f, 0.f, 0.f, 0.f};
        const int i = lane & 31, kh = lane >> 5;
        for (int st = 0; st < 2; ++st) {
            __syncthreads();
#pragma unroll
            for (int j = 0; j < 8; ++j) { const int idx = tid + 512 * j, tk = idx >> 7, c4 = idx & 127;
                *(LAS f32x4*)(XS + tk * 516 + 4 * c4) = *(const f32x4*)(F.out + (size_t)(m0 + tk) * D + 512 * st + 4 * c4); }
            __syncthreads();
            const int kb = 64 * F.wave + 32 * kh;
            const float* bp = W2 + (size_t)(512 * st + kb) * 32 + i;
#pragma unroll
            for (int c = 0; c < 8; ++c) { const f32x4 a = *(const LAS f32x4*)(XS + i * 516 + kb + 4 * c);
                const float b0 = bp[(4 * c + 0) * 32], b1 = bp[(4 * c + 1) * 32], b2 = bp[(4 * c + 2) * 32], b3 = bp[(4 * c + 3) * 32];
                acc = __builtin_amdgcn_mfma_f32_32x32x2f32(a.x, b0, acc, 0, 0, 0); acc = __builtin_amdgcn_mfma_f32_32x32x2f32(a.y, b1, acc, 0, 0, 0);
                acc = __builtin_amdgcn_mfma_f32_32x32x2f32(a.z, b2, acc, 0, 0, 0); acc = __builtin_amdgcn_mfma_f32_32x32x2f32(a.w, b3, acc, 0, 0, 0); }
        }
#pragma unroll
        for (int rg = 0; rg < 16; ++rg) PW[(F.wave * 32 + crow_(rg, kh)) * 33 + i] = acc[rg];
        __syncthreads();
        for (int idx = tid; idx < 1024; idx += NTHREADS) { const int tk = idx >> 5, e = idx & 31; float s = 0.f;
#pragma unroll
            for (int w = 0; w < 8; ++w) s += PW[(w * 32 + tk) * 33 + e];
            P[tk * 33 + e] = s; }
        __syncthreads();
        for (int pp = 0; pp < 2; ++pp) {
            f32x4 v[2][4]; float rstd[2];
#pragma unroll
            for (int j = 0; j < 2; ++j) {
                const int m = m0 + 4 * F.wave + 2 * pp + j;
                float s = 0.f;
#pragma unroll
                for (int q = 0; q < 4; ++q) { v[j][q] = ((const f32x4*)(F.out + (size_t)m * D) + lane)[64 * q]; s += (v[j][q].x * v[j][q].x + v[j][q].y * v[j][q].y) + (v[j][q].z * v[j][q].z + v[j][q].w * v[j][q].w); }
                rstd[j] = 1.f / sqrtf(wave_sum(s) * (1.f / D) + EPS);
#pragma unroll
                for (int q = 0; q < 4; ++q) { const f32x4 hv = v[j][q] * rstd[j] * wr[64 * q];
#if MOE_FP8
                    *(unsigned*)((unsigned char*)XN2 + (size_t)m * D + (lane + 64 * q) * 4) = pk_fp8x4(FP8_ASCALE * hv.x, FP8_ASCALE * hv.y, FP8_ASCALE * hv.z, FP8_ASCALE * hv.w);
#else
                    st_bf4(XN2 + (size_t)m * D + (lane + 64 * q) * 4, hv);
#endif
                }
            }
            const int jt = lane >> 5, e32 = lane & 31, t = 4 * F.wave + 2 * pp + jt;
            float val = P[t * 33 + e32] * (jt ? rstd[1] : rstd[0]) + rb32;
            int bi[4]; float bv[4];
#pragma unroll
            for (int k = 0; k < 4; ++k) {
                float mx = val;
#pragma unroll
                for (int o = 1; o < 32; o <<= 1) mx = fmaxf(mx, __shfl_xor(mx, o));
                const unsigned long long bal = __ballot(val == mx);
                const unsigned lo32 = (unsigned)bal, hi32 = (unsigned)(bal >> 32);
                const int e = jt ? (__ffs((int)hi32) - 1) : (__ffs((int)lo32) - 1);
                bi[k] = e; bv[k] = mx;
                if (e32 == e) val = -INFINITY;
            }
            const float e1 = __expf(bv[1] - bv[0]), e2 = __expf(bv[2] - bv[0]), e3 = __expf(bv[3] - bv[0]);
            const float inv = 1.f / (1.f + e1 + e2 + e3);
            if (e32 == 0) { const int m = m0 + t;
                *(int4*)(TOPI + (size_t)m * 4) = make_int4(bi[0], bi[1], bi[2], bi[3]);
                *(f32x4*)(TOPW + (size_t)m * 4) = (f32x4){inv, e1 * inv, e2 * inv, e3 * inv};
                atomicAdd((int*)&hist[bi[0]], 1); atomicAdd((int*)&hist[bi[1]], 1); atomicAdd((int*)&hist[bi[2]], 1); atomicAdd((int*)&hist[bi[3]], 1);
            }
        }
    }
    __syncthreads();
    if (((int)threadIdx.x) < 32) atomicAdd((unsigned*)(F.ctl + CW_CNT + 64 * ((int)threadIdx.x)), (unsigned)hist[((int)threadIdx.x)]);
    __syncthreads();
}

__device__ __forceinline__ void p_slots(Frame& F) {
    LAS int* hist = (LAS int*)F.lds;
    LAS int* base = hist + 32;
    LAS int* pst = hist + 64;
    if (((int)threadIdx.x) == 0) {
        int acc = 0;
        for (int e = 0; e < 32; ++e) { const int c = (int)__hip_atomic_load((unsigned*)(F.ctl + CW_CNT + 64 * e), __ATOMIC_RELAXED, __HIP_MEMORY_SCOPE_AGENT); pst[e] = acc; acc += (c + MOE_PAD - 1) / MOE_PAD * MOE_PAD; }
        pst[32] = acc;
    }
    __syncthreads();
    if (F.blk == 0) {
        int* TEXP = (int*)(F.ws + WS_SMALL);
        for (int i = ((int)threadIdx.x); i < NT256; i += NTHREADS) { const int r = i * 256; int e = -1;
            for (int k = 0; k < 32; ++k) if (r >= pst[k] && r < pst[k + 1]) e = k;
            TEXP[i] = e; }
        if (((int)threadIdx.x) == 0) TEXP[1024] = pst[32] / 256;
    }
    const int* TOPI = (const int*)(F.ws + WS_TOPI); int* SLOT = (int*)(F.ws + WS_SLOT); int* ROWMAP = (int*)(F.ws + WS_ROWMAP);
    for (int c = F.blk; c < T / 128; c += F.nblk) {
        if (((int)threadIdx.x) < 32) hist[((int)threadIdx.x)] = 0;
        __syncthreads();
        const int ai = c * 512 + ((int)threadIdx.x);
        const int e = TOPI[ai];
        const int lr = atomicAdd((int*)&hist[e], 1);
        __syncthreads();
        if (((int)threadIdx.x) < 32) base[((int)threadIdx.x)] = (int)atomicAdd((unsigned*)(F.ctl + CW_CUR + 64 * ((int)threadIdx.x)), (unsigned)hist[((int)threadIdx.x)]);
        __syncthreads();
        const int slot = pst[e] + base[e] + lr;
        SLOT[ai] = slot; ROWMAP[slot] = ai >> 2;
        __syncthreads();
    }
}

__device__ __forceinline__ void p_final(Frame& F) {
    const int gw = F.blk * NWAVES + F.wave, NGW = F.nblk * NWAVES;
    const int* SLOT = (const int*)(F.ws + WS_SLOT); const float* TOPW = (const float*)(F.ws + WS_TOPW); const bf16* YB = (const bf16*)(F.ws + WS_YB);
    for (int m = gw; m < T; m += NGW) {
        f32x4* xr = (f32x4*)(F.out + (size_t)m * D) + ((int)(threadIdx.x & 63u));
        const f32x4* wr = (const f32x4*)F.norm_final + ((int)(threadIdx.x & 63u));
        f32x4 v[4];
#pragma unroll
        for (int j = 0; j < 4; ++j) v[j] = xr[64 * j];
#pragma unroll
        for (int k = 0; k < 4; ++k) {
            const int sl = SLOT[m * 4 + k]; const float w = TOPW[m * 4 + k];
#pragma unroll
            for (int j = 0; j < 4; ++j) { const u32x2 y = __builtin_nontemporal_load((const u32x2*)(YB + (size_t)sl * 1024 + (((int)(threadIdx.x & 63u)) + 64 * j) * 4));
                v[j].x += w * bflo(y.x); v[j].y += w * bfhi(y.x); v[j].z += w * bflo(y.y); v[j].w += w * bfhi(y.y); }
        }
        float s = 0.f;
#pragma unroll
        for (int j = 0; j < 4; ++j) s += (v[j].x * v[j].x + v[j].y * v[j].y) + (v[j].z * v[j].z + v[j].w * v[j].w);
        const float rstd = 1.f / sqrtf(wave_sum(s) * (1.f / D) + EPS);
#pragma unroll
        for (int j = 0; j < 4; ++j) __builtin_nontemporal_store(v[j] * rstd * wr[64 * j], xr + 64 * j);
    }
}


__device__ __forceinline__ void stagger_start(int blk, int nblk, unsigned span_ticks  ) {
    const unsigned long long t0 = __builtin_amdgcn_s_memrealtime();
    const unsigned long long want = (unsigned long long)((blk * 37u) % (unsigned)nblk) * span_ticks / (unsigned)nblk;
    while (__builtin_amdgcn_s_memrealtime() - t0 < want) __builtin_amdgcn_s_sleep(8);
}
__global__ void __launch_bounds__(NTHREADS, 2) fwd(Args args) {
    extern __shared__ __attribute__((aligned(16))) unsigned char lds_raw[];
    Frame F;
    F.lds = (LAS unsigned char*)lds_raw;
    F.tid = threadIdx.x; F.lane = F.tid & 63; F.wave = __builtin_amdgcn_readfirstlane(F.tid >> 6);
    F.blk = blockIdx.x; F.nblk = gridDim.x;
    F.x = args.in[0]; F.w_in = args.in[1]; F.rel_bias = args.in[2]; F.w_ba = args.in[3]; F.conv_w = args.in[4]; F.conv_b = args.in[5];
    F.dt_bias = args.in[6]; F.a_log = args.in[7]; F.d_skip = args.in[8]; F.ssm_norm_w = args.in[9]; F.w_bs = args.in[10]; F.gate_bias = args.in[11];
    F.w_out = args.in[12]; F.norm_mix = args.in[13]; F.norm_ffn = args.in[14]; F.router_w = args.in[15]; F.router_b = args.in[16];
    F.w1 = args.in[17]; F.b1 = args.in[18]; F.w2 = args.in[19]; F.b2 = args.in[20]; F.norm_final = args.in[21];
    F.out = args.out; F.ws = args.ws; F.ctl = (gu32*)(args.ws + WS_CTL);
    volatile LAS unsigned* MISC = (volatile LAS unsigned*)(F.lds + MISC_OFF);
    if (((int)threadIdx.x) < 32) MISC[((int)threadIdx.x)] = 0u;
    __syncthreads();
    XcdBarrier bar; bar.bar = (unsigned*)(F.ctl + CW_BAR); bar.x = 0; bar.st = nullptr;
#if MK_FUSED
    bar = xcd_barrier_post((unsigned*)(F.ctl + CW_BAR), MISC + 8);
#define GRID_BAR() xcd_barrier(bar)
#else
#define GRID_BAR() do { } while (0)
#endif
    const int lo = args.ph_lo, hi = args.ph_hi;
#define IN(k) (lo <= (k) && (k) < hi)
#define SEAM(k) do { if (IN(k) && IN((k) + 1)) GRID_BAR(); \
        if (PROBE_TIME == (k) && F.blk == 0 && ((int)threadIdx.x) == 0) { const unsigned long long d_ = __builtin_amdgcn_s_memrealtime() - pt_; const unsigned long long s_ = __builtin_amdgcn_s_memrealtime(); \
            while (__builtin_amdgcn_s_memrealtime() - s_ < d_) __builtin_amdgcn_s_sleep(8); } \
        if (PROBE_TIME == (k) + 1) pt_ = __builtin_amdgcn_s_memrealtime(); } while (0)
    unsigned long long pt_ = 0; if (PROBE_TIME == 0) pt_ = __builtin_amdgcn_s_memrealtime();
    unsigned char* ws = F.ws;

    if (IN(0)) { p_rmsnorm_in(F); p_convert_small(F); if (PROBE_DUP == 0) { p_rmsnorm_in(F); p_convert_small(F); } } SEAM(0);
    if (IN(1)) {
#if FG_INPROJ
#if QKV_FP8
        {
            pg8::Gemm gq{(const bf16*)(ws + WS_XNQ), (const bf16*)(ws + WS_WQKVQ), T, C_Z, D / 2}; pg8::StaticOrder SQ; SQ.init(T, C_Z, F.nblk, F.blk);
            pg8::EpiInProjF EQ{ws, F.dt_bias, F.gate_bias, -1, 1.f / (FP8_ASCALE * FP8_WSCALE), 0};
            pg8::gemm_phase<pg8::EpiInProjF, pg8::StaticOrder, true, false, false, true>(F.lds, gq, SQ, EQ, nullptr, nullptr, 0);
        }
        constexpr int PN0 = C_Z / 256;
#else
        constexpr int PN0 = 0;
#endif
#if !(TAILFILL && QKV_FP8)
        pg8::Gemm g{(const bf16*)(ws + WS_XN), (const bf16*)(ws + WS_WIN_T) + (size_t)PN0 * 256 * D, T, NPROJ_PAD - PN0 * 256, D}; pg8::StaticOrder S; S.init(T, NPROJ_PAD - PN0 * 256, F.nblk, F.blk);
        pg8::EpiInProjF E{ws, F.dt_bias, F.gate_bias, -1, 1.f, PN0};
        if (STAGGER_TICKS) stagger_start(F.blk, F.nblk, STAGGER_TICKS);
        unsigned long long pc0_ = 0, pt0_ = 0;
        if (PROBE_DUP == 300) { pc0_ = clock64(); pt0_ = __builtin_amdgcn_s_memrealtime(); }
        pg8::gemm_phase<pg8::EpiInProjF, pg8::StaticOrder, true, false, false>(F.lds, g, S, E, nullptr, nullptr, 0);
        if (PROBE_DUP == 300 && F.blk == 0 && ((int)threadIdx.x) == 0) {
            const unsigned long long dc = clock64() - pc0_, dt = __builtin_amdgcn_s_memrealtime() - pt0_;
            const unsigned long long want = dc * 5000ull / (dt ? dt : 1ull);
            const unsigned long long s0 = __builtin_amdgcn_s_memrealtime();
            while (__builtin_amdgcn_s_memrealtime() - s0 < want) __builtin_amdgcn_s_sleep(8);
        }
        if (PROBE_DUP == 301 && F.blk == 0 && ((int)threadIdx.x) == 0) {
            const unsigned long long s0 = __builtin_amdgcn_s_memrealtime();
            while (__builtin_amdgcn_s_memrealtime() - s0 < 50000ull) __builtin_amdgcn_s_sleep(8);
        }
        if (PROBE_DUP == 103) { pg8::EpiNullF EN; pg8::Gemm g2{(const bf16*)(ws + WS_XN), (const bf16*)(ws + WS_WIN_T), 16384, 3072, D}; pg8::StaticOrder S2; S2.init(16384, 3072, F.nblk, F.blk);
            pg8::gemm_phase<pg8::EpiNullF, pg8::StaticOrder, true, false, false>(F.lds, g2, S2, EN, nullptr, nullptr, 0); }
        if (PROBE_DUP == 105) { pg8::EpiNullF EN; pg8::Gemm g2{(const bf16*)(ws + WS_XN), (const bf16*)(ws + WS_WIN_T), 16384, 3072, 512}; pg8::StaticOrder S2; S2.init(16384, 3072, F.nblk, F.blk);
            for (int rr = 0; rr < 4; ++rr) pg8::gemm_phase<pg8::EpiNullF, pg8::StaticOrder, true, false, false, true>(F.lds, g2, S2, EN, nullptr, nullptr, 0); }
        if (PROBE_DUP == 104) { pg8::EpiNullF EN; pg8::Gemm g2{(const bf16*)(ws + WS_XN), (const bf16*)(ws + WS_WIN_T), 16384, 3072, D}; pg8::StaticOrder S2; S2.init(16384, 3072, F.nblk, F.blk);
            for (int rr = 0; rr < 4; ++rr) pg8::gemm_phase<pg8::EpiNullF, pg8::StaticOrder, true, false, false>(F.lds, g2, S2, EN, nullptr, nullptr, 0); }
        if (PROBE_DUP == 101) { pg8::EpiNullF EN; pg8::gemm_phase<pg8::EpiNullF, pg8::StaticOrder, true, false, false>(F.lds, g, S, EN, nullptr, nullptr, 0); }
        if (PROBE_DUP == 1) { pg8::gemm_phase<pg8::EpiInProjF, pg8::StaticOrder, true, false, false>(F.lds, g, S, E, nullptr, nullptr, 0); }
#endif
#else
        EpiInProj E{ws, F.dt_bias, F.gate_bias}; gemm_naive(F, T / 128, NPROJ, D, (const bf16*)(ws + WS_XN), D, nullptr, F.w_in, NPROJ, nullptr, 0, E);
#endif
    } SEAM(1);
#if FA_ATTN
    if (IN(2)) {
#if TAILFILL && QKV_FP8 && FG_INPROJ
        { constexpr int PN0 = C_Z / 256;
        pg8::Gemm g{(const bf16*)(ws + WS_XN), (const bf16*)(ws + WS_WIN_T) + (size_t)PN0 * 256 * D, T, NPROJ_PAD - PN0 * 256, D}; pg8::StaticOrder S; S.init(T, NPROJ_PAD - PN0 * 256, F.nblk, F.blk);
        pg8::EpiInProjF E{ws, F.dt_bias, F.gate_bias, -1, 1.f, PN0};
        if (STAGGER_TICKS) stagger_start(F.blk, F.nblk, STAGGER_TICKS);
        unsigned long long pc0_ = 0, pt0_ = 0;
        if (PROBE_DUP == 300) { pc0_ = clock64(); pt0_ = __builtin_amdgcn_s_memrealtime(); }
        pg8::gemm_phase<pg8::EpiInProjF, pg8::StaticOrder, true, false, false>(F.lds, g, S, E, nullptr, nullptr, 0);
        if (PROBE_DUP == 300 && F.blk == 0 && ((int)threadIdx.x) == 0) {
            const unsigned long long dc = clock64() - pc0_, dt = __builtin_amdgcn_s_memrealtime() - pt0_;
            const unsigned long long want = dc * 5000ull / (dt ? dt : 1ull);
            const unsigned long long s0 = __builtin_amdgcn_s_memrealtime();
            while (__builtin_amdgcn_s_memrealtime() - s0 < want) __builtin_amdgcn_s_sleep(8);
        }
        if (PROBE_DUP == 301 && F.blk == 0 && ((int)threadIdx.x) == 0) {
            const unsigned long long s0 = __builtin_amdgcn_s_memrealtime();
            while (__builtin_amdgcn_s_memrealtime() - s0 < 50000ull) __builtin_amdgcn_s_sleep(8);
        }
        if (PROBE_DUP == 103) { pg8::EpiNullF EN; pg8::Gemm g2{(const bf16*)(ws + WS_XN), (const bf16*)(ws + WS_WIN_T), 16384, 3072, D}; pg8::StaticOrder S2; S2.init(16384, 3072, F.nblk, F.blk);
            pg8::gemm_phase<pg8::EpiNullF, pg8::StaticOrder, true, false, false>(F.lds, g2, S2, EN, nullptr, nullptr, 0); }
        if (PROBE_DUP == 105) { pg8::EpiNullF EN; pg8::Gemm g2{(const bf16*)(ws + WS_XN), (const bf16*)(ws + WS_WIN_T), 16384, 3072, 512}; pg8::StaticOrder S2; S2.init(16384, 3072, F.nblk, F.blk);
            for (int rr = 0; rr < 4; ++rr) pg8::gemm_phase<pg8::EpiNullF, pg8::StaticOrder, true, false, false, true>(F.lds, g2, S2, EN, nullptr, nullptr, 0); }
        if (PROBE_DUP == 104) { pg8::EpiNullF EN; pg8::Gemm g2{(const bf16*)(ws + WS_XN), (const bf16*)(ws + WS_WIN_T), 16384, 3072, D}; pg8::StaticOrder S2; S2.init(16384, 3072, F.nblk, F.blk);
            for (int rr = 0; rr < 4; ++rr) pg8::gemm_phase<pg8::EpiNullF, pg8::StaticOrder, true, false, false>(F.lds, g2, S2, EN, nullptr, nullptr, 0); }
        if (PROBE_DUP == 101) { pg8::EpiNullF EN; pg8::gemm_phase<pg8::EpiNullF, pg8::StaticOrder, true, false, false>(F.lds, g, S, EN, nullptr, nullptr, 0); }
        if (PROBE_DUP == 1) { pg8::gemm_phase<pg8::EpiInProjF, pg8::StaticOrder, true, false, false>(F.lds, g, S, E, nullptr, nullptr, 0); }
        }
#endif
        if (PROBE_DUP == 201) { p_attn_fast<false, true>(F); GRID_BAR(); }
        if (PROBE_DUP == 202) { p_attn_fast<true, false>(F); GRID_BAR(); }
        if (PROBE_DUP == 203) { p_attn_fast<false, false>(F); GRID_BAR(); }
        p_attn_fast(F); if (PROBE_DUP == 2) p_attn_fast(F); } SEAM(2);
    if (IN(3)) { p_attn_merge(F); p_conv2(F); if (PROBE_DUP == 3) { p_attn_merge(F); p_conv2(F); } } SEAM(3);
#else
    if (IN(2)) { p_attn_naive(F); } SEAM(2);
    if (IN(3)) { p_conv(F); } SEAM(3);
#endif
#if FS_SSD
    if (IN(4)) { p_ssd_fast2(F); if (PROBE_DUP == 4) p_ssd_fast2(F); } SEAM(4);
#if MOE_FP8
    if (IN(5)) { p_ypost2(F); p_convert_moe_fp8(F); if (PROBE_DUP == 5) { p_convert_moe_fp8(F); } } SEAM(5);
#else
    if (IN(5)) { p_ypost2(F); p_convert_moe(F); if (PROBE_DUP == 5) { p_convert_moe(F); } } SEAM(5);
#endif
#else
    if (IN(4)) { p_ssd_naive(F); } SEAM(4);
    if (IN(5)) { p_ypost(F); p_convert_moe(F); } SEAM(5);
#endif
    if (IN(6)) {
#if FG_MIX
        pg8::Gemm g{(const bf16*)(ws + WS_ATTN), (const bf16*)(ws + WS_WBA_T), T, D, 512}; pg8::StaticOrder S; S.init(T, D, F.nblk, F.blk);
        pg8::EpiM0F E{ws};
        pg8::gemm_phase<pg8::EpiM0F, pg8::StaticOrder, true, false, false>(F.lds, g, S, E, nullptr, nullptr, 0);
        if (PROBE_DUP == 6) { pg8::gemm_phase<pg8::EpiM0F, pg8::StaticOrder, true, false, false>(F.lds, g, S, E, nullptr, nullptr, 0); }
#else
        EpiM0 E{ws}; gemm_naive(F, T / 128, D, 512, (const bf16*)(ws + WS_ATTN), 512, nullptr, F.w_ba, D, nullptr, 0, E);
#endif
    } SEAM(6);
    if (IN(7)) {
#if FG_MIX
        pg8::Gemm g{(const bf16*)(ws + WS_YN), (const bf16*)(ws + WS_WBS_T), T, D, DI}; pg8::StaticOrder S; S.init(T, D, F.nblk, F.blk);
        pg8::EpiMergedF E{ws};
        pg8::gemm_phase<pg8::EpiMergedF, pg8::StaticOrder, true, false, false>(F.lds, g, S, E, nullptr, nullptr, 0);
        if (PROBE_DUP == 7) { pg8::gemm_phase<pg8::EpiMergedF, pg8::StaticOrder, true, false, false>(F.lds, g, S, E, nullptr, nullptr, 0); }
#else
        EpiMerged E{ws}; gemm_naive(F, T / 128, D, DI, (const bf16*)(ws + WS_YN), DI, nullptr, F.w_bs, D, nullptr, 0, E);
#endif
    } SEAM(7);
    if (IN(8)) {
#if FG_MIX
        pg8::Gemm g{(const bf16*)(ws + WS_MERGED), (const bf16*)(ws + WS_WOUT_T), T, D, D}; pg8::StaticOrder S; S.init(T, D, F.nblk, F.blk);
        pg8::EpiX1F E{F.x, F.out};
        pg8::gemm_phase<pg8::EpiX1F, pg8::StaticOrder, true, false, false>(F.lds, g, S, E, nullptr, nullptr, 0);
        if (PROBE_DUP == 8) { pg8::gemm_phase<pg8::EpiX1F, pg8::StaticOrder, true, false, false>(F.lds, g, S, E, nullptr, nullptr, 0); }
#else
        EpiX1 E{F.x, F.out}; gemm_naive(F, T / 128, D, D, (const bf16*)(ws + WS_MERGED), D, nullptr, F.w_out, D, nullptr, 0, E);
#endif
    } SEAM(8);
    if (IN(9)) { p_router3(F); } SEAM(9);
    if (IN(10)) { p_slots(F); } SEAM(10);
    if (IN(11)) {
#if FG_MOE && MOE_FP8
        const int* texp = (const int*)(ws + WS_SMALL); const int ntile = texp[1024];
        pg8::Gemm g{(const bf16*)(ws + WS_XN2), (const bf16*)(ws + WS_W1T), CAP, 2048, 512}; pg8::MoeOrder S; S.init(ntile, 8, F.nblk, F.blk);
        pg8::EpiMoe1Q E{ws, F.b1, texp};
        pg8::gemm_phase<pg8::EpiMoe1Q, pg8::MoeOrder, true, true, true, true>(F.lds, g, S, E, (const int*)(ws + WS_ROWMAP), texp, (size_t)2048 * 1024);
        if (PROBE_DUP == 11) { pg8::gemm_phase<pg8::EpiMoe1Q, pg8::MoeOrder, true, true, true, true>(F.lds, g, S, E, (const int*)(ws + WS_ROWMAP), texp, (size_t)2048 * 1024); }
#elif FG_MOE
        const int* texp = (const int*)(ws + WS_SMALL); const int ntile = texp[1024];
        pg8::Gemm g{(const bf16*)(ws + WS_XN2), (const bf16*)(ws + WS_W1T), CAP, 2048, D}; pg8::MoeOrder S; S.init(ntile, 8, F.nblk, F.blk);
        pg8::EpiMoe1F E{ws, F.b1, texp};
        pg8::gemm_phase<pg8::EpiMoe1F, pg8::MoeOrder, true, true, true>(F.lds, g, S, E, (const int*)(ws + WS_ROWMAP), texp, (size_t)2048 * 1024 * 2);
#else
        EpiMoe1 E{ws, F.b1}; gemm_naive(F, CAP / 128, 2048, D, (const bf16*)(ws + WS_XN2), D, (const int*)(ws + WS_ROWMAP), F.w1, 2048, (const int*)(ws + WS_SMALL), (size_t)1024 * 2048, E);
#endif
    } SEAM(11);
    if (IN(12)) {
#if FG_MOE && MOE_FP8
        const int* texp = (const int*)(ws + WS_SMALL); const int ntile = texp[1024];
        pg8::Gemm g{(const bf16*)(ws + WS_ACT), (const bf16*)(ws + WS_W2T), CAP, 1024, 512}; pg8::MoeOrder S; S.init(ntile, 4, F.nblk, F.blk);
        pg8::EpiMoe2Q E{ws, F.b2, texp};
        pg8::gemm_phase<pg8::EpiMoe2Q, pg8::MoeOrder, true, false, true, true>(F.lds, g, S, E, nullptr, texp, (size_t)1024 * 1024);
        if (PROBE_DUP == 12) { pg8::gemm_phase<pg8::EpiMoe2Q, pg8::MoeOrder, true, false, true, true>(F.lds, g, S, E, nullptr, texp, (size_t)1024 * 1024); }
#elif FG_MOE
        const int* texp = (const int*)(ws + WS_SMALL); const int ntile = texp[1024];
        pg8::Gemm g{(const bf16*)(ws + WS_ACT), (const bf16*)(ws + WS_W2T), CAP, 1024, 1024}; pg8::MoeOrder S; S.init(ntile, 4, F.nblk, F.blk);
        pg8::EpiMoe2F E{ws, F.b2, texp};
        pg8::gemm_phase<pg8::EpiMoe2F, pg8::MoeOrder, true, false, true>(F.lds, g, S, E, nullptr, texp, (size_t)1024 * 1024 * 2);
#else
        EpiMoe2 E{ws, F.b2}; gemm_naive(F, CAP / 128, 1024, 1024, (const bf16*)(ws + WS_ACT), 1024, nullptr, F.w2, 1024, (const int*)(ws + WS_SMALL), (size_t)1024 * 1024, E);
#endif
    } SEAM(12);
    if (IN(13)) { p_final(F); } SEAM(13);
#undef IN
#undef SEAM
}

extern "C" void kernel_launch(void* const* d_in, const int* in_sizes, int n_in, void* d_out, int out_size, void* d_ws, size_t ws_size, hipStream_t stream) {
    static int grid = 0;
    if (grid == 0) {
        if (n_in != 22 || out_size != T * D || ws_size < WS_END) { fprintf(stderr, "kernel_launch: unexpected shapes: n_in %d out %d ws %zu\n", n_in, out_size, ws_size); grid = -1; return; }
        int dev = 0, cus = 0, per_cu = 0;
        if (hipGetDevice(&dev) != hipSuccess || hipDeviceGetAttribute(&cus, hipDeviceAttributeMultiprocessorCount, dev) != hipSuccess) { grid = -1; return; }
        if (hipFuncSetAttribute((const void*)fwd, hipFuncAttributeMaxDynamicSharedMemorySize, LDS_BYTES) != hipSuccess) { fprintf(stderr, "kernel_launch: hipFuncSetAttribute failed\n"); grid = -1; return; }
        if (hipOccupancyMaxActiveBlocksPerMultiprocessor(&per_cu, (const void*)fwd, NTHREADS, LDS_BYTES) != hipSuccess || per_cu < 1) fprintf(stderr, "kernel_launch: occupancy query says %d\n", per_cu);
        (void)hipGetLastError();
        grid = cus;
    }
    if (grid < 0) return;
    (void)hipMemsetAsync((char*)d_ws + WS_CTL, 0, CTL_ZERO_BYTES, stream);
    Args a{};
    for (int i = 0; i < 22; ++i) a.in[i] = (const float*)d_in[i];
    a.out = (float*)d_out; a.ws = (unsigned char*)d_ws;
#if MK_FUSED
    a.ph_lo = 0; a.ph_hi = NPHASE; a.li = 0;
    hipLaunchKernelGGL(fwd, dim3(grid), dim3(NTHREADS), LDS_BYTES, stream, a);
#else
    for (int p = 0; p < NPHASE; ++p) { a.ph_lo = p; a.ph_hi = p + 1; a.li = p; hipLaunchKernelGGL(fwd, dim3(grid), dim3(NTHREADS), LDS_BYTES, stream, a); }
#endif
}
```

```cpp
#include <hip/hip_runtime.h>
#include <cstdio>
#include <cstdint>

#ifndef MK_FUSED
#define MK_FUSED 1
#endif

#ifndef FG_INPROJ
#define FG_INPROJ 1
#endif
#ifndef PROBE_DUP
#define PROBE_DUP (-1)
#endif
#ifndef STAGGER_TICKS
#define STAGGER_TICKS 0
#endif
#ifndef SSD_REP_A
#define SSD_REP_A 1
#endif
#ifndef SSD_REP_W
#define SSD_REP_W 1
#endif
#ifndef PROBE_TIME
#define PROBE_TIME (-1)
#endif
#ifndef PROBE_SEC
#define PROBE_SEC (-1)
#endif
#ifndef FA_ATTN
#define FA_ATTN 1
#endif
#ifndef FS_SSD
#define FS_SSD 1
#endif
#ifndef MOE_FP8
#define MOE_FP8 1
#endif
#ifndef QKV_FP8
#define QKV_FP8 1
#endif
#ifndef QKV_STORE_FP8
#define QKV_STORE_FP8 1
#endif
#ifndef FG_MIX
#define FG_MIX 1
#endif
#ifndef FG_MOE
#define FG_MOE 1
#endif
#define GAS __attribute__((address_space(1)))
#define LAS __attribute__((address_space(3)))
typedef unsigned short bf16;
typedef float f32x4 __attribute__((ext_vector_type(4)));
typedef unsigned u32x4 __attribute__((ext_vector_type(4)));
typedef unsigned u32x2 __attribute__((ext_vector_type(2)));
typedef GAS unsigned gu32;

constexpr int BATCH = 16, SEQ = 2048, D = 1024, T = BATCH * SEQ;
constexpr int NPROJ = 11808;
constexpr int AW = 1536;
constexpr int DI = 2048;
constexpr int CONVD = 3072;
constexpr int NH_SSM = 32, NG_SSM = 4, DSTATE = 128;
constexpr int NEXP = 32, TOPK = 4, NASSIGN = T * TOPK;
constexpr int MOE_PAD = 256;
constexpr int CAP = NASSIGN + NEXP * MOE_PAD;
constexpr int NT256 = CAP / 256;
constexpr float EPS = 1e-5f;
constexpr int C_Q = 0, C_K = 1536, C_V = 3072, C_Z = 4608, C_XBC = 6656, C_DT = 9728, C_GATE = 9760;

constexpr size_t MiB = 1u << 20;
constexpr size_t WS_CTL = 0, CTL_ZERO_BYTES = 128 * 1024;
constexpr size_t WS_SMALL = 1 * MiB;
constexpr size_t WS_XN = 34 * MiB;
constexpr size_t WS_Q = 98 * MiB, WS_K = 194 * MiB, WS_V = 290 * MiB;
constexpr size_t WS_Z = 386 * MiB;
constexpr size_t WS_XBC = 514 * MiB;
constexpr size_t WS_GATE = 706 * MiB;
constexpr size_t WS_DT = 834 * MiB;
constexpr size_t WS_ATTN = 838 * MiB;
constexpr size_t WS_M0 = 870 * MiB;
constexpr size_t WS_CONV = WS_K;
constexpr size_t WS_YZ = WS_XBC;
constexpr size_t WS_YN = WS_Z;
constexpr size_t WS_MERGED = WS_XN;
constexpr size_t WS_XN2 = WS_Q;
constexpr size_t WS_TOPI = 162 * MiB;
constexpr size_t WS_TOPW = 163 * MiB;
constexpr size_t WS_SLOT = 164 * MiB;
constexpr size_t WS_ROWMAP = 165 * MiB;
constexpr size_t WS_ACT = 386 * MiB;
constexpr size_t WS_YB = 658 * MiB;
constexpr size_t WS_WIN_T = 2 * MiB;
constexpr size_t WS_WBA_T = 26 * MiB;
constexpr size_t WS_WBS_T = 27 * MiB;
constexpr size_t WS_WOUT_T = 31 * MiB;
constexpr size_t WS_W1T = 194 * MiB;
constexpr size_t WS_W2T = 322 * MiB;
constexpr int NPROJ_PAD = 12032;
constexpr size_t WS_OUTG = 870 * MiB;
constexpr size_t WS_LSE = 966 * MiB;
constexpr size_t WS_BT = 1 * MiB + 65536;
constexpr float FP8_ASCALE = 4.f, FP8_WSCALE = 64.f;
constexpr size_t WS_WRT = 1 * MiB + 131072;
constexpr size_t WS_XNQ = 870 * MiB;
constexpr size_t WS_WQKVQ = 998 * MiB;
constexpr size_t WS_END = 1024 * MiB;
constexpr int CW_TMO = 0;
constexpr int CW_BAR = 4096;
constexpr int CW_CNT = 16384;
constexpr int CW_CUR = 16384 + 64 * 32;

constexpr int NWAVES = 8, NTHREADS = 512;
constexpr int LDS_BYTES = 147456;
constexpr int MISC_OFF = LDS_BYTES - 256;

constexpr int NPHASE = 14;

__device__ __forceinline__ unsigned f2bf(float f) { unsigned u = __builtin_bit_cast(unsigned, f); return (u + 0x7fffu + ((u >> 16) & 1u)) >> 16; }

typedef float f32x2_t __attribute__((ext_vector_type(2))); typedef __bf16 bf16x2_t __attribute__((ext_vector_type(2)));
__device__ __forceinline__ unsigned cvtpk(float lo, float hi) { const f32x2_t v = {lo, hi}; const bf16x2_t b = __builtin_convertvector(v, bf16x2_t); return __builtin_bit_cast(unsigned, b); }
__device__ __forceinline__ unsigned pk2(float lo, float hi) { return cvtpk(lo, hi); }
__device__ __forceinline__ unsigned pk_fp8x4(float a, float b, float c, float d) { int w = __builtin_amdgcn_cvt_pk_fp8_f32(a, b, 0, false); w = __builtin_amdgcn_cvt_pk_fp8_f32(c, d, w, true); return (unsigned)w; }
__device__ __forceinline__ unsigned fp8x2_to_bf16x2(unsigned w, bool hi) { const f32x2_t f = hi ? __builtin_amdgcn_cvt_pk_f32_fp8((int)w, true) : __builtin_amdgcn_cvt_pk_f32_fp8((int)w, false); return cvtpk(f.x, f.y); }
__device__ __forceinline__ u32x4 fp8x8_to_bf16x8(unsigned lo, unsigned hi) { u32x4 o; o.x = fp8x2_to_bf16x2(lo, false); o.y = fp8x2_to_bf16x2(lo, true); o.z = fp8x2_to_bf16x2(hi, false); o.w = fp8x2_to_bf16x2(hi, true); return o; }
__device__ __forceinline__ float bflo(unsigned u) { return __builtin_bit_cast(float, u << 16); }
__device__ __forceinline__ float bfhi(unsigned u) { return __builtin_bit_cast(float, u & 0xffff0000u); }
__device__ __forceinline__ float bf2f(bf16 b) { return __builtin_bit_cast(float, (unsigned)b << 16); }
__device__ __forceinline__ float wave_sum(float v) {
#pragma unroll
    for (int o = 1; o < 64; o <<= 1) v += __shfl_xor(v, o);
    return v;
}
#define LDS_BARRIER() do { asm volatile("s_waitcnt lgkmcnt(0)" ::: "memory"); __builtin_amdgcn_s_barrier(); asm volatile("" ::: "memory"); } while (0)
__device__ __forceinline__ float sigmoidf_(float x) { return __builtin_amdgcn_rcpf(1.f + __expf(-x)); }
__device__ __forceinline__ float siluf_(float x) { return x * __builtin_amdgcn_rcpf(1.f + __expf(-x)); }
__device__ __forceinline__ float softplusf_(float x) { return fmaxf(x, 0.f) + __logf(1.f + __expf(-fabsf(x))); }

#define XB_TMO      128
#define XB_XCNT(j)  (256  + 64 * (j))
#define XB_XSUB(j)  (1280 + 64 * (j))
#define XB_XGEN(j)  (2304 + 64 * (j))
#define XB_TOP      3328
#define XB_TOPGEN   3392
#define XCD_BAR_WORDS 3456
#define XB_SPIN_CAP (1u << 18)
__device__ __forceinline__ unsigned xb_ld(unsigned* p)              { return __hip_atomic_load(p, __ATOMIC_RELAXED, __HIP_MEMORY_SCOPE_AGENT); }
__device__ __forceinline__ unsigned xb_add(unsigned* p, unsigned v) { return __hip_atomic_fetch_add(p, v, __ATOMIC_RELAXED, __HIP_MEMORY_SCOPE_AGENT); }
__device__ __forceinline__ unsigned xb_xcc_id() { return (unsigned)__builtin_amdgcn_s_getreg((3 << 11) | 20) & 0xFu; }
#define XB_SPIN(cond, bar) do { unsigned _sp = 0; while (cond) { __builtin_amdgcn_s_sleep(1); \
    if ((++_sp & 255u) == 0u) { if (xb_ld(&(bar)[XB_TMO])) break; if (_sp > XB_SPIN_CAP) { atomicAdd(&(bar)[XB_TMO], 1u); break; } } } } while (0)
struct XcdBarrier { unsigned* bar; unsigned x; volatile LAS unsigned* st; };
__device__ __forceinline__ XcdBarrier xcd_barrier_post(unsigned* bar, volatile LAS unsigned* st) {
    XcdBarrier b; b.bar = bar; b.x = xb_xcc_id(); b.st = st;
    if (threadIdx.x == 0) (void)xb_add(&bar[XB_XCNT(b.x)], 1u);
    return b;
}
__device__ __forceinline__ void xcd_barrier_complete(unsigned* bar, unsigned x, unsigned& nloc, unsigned& nx) {
    const unsigned G = gridDim.x * gridDim.y * gridDim.z;
    unsigned sum, cnt, mine, sp = 0u;
    for (;;) {
        sum = 0u; cnt = 0u; mine = 0u;
#pragma unroll
        for (unsigned j = 0; j < 16; ++j) { const unsigned c = xb_ld(&bar[XB_XCNT(j)]); sum += c; cnt += (c > 0u) ? 1u : 0u; mine = (j == x) ? c : mine; }
        if (sum == G) break;
        __builtin_amdgcn_s_sleep(1);
        if ((++sp & 255u) == 0u) { if (xb_ld(&bar[XB_TMO])) break; if (sp > XB_SPIN_CAP) { atomicAdd(&bar[XB_TMO], 1u); break; } }
    }
    nloc = mine > 0u ? mine : 1u; nx = cnt > 0u ? cnt : 1u;
}
__device__ __forceinline__ void xcd_barrier(const XcdBarrier& b) {
    asm volatile("s_waitcnt vmcnt(0)" ::: "memory");
    __syncthreads();
    if (threadIdx.x == 0) {
        unsigned* bar = b.bar;
        __builtin_amdgcn_s_waitcnt(0);
        unsigned nloc = b.st[0], nx = b.st[1];
        if (nloc == 0u) { xcd_barrier_complete(bar, b.x, nloc, nx); b.st[0] = nloc; b.st[1] = nx; }
        const unsigned old = xb_add(&bar[XB_XSUB(b.x)], 1u);
        const unsigned gen = old / nloc;
        if (old + 1u == (gen + 1u) * nloc) {
            __builtin_amdgcn_fence(__ATOMIC_RELEASE, "agent");
            asm volatile("s_waitcnt vmcnt(0)" ::: "memory");
            const unsigned og = xb_add(&bar[XB_TOP], 1u);
            const unsigned tg = og / nx;
            if (og + 1u == (tg + 1u) * nx) xb_add(&bar[XB_TOPGEN], 1u);
            else XB_SPIN(xb_ld(&bar[XB_TOPGEN]) == tg, bar);
            __builtin_amdgcn_fence(__ATOMIC_ACQUIRE, "agent");
            xb_add(&bar[XB_XGEN(b.x)], 1u);
            asm volatile("s_waitcnt vmcnt(0)" ::: "memory");
        } else {
            XB_SPIN(xb_ld(&bar[XB_XGEN(b.x)]) == gen, bar);
            __builtin_amdgcn_fence(__ATOMIC_ACQUIRE, "agent");
            asm volatile("s_waitcnt vmcnt(0)" ::: "memory");
        }
    }
    __syncthreads();
}

struct Args { const float* in[22]; float* out; unsigned char* ws; int ph_lo, ph_hi, li, pad; };

struct Frame {
    LAS unsigned char* lds;
    int tid, lane, wave, blk, nblk;
    const float *x, *w_in, *rel_bias, *w_ba, *conv_w, *conv_b, *dt_bias, *a_log, *d_skip, *ssm_norm_w, *w_bs, *gate_bias, *w_out,
                *norm_mix, *norm_ffn, *router_w, *router_b, *w1, *b1, *w2, *b2, *norm_final;
    float* out; unsigned char* ws; gu32* ctl;
};

template <class Epi>
__device__ __forceinline__ void gemm_naive(Frame& F, int nMt, int N, int K, const bf16* A, int lda, const int* rowmap,
                                           const float* B, int ldb, const int* texp, size_t estride, const Epi& epi) {
    LAS float* As = (LAS float*)F.lds;
    LAS float* Bs = As + 16 * 132;
    const int tid = ((int)threadIdx.x), tx = tid & 31, ty = tid >> 5;
    const int nNt = (N + 127) / 128;
    const int ar = tid >> 2, ak = (tid & 3) * 4;
    const int bk = tid >> 5, bn = (tid & 31) * 4;
    for (int tile = F.blk; tile < nMt * nNt; tile += F.nblk) {
        const int mt = tile / nNt, nt = tile % nNt;
        int e = 0;
        if (texp) { e = texp[mt >> 1]; if (e < 0) continue; }
        const float* Bp = B + (size_t)e * estride;
        float acc[8][4];
#pragma unroll
        for (int i = 0; i < 8; ++i)
#pragma unroll
            for (int j = 0; j < 4; ++j) acc[i][j] = 0.f;
        int grow = mt * 128 + ar; if (rowmap) grow = rowmap[grow];
        const bf16* ap = A + (size_t)(grow < 0 ? 0 : grow) * lda + ak;
        const bool aok = grow >= 0;
        const int gcol = nt * 128 + bn;
        const bool bok = gcol < N;
        for (int k0 = 0; k0 < K; k0 += 16) {
            u32x2 av = (u32x2){0u, 0u};
            if (aok) av = *(const u32x2*)(ap + k0);
            f32x4 bv = (f32x4){0.f, 0.f, 0.f, 0.f};
            if (bok) bv = *(const f32x4*)(Bp + (size_t)(k0 + bk) * ldb + gcol);
            __syncthreads();
            As[(ak + 0) * 132 + ar] = bflo(av.x); As[(ak + 1) * 132 + ar] = bfhi(av.x);
            As[(ak + 2) * 132 + ar] = bflo(av.y); As[(ak + 3) * 132 + ar] = bfhi(av.y);
            *(LAS f32x4*)&Bs[bk * 132 + bn] = bv;
            __syncthreads();
#pragma unroll
            for (int k = 0; k < 16; ++k) {
                const f32x4 a0 = *(const LAS f32x4*)&As[k * 132 + ty * 8], a1 = *(const LAS f32x4*)&As[k * 132 + ty * 8 + 4];
                const f32x4 b = *(const LAS f32x4*)&Bs[k * 132 + tx * 4];
                const float a[8] = {a0.x, a0.y, a0.z, a0.w, a1.x, a1.y, a1.z, a1.w};
                const float bb[4] = {b.x, b.y, b.z, b.w};
#pragma unroll
                for (int i = 0; i < 8; ++i)
#pragma unroll
                    for (int j = 0; j < 4; ++j) acc[i][j] = fmaf(a[i], bb[j], acc[i][j]);
            }
        }
        const int col0 = nt * 128 + tx * 4;
        if (col0 < N) {
#pragma unroll
            for (int i = 0; i < 8; ++i) epi(mt * 128 + ty * 8 + i, col0, (f32x4){acc[i][0], acc[i][1], acc[i][2], acc[i][3]}, e);
        }
    }
    __syncthreads();
}

__device__ __forceinline__ void st_bf4(bf16* p, f32x4 v) { u32x2 w; w.x = pk2(v.x, v.y); w.y = pk2(v.z, v.w); *(u32x2*)p = w; }

struct EpiInProj {
    unsigned char* ws; const float* dt_bias; const float* gate_bias;
    __device__ __forceinline__ void operator()(int row, int col, f32x4 v, int) const {
        if (col < C_K)        st_bf4((bf16*)(ws + WS_Q) + (size_t)row * AW + (col - C_Q), v);
        else if (col < C_V)   st_bf4((bf16*)(ws + WS_K) + (size_t)row * AW + (col - C_K), v);
        else if (col < C_Z)   st_bf4((bf16*)(ws + WS_V) + (size_t)row * AW + (col - C_V), v);
        else if (col < C_XBC) st_bf4((bf16*)(ws + WS_Z) + (size_t)row * DI + (col - C_Z), v);
        else if (col < C_DT)  st_bf4((bf16*)(ws + WS_XBC) + (size_t)row * CONVD + (col - C_XBC), v);
        else if (col < C_GATE) { const int c = col - C_DT; f32x4 o;
            o.x = softplusf_(v.x + dt_bias[c]); o.y = softplusf_(v.y + dt_bias[c + 1]); o.z = softplusf_(v.z + dt_bias[c + 2]); o.w = softplusf_(v.w + dt_bias[c + 3]);
            float* dp = (float*)(ws + WS_DT) + row; dp[(size_t)c * T] = o.x; dp[(size_t)(c + 1) * T] = o.y; dp[(size_t)(c + 2) * T] = o.z; dp[(size_t)(c + 3) * T] = o.w; }
        else { const int c = col - C_GATE; f32x4 o;
            o.x = sigmoidf_(v.x + gate_bias[c]); o.y = sigmoidf_(v.y + gate_bias[c + 1]); o.z = sigmoidf_(v.z + gate_bias[c + 2]); o.w = sigmoidf_(v.w + gate_bias[c + 3]);
            st_bf4((bf16*)(ws + WS_GATE) + (size_t)row * 2048 + c, o); }
    }
};
struct EpiM0 {
    unsigned char* ws;
    __device__ __forceinline__ void operator()(int row, int col, f32x4 v, int) const {
        const u32x2 g = *(const u32x2*)((const bf16*)(ws + WS_GATE) + (size_t)row * 2048 + col);
        f32x4 o; o.x = v.x * bflo(g.x); o.y = v.y * bfhi(g.x); o.z = v.z * bflo(g.y); o.w = v.w * bfhi(g.y);
        st_bf4((bf16*)(ws + WS_M0) + (size_t)row * D + col, o);
    }
};
struct EpiMerged {
    unsigned char* ws;
    __device__ __forceinline__ void operator()(int row, int col, f32x4 v, int) const {
        const u32x2 g = *(const u32x2*)((const bf16*)(ws + WS_GATE) + (size_t)row * 2048 + 1024 + col);
        const u32x2 mw = *(const u32x2*)((const bf16*)(ws + WS_M0) + (size_t)row * D + col); const f32x4 m = (f32x4){bflo(mw.x), bfhi(mw.x), bflo(mw.y), bfhi(mw.y)};
        f32x4 o; o.x = m.x + v.x * bflo(g.x); o.y = m.y + v.y * bfhi(g.x); o.z = m.z + v.z * bflo(g.y); o.w = m.w + v.w * bfhi(g.y);
        st_bf4((bf16*)(ws + WS_MERGED) + (size_t)row * D + col, o);
    }
};
struct EpiX1 {
    const float* x; float* out;
    __device__ __forceinline__ void operator()(int row, int col, f32x4 v, int) const {
        const f32x4 xv = *(const f32x4*)(x + (size_t)row * D + col);
        *(f32x4*)(out + (size_t)row * D + col) = xv + v;
    }
};
__device__ __forceinline__ float swiglu_(float g, float l) {
    g = fminf(g, 7.f); l = fminf(fmaxf(l, -7.f), 7.f);
    return g * sigmoidf_(1.702f * g) * (l + 1.f);
}
struct EpiMoe1 {
    unsigned char* ws; const float* b1;
    __device__ __forceinline__ void operator()(int row, int col, f32x4 v, int e) const {
        const f32x4 b = *(const f32x4*)(b1 + (size_t)e * 2048 + col);
        const float o0 = swiglu_(v.x + b.x, v.y + b.y), o1 = swiglu_(v.z + b.z, v.w + b.w);
        *(unsigned*)((bf16*)(ws + WS_ACT) + (size_t)row * 1024 + (col >> 1)) = pk2(o0, o1);
    }
};
struct EpiMoe2 {
    unsigned char* ws; const float* b2;
    __device__ __forceinline__ void operator()(int row, int col, f32x4 v, int e) const {
        const f32x4 b = *(const f32x4*)(b2 + (size_t)e * 1024 + col);
        st_bf4((bf16*)(ws + WS_YB) + (size_t)row * 1024 + col, v + b);
    }
};

namespace pg8 {
typedef short bf16x8 __attribute__((ext_vector_type(8)));
typedef long i64x2 __attribute__((ext_vector_type(2)));
constexpr int BM = 256, BK = 64, HALF = 128, HTB = HALF * BK * 2, STAGE_BYTES = 8 * HTB, NXCD = 8, WGM = 8;
__host__ __device__ __forceinline__ int lds_byte(int r, int c) { const int st = (r >> 4) * 2 + (c >> 5), rr = r & 15, cc = c & 31, ob = rr * 64 + cc * 2; return st * 1024 + (ob ^ (((ob >> 9) & 1) << 5)); }
__host__ __device__ __forceinline__ void stage_rc(int b, int& R, int& C) { const int st = b / 1024, sb = b % 1024, swz = sb ^ (((sb >> 9) & 1) << 5); R = (st >> 1) * 16 + swz / 64; C = (st & 1) * 32 + (swz % 64) / 2; }
__host__ __device__ __forceinline__ int perm32(int rho) { const int n = rho >> 4, i = rho & 15; return 8 * (i >> 2) + 4 * n + (i & 3); }
struct Unit { int pm, pn; };
struct Gemm { const bf16* A; const bf16* Bt; int M, N, K; };
struct StaticOrder {
    int nM, nN, nwg, G, c;
    __host__ __device__ void init(int M, int N, int G_, int c_) { nM = M / BM; nN = N / BM; nwg = nM * nN; G = G_; c = c_; }
    __host__ __device__ bool next(int i, Unit& u) const {
        const long L = (long)i * G + c; if (L >= nwg) return false;
        int wgid = (int)L; { const int q = nwg / NXCD, r = nwg % NXCD, xcd = wgid % NXCD, off = wgid / NXCD; wgid = (xcd < r ? xcd * (q + 1) : r * (q + 1) + (xcd - r) * q) + off; }
        const int nig = WGM * nN, gid = wgid / nig, fm = gid * WGM, gsz = (nM - fm) < WGM ? (nM - fm) : WGM;
        u.pm = fm + ((wgid % nig) % gsz); u.pn = (wgid % nig) / gsz; return true;
    }
    __device__ __forceinline__ void a_ready(const Unit&) const {}
    __device__ __forceinline__ void done(const Unit&) const {}
};
struct MoeOrder {
    int nwg, nN, G, c;
    __device__ void init(int ntile, int nN_, int G_, int c_) { nN = nN_; nwg = ntile * nN_; G = G_; c = c_; }
    __device__ bool next(int i, Unit& u) const { const long L = (long)i * G + c; if (L >= nwg) return false; u.pm = (int)L / nN; u.pn = (int)L % nN; return true; }
    __device__ __forceinline__ void a_ready(const Unit&) const {}
    __device__ __forceinline__ void done(const Unit&) const {}
};
__device__ __forceinline__ unsigned cvt_pk_bf16(float lo, float hi) { unsigned r; asm volatile("v_cvt_pk_bf16_f32 %0, %1, %2" : "=v"(r) : "v"(lo), "v"(hi)); return r; }

template <class Epi, class Sched, bool ALIGN_EPI, bool GATHER, bool EXPERT, bool FP8 = false>
__device__ __forceinline__ void gemm_phase(LAS unsigned char* lds, const Gemm g, const Sched& S, const Epi& E, const int* rowmap, const int* texp, size_t bstride) {
    const int tid = threadIdx.x, wid = __builtin_amdgcn_readfirstlane(tid >> 6), lane = tid & 63, wr = wid >> 2, wc = wid & 3, fr = lane & 15, fq = lane >> 4;
    const int K = g.K, nt = K / BK;
    unsigned voffA[2], voffB[2], voffB1[2]; int RA[2]; unsigned CAb[2];
#pragma unroll
    for (int i = 0; i < 2; ++i) { int R, C; stage_rc(tid * 16 + i * 8192, R, C); const int Rb = Epi::PERM ? ((R & ~31) + perm32(R & 31)) : R;
        voffA[i] = (unsigned)(R * K + C) * 2u; voffB[i] = (unsigned)(Rb * K + C) * 2u; voffB1[i] = voffB[i] + (unsigned)(HALF * K * 2); RA[i] = R; CAb[i] = (unsigned)C * 2u;
        if constexpr (Epi::WIDE) {
            voffB[i] = (unsigned)((64 * (R >> 5) + perm32(R & 31)) * K + C) * 2u; voffB1[i] = (unsigned)((64 * (R >> 5) + 32 + perm32(R & 31)) * K + C) * 2u; } }
    const size_t kstep = (size_t)(BK * 2);
    const size_t hstep = (size_t)HALF * K * 2;
    const size_t tstep = 2 * hstep;
    const size_t ahs = GATHER ? 0 : hstep;
    const unsigned ldsw = (unsigned)wid * 1024u;
    const int aoff = lds_byte(wr * 64 + fr, fq * 8), boff = lds_byte(wc * 32 + fr, fq * 8);
#define PG8_SA(b, h) (((b) * 2 + (h)) * HTB)
#define PG8_SB(b, h) ((4 + (b) * 2 + (h)) * HTB)
#define PG8_STAGE(bufoff, gbase, voff) do { _Pragma("unroll") for (int _i = 0; _i < 2; ++_i) \
        __builtin_amdgcn_global_load_lds((const unsigned*)((const char*)(gbase) + (voff)[_i]), (LAS unsigned*)(lds + (bufoff) + ldsw + _i * 8192), 16, 0, 0); } while (0)
#define PG8_LDA(dst, b, h) do { _Pragma("unroll") for (int m = 0; m < 4; ++m) _Pragma("unroll") for (int k = 0; k < 2; ++k) dst[m][k] = *(const LAS bf16x8*)(lds + PG8_SA(b, h) + aoff + m * 2048 + k * 1024); } while (0)
#define PG8_LDB(dst, b, h) do { _Pragma("unroll") for (int n = 0; n < 2; ++n) _Pragma("unroll") for (int k = 0; k < 2; ++k) dst[n][k] = *(const LAS bf16x8*)(lds + PG8_SB(b, h) + boff + n * 2048 + k * 1024); } while (0)
#define PG8_MMA(ai, bj, At, Bt) do { __builtin_amdgcn_s_setprio(1); _Pragma("unroll") for (int m = 0; m < 4; ++m) _Pragma("unroll") for (int n = 0; n < 2; ++n) _Pragma("unroll") for (int k = 0; k < 2; ++k) { \
        if constexpr (FP8) { const i64x2 b_ = __builtin_bit_cast(i64x2, Bt[n][k]), a_ = __builtin_bit_cast(i64x2, At[m][k]);     \
            acc[ai][bj][m][n] = __builtin_amdgcn_mfma_f32_16x16x32_fp8_fp8(b_[0], a_[0], acc[ai][bj][m][n], 0, 0, 0); acc[ai][bj][m][n] = __builtin_amdgcn_mfma_f32_16x16x32_fp8_fp8(b_[1], a_[1], acc[ai][bj][m][n], 0, 0, 0); } \
        else acc[ai][bj][m][n] = __builtin_amdgcn_mfma_f32_16x16x32_bf16(Bt[n][k], At[m][k], acc[ai][bj][m][n], 0, 0, 0); } __builtin_amdgcn_s_setprio(0); } while (0)
#define PG8_WAIT_V(n) asm volatile("s_waitcnt vmcnt(" #n ")" ::: "memory")
#define PG8_WAIT_L(n) asm volatile("s_waitcnt lgkmcnt(" #n ")" ::: "memory")
#define PG8_BAR __builtin_amdgcn_s_barrier()
#define PG8_SCHED __builtin_amdgcn_sched_barrier(0)
#define PG8_ROWS(u, v) do { _Pragma("unroll") for (int _h = 0; _h < 2; ++_h) _Pragma("unroll") for (int _i = 0; _i < 2; ++_i) { int _r = rowmap[(u).pm * BM + _h * HALF + RA[_i]]; _r = _r < 0 ? 0 : _r; \
        v[_h][_i] = (unsigned)_r * (unsigned)(K * 2) + CAb[_i]; } } while (0)
#define PG8_BPTR(u) ((const char*)g.Bt + (EXPERT ? (size_t)texp[(u).pm] * bstride : (size_t)0) + (size_t)(u).pn * tstep)
#define PG8_APTR(u) ((const char*)g.A + (GATHER ? (size_t)0 : (size_t)(u).pm * tstep))
    Unit cur, nxt; int ui = 0;
    if (!S.next(0, cur)) return;
    f32x4 acc[2][2][4][2];
#pragma unroll
    for (int a = 0; a < 2; ++a)
#pragma unroll
        for (int b = 0; b < 2; ++b)
#pragma unroll
            for (int m = 0; m < 4; ++m)
#pragma unroll
                for (int n = 0; n < 2; ++n) acc[a][b][m][n] = (f32x4){0.f, 0.f, 0.f, 0.f};
    bf16x8 At[4][2], B0[2][2], B1[2][2];
    unsigned cv[2][2], nv[2][2];
    if constexpr (GATHER) { PG8_ROWS(cur, cv); } else { cv[0][0] = voffA[0]; cv[0][1] = voffA[1]; cv[1][0] = voffA[0]; cv[1][1] = voffA[1]; }
#pragma unroll
    for (int h = 0; h < 2; ++h) { nv[h][0] = cv[h][0]; nv[h][1] = cv[h][1]; }
    const char* cA = PG8_APTR(cur); const char* cB = PG8_BPTR(cur);
    S.a_ready(cur);
    PG8_STAGE(PG8_SB(0, 0), cB, voffB); PG8_STAGE(PG8_SB(0, 1), cB, voffB1); PG8_STAGE(PG8_SA(0, 0), cA, cv[0]); PG8_STAGE(PG8_SA(0, 1), cA + ahs, cv[1]);
    if (wr == 1) PG8_BAR;
    PG8_WAIT_V(2); PG8_BAR;
    PG8_STAGE(PG8_SB(1, 0), cB + kstep, voffB); PG8_STAGE(PG8_SA(1, 0), cA + kstep, cv[0]); PG8_STAGE(PG8_SB(1, 1), cB + kstep, voffB1);
    PG8_WAIT_V(6); PG8_BAR;
    for (;;) {
        const bool has_next = S.next(ui + 1, nxt);
        const char* nA = has_next ? PG8_APTR(nxt) : cA; const char* nB = has_next ? PG8_BPTR(nxt) : cB;
        if constexpr (GATHER) { if (has_next) { PG8_ROWS(nxt, nv); } }
        for (int t = 0; t < nt; t += 2) {
            const bool last = (t == nt - 2);
            const char* a1 = cA + (size_t)(t + 1) * kstep;
            const char* a2 = last ? nA : cA + (size_t)(t + 2) * kstep; const char* b2 = last ? nB : cB + (size_t)(t + 2) * kstep;
            const char* a3 = a2 + kstep; const char* b3 = b2 + kstep;
            unsigned s0[2], s1[2];
            s0[0] = last ? nv[0][0] : cv[0][0]; s0[1] = last ? nv[0][1] : cv[0][1]; s1[0] = last ? nv[1][0] : cv[1][0]; s1[1] = last ? nv[1][1] : cv[1][1];
            if (last && has_next) S.a_ready(nxt);
            PG8_LDB(B0, 0, 0); PG8_LDB(B1, 0, 1); PG8_SCHED; PG8_LDA(At, 0, 0); PG8_STAGE(PG8_SA(1, 1), a1 + ahs, cv[1]);
            PG8_WAIT_V(8); PG8_WAIT_L(0); PG8_BAR; PG8_MMA(0, 0, At, B0); PG8_MMA(0, 1, At, B1); PG8_BAR; PG8_SCHED;
            PG8_LDA(At, 0, 1); PG8_STAGE(PG8_SB(0, 0), b2, voffB); PG8_STAGE(PG8_SB(0, 1), b2, voffB1); PG8_STAGE(PG8_SA(0, 0), a2, s0);
            PG8_WAIT_V(8); PG8_WAIT_L(0); PG8_BAR; PG8_MMA(1, 0, At, B0); PG8_MMA(1, 1, At, B1); PG8_BAR; PG8_SCHED;
            PG8_LDB(B0, 1, 0); PG8_LDB(B1, 1, 1); PG8_SCHED; PG8_LDA(At, 1, 0); PG8_STAGE(PG8_SA(0, 1), a2 + ahs, s1);
            PG8_WAIT_V(8); PG8_WAIT_L(0); PG8_BAR; PG8_MMA(0, 0, At, B0); PG8_MMA(0, 1, At, B1); PG8_BAR; PG8_SCHED;
            PG8_LDA(At, 1, 1); PG8_STAGE(PG8_SB(1, 0), b3, voffB); PG8_STAGE(PG8_SB(1, 1), b3, voffB1); PG8_STAGE(PG8_SA(1, 0), a3, s0);
            PG8_WAIT_V(8); PG8_WAIT_L(0); PG8_BAR; PG8_MMA(1, 0, At, B0); PG8_MMA(1, 1, At, B1); PG8_BAR; PG8_SCHED;
        }
        if constexpr (ALIGN_EPI) { if (wr == 0) PG8_BAR; }
        E(acc, cur, wr, wc, fr, fq); S.done(cur);
        if (!has_next) break;
#pragma unroll
        for (int a = 0; a < 2; ++a)
#pragma unroll
            for (int b = 0; b < 2; ++b)
#pragma unroll
                for (int m = 0; m < 4; ++m)
#pragma unroll
                    for (int n = 0; n < 2; ++n) acc[a][b][m][n] = (f32x4){0.f, 0.f, 0.f, 0.f};
        cur = nxt; cA = nA; cB = nB; ++ui;
#pragma unroll
        for (int h = 0; h < 2; ++h) { cv[h][0] = nv[h][0]; cv[h][1] = nv[h][1]; }
        if constexpr (ALIGN_EPI) { if (wr == 1) PG8_BAR; }
    }
    PG8_WAIT_V(0);
    if constexpr (!ALIGN_EPI) { if (wr == 0) PG8_BAR; }
    PG8_BAR;
#undef PG8_SA
#undef PG8_SB
#undef PG8_STAGE
#undef PG8_LDA
#undef PG8_LDB
#undef PG8_MMA
#undef PG8_WAIT_V
#undef PG8_WAIT_L
#undef PG8_BAR
#undef PG8_SCHED
#undef PG8_ROWS
#undef PG8_BPTR
#undef PG8_APTR
}

struct EpiInProjF {
    static constexpr bool PERM = true, WIDE = true;
    unsigned char* ws; const float* dt_bias; const float* gate_bias; int pm_mask; float ds; int pn_off;
    __device__ __forceinline__ void operator()(const f32x4 (&acc)[2][2][4][2], const Unit& u, int wr, int wc, int fr, int fq) const {
        const int pn = u.pn + pn_off, row0 = (u.pm & pm_mask) * BM + wr * 64 + fr, c8 = wc * 64 + 8 * fq;
        if (pn < 46) {
            bf16* base; int ldc, ct; const bool gate = pn >= 38;
            if (pn < 6) { base = (bf16*)(ws + WS_Q); ldc = AW; ct = pn * 256; }
            else if (pn < 12) { base = (bf16*)(ws + WS_K); ldc = AW; ct = (pn - 6) * 256; }
            else if (pn < 18) { base = (bf16*)(ws + WS_V); ldc = AW; ct = (pn - 12) * 256; }
            else if (pn < 26) { base = (bf16*)(ws + WS_Z); ldc = DI; ct = (pn - 18) * 256; }
            else if (pn < 38) { base = (bf16*)(ws + WS_XBC); ldc = CONVD; ct = (pn - 26) * 256; }
            else { base = (bf16*)(ws + WS_GATE); ldc = 2048; ct = (pn - 38) * 256; }
#if QKV_STORE_FP8
            if (pn < 18) {
                unsigned char* qb8 = ws + (pn < 6 ? WS_Q : (pn < 12 ? WS_K : WS_V));
#pragma unroll
                for (int ai = 0; ai < 2; ++ai)
#pragma unroll
                    for (int m = 0; m < 4; ++m) { unsigned char* rowp = qb8 + (size_t)(row0 + ai * HALF + m * 16) * AW + ct + c8;
#pragma unroll
                        for (int bj = 0; bj < 2; ++bj) { const f32x4 v0 = acc[ai][bj][m][0] * (ds * FP8_ASCALE), v1 = acc[ai][bj][m][1] * (ds * FP8_ASCALE);
                            u32x2 w; w.x = pk_fp8x4(v0.x, v0.y, v0.z, v0.w); w.y = pk_fp8x4(v1.x, v1.y, v1.z, v1.w);
                            __builtin_nontemporal_store(w, (u32x2*)(rowp + bj * 32)); } }
                return;
            }
#endif
            f32x4 gb[2][2];
#pragma unroll
            for (int bj = 0; bj < 2; ++bj)
#pragma unroll
                for (int n = 0; n < 2; ++n) gb[bj][n] = gate ? *(const f32x4*)(gate_bias + ct + c8 + bj * 32 + 4 * n) : (f32x4){0.f, 0.f, 0.f, 0.f};
            const int hi8 = fr >> 3;
#pragma unroll
            for (int ai = 0; ai < 2; ++ai)
#pragma unroll
                for (int m = 0; m < 4; ++m) { bf16* rowp = base + (size_t)(row0 - fr + (fr & 7) + ai * HALF + m * 16) * ldc + ct + wc * 64 + 32 * hi8 + 8 * fq;
                    u32x4 w[2];
#pragma unroll
                    for (int bj = 0; bj < 2; ++bj) { f32x4 v0 = acc[ai][bj][m][0] * ds, v1 = acc[ai][bj][m][1] * ds;
                        if (gate) { v0 = v0 + gb[bj][0]; v1 = v1 + gb[bj][1];
                            v0 = (f32x4){sigmoidf_(v0.x), sigmoidf_(v0.y), sigmoidf_(v0.z), sigmoidf_(v0.w)}; v1 = (f32x4){sigmoidf_(v1.x), sigmoidf_(v1.y), sigmoidf_(v1.z), sigmoidf_(v1.w)}; }
                        w[bj].x = cvt_pk_bf16(v0.x, v0.y); w[bj].y = cvt_pk_bf16(v0.z, v0.w); w[bj].z = cvt_pk_bf16(v1.x, v1.y); w[bj].w = cvt_pk_bf16(v1.z, v1.w); }
                    const u32x4 snd = hi8 ? w[0] : w[1]; u32x4 rcv;
                    rcv.x = (unsigned)__builtin_amdgcn_update_dpp(0, (int)snd.x, 0x128, 0xf, 0xf, false); rcv.y = (unsigned)__builtin_amdgcn_update_dpp(0, (int)snd.y, 0x128, 0xf, 0xf, false);
                    rcv.z = (unsigned)__builtin_amdgcn_update_dpp(0, (int)snd.z, 0x128, 0xf, 0xf, false); rcv.w = (unsigned)__builtin_amdgcn_update_dpp(0, (int)snd.w, 0x128, 0xf, 0xf, false);
                    const u32x4 p0 = hi8 ? rcv : w[0], p1 = hi8 ? w[1] : rcv;
                    __builtin_nontemporal_store(p0, (u32x4*)rowp); __builtin_nontemporal_store(p1, (u32x4*)(rowp + (size_t)8 * ldc)); }
        } else if (wc == 0) {
            const f32x4 b0 = *(const f32x4*)(dt_bias + c8), b1 = *(const f32x4*)(dt_bias + c8 + 4);
#pragma unroll
            for (int ai = 0; ai < 2; ++ai)
#pragma unroll
                for (int m = 0; m < 4; ++m) { float* dp = (float*)(ws + WS_DT) + (size_t)c8 * T + (row0 + ai * HALF + m * 16);
                    const f32x4 v0 = acc[ai][0][m][0] * ds + b0, v1 = acc[ai][0][m][1] * ds + b1;
                    dp[0] = softplusf_(v0.x); dp[(size_t)T] = softplusf_(v0.y); dp[(size_t)2 * T] = softplusf_(v0.z); dp[(size_t)3 * T] = softplusf_(v0.w);
                    dp[(size_t)4 * T] = softplusf_(v1.x); dp[(size_t)5 * T] = softplusf_(v1.y); dp[(size_t)6 * T] = softplusf_(v1.z); dp[(size_t)7 * T] = softplusf_(v1.w); }
        }
    }
};
struct EpiNullF {
    static constexpr bool PERM = true, WIDE = false;
    __device__ __forceinline__ void operator()(const f32x4 (&acc)[2][2][4][2], const Unit&, int, int, int, int) const {
#pragma unroll
        for (int ai = 0; ai < 2; ++ai)
#pragma unroll
            for (int m = 0; m < 4; ++m)
#pragma unroll
                for (int bj = 0; bj < 2; ++bj)
#pragma unroll
                    for (int n = 0; n < 2; ++n) asm volatile("" :: "v"(acc[ai][bj][m][n]));
    }
};
struct EpiM0F {
    static constexpr bool PERM = true, WIDE = false;
    unsigned char* ws;
    __device__ __forceinline__ void operator()(const f32x4 (&acc)[2][2][4][2], const Unit& u, int wr, int wc, int fr, int fq) const {
        const int row0 = u.pm * BM + wr * 64 + fr, col0 = u.pn * BM + wc * 32 + 8 * fq;
#pragma unroll
        for (int ai = 0; ai < 2; ++ai)
#pragma unroll
            for (int m = 0; m < 4; ++m) { const size_t r = (size_t)(row0 + ai * HALF + m * 16);
#pragma unroll
                for (int bj = 0; bj < 2; ++bj) { const int c = col0 + bj * HALF;
                    const u32x4 gg = *(const u32x4*)((const bf16*)(ws + WS_GATE) + r * 2048 + c);
                    const f32x4 v0 = acc[ai][bj][m][0], v1 = acc[ai][bj][m][1];
                    u32x4 w; w.x = cvt_pk_bf16(v0.x * bflo(gg.x), v0.y * bfhi(gg.x)); w.y = cvt_pk_bf16(v0.z * bflo(gg.y), v0.w * bfhi(gg.y));
                    w.z = cvt_pk_bf16(v1.x * bflo(gg.z), v1.y * bfhi(gg.z)); w.w = cvt_pk_bf16(v1.z * bflo(gg.w), v1.w * bfhi(gg.w));
                    *(u32x4*)((bf16*)(ws + WS_M0) + r * D + c) = w; } }
    }
};
struct EpiMergedF {
    static constexpr bool PERM = true, WIDE = false;
    unsigned char* ws;
    __device__ __forceinline__ void operator()(const f32x4 (&acc)[2][2][4][2], const Unit& u, int wr, int wc, int fr, int fq) const {
        const int row0 = u.pm * BM + wr * 64 + fr, col0 = u.pn * BM + wc * 32 + 8 * fq;
#pragma unroll
        for (int ai = 0; ai < 2; ++ai)
#pragma unroll
            for (int m = 0; m < 4; ++m) { const size_t r = (size_t)(row0 + ai * HALF + m * 16);
#pragma unroll
                for (int bj = 0; bj < 2; ++bj) { const int c = col0 + bj * HALF;
                    const u32x4 gg = *(const u32x4*)((const bf16*)(ws + WS_GATE) + r * 2048 + 1024 + c);
                    const u32x4 mm = *(const u32x4*)((const bf16*)(ws + WS_M0) + r * D + c);
                    const f32x4 m0 = (f32x4){bflo(mm.x), bfhi(mm.x), bflo(mm.y), bfhi(mm.y)}, m1 = (f32x4){bflo(mm.z), bfhi(mm.z), bflo(mm.w), bfhi(mm.w)};
                    const f32x4 v0 = acc[ai][bj][m][0], v1 = acc[ai][bj][m][1];
                    u32x4 w; w.x = cvt_pk_bf16(m0.x + v0.x * bflo(gg.x), m0.y + v0.y * bfhi(gg.x)); w.y = cvt_pk_bf16(m0.z + v0.z * bflo(gg.y), m0.w + v0.w * bfhi(gg.y));
                    w.z = cvt_pk_bf16(m1.x + v1.x * bflo(gg.z), m1.y + v1.y * bfhi(gg.z)); w.w = cvt_pk_bf16(m1.z + v1.z * bflo(gg.w), m1.w + v1.w * bfhi(gg.w));
                    *(u32x4*)((bf16*)(ws + WS_MERGED) + r * D + c) = w; } }
    }
};
struct EpiX1F {
    static constexpr bool PERM = false, WIDE = false;
    const float* x; float* out;
    __device__ __forceinline__ void operator()(const f32x4 (&acc)[2][2][4][2], const Unit& u, int wr, int wc, int fr, int fq) const {
        const int row0 = u.pm * BM + wr * 64 + fr, col0 = u.pn * BM + wc * 32 + 4 * fq;
#pragma unroll
        for (int ai = 0; ai < 2; ++ai)
#pragma unroll
            for (int m = 0; m < 4; ++m) { const size_t r = (size_t)(row0 + ai * HALF + m * 16);
#pragma unroll
                for (int bj = 0; bj < 2; ++bj)
#pragma unroll
                    for (int n = 0; n < 2; ++n) { const int c = col0 + bj * HALF + n * 16;
                        *(f32x4*)(out + r * D + c) = *(const f32x4*)(x + r * D + c) + acc[ai][bj][m][n]; } }
    }
};
struct EpiMoe1F {
    static constexpr bool PERM = true, WIDE = false;
    unsigned char* ws; const float* b1; const int* texp;
    __device__ __forceinline__ void operator()(const f32x4 (&acc)[2][2][4][2], const Unit& u, int wr, int wc, int fr, int fq) const {
        const int e = texp[u.pm];
        const int row0 = u.pm * BM + wr * 64 + fr, col0 = u.pn * BM + wc * 32 + 8 * fq;
        f32x4 bv[2][2];
#pragma unroll
        for (int bj = 0; bj < 2; ++bj)
#pragma unroll
            for (int n = 0; n < 2; ++n) bv[bj][n] = *(const f32x4*)(b1 + (size_t)e * 2048 + col0 + bj * HALF + 4 * n);
#pragma unroll
        for (int ai = 0; ai < 2; ++ai)
#pragma unroll
            for (int m = 0; m < 4; ++m) { const size_t r = (size_t)(row0 + ai * HALF + m * 16);
#pragma unroll
                for (int bj = 0; bj < 2; ++bj) { const f32x4 v0 = acc[ai][bj][m][0] + bv[bj][0], v1 = acc[ai][bj][m][1] + bv[bj][1];
                    u32x2 w; w.x = cvt_pk_bf16(swiglu_(v0.x, v0.y), swiglu_(v0.z, v0.w)); w.y = cvt_pk_bf16(swiglu_(v1.x, v1.y), swiglu_(v1.z, v1.w));
                    __builtin_nontemporal_store(w, (u32x2*)((bf16*)(ws + WS_ACT) + r * 1024 + ((col0 + bj * HALF) >> 1))); } }
    }
};
struct EpiMoe1Q {
    static constexpr bool PERM = true, WIDE = false;
    unsigned char* ws; const float* b1; const int* texp;
    __device__ __forceinline__ void operator()(const f32x4 (&acc)[2][2][4][2], const Unit& u, int wr, int wc, int fr, int fq) const {
        const int e = texp[u.pm];
        const int row0 = u.pm * BM + wr * 64 + fr, col0 = u.pn * BM + wc * 32 + 8 * fq;
        constexpr float DS = 1.f / (FP8_ASCALE * FP8_WSCALE);
        f32x4 bv[2][2];
#pragma unroll
        for (int bj = 0; bj < 2; ++bj)
#pragma unroll
            for (int n = 0; n < 2; ++n) bv[bj][n] = *(const f32x4*)(b1 + (size_t)e * 2048 + col0 + bj * HALF + 4 * n);
#pragma unroll
        for (int ai = 0; ai < 2; ++ai)
#pragma unroll
            for (int m = 0; m < 4; ++m) { const size_t r = (size_t)(row0 + ai * HALF + m * 16);
#pragma unroll
                for (int bj = 0; bj < 2; ++bj) { const f32x4 v0 = acc[ai][bj][m][0] * DS + bv[bj][0], v1 = acc[ai][bj][m][1] * DS + bv[bj][1];
                    const unsigned w = pk_fp8x4(FP8_ASCALE * swiglu_(v0.x, v0.y), FP8_ASCALE * swiglu_(v0.z, v0.w), FP8_ASCALE * swiglu_(v1.x, v1.y), FP8_ASCALE * swiglu_(v1.z, v1.w));
                    __builtin_nontemporal_store(w, (unsigned*)(ws + WS_ACT + r * 1024 + ((col0 + bj * HALF) >> 1))); } }
    }
};
struct EpiMoe2Q {
    static constexpr bool PERM = true, WIDE = false;
    unsigned char* ws; const float* b2; const int* texp;
    __device__ __forceinline__ void operator()(const f32x4 (&acc)[2][2][4][2], const Unit& u, int wr, int wc, int fr, int fq) const {
        const int e = texp[u.pm];
        const int row0 = u.pm * BM + wr * 64 + fr, col0 = u.pn * BM + wc * 32 + 8 * fq;
        constexpr float DS = 1.f / (FP8_ASCALE * FP8_WSCALE);
        f32x4 bv[2][2];
#pragma unroll
        for (int bj = 0; bj < 2; ++bj)
#pragma unroll
            for (int n = 0; n < 2; ++n) bv[bj][n] = *(const f32x4*)(b2 + (size_t)e * 1024 + col0 + bj * HALF + 4 * n);
#pragma unroll
        for (int ai = 0; ai < 2; ++ai)
#pragma unroll
            for (int m = 0; m < 4; ++m) { const size_t r = (size_t)(row0 + ai * HALF + m * 16);
#pragma unroll
                for (int bj = 0; bj < 2; ++bj) { const f32x4 v0 = acc[ai][bj][m][0] * DS + bv[bj][0], v1 = acc[ai][bj][m][1] * DS + bv[bj][1];
                    u32x4 w; w.x = cvt_pk_bf16(v0.x, v0.y); w.y = cvt_pk_bf16(v0.z, v0.w); w.z = cvt_pk_bf16(v1.x, v1.y); w.w = cvt_pk_bf16(v1.z, v1.w);
                    __builtin_nontemporal_store(w, (u32x4*)((bf16*)(ws + WS_YB) + r * 1024 + col0 + bj * HALF)); } }
    }
};
struct EpiMoe2F {
    static constexpr bool PERM = true, WIDE = false;
    unsigned char* ws; const float* b2; const int* texp;
    __device__ __forceinline__ void operator()(const f32x4 (&acc)[2][2][4][2], const Unit& u, int wr, int wc, int fr, int fq) const {
        const int e = texp[u.pm];
        const int row0 = u.pm * BM + wr * 64 + fr, col0 = u.pn * BM + wc * 32 + 8 * fq;
        f32x4 bv[2][2];
#pragma unroll
        for (int bj = 0; bj < 2; ++bj)
#pragma unroll
            for (int n = 0; n < 2; ++n) bv[bj][n] = *(const f32x4*)(b2 + (size_t)e * 1024 + col0 + bj * HALF + 4 * n);
#pragma unroll
        for (int ai = 0; ai < 2; ++ai)
#pragma unroll
            for (int m = 0; m < 4; ++m) { const size_t r = (size_t)(row0 + ai * HALF + m * 16);
#pragma unroll
                for (int bj = 0; bj < 2; ++bj) { const f32x4 v0 = acc[ai][bj][m][0] + bv[bj][0], v1 = acc[ai][bj][m][1] + bv[bj][1];
                    u32x4 w; w.x = cvt_pk_bf16(v0.x, v0.y); w.y = cvt_pk_bf16(v0.z, v0.w); w.z = cvt_pk_bf16(v1.x, v1.y); w.w = cvt_pk_bf16(v1.z, v1.w);
                    __builtin_nontemporal_store(w, (u32x4*)((bf16*)(ws + WS_YB) + r * 1024 + col0 + bj * HALF)); } }
    }
};
}

__device__ __forceinline__ int t5_bucket_dev(int dist) {
    if (dist < 16) return dist;
    int l = 16 + (int)(logf((float)dist / 16.f) / logf(128.f) * 16.f);
    return l < 31 ? l : 31;
}
__device__ __forceinline__ void transpose_item(const float* W, int K, int N, bf16* WT, int k0, int n0, int drow0, LAS float* scr, int lane) {
#pragma unroll 8
    for (int i = 0; i < 32; ++i) { const int kk = 2 * i + (lane >> 5); scr[kk * 33 + (lane & 31)] = __builtin_nontemporal_load(W + (size_t)(k0 + kk) * N + n0 + (lane & 31)); }
    asm volatile("s_waitcnt lgkmcnt(0)" ::: "memory");
    const int c = lane & 7;
#pragma unroll
    for (int j = 0; j < 4; ++j) { const int n = (lane >> 3) + 8 * j; const LAS float* s = scr + (8 * c) * 33 + n;
        u32x4 o; o.x = pk2(s[0 * 33], s[1 * 33]); o.y = pk2(s[2 * 33], s[3 * 33]); o.z = pk2(s[4 * 33], s[5 * 33]); o.w = pk2(s[6 * 33], s[7 * 33]);
        *(u32x4*)(WT + (size_t)(drow0 + n) * K + k0 + 8 * c) = o; }
    asm volatile("s_waitcnt lgkmcnt(0)" ::: "memory");
}
__device__ __forceinline__ void transpose_item_fp8(const float* W, int K, int N, unsigned char* WT, int k0, int n0, int drow0, float scale, LAS float* scr, int lane) {
#pragma unroll 8
    for (int i = 0; i < 64; ++i) { const int kk = 2 * i + (lane >> 5); scr[kk * 33 + (lane & 31)] = __builtin_nontemporal_load(W + (size_t)(k0 + kk) * N + n0 + (lane & 31)) * scale; }
    asm volatile("s_waitcnt lgkmcnt(0)" ::: "memory");
    const int c = lane & 7;
#pragma unroll
    for (int j = 0; j < 4; ++j) { const int n = (lane >> 3) + 8 * j; const LAS float* s = scr + (16 * c) * 33 + n;
        u32x4 o; o.x = pk_fp8x4(s[0 * 33], s[1 * 33], s[2 * 33], s[3 * 33]); o.y = pk_fp8x4(s[4 * 33], s[5 * 33], s[6 * 33], s[7 * 33]);
        o.z = pk_fp8x4(s[8 * 33], s[9 * 33], s[10 * 33], s[11 * 33]); o.w = pk_fp8x4(s[12 * 33], s[13 * 33], s[14 * 33], s[15 * 33]);
        *(u32x4*)(WT + (size_t)(drow0 + n) * K + k0 + 16 * c) = o; }
    asm volatile("s_waitcnt lgkmcnt(0)" ::: "memory");
}
__device__ __forceinline__ int inproj_row_of_col(int n0) { return n0 < C_DT ? n0 : (n0 < C_GATE ? n0 - C_DT + 11776 : n0 - 32); }
__device__ __forceinline__ void p_convert_small(Frame& F) {
    LAS float* scr = (LAS float*)(F.lds + F.wave * 16896);
    const int gw = F.blk * NWAVES + F.wave, NGW = F.nblk * NWAVES;
    constexpr int NBQ = QKV_FP8 ? C_Z / 32 : 0;
    constexpr int I_INQ = 8 * NBQ, I_IN = 16 * (NPROJ / 32 - NBQ), I_BA = 8 * 32, I_BS = 32 * 32, I_OUT = 16 * 32, NIT = I_INQ + I_IN + I_BA + I_BS + I_OUT;
    for (int it = gw; it < NIT; it += NGW) {
        int r = it;
        if (r < I_INQ) { const int nb = r % (NBQ ? NBQ : 1), kb = r / (NBQ ? NBQ : 1); transpose_item_fp8(F.w_in, D, NPROJ, F.ws + WS_WQKVQ, 128 * kb, 32 * nb, 32 * nb, FP8_WSCALE, scr, ((int)(threadIdx.x & 63u))); continue; } r -= I_INQ;
        if (r < I_IN) { const int nb = NBQ + r % (NPROJ / 32 - NBQ), kb = r / (NPROJ / 32 - NBQ); transpose_item(F.w_in, D, NPROJ, (bf16*)(F.ws + WS_WIN_T), 64 * kb, 32 * nb, inproj_row_of_col(32 * nb), scr, ((int)(threadIdx.x & 63u))); continue; } r -= I_IN;
        if (r < I_BA) { const int nb = r % 32, kb = r / 32; transpose_item(F.w_ba, 512, D, (bf16*)(F.ws + WS_WBA_T), 64 * kb, 32 * nb, 32 * nb, scr, ((int)(threadIdx.x & 63u))); continue; } r -= I_BA;
        if (r < I_BS) { const int nb = r % 32, kb = r / 32; transpose_item(F.w_bs, DI, D, (bf16*)(F.ws + WS_WBS_T), 64 * kb, 32 * nb, 32 * nb, scr, ((int)(threadIdx.x & 63u))); continue; } r -= I_BS;
        { const int nb = r % 32, kb = r / 32; transpose_item(F.w_out, D, D, (bf16*)(F.ws + WS_WOUT_T), 64 * kb, 32 * nb, 32 * nb, scr, ((int)(threadIdx.x & 63u))); }
    }
    for (int i = F.blk * NTHREADS + ((int)threadIdx.x); i < 24 * 192; i += F.nblk * NTHREADS) { const int head = i / 192, dl = i % 192 - 32, g = head >> 3, dil = g == 0 ? 1 : (g == 1 ? 4 : 16);
        ((float*)(F.ws + WS_BT))[i] = F.rel_bias[t5_bucket_dev((dl < 0 ? 0 : (dl > 128 ? 128 : dl)) * dil) * 24 + head] * 1.4426950408889634f; }
    for (int i = F.blk * NTHREADS + ((int)threadIdx.x); i < 32 * 1024; i += F.nblk * NTHREADS) ((float*)(F.ws + WS_WRT))[i] = F.norm_ffn[i >> 5] * F.router_w[i];
    u32x4* z = (u32x4*)((bf16*)(F.ws + WS_WIN_T) + (size_t)11808 * D);
    for (int i = F.blk * NTHREADS + ((int)threadIdx.x); i < 224 * D * 2 / 16; i += F.nblk * NTHREADS) z[i] = (u32x4){0u, 0u, 0u, 0u};
}
__device__ __forceinline__ void p_convert_moe_fp8(Frame& F) {
    LAS float* scr = (LAS float*)(F.lds + F.wave * 16896);
    const int gw = F.blk * NWAVES + F.wave, NGW = F.nblk * NWAVES;
    constexpr int I_1 = 8 * 64, I_2 = 8 * 32, NIT = NEXP * (I_1 + I_2);
    for (int it = gw; it < NIT; it += NGW) {
        const int e = it / (I_1 + I_2); int r = it % (I_1 + I_2);
        if (r < I_1) { const int nb = r % 64, kb = r / 64; transpose_item_fp8(F.w1 + (size_t)e * 1024 * 2048, 1024, 2048, F.ws + WS_W1T + (size_t)e * 2048 * 1024, 128 * kb, 32 * nb, 32 * nb, FP8_WSCALE, scr, ((int)(threadIdx.x & 63u))); }
        else { r -= I_1; const int nb = r % 32, kb = r / 32; transpose_item_fp8(F.w2 + (size_t)e * 1024 * 1024, 1024, 1024, F.ws + WS_W2T + (size_t)e * 1024 * 1024, 128 * kb, 32 * nb, 32 * nb, FP8_WSCALE, scr, ((int)(threadIdx.x & 63u))); }
    }
}
__device__ __forceinline__ void p_convert_moe(Frame& F) {
    LAS float* scr = (LAS float*)(F.lds + F.wave * 16384);
    const int gw = F.blk * NWAVES + F.wave, NGW = F.nblk * NWAVES;
    constexpr int I_1 = 16 * 64, I_2 = 16 * 32, NIT = NEXP * (I_1 + I_2);
    for (int it = gw; it < NIT; it += NGW) {
        const int e = it / (I_1 + I_2); int r = it % (I_1 + I_2);
        if (r < I_1) { const int nb = r % 64, kb = r / 64; transpose_item(F.w1 + (size_t)e * 1024 * 2048, 1024, 2048, (bf16*)(F.ws + WS_W1T) + (size_t)e * 2048 * 1024, 64 * kb, 32 * nb, 32 * nb, scr, ((int)(threadIdx.x & 63u))); }
        else { r -= I_1; const int nb = r % 32, kb = r / 32; transpose_item(F.w2 + (size_t)e * 1024 * 1024, 1024, 1024, (bf16*)(F.ws + WS_W2T) + (size_t)e * 1024 * 1024, 64 * kb, 32 * nb, 32 * nb, scr, ((int)(threadIdx.x & 63u))); }
    }
}

__device__ __forceinline__ void p_rmsnorm_in(Frame& F) {
    const int gw = F.blk * NWAVES + F.wave, NGW = F.nblk * NWAVES;
    bf16* XN = (bf16*)(F.ws + WS_XN);
    for (int m = gw; m < T; m += NGW) {
        const f32x4* xr = (const f32x4*)(F.x + (size_t)m * D) + ((int)(threadIdx.x & 63u));
        const f32x4* wr = (const f32x4*)F.norm_mix + ((int)(threadIdx.x & 63u));
        f32x4 v[4]; float s = 0.f;
#pragma unroll
        for (int j = 0; j < 4; ++j) { v[j] = __builtin_nontemporal_load(xr + 64 * j); s += (v[j].x * v[j].x + v[j].y * v[j].y) + (v[j].z * v[j].z + v[j].w * v[j].w); }
        const float rstd = __builtin_amdgcn_rsqf(wave_sum(s) * (1.f / D) + EPS);
#pragma unroll
        for (int j = 0; j < 4; ++j) { const f32x4 w = wr[64 * j]; const f32x4 o = v[j] * rstd * w; st_bf4(XN + (size_t)m * D + (((int)(threadIdx.x & 63u)) + 64 * j) * 4, o);
#if QKV_FP8
            *(unsigned*)(F.ws + WS_XNQ + (size_t)m * D + (((int)(threadIdx.x & 63u)) + 64 * j) * 4) = pk_fp8x4(FP8_ASCALE * o.x, FP8_ASCALE * o.y, FP8_ASCALE * o.z, FP8_ASCALE * o.w);
#endif
        }
    }
}

__device__ __forceinline__ void p_attn_naive(Frame& F) {
    LAS float* btab = (LAS float*)F.lds;
    for (int i = ((int)threadIdx.x); i < 3 * 129 * 8; i += NTHREADS) {
        const int g = i / (129 * 8), j = (i >> 3) % 129, hg = i & 7;
        const int dil = g == 0 ? 1 : (g == 1 ? 4 : 16);
        btab[i] = F.rel_bias[t5_bucket_dev(j * dil) * 24 + g * 8 + hg];
    }
    __syncthreads();
    const bf16* Qb = (const bf16*)(F.ws + WS_Q); const bf16* Kb = (const bf16*)(F.ws + WS_K); const bf16* Vb = (const bf16*)(F.ws + WS_V);
    bf16* AT = (bf16*)(F.ws + WS_ATTN);
    for (int idx = F.blk * NTHREADS + ((int)threadIdx.x); idx < T * 8; idx += F.nblk * NTHREADS) {
        const int hg = idx & 7, row = idx >> 3, t = row & (SEQ - 1);
        float m = -INFINITY, den = 0.f;
        float acc[64];
#pragma unroll
        for (int i = 0; i < 64; ++i) acc[i] = 0.f;
        for (int g = 0; g < 3; ++g) {
            const int dil = g == 0 ? 1 : (g == 1 ? 4 : 16);
            const int head = g * 8 + hg;
            float q[64];
            { const u32x4* qp = (const u32x4*)(Qb + (size_t)row * AW + head * 64);
#pragma unroll
              for (int c = 0; c < 8; ++c) { const u32x4 w = qp[c]; q[8 * c + 0] = bflo(w.x); q[8 * c + 1] = bfhi(w.x); q[8 * c + 2] = bflo(w.y); q[8 * c + 3] = bfhi(w.y);
                  q[8 * c + 4] = bflo(w.z); q[8 * c + 5] = bfhi(w.z); q[8 * c + 6] = bflo(w.w); q[8 * c + 7] = bfhi(w.w); } }
            for (int j = 0; j <= 128; ++j) {
                const int kt = t - j * dil; if (kt < 0) break;
                const size_t krow = (size_t)(row - j * dil);
                const u32x4* kp = (const u32x4*)(Kb + krow * AW + head * 64);
                float s = 0.f;
#pragma unroll
                for (int c = 0; c < 8; ++c) { const u32x4 w = kp[c];
                    s += q[8 * c + 0] * bflo(w.x) + q[8 * c + 1] * bfhi(w.x) + q[8 * c + 2] * bflo(w.y) + q[8 * c + 3] * bfhi(w.y)
                       + q[8 * c + 4] * bflo(w.z) + q[8 * c + 5] * bfhi(w.z) + q[8 * c + 6] * bflo(w.w) + q[8 * c + 7] * bfhi(w.w); }
                s = s * 0.125f + btab[(g * 129 + j) * 8 + hg];
                const float mn = fmaxf(m, s), sc = __expf(m - mn), p = __expf(s - mn);
                m = mn; den = den * sc + p;
                const u32x4* vp = (const u32x4*)(Vb + krow * AW + head * 64);
#pragma unroll
                for (int c = 0; c < 8; ++c) { const u32x4 w = vp[c];
                    acc[8 * c + 0] = acc[8 * c + 0] * sc + p * bflo(w.x); acc[8 * c + 1] = acc[8 * c + 1] * sc + p * bfhi(w.x);
                    acc[8 * c + 2] = acc[8 * c + 2] * sc + p * bflo(w.y); acc[8 * c + 3] = acc[8 * c + 3] * sc + p * bfhi(w.y);
                    acc[8 * c + 4] = acc[8 * c + 4] * sc + p * bflo(w.z); acc[8 * c + 5] = acc[8 * c + 5] * sc + p * bfhi(w.z);
                    acc[8 * c + 6] = acc[8 * c + 6] * sc + p * bflo(w.w); acc[8 * c + 7] = acc[8 * c + 7] * sc + p * bfhi(w.w); }
            }
        }
        const float inv = 1.f / den;
        u32x4* op = (u32x4*)(AT + (size_t)row * 512 + hg * 64);
#pragma unroll
        for (int c = 0; c < 8; ++c) { u32x4 w; w.x = pk2(acc[8 * c] * inv, acc[8 * c + 1] * inv); w.y = pk2(acc[8 * c + 2] * inv, acc[8 * c + 3] * inv);
            w.z = pk2(acc[8 * c + 4] * inv, acc[8 * c + 5] * inv); w.w = pk2(acc[8 * c + 6] * inv, acc[8 * c + 7] * inv); op[c] = w; }
    }
    __syncthreads();
}

typedef short bf16x8_t __attribute__((ext_vector_type(8)));
typedef short s16x4_t __attribute__((ext_vector_type(4)));
typedef float f32x16 __attribute__((ext_vector_type(16)));
__device__ __forceinline__ int crow_(int reg, int h) { return (reg & 3) + 8 * (reg >> 2) + 4 * h; }
__device__ __forceinline__ s16x4_t tr_read_(const LAS unsigned char* p) { return __builtin_bit_cast(s16x4_t, __builtin_amdgcn_ds_read_tr16_b64_v4i16((LAS s16x4_t*)p)); }
constexpr int ATT_HALF_BYTES = 66560;
template <bool LOADKV = true, bool DOSTORE = true, bool DOMATH = true>
__device__ __forceinline__ void p_attn_fast(Frame& F) {
    const int half = F.wave >> 2, qb = F.wave & 3;
    const bf16* Qb = (const bf16*)(F.ws + WS_Q); const bf16* Kb = (const bf16*)(F.ws + WS_K); const bf16* Vb = (const bf16*)(F.ws + WS_V);
    bf16* OUTG = (bf16*)(F.ws + WS_OUTG); float* LSE = (float*)(F.ws + WS_LSE); const float* BT = (const float*)(F.ws + WS_BT);
    constexpr int NUNIT = BATCH * 24 * 16;
    constexpr float LOG2E = 1.4426950408889634f;
    constexpr float QKS = QKV_STORE_FP8 ? 1.f / (FP8_ASCALE * FP8_ASCALE) : 1.f, VS = QKV_STORE_FP8 ? 1.f / FP8_ASCALE : 1.f;
    const int nhw = F.nblk * 2, per = (NUNIT + nhw - 1) / nhw, u0 = (F.blk * 2 + half) * per;
#if QKV_STORE_FP8
    const unsigned char* Q8 = F.ws + WS_Q; const unsigned char* K8 = F.ws + WS_K; const unsigned char* V8 = F.ws + WS_V; (void)Qb; (void)Kb; (void)Vb;
    u32x4 kreg[2], vreg[2]; float breg = 0.f;
#else
    u32x4 kreg[4], vreg[4]; float breg = 0.f;
#endif
#define ATT_DECODE(u_) const int zn = (u_) & 15, head = ((u_) >> 4) % 24, b = (u_) / (16 * 24); const int g = head >> 3, hg = head & 7; \
        const int dil = g == 0 ? 1 : (g == 1 ? 4 : 16), nb = 16 / dil; const int z = zn / nb, n = zn % nb; const size_t rowb = (size_t)b * SEQ; (void)hg; (void)rowb; (void)z; (void)n
#if QKV_STORE_FP8
#define ATT_LOADBLK(u_, blk_) do { ATT_DECODE(u_); const int th_ = ((int)threadIdx.x) & 255; \
        _Pragma("unroll") for (int i = 0; i < 2; ++i) { const int piece = th_ + 256 * i, kw = piece >> 2, c16 = piece & 3; const int p = (blk_) * 128 + kw; \
            kreg[i] = (u32x4){0u, 0u, 0u, 0u}; vreg[i] = (u32x4){0u, 0u, 0u, 0u}; \
            if (LOADKV && (u_) < NUNIT) { const size_t row = rowb + (size_t)p * dil + z; kreg[i] = *(const u32x4*)(K8 + row * AW + head * 64 + c16 * 16); vreg[i] = *(const u32x4*)(V8 + row * AW + head * 64 + c16 * 16); } } \
        if (th_ < 192 && (u_) < NUNIT) breg = BT[head * 192 + th_]; } while (0)
#define ATT_STOREBLK(slot_) do { _Pragma("unroll") for (int i = 0; i < 2; ++i) { const int piece = th + 256 * i, kw = piece >> 2, c16 = piece & 3; const int rb_ = ((slot_) * 128 + kw) * 128; \
            *(LAS u32x4*)(Kimg + rb_ + (((2 * c16) ^ (kw & 7)) << 4)) = fp8x8_to_bf16x8(kreg[i].x, kreg[i].y); *(LAS u32x4*)(Kimg + rb_ + (((2 * c16 + 1) ^ (kw & 7)) << 4)) = fp8x8_to_bf16x8(kreg[i].z, kreg[i].w); \
            *(LAS u32x4*)(Vimg + rb_ + (((2 * c16) ^ (kw & 7)) << 4)) = fp8x8_to_bf16x8(vreg[i].x, vreg[i].y); *(LAS u32x4*)(Vimg + rb_ + (((2 * c16 + 1) ^ (kw & 7)) << 4)) = fp8x8_to_bf16x8(vreg[i].z, vreg[i].w); } } while (0)
#else
#define ATT_LOADBLK(u_, blk_) do { ATT_DECODE(u_); const int th_ = ((int)threadIdx.x) & 255; \
        _Pragma("unroll") for (int i = 0; i < 4; ++i) { const int piece = th_ + 256 * i, kw = piece >> 3, ch = piece & 7; const int p = (blk_) * 128 + kw; \
            kreg[i] = (u32x4){0u, 0u, 0u, 0u}; vreg[i] = (u32x4){0u, 0u, 0u, 0u}; \
            if (LOADKV && (u_) < NUNIT) { const size_t row = rowb + (size_t)p * dil + z; kreg[i] = *(const u32x4*)(Kb + row * AW + head * 64 + ch * 8); vreg[i] = *(const u32x4*)(Vb + row * AW + head * 64 + ch * 8); } } \
        if (th_ < 192 && (u_) < NUNIT) breg = BT[head * 192 + th_]; } while (0)
#define ATT_STOREBLK(slot_) do { _Pragma("unroll") for (int i = 0; i < 4; ++i) { const int piece = th + 256 * i, kw = piece >> 3, ch = piece & 7; const int off = ((slot_) * 128 + kw) * 128 + ((ch ^ (kw & 7)) << 4); \
            *(LAS u32x4*)(Kimg + off) = kreg[i]; *(LAS u32x4*)(Vimg + off) = vreg[i]; } } while (0)
#endif
    {
        for (int i = ((int)threadIdx.x); i < 2 * ATT_HALF_BYTES / 16; i += NTHREADS) ((LAS u32x4*)F.lds)[i] = (u32x4){0u, 0u, 0u, 0u};
        __syncthreads();
        const int th = ((int)threadIdx.x) & 255;
        LAS unsigned char* base = F.lds + half * ATT_HALF_BYTES; LAS unsigned char* Kimg = base; LAS unsigned char* Vimg = base + 32768;
        if (u0 < NUNIT) { const int n0 = (u0 & 15) % (16 / ((((u0 >> 4) % 24) >> 3) == 0 ? 1 : ((((u0 >> 4) % 24) >> 3) == 1 ? 4 : 16)));
            if (n0 > 0) { ATT_LOADBLK(u0, n0 - 1); ATT_STOREBLK((n0 - 1) & 1); } }
        ATT_LOADBLK(u0, (u0 & 15) % (16 / ((((u0 >> 4) % 24) >> 3) == 0 ? 1 : ((((u0 >> 4) % 24) >> 3) == 1 ? 4 : 16))));
    }
    for (int it = 0; it < per; ++it) {
        const int u = u0 + it;
        const bool live = u < NUNIT;
        ATT_DECODE(live ? u : 0);
        unsigned opq_ = 0; asm volatile("" : "+s"(opq_));
        int tl_ = ((int)threadIdx.x); asm volatile("" : "+v"(tl_));
        const int th = tl_ & 255, lane = tl_ & 63, r = lane & 31, h = lane >> 5;
        LAS unsigned char* base = F.lds + half * ATT_HALF_BYTES + opq_;
        LAS unsigned char* Kimg = base; LAS unsigned char* Vimg = base + 32768; LAS float* btab = (LAS float*)(base + 65536);
        const int flip = ((n - 1) & 1) << 7;
        bf16x8_t qf[4];
        { const size_t qrow = rowb + (size_t)(n * 128 + 32 * qb + r) * dil + z;
#pragma unroll
#if QKV_STORE_FP8
          for (int dd = 0; dd < 4; ++dd) { const u32x2 q8 = *(const u32x2*)(Q8 + qrow * AW + head * 64 + 16 * dd + 8 * h); qf[dd] = __builtin_bit_cast(bf16x8_t, fp8x8_to_bf16x8(q8.x, q8.y)); } }
#else
          for (int dd = 0; dd < 4; ++dd) qf[dd] = *(const bf16x8_t*)(Qb + qrow * AW + head * 64 + 16 * dd + 8 * h); }
#endif
        LDS_BARRIER();
        ATT_STOREBLK(n & 1);
        if (th < 192) btab[th] = breg;
        LDS_BARRIER();
        if (it + 1 < per) { const int un = u + 1; ATT_LOADBLK(un, ((un) & 15) % (16 / ((((un >> 4) % 24) >> 3) == 0 ? 1 : ((((un >> 4) % 24) >> 3) == 1 ? 4 : 16)))); }
        if (!live) continue;
        f32x16 sc[5];
#pragma unroll
        for (int kb = 0; kb < 5; ++kb) {
            f32x16 a = {0.f, 0.f, 0.f, 0.f, 0.f, 0.f, 0.f, 0.f, 0.f, 0.f, 0.f, 0.f, 0.f, 0.f, 0.f, 0.f};
            const int krow0 = (32 * (qb + kb) + r) ^ flip;
            if (!(n == 0 && qb + kb <= 3))
#pragma unroll
            for (int dd = 0; dd < 4; ++dd) {
                const bf16x8_t kf = *(const LAS bf16x8_t*)(Kimg + krow0 * 128 + (((2 * dd + h) ^ (r & 7)) << 4));
                a = __builtin_amdgcn_mfma_f32_32x32x16_bf16(kf, qf[dd], a, 0, 0, 0);
            }
            sc[kb] = a;
        }
        float m = -INFINITY;
        const LAS float* const bl = btab + (r - 4 * h);
#pragma unroll
        for (int kb = 0; kb < 5; ++kb)
#pragma unroll
            for (int i = 0; i < 16; ++i) {
                const int cc = (i & 3) + 8 * (i >> 2);
                const float bias = bl[160 - 32 * kb - cc];
                float s = sc[kb][i] * (0.125f * LOG2E * QKS) + bias;
                const int c = cc + 4 * h;
                if (kb == 0) s = (r <= c && n != 0) ? s : -INFINITY;
                else if (kb == 4) s = (c <= r) ? s : -INFINITY;
                else s = (n == 0 && (32 * (qb + kb) + c) < 128) ? -INFINITY : s;
                sc[kb][i] = s; m = fmaxf(m, s);
            }
        m = fmaxf(m, __shfl_xor(m, 32));
        float den = 0.f;
#pragma unroll
        for (int kb = 0; kb < 5; ++kb) {
            if (n == 0 && qb + kb <= 3) continue;
#pragma unroll
            for (int i = 0; i < 16; ++i) { const float p = __builtin_amdgcn_exp2f(sc[kb][i] - m); sc[kb][i] = p; den += p; } }
        den += __shfl_xor(den, 32);
        const float inv = VS * __builtin_amdgcn_rcpf(den);
        if (DOSTORE && h == 0) LSE[((size_t)g * T + rowb + (size_t)(n * 128 + 32 * qb + r) * dil + z) * 8 + hg] = (m + __builtin_amdgcn_logf(den)) * (1.f / LOG2E);
        f32x16 o[2];
        o[0] = (f32x16){0.f, 0.f, 0.f, 0.f, 0.f, 0.f, 0.f, 0.f, 0.f, 0.f, 0.f, 0.f, 0.f, 0.f, 0.f, 0.f}; o[1] = o[0];
        const int q4 = (lane & 15) >> 2, blk16 = (lane >> 4) & 1, p4 = lane & 3;
#pragma unroll
        for (int kb = 0; kb < 5; ++kb) {
            if (n == 0 && qb + kb <= 3) continue;
#pragma unroll
            for (int s = 0; s < 2; ++s) {
                u32x4 pw;
                pw.x = cvtpk(sc[kb][8 * s + 0] * inv, sc[kb][8 * s + 1] * inv); pw.y = cvtpk(sc[kb][8 * s + 2] * inv, sc[kb][8 * s + 3] * inv);
                pw.z = cvtpk(sc[kb][8 * s + 4] * inv, sc[kb][8 * s + 5] * inv); pw.w = cvtpk(sc[kb][8 * s + 6] * inv, sc[kb][8 * s + 7] * inv);
                const bf16x8_t pa = __builtin_bit_cast(bf16x8_t, pw);
                const int row_lo = (32 * (qb + kb) + 16 * s + 4 * h + q4) ^ flip, row_hi = row_lo + 8;
#pragma unroll
                for (int db = 0; db < 2; ++db) {
                    const int chunk = 4 * db + 2 * blk16 + (p4 >> 1), sub = (p4 & 1) * 8;
                    const s16x4_t lo = tr_read_(Vimg + row_lo * 128 + ((chunk ^ (row_lo & 7)) << 4) + sub);
                    const s16x4_t hi = tr_read_(Vimg + row_hi * 128 + ((chunk ^ (row_hi & 7)) << 4) + sub);
                    const bf16x8_t vf = (bf16x8_t){lo[0], lo[1], lo[2], lo[3], hi[0], hi[1], hi[2], hi[3]};
                    o[db] = __builtin_amdgcn_mfma_f32_32x32x16_bf16(pa, vf, o[db], 0, 0, 0);
                }
            } }
#pragma unroll
        for (int i = 0; i < 16; ++i) {
            const size_t row = rowb + (size_t)(n * 128 + 32 * qb + crow_(i, h)) * dil + z;
            bf16* op = OUTG + ((size_t)g * T + row) * 512 + hg * 64 + r;
            const unsigned w = cvtpk(o[0][i], o[1][i]);
            if (DOSTORE) { op[0] = (bf16)(w & 0xffffu); op[32] = (bf16)(w >> 16); } else asm volatile("" :: "v"(w));
        }
    }
#undef ATT_DECODE
#undef ATT_LOADBLK
#undef ATT_STOREBLK
    __syncthreads();
}
__device__ __forceinline__ void p_attn_merge(Frame& F) {
    const bf16* OUTG = (const bf16*)(F.ws + WS_OUTG); const float* LSE = (const float*)(F.ws + WS_LSE); bf16* AT = (bf16*)(F.ws + WS_ATTN);
    for (int idx = F.blk * NTHREADS + ((int)threadIdx.x); idx < T * 64; idx += F.nblk * NTHREADS) {
        const int row = idx >> 6, c8 = (idx & 63) * 8, hg = c8 >> 6;
        const float l0 = LSE[((size_t)0 * T + row) * 8 + hg], l1 = LSE[((size_t)1 * T + row) * 8 + hg], l2 = LSE[((size_t)2 * T + row) * 8 + hg];
        const float mx = fmaxf(l0, fmaxf(l1, l2)), e0 = __expf(l0 - mx), e1 = __expf(l1 - mx), e2 = __expf(l2 - mx), inv = __builtin_amdgcn_rcpf(e0 + e1 + e2);
        const float w[3] = {e0 * inv, e1 * inv, e2 * inv};
        float a[8] = {0.f, 0.f, 0.f, 0.f, 0.f, 0.f, 0.f, 0.f};
#pragma unroll
        for (int g = 0; g < 3; ++g) { const u32x4 v = *(const u32x4*)(OUTG + ((size_t)g * T + row) * 512 + c8);
            a[0] += w[g] * bflo(v.x); a[1] += w[g] * bfhi(v.x); a[2] += w[g] * bflo(v.y); a[3] += w[g] * bfhi(v.y);
            a[4] += w[g] * bflo(v.z); a[5] += w[g] * bfhi(v.z); a[6] += w[g] * bflo(v.w); a[7] += w[g] * bfhi(v.w); }
        u32x4 o; o.x = pk2(a[0], a[1]); o.y = pk2(a[2], a[3]); o.z = pk2(a[4], a[5]); o.w = pk2(a[6], a[7]);
        *(u32x4*)(AT + (size_t)row * 512 + c8) = o;
    }
}

__device__ __forceinline__ void p_conv(Frame& F) {
    const bf16* X = (const bf16*)(F.ws + WS_XBC); bf16* O = (bf16*)(F.ws + WS_CONV);
    const int total = T * (CONVD / 8);
    for (int idx = F.blk * NTHREADS + ((int)threadIdx.x); idx < total; idx += F.nblk * NTHREADS) {
        const int row = idx / (CONVD / 8), c0 = (idx % (CONVD / 8)) * 8, t = row & (SEQ - 1);
        float a[8];
#pragma unroll
        for (int i = 0; i < 8; ++i) a[i] = F.conv_b[c0 + i];
#pragma unroll
        for (int w = 0; w < 4; ++w) {
            const int tt = t + w - 3; if (tt < 0) continue;
            const u32x4 u = *(const u32x4*)(X + (size_t)(row + w - 3) * CONVD + c0);
            const float* cw = F.conv_w + (size_t)w * CONVD + c0;
            a[0] += cw[0] * bflo(u.x); a[1] += cw[1] * bfhi(u.x); a[2] += cw[2] * bflo(u.y); a[3] += cw[3] * bfhi(u.y);
            a[4] += cw[4] * bflo(u.z); a[5] += cw[5] * bfhi(u.z); a[6] += cw[6] * bflo(u.w); a[7] += cw[7] * bfhi(u.w);
        }
        u32x4 o; o.x = pk2(siluf_(a[0]), siluf_(a[1])); o.y = pk2(siluf_(a[2]), siluf_(a[3])); o.z = pk2(siluf_(a[4]), siluf_(a[5])); o.w = pk2(siluf_(a[6]), siluf_(a[7]));
        *(u32x4*)(O + (size_t)row * CONVD + c0) = o;
    }
}

__device__ __forceinline__ void p_ssd_naive(Frame& F) {
    const bf16* CV = (const bf16*)(F.ws + WS_CONV); const float* DT = (const float*)(F.ws + WS_DT); const bf16* Z = (const bf16*)(F.ws + WS_Z);
    bf16* YZ = (bf16*)(F.ws + WS_YZ);
    const int t256 = ((int)threadIdx.x) & 255, p = t256 >> 2, q = t256 & 3;
    for (int unit = F.blk * 2 + (((int)threadIdx.x) >> 8); unit < BATCH * NH_SSM; unit += F.nblk * 2) {
        const int b = unit / NH_SSM, h = unit % NH_SSM, g = h / 8;
        const float a = -__expf(F.a_log[h]), dsk = F.d_skip[h];
        float st[32];
#pragma unroll
        for (int i = 0; i < 32; ++i) st[i] = 0.f;
        for (int t = 0; t < SEQ; ++t) {
            const size_t row = (size_t)b * SEQ + t;
            const float dt = DT[(size_t)h * T + row];
            const float dA = __expf(dt * a);
            const float xv = bf2f(CV[row * CONVD + h * 64 + p]);
            const float dtx = dt * xv;
            const u32x4* bp = (const u32x4*)(CV + row * CONVD + 2048 + g * 128 + q * 32);
            const u32x4* cp = (const u32x4*)(CV + row * CONVD + 2560 + g * 128 + q * 32);
            float yp = 0.f;
#pragma unroll
            for (int c = 0; c < 4; ++c) {
                const u32x4 bw = bp[c], cw = cp[c];
                const float bv[8] = {bflo(bw.x), bfhi(bw.x), bflo(bw.y), bfhi(bw.y), bflo(bw.z), bfhi(bw.z), bflo(bw.w), bfhi(bw.w)};
                const float cv[8] = {bflo(cw.x), bfhi(cw.x), bflo(cw.y), bfhi(cw.y), bflo(cw.z), bfhi(cw.z), bflo(cw.w), bfhi(cw.w)};
#pragma unroll
                for (int i = 0; i < 8; ++i) { st[8 * c + i] = st[8 * c + i] * dA + dtx * bv[i]; yp += cv[i] * st[8 * c + i]; }
            }
            yp += __shfl_xor(yp, 1); yp += __shfl_xor(yp, 2);
            if (q == 0) {
                const float y = yp + dsk * xv;
                const float z = bf2f(Z[row * DI + h * 64 + p]);
                YZ[row * DI + h * 64 + p] = (bf16)f2bf(y * siluf_(z));
            }
        }
    }
}

__device__ __forceinline__ int swz256(int row, int chunk) { return row * 272 + (chunk << 4); }
__device__ __forceinline__ int swz128(int row, int chunk) { return row * 144 + (chunk << 4); }
__device__ __forceinline__ void p_ssd_fast(Frame& F) {
    const int lane = ((int)(threadIdx.x & 63u)), r = lane & 31, hh = lane >> 5, lb = F.wave & 3, pb = F.wave >> 2, tid = ((int)threadIdx.x);
    LAS unsigned char* Bimg = F.lds; LAS unsigned char* Cimg = F.lds + 34816; LAS unsigned char* Ximg = F.lds + 69632; LAS unsigned char* Xwimg = F.lds + 88064;
    LAS unsigned char* Simg = F.lds + 106496; LAS float* acs = (LAS float*)(F.lds + 123904); LAS float* dtv = (LAS float*)(F.lds + 124416);
    const bf16* CV = (const bf16*)(F.ws + WS_CONV); const float* DT = (const float*)(F.ws + WS_DT); bf16* Y = (bf16*)(F.ws + WS_YZ);
    const int q4 = (lane & 15) >> 2, blk16 = (lane >> 4) & 1, p4 = lane & 3;
    const f32x16 zero16 = {0.f, 0.f, 0.f, 0.f, 0.f, 0.f, 0.f, 0.f, 0.f, 0.f, 0.f, 0.f, 0.f, 0.f, 0.f, 0.f};
    for (int unit = F.blk; unit < BATCH * NH_SSM; unit += F.nblk) {
        const int b = unit / NH_SSM, h = unit % NH_SSM, g = h >> 3;
        const float a = -__expf(F.a_log[h]);
        f32x16 st = zero16;
        u32x4 rb[4], rc[4], rx[2]; float d0, d1;
#define SSD_LOAD(c) do { const size_t row0_ = (size_t)b * SEQ + (size_t)(c) * 128; \
            _Pragma("unroll") for (int i = 0; i < 4; ++i) { const int piece = tid + 512 * i, row = piece >> 4, ch = piece & 15; \
                rb[i] = *(const u32x4*)(CV + (row0_ + row) * CONVD + 2048 + g * 128 + ch * 8); rc[i] = *(const u32x4*)(CV + (row0_ + row) * CONVD + 2560 + g * 128 + ch * 8); } \
            _Pragma("unroll") for (int i = 0; i < 2; ++i) { const int piece = tid + 512 * i, row = piece >> 3, ch = piece & 7; rx[i] = *(const u32x4*)(CV + (row0_ + row) * CONVD + h * 64 + ch * 8); } \
            d0 = DT[(size_t)h * T + row0_ + lane]; d1 = DT[(size_t)h * T + row0_ + 64 + lane]; } while (0)
        SSD_LOAD(0);
        for (int c = 0; c < 16; ++c) {
            const size_t row0 = (size_t)b * SEQ + (size_t)c * 128;
            float x0 = d0 * a, x1 = d1 * a;
#pragma unroll
            for (int o = 1; o < 64; o <<= 1) { const float t0 = __shfl_up(x0, o), t1 = __shfl_up(x1, o); if (lane >= o) { x0 += t0; x1 += t1; } }
            x1 += __shfl(x0, 63);
            const float total = __shfl(x1, 63);
            __syncthreads();
            acs[lane] = x0; acs[64 + lane] = x1; dtv[lane] = d0; dtv[64 + lane] = d1;
#pragma unroll
            for (int i = 0; i < 4; ++i) { const int piece = tid + 512 * i, row = piece >> 4, ch = piece & 15;
                *(LAS u32x4*)(Bimg + swz256(row, ch)) = rb[i]; *(LAS u32x4*)(Cimg + swz256(row, ch)) = rc[i]; }
#pragma unroll
            for (int i = 0; i < 2; ++i) { const int piece = tid + 512 * i, row = piece >> 3, ch = piece & 7;
                const float w = __expf(total - acs[row]) * dtv[row];
                const u32x4 v = rx[i]; u32x4 o;
                o.x = pk2(bflo(v.x) * w, bfhi(v.x) * w); o.y = pk2(bflo(v.y) * w, bfhi(v.y) * w); o.z = pk2(bflo(v.z) * w, bfhi(v.z) * w); o.w = pk2(bflo(v.w) * w, bfhi(v.w) * w);
                *(LAS u32x4*)(Ximg + swz128(row, ch)) = v; *(LAS u32x4*)(Xwimg + swz128(row, ch)) = o; }
#pragma unroll
            for (int g4 = 0; g4 < 4; ++g4) { u32x2 w2; w2.x = pk2(st[4 * g4], st[4 * g4 + 1]); w2.y = pk2(st[4 * g4 + 2], st[4 * g4 + 3]);
                *(LAS u32x2*)(Simg + swz256(32 * pb + r, 4 * lb + g4) + 8 * hh) = w2; }
            __syncthreads();
            bf16x8_t cf[8];
#pragma unroll
            for (int kk = 0; kk < 8; ++kk) cf[kk] = *(const LAS bf16x8_t*)(Cimg + swz256(32 * lb + r, 2 * kk + hh));
            const float acs_l = acs[32 * lb + r];
            f32x16 yd = zero16;
            for (int sb = 0; sb <= lb; ++sb) {
                f32x16 gt = zero16;
#pragma unroll
                for (int kk = 0; kk < 8; ++kk) { const bf16x8_t bfm = *(const LAS bf16x8_t*)(Bimg + swz256(32 * sb + r, 2 * kk + hh)); gt = __builtin_amdgcn_mfma_f32_32x32x16_bf16(bfm, cf[kk], gt, 0, 0, 0); }
#pragma unroll
                for (int i = 0; i < 16; ++i) { const int s = 32 * sb + crow_(i, hh), l = 32 * lb + r;
                    const float e = __expf(fminf(acs_l - acs[s], 0.f)) * dtv[s];
                    gt[i] = (s <= l) ? gt[i] * e : 0.f; }
#pragma unroll
                for (int q = 0; q < 2; ++q) {
                    u32x4 pw; pw.x = pk2(gt[8 * q], gt[8 * q + 1]); pw.y = pk2(gt[8 * q + 2], gt[8 * q + 3]); pw.z = pk2(gt[8 * q + 4], gt[8 * q + 5]); pw.w = pk2(gt[8 * q + 6], gt[8 * q + 7]);
                    const bf16x8_t pa = __builtin_bit_cast(bf16x8_t, pw);
                    const int row_lo = 32 * sb + 16 * q + 4 * hh + q4, row_hi = row_lo + 8, chunk = 4 * pb + 2 * blk16 + (p4 >> 1), sub = (p4 & 1) * 8;
                    const s16x4_t lo = tr_read_(Ximg + swz128(row_lo, chunk) + sub), hi = tr_read_(Ximg + swz128(row_hi, chunk) + sub);
                    const bf16x8_t xf = (bf16x8_t){lo[0], lo[1], lo[2], lo[3], hi[0], hi[1], hi[2], hi[3]};
                    yd = __builtin_amdgcn_mfma_f32_32x32x16_bf16(pa, xf, yd, 0, 0, 0);
                }
            }
            f32x16 yo = zero16;
#pragma unroll
            for (int kk = 0; kk < 8; ++kk) { const bf16x8_t sf = *(const LAS bf16x8_t*)(Simg + swz256(32 * pb + r, 2 * kk + hh)); yo = __builtin_amdgcn_mfma_f32_32x32x16_bf16(cf[kk], sf, yo, 0, 0, 0); }
#pragma unroll
            for (int i = 0; i < 16; ++i) { const int l = 32 * lb + crow_(i, hh);
                const float y = yd[i] + __expf(acs[l]) * yo[i];
                Y[(row0 + l) * DI + h * 64 + 32 * pb + r] = (bf16)f2bf(y); }
            if (c + 1 < 16) SSD_LOAD(c + 1);
            const float cd = __expf(total);
#pragma unroll
            for (int i = 0; i < 16; ++i) st[i] *= cd;
#pragma unroll
            for (int kk = 0; kk < 8; ++kk) {
                const int row_lo = 16 * kk + 4 * hh + q4, row_hi = row_lo + 8, sub = (p4 & 1) * 8;
                const int chb = 4 * lb + 2 * blk16 + (p4 >> 1), chx = 4 * pb + 2 * blk16 + (p4 >> 1);
                const s16x4_t blo = tr_read_(Bimg + swz256(row_lo, chb) + sub), bhi = tr_read_(Bimg + swz256(row_hi, chb) + sub);
                const s16x4_t xlo = tr_read_(Xwimg + swz128(row_lo, chx) + sub), xhi = tr_read_(Xwimg + swz128(row_hi, chx) + sub);
                const bf16x8_t af = (bf16x8_t){blo[0], blo[1], blo[2], blo[3], bhi[0], bhi[1], bhi[2], bhi[3]};
                const bf16x8_t xf = (bf16x8_t){xlo[0], xlo[1], xlo[2], xlo[3], xhi[0], xhi[1], xhi[2], xhi[3]};
                st = __builtin_amdgcn_mfma_f32_32x32x16_bf16(af, xf, st, 0, 0, 0);
            }
        }
#undef SSD_LOAD
    }
    __syncthreads();
}
__device__ __forceinline__ void p_ssd_fast2(Frame& F) {
    const int lane = ((int)(threadIdx.x & 63u)), r = lane & 31, hh = lane >> 5, pb = F.wave >> 2, nb = F.wave & 3, lb = pb ? 3 - nb : nb, tid = ((int)threadIdx.x);
#define SSD2_PTRS() unsigned opq_ = 0; asm volatile("" : "+s"(opq_)); \
    LAS unsigned char* const Bimg = F.lds + opq_; LAS unsigned char* const Cimg = Bimg + 34816; LAS unsigned char* const Ximg0 = Bimg + 69632; LAS unsigned char* const Simg0 = Bimg + 106496; \
    LAS float* const tab0 = (LAS float*)(Bimg + 141312); \
    const bf16* const CV = (const bf16*)(F.ws + WS_CONV + opq_); const float* const DT = (const float*)(F.ws + WS_DT + opq_); bf16* const Y = (bf16*)(F.ws + WS_YZ + opq_); \
    int tidl_ = ((int)threadIdx.x); asm volatile("" : "+v"(tidl_)); const int tid = tidl_, lane = tid & 63, r = lane & 31, hh = lane >> 5, q4 = (lane & 15) >> 2, blk16 = (lane >> 4) & 1, p4 = lane & 3; \
    (void)tid; (void)r; (void)hh; (void)q4; (void)blk16; (void)p4
    const int q4 = (lane & 15) >> 2, blk16 = (lane >> 4) & 1, p4 = lane & 3;
    const f32x16 zero16 = {0.f, 0.f, 0.f, 0.f, 0.f, 0.f, 0.f, 0.f, 0.f, 0.f, 0.f, 0.f, 0.f, 0.f, 0.f, 0.f};
    for (int unit = F.blk; unit < BATCH * NG_SSM * 4; unit += F.nblk) {
        const int b = unit >> 4, g = (unit >> 2) & 3, h0 = 8 * g + 2 * (unit & 3);
        const float a0 = -__expf(F.a_log[h0]), a1 = -__expf(F.a_log[h0 + 1]), dsk0 = F.d_skip[h0], dsk1 = F.d_skip[h0 + 1];
        f32x16 st[2]; st[0] = zero16; st[1] = zero16;
        u32x4 rb[4], rc[4], rx[2][2]; float d[2][2];
#define SSD2_LOAD(c) do { const size_t row0_ = (size_t)b * SEQ + (size_t)(c) * 128; \
            _Pragma("unroll") for (int i = 0; i < 4; ++i) { const int piece = tid + 512 * i, row = piece >> 4, ch = piece & 15; \
                rb[i] = *(const u32x4*)(CV + (row0_ + row) * CONVD + 2048 + g * 128 + ch * 8); rc[i] = *(const u32x4*)(CV + (row0_ + row) * CONVD + 2560 + g * 128 + ch * 8); } \
            _Pragma("unroll") for (int e = 0; e < 2; ++e) { \
                _Pragma("unroll") for (int i = 0; i < 2; ++i) { const int piece = tid + 512 * i, row = piece >> 3, ch = piece & 7; rx[e][i] = *(const u32x4*)(CV + (row0_ + row) * CONVD + (h0 + e) * 64 + ch * 8); } \
                d[e][0] = DT[(size_t)(h0 + e) * T + row0_ + lane]; d[e][1] = DT[(size_t)(h0 + e) * T + row0_ + 64 + lane]; } } while (0)
        { SSD2_PTRS(); SSD2_LOAD(0); }
        for (int c = 0; c < 16; ++c) {
            const size_t row0 = (size_t)b * SEQ + (size_t)c * 128;
            float x0[2], x1[2], total[2];
#pragma unroll
            for (int e = 0; e < 2; ++e) { const float a = e ? a1 : a0; x0[e] = d[e][0] * a; x1[e] = d[e][1] * a; }
#pragma unroll
            for (int o = 1; o < 64; o <<= 1) {
#pragma unroll
                for (int e = 0; e < 2; ++e) { const float t0 = __shfl_up(x0[e], o), t1 = __shfl_up(x1[e], o); if (lane >= o) { x0[e] += t0; x1[e] += t1; } } }
#pragma unroll
            for (int e = 0; e < 2; ++e) { x1[e] += __shfl(x0[e], 63); total[e] = __shfl(x1[e], 63); }
            LDS_BARRIER();
            for (int repw_ = 0; repw_ < SSD_REP_W; ++repw_) { SSD2_PTRS();
#pragma unroll
            for (int e = 0; e < 2; ++e) { LAS float* const tb = tab0 + 704 * e;
                tb[lane] = x0[e]; tb[64 + lane] = x1[e]; tb[128 + lane] = d[e][0]; tb[192 + lane] = d[e][1];
                tb[256 + lane] = __expf(total[e] - x0[e]) * d[e][0]; tb[320 + lane] = __expf(total[e] - x1[e]) * d[e][1];
                tb[384 + lane] = __expf(x0[e]); tb[448 + lane] = __expf(x1[e]);
                const float a32 = __shfl(x0[e], 32), a64 = __shfl(x1[e], 0), a96 = __shfl(x1[e], 32);
                if (lane < 32) { tb[512 + lane] = __expf(a32 - x0[e]) * d[e][0]; tb[512 + 96 + 64 + lane] = __expf(a96 - x1[e]) * d[e][1]; }
                tb[512 + 32 + lane] = __expf(a64 - x0[e]) * d[e][0]; tb[512 + 96 + lane] = __expf(a96 - x0[e]) * d[e][0]; }
#pragma unroll
            for (int i = 0; i < 4; ++i) { const int piece = tid + 512 * i, row = piece >> 4, ch = piece & 15;
                *(LAS u32x4*)(Bimg + swz256(row, ch)) = rb[i]; *(LAS u32x4*)(Cimg + swz256(row, ch)) = rc[i]; }
#pragma unroll
            for (int e = 0; e < 2; ++e) {
#pragma unroll
                for (int i = 0; i < 2; ++i) { const int piece = tid + 512 * i, row = piece >> 3, ch = piece & 7; *(LAS u32x4*)(Ximg0 + 18432 * e + swz128(row, ch)) = rx[e][i]; }
#pragma unroll
                for (int g4 = 0; g4 < 4; ++g4) { u32x2 w2; w2.x = cvtpk(st[e][4 * g4], st[e][4 * g4 + 1]); w2.y = cvtpk(st[e][4 * g4 + 2], st[e][4 * g4 + 3]);
                    *(LAS u32x2*)(Simg0 + 17408 * e + swz256(32 * pb + r, 4 * nb + g4) + 8 * hh) = w2; }
            }
            }
            LDS_BARRIER();
            { SSD2_PTRS(); if (c + 1 < 16) SSD2_LOAD(c + 1); }
            for (int repa_ = 0; repa_ < SSD_REP_A; ++repa_) { SSD2_PTRS();
            bf16x8_t cf[8];
#pragma unroll
            for (int kk = 0; kk < 8; ++kk) cf[kk] = *(const LAS bf16x8_t*)(Cimg + swz256(32 * lb + r, 2 * kk + hh));
            const float acs_l0 = tab0[32 * lb + r], acs_l1 = tab0[704 + 32 * lb + r];
            const float e1_0 = __expf(acs_l0 - tab0[32 * lb]), e1_1 = __expf(acs_l1 - tab0[704 + 32 * lb]);
            const int e2off = lb == 1 ? 0 : (lb == 2 ? 32 : 96);
            f32x16 yd[2]; yd[0] = zero16; yd[1] = zero16;
            for (int sb = 0; sb <= lb; ++sb) {
                f32x16 gt = zero16;
#pragma unroll
                for (int kk = 0; kk < 8; ++kk) { const bf16x8_t bfm = *(const LAS bf16x8_t*)(Bimg + swz256(32 * sb + r, 2 * kk + hh)); gt = __builtin_amdgcn_mfma_f32_32x32x16_bf16(bfm, cf[kk], gt, 0, 0, 0); }
#pragma unroll
                for (int e = 0; e < 2; ++e) {
                    const LAS float* const tb = tab0 + 704 * e;
                    float gv[16];
                    if (sb < lb) {
                        const float e1 = e ? e1_1 : e1_0;
#pragma unroll
                        for (int g4 = 0; g4 < 4; ++g4) { const f32x4 t = *(const LAS f32x4*)(tb + 512 + e2off + 32 * sb + 8 * g4 + 4 * hh);
                            gv[4 * g4] = gt[4 * g4] * (t.x * e1); gv[4 * g4 + 1] = gt[4 * g4 + 1] * (t.y * e1); gv[4 * g4 + 2] = gt[4 * g4 + 2] * (t.z * e1); gv[4 * g4 + 3] = gt[4 * g4 + 3] * (t.w * e1); }
                    } else {
                        const float acs_l = e ? acs_l1 : acs_l0;
#pragma unroll
                        for (int g4 = 0; g4 < 4; ++g4) { const f32x4 ta = *(const LAS f32x4*)(tb + 32 * sb + 8 * g4 + 4 * hh), td = *(const LAS f32x4*)(tb + 128 + 32 * sb + 8 * g4 + 4 * hh);
                            const float av[4] = {ta.x, ta.y, ta.z, ta.w}, dv[4] = {td.x, td.y, td.z, td.w};
#pragma unroll
                            for (int j = 0; j < 4; ++j) { const int sl = 8 * g4 + 4 * hh + j;
                                gv[4 * g4 + j] = (sl <= r) ? gt[4 * g4 + j] * (__expf(fminf(acs_l - av[j], 0.f)) * dv[j]) : 0.f; } }
                    }
#pragma unroll
                    for (int q = 0; q < 2; ++q) {
                        u32x4 pw; pw.x = cvtpk(gv[8 * q], gv[8 * q + 1]); pw.y = cvtpk(gv[8 * q + 2], gv[8 * q + 3]); pw.z = cvtpk(gv[8 * q + 4], gv[8 * q + 5]); pw.w = cvtpk(gv[8 * q + 6], gv[8 * q + 7]);
                        const bf16x8_t pa = __builtin_bit_cast(bf16x8_t, pw);
                        const int row_lo = 32 * sb + 16 * q + 4 * hh + q4, row_hi = row_lo + 8, chunk = 4 * pb + 2 * blk16 + (p4 >> 1), sub = (p4 & 1) * 8;
                        const s16x4_t lo = tr_read_(Ximg0 + 18432 * e + swz128(row_lo, chunk) + sub), hi = tr_read_(Ximg0 + 18432 * e + swz128(row_hi, chunk) + sub);
                        const bf16x8_t xf = (bf16x8_t){lo[0], lo[1], lo[2], lo[3], hi[0], hi[1], hi[2], hi[3]};
                        yd[e] = __builtin_amdgcn_mfma_f32_32x32x16_bf16(pa, xf, yd[e], 0, 0, 0);
                    }
                }
            }
#pragma unroll
            for (int e = 0; e < 2; ++e) {
                f32x16 yo = zero16;
#pragma unroll
                for (int kk = 0; kk < 8; ++kk) { const bf16x8_t sf = *(const LAS bf16x8_t*)(Simg0 + 17408 * e + swz256(32 * pb + r, 2 * kk + hh)); yo = __builtin_amdgcn_mfma_f32_32x32x16_bf16(cf[kk], sf, yo, 0, 0, 0); }
#pragma unroll
                for (int g4 = 0; g4 < 4; ++g4) { const f32x4 ea = *(const LAS f32x4*)(tab0 + 704 * e + 384 + 32 * lb + 8 * g4 + 4 * hh); const float eav[4] = {ea.x, ea.y, ea.z, ea.w};
                    const s16x4_t xs4 = tr_read_(Ximg0 + 18432 * e + swz128(32 * lb + 8 * g4 + 4 * hh + q4, 4 * pb + 2 * blk16 + (p4 >> 1)) + (p4 & 1) * 8);
#pragma unroll
                    for (int j = 0; j < 4; ++j) { const int i = 4 * g4 + j, l = 32 * lb + 8 * g4 + 4 * hh + j;
                        const float y = yd[e][i] + eav[j] * yo[i] + (e ? dsk1 : dsk0) * bf2f((bf16)xs4[j]);
                        Y[(row0 + l) * DI + (h0 + e) * 64 + 32 * pb + r] = (bf16)(cvtpk(y, y) & 0xffffu); } }
            }
            }
            { SSD2_PTRS();
            { const float cd0 = __expf(total[0]), cd1 = __expf(total[1]);
#pragma unroll
              for (int i = 0; i < 16; ++i) { st[0][i] *= cd0; st[1][i] *= cd1; } }
#pragma unroll
            for (int kk = 0; kk < 8; ++kk) {
                const int row_lo = 16 * kk + 4 * hh + q4, row_hi = row_lo + 8, sub = (p4 & 1) * 8;
                const int chb = 4 * nb + 2 * blk16 + (p4 >> 1), chx = 4 * pb + 2 * blk16 + (p4 >> 1);
                const s16x4_t blo = tr_read_(Bimg + swz256(row_lo, chb) + sub), bhi = tr_read_(Bimg + swz256(row_hi, chb) + sub);
                const bf16x8_t af = (bf16x8_t){blo[0], blo[1], blo[2], blo[3], bhi[0], bhi[1], bhi[2], bhi[3]};
#pragma unroll
                for (int e = 0; e < 2; ++e) {
                    const s16x4_t xlo = tr_read_(Ximg0 + 18432 * e + swz128(row_lo, chx) + sub), xhi = tr_read_(Ximg0 + 18432 * e + swz128(row_hi, chx) + sub);
                    const f32x4 wl = *(const LAS f32x4*)(tab0 + 704 * e + 256 + 16 * kk + 4 * hh), wh = *(const LAS f32x4*)(tab0 + 704 * e + 256 + 16 * kk + 8 + 4 * hh);
                    u32x4 pw;
                    pw.x = cvtpk(bf2f((bf16)xlo[0]) * wl.x, bf2f((bf16)xlo[1]) * wl.y); pw.y = cvtpk(bf2f((bf16)xlo[2]) * wl.z, bf2f((bf16)xlo[3]) * wl.w);
                    pw.z = cvtpk(bf2f((bf16)xhi[0]) * wh.x, bf2f((bf16)xhi[1]) * wh.y); pw.w = cvtpk(bf2f((bf16)xhi[2]) * wh.z, bf2f((bf16)xhi[3]) * wh.w);
                    st[e] = __builtin_amdgcn_mfma_f32_32x32x16_bf16(af, __builtin_bit_cast(bf16x8_t, pw), st[e], 0, 0, 0);
                }
            }
            }
        }
#undef SSD2_LOAD
#undef SSD2_PTRS
    }
    __syncthreads();
}

__device__ __forceinline__ void p_ypost2(Frame& F) {
    const int gw = F.blk * NWAVES + F.wave, NGW = F.nblk * NWAVES;
    const bf16* Y = (const bf16*)(F.ws + WS_YZ); const bf16* CV = (const bf16*)(F.ws + WS_CONV); const bf16* Z = (const bf16*)(F.ws + WS_Z); bf16* YN = (bf16*)(F.ws + WS_YN);
    for (int m = gw; m < T; m += NGW) {
#pragma unroll
        for (int g = 0; g < 4; ++g) {
            const int c0 = g * 512 + ((int)(threadIdx.x & 63u)) * 8;
            const u32x4 yw = __builtin_nontemporal_load((const u32x4*)(Y + (size_t)m * DI + c0)), zw = __builtin_nontemporal_load((const u32x4*)(Z + (size_t)m * DI + c0));
            const float yv[8] = {bflo(yw.x), bfhi(yw.x), bflo(yw.y), bfhi(yw.y), bflo(yw.z), bfhi(yw.z), bflo(yw.w), bfhi(yw.w)};
            const float zv[8] = {bflo(zw.x), bfhi(zw.x), bflo(zw.y), bfhi(zw.y), bflo(zw.z), bfhi(zw.z), bflo(zw.w), bfhi(zw.w)};
            float v[8]; float s = 0.f;
#pragma unroll
            for (int i = 0; i < 8; ++i) { v[i] = yv[i] * siluf_(zv[i]); s += v[i] * v[i]; }
            const float rstd = __builtin_amdgcn_rsqf(wave_sum(s) * (1.f / 512.f) + EPS);
            const float* nw = F.ssm_norm_w + c0;
            u32x4 o; o.x = pk2(v[0] * rstd * nw[0], v[1] * rstd * nw[1]); o.y = pk2(v[2] * rstd * nw[2], v[3] * rstd * nw[3]);
            o.z = pk2(v[4] * rstd * nw[4], v[5] * rstd * nw[5]); o.w = pk2(v[6] * rstd * nw[6], v[7] * rstd * nw[7]);
            *(u32x4*)(YN + (size_t)m * DI + c0) = o;
        }
    }
}

__device__ __forceinline__ void p_ypost(Frame& F) {
    const int gw = F.blk * NWAVES + F.wave, NGW = F.nblk * NWAVES;
    const bf16* YZ = (const bf16*)(F.ws + WS_YZ); bf16* YN = (bf16*)(F.ws + WS_YN);
    for (int m = gw; m < T; m += NGW) {
#pragma unroll
        for (int g = 0; g < 4; ++g) {
            const int c0 = g * 512 + ((int)(threadIdx.x & 63u)) * 8;
            const u32x4 w = *(const u32x4*)(YZ + (size_t)m * DI + c0);
            float v[8] = {bflo(w.x), bfhi(w.x), bflo(w.y), bfhi(w.y), bflo(w.z), bfhi(w.z), bflo(w.w), bfhi(w.w)};
            float s = 0.f;
#pragma unroll
            for (int i = 0; i < 8; ++i) s += v[i] * v[i];
            const float rstd = __builtin_amdgcn_rsqf(wave_sum(s) * (1.f / 512.f) + EPS);
            const float* nw = F.ssm_norm_w + c0;
            u32x4 o; o.x = pk2(v[0] * rstd * nw[0], v[1] * rstd * nw[1]); o.y = pk2(v[2] * rstd * nw[2], v[3] * rstd * nw[3]);
            o.z = pk2(v[4] * rstd * nw[4], v[5] * rstd * nw[5]); o.w = pk2(v[6] * rstd * nw[6], v[7] * rstd * nw[7]);
            *(u32x4*)(YN + (size_t)m * DI + c0) = o;
        }
    }
}

__device__ __forceinline__ void p_router(Frame& F) {
    LAS int* hist = (LAS int*)F.lds;
    if (((int)threadIdx.x) < 32) hist[((int)threadIdx.x)] = 0;
    __syncthreads();
    int* ROWMAP = (int*)(F.ws + WS_ROWMAP);
    for (int i = F.blk * NTHREADS + ((int)threadIdx.x); i < CAP; i += F.nblk * NTHREADS) ROWMAP[i] = -1;
    const int gw = F.blk * NWAVES + F.wave, NGW = F.nblk * NWAVES;
    bf16* XN2 = (bf16*)(F.ws + WS_XN2); int* TOPI = (int*)(F.ws + WS_TOPI); float* TOPW = (float*)(F.ws + WS_TOPW);
    for (int m = gw; m < T; m += NGW) {
        const f32x4* xr = (const f32x4*)(F.out + (size_t)m * D) + ((int)(threadIdx.x & 63u));
        const f32x4* wr = (const f32x4*)F.norm_ffn + ((int)(threadIdx.x & 63u));
        f32x4 v[4]; float s = 0.f;
#pragma unroll
        for (int j = 0; j < 4; ++j) { v[j] = xr[64 * j]; s += (v[j].x * v[j].x + v[j].y * v[j].y) + (v[j].z * v[j].z + v[j].w * v[j].w); }
        const float rstd = __builtin_amdgcn_rsqf(wave_sum(s) * (1.f / D) + EPS);
        float lg[32];
#pragma unroll
        for (int e = 0; e < 32; ++e) lg[e] = 0.f;
#pragma unroll
        for (int j = 0; j < 4; ++j) {
            v[j] = v[j] * rstd * wr[64 * j];
            st_bf4(XN2 + (size_t)m * D + (((int)(threadIdx.x & 63u)) + 64 * j) * 4, v[j]);
            const float hv[4] = {v[j].x, v[j].y, v[j].z, v[j].w};
#pragma unroll
            for (int i = 0; i < 4; ++i) {
                const f32x4* rw = (const f32x4*)(F.router_w + (size_t)((((int)(threadIdx.x & 63u)) + 64 * j) * 4 + i) * 32);
#pragma unroll
                for (int c = 0; c < 8; ++c) { const f32x4 w = rw[c]; lg[4 * c] += hv[i] * w.x; lg[4 * c + 1] += hv[i] * w.y; lg[4 * c + 2] += hv[i] * w.z; lg[4 * c + 3] += hv[i] * w.w; }
            }
        }
#pragma unroll
        for (int e = 0; e < 32; ++e) lg[e] = wave_sum(lg[e]) + F.router_b[e];
        int bi[4]; float bv[4];
#pragma unroll
        for (int k = 0; k < 4; ++k) {
            float best = -INFINITY; int be = 0;
#pragma unroll
            for (int e = 0; e < 32; ++e) if (lg[e] > best) { best = lg[e]; be = e; }
            bi[k] = be; bv[k] = best;
#pragma unroll
            for (int e = 0; e < 32; ++e) if (e == be) lg[e] = -INFINITY;
        }
        const float e0 = 1.f, e1 = __expf(bv[1] - bv[0]), e2 = __expf(bv[2] - bv[0]), e3 = __expf(bv[3] - bv[0]);
        const float inv = 1.f / (e0 + e1 + e2 + e3);
        if (((int)(threadIdx.x & 63u)) == 0) {
            *(int4*)(TOPI + (size_t)m * 4) = make_int4(bi[0], bi[1], bi[2], bi[3]);
            *(f32x4*)(TOPW + (size_t)m * 4) = (f32x4){e0 * inv, e1 * inv, e2 * inv, e3 * inv};
            atomicAdd((int*)&hist[bi[0]], 1); atomicAdd((int*)&hist[bi[1]], 1); atomicAdd((int*)&hist[bi[2]], 1); atomicAdd((int*)&hist[bi[3]], 1);
        }
    }
    __syncthreads();
    if (((int)threadIdx.x) < 32) atomicAdd((unsigned*)(F.ctl + CW_CNT + 64 * ((int)threadIdx.x)), (unsigned)hist[((int)threadIdx.x)]);
    __syncthreads();
}

__device__ __forceinline__ void p_conv2(Frame& F) {
    const bf16* X = (const bf16*)(F.ws + WS_XBC); bf16* O = (bf16*)(F.ws + WS_CONV);
    constexpr int NCG = CONVD / 8, total = (T / 8) * NCG;
    for (int idx = F.blk * NTHREADS + ((int)threadIdx.x); idx < total; idx += F.nblk * NTHREADS) {
        const int cg = idx % NCG, tb = idx / NCG, c0 = cg * 8, row0 = tb * 8, t0 = row0 & (SEQ - 1);
        float cw[4][8], cb[8];
#pragma unroll
        for (int w = 0; w < 4; ++w) { const f32x4 a = *(const f32x4*)(F.conv_w + (size_t)w * CONVD + c0), b = *(const f32x4*)(F.conv_w + (size_t)w * CONVD + c0 + 4);
            cw[w][0] = a.x; cw[w][1] = a.y; cw[w][2] = a.z; cw[w][3] = a.w; cw[w][4] = b.x; cw[w][5] = b.y; cw[w][6] = b.z; cw[w][7] = b.w; }
        { const f32x4 a = *(const f32x4*)(F.conv_b + c0), b = *(const f32x4*)(F.conv_b + c0 + 4); cb[0] = a.x; cb[1] = a.y; cb[2] = a.z; cb[3] = a.w; cb[4] = b.x; cb[5] = b.y; cb[6] = b.z; cb[7] = b.w; }
        u32x4 raw[11];
#pragma unroll
        for (int i = 0; i < 11; ++i) { raw[i] = (u32x4){0u, 0u, 0u, 0u}; if (t0 + i - 3 >= 0) raw[i] = *(const u32x4*)(X + (size_t)(row0 + i - 3) * CONVD + c0); }
        float acc[8][8];
#pragma unroll
        for (int tt = 0; tt < 8; ++tt)
#pragma unroll
            for (int c = 0; c < 8; ++c) acc[tt][c] = cb[c];
#pragma unroll
        for (int i = 0; i < 11; ++i) {
            const float xv[8] = {bflo(raw[i].x), bfhi(raw[i].x), bflo(raw[i].y), bfhi(raw[i].y), bflo(raw[i].z), bfhi(raw[i].z), bflo(raw[i].w), bfhi(raw[i].w)};
#pragma unroll
            for (int w = 0; w < 4; ++w) { const int tt = i - w;
                if (tt >= 0 && tt < 8) {
#pragma unroll
                    for (int c = 0; c < 8; ++c) acc[tt][c] += cw[w][c] * xv[c]; } }
        }
#pragma unroll
        for (int tt = 0; tt < 8; ++tt) { u32x4 o; o.x = pk2(siluf_(acc[tt][0]), siluf_(acc[tt][1])); o.y = pk2(siluf_(acc[tt][2]), siluf_(acc[tt][3]));
            o.z = pk2(siluf_(acc[tt][4]), siluf_(acc[tt][5])); o.w = pk2(siluf_(acc[tt][6]), siluf_(acc[tt][7]));
            *(u32x4*)(O + (size_t)(row0 + tt) * CONVD + c0) = o; }
    }
}

__device__ __forceinline__ void p_router2(Frame& F) {
    LAS float* WrT = (LAS float*)F.lds;
    LAS int* hist = (LAS int*)(F.lds + 131072);
    if (((int)threadIdx.x) < 32) hist[((int)threadIdx.x)] = 0;
    for (int i = ((int)threadIdx.x); i < 1024 * 8; i += NTHREADS) { const int k = i >> 3, e4 = (i & 7) * 4; const f32x4 w = *(const f32x4*)(F.router_w + (size_t)k * 32 + e4);
        WrT[(e4 + 0) * 1024 + k] = w.x; WrT[(e4 + 1) * 1024 + k] = w.y; WrT[(e4 + 2) * 1024 + k] = w.z; WrT[(e4 + 3) * 1024 + k] = w.w; }
    int* ROWMAP = (int*)(F.ws + WS_ROWMAP);
    for (int i = F.blk * NTHREADS + ((int)threadIdx.x); i < CAP; i += F.nblk * NTHREADS) ROWMAP[i] = -1;
    __syncthreads();
    const int lane = ((int)(threadIdx.x & 63u)), gw = F.blk * NWAVES + F.wave, NGW = F.nblk * NWAVES;
    bf16* XN2 = (bf16*)(F.ws + WS_XN2); int* TOPI = (int*)(F.ws + WS_TOPI); float* TOPW = (float*)(F.ws + WS_TOPW);
    const float rb = F.router_b[lane >> 1];
    for (int mp = gw; mp < T / 2; mp += NGW) {
        f32x4 v[2][4];
#pragma unroll
        for (int j = 0; j < 2; ++j) {
            const int m = mp * 2 + j;
            const f32x4* xr = (const f32x4*)(F.out + (size_t)m * D) + lane; const f32x4* wr = (const f32x4*)F.norm_ffn + lane;
            float s = 0.f;
#pragma unroll
            for (int q = 0; q < 4; ++q) { v[j][q] = xr[64 * q]; s += (v[j][q].x * v[j][q].x + v[j][q].y * v[j][q].y) + (v[j][q].z * v[j][q].z + v[j][q].w * v[j][q].w); }
            const float rstd = __builtin_amdgcn_rsqf(wave_sum(s) * (1.f / D) + EPS);
#pragma unroll
            for (int q = 0; q < 4; ++q) { v[j][q] = v[j][q] * rstd * wr[64 * q];
#if MOE_FP8
                *(unsigned*)((unsigned char*)XN2 + (size_t)m * D + (lane + 64 * q) * 4) = pk_fp8x4(FP8_ASCALE * v[j][q].x, FP8_ASCALE * v[j][q].y, FP8_ASCALE * v[j][q].z, FP8_ASCALE * v[j][q].w);
#else
                st_bf4(XN2 + (size_t)m * D + (lane + 64 * q) * 4, v[j][q]);
#endif
            }
        }
        float p0[32], p1[32];
        f32x2_t tv[4][4];
#pragma unroll
        for (int q = 0; q < 4; ++q) { tv[q][0] = (f32x2_t){v[0][q].x, v[1][q].x}; tv[q][1] = (f32x2_t){v[0][q].y, v[1][q].y}; tv[q][2] = (f32x2_t){v[0][q].z, v[1][q].z}; tv[q][3] = (f32x2_t){v[0][q].w, v[1][q].w}; }
#pragma unroll
        for (int e = 0; e < 32; ++e) {
            f32x2_t a = {0.f, 0.f};
#pragma unroll
            for (int q = 0; q < 4; ++q) { const f32x4 w = *(const LAS f32x4*)(WrT + e * 1024 + (lane + 64 * q) * 4);
                a = __builtin_elementwise_fma(tv[q][0], (f32x2_t){w.x, w.x}, a); a = __builtin_elementwise_fma(tv[q][1], (f32x2_t){w.y, w.y}, a);
                a = __builtin_elementwise_fma(tv[q][2], (f32x2_t){w.z, w.z}, a); a = __builtin_elementwise_fma(tv[q][3], (f32x2_t){w.w, w.w}, a); }
            p0[e] = a.x; p1[e] = a.y;
        }
#define RS_STEP(P, N, MASK) do { const bool up = (lane & (MASK)) != 0; _Pragma("unroll") for (int i = 0; i < (N); ++i) { const float mine = up ? P[(N) + i] : P[i], other = up ? P[i] : P[(N) + i]; P[i] = mine + __shfl_xor(other, (MASK)); } } while (0)
        RS_STEP(p0, 16, 32); RS_STEP(p0, 8, 16); RS_STEP(p0, 4, 8); RS_STEP(p0, 2, 4); RS_STEP(p0, 1, 2);
        RS_STEP(p1, 16, 32); RS_STEP(p1, 8, 16); RS_STEP(p1, 4, 8); RS_STEP(p1, 2, 4); RS_STEP(p1, 1, 2);
#undef RS_STEP
        float lg[2] = {p0[0] + __shfl_xor(p0[0], 1) + rb, p1[0] + __shfl_xor(p1[0], 1) + rb};
#pragma unroll
        for (int j = 0; j < 2; ++j) {
            const int m = mp * 2 + j; float val = lg[j]; int bi[4]; float bv[4];
#pragma unroll
            for (int k = 0; k < 4; ++k) {
                float mx = val;
#pragma unroll
                for (int o = 1; o < 64; o <<= 1) mx = fmaxf(mx, __shfl_xor(mx, o));
                const unsigned long long bal = __ballot(val == mx);
                const int e = (int)(__ffsll((long long)bal) - 1) >> 1;
                bi[k] = e; bv[k] = mx;
                if ((lane >> 1) == e) val = -INFINITY;
            }
            const float e1 = __expf(bv[1] - bv[0]), e2 = __expf(bv[2] - bv[0]), e3 = __expf(bv[3] - bv[0]);
            const float inv = __builtin_amdgcn_rcpf(1.f + e1 + e2 + e3);
            if (lane == 0) {
                *(int4*)(TOPI + (size_t)m * 4) = make_int4(bi[0], bi[1], bi[2], bi[3]);
                *(f32x4*)(TOPW + (size_t)m * 4) = (f32x4){inv, e1 * inv, e2 * inv, e3 * inv};
                atomicAdd((int*)&hist[bi[0]], 1); atomicAdd((int*)&hist[bi[1]], 1); atomicAdd((int*)&hist[bi[2]], 1); atomicAdd((int*)&hist[bi[3]], 1);
            }
        }
    }
    __syncthreads();
    if (((int)threadIdx.x) < 32) atomicAdd((unsigned*)(F.ctl + CW_CNT + 64 * ((int)threadIdx.x)), (unsigned)hist[((int)threadIdx.x)]);
    __syncthreads();
}

__device__ __forceinline__ void p_router3(Frame& F) {
    LAS float* XS = (LAS float*)F.lds; LAS float* PW = (LAS float*)(F.lds + 66048); LAS float* P = (LAS float*)(F.lds + 66048 + 33792); LAS int* hist = (LAS int*)(F.lds + 66048 + 33792 + 4224);
    if (((int)threadIdx.x) < 32) hist[((int)threadIdx.x)] = 0;
    int* ROWMAP = (int*)(F.ws + WS_ROWMAP);
    for (int i = F.blk * NTHREADS + ((int)threadIdx.x); i < CAP; i += F.nblk * NTHREADS) ROWMAP[i] = -1;
    const int lane = ((int)(threadIdx.x & 63u)), tid = (int)threadIdx.x;
    bf16* XN2 = (bf16*)(F.ws + WS_XN2); int* TOPI = (int*)(F.ws + WS_TOPI); float* TOPW = (float*)(F.ws + WS_TOPW); const float* W2 = (const float*)(F.ws + WS_WRT);
    const float rb32 = F.router_b[lane & 31];
    const f32x4* wr = (const f32x4*)F.norm_ffn + lane;
    for (int tile = F.blk; tile < T / 32; tile += F.nblk) {
        const int m0 = tile * 32;
        f32x16 acc = {0.f, 0.f, 0.f, 0.f, 0.f, 0.f, 0.f, 0.f, 0.f, 0.f, 0.f, 0.f, 0.f, 0.f, 0.f, 0.f};
        const int i = lane & 31, kh = lane >> 5;
        for (int st = 0; st < 2; ++st) {
            __syncthreads();
#pragma unroll
            for (int j = 0; j < 8; ++j) { const int idx = tid + 512 * j, tk = idx >> 7, c4 = idx & 127;
                *(LAS f32x4*)(XS + tk * 516 + 4 * c4) = *(const f32x4*)(F.out + (size_t)(m0 + tk) * D + 512 * st + 4 * c4); }
            __syncthreads();
            const int kb = 64 * F.wave + 32 * kh;
            const float* bp = W2 + (size_t)(512 * st + kb) * 32 + i;
#pragma unroll
            for (int c = 0; c < 8; ++c) { const f32x4 a = *(const LAS f32x4*)(XS + i * 516 + kb + 4 * c);
                const float b0 = bp[(4 * c + 0) * 32], b1 = bp[(4 * c + 1) * 32], b2 = bp[(4 * c + 2) * 32], b3 = bp[(4 * c + 3) * 32];
                acc = __builtin_amdgcn_mfma_f32_32x32x2f32(a.x, b0, acc, 0, 0, 0); acc = __builtin_amdgcn_mfma_f32_32x32x2f32(a.y, b1, acc, 0, 0, 0);
                acc = __builtin_amdgcn_mfma_f32_32x32x2f32(a.z, b2, acc, 0, 0, 0); acc = __builtin_amdgcn_mfma_f32_32x32x2f32(a.w, b3, acc, 0, 0, 0); }
        }
#pragma unroll
        for (int rg = 0; rg < 16; ++rg) PW[(F.wave * 32 + crow_(rg, kh)) * 33 + i] = acc[rg];
        __syncthreads();
        for (int idx = tid; idx < 1024; idx += NTHREADS) { const int tk = idx >> 5, e = idx & 31; float s = 0.f;
#pragma unroll
            for (int w = 0; w < 8; ++w) s += PW[(w * 32 + tk) * 33 + e];
            P[tk * 33 + e] = s; }
        __syncthreads();
        for (int pp = 0; pp < 2; ++pp) {
            f32x4 v[2][4]; float rstd[2];
#pragma unroll
            for (int j = 0; j < 2; ++j) {
                const int m = m0 + 4 * F.wave + 2 * pp + j;
                float s = 0.f;
#pragma unroll
                for (int q = 0; q < 4; ++q) { v[j][q] = ((const f32x4*)(F.out + (size_t)m * D) + lane)[64 * q]; s += (v[j][q].x * v[j][q].x + v[j][q].y * v[j][q].y) + (v[j][q].z * v[j][q].z + v[j][q].w * v[j][q].w); }
                rstd[j] = __builtin_amdgcn_rsqf(wave_sum(s) * (1.f / D) + EPS);
#pragma unroll
                for (int q = 0; q < 4; ++q) { const f32x4 hv = v[j][q] * rstd[j] * wr[64 * q];
#if MOE_FP8
                    *(unsigned*)((unsigned char*)XN2 + (size_t)m * D + (lane + 64 * q) * 4) = pk_fp8x4(FP8_ASCALE * hv.x, FP8_ASCALE * hv.y, FP8_ASCALE * hv.z, FP8_ASCALE * hv.w);
#else
                    st_bf4(XN2 + (size_t)m * D + (lane + 64 * q) * 4, hv);
#endif
                }
            }
            const int jt = lane >> 5, e32 = lane & 31, t = 4 * F.wave + 2 * pp + jt;
            float val = P[t * 33 + e32] * (jt ? rstd[1] : rstd[0]) + rb32;
            int bi[4]; float bv[4];
#pragma unroll
            for (int k = 0; k < 4; ++k) {
                float mx = val;
#pragma unroll
                for (int o = 1; o < 32; o <<= 1) mx = fmaxf(mx, __shfl_xor(mx, o));
                const unsigned long long bal = __ballot(val == mx);
                const unsigned lo32 = (unsigned)bal, hi32 = (unsigned)(bal >> 32);
                const int e = jt ? (__ffs((int)hi32) - 1) : (__ffs((int)lo32) - 1);
                bi[k] = e; bv[k] = mx;
                if (e32 == e) val = -INFINITY;
            }
            const float e1 = __expf(bv[1] - bv[0]), e2 = __expf(bv[2] - bv[0]), e3 = __expf(bv[3] - bv[0]);
            const float inv = __builtin_amdgcn_rcpf(1.f + e1 + e2 + e3);
            if (e32 == 0) { const int m = m0 + t;
                *(int4*)(TOPI + (size_t)m * 4) = make_int4(bi[0], bi[1], bi[2], bi[3]);
                *(f32x4*)(TOPW + (size_t)m * 4) = (f32x4){inv, e1 * inv, e2 * inv, e3 * inv};
                atomicAdd((int*)&hist[bi[0]], 1); atomicAdd((int*)&hist[bi[1]], 1); atomicAdd((int*)&hist[bi[2]], 1); atomicAdd((int*)&hist[bi[3]], 1);
            }
        }
    }
    __syncthreads();
    if (((int)threadIdx.x) < 32) atomicAdd((unsigned*)(F.ctl + CW_CNT + 64 * ((int)threadIdx.x)), (unsigned)hist[((int)threadIdx.x)]);
    __syncthreads();
}

__device__ __forceinline__ void p_slots(Frame& F) {
    LAS int* hist = (LAS int*)F.lds;
    LAS int* base = hist + 32;
    LAS int* pst = hist + 64;
    if (((int)threadIdx.x) == 0) {
        int acc = 0;
        for (int e = 0; e < 32; ++e) { const int c = (int)__hip_atomic_load((unsigned*)(F.ctl + CW_CNT + 64 * e), __ATOMIC_RELAXED, __HIP_MEMORY_SCOPE_AGENT); pst[e] = acc; acc += (c + MOE_PAD - 1) / MOE_PAD * MOE_PAD; }
        pst[32] = acc;
    }
    __syncthreads();
    if (F.blk == 0) {
        int* TEXP = (int*)(F.ws + WS_SMALL);
        for (int i = ((int)threadIdx.x); i < NT256; i += NTHREADS) { const int r = i * 256; int e = -1;
            for (int k = 0; k < 32; ++k) if (r >= pst[k] && r < pst[k + 1]) e = k;
            TEXP[i] = e; }
        if (((int)threadIdx.x) == 0) TEXP[1024] = pst[32] / 256;
    }
    const int* TOPI = (const int*)(F.ws + WS_TOPI); int* SLOT = (int*)(F.ws + WS_SLOT); int* ROWMAP = (int*)(F.ws + WS_ROWMAP);
    for (int c = F.blk; c < T / 128; c += F.nblk) {
        if (((int)threadIdx.x) < 32) hist[((int)threadIdx.x)] = 0;
        __syncthreads();
        const int ai = c * 512 + ((int)threadIdx.x);
        const int e = TOPI[ai];
        const int lr = atomicAdd((int*)&hist[e], 1);
        __syncthreads();
        if (((int)threadIdx.x) < 32) base[((int)threadIdx.x)] = (int)atomicAdd((unsigned*)(F.ctl + CW_CUR + 64 * ((int)threadIdx.x)), (unsigned)hist[((int)threadIdx.x)]);
        __syncthreads();
        const int slot = pst[e] + base[e] + lr;
        SLOT[ai] = slot; ROWMAP[slot] = ai >> 2;
        __syncthreads();
    }
}

__device__ __forceinline__ void p_final(Frame& F) {
    const int gw = F.blk * NWAVES + F.wave, NGW = F.nblk * NWAVES;
    const int* SLOT = (const int*)(F.ws + WS_SLOT); const float* TOPW = (const float*)(F.ws + WS_TOPW); const bf16* YB = (const bf16*)(F.ws + WS_YB);
    for (int m = gw; m < T; m += NGW) {
        f32x4* xr = (f32x4*)(F.out + (size_t)m * D) + ((int)(threadIdx.x & 63u));
        const f32x4* wr = (const f32x4*)F.norm_final + ((int)(threadIdx.x & 63u));
        f32x4 v[4];
#pragma unroll
        for (int j = 0; j < 4; ++j) v[j] = xr[64 * j];
#pragma unroll
        for (int k = 0; k < 4; ++k) {
            const int sl = SLOT[m * 4 + k]; const float w = TOPW[m * 4 + k];
#pragma unroll
            for (int j = 0; j < 4; ++j) { const u32x2 y = __builtin_nontemporal_load((const u32x2*)(YB + (size_t)sl * 1024 + (((int)(threadIdx.x & 63u)) + 64 * j) * 4));
                v[j].x += w * bflo(y.x); v[j].y += w * bfhi(y.x); v[j].z += w * bflo(y.y); v[j].w += w * bfhi(y.y); }
        }
        float s = 0.f;
#pragma unroll
        for (int j = 0; j < 4; ++j) s += (v[j].x * v[j].x + v[j].y * v[j].y) + (v[j].z * v[j].z + v[j].w * v[j].w);
        const float rstd = __builtin_amdgcn_rsqf(wave_sum(s) * (1.f / D) + EPS);
#pragma unroll
        for (int j = 0; j < 4; ++j) __builtin_nontemporal_store(v[j] * rstd * wr[64 * j], xr + 64 * j);
    }
}


__device__ __forceinline__ void stagger_start(int blk, int nblk, unsigned span_ticks  ) {
    const unsigned long long t0 = __builtin_amdgcn_s_memrealtime();
    const unsigned long long want = (unsigned long long)((blk * 37u) % (unsigned)nblk) * span_ticks / (unsigned)nblk;
    while (__builtin_amdgcn_s_memrealtime() - t0 < want) __builtin_amdgcn_s_sleep(8);
}
__global__ void __launch_bounds__(NTHREADS, 2) fwd(Args args) {
    extern __shared__ __attribute__((aligned(16))) unsigned char lds_raw[];
    Frame F;
    F.lds = (LAS unsigned char*)lds_raw;
    F.tid = threadIdx.x; F.lane = F.tid & 63; F.wave = __builtin_amdgcn_readfirstlane(F.tid >> 6);
    F.blk = blockIdx.x; F.nblk = gridDim.x;
    F.x = args.in[0]; F.w_in = args.in[1]; F.rel_bias = args.in[2]; F.w_ba = args.in[3]; F.conv_w = args.in[4]; F.conv_b = args.in[5];
    F.dt_bias = args.in[6]; F.a_log = args.in[7]; F.d_skip = args.in[8]; F.ssm_norm_w = args.in[9]; F.w_bs = args.in[10]; F.gate_bias = args.in[11];
    F.w_out = args.in[12]; F.norm_mix = args.in[13]; F.norm_ffn = args.in[14]; F.router_w = args.in[15]; F.router_b = args.in[16];
    F.w1 = args.in[17]; F.b1 = args.in[18]; F.w2 = args.in[19]; F.b2 = args.in[20]; F.norm_final = args.in[21];
    F.out = args.out; F.ws = args.ws; F.ctl = (gu32*)(args.ws + WS_CTL);
    volatile LAS unsigned* MISC = (volatile LAS unsigned*)(F.lds + MISC_OFF);
    if (((int)threadIdx.x) < 32) MISC[((int)threadIdx.x)] = 0u;
    __syncthreads();
    XcdBarrier bar; bar.bar = (unsigned*)(F.ctl + CW_BAR); bar.x = 0; bar.st = nullptr;
#if MK_FUSED
    bar = xcd_barrier_post((unsigned*)(F.ctl + CW_BAR), MISC + 8);
#define GRID_BAR() xcd_barrier(bar)
#else
#define GRID_BAR() do { } while (0)
#endif
    const int lo = args.ph_lo, hi = args.ph_hi;
#define IN(k) (lo <= (k) && (k) < hi)
#define SEAM(k) do { if ((k) != 5 && IN(k) && IN((k) + 1)) GRID_BAR();     \
        if (PROBE_TIME == (k) && F.blk == 0 && ((int)threadIdx.x) == 0) { const unsigned long long d_ = __builtin_amdgcn_s_memrealtime() - pt_; const unsigned long long s_ = __builtin_amdgcn_s_memrealtime(); \
            while (__builtin_amdgcn_s_memrealtime() - s_ < d_) __builtin_amdgcn_s_sleep(8); } \
        if (PROBE_TIME == (k) + 1) pt_ = __builtin_amdgcn_s_memrealtime(); } while (0)
    unsigned long long pt_ = 0; if (PROBE_TIME == 0) pt_ = __builtin_amdgcn_s_memrealtime();
    unsigned char* ws = F.ws;

    if (IN(0)) { p_rmsnorm_in(F); p_convert_small(F); if (PROBE_DUP == 0) { p_rmsnorm_in(F); p_convert_small(F); } } SEAM(0);
    if (IN(1)) {
#if FG_INPROJ
#if QKV_FP8
        {
            pg8::Gemm gq{(const bf16*)(ws + WS_XNQ), (const bf16*)(ws + WS_WQKVQ), T, C_Z, D / 2}; pg8::StaticOrder SQ; SQ.init(T, C_Z, F.nblk, F.blk);
            pg8::EpiInProjF EQ{ws, F.dt_bias, F.gate_bias, -1, 1.f / (FP8_ASCALE * FP8_WSCALE), 0};
            pg8::gemm_phase<pg8::EpiInProjF, pg8::StaticOrder, true, false, false, true>(F.lds, gq, SQ, EQ, nullptr, nullptr, 0);
        }
        constexpr int PN0 = C_Z / 256;
#else
        constexpr int PN0 = 0;
#endif
        pg8::Gemm g{(const bf16*)(ws + WS_XN), (const bf16*)(ws + WS_WIN_T) + (size_t)PN0 * 256 * D, T, NPROJ_PAD - PN0 * 256, D}; pg8::StaticOrder S; S.init(T, NPROJ_PAD - PN0 * 256, F.nblk, F.blk);
        pg8::EpiInProjF E{ws, F.dt_bias, F.gate_bias, -1, 1.f, PN0};
        if (STAGGER_TICKS) stagger_start(F.blk, F.nblk, STAGGER_TICKS);
        unsigned long long pc0_ = 0, pt0_ = 0;
        if (PROBE_DUP == 300) { pc0_ = clock64(); pt0_ = __builtin_amdgcn_s_memrealtime(); }
        pg8::gemm_phase<pg8::EpiInProjF, pg8::StaticOrder, true, false, false>(F.lds, g, S, E, nullptr, nullptr, 0);
        if (PROBE_DUP == 300 && F.blk == 0 && ((int)threadIdx.x) == 0) {
            const unsigned long long dc = clock64() - pc0_, dt = __builtin_amdgcn_s_memrealtime() - pt0_;
            const unsigned long long want = dc * 5000ull / (dt ? dt : 1ull);
            const unsigned long long s0 = __builtin_amdgcn_s_memrealtime();
            while (__builtin_amdgcn_s_memrealtime() - s0 < want) __builtin_amdgcn_s_sleep(8);
        }
        if (PROBE_DUP == 301 && F.blk == 0 && ((int)threadIdx.x) == 0) {
            const unsigned long long s0 = __builtin_amdgcn_s_memrealtime();
            while (__builtin_amdgcn_s_memrealtime() - s0 < 50000ull) __builtin_amdgcn_s_sleep(8);
        }
        if (PROBE_DUP == 103) { pg8::EpiNullF EN; pg8::Gemm g2{(const bf16*)(ws + WS_XN), (const bf16*)(ws + WS_WIN_T), 16384, 3072, D}; pg8::StaticOrder S2; S2.init(16384, 3072, F.nblk, F.blk);
            pg8::gemm_phase<pg8::EpiNullF, pg8::StaticOrder, true, false, false>(F.lds, g2, S2, EN, nullptr, nullptr, 0); }
        if (PROBE_DUP == 105) { pg8::EpiNullF EN; pg8::Gemm g2{(const bf16*)(ws + WS_XN), (const bf16*)(ws + WS_WIN_T), 16384, 3072, 512}; pg8::StaticOrder S2; S2.init(16384, 3072, F.nblk, F.blk);
            for (int rr = 0; rr < 4; ++rr) pg8::gemm_phase<pg8::EpiNullF, pg8::StaticOrder, true, false, false, true>(F.lds, g2, S2, EN, nullptr, nullptr, 0); }
        if (PROBE_DUP == 104) { pg8::EpiNullF EN; pg8::Gemm g2{(const bf16*)(ws + WS_XN), (const bf16*)(ws + WS_WIN_T), 16384, 3072, D}; pg8::StaticOrder S2; S2.init(16384, 3072, F.nblk, F.blk);
            for (int rr = 0; rr < 4; ++rr) pg8::gemm_phase<pg8::EpiNullF, pg8::StaticOrder, true, false, false>(F.lds, g2, S2, EN, nullptr, nullptr, 0); }
        if (PROBE_DUP == 101) { pg8::EpiNullF EN; pg8::gemm_phase<pg8::EpiNullF, pg8::StaticOrder, true, false, false>(F.lds, g, S, EN, nullptr, nullptr, 0); }
        if (PROBE_DUP == 1) { pg8::gemm_phase<pg8::EpiInProjF, pg8::StaticOrder, true, false, false>(F.lds, g, S, E, nullptr, nullptr, 0); }
#else
        EpiInProj E{ws, F.dt_bias, F.gate_bias}; gemm_naive(F, T / 128, NPROJ, D, (const bf16*)(ws + WS_XN), D, nullptr, F.w_in, NPROJ, nullptr, 0, E);
#endif
    } SEAM(1);
#if FA_ATTN
    if (IN(2)) {
        if (PROBE_DUP == 201) { p_attn_fast<false, true>(F); GRID_BAR(); }
        if (PROBE_DUP == 202) { p_attn_fast<true, false>(F); GRID_BAR(); }
        if (PROBE_DUP == 203) { p_attn_fast<false, false>(F); GRID_BAR(); }
        p_attn_fast(F); if (PROBE_DUP == 2) p_attn_fast(F); } SEAM(2);
    if (IN(3)) { p_attn_merge(F); p_conv2(F); if (PROBE_DUP == 3) { p_attn_merge(F); p_conv2(F); } } SEAM(3);
#else
    if (IN(2)) { p_attn_naive(F); } SEAM(2);
    if (IN(3)) { p_conv(F); } SEAM(3);
#endif
#if FS_SSD
    if (IN(4)) { p_ssd_fast2(F); if (PROBE_DUP == 4) p_ssd_fast2(F); } SEAM(4);
#if MOE_FP8
    if (IN(5)) { p_ypost2(F); p_convert_moe_fp8(F); if (PROBE_DUP == 5) { p_convert_moe_fp8(F); } } SEAM(5);
#else
    if (IN(5)) { p_ypost2(F); p_convert_moe(F); if (PROBE_DUP == 5) { p_convert_moe(F); } } SEAM(5);
#endif
#else
    if (IN(4)) { p_ssd_naive(F); } SEAM(4);
    if (IN(5)) { p_ypost(F); p_convert_moe(F); } SEAM(5);
#endif
    if (IN(6)) {
        __syncthreads();
#if FG_MIX
        pg8::Gemm g{(const bf16*)(ws + WS_ATTN), (const bf16*)(ws + WS_WBA_T), T, D, 512}; pg8::StaticOrder S; S.init(T, D, F.nblk, F.blk);
        pg8::EpiM0F E{ws};
        pg8::gemm_phase<pg8::EpiM0F, pg8::StaticOrder, true, false, false>(F.lds, g, S, E, nullptr, nullptr, 0);
        if (PROBE_DUP == 6) { pg8::gemm_phase<pg8::EpiM0F, pg8::StaticOrder, true, false, false>(F.lds, g, S, E, nullptr, nullptr, 0); }
#else
        EpiM0 E{ws}; gemm_naive(F, T / 128, D, 512, (const bf16*)(ws + WS_ATTN), 512, nullptr, F.w_ba, D, nullptr, 0, E);
#endif
    } SEAM(6);
    if (IN(7)) {
#if FG_MIX
        pg8::Gemm g{(const bf16*)(ws + WS_YN), (const bf16*)(ws + WS_WBS_T), T, D, DI}; pg8::StaticOrder S; S.init(T, D, F.nblk, F.blk);
        pg8::EpiMergedF E{ws};
        pg8::gemm_phase<pg8::EpiMergedF, pg8::StaticOrder, true, false, false>(F.lds, g, S, E, nullptr, nullptr, 0);
        if (PROBE_DUP == 7) { pg8::gemm_phase<pg8::EpiMergedF, pg8::StaticOrder, true, false, false>(F.lds, g, S, E, nullptr, nullptr, 0); }
#else
        EpiMerged E{ws}; gemm_naive(F, T / 128, D, DI, (const bf16*)(ws + WS_YN), DI, nullptr, F.w_bs, D, nullptr, 0, E);
#endif
    } SEAM(7);
    if (IN(8)) {
#if FG_MIX
        pg8::Gemm g{(const bf16*)(ws + WS_MERGED), (const bf16*)(ws + WS_WOUT_T), T, D, D}; pg8::StaticOrder S; S.init(T, D, F.nblk, F.blk);
        pg8::EpiX1F E{F.x, F.out};
        pg8::gemm_phase<pg8::EpiX1F, pg8::StaticOrder, true, false, false>(F.lds, g, S, E, nullptr, nullptr, 0);
        if (PROBE_DUP == 8) { pg8::gemm_phase<pg8::EpiX1F, pg8::StaticOrder, true, false, false>(F.lds, g, S, E, nullptr, nullptr, 0); }
#else
        EpiX1 E{F.x, F.out}; gemm_naive(F, T / 128, D, D, (const bf16*)(ws + WS_MERGED), D, nullptr, F.w_out, D, nullptr, 0, E);
#endif
    } SEAM(8);
    if (IN(9)) { p_router3(F); } SEAM(9);
    if (IN(10)) { p_slots(F); } SEAM(10);
    if (IN(11)) {
#if FG_MOE && MOE_FP8
        const int* texp = (const int*)(ws + WS_SMALL); const int ntile = texp[1024];
        pg8::Gemm g{(const bf16*)(ws + WS_XN2), (const bf16*)(ws + WS_W1T), CAP, 2048, 512}; pg8::MoeOrder S; S.init(ntile, 8, F.nblk, F.blk);
        pg8::EpiMoe1Q E{ws, F.b1, texp};
        pg8::gemm_phase<pg8::EpiMoe1Q, pg8::MoeOrder, true, true, true, true>(F.lds, g, S, E, (const int*)(ws + WS_ROWMAP), texp, (size_t)2048 * 1024);
        if (PROBE_DUP == 11) { pg8::gemm_phase<pg8::EpiMoe1Q, pg8::MoeOrder, true, true, true, true>(F.lds, g, S, E, (const int*)(ws + WS_ROWMAP), texp, (size_t)2048 * 1024); }
#elif FG_MOE
        const int* texp = (const int*)(ws + WS_SMALL); const int ntile = texp[1024];
        pg8::Gemm g{(const bf16*)(ws + WS_XN2), (const bf16*)(ws + WS_W1T), CAP, 2048, D}; pg8::MoeOrder S; S.init(ntile, 8, F.nblk, F.blk);
        pg8::EpiMoe1F E{ws, F.b1, texp};
        pg8::gemm_phase<pg8::EpiMoe1F, pg8::MoeOrder, true, true, true>(F.lds, g, S, E, (const int*)(ws + WS_ROWMAP), texp, (size_t)2048 * 1024 * 2);
#else
        EpiMoe1 E{ws, F.b1}; gemm_naive(F, CAP / 128, 2048, D, (const bf16*)(ws + WS_XN2), D, (const int*)(ws + WS_ROWMAP), F.w1, 2048, (const int*)(ws + WS_SMALL), (size_t)1024 * 2048, E);
#endif
    } SEAM(11);
    if (IN(12)) {
#if FG_MOE && MOE_FP8
        const int* texp = (const int*)(ws + WS_SMALL); const int ntile = texp[1024];
        pg8::Gemm g{(const bf16*)(ws + WS_ACT), (const bf16*)(ws + WS_W2T), CAP, 1024, 512}; pg8::MoeOrder S; S.init(ntile, 4, F.nblk, F.blk);
        pg8::EpiMoe2Q E{ws, F.b2, texp};
        pg8::gemm_phase<pg8::EpiMoe2Q, pg8::MoeOrder, true, false, true, true>(F.lds, g, S, E, nullptr, texp, (size_t)1024 * 1024);
        if (PROBE_DUP == 12) { pg8::gemm_phase<pg8::EpiMoe2Q, pg8::MoeOrder, true, false, true, true>(F.lds, g, S, E, nullptr, texp, (size_t)1024 * 1024); }
#elif FG_MOE
        const int* texp = (const int*)(ws + WS_SMALL); const int ntile = texp[1024];
        pg8::Gemm g{(const bf16*)(ws + WS_ACT), (const bf16*)(ws + WS_W2T), CAP, 1024, 1024}; pg8::MoeOrder S; S.init(ntile, 4, F.nblk, F.blk);
        pg8::EpiMoe2F E{ws, F.b2, texp};
        pg8::gemm_phase<pg8::EpiMoe2F, pg8::MoeOrder, true, false, true>(F.lds, g, S, E, nullptr, texp, (size_t)1024 * 1024 * 2);
#else
        EpiMoe2 E{ws, F.b2}; gemm_naive(F, CAP / 128, 1024, 1024, (const bf16*)(ws + WS_ACT), 1024, nullptr, F.w2, 1024, (const int*)(ws + WS_SMALL), (size_t)1024 * 1024, E);
#endif
    } SEAM(12);
    if (IN(13)) { p_final(F); } SEAM(13);
#undef IN
#undef SEAM
}

extern "C" void kernel_launch(void* const* d_in, const int* in_sizes, int n_in, void* d_out, int out_size, void* d_ws, size_t ws_size, hipStream_t stream) {
    static int grid = 0;
    if (grid == 0) {
        if (n_in != 22 || out_size != T * D || ws_size < WS_END) { fprintf(stderr, "kernel_launch: unexpected shapes: n_in %d out %d ws %zu\n", n_in, out_size, ws_size); grid = -1; return; }
        int dev = 0, cus = 0, per_cu = 0;
        if (hipGetDevice(&dev) != hipSuccess || hipDeviceGetAttribute(&cus, hipDeviceAttributeMultiprocessorCount, dev) != hipSuccess) { grid = -1; return; }
        if (hipFuncSetAttribute((const void*)fwd, hipFuncAttributeMaxDynamicSharedMemorySize, LDS_BYTES) != hipSuccess) { fprintf(stderr, "kernel_launch: hipFuncSetAttribute failed\n"); grid = -1; return; }
        if (hipOccupancyMaxActiveBlocksPerMultiprocessor(&per_cu, (const void*)fwd, NTHREADS, LDS_BYTES) != hipSuccess || per_cu < 1) fprintf(stderr, "kernel_launch: occupancy query says %d\n", per_cu);
        (void)hipGetLastError();
        grid = cus;
    }
    if (grid < 0) return;
    (void)hipMemsetAsync((char*)d_ws + WS_CTL, 0, CTL_ZERO_BYTES, stream);
    Args a{};
    for (int i = 0; i < 22; ++i) a.in[i] = (const float*)d_in[i];
    a.out = (float*)d_out; a.ws = (unsigned char*)d_ws;
#if MK_FUSED
    a.ph_lo = 0; a.ph_hi = NPHASE; a.li = 0;
    hipLaunchKernelGGL(fwd, dim3(grid), dim3(NTHREADS), LDS_BYTES, stream, a);
#else
    for (int p = 0; p < NPHASE; ++p) { a.ph_lo = p; a.ph_hi = p + 1; a.li = p; hipLaunchKernelGGL(fwd, dim3(grid), dim3(NTHREADS), LDS_BYTES, stream, a); }
#endif
}
```

```cpp
#include <hip/hip_runtime.h>
#include <cstdio>
#include <cstdint>

#ifndef MK_FUSED
#define MK_FUSED 1
#endif

#ifndef FG_INPROJ
#define FG_INPROJ 1
#endif
#ifndef PROBE_DUP
#define PROBE_DUP (-1)
#endif
#ifndef STAGGER_TICKS
#define STAGGER_TICKS 0
#endif
#ifndef SSD_REP_A
#define SSD_REP_A 1
#endif
#ifndef SSD_REP_W
#define SSD_REP_W 1
#endif
#ifndef PROBE_TIME
#define PROBE_TIME (-1)
#endif
#ifndef PROBE_SEC
#define PROBE_SEC (-1)
#endif
#ifndef FA_ATTN
#define FA_ATTN 1
#endif
#ifndef FS_SSD
#define FS_SSD 1
#endif
#ifndef MOE_FP8
#define MOE_FP8 1
#endif
#ifndef QKV_FP8
#define QKV_FP8 1
#endif
#ifndef QKV_STORE_FP8
#define QKV_STORE_FP8 1
#endif
#ifndef FG_MIX
#define FG_MIX 1
#endif
#ifndef FG_MOE
#define FG_MOE 1
#endif
#define GAS __attribute__((address_space(1)))
#define LAS __attribute__((address_space(3)))
typedef unsigned short bf16;
typedef float f32x4 __attribute__((ext_vector_type(4)));
typedef unsigned u32x4 __attribute__((ext_vector_type(4)));
typedef unsigned u32x2 __attribute__((ext_vector_type(2)));
typedef GAS unsigned gu32;

constexpr int BATCH = 16, SEQ = 2048, D = 1024, T = BATCH * SEQ;
constexpr int NPROJ = 11808;
constexpr int AW = 1536;
constexpr int DI = 2048;
constexpr int CONVD = 3072;
constexpr int NH_SSM = 32, NG_SSM = 4, DSTATE = 128;
constexpr int NEXP = 32, TOPK = 4, NASSIGN = T * TOPK;
constexpr int MOE_PAD = 256;
constexpr int CAP = NASSIGN + NEXP * MOE_PAD;
constexpr int NT256 = CAP / 256;
constexpr float EPS = 1e-5f;
constexpr int C_Q = 0, C_K = 1536, C_V = 3072, C_Z = 4608, C_XBC = 6656, C_DT = 9728, C_GATE = 9760;

constexpr size_t MiB = 1u << 20;
constexpr size_t WS_CTL = 0, CTL_ZERO_BYTES = 128 * 1024;
constexpr size_t WS_SMALL = 1 * MiB;
constexpr size_t WS_XN = 34 * MiB;
constexpr size_t WS_Q = 98 * MiB, WS_K = 194 * MiB, WS_V = 290 * MiB;
constexpr size_t WS_Z = 386 * MiB;
constexpr size_t WS_XBC = 514 * MiB;
constexpr size_t WS_GATE = 706 * MiB;
constexpr size_t WS_DT = 834 * MiB;
constexpr size_t WS_ATTN = 838 * MiB;
constexpr size_t WS_M0 = 870 * MiB;
constexpr size_t WS_CONV = WS_K;
constexpr size_t WS_YZ = WS_XBC;
constexpr size_t WS_YN = WS_Z;
constexpr size_t WS_MERGED = WS_XN;
constexpr size_t WS_XN2 = WS_Q;
constexpr size_t WS_TOPI = 162 * MiB;
constexpr size_t WS_TOPW = 163 * MiB;
constexpr size_t WS_SLOT = 164 * MiB;
constexpr size_t WS_ROWMAP = 165 * MiB;
constexpr size_t WS_ACT = 386 * MiB;
constexpr size_t WS_YB = 658 * MiB;
constexpr size_t WS_WIN_T = 2 * MiB;
constexpr size_t WS_WBA_T = 26 * MiB;
constexpr size_t WS_WBS_T = 27 * MiB;
constexpr size_t WS_WOUT_T = 31 * MiB;
constexpr size_t WS_W1T = 194 * MiB;
constexpr size_t WS_W2T = 322 * MiB;
constexpr int NPROJ_PAD = 12032;
constexpr size_t WS_OUTG = 870 * MiB;
constexpr size_t WS_LSE = 966 * MiB;
constexpr size_t WS_BT = 1 * MiB + 65536;
constexpr float FP8_ASCALE = 4.f, FP8_WSCALE = 64.f;
constexpr size_t WS_WRT = 1 * MiB + 131072;
constexpr size_t WS_XNQ = 870 * MiB;
constexpr size_t WS_WQKVQ = 998 * MiB;
constexpr size_t WS_END = 1024 * MiB;
constexpr int CW_TMO = 0;
constexpr int CW_BAR = 4096;
constexpr int CW_CNT = 16384;
constexpr int CW_CUR = 16384 + 64 * 32;

constexpr int NWAVES = 8, NTHREADS = 512;
constexpr int LDS_BYTES = 147456;
constexpr int MISC_OFF = LDS_BYTES - 256;

constexpr int NPHASE = 14;

__device__ __forceinline__ unsigned f2bf(float f) { unsigned u = __builtin_bit_cast(unsigned, f); return (u + 0x7fffu + ((u >> 16) & 1u)) >> 16; }

typedef float f32x2_t __attribute__((ext_vector_type(2))); typedef __bf16 bf16x2_t __attribute__((ext_vector_type(2)));
__device__ __forceinline__ unsigned cvtpk(float lo, float hi) { const f32x2_t v = {lo, hi}; const bf16x2_t b = __builtin_convertvector(v, bf16x2_t); return __builtin_bit_cast(unsigned, b); }
__device__ __forceinline__ unsigned pk2(float lo, float hi) { return cvtpk(lo, hi); }
__device__ __forceinline__ unsigned pk_fp8x4(float a, float b, float c, float d) { int w = __builtin_amdgcn_cvt_pk_fp8_f32(a, b, 0, false); w = __builtin_amdgcn_cvt_pk_fp8_f32(c, d, w, true); return (unsigned)w; }
__device__ __forceinline__ unsigned fp8x2_to_bf16x2(unsigned w, bool hi) { const f32x2_t f = hi ? __builtin_amdgcn_cvt_pk_f32_fp8((int)w, true) : __builtin_amdgcn_cvt_pk_f32_fp8((int)w, false); return cvtpk(f.x, f.y); }
__device__ __forceinline__ u32x4 fp8x8_to_bf16x8(unsigned lo, unsigned hi) { u32x4 o; o.x = fp8x2_to_bf16x2(lo, false); o.y = fp8x2_to_bf16x2(lo, true); o.z = fp8x2_to_bf16x2(hi, false); o.w = fp8x2_to_bf16x2(hi, true); return o; }
__device__ __forceinline__ float bflo(unsigned u) { return __builtin_bit_cast(float, u << 16); }
__device__ __forceinline__ float bfhi(unsigned u) { return __builtin_bit_cast(float, u & 0xffff0000u); }
__device__ __forceinline__ float bf2f(bf16 b) { return __builtin_bit_cast(float, (unsigned)b << 16); }
__device__ __forceinline__ float wave_sum(float v) {
#pragma unroll
    for (int o = 1; o < 64; o <<= 1) v += __shfl_xor(v, o);
    return v;
}
#define LDS_BARRIER() do { asm volatile("s_waitcnt lgkmcnt(0)" ::: "memory"); __builtin_amdgcn_s_barrier(); asm volatile("" ::: "memory"); } while (0)
__device__ __forceinline__ float sigmoidf_(float x) { return __builtin_amdgcn_rcpf(1.f + __expf(-x)); }
__device__ __forceinline__ float siluf_(float x) { return x * __builtin_amdgcn_rcpf(1.f + __expf(-x)); }
__device__ __forceinline__ float softplusf_(float x) { return fmaxf(x, 0.f) + __logf(1.f + __expf(-fabsf(x))); }

#define XB_TMO      128
#define XB_XCNT(j)  (256  + 64 * (j))
#define XB_XSUB(j)  (1280 + 64 * (j))
#define XB_XGEN(j)  (2304 + 64 * (j))
#define XB_TOP      3328
#define XB_TOPGEN   3392
#define XCD_BAR_WORDS 3456
#define XB_SPIN_CAP (1u << 18)
__device__ __forceinline__ unsigned xb_ld(unsigned* p)              { return __hip_atomic_load(p, __ATOMIC_RELAXED, __HIP_MEMORY_SCOPE_AGENT); }
__device__ __forceinline__ unsigned xb_add(unsigned* p, unsigned v) { return __hip_atomic_fetch_add(p, v, __ATOMIC_RELAXED, __HIP_MEMORY_SCOPE_AGENT); }
__device__ __forceinline__ unsigned xb_xcc_id() { return (unsigned)__builtin_amdgcn_s_getreg((3 << 11) | 20) & 0xFu; }
#define XB_SPIN(cond, bar) do { unsigned _sp = 0; while (cond) { __builtin_amdgcn_s_sleep(1); \
    if ((++_sp & 255u) == 0u) { if (xb_ld(&(bar)[XB_TMO])) break; if (_sp > XB_SPIN_CAP) { atomicAdd(&(bar)[XB_TMO], 1u); break; } } } } while (0)
struct XcdBarrier { unsigned* bar; unsigned x; volatile LAS unsigned* st; };
__device__ __forceinline__ XcdBarrier xcd_barrier_post(unsigned* bar, volatile LAS unsigned* st) {
    XcdBarrier b; b.bar = bar; b.x = xb_xcc_id(); b.st = st;
    if (threadIdx.x == 0) (void)xb_add(&bar[XB_XCNT(b.x)], 1u);
    return b;
}
__device__ __forceinline__ void xcd_barrier_complete(unsigned* bar, unsigned x, unsigned& nloc, unsigned& nx) {
    const unsigned G = gridDim.x * gridDim.y * gridDim.z;
    unsigned sum, cnt, mine, sp = 0u;
    for (;;) {
        sum = 0u; cnt = 0u; mine = 0u;
#pragma unroll
        for (unsigned j = 0; j < 16; ++j) { const unsigned c = xb_ld(&bar[XB_XCNT(j)]); sum += c; cnt += (c > 0u) ? 1u : 0u; mine = (j == x) ? c : mine; }
        if (sum == G) break;
        __builtin_amdgcn_s_sleep(1);
        if ((++sp & 255u) == 0u) { if (xb_ld(&bar[XB_TMO])) break; if (sp > XB_SPIN_CAP) { atomicAdd(&bar[XB_TMO], 1u); break; } }
    }
    nloc = mine > 0u ? mine : 1u; nx = cnt > 0u ? cnt : 1u;
}
__device__ __forceinline__ void xcd_barrier(const XcdBarrier& b) {
    asm volatile("s_waitcnt vmcnt(0)" ::: "memory");
    __syncthreads();
    if (threadIdx.x == 0) {
        unsigned* bar = b.bar;
        __builtin_amdgcn_s_waitcnt(0);
        unsigned nloc = b.st[0], nx = b.st[1];
        if (nloc == 0u) { xcd_barrier_complete(bar, b.x, nloc, nx); b.st[0] = nloc; b.st[1] = nx; }
        const unsigned old = xb_add(&bar[XB_XSUB(b.x)], 1u);
        const unsigned gen = old / nloc;
        if (old + 1u == (gen + 1u) * nloc) {
            __builtin_amdgcn_fence(__ATOMIC_RELEASE, "agent");
            asm volatile("s_waitcnt vmcnt(0)" ::: "memory");
            const unsigned og = xb_add(&bar[XB_TOP], 1u);
            const unsigned tg = og / nx;
            if (og + 1u == (tg + 1u) * nx) xb_add(&bar[XB_TOPGEN], 1u);
            else XB_SPIN(xb_ld(&bar[XB_TOPGEN]) == tg, bar);
            __builtin_amdgcn_fence(__ATOMIC_ACQUIRE, "agent");
            xb_add(&bar[XB_XGEN(b.x)], 1u);
            asm volatile("s_waitcnt vmcnt(0)" ::: "memory");
        } else {
            XB_SPIN(xb_ld(&bar[XB_XGEN(b.x)]) == gen, bar);
            __builtin_amdgcn_fence(__ATOMIC_ACQUIRE, "agent");
            asm volatile("s_waitcnt vmcnt(0)" ::: "memory");
        }
    }
    __syncthreads();
}

struct Args { const float* in[22]; float* out; unsigned char* ws; int ph_lo, ph_hi, li, pad; };

struct Frame {
    LAS unsigned char* lds;
    int tid, lane, wave, blk, nblk;
    const float *x, *w_in, *rel_bias, *w_ba, *conv_w, *conv_b, *dt_bias, *a_log, *d_skip, *ssm_norm_w, *w_bs, *gate_bias, *w_out,
                *norm_mix, *norm_ffn, *router_w, *router_b, *w1, *b1, *w2, *b2, *norm_final;
    float* out; unsigned char* ws; gu32* ctl;
};

template <class Epi>
__device__ __forceinline__ void gemm_naive(Frame& F, int nMt, int N, int K, const bf16* A, int lda, const int* rowmap,
                                           const float* B, int ldb, const int* texp, size_t estride, const Epi& epi) {
    LAS float* As = (LAS float*)F.lds;
    LAS float* Bs = As + 16 * 132;
    const int tid = ((int)threadIdx.x), tx = tid & 31, ty = tid >> 5;
    const int nNt = (N + 127) / 128;
    const int ar = tid >> 2, ak = (tid & 3) * 4;
    const int bk = tid >> 5, bn = (tid & 31) * 4;
    for (int tile = F.blk; tile < nMt * nNt; tile += F.nblk) {
        const int mt = tile / nNt, nt = tile % nNt;
        int e = 0;
        if (texp) { e = texp[mt >> 1]; if (e < 0) continue; }
        const float* Bp = B + (size_t)e * estride;
        float acc[8][4];
#pragma unroll
        for (int i = 0; i < 8; ++i)
#pragma unroll
            for (int j = 0; j < 4; ++j) acc[i][j] = 0.f;
        int grow = mt * 128 + ar; if (rowmap) grow = rowmap[grow];
        const bf16* ap = A + (size_t)(grow < 0 ? 0 : grow) * lda + ak;
        const bool aok = grow >= 0;
        const int gcol = nt * 128 + bn;
        const bool bok = gcol < N;
        for (int k0 = 0; k0 < K; k0 += 16) {
            u32x2 av = (u32x2){0u, 0u};
            if (aok) av = *(const u32x2*)(ap + k0);
            f32x4 bv = (f32x4){0.f, 0.f, 0.f, 0.f};
            if (bok) bv = *(const f32x4*)(Bp + (size_t)(k0 + bk) * ldb + gcol);
            __syncthreads();
            As[(ak + 0) * 132 + ar] = bflo(av.x); As[(ak + 1) * 132 + ar] = bfhi(av.x);
            As[(ak + 2) * 132 + ar] = bflo(av.y); As[(ak + 3) * 132 + ar] = bfhi(av.y);
            *(LAS f32x4*)&Bs[bk * 132 + bn] = bv;
            __syncthreads();
#pragma unroll
            for (int k = 0; k < 16; ++k) {
                const f32x4 a0 = *(const LAS f32x4*)&As[k * 132 + ty * 8], a1 = *(const LAS f32x4*)&As[k * 132 + ty * 8 + 4];
                const f32x4 b = *(const LAS f32x4*)&Bs[k * 132 + tx * 4];
                const float a[8] = {a0.x, a0.y, a0.z, a0.w, a1.x, a1.y, a1.z, a1.w};
                const float bb[4] = {b.x, b.y, b.z, b.w};
#pragma unroll
                for (int i = 0; i < 8; ++i)
#pragma unroll
                    for (int j = 0; j < 4; ++j) acc[i][j] = fmaf(a[i], bb[j], acc[i][j]);
            }
        }
        const int col0 = nt * 128 + tx * 4;
        if (col0 < N) {
#pragma unroll
            for (int i = 0; i < 8; ++i) epi(mt * 128 + ty * 8 + i, col0, (f32x4){acc[i][0], acc[i][1], acc[i][2], acc[i][3]}, e);
        }
    }
    __syncthreads();
}

__device__ __forceinline__ void st_bf4(bf16* p, f32x4 v) { u32x2 w; w.x = pk2(v.x, v.y); w.y = pk2(v.z, v.w); *(u32x2*)p = w; }

struct EpiInProj {
    unsigned char* ws; const float* dt_bias; const float* gate_bias;
    __device__ __forceinline__ void operator()(int row, int col, f32x4 v, int) const {
        if (col < C_K)        st_bf4((bf16*)(ws + WS_Q) + (size_t)row * AW + (col - C_Q), v);
        else if (col < C_V)   st_bf4((bf16*)(ws + WS_K) + (size_t)row * AW + (col - C_K), v);
        else if (col < C_Z)   st_bf4((bf16*)(ws + WS_V) + (size_t)row * AW + (col - C_V), v);
        else if (col < C_XBC) st_bf4((bf16*)(ws + WS_Z) + (size_t)row * DI + (col - C_Z), v);
        else if (col < C_DT)  st_bf4((bf16*)(ws + WS_XBC) + (size_t)row * CONVD + (col - C_XBC), v);
        else if (col < C_GATE) { const int c = col - C_DT; f32x4 o;
            o.x = softplusf_(v.x + dt_bias[c]); o.y = softplusf_(v.y + dt_bias[c + 1]); o.z = softplusf_(v.z + dt_bias[c + 2]); o.w = softplusf_(v.w + dt_bias[c + 3]);
            float* dp = (float*)(ws + WS_DT) + row; dp[(size_t)c * T] = o.x; dp[(size_t)(c + 1) * T] = o.y; dp[(size_t)(c + 2) * T] = o.z; dp[(size_t)(c + 3) * T] = o.w; }
        else { const int c = col - C_GATE; f32x4 o;
            o.x = sigmoidf_(v.x + gate_bias[c]); o.y = sigmoidf_(v.y + gate_bias[c + 1]); o.z = sigmoidf_(v.z + gate_bias[c + 2]); o.w = sigmoidf_(v.w + gate_bias[c + 3]);
            st_bf4((bf16*)(ws + WS_GATE) + (size_t)row * 2048 + c, o); }
    }
};
struct EpiM0 {
    unsigned char* ws;
    __device__ __forceinline__ void operator()(int row, int col, f32x4 v, int) const {
        const u32x2 g = *(const u32x2*)((const bf16*)(ws + WS_GATE) + (size_t)row * 2048 + col);
        f32x4 o; o.x = v.x * bflo(g.x); o.y = v.y * bfhi(g.x); o.z = v.z * bflo(g.y); o.w = v.w * bfhi(g.y);
        st_bf4((bf16*)(ws + WS_M0) + (size_t)row * D + col, o);
    }
};
struct EpiMerged {
    unsigned char* ws;
    __device__ __forceinline__ void operator()(int row, int col, f32x4 v, int) const {
        const u32x2 g = *(const u32x2*)((const bf16*)(ws + WS_GATE) + (size_t)row * 2048 + 1024 + col);
        const u32x2 mw = *(const u32x2*)((const bf16*)(ws + WS_M0) + (size_t)row * D + col); const f32x4 m = (f32x4){bflo(mw.x), bfhi(mw.x), bflo(mw.y), bfhi(mw.y)};
        f32x4 o; o.x = m.x + v.x * bflo(g.x); o.y = m.y + v.y * bfhi(g.x); o.z = m.z + v.z * bflo(g.y); o.w = m.w + v.w * bfhi(g.y);
        st_bf4((bf16*)(ws + WS_MERGED) + (size_t)row * D + col, o);
    }
};
struct EpiX1 {
    const float* x; float* out;
    __device__ __forceinline__ void operator()(int row, int col, f32x4 v, int) const {
        const f32x4 xv = *(const f32x4*)(x + (size_t)row * D + col);
        *(f32x4*)(out + (size_t)row * D + col) = xv + v;
    }
};
__device__ __forceinline__ float swiglu_(float g, float l) {
    g = fminf(g, 7.f); l = fminf(fmaxf(l, -7.f), 7.f);
    return g * sigmoidf_(1.702f * g) * (l + 1.f);
}
struct EpiMoe1 {
    unsigned char* ws; const float* b1;
    __device__ __forceinline__ void operator()(int row, int col, f32x4 v, int e) const {
        const f32x4 b = *(const f32x4*)(b1 + (size_t)e * 2048 + col);
        const float o0 = swiglu_(v.x + b.x, v.y + b.y), o1 = swiglu_(v.z + b.z, v.w + b.w);
        *(unsigned*)((bf16*)(ws + WS_ACT) + (size_t)row * 1024 + (col >> 1)) = pk2(o0, o1);
    }
};
struct EpiMoe2 {
    unsigned char* ws; const float* b2;
    __device__ __forceinline__ void operator()(int row, int col, f32x4 v, int e) const {
        const f32x4 b = *(const f32x4*)(b2 + (size_t)e * 1024 + col);
        st_bf4((bf16*)(ws + WS_YB) + (size_t)row * 1024 + col, v + b);
    }
};

namespace pg8 {
typedef short bf16x8 __attribute__((ext_vector_type(8)));
typedef long i64x2 __attribute__((ext_vector_type(2)));
constexpr int BM = 256, BK = 64, HALF = 128, HTB = HALF * BK * 2, STAGE_BYTES = 8 * HTB, NXCD = 8, WGM = 8;
__host__ __device__ __forceinline__ int lds_byte(int r, int c) { const int st = (r >> 4) * 2 + (c >> 5), rr = r & 15, cc = c & 31, ob = rr * 64 + cc * 2; return st * 1024 + (ob ^ (((ob >> 9) & 1) << 5)); }
__host__ __device__ __forceinline__ void stage_rc(int b, int& R, int& C) { const int st = b / 1024, sb = b % 1024, swz = sb ^ (((sb >> 9) & 1) << 5); R = (st >> 1) * 16 + swz / 64; C = (st & 1) * 32 + (swz % 64) / 2; }
__host__ __device__ __forceinline__ int perm32(int rho) { const int n = rho >> 4, i = rho & 15; return 8 * (i >> 2) + 4 * n + (i & 3); }
struct Unit { int pm, pn; };
struct Gemm { const bf16* A; const bf16* Bt; int M, N, K; };
struct StaticOrder {
    int nM, nN, nwg, G, c;
    __host__ __device__ void init(int M, int N, int G_, int c_) { nM = M / BM; nN = N / BM; nwg = nM * nN; G = G_; c = c_; }
    __host__ __device__ bool next(int i, Unit& u) const {
        const long L = (long)i * G + c; if (L >= nwg) return false;
        int wgid = (int)L; { const int q = nwg / NXCD, r = nwg % NXCD, xcd = wgid % NXCD, off = wgid / NXCD; wgid = (xcd < r ? xcd * (q + 1) : r * (q + 1) + (xcd - r) * q) + off; }
        const int nig = WGM * nN, gid = wgid / nig, fm = gid * WGM, gsz = (nM - fm) < WGM ? (nM - fm) : WGM;
        u.pm = fm + ((wgid % nig) % gsz); u.pn = (wgid % nig) / gsz; return true;
    }
    __device__ __forceinline__ void a_ready(const Unit&) const {}
    __device__ __forceinline__ void done(const Unit&) const {}
};
struct MoeOrder {
    int nwg, nN, G, c;
    __device__ void init(int ntile, int nN_, int G_, int c_) { nN = nN_; nwg = ntile * nN_; G = G_; c = c_; }
    __device__ bool next(int i, Unit& u) const { const long L = (long)i * G + c; if (L >= nwg) return false; u.pm = (int)L / nN; u.pn = (int)L % nN; return true; }
    __device__ __forceinline__ void a_ready(const Unit&) const {}
    __device__ __forceinline__ void done(const Unit&) const {}
};
__device__ __forceinline__ unsigned cvt_pk_bf16(float lo, float hi) { unsigned r; asm volatile("v_cvt_pk_bf16_f32 %0, %1, %2" : "=v"(r) : "v"(lo), "v"(hi)); return r; }

template <class Epi, class Sched, bool ALIGN_EPI, bool GATHER, bool EXPERT, bool FP8 = false>
__device__ __forceinline__ void gemm_phase(LAS unsigned char* lds, const Gemm g, const Sched& S, const Epi& E, const int* rowmap, const int* texp, size_t bstride) {
    const int tid = threadIdx.x, wid = __builtin_amdgcn_readfirstlane(tid >> 6), lane = tid & 63, wr = wid >> 2, wc = wid & 3, fr = lane & 15, fq = lane >> 4;
    const int K = g.K, nt = K / BK;
    unsigned voffA[2], voffB[2], voffB1[2]; int RA[2]; unsigned CAb[2];
#pragma unroll
    for (int i = 0; i < 2; ++i) { int R, C; stage_rc(tid * 16 + i * 8192, R, C); const int Rb = Epi::PERM ? ((R & ~31) + perm32(R & 31)) : R;
        voffA[i] = (unsigned)(R * K + C) * 2u; voffB[i] = (unsigned)(Rb * K + C) * 2u; voffB1[i] = voffB[i] + (unsigned)(HALF * K * 2); RA[i] = R; CAb[i] = (unsigned)C * 2u;
        if constexpr (Epi::WIDE) {
            voffB[i] = (unsigned)((64 * (R >> 5) + perm32(R & 31)) * K + C) * 2u; voffB1[i] = (unsigned)((64 * (R >> 5) + 32 + perm32(R & 31)) * K + C) * 2u; } }
    const size_t kstep = (size_t)(BK * 2);
    const size_t hstep = (size_t)HALF * K * 2;
    const size_t tstep = 2 * hstep;
    const size_t ahs = GATHER ? 0 : hstep;
    const unsigned ldsw = (unsigned)wid * 1024u;
    const int aoff = lds_byte(wr * 64 + fr, fq * 8), boff = lds_byte(wc * 32 + fr, fq * 8);
#define PG8_SA(b, h) (((b) * 2 + (h)) * HTB)
#define PG8_SB(b, h) ((4 + (b) * 2 + (h)) * HTB)
#define PG8_STAGE(bufoff, gbase, voff) do { _Pragma("unroll") for (int _i = 0; _i < 2; ++_i) \
        __builtin_amdgcn_global_load_lds((const unsigned*)((const char*)(gbase) + (voff)[_i]), (LAS unsigned*)(lds + (bufoff) + ldsw + _i * 8192), 16, 0, 0); } while (0)
#define PG8_LDA(dst, b, h) do { _Pragma("unroll") for (int m = 0; m < 4; ++m) _Pragma("unroll") for (int k = 0; k < 2; ++k) dst[m][k] = *(const LAS bf16x8*)(lds + PG8_SA(b, h) + aoff + m * 2048 + k * 1024); } while (0)
#define PG8_LDB(dst, b, h) do { _Pragma("unroll") for (int n = 0; n < 2; ++n) _Pragma("unroll") for (int k = 0; k < 2; ++k) dst[n][k] = *(const LAS bf16x8*)(lds + PG8_SB(b, h) + boff + n * 2048 + k * 1024); } while (0)
#define PG8_MMA(ai, bj, At, Bt) do { __builtin_amdgcn_s_setprio(1); _Pragma("unroll") for (int m = 0; m < 4; ++m) _Pragma("unroll") for (int n = 0; n < 2; ++n) _Pragma("unroll") for (int k = 0; k < 2; ++k) { \
        if constexpr (FP8) { const i64x2 b_ = __builtin_bit_cast(i64x2, Bt[n][k]), a_ = __builtin_bit_cast(i64x2, At[m][k]);     \
            acc[ai][bj][m][n] = __builtin_amdgcn_mfma_f32_16x16x32_fp8_fp8(b_[0], a_[0], acc[ai][bj][m][n], 0, 0, 0); acc[ai][bj][m][n] = __builtin_amdgcn_mfma_f32_16x16x32_fp8_fp8(b_[1], a_[1], acc[ai][bj][m][n], 0, 0, 0); } \
        else acc[ai][bj][m][n] = __builtin_amdgcn_mfma_f32_16x16x32_bf16(Bt[n][k], At[m][k], acc[ai][bj][m][n], 0, 0, 0); } __builtin_amdgcn_s_setprio(0); } while (0)
#define PG8_WAIT_V(n) asm volatile("s_waitcnt vmcnt(" #n ")" ::: "memory")
#define PG8_WAIT_L(n) asm volatile("s_waitcnt lgkmcnt(" #n ")" ::: "memory")
#define PG8_BAR __builtin_amdgcn_s_barrier()
#define PG8_SCHED __builtin_amdgcn_sched_barrier(0)
#define PG8_ROWS(u, v) do { _Pragma("unroll") for (int _h = 0; _h < 2; ++_h) _Pragma("unroll") for (int _i = 0; _i < 2; ++_i) { int _r = rowmap[(u).pm * BM + _h * HALF + RA[_i]]; _r = _r < 0 ? 0 : _r; \
        v[_h][_i] = (unsigned)_r * (unsigned)(K * 2) + CAb[_i]; } } while (0)
#define PG8_BPTR(u) ((const char*)g.Bt + (EXPERT ? (size_t)texp[(u).pm] * bstride : (size_t)0) + (size_t)(u).pn * tstep)
#define PG8_APTR(u) ((const char*)g.A + (GATHER ? (size_t)0 : (size_t)(u).pm * tstep))
    Unit cur, nxt; int ui = 0;
    if (!S.next(0, cur)) return;
    f32x4 acc[2][2][4][2];
#pragma unroll
    for (int a = 0; a < 2; ++a)
#pragma unroll
        for (int b = 0; b < 2; ++b)
#pragma unroll
            for (int m = 0; m < 4; ++m)
#pragma unroll
                for (int n = 0; n < 2; ++n) acc[a][b][m][n] = (f32x4){0.f, 0.f, 0.f, 0.f};
    bf16x8 At[4][2], B0[2][2], B1[2][2];
    unsigned cv[2][2], nv[2][2];
    if constexpr (GATHER) { PG8_ROWS(cur, cv); } else { cv[0][0] = voffA[0]; cv[0][1] = voffA[1]; cv[1][0] = voffA[0]; cv[1][1] = voffA[1]; }
#pragma unroll
    for (int h = 0; h < 2; ++h) { nv[h][0] = cv[h][0]; nv[h][1] = cv[h][1]; }
    const char* cA = PG8_APTR(cur); const char* cB = PG8_BPTR(cur);
    S.a_ready(cur);
    PG8_STAGE(PG8_SB(0, 0), cB, voffB); PG8_STAGE(PG8_SB(0, 1), cB, voffB1); PG8_STAGE(PG8_SA(0, 0), cA, cv[0]); PG8_STAGE(PG8_SA(0, 1), cA + ahs, cv[1]);
    if (wr == 1) PG8_BAR;
    PG8_WAIT_V(2); PG8_BAR;
    PG8_STAGE(PG8_SB(1, 0), cB + kstep, voffB); PG8_STAGE(PG8_SA(1, 0), cA + kstep, cv[0]); PG8_STAGE(PG8_SB(1, 1), cB + kstep, voffB1);
    PG8_WAIT_V(6); PG8_BAR;
    for (;;) {
        const bool has_next = S.next(ui + 1, nxt);
        const char* nA = has_next ? PG8_APTR(nxt) : cA; const char* nB = has_next ? PG8_BPTR(nxt) : cB;
        if constexpr (GATHER) { if (has_next) { PG8_ROWS(nxt, nv); } }
        for (int t = 0; t < nt; t += 2) {
            const bool last = (t == nt - 2);
            const char* a1 = cA + (size_t)(t + 1) * kstep;
            const char* a2 = last ? nA : cA + (size_t)(t + 2) * kstep; const char* b2 = last ? nB : cB + (size_t)(t + 2) * kstep;
            const char* a3 = a2 + kstep; const char* b3 = b2 + kstep;
            unsigned s0[2], s1[2];
            s0[0] = last ? nv[0][0] : cv[0][0]; s0[1] = last ? nv[0][1] : cv[0][1]; s1[0] = last ? nv[1][0] : cv[1][0]; s1[1] = last ? nv[1][1] : cv[1][1];
            if (last && has_next) S.a_ready(nxt);
            PG8_LDB(B0, 0, 0); PG8_LDB(B1, 0, 1); PG8_SCHED; PG8_LDA(At, 0, 0); PG8_STAGE(PG8_SA(1, 1), a1 + ahs, cv[1]);
            PG8_WAIT_V(8); PG8_WAIT_L(0); PG8_BAR; PG8_MMA(0, 0, At, B0); PG8_MMA(0, 1, At, B1); PG8_BAR; PG8_SCHED;
            PG8_LDA(At, 0, 1); PG8_STAGE(PG8_SB(0, 0), b2, voffB); PG8_STAGE(PG8_SB(0, 1), b2, voffB1); PG8_STAGE(PG8_SA(0, 0), a2, s0);
            PG8_WAIT_V(8); PG8_WAIT_L(0); PG8_BAR; PG8_MMA(1, 0, At, B0); PG8_MMA(1, 1, At, B1); PG8_BAR; PG8_SCHED;
            PG8_LDB(B0, 1, 0); PG8_LDB(B1, 1, 1); PG8_SCHED; PG8_LDA(At, 1, 0); PG8_STAGE(PG8_SA(0, 1), a2 + ahs, s1);
            PG8_WAIT_V(8); PG8_WAIT_L(0); PG8_BAR; PG8_MMA(0, 0, At, B0); PG8_MMA(0, 1, At, B1); PG8_BAR; PG8_SCHED;
            PG8_LDA(At, 1, 1); PG8_STAGE(PG8_SB(1, 0), b3, voffB); PG8_STAGE(PG8_SB(1, 1), b3, voffB1); PG8_STAGE(PG8_SA(1, 0), a3, s0);
            PG8_WAIT_V(8); PG8_WAIT_L(0); PG8_BAR; PG8_MMA(1, 0, At, B0); PG8_MMA(1, 1, At, B1); PG8_BAR; PG8_SCHED;
        }
        if constexpr (ALIGN_EPI) { if (wr == 0) PG8_BAR; }
        E(acc, cur, wr, wc, fr, fq); S.done(cur);
        if (!has_next) break;
#pragma unroll
        for (int a = 0; a < 2; ++a)
#pragma unroll
            for (int b = 0; b < 2; ++b)
#pragma unroll
                for (int m = 0; m < 4; ++m)
#pragma unroll
                    for (int n = 0; n < 2; ++n) acc[a][b][m][n] = (f32x4){0.f, 0.f, 0.f, 0.f};
        cur = nxt; cA = nA; cB = nB; ++ui;
#pragma unroll
        for (int h = 0; h < 2; ++h) { cv[h][0] = nv[h][0]; cv[h][1] = nv[h][1]; }
        if constexpr (ALIGN_EPI) { if (wr == 1) PG8_BAR; }
    }
    PG8_WAIT_V(0);
    if constexpr (!ALIGN_EPI) { if (wr == 0) PG8_BAR; }
    PG8_BAR;
#undef PG8_SA
#undef PG8_SB
#undef PG8_STAGE
#undef PG8_LDA
#undef PG8_LDB
#undef PG8_MMA
#undef PG8_WAIT_V
#undef PG8_WAIT_L
#undef PG8_BAR
#undef PG8_SCHED
#undef PG8_ROWS
#undef PG8_BPTR
#undef PG8_APTR
}

struct EpiInProjF {
    static constexpr bool PERM = true, WIDE = true;
    unsigned char* ws; const float* dt_bias; const float* gate_bias; int pm_mask; float ds; int pn_off;
    __device__ __forceinline__ void operator()(const f32x4 (&acc)[2][2][4][2], const Unit& u, int wr, int wc, int fr, int fq) const {
        const int pn = u.pn + pn_off, row0 = (u.pm & pm_mask) * BM + wr * 64 + fr, c8 = wc * 64 + 8 * fq;
        if (pn < 46) {
            bf16* base; int ldc, ct; const bool gate = pn >= 38;
            if (pn < 6) { base = (bf16*)(ws + WS_Q); ldc = AW; ct = pn * 256; }
            else if (pn < 12) { base = (bf16*)(ws + WS_K); ldc = AW; ct = (pn - 6) * 256; }
            else if (pn < 18) { base = (bf16*)(ws + WS_V); ldc = AW; ct = (pn - 12) * 256; }
            else if (pn < 26) { base = (bf16*)(ws + WS_Z); ldc = DI; ct = (pn - 18) * 256; }
            else if (pn < 38) { base = (bf16*)(ws + WS_XBC); ldc = CONVD; ct = (pn - 26) * 256; }
            else { base = (bf16*)(ws + WS_GATE); ldc = 2048; ct = (pn - 38) * 256; }
#if QKV_STORE_FP8
            if (pn < 18) {
                unsigned char* qb8 = ws + (pn < 6 ? WS_Q : (pn < 12 ? WS_K : WS_V));
#pragma unroll
                for (int ai = 0; ai < 2; ++ai)
#pragma unroll
                    for (int m = 0; m < 4; ++m) { unsigned char* rowp = qb8 + (size_t)(row0 + ai * HALF + m * 16) * AW + ct + c8;
#pragma unroll
                        for (int bj = 0; bj < 2; ++bj) { const f32x4 v0 = acc[ai][bj][m][0] * (ds * FP8_ASCALE), v1 = acc[ai][bj][m][1] * (ds * FP8_ASCALE);
                            u32x2 w; w.x = pk_fp8x4(v0.x, v0.y, v0.z, v0.w); w.y = pk_fp8x4(v1.x, v1.y, v1.z, v1.w);
                            __builtin_nontemporal_store(w, (u32x2*)(rowp + bj * 32)); } }
                return;
            }
#endif
            f32x4 gb[2][2];
#pragma unroll
            for (int bj = 0; bj < 2; ++bj)
#pragma unroll
                for (int n = 0; n < 2; ++n) gb[bj][n] = gate ? *(const f32x4*)(gate_bias + ct + c8 + bj * 32 + 4 * n) : (f32x4){0.f, 0.f, 0.f, 0.f};
            const int hi8 = fr >> 3;
#pragma unroll
            for (int ai = 0; ai < 2; ++ai)
#pragma unroll
                for (int m = 0; m < 4; ++m) { bf16* rowp = base + (size_t)(row0 - fr + (fr & 7) + ai * HALF + m * 16) * ldc + ct + wc * 64 + 32 * hi8 + 8 * fq;
                    u32x4 w[2];
#pragma unroll
                    for (int bj = 0; bj < 2; ++bj) { f32x4 v0 = acc[ai][bj][m][0] * ds, v1 = acc[ai][bj][m][1] * ds;
                        if (gate) { v0 = v0 + gb[bj][0]; v1 = v1 + gb[bj][1];
                            v0 = (f32x4){sigmoidf_(v0.x), sigmoidf_(v0.y), sigmoidf_(v0.z), sigmoidf_(v0.w)}; v1 = (f32x4){sigmoidf_(v1.x), sigmoidf_(v1.y), sigmoidf_(v1.z), sigmoidf_(v1.w)}; }
                        w[bj].x = cvt_pk_bf16(v0.x, v0.y); w[bj].y = cvt_pk_bf16(v0.z, v0.w); w[bj].z = cvt_pk_bf16(v1.x, v1.y); w[bj].w = cvt_pk_bf16(v1.z, v1.w); }
                    const u32x4 snd = hi8 ? w[0] : w[1]; u32x4 rcv;
                    rcv.x = (unsigned)__builtin_amdgcn_update_dpp(0, (int)snd.x, 0x128, 0xf, 0xf, false); rcv.y = (unsigned)__builtin_amdgcn_update_dpp(0, (int)snd.y, 0x128, 0xf, 0xf, false);
                    rcv.z = (unsigned)__builtin_amdgcn_update_dpp(0, (int)snd.z, 0x128, 0xf, 0xf, false); rcv.w = (unsigned)__builtin_amdgcn_update_dpp(0, (int)snd.w, 0x128, 0xf, 0xf, false);
                    const u32x4 p0 = hi8 ? rcv : w[0], p1 = hi8 ? w[1] : rcv;
                    __builtin_nontemporal_store(p0, (u32x4*)rowp); __builtin_nontemporal_store(p1, (u32x4*)(rowp + (size_t)8 * ldc)); }
        } else if (wc == 0) {
            const f32x4 b0 = *(const f32x4*)(dt_bias + c8), b1 = *(const f32x4*)(dt_bias + c8 + 4);
#pragma unroll
            for (int ai = 0; ai < 2; ++ai)
#pragma unroll
                for (int m = 0; m < 4; ++m) { float* dp = (float*)(ws + WS_DT) + (size_t)c8 * T + (row0 + ai * HALF + m * 16);
                    const f32x4 v0 = acc[ai][0][m][0] * ds + b0, v1 = acc[ai][0][m][1] * ds + b1;
                    dp[0] = softplusf_(v0.x); dp[(size_t)T] = softplusf_(v0.y); dp[(size_t)2 * T] = softplusf_(v0.z); dp[(size_t)3 * T] = softplusf_(v0.w);
                    dp[(size_t)4 * T] = softplusf_(v1.x); dp[(size_t)5 * T] = softplusf_(v1.y); dp[(size_t)6 * T] = softplusf_(v1.z); dp[(size_t)7 * T] = softplusf_(v1.w); }
        }
    }
};
struct EpiNullF {
    static constexpr bool PERM = true, WIDE = false;
    __device__ __forceinline__ void operator()(const f32x4 (&acc)[2][2][4][2], const Unit&, int, int, int, int) const {
#pragma unroll
        for (int ai = 0; ai < 2; ++ai)
#pragma unroll
            for (int m = 0; m < 4; ++m)
#pragma unroll
                for (int bj = 0; bj < 2; ++bj)
#pragma unroll
                    for (int n = 0; n < 2; ++n) asm volatile("" :: "v"(acc[ai][bj][m][n]));
    }
};
struct EpiM0F {
    static constexpr bool PERM = true, WIDE = false;
    unsigned char* ws;
    __device__ __forceinline__ void operator()(const f32x4 (&acc)[2][2][4][2], const Unit& u, int wr, int wc, int fr, int fq) const {
        const int row0 = u.pm * BM + wr * 64 + fr, col0 = u.pn * BM + wc * 32 + 8 * fq;
#pragma unroll
        for (int ai = 0; ai < 2; ++ai)
#pragma unroll
            for (int m = 0; m < 4; ++m) { const size_t r = (size_t)(row0 + ai * HALF + m * 16);
#pragma unroll
                for (int bj = 0; bj < 2; ++bj) { const int c = col0 + bj * HALF;
                    const u32x4 gg = *(const u32x4*)((const bf16*)(ws + WS_GATE) + r * 2048 + c);
                    const f32x4 v0 = acc[ai][bj][m][0], v1 = acc[ai][bj][m][1];
                    u32x4 w; w.x = cvt_pk_bf16(v0.x * bflo(gg.x), v0.y * bfhi(gg.x)); w.y = cvt_pk_bf16(v0.z * bflo(gg.y), v0.w * bfhi(gg.y));
                    w.z = cvt_pk_bf16(v1.x * bflo(gg.z), v1.y * bfhi(gg.z)); w.w = cvt_pk_bf16(v1.z * bflo(gg.w), v1.w * bfhi(gg.w));
                    *(u32x4*)((bf16*)(ws + WS_M0) + r * D + c) = w; } }
    }
};
struct EpiMergedF {
    static constexpr bool PERM = true, WIDE = false;
    unsigned char* ws;
    __device__ __forceinline__ void operator()(const f32x4 (&acc)[2][2][4][2], const Unit& u, int wr, int wc, int fr, int fq) const {
        const int row0 = u.pm * BM + wr * 64 + fr, col0 = u.pn * BM + wc * 32 + 8 * fq;
#pragma unroll
        for (int ai = 0; ai < 2; ++ai)
#pragma unroll
            for (int m = 0; m < 4; ++m) { const size_t r = (size_t)(row0 + ai * HALF + m * 16);
#pragma unroll
                for (int bj = 0; bj < 2; ++bj) { const int c = col0 + bj * HALF;
                    const u32x4 gg = *(const u32x4*)((const bf16*)(ws + WS_GATE) + r * 2048 + 1024 + c);
                    const u32x4 mm = *(const u32x4*)((const bf16*)(ws + WS_M0) + r * D + c);
                    const f32x4 m0 = (f32x4){bflo(mm.x), bfhi(mm.x), bflo(mm.y), bfhi(mm.y)}, m1 = (f32x4){bflo(mm.z), bfhi(mm.z), bflo(mm.w), bfhi(mm.w)};
                    const f32x4 v0 = acc[ai][bj][m][0], v1 = acc[ai][bj][m][1];
                    u32x4 w; w.x = cvt_pk_bf16(m0.x + v0.x * bflo(gg.x), m0.y + v0.y * bfhi(gg.x)); w.y = cvt_pk_bf16(m0.z + v0.z * bflo(gg.y), m0.w + v0.w * bfhi(gg.y));
                    w.z = cvt_pk_bf16(m1.x + v1.x * bflo(gg.z), m1.y + v1.y * bfhi(gg.z)); w.w = cvt_pk_bf16(m1.z + v1.z * bflo(gg.w), m1.w + v1.w * bfhi(gg.w));
                    *(u32x4*)((bf16*)(ws + WS_MERGED) + r * D + c) = w; } }
    }
};
struct EpiX1F {
    static constexpr bool PERM = false, WIDE = false;
    const float* x; float* out;
    __device__ __forceinline__ void operator()(const f32x4 (&acc)[2][2][4][2], const Unit& u, int wr, int wc, int fr, int fq) const {
        const int row0 = u.pm * BM + wr * 64 + fr, col0 = u.pn * BM + wc * 32 + 4 * fq;
#pragma unroll
        for (int ai = 0; ai < 2; ++ai)
#pragma unroll
            for (int m = 0; m < 4; ++m) { const size_t r = (size_t)(row0 + ai * HALF + m * 16);
#pragma unroll
                for (int bj = 0; bj < 2; ++bj)
#pragma unroll
                    for (int n = 0; n < 2; ++n) { const int c = col0 + bj * HALF + n * 16;
                        *(f32x4*)(out + r * D + c) = *(const f32x4*)(x + r * D + c) + acc[ai][bj][m][n]; } }
    }
};
struct EpiMoe1F {
    static constexpr bool PERM = true, WIDE = false;
    unsigned char* ws; const float* b1; const int* texp;
    __device__ __forceinline__ void operator()(const f32x4 (&acc)[2][2][4][2], const Unit& u, int wr, int wc, int fr, int fq) const {
        const int e = texp[u.pm];
        const int row0 = u.pm * BM + wr * 64 + fr, col0 = u.pn * BM + wc * 32 + 8 * fq;
        f32x4 bv[2][2];
#pragma unroll
        for (int bj = 0; bj < 2; ++bj)
#pragma unroll
            for (int n = 0; n < 2; ++n) bv[bj][n] = *(const f32x4*)(b1 + (size_t)e * 2048 + col0 + bj * HALF + 4 * n);
#pragma unroll
        for (int ai = 0; ai < 2; ++ai)
#pragma unroll
            for (int m = 0; m < 4; ++m) { const size_t r = (size_t)(row0 + ai * HALF + m * 16);
#pragma unroll
                for (int bj = 0; bj < 2; ++bj) { const f32x4 v0 = acc[ai][bj][m][0] + bv[bj][0], v1 = acc[ai][bj][m][1] + bv[bj][1];
                    u32x2 w; w.x = cvt_pk_bf16(swiglu_(v0.x, v0.y), swiglu_(v0.z, v0.w)); w.y = cvt_pk_bf16(swiglu_(v1.x, v1.y), swiglu_(v1.z, v1.w));
                    __builtin_nontemporal_store(w, (u32x2*)((bf16*)(ws + WS_ACT) + r * 1024 + ((col0 + bj * HALF) >> 1))); } }
    }
};
struct EpiMoe1Q {
    static constexpr bool PERM = true, WIDE = false;
    unsigned char* ws; const float* b1; const int* texp;
    __device__ __forceinline__ void operator()(const f32x4 (&acc)[2][2][4][2], const Unit& u, int wr, int wc, int fr, int fq) const {
        const int e = texp[u.pm];
        const int row0 = u.pm * BM + wr * 64 + fr, col0 = u.pn * BM + wc * 32 + 8 * fq;
        constexpr float DS = 1.f / (FP8_ASCALE * FP8_WSCALE);
        f32x4 bv[2][2];
#pragma unroll
        for (int bj = 0; bj < 2; ++bj)
#pragma unroll
            for (int n = 0; n < 2; ++n) bv[bj][n] = *(const f32x4*)(b1 + (size_t)e * 2048 + col0 + bj * HALF + 4 * n);
#pragma unroll
        for (int ai = 0; ai < 2; ++ai)
#pragma unroll
            for (int m = 0; m < 4; ++m) { const size_t r = (size_t)(row0 + ai * HALF + m * 16);
#pragma unroll
                for (int bj = 0; bj < 2; ++bj) { const f32x4 v0 = acc[ai][bj][m][0] * DS + bv[bj][0], v1 = acc[ai][bj][m][1] * DS + bv[bj][1];
                    const unsigned w = pk_fp8x4(FP8_ASCALE * swiglu_(v0.x, v0.y), FP8_ASCALE * swiglu_(v0.z, v0.w), FP8_ASCALE * swiglu_(v1.x, v1.y), FP8_ASCALE * swiglu_(v1.z, v1.w));
                    __builtin_nontemporal_store(w, (unsigned*)(ws + WS_ACT + r * 1024 + ((col0 + bj * HALF) >> 1))); } }
    }
};
struct EpiMoe2Q {
    static constexpr bool PERM = true, WIDE = false;
    unsigned char* ws; const float* b2; const int* texp;
    __device__ __forceinline__ void operator()(const f32x4 (&acc)[2][2][4][2], const Unit& u, int wr, int wc, int fr, int fq) const {
        const int e = texp[u.pm];
        const int row0 = u.pm * BM + wr * 64 + fr, col0 = u.pn * BM + wc * 32 + 8 * fq;
        constexpr float DS = 1.f / (FP8_ASCALE * FP8_WSCALE);
        f32x4 bv[2][2];
#pragma unroll
        for (int bj = 0; bj < 2; ++bj)
#pragma unroll
            for (int n = 0; n < 2; ++n) bv[bj][n] = *(const f32x4*)(b2 + (size_t)e * 1024 + col0 + bj * HALF + 4 * n);
#pragma unroll
        for (int ai = 0; ai < 2; ++ai)
#pragma unroll
            for (int m = 0; m < 4; ++m) { const size_t r = (size_t)(row0 + ai * HALF + m * 16);
#pragma unroll
                for (int bj = 0; bj < 2; ++bj) { const f32x4 v0 = acc[ai][bj][m][0] * DS + bv[bj][0], v1 = acc[ai][bj][m][1] * DS + bv[bj][1];
                    u32x4 w; w.x = cvt_pk_bf16(v0.x, v0.y); w.y = cvt_pk_bf16(v0.z, v0.w); w.z = cvt_pk_bf16(v1.x, v1.y); w.w = cvt_pk_bf16(v1.z, v1.w);
                    __builtin_nontemporal_store(w, (u32x4*)((bf16*)(ws + WS_YB) + r * 1024 + col0 + bj * HALF)); } }
    }
};
struct EpiMoe2F {
    static constexpr bool PERM = true, WIDE = false;
    unsigned char* ws; const float* b2; const int* texp;
    __device__ __forceinline__ void operator()(const f32x4 (&acc)[2][2][4][2], const Unit& u, int wr, int wc, int fr, int fq) const {
        const int e = texp[u.pm];
        const int row0 = u.pm * BM + wr * 64 + fr, col0 = u.pn * BM + wc * 32 + 8 * fq;
        f32x4 bv[2][2];
#pragma unroll
        for (int bj = 0; bj < 2; ++bj)
#pragma unroll
            for (int n = 0; n < 2; ++n) bv[bj][n] = *(const f32x4*)(b2 + (size_t)e * 1024 + col0 + bj * HALF + 4 * n);
#pragma unroll
        for (int ai = 0; ai < 2; ++ai)
#pragma unroll
            for (int m = 0; m < 4; ++m) { const size_t r = (size_t)(row0 + ai * HALF + m * 16);
#pragma unroll
                for (int bj = 0; bj < 2; ++bj) { const f32x4 v0 = acc[ai][bj][m][0] + bv[bj][0], v1 = acc[ai][bj][m][1] + bv[bj][1];
                    u32x4 w; w.x = cvt_pk_bf16(v0.x, v0.y); w.y = cvt_pk_bf16(v0.z, v0.w); w.z = cvt_pk_bf16(v1.x, v1.y); w.w = cvt_pk_bf16(v1.z, v1.w);
                    __builtin_nontemporal_store(w, (u32x4*)((bf16*)(ws + WS_YB) + r * 1024 + col0 + bj * HALF)); } }
    }
};
}

__device__ __forceinline__ int t5_bucket_dev(int dist) {
    if (dist < 16) return dist;
    int l = 16 + (int)(logf((float)dist / 16.f) / logf(128.f) * 16.f);
    return l < 31 ? l : 31;
}
__device__ __forceinline__ void transpose_item(const float* W, int K, int N, bf16* WT, int k0, int n0, int drow0, LAS float* scr, int lane) {
#pragma unroll 8
    for (int i = 0; i < 32; ++i) { const int kk = 2 * i + (lane >> 5); scr[kk * 33 + (lane & 31)] = __builtin_nontemporal_load(W + (size_t)(k0 + kk) * N + n0 + (lane & 31)); }
    asm volatile("s_waitcnt lgkmcnt(0)" ::: "memory");
    const int c = lane & 7;
#pragma unroll
    for (int j = 0; j < 4; ++j) { const int n = (lane >> 3) + 8 * j; const LAS float* s = scr + (8 * c) * 33 + n;
        u32x4 o; o.x = pk2(s[0 * 33], s[1 * 33]); o.y = pk2(s[2 * 33], s[3 * 33]); o.z = pk2(s[4 * 33], s[5 * 33]); o.w = pk2(s[6 * 33], s[7 * 33]);
        *(u32x4*)(WT + (size_t)(drow0 + n) * K + k0 + 8 * c) = o; }
    asm volatile("s_waitcnt lgkmcnt(0)" ::: "memory");
}
__device__ __forceinline__ void transpose_item_fp8(const float* W, int K, int N, unsigned char* WT, int k0, int n0, int drow0, float scale, LAS float* scr, int lane) {
#pragma unroll 8
    for (int i = 0; i < 64; ++i) { const int kk = 2 * i + (lane >> 5); scr[kk * 33 + (lane & 31)] = __builtin_nontemporal_load(W + (size_t)(k0 + kk) * N + n0 + (lane & 31)) * scale; }
    asm volatile("s_waitcnt lgkmcnt(0)" ::: "memory");
    const int c = lane & 7;
#pragma unroll
    for (int j = 0; j < 4; ++j) { const int n = (lane >> 3) + 8 * j; const LAS float* s = scr + (16 * c) * 33 + n;
        u32x4 o; o.x = pk_fp8x4(s[0 * 33], s[1 * 33], s[2 * 33], s[3 * 33]); o.y = pk_fp8x4(s[4 * 33], s[5 * 33], s[6 * 33], s[7 * 33]);
        o.z = pk_fp8x4(s[8 * 33], s[9 * 33], s[10 * 33], s[11 * 33]); o.w = pk_fp8x4(s[12 * 33], s[13 * 33], s[14 * 33], s[15 * 33]);
        *(u32x4*)(WT + (size_t)(drow0 + n) * K + k0 + 16 * c) = o; }
    asm volatile("s_waitcnt lgkmcnt(0)" ::: "memory");
}
__device__ __forceinline__ int inproj_row_of_col(int n0) { return n0 < C_DT ? n0 : (n0 < C_GATE ? n0 - C_DT + 11776 : n0 - 32); }
__device__ __forceinline__ void p_convert_small(Frame& F) {
    LAS float* scr = (LAS float*)(F.lds + F.wave * 16896);
    const int gw = F.blk * NWAVES + F.wave, NGW = F.nblk * NWAVES;
    constexpr int NBQ = QKV_FP8 ? C_Z / 32 : 0;
    constexpr int I_INQ = 8 * NBQ, I_IN = 16 * (NPROJ / 32 - NBQ), I_BA = 8 * 32, I_BS = 32 * 32, I_OUT = 16 * 32, NIT = I_INQ + I_IN + I_BA + I_BS + I_OUT;
    for (int it = gw; it < NIT; it += NGW) {
        int r = it;
        if (r < I_INQ) { const int nb = r % (NBQ ? NBQ : 1), kb = r / (NBQ ? NBQ : 1); transpose_item_fp8(F.w_in, D, NPROJ, F.ws + WS_WQKVQ, 128 * kb, 32 * nb, 32 * nb, FP8_WSCALE, scr, ((int)(threadIdx.x & 63u))); continue; } r -= I_INQ;
        if (r < I_IN) { const int nb = NBQ + r % (NPROJ / 32 - NBQ), kb = r / (NPROJ / 32 - NBQ); transpose_item(F.w_in, D, NPROJ, (bf16*)(F.ws + WS_WIN_T), 64 * kb, 32 * nb, inproj_row_of_col(32 * nb), scr, ((int)(threadIdx.x & 63u))); continue; } r -= I_IN;
        if (r < I_BA) { const int nb = r % 32, kb = r / 32; transpose_item(F.w_ba, 512, D, (bf16*)(F.ws + WS_WBA_T), 64 * kb, 32 * nb, 32 * nb, scr, ((int)(threadIdx.x & 63u))); continue; } r -= I_BA;
        if (r < I_BS) { const int nb = r % 32, kb = r / 32; transpose_item(F.w_bs, DI, D, (bf16*)(F.ws + WS_WBS_T), 64 * kb, 32 * nb, 32 * nb, scr, ((int)(threadIdx.x & 63u))); continue; } r -= I_BS;
        { const int nb = r % 32, kb = r / 32; transpose_item(F.w_out, D, D, (bf16*)(F.ws + WS_WOUT_T), 64 * kb, 32 * nb, 32 * nb, scr, ((int)(threadIdx.x & 63u))); }
    }
    for (int i = F.blk * NTHREADS + ((int)threadIdx.x); i < 24 * 192; i += F.nblk * NTHREADS) { const int head = i / 192, dl = i % 192 - 32, g = head >> 3, dil = g == 0 ? 1 : (g == 1 ? 4 : 16);
        ((float*)(F.ws + WS_BT))[i] = F.rel_bias[t5_bucket_dev((dl < 0 ? 0 : (dl > 128 ? 128 : dl)) * dil) * 24 + head] * 1.4426950408889634f; }
    for (int i = F.blk * NTHREADS + ((int)threadIdx.x); i < 32 * 1024; i += F.nblk * NTHREADS) ((float*)(F.ws + WS_WRT))[i] = F.norm_ffn[i >> 5] * F.router_w[i];
    u32x4* z = (u32x4*)((bf16*)(F.ws + WS_WIN_T) + (size_t)11808 * D);
    for (int i = F.blk * NTHREADS + ((int)threadIdx.x); i < 224 * D * 2 / 16; i += F.nblk * NTHREADS) z[i] = (u32x4){0u, 0u, 0u, 0u};
}
__device__ __forceinline__ void p_convert_moe_fp8(Frame& F) {
    LAS float* scr = (LAS float*)(F.lds + F.wave * 16896);
    const int gw = F.blk * NWAVES + F.wave, NGW = F.nblk * NWAVES;
    constexpr int I_1 = 8 * 64, I_2 = 8 * 32, NIT = NEXP * (I_1 + I_2);
    for (int it = gw; it < NIT; it += NGW) {
        const int e = it / (I_1 + I_2); int r = it % (I_1 + I_2);
        if (r < I_1) { const int nb = r % 64, kb = r / 64; transpose_item_fp8(F.w1 + (size_t)e * 1024 * 2048, 1024, 2048, F.ws + WS_W1T + (size_t)e * 2048 * 1024, 128 * kb, 32 * nb, 32 * nb, FP8_WSCALE, scr, ((int)(threadIdx.x & 63u))); }
        else { r -= I_1; const int nb = r % 32, kb = r / 32; transpose_item_fp8(F.w2 + (size_t)e * 1024 * 1024, 1024, 1024, F.ws + WS_W2T + (size_t)e * 1024 * 1024, 128 * kb, 32 * nb, 32 * nb, FP8_WSCALE, scr, ((int)(threadIdx.x & 63u))); }
    }
}
__device__ __forceinline__ void p_convert_moe(Frame& F) {
    LAS float* scr = (LAS float*)(F.lds + F.wave * 16384);
    const int gw = F.blk * NWAVES + F.wave, NGW = F.nblk * NWAVES;
    constexpr int I_1 = 16 * 64, I_2 = 16 * 32, NIT = NEXP * (I_1 + I_2);
    for (int it = gw; it < NIT; it += NGW) {
        const int e = it / (I_1 + I_2); int r = it % (I_1 + I_2);
        if (r < I_1) { const int nb = r % 64, kb = r / 64; transpose_item(F.w1 + (size_t)e * 1024 * 2048, 1024, 2048, (bf16*)(F.ws + WS_W1T) + (size_t)e * 2048 * 1024, 64 * kb, 32 * nb, 32 * nb, scr, ((int)(threadIdx.x & 63u))); }
        else { r -= I_1; const int nb = r % 32, kb = r / 32; transpose_item(F.w2 + (size_t)e * 1024 * 1024, 1024, 1024, (bf16*)(F.ws + WS_W2T) + (size_t)e * 1024 * 1024, 64 * kb, 32 * nb, 32 * nb, scr, ((int)(threadIdx.x & 63u))); }
    }
}

__device__ __forceinline__ void p_rmsnorm_in(Frame& F) {
    const int gw = F.blk * NWAVES + F.wave, NGW = F.nblk * NWAVES;
    bf16* XN = (bf16*)(F.ws + WS_XN);
    for (int m = gw; m < T; m += NGW) {
        const f32x4* xr = (const f32x4*)(F.x + (size_t)m * D) + ((int)(threadIdx.x & 63u));
        const f32x4* wr = (const f32x4*)F.norm_mix + ((int)(threadIdx.x & 63u));
        f32x4 v[4]; float s = 0.f;
#pragma unroll
        for (int j = 0; j < 4; ++j) { v[j] = __builtin_nontemporal_load(xr + 64 * j); s += (v[j].x * v[j].x + v[j].y * v[j].y) + (v[j].z * v[j].z + v[j].w * v[j].w); }
        const float rstd = __builtin_amdgcn_rsqf(wave_sum(s) * (1.f / D) + EPS);
#pragma unroll
        for (int j = 0; j < 4; ++j) { const f32x4 w = wr[64 * j]; const f32x4 o = v[j] * rstd * w; st_bf4(XN + (size_t)m * D + (((int)(threadIdx.x & 63u)) + 64 * j) * 4, o);
#if QKV_FP8
            *(unsigned*)(F.ws + WS_XNQ + (size_t)m * D + (((int)(threadIdx.x & 63u)) + 64 * j) * 4) = pk_fp8x4(FP8_ASCALE * o.x, FP8_ASCALE * o.y, FP8_ASCALE * o.z, FP8_ASCALE * o.w);
#endif
        }
    }
}

__device__ __forceinline__ void p_attn_naive(Frame& F) {
    LAS float* btab = (LAS float*)F.lds;
    for (int i = ((int)threadIdx.x); i < 3 * 129 * 8; i += NTHREADS) {
        const int g = i / (129 * 8), j = (i >> 3) % 129, hg = i & 7;
        const int dil = g == 0 ? 1 : (g == 1 ? 4 : 16);
        btab[i] = F.rel_bias[t5_bucket_dev(j * dil) * 24 + g * 8 + hg];
    }
    __syncthreads();
    const bf16* Qb = (const bf16*)(F.ws + WS_Q); const bf16* Kb = (const bf16*)(F.ws + WS_K); const bf16* Vb = (const bf16*)(F.ws + WS_V);
    bf16* AT = (bf16*)(F.ws + WS_ATTN);
    for (int idx = F.blk * NTHREADS + ((int)threadIdx.x); idx < T * 8; idx += F.nblk * NTHREADS) {
        const int hg = idx & 7, row = idx >> 3, t = row & (SEQ - 1);
        float m = -INFINITY, den = 0.f;
        float acc[64];
#pragma unroll
        for (int i = 0; i < 64; ++i) acc[i] = 0.f;
        for (int g = 0; g < 3; ++g) {
            const int dil = g == 0 ? 1 : (g == 1 ? 4 : 16);
            const int head = g * 8 + hg;
            float q[64];
            { const u32x4* qp = (const u32x4*)(Qb + (size_t)row * AW + head * 64);
#pragma unroll
              for (int c = 0; c < 8; ++c) { const u32x4 w = qp[c]; q[8 * c + 0] = bflo(w.x); q[8 * c + 1] = bfhi(w.x); q[8 * c + 2] = bflo(w.y); q[8 * c + 3] = bfhi(w.y);
                  q[8 * c + 4] = bflo(w.z); q[8 * c + 5] = bfhi(w.z); q[8 * c + 6] = bflo(w.w); q[8 * c + 7] = bfhi(w.w); } }
            for (int j = 0; j <= 128; ++j) {
                const int kt = t - j * dil; if (kt < 0) break;
                const size_t krow = (size_t)(row - j * dil);
                const u32x4* kp = (const u32x4*)(Kb + krow * AW + head * 64);
                float s = 0.f;
#pragma unroll
                for (int c = 0; c < 8; ++c) { const u32x4 w = kp[c];
                    s += q[8 * c + 0] * bflo(w.x) + q[8 * c + 1] * bfhi(w.x) + q[8 * c + 2] * bflo(w.y) + q[8 * c + 3] * bfhi(w.y)
                       + q[8 * c + 4] * bflo(w.z) + q[8 * c + 5] * bfhi(w.z) + q[8 * c + 6] * bflo(w.w) + q[8 * c + 7] * bfhi(w.w); }
                s = s * 0.125f + btab[(g * 129 + j) * 8 + hg];
                const float mn = fmaxf(m, s), sc = __expf(m - mn), p = __expf(s - mn);
                m = mn; den = den * sc + p;
                const u32x4* vp = (const u32x4*)(Vb + krow * AW + head * 64);
#pragma unroll
                for (int c = 0; c < 8; ++c) { const u32x4 w = vp[c];
                    acc[8 * c + 0] = acc[8 * c + 0] * sc + p * bflo(w.x); acc[8 * c + 1] = acc[8 * c + 1] * sc + p * bfhi(w.x);
                    acc[8 * c + 2] = acc[8 * c + 2] * sc + p * bflo(w.y); acc[8 * c + 3] = acc[8 * c + 3] * sc + p * bfhi(w.y);
                    acc[8 * c + 4] = acc[8 * c + 4] * sc + p * bflo(w.z); acc[8 * c + 5] = acc[8 * c + 5] * sc + p * bfhi(w.z);
                    acc[8 * c + 6] = acc[8 * c + 6] * sc + p * bflo(w.w); acc[8 * c + 7] = acc[8 * c + 7] * sc + p * bfhi(w.w); }
            }
        }
        const float inv = 1.f / den;
        u32x4* op = (u32x4*)(AT + (size_t)row * 512 + hg * 64);
#pragma unroll
        for (int c = 0; c < 8; ++c) { u32x4 w; w.x = pk2(acc[8 * c] * inv, acc[8 * c + 1] * inv); w.y = pk2(acc[8 * c + 2] * inv, acc[8 * c + 3] * inv);
            w.z = pk2(acc[8 * c + 4] * inv, acc[8 * c + 5] * inv); w.w = pk2(acc[8 * c + 6] * inv, acc[8 * c + 7] * inv); op[c] = w; }
    }
    __syncthreads();
}

typedef short bf16x8_t __attribute__((ext_vector_type(8)));
typedef short s16x4_t __attribute__((ext_vector_type(4)));
typedef float f32x16 __attribute__((ext_vector_type(16)));
__device__ __forceinline__ int crow_(int reg, int h) { return (reg & 3) + 8 * (reg >> 2) + 4 * h; }
__device__ __forceinline__ s16x4_t tr_read_(const LAS unsigned char* p) { return __builtin_bit_cast(s16x4_t, __builtin_amdgcn_ds_read_tr16_b64_v4i16((LAS s16x4_t*)p)); }
constexpr int ATT_HALF_BYTES = 66560;
template <bool LOADKV = true, bool DOSTORE = true, bool DOMATH = true>
__device__ __forceinline__ void p_attn_fast(Frame& F) {
    const int half = F.wave >> 2, qb = F.wave & 3;
    const bf16* Qb = (const bf16*)(F.ws + WS_Q); const bf16* Kb = (const bf16*)(F.ws + WS_K); const bf16* Vb = (const bf16*)(F.ws + WS_V);
    bf16* OUTG = (bf16*)(F.ws + WS_OUTG); float* LSE = (float*)(F.ws + WS_LSE); const float* BT = (const float*)(F.ws + WS_BT);
    constexpr int NUNIT = BATCH * 24 * 16;
    constexpr float LOG2E = 1.4426950408889634f;
    constexpr float QKS = QKV_STORE_FP8 ? 1.f / (FP8_ASCALE * FP8_ASCALE) : 1.f, VS = QKV_STORE_FP8 ? 1.f / FP8_ASCALE : 1.f;
    const int nhw = F.nblk * 2, per = (NUNIT + nhw - 1) / nhw, u0 = (F.blk * 2 + half) * per;
#if QKV_STORE_FP8
    const unsigned char* Q8 = F.ws + WS_Q; const unsigned char* K8 = F.ws + WS_K; const unsigned char* V8 = F.ws + WS_V; (void)Qb; (void)Kb; (void)Vb;
    u32x4 kreg[2], vreg[2]; float breg = 0.f;
#else
    u32x4 kreg[4], vreg[4]; float breg = 0.f;
#endif
#define ATT_DECODE(u_) const int zn = (u_) & 15, head = ((u_) >> 4) % 24, b = (u_) / (16 * 24); const int g = head >> 3, hg = head & 7; \
        const int dil = g == 0 ? 1 : (g == 1 ? 4 : 16), nb = 16 / dil; const int z = zn / nb, n = zn % nb; const size_t rowb = (size_t)b * SEQ; (void)hg; (void)rowb; (void)z; (void)n
#if QKV_STORE_FP8
#define ATT_LOADBLK(u_, blk_) do { ATT_DECODE(u_); const int th_ = ((int)threadIdx.x) & 255; \
        _Pragma("unroll") for (int i = 0; i < 2; ++i) { const int piece = th_ + 256 * i, kw = piece >> 2, c16 = piece & 3; const int p = (blk_) * 128 + kw; \
            kreg[i] = (u32x4){0u, 0u, 0u, 0u}; vreg[i] = (u32x4){0u, 0u, 0u, 0u}; \
            if (LOADKV && (u_) < NUNIT) { const size_t row = rowb + (size_t)p * dil + z; kreg[i] = *(const u32x4*)(K8 + row * AW + head * 64 + c16 * 16); vreg[i] = *(const u32x4*)(V8 + row * AW + head * 64 + c16 * 16); } } \
        if (th_ < 192 && (u_) < NUNIT) breg = BT[head * 192 + th_]; } while (0)
#define ATT_STOREBLK(slot_) do { _Pragma("unroll") for (int i = 0; i < 2; ++i) { const int piece = th + 256 * i, kw = piece >> 2, c16 = piece & 3; const int rb_ = ((slot_) * 128 + kw) * 128; \
            *(LAS u32x4*)(Kimg + rb_ + (((2 * c16) ^ (kw & 7)) << 4)) = fp8x8_to_bf16x8(kreg[i].x, kreg[i].y); *(LAS u32x4*)(Kimg + rb_ + (((2 * c16 + 1) ^ (kw & 7)) << 4)) = fp8x8_to_bf16x8(kreg[i].z, kreg[i].w); \
            *(LAS u32x4*)(Vimg + rb_ + (((2 * c16) ^ (kw & 7)) << 4)) = fp8x8_to_bf16x8(vreg[i].x, vreg[i].y); *(LAS u32x4*)(Vimg + rb_ + (((2 * c16 + 1) ^ (kw & 7)) << 4)) = fp8x8_to_bf16x8(vreg[i].z, vreg[i].w); } } while (0)
#else
#define ATT_LOADBLK(u_, blk_) do { ATT_DECODE(u_); const int th_ = ((int)threadIdx.x) & 255; \
        _Pragma("unroll") for (int i = 0; i < 4; ++i) { const int piece = th_ + 256 * i, kw = piece >> 3, ch = piece & 7; const int p = (blk_) * 128 + kw; \
            kreg[i] = (u32x4){0u, 0u, 0u, 0u}; vreg[i] = (u32x4){0u, 0u, 0u, 0u}; \
            if (LOADKV && (u_) < NUNIT) { const size_t row = rowb + (size_t)p * dil + z; kreg[i] = *(const u32x4*)(Kb + row * AW + head * 64 + ch * 8); vreg[i] = *(const u32x4*)(Vb + row * AW + head * 64 + ch * 8); } } \
        if (th_ < 192 && (u_) < NUNIT) breg = BT[head * 192 + th_]; } while (0)
#define ATT_STOREBLK(slot_) do { _Pragma("unroll") for (int i = 0; i < 4; ++i) { const int piece = th + 256 * i, kw = piece >> 3, ch = piece & 7; const int off = ((slot_) * 128 + kw) * 128 + ((ch ^ (kw & 7)) << 4); \
            *(LAS u32x4*)(Kimg + off) = kreg[i]; *(LAS u32x4*)(Vimg + off) = vreg[i]; } } while (0)
#endif
    {
        for (int i = ((int)threadIdx.x); i < 2 * ATT_HALF_BYTES / 16; i += NTHREADS) ((LAS u32x4*)F.lds)[i] = (u32x4){0u, 0u, 0u, 0u};
        __syncthreads();
        const int th = ((int)threadIdx.x) & 255;
        LAS unsigned char* base = F.lds + half * ATT_HALF_BYTES; LAS unsigned char* Kimg = base; LAS unsigned char* Vimg = base + 32768;
        if (u0 < NUNIT) { const int n0 = (u0 & 15) % (16 / ((((u0 >> 4) % 24) >> 3) == 0 ? 1 : ((((u0 >> 4) % 24) >> 3) == 1 ? 4 : 16)));
            if (n0 > 0) { ATT_LOADBLK(u0, n0 - 1); ATT_STOREBLK((n0 - 1) & 1); } }
        ATT_LOADBLK(u0, (u0 & 15) % (16 / ((((u0 >> 4) % 24) >> 3) == 0 ? 1 : ((((u0 >> 4) % 24) >> 3) == 1 ? 4 : 16))));
    }
    for (int it = 0; it < per; ++it) {
        const int u = u0 + it;
        const bool live = u < NUNIT;
        ATT_DECODE(live ? u : 0);
        unsigned opq_ = 0; asm volatile("" : "+s"(opq_));
        int tl_ = ((int)threadIdx.x); asm volatile("" : "+v"(tl_));
        const int th = tl_ & 255, lane = tl_ & 63, r = lane & 31, h = lane >> 5;
        LAS unsigned char* base = F.lds + half * ATT_HALF_BYTES + opq_;
        LAS unsigned char* Kimg = base; LAS unsigned char* Vimg = base + 32768; LAS float* btab = (LAS float*)(base + 65536);
        const int flip = ((n - 1) & 1) << 7;
        bf16x8_t qf[4];
        { const size_t qrow = rowb + (size_t)(n * 128 + 32 * qb + r) * dil + z;
#pragma unroll
#if QKV_STORE_FP8
          for (int dd = 0; dd < 4; ++dd) { const u32x2 q8 = *(const u32x2*)(Q8 + qrow * AW + head * 64 + 16 * dd + 8 * h); qf[dd] = __builtin_bit_cast(bf16x8_t, fp8x8_to_bf16x8(q8.x, q8.y)); } }
#else
          for (int dd = 0; dd < 4; ++dd) qf[dd] = *(const bf16x8_t*)(Qb + qrow * AW + head * 64 + 16 * dd + 8 * h); }
#endif
        LDS_BARRIER();
        ATT_STOREBLK(n & 1);
        if (th < 192) btab[th] = breg;
        LDS_BARRIER();
        if (it + 1 < per) { const int un = u + 1; ATT_LOADBLK(un, ((un) & 15) % (16 / ((((un >> 4) % 24) >> 3) == 0 ? 1 : ((((un >> 4) % 24) >> 3) == 1 ? 4 : 16)))); }
        if (!live) continue;
        f32x16 sc[5];
#pragma unroll
        for (int kb = 0; kb < 5; ++kb) {
            f32x16 a = {0.f, 0.f, 0.f, 0.f, 0.f, 0.f, 0.f, 0.f, 0.f, 0.f, 0.f, 0.f, 0.f, 0.f, 0.f, 0.f};
            const int krow0 = (32 * (qb + kb) + r) ^ flip;
            if (!(n == 0 && qb + kb <= 3))
#pragma unroll
            for (int dd = 0; dd < 4; ++dd) {
                const bf16x8_t kf = *(const LAS bf16x8_t*)(Kimg + krow0 * 128 + (((2 * dd + h) ^ (r & 7)) << 4));
                a = __builtin_amdgcn_mfma_f32_32x32x16_bf16(kf, qf[dd], a, 0, 0, 0);
            }
            sc[kb] = a;
        }
        float m = -INFINITY;
        const LAS float* const bl = btab + (r - 4 * h);
#pragma unroll
        for (int kb = 0; kb < 5; ++kb)
#pragma unroll
            for (int i = 0; i < 16; ++i) {
                const int cc = (i & 3) + 8 * (i >> 2);
                const float bias = bl[160 - 32 * kb - cc];
                float s = sc[kb][i] * (0.125f * LOG2E * QKS) + bias;
                const int c = cc + 4 * h;
                if (kb == 0) s = (r <= c && n != 0) ? s : -INFINITY;
                else if (kb == 4) s = (c <= r) ? s : -INFINITY;
                else s = (n == 0 && (32 * (qb + kb) + c) < 128) ? -INFINITY : s;
                sc[kb][i] = s; m = fmaxf(m, s);
            }
        m = fmaxf(m, __shfl_xor(m, 32));
        float den = 0.f;
#pragma unroll
        for (int kb = 0; kb < 5; ++kb) {
            if (n == 0 && qb + kb <= 3) continue;
#pragma unroll
            for (int i = 0; i < 16; ++i) { const float p = __builtin_amdgcn_exp2f(sc[kb][i] - m); sc[kb][i] = p; den += p; } }
        den += __shfl_xor(den, 32);
        const float inv = VS * __builtin_amdgcn_rcpf(den);
        if (DOSTORE && h == 0) LSE[((size_t)g * T + rowb + (size_t)(n * 128 + 32 * qb + r) * dil + z) * 8 + hg] = (m + __builtin_amdgcn_logf(den)) * (1.f / LOG2E);
        f32x16 o[2];
        o[0] = (f32x16){0.f, 0.f, 0.f, 0.f, 0.f, 0.f, 0.f, 0.f, 0.f, 0.f, 0.f, 0.f, 0.f, 0.f, 0.f, 0.f}; o[1] = o[0];
        const int q4 = (lane & 15) >> 2, blk16 = (lane >> 4) & 1, p4 = lane & 3;
#pragma unroll
        for (int kb = 0; kb < 5; ++kb) {
            if (n == 0 && qb + kb <= 3) continue;
#pragma unroll
            for (int s = 0; s < 2; ++s) {
                u32x4 pw;
                pw.x = cvtpk(sc[kb][8 * s + 0] * inv, sc[kb][8 * s + 1] * inv); pw.y = cvtpk(sc[kb][8 * s + 2] * inv, sc[kb][8 * s + 3] * inv);
                pw.z = cvtpk(sc[kb][8 * s + 4] * inv, sc[kb][8 * s + 5] * inv); pw.w = cvtpk(sc[kb][8 * s + 6] * inv, sc[kb][8 * s + 7] * inv);
                const bf16x8_t pa = __builtin_bit_cast(bf16x8_t, pw);
                const int row_lo = (32 * (qb + kb) + 16 * s + 4 * h + q4) ^ flip, row_hi = row_lo + 8;
#pragma unroll
                for (int db = 0; db < 2; ++db) {
                    const int chunk = 4 * db + 2 * blk16 + (p4 >> 1), sub = (p4 & 1) * 8;
                    const s16x4_t lo = tr_read_(Vimg + row_lo * 128 + ((chunk ^ (row_lo & 7)) << 4) + sub);
                    const s16x4_t hi = tr_read_(Vimg + row_hi * 128 + ((chunk ^ (row_hi & 7)) << 4) + sub);
                    const bf16x8_t vf = (bf16x8_t){lo[0], lo[1], lo[2], lo[3], hi[0], hi[1], hi[2], hi[3]};
                    o[db] = __builtin_amdgcn_mfma_f32_32x32x16_bf16(pa, vf, o[db], 0, 0, 0);
                }
            } }
#pragma unroll
        for (int i = 0; i < 16; ++i) {
            const size_t row = rowb + (size_t)(n * 128 + 32 * qb + crow_(i, h)) * dil + z;
            bf16* op = OUTG + ((size_t)g * T + row) * 512 + hg * 64 + r;
            const unsigned w = cvtpk(o[0][i], o[1][i]);
            if (DOSTORE) { op[0] = (bf16)(w & 0xffffu); op[32] = (bf16)(w >> 16); } else asm volatile("" :: "v"(w));
        }
    }
#undef ATT_DECODE
#undef ATT_LOADBLK
#undef ATT_STOREBLK
    __syncthreads();
}
__device__ __forceinline__ void p_attn_merge(Frame& F) {
    const bf16* OUTG = (const bf16*)(F.ws + WS_OUTG); const float* LSE = (const float*)(F.ws + WS_LSE); bf16* AT = (bf16*)(F.ws + WS_ATTN);
    for (int idx = F.blk * NTHREADS + ((int)threadIdx.x); idx < T * 64; idx += F.nblk * NTHREADS) {
        const int row = idx >> 6, c8 = (idx & 63) * 8, hg = c8 >> 6;
        const float l0 = LSE[((size_t)0 * T + row) * 8 + hg], l1 = LSE[((size_t)1 * T + row) * 8 + hg], l2 = LSE[((size_t)2 * T + row) * 8 + hg];
        const float mx = fmaxf(l0, fmaxf(l1, l2)), e0 = __expf(l0 - mx), e1 = __expf(l1 - mx), e2 = __expf(l2 - mx), inv = __builtin_amdgcn_rcpf(e0 + e1 + e2);
        const float w[3] = {e0 * inv, e1 * inv, e2 * inv};
        float a[8] = {0.f, 0.f, 0.f, 0.f, 0.f, 0.f, 0.f, 0.f};
#pragma unroll
        for (int g = 0; g < 3; ++g) { const u32x4 v = *(const u32x4*)(OUTG + ((size_t)g * T + row) * 512 + c8);
            a[0] += w[g] * bflo(v.x); a[1] += w[g] * bfhi(v.x); a[2] += w[g] * bflo(v.y); a[3] += w[g] * bfhi(v.y);
            a[4] += w[g] * bflo(v.z); a[5] += w[g] * bfhi(v.z); a[6] += w[g] * bflo(v.w); a[7] += w[g] * bfhi(v.w); }
        u32x4 o; o.x = pk2(a[0], a[1]); o.y = pk2(a[2], a[3]); o.z = pk2(a[4], a[5]); o.w = pk2(a[6], a[7]);
        *(u32x4*)(AT + (size_t)row * 512 + c8) = o;
    }
}

__device__ __forceinline__ void p_conv(Frame& F) {
    const bf16* X = (const bf16*)(F.ws + WS_XBC); bf16* O = (bf16*)(F.ws + WS_CONV);
    const int total = T * (CONVD / 8);
    for (int idx = F.blk * NTHREADS + ((int)threadIdx.x); idx < total; idx += F.nblk * NTHREADS) {
        const int row = idx / (CONVD / 8), c0 = (idx % (CONVD / 8)) * 8, t = row & (SEQ - 1);
        float a[8];
#pragma unroll
        for (int i = 0; i < 8; ++i) a[i] = F.conv_b[c0 + i];
#pragma unroll
        for (int w = 0; w < 4; ++w) {
            const int tt = t + w - 3; if (tt < 0) continue;
            const u32x4 u = *(const u32x4*)(X + (size_t)(row + w - 3) * CONVD + c0);
            const float* cw = F.conv_w + (size_t)w * CONVD + c0;
            a[0] += cw[0] * bflo(u.x); a[1] += cw[1] * bfhi(u.x); a[2] += cw[2] * bflo(u.y); a[3] += cw[3] * bfhi(u.y);
            a[4] += cw[4] * bflo(u.z); a[5] += cw[5] * bfhi(u.z); a[6] += cw[6] * bflo(u.w); a[7] += cw[7] * bfhi(u.w);
        }
        u32x4 o; o.x = pk2(siluf_(a[0]), siluf_(a[1])); o.y = pk2(siluf_(a[2]), siluf_(a[3])); o.z = pk2(siluf_(a[4]), siluf_(a[5])); o.w = pk2(siluf_(a[6]), siluf_(a[7]));
        *(u32x4*)(O + (size_t)row * CONVD + c0) = o;
    }
}

__device__ __forceinline__ void p_ssd_naive(Frame& F) {
    const bf16* CV = (const bf16*)(F.ws + WS_CONV); const float* DT = (const float*)(F.ws + WS_DT); const bf16* Z = (const bf16*)(F.ws + WS_Z);
    bf16* YZ = (bf16*)(F.ws + WS_YZ);
    const int t256 = ((int)threadIdx.x) & 255, p = t256 >> 2, q = t256 & 3;
    for (int unit = F.blk * 2 + (((int)threadIdx.x) >> 8); unit < BATCH * NH_SSM; unit += F.nblk * 2) {
        const int b = unit / NH_SSM, h = unit % NH_SSM, g = h / 8;
        const float a = -__expf(F.a_log[h]), dsk = F.d_skip[h];
        float st[32];
#pragma unroll
        for (int i = 0; i < 32; ++i) st[i] = 0.f;
        for (int t = 0; t < SEQ; ++t) {
            const size_t row = (size_t)b * SEQ + t;
            const float dt = DT[(size_t)h * T + row];
            const float dA = __expf(dt * a);
            const float xv = bf2f(CV[row * CONVD + h * 64 + p]);
            const float dtx = dt * xv;
            const u32x4* bp = (const u32x4*)(CV + row * CONVD + 2048 + g * 128 + q * 32);
            const u32x4* cp = (const u32x4*)(CV + row * CONVD + 2560 + g * 128 + q * 32);
            float yp = 0.f;
#pragma unroll
            for (int c = 0; c < 4; ++c) {
                const u32x4 bw = bp[c], cw = cp[c];
                const float bv[8] = {bflo(bw.x), bfhi(bw.x), bflo(bw.y), bfhi(bw.y), bflo(bw.z), bfhi(bw.z), bflo(bw.w), bfhi(bw.w)};
                const float cv[8] = {bflo(cw.x), bfhi(cw.x), bflo(cw.y), bfhi(cw.y), bflo(cw.z), bfhi(cw.z), bflo(cw.w), bfhi(cw.w)};
#pragma unroll
                for (int i = 0; i < 8; ++i) { st[8 * c + i] = st[8 * c + i] * dA + dtx * bv[i]; yp += cv[i] * st[8 * c + i]; }
            }
            yp += __shfl_xor(yp, 1); yp += __shfl_xor(yp, 2);
            if (q == 0) {
                const float y = yp + dsk * xv;
                const float z = bf2f(Z[row * DI + h * 64 + p]);
                YZ[row * DI + h * 64 + p] = (bf16)f2bf(y * siluf_(z));
            }
        }
    }
}

__device__ __forceinline__ int swz256(int row, int chunk) { return row * 272 + (chunk << 4); }
__device__ __forceinline__ int swz128(int row, int chunk) { return row * 144 + (chunk << 4); }
__device__ __forceinline__ void p_ssd_fast(Frame& F) {
    const int lane = ((int)(threadIdx.x & 63u)), r = lane & 31, hh = lane >> 5, lb = F.wave & 3, pb = F.wave >> 2, tid = ((int)threadIdx.x);
    LAS unsigned char* Bimg = F.lds; LAS unsigned char* Cimg = F.lds + 34816; LAS unsigned char* Ximg = F.lds + 69632; LAS unsigned char* Xwimg = F.lds + 88064;
    LAS unsigned char* Simg = F.lds + 106496; LAS float* acs = (LAS float*)(F.lds + 123904); LAS float* dtv = (LAS float*)(F.lds + 124416);
    const bf16* CV = (const bf16*)(F.ws + WS_CONV); const float* DT = (const float*)(F.ws + WS_DT); bf16* Y = (bf16*)(F.ws + WS_YZ);
    const int q4 = (lane & 15) >> 2, blk16 = (lane >> 4) & 1, p4 = lane & 3;
    const f32x16 zero16 = {0.f, 0.f, 0.f, 0.f, 0.f, 0.f, 0.f, 0.f, 0.f, 0.f, 0.f, 0.f, 0.f, 0.f, 0.f, 0.f};
    for (int unit = F.blk; unit < BATCH * NH_SSM; unit += F.nblk) {
        const int b = unit / NH_SSM, h = unit % NH_SSM, g = h >> 3;
        const float a = -__expf(F.a_log[h]);
        f32x16 st = zero16;
        u32x4 rb[4], rc[4], rx[2]; float d0, d1;
#define SSD_LOAD(c) do { const size_t row0_ = (size_t)b * SEQ + (size_t)(c) * 128; \
            _Pragma("unroll") for (int i = 0; i < 4; ++i) { const int piece = tid + 512 * i, row = piece >> 4, ch = piece & 15; \
                rb[i] = *(const u32x4*)(CV + (row0_ + row) * CONVD + 2048 + g * 128 + ch * 8); rc[i] = *(const u32x4*)(CV + (row0_ + row) * CONVD + 2560 + g * 128 + ch * 8); } \
            _Pragma("unroll") for (int i = 0; i < 2; ++i) { const int piece = tid + 512 * i, row = piece >> 3, ch = piece & 7; rx[i] = *(const u32x4*)(CV + (row0_ + row) * CONVD + h * 64 + ch * 8); } \
            d0 = DT[(size_t)h * T + row0_ + lane]; d1 = DT[(size_t)h * T + row0_ + 64 + lane]; } while (0)
        SSD_LOAD(0);
        for (int c = 0; c < 16; ++c) {
            const size_t row0 = (size_t)b * SEQ + (size_t)c * 128;
            float x0 = d0 * a, x1 = d1 * a;
#pragma unroll
            for (int o = 1; o < 64; o <<= 1) { const float t0 = __shfl_up(x0, o), t1 = __shfl_up(x1, o); if (lane >= o) { x0 += t0; x1 += t1; } }
            x1 += __shfl(x0, 63);
            const float total = __shfl(x1, 63);
            __syncthreads();
            acs[lane] = x0; acs[64 + lane] = x1; dtv[lane] = d0; dtv[64 + lane] = d1;
#pragma unroll
            for (int i = 0; i < 4; ++i) { const int piece = tid + 512 * i, row = piece >> 4, ch = piece & 15;
                *(LAS u32x4*)(Bimg + swz256(row, ch)) = rb[i]; *(LAS u32x4*)(Cimg + swz256(row, ch)) = rc[i]; }
#pragma unroll
            for (int i = 0; i < 2; ++i) { const int piece = tid + 512 * i, row = piece >> 3, ch = piece & 7;
                const float w = __expf(total - acs[row]) * dtv[row];
                const u32x4 v = rx[i]; u32x4 o;
                o.x = pk2(bflo(v.x) * w, bfhi(v.x) * w); o.y = pk2(bflo(v.y) * w, bfhi(v.y) * w); o.z = pk2(bflo(v.z) * w, bfhi(v.z) * w); o.w = pk2(bflo(v.w) * w, bfhi(v.w) * w);
                *(LAS u32x4*)(Ximg + swz128(row, ch)) = v; *(LAS u32x4*)(Xwimg + swz128(row, ch)) = o; }
#pragma unroll
            for (int g4 = 0; g4 < 4; ++g4) { u32x2 w2; w2.x = pk2(st[4 * g4], st[4 * g4 + 1]); w2.y = pk2(st[4 * g4 + 2], st[4 * g4 + 3]);
                *(LAS u32x2*)(Simg + swz256(32 * pb + r, 4 * lb + g4) + 8 * hh) = w2; }
            __syncthreads();
            bf16x8_t cf[8];
#pragma unroll
            for (int kk = 0; kk < 8; ++kk) cf[kk] = *(const LAS bf16x8_t*)(Cimg + swz256(32 * lb + r, 2 * kk + hh));
            const float acs_l = acs[32 * lb + r];
            f32x16 yd = zero16;
            for (int sb = 0; sb <= lb; ++sb) {
                f32x16 gt = zero16;
#pragma unroll
                for (int kk = 0; kk < 8; ++kk) { const bf16x8_t bfm = *(const LAS bf16x8_t*)(Bimg + swz256(32 * sb + r, 2 * kk + hh)); gt = __builtin_amdgcn_mfma_f32_32x32x16_bf16(bfm, cf[kk], gt, 0, 0, 0); }
#pragma unroll
                for (int i = 0; i < 16; ++i) { const int s = 32 * sb + crow_(i, hh), l = 32 * lb + r;
                    const float e = __expf(fminf(acs_l - acs[s], 0.f)) * dtv[s];
                    gt[i] = (s <= l) ? gt[i] * e : 0.f; }
#pragma unroll
                for (int q = 0; q < 2; ++q) {
                    u32x4 pw; pw.x = pk2(gt[8 * q], gt[8 * q + 1]); pw.y = pk2(gt[8 * q + 2], gt[8 * q + 3]); pw.z = pk2(gt[8 * q + 4], gt[8 * q + 5]); pw.w = pk2(gt[8 * q + 6], gt[8 * q + 7]);
                    const bf16x8_t pa = __builtin_bit_cast(bf16x8_t, pw);
                    const int row_lo = 32 * sb + 16 * q + 4 * hh + q4, row_hi = row_lo + 8, chunk = 4 * pb + 2 * blk16 + (p4 >> 1), sub = (p4 & 1) * 8;
                    const s16x4_t lo = tr_read_(Ximg + swz128(row_lo, chunk) + sub), hi = tr_read_(Ximg + swz128(row_hi, chunk) + sub);
                    const bf16x8_t xf = (bf16x8_t){lo[0], lo[1], lo[2], lo[3], hi[0], hi[1], hi[2], hi[3]};
                    yd = __builtin_amdgcn_mfma_f32_32x32x16_bf16(pa, xf, yd, 0, 0, 0);
                }
            }
            f32x16 yo = zero16;
#pragma unroll
            for (int kk = 0; kk < 8; ++kk) { const bf16x8_t sf = *(const LAS bf16x8_t*)(Simg + swz256(32 * pb + r, 2 * kk + hh)); yo = __builtin_amdgcn_mfma_f32_32x32x16_bf16(cf[kk], sf, yo, 0, 0, 0); }
#pragma unroll
            for (int i = 0; i < 16; ++i) { const int l = 32 * lb + crow_(i, hh);
                const float y = yd[i] + __expf(acs[l]) * yo[i];
                Y[(row0 + l) * DI + h * 64 + 32 * pb + r] = (bf16)f2bf(y); }
            if (c + 1 < 16) SSD_LOAD(c + 1);
            const float cd = __expf(total);
#pragma unroll
            for (int i = 0; i < 16; ++i) st[i] *= cd;
#pragma unroll
            for (int kk = 0; kk < 8; ++kk) {
                const int row_lo = 16 * kk + 4 * hh + q4, row_hi = row_lo + 8, sub = (p4 & 1) * 8;
                const int chb = 4 * lb + 2 * blk16 + (p4 >> 1), chx = 4 * pb + 2 * blk16 + (p4 >> 1);
                const s16x4_t blo = tr_read_(Bimg + swz256(row_lo, chb) + sub), bhi = tr_read_(Bimg + swz256(row_hi, chb) + sub);
                const s16x4_t xlo = tr_read_(Xwimg + swz128(row_lo, chx) + sub), xhi = tr_read_(Xwimg + swz128(row_hi, chx) + sub);
                const bf16x8_t af = (bf16x8_t){blo[0], blo[1], blo[2], blo[3], bhi[0], bhi[1], bhi[2], bhi[3]};
                const bf16x8_t xf = (bf16x8_t){xlo[0], xlo[1], xlo[2], xlo[3], xhi[0], xhi[1], xhi[2], xhi[3]};
                st = __builtin_amdgcn_mfma_f32_32x32x16_bf16(af, xf, st, 0, 0, 0);
            }
        }
#undef SSD_LOAD
    }
    __syncthreads();
}
__device__ __forceinline__ void p_ssd_fast2(Frame& F) {
    const int lane = ((int)(threadIdx.x & 63u)), r = lane & 31, hh = lane >> 5, pb = F.wave >> 2, nb = F.wave & 3, lb = pb ? 3 - nb : nb, tid = ((int)threadIdx.x);
#define SSD2_PTRS() unsigned opq_ = 0; asm volatile("" : "+s"(opq_)); \
    LAS unsigned char* const Bimg = F.lds + opq_; LAS unsigned char* const Cimg = Bimg + 34816; LAS unsigned char* const Ximg0 = Bimg + 69632; LAS unsigned char* const Simg0 = Bimg + 106496; \
    LAS float* const tab0 = (LAS float*)(Bimg + 141312); \
    const bf16* const CV = (const bf16*)(F.ws + WS_CONV + opq_); const float* const DT = (const float*)(F.ws + WS_DT + opq_); bf16* const Y = (bf16*)(F.ws + WS_YZ + opq_); \
    int tidl_ = ((int)threadIdx.x); asm volatile("" : "+v"(tidl_)); const int tid = tidl_, lane = tid & 63, r = lane & 31, hh = lane >> 5, q4 = (lane & 15) >> 2, blk16 = (lane >> 4) & 1, p4 = lane & 3; \
    (void)tid; (void)r; (void)hh; (void)q4; (void)blk16; (void)p4
    const int q4 = (lane & 15) >> 2, blk16 = (lane >> 4) & 1, p4 = lane & 3;
    const f32x16 zero16 = {0.f, 0.f, 0.f, 0.f, 0.f, 0.f, 0.f, 0.f, 0.f, 0.f, 0.f, 0.f, 0.f, 0.f, 0.f, 0.f};
    for (int unit = F.blk; unit < BATCH * NG_SSM * 4; unit += F.nblk) {
        const int b = unit >> 4, g = (unit >> 2) & 3, h0 = 8 * g + 2 * (unit & 3);
        const float a0 = -__expf(F.a_log[h0]), a1 = -__expf(F.a_log[h0 + 1]), dsk0 = F.d_skip[h0], dsk1 = F.d_skip[h0 + 1];
        f32x16 st[2]; st[0] = zero16; st[1] = zero16;
        u32x4 rb[4], rc[4], rx[2][2]; float dm0 = 0.f, dm1 = 0.f;
#define SSD2_LOAD(c) do { const size_t row0_ = (size_t)b * SEQ + (size_t)(c) * 128; \
            _Pragma("unroll") for (int i = 0; i < 4; ++i) { const int piece = tid + 512 * i, row = piece >> 4, ch = piece & 15; \
                rb[i] = *(const u32x4*)(CV + (row0_ + row) * CONVD + 2048 + g * 128 + ch * 8); rc[i] = *(const u32x4*)(CV + (row0_ + row) * CONVD + 2560 + g * 128 + ch * 8); } \
            _Pragma("unroll") for (int e = 0; e < 2; ++e) { \
                _Pragma("unroll") for (int i = 0; i < 2; ++i) { const int piece = tid + 512 * i, row = piece >> 3, ch = piece & 7; rx[e][i] = *(const u32x4*)(CV + (row0_ + row) * CONVD + (h0 + e) * 64 + ch * 8); } \
                } \
            if (F.wave < 2) { dm0 = DT[(size_t)(h0 + (F.wave & 1)) * T + row0_ + lane]; dm1 = DT[(size_t)(h0 + (F.wave & 1)) * T + row0_ + 64 + lane]; } } while (0)
        { SSD2_PTRS(); SSD2_LOAD(0); }
        for (int c = 0; c < 16; ++c) {
            const size_t row0 = (size_t)b * SEQ + (size_t)c * 128;
            float x0 = 0.f, x1 = 0.f, tot = 0.f; const int es = F.wave & 1;
            if (F.wave < 2) { const float a = es ? a1 : a0; x0 = dm0 * a; x1 = dm1 * a;
#pragma unroll
                for (int o = 1; o < 64; o <<= 1) { const float t0 = __shfl_up(x0, o), t1 = __shfl_up(x1, o); if (lane >= o) { x0 += t0; x1 += t1; } }
                x1 += __shfl(x0, 63); tot = __shfl(x1, 63); }
            LDS_BARRIER();
            for (int repw_ = 0; repw_ < SSD_REP_W; ++repw_) { SSD2_PTRS();
            if (F.wave < 2) { LAS float* const tb = tab0 + 704 * es;
                const float dd0 = dm0, dd1 = dm1;
                tb[lane] = x0; tb[64 + lane] = x1; tb[128 + lane] = dd0; tb[192 + lane] = dd1;
                tb[256 + lane] = __expf(tot - x0) * dd0; tb[320 + lane] = __expf(tot - x1) * dd1;
                tb[384 + lane] = __expf(x0); tb[448 + lane] = __expf(x1);
                const float a32 = __shfl(x0, 32), a64 = __shfl(x1, 0), a96 = __shfl(x1, 32);
                if (lane < 32) { tb[512 + lane] = __expf(a32 - x0) * dd0; tb[512 + 96 + 64 + lane] = __expf(a96 - x1) * dd1; }
                tb[512 + 32 + lane] = __expf(a64 - x0) * dd0; tb[512 + 96 + lane] = __expf(a96 - x0) * dd0; }
#pragma unroll
            for (int i = 0; i < 4; ++i) { const int piece = tid + 512 * i, row = piece >> 4, ch = piece & 15;
                *(LAS u32x4*)(Bimg + swz256(row, ch)) = rb[i]; *(LAS u32x4*)(Cimg + swz256(row, ch)) = rc[i]; }
#pragma unroll
            for (int e = 0; e < 2; ++e) {
#pragma unroll
                for (int i = 0; i < 2; ++i) { const int piece = tid + 512 * i, row = piece >> 3, ch = piece & 7; *(LAS u32x4*)(Ximg0 + 18432 * e + swz128(row, ch)) = rx[e][i]; }
#pragma unroll
                for (int g4 = 0; g4 < 4; ++g4) { u32x2 w2; w2.x = cvtpk(st[e][4 * g4], st[e][4 * g4 + 1]); w2.y = cvtpk(st[e][4 * g4 + 2], st[e][4 * g4 + 3]);
                    *(LAS u32x2*)(Simg0 + 17408 * e + swz256(32 * pb + r, 4 * nb + g4) + 8 * hh) = w2; }
            }
            }
            LDS_BARRIER();
            { SSD2_PTRS(); if (c + 1 < 16) SSD2_LOAD(c + 1); }
            for (int repa_ = 0; repa_ < SSD_REP_A; ++repa_) { SSD2_PTRS();
            bf16x8_t cf[8];
#pragma unroll
            for (int kk = 0; kk < 8; ++kk) cf[kk] = *(const LAS bf16x8_t*)(Cimg + swz256(32 * lb + r, 2 * kk + hh));
            const float acs_l0 = tab0[32 * lb + r], acs_l1 = tab0[704 + 32 * lb + r];
            const float e1_0 = __expf(acs_l0 - tab0[32 * lb]), e1_1 = __expf(acs_l1 - tab0[704 + 32 * lb]);
            const int e2off = lb == 1 ? 0 : (lb == 2 ? 32 : 96);
            f32x16 yd[2]; yd[0] = zero16; yd[1] = zero16;
            for (int sb = 0; sb <= lb; ++sb) {
                f32x16 gt = zero16;
#pragma unroll
                for (int kk = 0; kk < 8; ++kk) { const bf16x8_t bfm = *(const LAS bf16x8_t*)(Bimg + swz256(32 * sb + r, 2 * kk + hh)); gt = __builtin_amdgcn_mfma_f32_32x32x16_bf16(bfm, cf[kk], gt, 0, 0, 0); }
#pragma unroll
                for (int e = 0; e < 2; ++e) {
                    const LAS float* const tb = tab0 + 704 * e;
                    float gv[16];
                    if (sb < lb) {
                        const float e1 = e ? e1_1 : e1_0;
#pragma unroll
                        for (int g4 = 0; g4 < 4; ++g4) { const f32x4 t = *(const LAS f32x4*)(tb + 512 + e2off + 32 * sb + 8 * g4 + 4 * hh);
                            gv[4 * g4] = gt[4 * g4] * (t.x * e1); gv[4 * g4 + 1] = gt[4 * g4 + 1] * (t.y * e1); gv[4 * g4 + 2] = gt[4 * g4 + 2] * (t.z * e1); gv[4 * g4 + 3] = gt[4 * g4 + 3] * (t.w * e1); }
                    } else {
                        const float acs_l = e ? acs_l1 : acs_l0;
#pragma unroll
                        for (int g4 = 0; g4 < 4; ++g4) { const f32x4 ta = *(const LAS f32x4*)(tb + 32 * sb + 8 * g4 + 4 * hh), td = *(const LAS f32x4*)(tb + 128 + 32 * sb + 8 * g4 + 4 * hh);
                            const float av[4] = {ta.x, ta.y, ta.z, ta.w}, dv[4] = {td.x, td.y, td.z, td.w};
#pragma unroll
                            for (int j = 0; j < 4; ++j) { const int sl = 8 * g4 + 4 * hh + j;
                                gv[4 * g4 + j] = (sl <= r) ? gt[4 * g4 + j] * (__expf(fminf(acs_l - av[j], 0.f)) * dv[j]) : 0.f; } }
                    }
#pragma unroll
                    for (int q = 0; q < 2; ++q) {
                        u32x4 pw; pw.x = cvtpk(gv[8 * q], gv[8 * q + 1]); pw.y = cvtpk(gv[8 * q + 2], gv[8 * q + 3]); pw.z = cvtpk(gv[8 * q + 4], gv[8 * q + 5]); pw.w = cvtpk(gv[8 * q + 6], gv[8 * q + 7]);
                        const bf16x8_t pa = __builtin_bit_cast(bf16x8_t, pw);
                        const int row_lo = 32 * sb + 16 * q + 4 * hh + q4, row_hi = row_lo + 8, chunk = 4 * pb + 2 * blk16 + (p4 >> 1), sub = (p4 & 1) * 8;
                        const s16x4_t lo = tr_read_(Ximg0 + 18432 * e + swz128(row_lo, chunk) + sub), hi = tr_read_(Ximg0 + 18432 * e + swz128(row_hi, chunk) + sub);
                        const bf16x8_t xf = (bf16x8_t){lo[0], lo[1], lo[2], lo[3], hi[0], hi[1], hi[2], hi[3]};
                        yd[e] = __builtin_amdgcn_mfma_f32_32x32x16_bf16(pa, xf, yd[e], 0, 0, 0);
                    }
                }
            }
#pragma unroll
            for (int e = 0; e < 2; ++e) {
                f32x16 yo = zero16;
#pragma unroll
                for (int kk = 0; kk < 8; ++kk) { const bf16x8_t sf = *(const LAS bf16x8_t*)(Simg0 + 17408 * e + swz256(32 * pb + r, 2 * kk + hh)); yo = __builtin_amdgcn_mfma_f32_32x32x16_bf16(cf[kk], sf, yo, 0, 0, 0); }
#pragma unroll
                for (int g4 = 0; g4 < 4; ++g4) { const f32x4 ea = *(const LAS f32x4*)(tab0 + 704 * e + 384 + 32 * lb + 8 * g4 + 4 * hh); const float eav[4] = {ea.x, ea.y, ea.z, ea.w};
                    const s16x4_t xs4 = tr_read_(Ximg0 + 18432 * e + swz128(32 * lb + 8 * g4 + 4 * hh + q4, 4 * pb + 2 * blk16 + (p4 >> 1)) + (p4 & 1) * 8);
#pragma unroll
                    for (int j = 0; j < 4; ++j) { const int i = 4 * g4 + j, l = 32 * lb + 8 * g4 + 4 * hh + j;
                        const float y = yd[e][i] + eav[j] * yo[i] + (e ? dsk1 : dsk0) * bf2f((bf16)xs4[j]);
                        Y[(row0 + l) * DI + (h0 + e) * 64 + 32 * pb + r] = (bf16)(cvtpk(y, y) & 0xffffu); } }
            }
            }
            { SSD2_PTRS();
            { const float cd0 = __expf(tab0[127]), cd1 = __expf(tab0[704 + 127]);
#pragma unroll
              for (int i = 0; i < 16; ++i) { st[0][i] *= cd0; st[1][i] *= cd1; } }
#pragma unroll
            for (int kk = 0; kk < 8; ++kk) {
                const int row_lo = 16 * kk + 4 * hh + q4, row_hi = row_lo + 8, sub = (p4 & 1) * 8;
                const int chb = 4 * nb + 2 * blk16 + (p4 >> 1), chx = 4 * pb + 2 * blk16 + (p4 >> 1);
                const s16x4_t blo = tr_read_(Bimg + swz256(row_lo, chb) + sub), bhi = tr_read_(Bimg + swz256(row_hi, chb) + sub);
                const bf16x8_t af = (bf16x8_t){blo[0], blo[1], blo[2], blo[3], bhi[0], bhi[1], bhi[2], bhi[3]};
#pragma unroll
                for (int e = 0; e < 2; ++e) {
                    const s16x4_t xlo = tr_read_(Ximg0 + 18432 * e + swz128(row_lo, chx) + sub), xhi = tr_read_(Ximg0 + 18432 * e + swz128(row_hi, chx) + sub);
                    const f32x4 wl = *(const LAS f32x4*)(tab0 + 704 * e + 256 + 16 * kk + 4 * hh), wh = *(const LAS f32x4*)(tab0 + 704 * e + 256 + 16 * kk + 8 + 4 * hh);
                    u32x4 pw;
                    pw.x = cvtpk(bf2f((bf16)xlo[0]) * wl.x, bf2f((bf16)xlo[1]) * wl.y); pw.y = cvtpk(bf2f((bf16)xlo[2]) * wl.z, bf2f((bf16)xlo[3]) * wl.w);
                    pw.z = cvtpk(bf2f((bf16)xhi[0]) * wh.x, bf2f((bf16)xhi[1]) * wh.y); pw.w = cvtpk(bf2f((bf16)xhi[2]) * wh.z, bf2f((bf16)xhi[3]) * wh.w);
                    st[e] = __builtin_amdgcn_mfma_f32_32x32x16_bf16(af, __builtin_bit_cast(bf16x8_t, pw), st[e], 0, 0, 0);
                }
            }
            }
        }
#undef SSD2_LOAD
#undef SSD2_PTRS
    }
    __syncthreads();
}

__device__ __forceinline__ void p_ypost2(Frame& F) {
    const int gw = F.blk * NWAVES + F.wave, NGW = F.nblk * NWAVES;
    const bf16* Y = (const bf16*)(F.ws + WS_YZ); const bf16* CV = (const bf16*)(F.ws + WS_CONV); const bf16* Z = (const bf16*)(F.ws + WS_Z); bf16* YN = (bf16*)(F.ws + WS_YN);
    for (int m = gw; m < T; m += NGW) {
#pragma unroll
        for (int g = 0; g < 4; ++g) {
            const int c0 = g * 512 + ((int)(threadIdx.x & 63u)) * 8;
            const u32x4 yw = __builtin_nontemporal_load((const u32x4*)(Y + (size_t)m * DI + c0)), zw = __builtin_nontemporal_load((const u32x4*)(Z + (size_t)m * DI + c0));
            const float yv[8] = {bflo(yw.x), bfhi(yw.x), bflo(yw.y), bfhi(yw.y), bflo(yw.z), bfhi(yw.z), bflo(yw.w), bfhi(yw.w)};
            const float zv[8] = {bflo(zw.x), bfhi(zw.x), bflo(zw.y), bfhi(zw.y), bflo(zw.z), bfhi(zw.z), bflo(zw.w), bfhi(zw.w)};
            float v[8]; float s = 0.f;
#pragma unroll
            for (int i = 0; i < 8; ++i) { v[i] = yv[i] * siluf_(zv[i]); s += v[i] * v[i]; }
            const float rstd = __builtin_amdgcn_rsqf(wave_sum(s) * (1.f / 512.f) + EPS);
            const float* nw = F.ssm_norm_w + c0;
            u32x4 o; o.x = pk2(v[0] * rstd * nw[0], v[1] * rstd * nw[1]); o.y = pk2(v[2] * rstd * nw[2], v[3] * rstd * nw[3]);
            o.z = pk2(v[4] * rstd * nw[4], v[5] * rstd * nw[5]); o.w = pk2(v[6] * rstd * nw[6], v[7] * rstd * nw[7]);
            *(u32x4*)(YN + (size_t)m * DI + c0) = o;
        }
    }
}

__device__ __forceinline__ void p_ypost(Frame& F) {
    const int gw = F.blk * NWAVES + F.wave, NGW = F.nblk * NWAVES;
    const bf16* YZ = (const bf16*)(F.ws + WS_YZ); bf16* YN = (bf16*)(F.ws + WS_YN);
    for (int m = gw; m < T; m += NGW) {
#pragma unroll
        for (int g = 0; g < 4; ++g) {
            const int c0 = g * 512 + ((int)(threadIdx.x & 63u)) * 8;
            const u32x4 w = *(const u32x4*)(YZ + (size_t)m * DI + c0);
            float v[8] = {bflo(w.x), bfhi(w.x), bflo(w.y), bfhi(w.y), bflo(w.z), bfhi(w.z), bflo(w.w), bfhi(w.w)};
            float s = 0.f;
#pragma unroll
            for (int i = 0; i < 8; ++i) s += v[i] * v[i];
            const float rstd = __builtin_amdgcn_rsqf(wave_sum(s) * (1.f / 512.f) + EPS);
            const float* nw = F.ssm_norm_w + c0;
            u32x4 o; o.x = pk2(v[0] * rstd * nw[0], v[1] * rstd * nw[1]); o.y = pk2(v[2] * rstd * nw[2], v[3] * rstd * nw[3]);
            o.z = pk2(v[4] * rstd * nw[4], v[5] * rstd * nw[5]); o.w = pk2(v[6] * rstd * nw[6], v[7] * rstd * nw[7]);
            *(u32x4*)(YN + (size_t)m * DI + c0) = o;
        }
    }
}

__device__ __forceinline__ void p_router(Frame& F) {
    LAS int* hist = (LAS int*)F.lds;
    if (((int)threadIdx.x) < 32) hist[((int)threadIdx.x)] = 0;
    __syncthreads();
    int* ROWMAP = (int*)(F.ws + WS_ROWMAP);
    for (int i = F.blk * NTHREADS + ((int)threadIdx.x); i < CAP; i += F.nblk * NTHREADS) ROWMAP[i] = -1;
    const int gw = F.blk * NWAVES + F.wave, NGW = F.nblk * NWAVES;
    bf16* XN2 = (bf16*)(F.ws + WS_XN2); int* TOPI = (int*)(F.ws + WS_TOPI); float* TOPW = (float*)(F.ws + WS_TOPW);
    for (int m = gw; m < T; m += NGW) {
        const f32x4* xr = (const f32x4*)(F.out + (size_t)m * D) + ((int)(threadIdx.x & 63u));
        const f32x4* wr = (const f32x4*)F.norm_ffn + ((int)(threadIdx.x & 63u));
        f32x4 v[4]; float s = 0.f;
#pragma unroll
        for (int j = 0; j < 4; ++j) { v[j] = xr[64 * j]; s += (v[j].x * v[j].x + v[j].y * v[j].y) + (v[j].z * v[j].z + v[j].w * v[j].w); }
        const float rstd = __builtin_amdgcn_rsqf(wave_sum(s) * (1.f / D) + EPS);
        float lg[32];
#pragma unroll
        for (int e = 0; e < 32; ++e) lg[e] = 0.f;
#pragma unroll
        for (int j = 0; j < 4; ++j) {
            v[j] = v[j] * rstd * wr[64 * j];
            st_bf4(XN2 + (size_t)m * D + (((int)(threadIdx.x & 63u)) + 64 * j) * 4, v[j]);
            const float hv[4] = {v[j].x, v[j].y, v[j].z, v[j].w};
#pragma unroll
            for (int i = 0; i < 4; ++i) {
                const f32x4* rw = (const f32x4*)(F.router_w + (size_t)((((int)(threadIdx.x & 63u)) + 64 * j) * 4 + i) * 32);
#pragma unroll
                for (int c = 0; c < 8; ++c) { const f32x4 w = rw[c]; lg[4 * c] += hv[i] * w.x; lg[4 * c + 1] += hv[i] * w.y; lg[4 * c + 2] += hv[i] * w.z; lg[4 * c + 3] += hv[i] * w.w; }
            }
        }
#pragma unroll
        for (int e = 0; e < 32; ++e) lg[e] = wave_sum(lg[e]) + F.router_b[e];
        int bi[4]; float bv[4];
#pragma unroll
        for (int k = 0; k < 4; ++k) {
            float best = -INFINITY; int be = 0;
#pragma unroll
            for (int e = 0; e < 32; ++e) if (lg[e] > best) { best = lg[e]; be = e; }
            bi[k] = be; bv[k] = best;
#pragma unroll
            for (int e = 0; e < 32; ++e) if (e == be) lg[e] = -INFINITY;
        }
        const float e0 = 1.f, e1 = __expf(bv[1] - bv[0]), e2 = __expf(bv[2] - bv[0]), e3 = __expf(bv[3] - bv[0]);
        const float inv = 1.f / (e0 + e1 + e2 + e3);
        if (((int)(threadIdx.x & 63u)) == 0) {
            *(int4*)(TOPI + (size_t)m * 4) = make_int4(bi[0], bi[1], bi[2], bi[3]);
            *(f32x4*)(TOPW + (size_t)m * 4) = (f32x4){e0 * inv, e1 * inv, e2 * inv, e3 * inv};
            atomicAdd((int*)&hist[bi[0]], 1); atomicAdd((int*)&hist[bi[1]], 1); atomicAdd((int*)&hist[bi[2]], 1); atomicAdd((int*)&hist[bi[3]], 1);
        }
    }
    __syncthreads();
    if (((int)threadIdx.x) < 32) atomicAdd((unsigned*)(F.ctl + CW_CNT + 64 * ((int)threadIdx.x)), (unsigned)hist[((int)threadIdx.x)]);
    __syncthreads();
}

__device__ __forceinline__ void p_conv2(Frame& F) {
    const bf16* X = (const bf16*)(F.ws + WS_XBC); bf16* O = (bf16*)(F.ws + WS_CONV);
    constexpr int NCG = CONVD / 8, total = (T / 8) * NCG;
    for (int idx = F.blk * NTHREADS + ((int)threadIdx.x); idx < total; idx += F.nblk * NTHREADS) {
        const int cg = idx % NCG, tb = idx / NCG, c0 = cg * 8, row0 = tb * 8, t0 = row0 & (SEQ - 1);
        float cw[4][8], cb[8];
#pragma unroll
        for (int w = 0; w < 4; ++w) { const f32x4 a = *(const f32x4*)(F.conv_w + (size_t)w * CONVD + c0), b = *(const f32x4*)(F.conv_w + (size_t)w * CONVD + c0 + 4);
            cw[w][0] = a.x; cw[w][1] = a.y; cw[w][2] = a.z; cw[w][3] = a.w; cw[w][4] = b.x; cw[w][5] = b.y; cw[w][6] = b.z; cw[w][7] = b.w; }
        { const f32x4 a = *(const f32x4*)(F.conv_b + c0), b = *(const f32x4*)(F.conv_b + c0 + 4); cb[0] = a.x; cb[1] = a.y; cb[2] = a.z; cb[3] = a.w; cb[4] = b.x; cb[5] = b.y; cb[6] = b.z; cb[7] = b.w; }
        u32x4 raw[11];
#pragma unroll
        for (int i = 0; i < 11; ++i) { raw[i] = (u32x4){0u, 0u, 0u, 0u}; if (t0 + i - 3 >= 0) raw[i] = *(const u32x4*)(X + (size_t)(row0 + i - 3) * CONVD + c0); }
        float acc[8][8];
#pragma unroll
        for (int tt = 0; tt < 8; ++tt)
#pragma unroll
            for (int c = 0; c < 8; ++c) acc[tt][c] = cb[c];
#pragma unroll
        for (int i = 0; i < 11; ++i) {
            const float xv[8] = {bflo(raw[i].x), bfhi(raw[i].x), bflo(raw[i].y), bfhi(raw[i].y), bflo(raw[i].z), bfhi(raw[i].z), bflo(raw[i].w), bfhi(raw[i].w)};
#pragma unroll
            for (int w = 0; w < 4; ++w) { const int tt = i - w;
                if (tt >= 0 && tt < 8) {
#pragma unroll
                    for (int c = 0; c < 8; ++c) acc[tt][c] += cw[w][c] * xv[c]; } }
        }
#pragma unroll
        for (int tt = 0; tt < 8; ++tt) { u32x4 o; o.x = pk2(siluf_(acc[tt][0]), siluf_(acc[tt][1])); o.y = pk2(siluf_(acc[tt][2]), siluf_(acc[tt][3]));
            o.z = pk2(siluf_(acc[tt][4]), siluf_(acc[tt][5])); o.w = pk2(siluf_(acc[tt][6]), siluf_(acc[tt][7]));
            *(u32x4*)(O + (size_t)(row0 + tt) * CONVD + c0) = o; }
    }
}

__device__ __forceinline__ void p_router2(Frame& F) {
    LAS float* WrT = (LAS float*)F.lds;
    LAS int* hist = (LAS int*)(F.lds + 131072);
    if (((int)threadIdx.x) < 32) hist[((int)threadIdx.x)] = 0;
    for (int i = ((int)threadIdx.x); i < 1024 * 8; i += NTHREADS) { const int k = i >> 3, e4 = (i & 7) * 4; const f32x4 w = *(const f32x4*)(F.router_w + (size_t)k * 32 + e4);
        WrT[(e4 + 0) * 1024 + k] = w.x; WrT[(e4 + 1) * 1024 + k] = w.y; WrT[(e4 + 2) * 1024 + k] = w.z; WrT[(e4 + 3) * 1024 + k] = w.w; }
    int* ROWMAP = (int*)(F.ws + WS_ROWMAP);
    for (int i = F.blk * NTHREADS + ((int)threadIdx.x); i < CAP; i += F.nblk * NTHREADS) ROWMAP[i] = -1;
    __syncthreads();
    const int lane = ((int)(threadIdx.x & 63u)), gw = F.blk * NWAVES + F.wave, NGW = F.nblk * NWAVES;
    bf16* XN2 = (bf16*)(F.ws + WS_XN2); int* TOPI = (int*)(F.ws + WS_TOPI); float* TOPW = (float*)(F.ws + WS_TOPW);
    const float rb = F.router_b[lane >> 1];
    for (int mp = gw; mp < T / 2; mp += NGW) {
        f32x4 v[2][4];
#pragma unroll
        for (int j = 0; j < 2; ++j) {
            const int m = mp * 2 + j;
            const f32x4* xr = (const f32x4*)(F.out + (size_t)m * D) + lane; const f32x4* wr = (const f32x4*)F.norm_ffn + lane;
            float s = 0.f;
#pragma unroll
            for (int q = 0; q < 4; ++q) { v[j][q] = xr[64 * q]; s += (v[j][q].x * v[j][q].x + v[j][q].y * v[j][q].y) + (v[j][q].z * v[j][q].z + v[j][q].w * v[j][q].w); }
            const float rstd = __builtin_amdgcn_rsqf(wave_sum(s) * (1.f / D) + EPS);
#pragma unroll
            for (int q = 0; q < 4; ++q) { v[j][q] = v[j][q] * rstd * wr[64 * q];
#if MOE_FP8
                *(unsigned*)((unsigned char*)XN2 + (size_t)m * D + (lane + 64 * q) * 4) = pk_fp8x4(FP8_ASCALE * v[j][q].x, FP8_ASCALE * v[j][q].y, FP8_ASCALE * v[j][q].z, FP8_ASCALE * v[j][q].w);
#else
                st_bf4(XN2 + (size_t)m * D + (lane + 64 * q) * 4, v[j][q]);
#endif
            }
        }
        float p0[32], p1[32];
        f32x2_t tv[4][4];
#pragma unroll
        for (int q = 0; q < 4; ++q) { tv[q][0] = (f32x2_t){v[0][q].x, v[1][q].x}; tv[q][1] = (f32x2_t){v[0][q].y, v[1][q].y}; tv[q][2] = (f32x2_t){v[0][q].z, v[1][q].z}; tv[q][3] = (f32x2_t){v[0][q].w, v[1][q].w}; }
#pragma unroll
        for (int e = 0; e < 32; ++e) {
            f32x2_t a = {0.f, 0.f};
#pragma unroll
            for (int q = 0; q < 4; ++q) { const f32x4 w = *(const LAS f32x4*)(WrT + e * 1024 + (lane + 64 * q) * 4);
                a = __builtin_elementwise_fma(tv[q][0], (f32x2_t){w.x, w.x}, a); a = __builtin_elementwise_fma(tv[q][1], (f32x2_t){w.y, w.y}, a);
                a = __builtin_elementwise_fma(tv[q][2], (f32x2_t){w.z, w.z}, a); a = __builtin_elementwise_fma(tv[q][3], (f32x2_t){w.w, w.w}, a); }
            p0[e] = a.x; p1[e] = a.y;
        }
#define RS_STEP(P, N, MASK) do { const bool up = (lane & (MASK)) != 0; _Pragma("unroll") for (int i = 0; i < (N); ++i) { const float mine = up ? P[(N) + i] : P[i], other = up ? P[i] : P[(N) + i]; P[i] = mine + __shfl_xor(other, (MASK)); } } while (0)
        RS_STEP(p0, 16, 32); RS_STEP(p0, 8, 16); RS_STEP(p0, 4, 8); RS_STEP(p0, 2, 4); RS_STEP(p0, 1, 2);
        RS_STEP(p1, 16, 32); RS_STEP(p1, 8, 16); RS_STEP(p1, 4, 8); RS_STEP(p1, 2, 4); RS_STEP(p1, 1, 2);
#undef RS_STEP
        float lg[2] = {p0[0] + __shfl_xor(p0[0], 1) + rb, p1[0] + __shfl_xor(p1[0], 1) + rb};
#pragma unroll
        for (int j = 0; j < 2; ++j) {
            const int m = mp * 2 + j; float val = lg[j]; int bi[4]; float bv[4];
#pragma unroll
            for (int k = 0; k < 4; ++k) {
                float mx = val;
#pragma unroll
                for (int o = 1; o < 64; o <<= 1) mx = fmaxf(mx, __shfl_xor(mx, o));
                const unsigned long long bal = __ballot(val == mx);
                const int e = (int)(__ffsll((long long)bal) - 1) >> 1;
                bi[k] = e; bv[k] = mx;
                if ((lane >> 1) == e) val = -INFINITY;
            }
            const float e1 = __expf(bv[1] - bv[0]), e2 = __expf(bv[2] - bv[0]), e3 = __expf(bv[3] - bv[0]);
            const float inv = __builtin_amdgcn_rcpf(1.f + e1 + e2 + e3);
            if (lane == 0) {
                *(int4*)(TOPI + (size_t)m * 4) = make_int4(bi[0], bi[1], bi[2], bi[3]);
                *(f32x4*)(TOPW + (size_t)m * 4) = (f32x4){inv, e1 * inv, e2 * inv, e3 * inv};
                atomicAdd((int*)&hist[bi[0]], 1); atomicAdd((int*)&hist[bi[1]], 1); atomicAdd((int*)&hist[bi[2]], 1); atomicAdd((int*)&hist[bi[3]], 1);
            }
        }
    }
    __syncthreads();
    if (((int)threadIdx.x) < 32) atomicAdd((unsigned*)(F.ctl + CW_CNT + 64 * ((int)threadIdx.x)), (unsigned)hist[((int)threadIdx.x)]);
    __syncthreads();
}

__device__ __forceinline__ void p_router3(Frame& F) {
    LAS float* XS = (LAS float*)F.lds; LAS float* PW = (LAS float*)(F.lds + 66048); LAS float* P = (LAS float*)(F.lds + 66048 + 33792); LAS int* hist = (LAS int*)(F.lds + 66048 + 33792 + 4224);
    if (((int)threadIdx.x) < 32) hist[((int)threadIdx.x)] = 0;
    int* ROWMAP = (int*)(F.ws + WS_ROWMAP);
    for (int i = F.blk * NTHREADS + ((int)threadIdx.x); i < CAP; i += F.nblk * NTHREADS) ROWMAP[i] = -1;
    const int lane = ((int)(threadIdx.x & 63u)), tid = (int)threadIdx.x;
    bf16* XN2 = (bf16*)(F.ws + WS_XN2); int* TOPI = (int*)(F.ws + WS_TOPI); float* TOPW = (float*)(F.ws + WS_TOPW); const float* W2 = (const float*)(F.ws + WS_WRT);
    const float rb32 = F.router_b[lane & 31];
    const f32x4* wr = (const f32x4*)F.norm_ffn + lane;
    for (int tile = F.blk; tile < T / 32; tile += F.nblk) {
        const int m0 = tile * 32;
        f32x16 acc = {0.f, 0.f, 0.f, 0.f, 0.f, 0.f, 0.f, 0.f, 0.f, 0.f, 0.f, 0.f, 0.f, 0.f, 0.f, 0.f};
        const int i = lane & 31, kh = lane >> 5;
        for (int st = 0; st < 2; ++st) {
            __syncthreads();
#pragma unroll
            for (int j = 0; j < 8; ++j) { const int idx = tid + 512 * j, tk = idx >> 7, c4 = idx & 127;
                *(LAS f32x4*)(XS + tk * 516 + 4 * c4) = *(const f32x4*)(F.out + (size_t)(m0 + tk) * D + 512 * st + 4 * c4); }
            __syncthreads();
            const int kb = 64 * F.wave + 32 * kh;
            const float* bp = W2 + (size_t)(512 * st + kb) * 32 + i;
#pragma unroll
            for (int c = 0; c < 8; ++c) { const f32x4 a = *(const LAS f32x4*)(XS + i * 516 + kb + 4 * c);
                const float b0 = bp[(4 * c + 0) * 32], b1 = bp[(4 * c + 1) * 32], b2 = bp[(4 * c + 2) * 32], b3 = bp[(4 * c + 3) * 32];
                acc = __builtin_amdgcn_mfma_f32_32x32x2f32(a.x, b0, acc, 0, 0, 0); acc = __builtin_amdgcn_mfma_f32_32x32x2f32(a.y, b1, acc, 0, 0, 0);
                acc = __builtin_amdgcn_mfma_f32_32x32x2f32(a.z, b2, acc, 0, 0, 0); acc = __builtin_amdgcn_mfma_f32_32x32x2f32(a.w, b3, acc, 0, 0, 0); }
        }
#pragma unroll
        for (int rg = 0; rg < 16; ++rg) PW[(F.wave * 32 + crow_(rg, kh)) * 33 + i] = acc[rg];
        __syncthreads();
        for (int idx = tid; idx < 1024; idx += NTHREADS) { const int tk = idx >> 5, e = idx & 31; float s = 0.f;
#pragma unroll
            for (int w = 0; w < 8; ++w) s += PW[(w * 32 + tk) * 33 + e];
            P[tk * 33 + e] = s; }
        __syncthreads();
        for (int pp = 0; pp < 2; ++pp) {
            f32x4 v[2][4]; float rstd[2];
#pragma unroll
            for (int j = 0; j < 2; ++j) {
                const int m = m0 + 4 * F.wave + 2 * pp + j;
                float s = 0.f;
#pragma unroll
                for (int q = 0; q < 4; ++q) { v[j][q] = ((const f32x4*)(F.out + (size_t)m * D) + lane)[64 * q]; s += (v[j][q].x * v[j][q].x + v[j][q].y * v[j][q].y) + (v[j][q].z * v[j][q].z + v[j][q].w * v[j][q].w); }
                rstd[j] = __builtin_amdgcn_rsqf(wave_sum(s) * (1.f / D) + EPS);
#pragma unroll
                for (int q = 0; q < 4; ++q) { const f32x4 hv = v[j][q] * rstd[j] * wr[64 * q];
#if MOE_FP8
                    *(unsigned*)((unsigned char*)XN2 + (size_t)m * D + (lane + 64 * q) * 4) = pk_fp8x4(FP8_ASCALE * hv.x, FP8_ASCALE * hv.y, FP8_ASCALE * hv.z, FP8_ASCALE * hv.w);
#else
                    st_bf4(XN2 + (size_t)m * D + (lane + 64 * q) * 4, hv);
#endif
                }
            }
            const int jt = lane >> 5, e32 = lane & 31, t = 4 * F.wave + 2 * pp + jt;
            float val = P[t * 33 + e32] * (jt ? rstd[1] : rstd[0]) + rb32;
            int bi[4]; float bv[4];
#pragma unroll
            for (int k = 0; k < 4; ++k) {
                float mx = val;
#pragma unroll
                for (int o = 1; o < 32; o <<= 1) mx = fmaxf(mx, __shfl_xor(mx, o));
                const unsigned long long bal = __ballot(val == mx);
                const unsigned lo32 = (unsigned)bal, hi32 = (unsigned)(bal >> 32);
                const int e = jt ? (__ffs((int)hi32) - 1) : (__ffs((int)lo32) - 1);
                bi[k] = e; bv[k] = mx;
                if (e32 == e) val = -INFINITY;
            }
            const float e1 = __expf(bv[1] - bv[0]), e2 = __expf(bv[2] - bv[0]), e3 = __expf(bv[3] - bv[0]);
            const float inv = __builtin_amdgcn_rcpf(1.f + e1 + e2 + e3);
            if (e32 == 0) { const int m = m0 + t;
                *(int4*)(TOPI + (size_t)m * 4) = make_int4(bi[0], bi[1], bi[2], bi[3]);
                *(f32x4*)(TOPW + (size_t)m * 4) = (f32x4){inv, e1 * inv, e2 * inv, e3 * inv};
                atomicAdd((int*)&hist[bi[0]], 1); atomicAdd((int*)&hist[bi[1]], 1); atomicAdd((int*)&hist[bi[2]], 1); atomicAdd((int*)&hist[bi[3]], 1);
            }
        }
    }
    __syncthreads();
    if (((int)threadIdx.x) < 32) atomicAdd((unsigned*)(F.ctl + CW_CNT + 64 * ((int)threadIdx.x)), (unsigned)hist[((int)threadIdx.x)]);
    __syncthreads();
}

__device__ __forceinline__ void p_slots(Frame& F) {
    LAS int* hist = (LAS int*)F.lds;
    LAS int* base = hist + 32;
    LAS int* pst = hist + 64;
    if (((int)threadIdx.x) == 0) {
        int acc = 0;
        for (int e = 0; e < 32; ++e) { const int c = (int)__hip_atomic_load((unsigned*)(F.ctl + CW_CNT + 64 * e), __ATOMIC_RELAXED, __HIP_MEMORY_SCOPE_AGENT); pst[e] = acc; acc += (c + MOE_PAD - 1) / MOE_PAD * MOE_PAD; }
        pst[32] = acc;
    }
    __syncthreads();
    if (F.blk == 0) {
        int* TEXP = (int*)(F.ws + WS_SMALL);
        for (int i = ((int)threadIdx.x); i < NT256; i += NTHREADS) { const int r = i * 256; int e = -1;
            for (int k = 0; k < 32; ++k) if (r >= pst[k] && r < pst[k + 1]) e = k;
            TEXP[i] = e; }
        if (((int)threadIdx.x) == 0) TEXP[1024] = pst[32] / 256;
    }
    const int* TOPI = (const int*)(F.ws + WS_TOPI); int* SLOT = (int*)(F.ws + WS_SLOT); int* ROWMAP = (int*)(F.ws + WS_ROWMAP);
    for (int c = F.blk; c < T / 128; c += F.nblk) {
        if (((int)threadIdx.x) < 32) hist[((int)threadIdx.x)] = 0;
        __syncthreads();
        const int ai = c * 512 + ((int)threadIdx.x);
        const int e = TOPI[ai];
        const int lr = atomicAdd((int*)&hist[e], 1);
        __syncthreads();
        if (((int)threadIdx.x) < 32) base[((int)threadIdx.x)] = (int)atomicAdd((unsigned*)(F.ctl + CW_CUR + 64 * ((int)threadIdx.x)), (unsigned)hist[((int)threadIdx.x)]);
        __syncthreads();
        const int slot = pst[e] + base[e] + lr;
        SLOT[ai] = slot; ROWMAP[slot] = ai >> 2;
        __syncthreads();
    }
}

__device__ __forceinline__ void p_final(Frame& F) {
    const int gw = F.blk * NWAVES + F.wave, NGW = F.nblk * NWAVES;
    const int* SLOT = (const int*)(F.ws + WS_SLOT); const float* TOPW = (const float*)(F.ws + WS_TOPW); const bf16* YB = (const bf16*)(F.ws + WS_YB);
    for (int m = gw; m < T; m += NGW) {
        f32x4* xr = (f32x4*)(F.out + (size_t)m * D) + ((int)(threadIdx.x & 63u));
        const f32x4* wr = (const f32x4*)F.norm_final + ((int)(threadIdx.x & 63u));
        f32x4 v[4];
#pragma unroll
        for (int j = 0; j < 4; ++j) v[j] = xr[64 * j];
#pragma unroll
        for (int k = 0; k < 4; ++k) {
            const int sl = SLOT[m * 4 + k]; const float w = TOPW[m * 4 + k];
#pragma unroll
            for (int j = 0; j < 4; ++j) { const u32x2 y = __builtin_nontemporal_load((const u32x2*)(YB + (size_t)sl * 1024 + (((int)(threadIdx.x & 63u)) + 64 * j) * 4));
                v[j].x += w * bflo(y.x); v[j].y += w * bfhi(y.x); v[j].z += w * bflo(y.y); v[j].w += w * bfhi(y.y); }
        }
        float s = 0.f;
#pragma unroll
        for (int j = 0; j < 4; ++j) s += (v[j].x * v[j].x + v[j].y * v[j].y) + (v[j].z * v[j].z + v[j].w * v[j].w);
        const float rstd = __builtin_amdgcn_rsqf(wave_sum(s) * (1.f / D) + EPS);
#pragma unroll
        for (int j = 0; j < 4; ++j) __builtin_nontemporal_store(v[j] * rstd * wr[64 * j], xr + 64 * j);
    }
}


__device__ __forceinline__ void stagger_start(int blk, int nblk, unsigned span_ticks  ) {
    const unsigned long long t0 = __builtin_amdgcn_s_memrealtime();
    const unsigned long long want = (unsigned long long)((blk * 37u) % (unsigned)nblk) * span_ticks / (unsigned)nblk;
    while (__builtin_amdgcn_s_memrealtime() - t0 < want) __builtin_amdgcn_s_sleep(8);
}
__global__ void __launch_bounds__(NTHREADS, 2) fwd(Args args) {
    extern __shared__ __attribute__((aligned(16))) unsigned char lds_raw[];
    Frame F;
    F.lds = (LAS unsigned char*)lds_raw;
    F.tid = threadIdx.x; F.lane = F.tid & 63; F.wave = __builtin_amdgcn_readfirstlane(F.tid >> 6);
    F.blk = blockIdx.x; F.nblk = gridDim.x;
    F.x = args.in[0]; F.w_in = args.in[1]; F.rel_bias = args.in[2]; F.w_ba = args.in[3]; F.conv_w = args.in[4]; F.conv_b = args.in[5];
    F.dt_bias = args.in[6]; F.a_log = args.in[7]; F.d_skip = args.in[8]; F.ssm_norm_w = args.in[9]; F.w_bs = args.in[10]; F.gate_bias = args.in[11];
    F.w_out = args.in[12]; F.norm_mix = args.in[13]; F.norm_ffn = args.in[14]; F.router_w = args.in[15]; F.router_b = args.in[16];
    F.w1 = args.in[17]; F.b1 = args.in[18]; F.w2 = args.in[19]; F.b2 = args.in[20]; F.norm_final = args.in[21];
    F.out = args.out; F.ws = args.ws; F.ctl = (gu32*)(args.ws + WS_CTL);
    volatile LAS unsigned* MISC = (volatile LAS unsigned*)(F.lds + MISC_OFF);
    if (((int)threadIdx.x) < 32) MISC[((int)threadIdx.x)] = 0u;
    __syncthreads();
    XcdBarrier bar; bar.bar = (unsigned*)(F.ctl + CW_BAR); bar.x = 0; bar.st = nullptr;
#if MK_FUSED
    bar = xcd_barrier_post((unsigned*)(F.ctl + CW_BAR), MISC + 8);
#define GRID_BAR() xcd_barrier(bar)
#else
#define GRID_BAR() do { } while (0)
#endif
    const int lo = args.ph_lo, hi = args.ph_hi;
#define IN(k) (lo <= (k) && (k) < hi)
#define SEAM(k) do { if ((k) != 5 && IN(k) && IN((k) + 1)) GRID_BAR();     \
        if (PROBE_TIME == (k) && F.blk == 0 && ((int)threadIdx.x) == 0) { const unsigned long long d_ = __builtin_amdgcn_s_memrealtime() - pt_; const unsigned long long s_ = __builtin_amdgcn_s_memrealtime(); \
            while (__builtin_amdgcn_s_memrealtime() - s_ < d_) __builtin_amdgcn_s_sleep(8); } \
        if (PROBE_TIME == (k) + 1) pt_ = __builtin_amdgcn_s_memrealtime(); } while (0)
    unsigned long long pt_ = 0; if (PROBE_TIME == 0) pt_ = __builtin_amdgcn_s_memrealtime();
    unsigned char* ws = F.ws;

    if (IN(0)) { p_rmsnorm_in(F); p_convert_small(F); if (PROBE_DUP == 0) { p_rmsnorm_in(F); p_convert_small(F); } } SEAM(0);
    if (IN(1)) {
#if FG_INPROJ
#if QKV_FP8
        {
            pg8::Gemm gq{(const bf16*)(ws + WS_XNQ), (const bf16*)(ws + WS_WQKVQ), T, C_Z, D / 2}; pg8::StaticOrder SQ; SQ.init(T, C_Z, F.nblk, F.blk);
            pg8::EpiInProjF EQ{ws, F.dt_bias, F.gate_bias, -1, 1.f / (FP8_ASCALE * FP8_WSCALE), 0};
            pg8::gemm_phase<pg8::EpiInProjF, pg8::StaticOrder, true, false, false, true>(F.lds, gq, SQ, EQ, nullptr, nullptr, 0);
        }
        constexpr int PN0 = C_Z / 256;
#else
        constexpr int PN0 = 0;
#endif
        pg8::Gemm g{(const bf16*)(ws + WS_XN), (const bf16*)(ws + WS_WIN_T) + (size_t)PN0 * 256 * D, T, NPROJ_PAD - PN0 * 256, D}; pg8::StaticOrder S; S.init(T, NPROJ_PAD - PN0 * 256, F.nblk, F.blk);
        pg8::EpiInProjF E{ws, F.dt_bias, F.gate_bias, -1, 1.f, PN0};
        if (STAGGER_TICKS) stagger_start(F.blk, F.nblk, STAGGER_TICKS);
        unsigned long long pc0_ = 0, pt0_ = 0;
        if (PROBE_DUP == 300) { pc0_ = clock64(); pt0_ = __builtin_amdgcn_s_memrealtime(); }
        pg8::gemm_phase<pg8::EpiInProjF, pg8::StaticOrder, true, false, false>(F.lds, g, S, E, nullptr, nullptr, 0);
        if (PROBE_DUP == 300 && F.blk == 0 && ((int)threadIdx.x) == 0) {
            const unsigned long long dc = clock64() - pc0_, dt = __builtin_amdgcn_s_memrealtime() - pt0_;
            const unsigned long long want = dc * 5000ull / (dt ? dt : 1ull);
            const unsigned long long s0 = __builtin_amdgcn_s_memrealtime();
            while (__builtin_amdgcn_s_memrealtime() - s0 < want) __builtin_amdgcn_s_sleep(8);
        }
        if (PROBE_DUP == 301 && F.blk == 0 && ((int)threadIdx.x) == 0) {
            const unsigned long long s0 = __builtin_amdgcn_s_memrealtime();
            while (__builtin_amdgcn_s_memrealtime() - s0 < 50000ull) __builtin_amdgcn_s_sleep(8);
        }
        if (PROBE_DUP == 103) { pg8::EpiNullF EN; pg8::Gemm g2{(const bf16*)(ws + WS_XN), (const bf16*)(ws + WS_WIN_T), 16384, 3072, D}; pg8::StaticOrder S2; S2.init(16384, 3072, F.nblk, F.blk);
            pg8::gemm_phase<pg8::EpiNullF, pg8::StaticOrder, true, false, false>(F.lds, g2, S2, EN, nullptr, nullptr, 0); }
        if (PROBE_DUP == 105) { pg8::EpiNullF EN; pg8::Gemm g2{(const bf16*)(ws + WS_XN), (const bf16*)(ws + WS_WIN_T), 16384, 3072, 512}; pg8::StaticOrder S2; S2.init(16384, 3072, F.nblk, F.blk);
            for (int rr = 0; rr < 4; ++rr) pg8::gemm_phase<pg8::EpiNullF, pg8::StaticOrder, true, false, false, true>(F.lds, g2, S2, EN, nullptr, nullptr, 0); }
        if (PROBE_DUP == 104) { pg8::EpiNullF EN; pg8::Gemm g2{(const bf16*)(ws + WS_XN), (const bf16*)(ws + WS_WIN_T), 16384, 3072, D}; pg8::StaticOrder S2; S2.init(16384, 3072, F.nblk, F.blk);
            for (int rr = 0; rr < 4; ++rr) pg8::gemm_phase<pg8::EpiNullF, pg8::StaticOrder, true, false, false>(F.lds, g2, S2, EN, nullptr, nullptr, 0); }
        if (PROBE_DUP == 101) { pg8::EpiNullF EN; pg8::gemm_phase<pg8::EpiNullF, pg8::StaticOrder, true, false, false>(F.lds, g, S, EN, nullptr, nullptr, 0); }
        if (PROBE_DUP == 1) { pg8::gemm_phase<pg8::EpiInProjF, pg8::StaticOrder, true, false, false>(F.lds, g, S, E, nullptr, nullptr, 0); }
#else
        EpiInProj E{ws, F.dt_bias, F.gate_bias}; gemm_naive(F, T / 128, NPROJ, D, (const bf16*)(ws + WS_XN), D, nullptr, F.w_in, NPROJ, nullptr, 0, E);
#endif
    } SEAM(1);
#if FA_ATTN
    if (IN(2)) {
        if (PROBE_DUP == 201) { p_attn_fast<false, true>(F); GRID_BAR(); }
        if (PROBE_DUP == 202) { p_attn_fast<true, false>(F); GRID_BAR(); }
        if (PROBE_DUP == 203) { p_attn_fast<false, false>(F); GRID_BAR(); }
        p_attn_fast(F); if (PROBE_DUP == 2) p_attn_fast(F); } SEAM(2);
    if (IN(3)) { p_attn_merge(F); p_conv2(F); if (PROBE_DUP == 3) { p_attn_merge(F); p_conv2(F); } } SEAM(3);
#else
    if (IN(2)) { p_attn_naive(F); } SEAM(2);
    if (IN(3)) { p_conv(F); } SEAM(3);
#endif
#if FS_SSD
    if (IN(4)) { p_ssd_fast2(F); if (PROBE_DUP == 4) p_ssd_fast2(F); } SEAM(4);
#if MOE_FP8
    if (IN(5)) { p_ypost2(F); p_convert_moe_fp8(F); if (PROBE_DUP == 5) { p_convert_moe_fp8(F); } } SEAM(5);
#else
    if (IN(5)) { p_ypost2(F); p_convert_moe(F); if (PROBE_DUP == 5) { p_convert_moe(F); } } SEAM(5);
#endif
#else
    if (IN(4)) { p_ssd_naive(F); } SEAM(4);
    if (IN(5)) { p_ypost(F); p_convert_moe(F); } SEAM(5);
#endif
    if (IN(6)) {
        __syncthreads();
#if FG_MIX
        pg8::Gemm g{(const bf16*)(ws + WS_ATTN), (const bf16*)(ws + WS_WBA_T), T, D, 512}; pg8::StaticOrder S; S.init(T, D, F.nblk, F.blk);
        pg8::EpiM0F E{ws};
        pg8::gemm_phase<pg8::EpiM0F, pg8::StaticOrder, true, false, false>(F.lds, g, S, E, nullptr, nullptr, 0);
        if (PROBE_DUP == 6) { pg8::gemm_phase<pg8::EpiM0F, pg8::StaticOrder, true, false, false>(F.lds, g, S, E, nullptr, nullptr, 0); }
#else
        EpiM0 E{ws}; gemm_naive(F, T / 128, D, 512, (const bf16*)(ws + WS_ATTN), 512, nullptr, F.w_ba, D, nullptr, 0, E);
#endif
    } SEAM(6);
    if (IN(7)) {
#if FG_MIX
        pg8::Gemm g{(const bf16*)(ws + WS_YN), (const bf16*)(ws + WS_WBS_T), T, D, DI}; pg8::StaticOrder S; S.init(T, D, F.nblk, F.blk);
        pg8::EpiMergedF E{ws};
        pg8::gemm_phase<pg8::EpiMergedF, pg8::StaticOrder, true, false, false>(F.lds, g, S, E, nullptr, nullptr, 0);
        if (PROBE_DUP == 7) { pg8::gemm_phase<pg8::EpiMergedF, pg8::StaticOrder, true, false, false>(F.lds, g, S, E, nullptr, nullptr, 0); }
#else
        EpiMerged E{ws}; gemm_naive(F, T / 128, D, DI, (const bf16*)(ws + WS_YN), DI, nullptr, F.w_bs, D, nullptr, 0, E);
#endif
    } SEAM(7);
    if (IN(8)) {
#if FG_MIX
        pg8::Gemm g{(const bf16*)(ws + WS_MERGED), (const bf16*)(ws + WS_WOUT_T), T, D, D}; pg8::StaticOrder S; S.init(T, D, F.nblk, F.blk);
        pg8::EpiX1F E{F.x, F.out};
        pg8::gemm_phase<pg8::EpiX1F, pg8::StaticOrder, true, false, false>(F.lds, g, S, E, nullptr, nullptr, 0);
        if (PROBE_DUP == 8) { pg8::gemm_phase<pg8::EpiX1F, pg8::StaticOrder, true, false, false>(F.lds, g, S, E, nullptr, nullptr, 0); }
#else
        EpiX1 E{F.x, F.out}; gemm_naive(F, T / 128, D, D, (const bf16*)(ws + WS_MERGED), D, nullptr, F.w_out, D, nullptr, 0, E);
#endif
    } SEAM(8);
    if (IN(9)) { p_router3(F); } SEAM(9);
    if (IN(10)) { p_slots(F); } SEAM(10);
    if (IN(11)) {
#if FG_MOE && MOE_FP8
        const int* texp = (const int*)(ws + WS_SMALL); const int ntile = texp[1024];
        pg8::Gemm g{(const bf16*)(ws + WS_XN2), (const bf16*)(ws + WS_W1T), CAP, 2048, 512}; pg8::MoeOrder S; S.init(ntile, 8, F.nblk, F.blk);
        pg8::EpiMoe1Q E{ws, F.b1, texp};
        pg8::gemm_phase<pg8::EpiMoe1Q, pg8::MoeOrder, true, true, true, true>(F.lds, g, S, E, (const int*)(ws + WS_ROWMAP), texp, (size_t)2048 * 1024);
        if (PROBE_DUP == 11) { pg8::gemm_phase<pg8::EpiMoe1Q, pg8::MoeOrder, true, true, true, true>(F.lds, g, S, E, (const int*)(ws + WS_ROWMAP), texp, (size_t)2048 * 1024); }
#elif FG_MOE
        const int* texp = (const int*)(ws + WS_SMALL); const int ntile = texp[1024];
        pg8::Gemm g{(const bf16*)(ws + WS_XN2), (const bf16*)(ws + WS_W1T), CAP, 2048, D}; pg8::MoeOrder S; S.init(ntile, 8, F.nblk, F.blk);
        pg8::EpiMoe1F E{ws, F.b1, texp};
        pg8::gemm_phase<pg8::EpiMoe1F, pg8::MoeOrder, true, true, true>(F.lds, g, S, E, (const int*)(ws + WS_ROWMAP), texp, (size_t)2048 * 1024 * 2);
#else
        EpiMoe1 E{ws, F.b1}; gemm_naive(F, CAP / 128, 2048, D, (const bf16*)(ws + WS_XN2), D, (const int*)(ws + WS_ROWMAP), F.w1, 2048, (const int*)(ws + WS_SMALL), (size_t)1024 * 2048, E);
#endif
    } SEAM(11);
    if (IN(12)) {
#if FG_MOE && MOE_FP8
        const int* texp = (const int*)(ws + WS_SMALL); const int ntile = texp[1024];
        pg8::Gemm g{(const bf16*)(ws + WS_ACT), (const bf16*)(ws + WS_W2T), CAP, 1024, 512}; pg8::MoeOrder S; S.init(ntile, 4, F.nblk, F.blk);
        pg8::EpiMoe2Q E{ws, F.b2, texp};
        pg8::gemm_phase<pg8::EpiMoe2Q, pg8::MoeOrder, true, false, true, true>(F.lds, g, S, E, nullptr, texp, (size_t)1024 * 1024);
        if (PROBE_DUP == 12) { pg8::gemm_phase<pg8::EpiMoe2Q, pg8::MoeOrder, true, false, true, true>(F.lds, g, S, E, nullptr, texp, (size_t)1024 * 1024); }
#elif FG_MOE
        const int* texp = (const int*)(ws + WS_SMALL); const int ntile = texp[1024];
        pg8::Gemm g{(const bf16*)(ws + WS_ACT), (const bf16*)(ws + WS_W2T), CAP, 1024, 1024}; pg8::MoeOrder S; S.init(ntile, 4, F.nblk, F.blk);
        pg8::EpiMoe2F E{ws, F.b2, texp};
        pg8::gemm_phase<pg8::EpiMoe2F, pg8::MoeOrder, true, false, true>(F.lds, g, S, E, nullptr, texp, (size_t)1024 * 1024 * 2);
#else
        EpiMoe2 E{ws, F.b2}; gemm_naive(F, CAP / 128, 1024, 1024, (const bf16*)(ws + WS_ACT), 1024, nullptr, F.w2, 1024, (const int*)(ws + WS_SMALL), (size_t)1024 * 1024, E);
#endif
    } SEAM(12);
    if (IN(13)) { p_final(F); } SEAM(13);
#undef IN
#undef SEAM
}

extern "C" void kernel_launch(void* const* d_in, const int* in_sizes, int n_in, void* d_out, int out_size, void* d_ws, size_t ws_size, hipStream_t stream) {
    static int grid = 0;
    if (grid == 0) {
        if (n_in != 22 || out_size != T * D || ws_size < WS_END) { fprintf(stderr, "kernel_launch: unexpected shapes: n_in %d out %d ws %zu\n", n_in, out_size, ws_size); grid = -1; return; }
        int dev = 0, cus = 0, per_cu = 0;
        if (hipGetDevice(&dev) != hipSuccess || hipDeviceGetAttribute(&cus, hipDeviceAttributeMultiprocessorCount, dev) != hipSuccess) { grid = -1; return; }
        if (hipFuncSetAttribute((const void*)fwd, hipFuncAttributeMaxDynamicSharedMemorySize, LDS_BYTES) != hipSuccess) { fprintf(stderr, "kernel_launch: hipFuncSetAttribute failed\n"); grid = -1; return; }
        if (hipOccupancyMaxActiveBlocksPerMultiprocessor(&per_cu, (const void*)fwd, NTHREADS, LDS_BYTES) != hipSuccess || per_cu < 1) fprintf(stderr, "kernel_launch: occupancy query says %d\n", per_cu);
        (void)hipGetLastError();
        grid = cus;
    }
    if (grid < 0) return;
    (void)hipMemsetAsync((char*)d_ws + WS_CTL, 0, CTL_ZERO_BYTES, stream);
    Args a{};
    for (int i = 0; i < 22; ++i) a.in[i] = (const float*)d_in[i];
    a.out = (float*)d_out; a.ws = (unsigned char*)d_ws;
#if MK_FUSED
    a.ph_lo = 0; a.ph_hi = NPHASE; a.li = 0;
    hipLaunchKernelGGL(fwd, dim3(grid), dim3(NTHREADS), LDS_BYTES, stream, a);
#else
    for (int p = 0; p < NPHASE; ++p) { a.ph_lo = p; a.ph_hi = p + 1; a.li = p; hipLaunchKernelGGL(fwd, dim3(grid), dim3(NTHREADS), LDS_BYTES, stream, a); }
#endif
}
```

```cpp
#include <hip/hip_runtime.h>
#include <cstdio>
#include <cstdint>

#ifndef MK_FUSED
#define MK_FUSED 1
#endif

#ifndef FG_INPROJ
#define FG_INPROJ 1
#endif
#ifndef PROBE_DUP
#define PROBE_DUP (-1)
#endif
#ifndef STAGGER_TICKS
#define STAGGER_TICKS 0
#endif
#ifndef SSD_REP_A
#define SSD_REP_A 1
#endif
#ifndef SSD_REP_W
#define SSD_REP_W 1
#endif
#ifndef PROBE_TIME
#define PROBE_TIME (-1)
#endif
#ifndef PROBE_SEC
#define PROBE_SEC (-1)
#endif
#ifndef FA_ATTN
#define FA_ATTN 1
#endif
#ifndef FS_SSD
#define FS_SSD 1
#endif
#ifndef MOE_FP8
#define MOE_FP8 1
#endif
#ifndef FP8_X128
#define FP8_X128 1
#endif
#ifndef QKV_FP8
#define QKV_FP8 1
#endif
#ifndef QKV_STORE_FP8
#define QKV_STORE_FP8 1
#endif
#ifndef FG_MIX
#define FG_MIX 1
#endif
#ifndef FG_MOE
#define FG_MOE 1
#endif
#define GAS __attribute__((address_space(1)))
#define LAS __attribute__((address_space(3)))
typedef unsigned short bf16;
typedef float f32x4 __attribute__((ext_vector_type(4)));
typedef unsigned u32x4 __attribute__((ext_vector_type(4)));
typedef unsigned u32x2 __attribute__((ext_vector_type(2)));
typedef GAS unsigned gu32;

constexpr int BATCH = 16, SEQ = 2048, D = 1024, T = BATCH * SEQ;
constexpr int NPROJ = 11808;
constexpr int AW = 1536;
constexpr int DI = 2048;
constexpr int CONVD = 3072;
constexpr int NH_SSM = 32, NG_SSM = 4, DSTATE = 128;
constexpr int NEXP = 32, TOPK = 4, NASSIGN = T * TOPK;
constexpr int MOE_PAD = 256;
constexpr int CAP = NASSIGN + NEXP * MOE_PAD;
constexpr int NT256 = CAP / 256;
constexpr float EPS = 1e-5f;
constexpr int C_Q = 0, C_K = 1536, C_V = 3072, C_Z = 4608, C_XBC = 6656, C_DT = 9728, C_GATE = 9760;

constexpr size_t MiB = 1u << 20;
constexpr size_t WS_CTL = 0, CTL_ZERO_BYTES = 128 * 1024;
constexpr size_t WS_SMALL = 1 * MiB;
constexpr size_t WS_XN = 34 * MiB;
constexpr size_t WS_Q = 98 * MiB, WS_K = 194 * MiB, WS_V = 290 * MiB;
constexpr size_t WS_Z = 386 * MiB;
constexpr size_t WS_XBC = 514 * MiB;
constexpr size_t WS_GATE = 706 * MiB;
constexpr size_t WS_DT = 834 * MiB;
constexpr size_t WS_ATTN = 838 * MiB;
constexpr size_t WS_M0 = 870 * MiB;
constexpr size_t WS_CONV = WS_K;
constexpr size_t WS_YZ = WS_XBC;
constexpr size_t WS_YN = WS_Z;
constexpr size_t WS_MERGED = WS_XN;
constexpr size_t WS_XN2 = WS_Q;
constexpr size_t WS_TOPI = 162 * MiB;
constexpr size_t WS_TOPW = 163 * MiB;
constexpr size_t WS_SLOT = 164 * MiB;
constexpr size_t WS_ROWMAP = 165 * MiB;
constexpr size_t WS_ACT = 386 * MiB;
constexpr size_t WS_YB = 658 * MiB;
constexpr size_t WS_WIN_T = 2 * MiB;
constexpr size_t WS_WBA_T = 26 * MiB;
constexpr size_t WS_WBS_T = 27 * MiB;
constexpr size_t WS_WOUT_T = 31 * MiB;
constexpr size_t WS_W1T = 194 * MiB;
constexpr size_t WS_W2T = 322 * MiB;
constexpr int NPROJ_PAD = 12032;
constexpr size_t WS_OUTG = 870 * MiB;
constexpr size_t WS_LSE = 966 * MiB;
constexpr size_t WS_BT = 1 * MiB + 65536;
constexpr float FP8_ASCALE = 4.f, FP8_WSCALE = 64.f;
constexpr size_t WS_WRT = 1 * MiB + 131072;
constexpr size_t WS_XNQ = 870 * MiB;
constexpr size_t WS_WQKVQ = 998 * MiB;
constexpr size_t WS_END = 1024 * MiB;
constexpr int CW_TMO = 0;
constexpr int CW_BAR = 4096;
constexpr int CW_CNT = 16384;
constexpr int CW_CUR = 16384 + 64 * 32;

constexpr int NWAVES = 8, NTHREADS = 512;
constexpr int LDS_BYTES = 147456;
constexpr int MISC_OFF = LDS_BYTES - 256;

constexpr int NPHASE = 14;

__device__ __forceinline__ unsigned f2bf(float f) { unsigned u = __builtin_bit_cast(unsigned, f); return (u + 0x7fffu + ((u >> 16) & 1u)) >> 16; }

typedef float f32x2_t __attribute__((ext_vector_type(2))); typedef __bf16 bf16x2_t __attribute__((ext_vector_type(2)));
__device__ __forceinline__ unsigned cvtpk(float lo, float hi) { const f32x2_t v = {lo, hi}; const bf16x2_t b = __builtin_convertvector(v, bf16x2_t); return __builtin_bit_cast(unsigned, b); }
__device__ __forceinline__ unsigned pk2(float lo, float hi) { return cvtpk(lo, hi); }
__device__ __forceinline__ unsigned pk_fp8x4(float a, float b, float c, float d) { int w = __builtin_amdgcn_cvt_pk_fp8_f32(a, b, 0, false); w = __builtin_amdgcn_cvt_pk_fp8_f32(c, d, w, true); return (unsigned)w; }
__device__ __forceinline__ unsigned fp8x2_to_bf16x2(unsigned w, bool hi) { const f32x2_t f = hi ? __builtin_amdgcn_cvt_pk_f32_fp8((int)w, true) : __builtin_amdgcn_cvt_pk_f32_fp8((int)w, false); return cvtpk(f.x, f.y); }
__device__ __forceinline__ u32x4 fp8x8_to_bf16x8(unsigned lo, unsigned hi) { u32x4 o; o.x = fp8x2_to_bf16x2(lo, false); o.y = fp8x2_to_bf16x2(lo, true); o.z = fp8x2_to_bf16x2(hi, false); o.w = fp8x2_to_bf16x2(hi, true); return o; }
__device__ __forceinline__ float bflo(unsigned u) { return __builtin_bit_cast(float, u << 16); }
__device__ __forceinline__ float bfhi(unsigned u) { return __builtin_bit_cast(float, u & 0xffff0000u); }
__device__ __forceinline__ float bf2f(bf16 b) { return __builtin_bit_cast(float, (unsigned)b << 16); }
__device__ __forceinline__ float wave_sum(float v) {
#pragma unroll
    for (int o = 1; o < 64; o <<= 1) v += __shfl_xor(v, o);
    return v;
}
#define LDS_BARRIER() do { asm volatile("s_waitcnt lgkmcnt(0)" ::: "memory"); __builtin_amdgcn_s_barrier(); asm volatile("" ::: "memory"); } while (0)
__device__ __forceinline__ float sigmoidf_(float x) { return __builtin_amdgcn_rcpf(1.f + __expf(-x)); }
__device__ __forceinline__ float siluf_(float x) { return x * __builtin_amdgcn_rcpf(1.f + __expf(-x)); }
__device__ __forceinline__ float softplusf_(float x) { return fmaxf(x, 0.f) + __logf(1.f + __expf(-fabsf(x))); }

#define XB_TMO      128
#define XB_XCNT(j)  (256  + 64 * (j))
#define XB_XSUB(j)  (1280 + 64 * (j))
#define XB_XGEN(j)  (2304 + 64 * (j))
#define XB_TOP      3328
#define XB_TOPGEN   3392
#define XCD_BAR_WORDS 3456
#define XB_SPIN_CAP (1u << 18)
__device__ __forceinline__ unsigned xb_ld(unsigned* p)              { return __hip_atomic_load(p, __ATOMIC_RELAXED, __HIP_MEMORY_SCOPE_AGENT); }
__device__ __forceinline__ unsigned xb_add(unsigned* p, unsigned v) { return __hip_atomic_fetch_add(p, v, __ATOMIC_RELAXED, __HIP_MEMORY_SCOPE_AGENT); }
__device__ __forceinline__ unsigned xb_xcc_id() { return (unsigned)__builtin_amdgcn_s_getreg((3 << 11) | 20) & 0xFu; }
#define XB_SPIN(cond, bar) do { unsigned _sp = 0; while (cond) { __builtin_amdgcn_s_sleep(1); \
    if ((++_sp & 255u) == 0u) { if (xb_ld(&(bar)[XB_TMO])) break; if (_sp > XB_SPIN_CAP) { atomicAdd(&(bar)[XB_TMO], 1u); break; } } } } while (0)
struct XcdBarrier { unsigned* bar; unsigned x; volatile LAS unsigned* st; };
__device__ __forceinline__ XcdBarrier xcd_barrier_post(unsigned* bar, volatile LAS unsigned* st) {
    XcdBarrier b; b.bar = bar; b.x = xb_xcc_id(); b.st = st;
    if (threadIdx.x == 0) (void)xb_add(&bar[XB_XCNT(b.x)], 1u);
    return b;
}
__device__ __forceinline__ void xcd_barrier_complete(unsigned* bar, unsigned x, unsigned& nloc, unsigned& nx) {
    const unsigned G = gridDim.x * gridDim.y * gridDim.z;
    unsigned sum, cnt, mine, sp = 0u;
    for (;;) {
        sum = 0u; cnt = 0u; mine = 0u;
#pragma unroll
        for (unsigned j = 0; j < 16; ++j) { const unsigned c = xb_ld(&bar[XB_XCNT(j)]); sum += c; cnt += (c > 0u) ? 1u : 0u; mine = (j == x) ? c : mine; }
        if (sum == G) break;
        __builtin_amdgcn_s_sleep(1);
        if ((++sp & 255u) == 0u) { if (xb_ld(&bar[XB_TMO])) break; if (sp > XB_SPIN_CAP) { atomicAdd(&bar[XB_TMO], 1u); break; } }
    }
    nloc = mine > 0u ? mine : 1u; nx = cnt > 0u ? cnt : 1u;
}
__device__ __forceinline__ void xcd_barrier(const XcdBarrier& b) {
    asm volatile("s_waitcnt vmcnt(0)" ::: "memory");
    __syncthreads();
    if (threadIdx.x == 0) {
        unsigned* bar = b.bar;
        __builtin_amdgcn_s_waitcnt(0);
        unsigned nloc = b.st[0], nx = b.st[1];
        if (nloc == 0u) { xcd_barrier_complete(bar, b.x, nloc, nx); b.st[0] = nloc; b.st[1] = nx; }
        const unsigned old = xb_add(&bar[XB_XSUB(b.x)], 1u);
        const unsigned gen = old / nloc;
        if (old + 1u == (gen + 1u) * nloc) {
            __builtin_amdgcn_fence(__ATOMIC_RELEASE, "agent");
            asm volatile("s_waitcnt vmcnt(0)" ::: "memory");
            const unsigned og = xb_add(&bar[XB_TOP], 1u);
            const unsigned tg = og / nx;
            if (og + 1u == (tg + 1u) * nx) xb_add(&bar[XB_TOPGEN], 1u);
            else XB_SPIN(xb_ld(&bar[XB_TOPGEN]) == tg, bar);
            __builtin_amdgcn_fence(__ATOMIC_ACQUIRE, "agent");
            xb_add(&bar[XB_XGEN(b.x)], 1u);
            asm volatile("s_waitcnt vmcnt(0)" ::: "memory");
        } else {
            XB_SPIN(xb_ld(&bar[XB_XGEN(b.x)]) == gen, bar);
            __builtin_amdgcn_fence(__ATOMIC_ACQUIRE, "agent");
            asm volatile("s_waitcnt vmcnt(0)" ::: "memory");
        }
    }
    __syncthreads();
}

struct Args { const float* in[22]; float* out; unsigned char* ws; int ph_lo, ph_hi, li, pad; };

struct Frame {
    LAS unsigned char* lds;
    int tid, lane, wave, blk, nblk;
    const float *x, *w_in, *rel_bias, *w_ba, *conv_w, *conv_b, *dt_bias, *a_log, *d_skip, *ssm_norm_w, *w_bs, *gate_bias, *w_out,
                *norm_mix, *norm_ffn, *router_w, *router_b, *w1, *b1, *w2, *b2, *norm_final;
    float* out; unsigned char* ws; gu32* ctl;
};

template <class Epi>
__device__ __forceinline__ void gemm_naive(Frame& F, int nMt, int N, int K, const bf16* A, int lda, const int* rowmap,
                                           const float* B, int ldb, const int* texp, size_t estride, const Epi& epi) {
    LAS float* As = (LAS float*)F.lds;
    LAS float* Bs = As + 16 * 132;
    const int tid = ((int)threadIdx.x), tx = tid & 31, ty = tid >> 5;
    const int nNt = (N + 127) / 128;
    const int ar = tid >> 2, ak = (tid & 3) * 4;
    const int bk = tid >> 5, bn = (tid & 31) * 4;
    for (int tile = F.blk; tile < nMt * nNt; tile += F.nblk) {
        const int mt = tile / nNt, nt = tile % nNt;
        int e = 0;
        if (texp) { e = texp[mt >> 1]; if (e < 0) continue; }
        const float* Bp = B + (size_t)e * estride;
        float acc[8][4];
#pragma unroll
        for (int i = 0; i < 8; ++i)
#pragma unroll
            for (int j = 0; j < 4; ++j) acc[i][j] = 0.f;
        int grow = mt * 128 + ar; if (rowmap) grow = rowmap[grow];
        const bf16* ap = A + (size_t)(grow < 0 ? 0 : grow) * lda + ak;
        const bool aok = grow >= 0;
        const int gcol = nt * 128 + bn;
        const bool bok = gcol < N;
        for (int k0 = 0; k0 < K; k0 += 16) {
            u32x2 av = (u32x2){0u, 0u};
            if (aok) av = *(const u32x2*)(ap + k0);
            f32x4 bv = (f32x4){0.f, 0.f, 0.f, 0.f};
            if (bok) bv = *(const f32x4*)(Bp + (size_t)(k0 + bk) * ldb + gcol);
            __syncthreads();
            As[(ak + 0) * 132 + ar] = bflo(av.x); As[(ak + 1) * 132 + ar] = bfhi(av.x);
            As[(ak + 2) * 132 + ar] = bflo(av.y); As[(ak + 3) * 132 + ar] = bfhi(av.y);
            *(LAS f32x4*)&Bs[bk * 132 + bn] = bv;
            __syncthreads();
#pragma unroll
            for (int k = 0; k < 16; ++k) {
                const f32x4 a0 = *(const LAS f32x4*)&As[k * 132 + ty * 8], a1 = *(const LAS f32x4*)&As[k * 132 + ty * 8 + 4];
                const f32x4 b = *(const LAS f32x4*)&Bs[k * 132 + tx * 4];
                const float a[8] = {a0.x, a0.y, a0.z, a0.w, a1.x, a1.y, a1.z, a1.w};
                const float bb[4] = {b.x, b.y, b.z, b.w};
#pragma unroll
                for (int i = 0; i < 8; ++i)
#pragma unroll
                    for (int j = 0; j < 4; ++j) acc[i][j] = fmaf(a[i], bb[j], acc[i][j]);
            }
        }
        const int col0 = nt * 128 + tx * 4;
        if (col0 < N) {
#pragma unroll
            for (int i = 0; i < 8; ++i) epi(mt * 128 + ty * 8 + i, col0, (f32x4){acc[i][0], acc[i][1], acc[i][2], acc[i][3]}, e);
        }
    }
    __syncthreads();
}

__device__ __forceinline__ void st_bf4(bf16* p, f32x4 v) { u32x2 w; w.x = pk2(v.x, v.y); w.y = pk2(v.z, v.w); *(u32x2*)p = w; }

struct EpiInProj {
    unsigned char* ws; const float* dt_bias; const float* gate_bias;
    __device__ __forceinline__ void operator()(int row, int col, f32x4 v, int) const {
        if (col < C_K)        st_bf4((bf16*)(ws + WS_Q) + (size_t)row * AW + (col - C_Q), v);
        else if (col < C_V)   st_bf4((bf16*)(ws + WS_K) + (size_t)row * AW + (col - C_K), v);
        else if (col < C_Z)   st_bf4((bf16*)(ws + WS_V) + (size_t)row * AW + (col - C_V), v);
        else if (col < C_XBC) st_bf4((bf16*)(ws + WS_Z) + (size_t)row * DI + (col - C_Z), v);
        else if (col < C_DT)  st_bf4((bf16*)(ws + WS_XBC) + (size_t)row * CONVD + (col - C_XBC), v);
        else if (col < C_GATE) { const int c = col - C_DT; f32x4 o;
            o.x = softplusf_(v.x + dt_bias[c]); o.y = softplusf_(v.y + dt_bias[c + 1]); o.z = softplusf_(v.z + dt_bias[c + 2]); o.w = softplusf_(v.w + dt_bias[c + 3]);
            float* dp = (float*)(ws + WS_DT) + row; dp[(size_t)c * T] = o.x; dp[(size_t)(c + 1) * T] = o.y; dp[(size_t)(c + 2) * T] = o.z; dp[(size_t)(c + 3) * T] = o.w; }
        else { const int c = col - C_GATE; f32x4 o;
            o.x = sigmoidf_(v.x + gate_bias[c]); o.y = sigmoidf_(v.y + gate_bias[c + 1]); o.z = sigmoidf_(v.z + gate_bias[c + 2]); o.w = sigmoidf_(v.w + gate_bias[c + 3]);
            st_bf4((bf16*)(ws + WS_GATE) + (size_t)row * 2048 + c, o); }
    }
};
struct EpiM0 {
    unsigned char* ws;
    __device__ __forceinline__ void operator()(int row, int col, f32x4 v, int) const {
        const u32x2 g = *(const u32x2*)((const bf16*)(ws + WS_GATE) + (size_t)row * 2048 + col);
        f32x4 o; o.x = v.x * bflo(g.x); o.y = v.y * bfhi(g.x); o.z = v.z * bflo(g.y); o.w = v.w * bfhi(g.y);
        st_bf4((bf16*)(ws + WS_M0) + (size_t)row * D + col, o);
    }
};
struct EpiMerged {
    unsigned char* ws;
    __device__ __forceinline__ void operator()(int row, int col, f32x4 v, int) const {
        const u32x2 g = *(const u32x2*)((const bf16*)(ws + WS_GATE) + (size_t)row * 2048 + 1024 + col);
        const u32x2 mw = *(const u32x2*)((const bf16*)(ws + WS_M0) + (size_t)row * D + col); const f32x4 m = (f32x4){bflo(mw.x), bfhi(mw.x), bflo(mw.y), bfhi(mw.y)};
        f32x4 o; o.x = m.x + v.x * bflo(g.x); o.y = m.y + v.y * bfhi(g.x); o.z = m.z + v.z * bflo(g.y); o.w = m.w + v.w * bfhi(g.y);
        st_bf4((bf16*)(ws + WS_MERGED) + (size_t)row * D + col, o);
    }
};
struct EpiX1 {
    const float* x; float* out;
    __device__ __forceinline__ void operator()(int row, int col, f32x4 v, int) const {
        const f32x4 xv = *(const f32x4*)(x + (size_t)row * D + col);
        *(f32x4*)(out + (size_t)row * D + col) = xv + v;
    }
};
__device__ __forceinline__ float swiglu_(float g, float l) {
    g = fminf(g, 7.f); l = fminf(fmaxf(l, -7.f), 7.f);
    return g * sigmoidf_(1.702f * g) * (l + 1.f);
}
struct EpiMoe1 {
    unsigned char* ws; const float* b1;
    __device__ __forceinline__ void operator()(int row, int col, f32x4 v, int e) const {
        const f32x4 b = *(const f32x4*)(b1 + (size_t)e * 2048 + col);
        const float o0 = swiglu_(v.x + b.x, v.y + b.y), o1 = swiglu_(v.z + b.z, v.w + b.w);
        *(unsigned*)((bf16*)(ws + WS_ACT) + (size_t)row * 1024 + (col >> 1)) = pk2(o0, o1);
    }
};
struct EpiMoe2 {
    unsigned char* ws; const float* b2;
    __device__ __forceinline__ void operator()(int row, int col, f32x4 v, int e) const {
        const f32x4 b = *(const f32x4*)(b2 + (size_t)e * 1024 + col);
        st_bf4((bf16*)(ws + WS_YB) + (size_t)row * 1024 + col, v + b);
    }
};

namespace pg8 {
typedef short bf16x8 __attribute__((ext_vector_type(8)));
typedef long i64x2 __attribute__((ext_vector_type(2)));
typedef int i32x4 __attribute__((ext_vector_type(4)));
typedef int i32x8 __attribute__((ext_vector_type(8)));
constexpr int BM = 256, BK = 64, HALF = 128, HTB = HALF * BK * 2, STAGE_BYTES = 8 * HTB, NXCD = 8, WGM = 8;
__host__ __device__ __forceinline__ int lds_byte(int r, int c) { const int st = (r >> 4) * 2 + (c >> 5), rr = r & 15, cc = c & 31, ob = rr * 64 + cc * 2; return st * 1024 + (ob ^ (((ob >> 9) & 1) << 5)); }
__host__ __device__ __forceinline__ void stage_rc(int b, int& R, int& C) { const int st = b / 1024, sb = b % 1024, swz = sb ^ (((sb >> 9) & 1) << 5); R = (st >> 1) * 16 + swz / 64; C = (st & 1) * 32 + (swz % 64) / 2; }
__host__ __device__ __forceinline__ int perm32(int rho) { const int n = rho >> 4, i = rho & 15; return 8 * (i >> 2) + 4 * n + (i & 3); }
struct Unit { int pm, pn; };
struct Gemm { const bf16* A; const bf16* Bt; int M, N, K; };
struct StaticOrder {
    int nM, nN, nwg, G, c;
    __host__ __device__ void init(int M, int N, int G_, int c_) { nM = M / BM; nN = N / BM; nwg = nM * nN; G = G_; c = c_; }
    __host__ __device__ bool next(int i, Unit& u) const {
        const long L = (long)i * G + c; if (L >= nwg) return false;
        int wgid = (int)L; { const int q = nwg / NXCD, r = nwg % NXCD, xcd = wgid % NXCD, off = wgid / NXCD; wgid = (xcd < r ? xcd * (q + 1) : r * (q + 1) + (xcd - r) * q) + off; }
        const int nig = WGM * nN, gid = wgid / nig, fm = gid * WGM, gsz = (nM - fm) < WGM ? (nM - fm) : WGM;
        u.pm = fm + ((wgid % nig) % gsz); u.pn = (wgid % nig) / gsz; return true;
    }
    __device__ __forceinline__ void a_ready(const Unit&) const {}
    __device__ __forceinline__ void done(const Unit&) const {}
};
struct MoeOrder {
    int nwg, nN, G, c;
    __device__ void init(int ntile, int nN_, int G_, int c_) { nN = nN_; nwg = ntile * nN_; G = G_; c = c_; }
    __device__ bool next(int i, Unit& u) const { const long L = (long)i * G + c; if (L >= nwg) return false; u.pm = (int)L / nN; u.pn = (int)L % nN; return true; }
    __device__ __forceinline__ void a_ready(const Unit&) const {}
    __device__ __forceinline__ void done(const Unit&) const {}
};
__device__ __forceinline__ unsigned cvt_pk_bf16(float lo, float hi) { unsigned r; asm volatile("v_cvt_pk_bf16_f32 %0, %1, %2" : "=v"(r) : "v"(lo), "v"(hi)); return r; }

template <class Epi, class Sched, bool ALIGN_EPI, bool GATHER, bool EXPERT, bool FP8 = false>
__device__ __forceinline__ void gemm_phase(LAS unsigned char* lds, const Gemm g, const Sched& S, const Epi& E, const int* rowmap, const int* texp, size_t bstride) {
    int tid_ = threadIdx.x; asm volatile("" : "+v"(tid_));
    const int tid = tid_, wid = __builtin_amdgcn_readfirstlane(tid >> 6), lane = tid & 63, wr = wid >> 2, wc = wid & 3, fr = lane & 15, fq = lane >> 4;
    const int K = g.K, nt = K / BK;
    unsigned voffA[2], voffB[2], voffB1[2]; int RA[2]; unsigned CAb[2];
#pragma unroll
    for (int i = 0; i < 2; ++i) { int R, C; stage_rc(tid * 16 + i * 8192, R, C); const int Rb = Epi::PERM ? ((R & ~31) + perm32(R & 31)) : R;
        voffA[i] = (unsigned)(R * K + C) * 2u; voffB[i] = (unsigned)(Rb * K + C) * 2u; voffB1[i] = voffB[i] + (unsigned)(HALF * K * 2); RA[i] = R; CAb[i] = (unsigned)C * 2u;
        if constexpr (Epi::WIDE) {
            voffB[i] = (unsigned)((64 * (R >> 5) + perm32(R & 31)) * K + C) * 2u; voffB1[i] = (unsigned)((64 * (R >> 5) + 32 + perm32(R & 31)) * K + C) * 2u; } }
    const size_t kstep = (size_t)(BK * 2);
    const size_t hstep = (size_t)HALF * K * 2;
    const size_t tstep = 2 * hstep;
    const size_t ahs = GATHER ? 0 : hstep;
    const unsigned ldsw = (unsigned)wid * 1024u;
    const int aoff = lds_byte(wr * 64 + fr, fq * 8), boff = lds_byte(wc * 32 + fr, fq * 8);
#define PG8_SA(b, h) (((b) * 2 + (h)) * HTB)
#define PG8_SB(b, h) ((4 + (b) * 2 + (h)) * HTB)
#define PG8_STAGE(bufoff, gbase, voff) do { _Pragma("unroll") for (int _i = 0; _i < 2; ++_i) { unsigned _v = (voff)[_i]; const char* _g = (const char*)(gbase); asm volatile("" : "+v"(_v), "+s"(_g));     \
        __builtin_amdgcn_global_load_lds((const unsigned*)(_g + _v), (LAS unsigned*)(lds + (bufoff) + ldsw + _i * 8192), 16, 0, 0); } } while (0)
#define PG8_LDA(dst, b, h) do { _Pragma("unroll") for (int m = 0; m < 4; ++m) _Pragma("unroll") for (int k = 0; k < 2; ++k) dst[m][k] = *(const LAS bf16x8*)(lds + PG8_SA(b, h) + aoff + m * 2048 + k * 1024); } while (0)
#define PG8_LDB(dst, b, h) do { _Pragma("unroll") for (int n = 0; n < 2; ++n) _Pragma("unroll") for (int k = 0; k < 2; ++k) dst[n][k] = *(const LAS bf16x8*)(lds + PG8_SB(b, h) + boff + n * 2048 + k * 1024); } while (0)
#define PG8_MMA(ai, bj, At, Bt) do { __builtin_amdgcn_s_setprio(1); if constexpr (FP8 && FP8_X128) asm volatile("s_nop 1"); _Pragma("unroll") for (int m = 0; m < 4; ++m) _Pragma("unroll") for (int n = 0; n < 2; ++n) _Pragma("unroll") for (int k = 0; k < 2; ++k) { \
        if constexpr (FP8 && FP8_X128) { if (k == 0) {     \
            const i32x8 b_ = __builtin_shufflevector(__builtin_bit_cast(i32x4, Bt[n][0]), __builtin_bit_cast(i32x4, Bt[n][1]), 0, 1, 2, 3, 4, 5, 6, 7), a_ = __builtin_shufflevector(__builtin_bit_cast(i32x4, At[m][0]), __builtin_bit_cast(i32x4, At[m][1]), 0, 1, 2, 3, 4, 5, 6, 7); \
            asm volatile("v_mfma_f32_16x16x128_f8f6f4 %0, %1, %2, %0" : "+v"(acc[ai][bj][m][n]) : "v"(b_), "v"(a_)); } }     \
        else if constexpr (FP8) { const i64x2 b_ = __builtin_bit_cast(i64x2, Bt[n][k]), a_ = __builtin_bit_cast(i64x2, At[m][k]);     \
            acc[ai][bj][m][n] = __builtin_amdgcn_mfma_f32_16x16x32_fp8_fp8(b_[0], a_[0], acc[ai][bj][m][n], 0, 0, 0); acc[ai][bj][m][n] = __builtin_amdgcn_mfma_f32_16x16x32_fp8_fp8(b_[1], a_[1], acc[ai][bj][m][n], 0, 0, 0); } \
        else acc[ai][bj][m][n] = __builtin_amdgcn_mfma_f32_16x16x32_bf16(Bt[n][k], At[m][k], acc[ai][bj][m][n], 0, 0, 0); } __builtin_amdgcn_s_setprio(0); } while (0)
#define PG8_WAIT_V(n) asm volatile("s_waitcnt vmcnt(" #n ")" ::: "memory")
#define PG8_WAIT_L(n) asm volatile("s_waitcnt lgkmcnt(" #n ")" ::: "memory")
#define PG8_BAR __builtin_amdgcn_s_barrier()
#define PG8_SCHED __builtin_amdgcn_sched_barrier(0)
#define PG8_ROWS(u, v) do { _Pragma("unroll") for (int _h = 0; _h < 2; ++_h) _Pragma("unroll") for (int _i = 0; _i < 2; ++_i) { int _r = rowmap[(u).pm * BM + _h * HALF + RA[_i]]; _r = _r < 0 ? 0 : _r; \
        v[_h][_i] = (unsigned)_r * (unsigned)(K * 2) + CAb[_i]; } } while (0)
#define PG8_BPTR(u) ((const char*)g.Bt + (EXPERT ? (size_t)texp[(u).pm] * bstride : (size_t)0) + (size_t)(u).pn * tstep)
#define PG8_APTR(u) ((const char*)g.A + (GATHER ? (size_t)0 : (size_t)(u).pm * tstep))
    Unit cur, nxt; int ui = 0;
    if (!S.next(0, cur)) return;
    f32x4 acc[2][2][4][2];
#pragma unroll
    for (int a = 0; a < 2; ++a)
#pragma unroll
        for (int b = 0; b < 2; ++b)
#pragma unroll
            for (int m = 0; m < 4; ++m)
#pragma unroll
                for (int n = 0; n < 2; ++n) acc[a][b][m][n] = (f32x4){0.f, 0.f, 0.f, 0.f};
    bf16x8 At[4][2], B0[2][2], B1[2][2];
    unsigned cv[2][2], nv[2][2];
    if constexpr (GATHER) { PG8_ROWS(cur, cv); } else { cv[0][0] = voffA[0]; cv[0][1] = voffA[1]; cv[1][0] = voffA[0]; cv[1][1] = voffA[1]; }
#pragma unroll
    for (int h = 0; h < 2; ++h) { nv[h][0] = cv[h][0]; nv[h][1] = cv[h][1]; }
    const char* cA = PG8_APTR(cur); const char* cB = PG8_BPTR(cur);
    S.a_ready(cur);
    PG8_STAGE(PG8_SB(0, 0), cB, voffB); PG8_STAGE(PG8_SB(0, 1), cB, voffB1); PG8_STAGE(PG8_SA(0, 0), cA, cv[0]); PG8_STAGE(PG8_SA(0, 1), cA + ahs, cv[1]);
    if (wr == 1) PG8_BAR;
    PG8_WAIT_V(2); PG8_BAR;
    PG8_STAGE(PG8_SB(1, 0), cB + kstep, voffB); PG8_STAGE(PG8_SA(1, 0), cA + kstep, cv[0]); PG8_STAGE(PG8_SB(1, 1), cB + kstep, voffB1);
    PG8_WAIT_V(6); PG8_BAR;
    for (;;) {
        const bool has_next = S.next(ui + 1, nxt);
        const char* nA = has_next ? PG8_APTR(nxt) : cA; const char* nB = has_next ? PG8_BPTR(nxt) : cB;
        if constexpr (GATHER) { if (has_next) { PG8_ROWS(nxt, nv); } }
        for (int t = 0; t < nt; t += 2) {
            const bool last = (t == nt - 2);
            const char* a1 = cA + (size_t)(t + 1) * kstep;
            const char* a2 = last ? nA : cA + (size_t)(t + 2) * kstep; const char* b2 = last ? nB : cB + (size_t)(t + 2) * kstep;
            const char* a3 = a2 + kstep; const char* b3 = b2 + kstep;
            unsigned s0[2], s1[2];
            s0[0] = last ? nv[0][0] : cv[0][0]; s0[1] = last ? nv[0][1] : cv[0][1]; s1[0] = last ? nv[1][0] : cv[1][0]; s1[1] = last ? nv[1][1] : cv[1][1];
            if (last && has_next) S.a_ready(nxt);
            PG8_LDB(B0, 0, 0); PG8_LDB(B1, 0, 1); PG8_SCHED; PG8_LDA(At, 0, 0); PG8_STAGE(PG8_SA(1, 1), a1 + ahs, cv[1]);
            PG8_WAIT_V(8); PG8_WAIT_L(0); PG8_BAR; PG8_MMA(0, 0, At, B0); PG8_MMA(0, 1, At, B1); PG8_BAR; PG8_SCHED;
            PG8_LDA(At, 0, 1); PG8_STAGE(PG8_SB(0, 0), b2, voffB); PG8_STAGE(PG8_SB(0, 1), b2, voffB1); PG8_STAGE(PG8_SA(0, 0), a2, s0);
            PG8_WAIT_V(8); PG8_WAIT_L(0); PG8_BAR; PG8_MMA(1, 0, At, B0); PG8_MMA(1, 1, At, B1); PG8_BAR; PG8_SCHED;
            PG8_LDB(B0, 1, 0); PG8_LDB(B1, 1, 1); PG8_SCHED; PG8_LDA(At, 1, 0); PG8_STAGE(PG8_SA(0, 1), a2 + ahs, s1);
            PG8_WAIT_V(8); PG8_WAIT_L(0); PG8_BAR; PG8_MMA(0, 0, At, B0); PG8_MMA(0, 1, At, B1); PG8_BAR; PG8_SCHED;
            PG8_LDA(At, 1, 1); PG8_STAGE(PG8_SB(1, 0), b3, voffB); PG8_STAGE(PG8_SB(1, 1), b3, voffB1); PG8_STAGE(PG8_SA(1, 0), a3, s0);
            PG8_WAIT_V(8); PG8_WAIT_L(0); PG8_BAR; PG8_MMA(1, 0, At, B0); PG8_MMA(1, 1, At, B1); PG8_BAR; PG8_SCHED;
        }
        if constexpr (FP8 && FP8_X128) { asm volatile("s_nop 15\n\ts_nop 7" ::: "memory"); PG8_SCHED; }
        if constexpr (ALIGN_EPI) { if (wr == 0) PG8_BAR; }
        { int ln_ = threadIdx.x; asm volatile("" : "+v"(ln_));
          E(acc, cur, wr, wc, ln_ & 15, (ln_ & 63) >> 4); } S.done(cur);
        if (!has_next) break;
#pragma unroll
        for (int a = 0; a < 2; ++a)
#pragma unroll
            for (int b = 0; b < 2; ++b)
#pragma unroll
                for (int m = 0; m < 4; ++m)
#pragma unroll
                    for (int n = 0; n < 2; ++n) acc[a][b][m][n] = (f32x4){0.f, 0.f, 0.f, 0.f};
        cur = nxt; cA = nA; cB = nB; ++ui;
#pragma unroll
        for (int h = 0; h < 2; ++h) { cv[h][0] = nv[h][0]; cv[h][1] = nv[h][1]; }
        if constexpr (ALIGN_EPI) { if (wr == 1) PG8_BAR; }
    }
    PG8_WAIT_V(0);
    if constexpr (!ALIGN_EPI) { if (wr == 0) PG8_BAR; }
    PG8_BAR;
#undef PG8_SA
#undef PG8_SB
#undef PG8_STAGE
#undef PG8_LDA
#undef PG8_LDB
#undef PG8_MMA
#undef PG8_WAIT_V
#undef PG8_WAIT_L
#undef PG8_BAR
#undef PG8_SCHED
#undef PG8_ROWS
#undef PG8_BPTR
#undef PG8_APTR
}

struct EpiInProjF {
    static constexpr bool PERM = true, WIDE = true;
    unsigned char* ws; const float* dt_bias; const float* gate_bias; int pm_mask; float ds; int pn_off;
    __device__ __forceinline__ void operator()(const f32x4 (&acc)[2][2][4][2], const Unit& u, int wr, int wc, int fr, int fq) const {
        const int pn = u.pn + pn_off, row0 = (u.pm & pm_mask) * BM + wr * 64 + fr, c8 = wc * 64 + 8 * fq;
        if (pn < 46) {
            bf16* base; int ldc, ct; const bool gate = pn >= 38;
            if (pn < 6) { base = (bf16*)(ws + WS_Q); ldc = AW; ct = pn * 256; }
            else if (pn < 12) { base = (bf16*)(ws + WS_K); ldc = AW; ct = (pn - 6) * 256; }
            else if (pn < 18) { base = (bf16*)(ws + WS_V); ldc = AW; ct = (pn - 12) * 256; }
            else if (pn < 26) { base = (bf16*)(ws + WS_Z); ldc = DI; ct = (pn - 18) * 256; }
            else if (pn < 38) { base = (bf16*)(ws + WS_XBC); ldc = CONVD; ct = (pn - 26) * 256; }
            else { base = (bf16*)(ws + WS_GATE); ldc = 2048; ct = (pn - 38) * 256; }
#if QKV_STORE_FP8
            if (pn < 18) {
                unsigned char* qb8 = ws + (pn < 6 ? WS_Q : (pn < 12 ? WS_K : WS_V));
#pragma unroll
                for (int ai = 0; ai < 2; ++ai)
#pragma unroll
                    for (int m = 0; m < 4; ++m) { unsigned char* rowp = qb8 + (size_t)(row0 + ai * HALF + m * 16) * AW + ct + c8;
#pragma unroll
                        for (int bj = 0; bj < 2; ++bj) { const f32x4 v0 = acc[ai][bj][m][0] * (ds * FP8_ASCALE), v1 = acc[ai][bj][m][1] * (ds * FP8_ASCALE);
                            u32x2 w; w.x = pk_fp8x4(v0.x, v0.y, v0.z, v0.w); w.y = pk_fp8x4(v1.x, v1.y, v1.z, v1.w);
                            __builtin_nontemporal_store(w, (u32x2*)(rowp + bj * 32)); } }
                return;
            }
#endif
            f32x4 gb[2][2];
#pragma unroll
            for (int bj = 0; bj < 2; ++bj)
#pragma unroll
                for (int n = 0; n < 2; ++n) gb[bj][n] = gate ? *(const f32x4*)(gate_bias + ct + c8 + bj * 32 + 4 * n) : (f32x4){0.f, 0.f, 0.f, 0.f};
            const int hi8 = fr >> 3;
#pragma unroll
            for (int ai = 0; ai < 2; ++ai)
#pragma unroll
                for (int m = 0; m < 4; ++m) { bf16* rowp = base + (size_t)(row0 - fr + (fr & 7) + ai * HALF + m * 16) * ldc + ct + wc * 64 + 32 * hi8 + 8 * fq;
                    u32x4 w[2];
#pragma unroll
                    for (int bj = 0; bj < 2; ++bj) { f32x4 v0 = acc[ai][bj][m][0] * ds, v1 = acc[ai][bj][m][1] * ds;
                        if (gate) { v0 = v0 + gb[bj][0]; v1 = v1 + gb[bj][1];
                            v0 = (f32x4){sigmoidf_(v0.x), sigmoidf_(v0.y), sigmoidf_(v0.z), sigmoidf_(v0.w)}; v1 = (f32x4){sigmoidf_(v1.x), sigmoidf_(v1.y), sigmoidf_(v1.z), sigmoidf_(v1.w)}; }
                        w[bj].x = cvt_pk_bf16(v0.x, v0.y); w[bj].y = cvt_pk_bf16(v0.z, v0.w); w[bj].z = cvt_pk_bf16(v1.x, v1.y); w[bj].w = cvt_pk_bf16(v1.z, v1.w); }
                    const u32x4 snd = hi8 ? w[0] : w[1]; u32x4 rcv;
                    rcv.x = (unsigned)__builtin_amdgcn_update_dpp(0, (int)snd.x, 0x128, 0xf, 0xf, false); rcv.y = (unsigned)__builtin_amdgcn_update_dpp(0, (int)snd.y, 0x128, 0xf, 0xf, false);
                    rcv.z = (unsigned)__builtin_amdgcn_update_dpp(0, (int)snd.z, 0x128, 0xf, 0xf, false); rcv.w = (unsigned)__builtin_amdgcn_update_dpp(0, (int)snd.w, 0x128, 0xf, 0xf, false);
                    const u32x4 p0 = hi8 ? rcv : w[0], p1 = hi8 ? w[1] : rcv;
                    __builtin_nontemporal_store(p0, (u32x4*)rowp); __builtin_nontemporal_store(p1, (u32x4*)(rowp + (size_t)8 * ldc)); }
        } else if (wc == 0) {
            const f32x4 b0 = *(const f32x4*)(dt_bias + c8), b1 = *(const f32x4*)(dt_bias + c8 + 4);
#pragma unroll
            for (int ai = 0; ai < 2; ++ai)
#pragma unroll
                for (int m = 0; m < 4; ++m) { float* dp = (float*)(ws + WS_DT) + (size_t)c8 * T + (row0 + ai * HALF + m * 16);
                    const f32x4 v0 = acc[ai][0][m][0] * ds + b0, v1 = acc[ai][0][m][1] * ds + b1;
                    dp[0] = softplusf_(v0.x); dp[(size_t)T] = softplusf_(v0.y); dp[(size_t)2 * T] = softplusf_(v0.z); dp[(size_t)3 * T] = softplusf_(v0.w);
                    dp[(size_t)4 * T] = softplusf_(v1.x); dp[(size_t)5 * T] = softplusf_(v1.y); dp[(size_t)6 * T] = softplusf_(v1.z); dp[(size_t)7 * T] = softplusf_(v1.w); }
        }
    }
};
struct EpiNullF {
    static constexpr bool PERM = true, WIDE = false;
    __device__ __forceinline__ void operator()(const f32x4 (&acc)[2][2][4][2], const Unit&, int, int, int, int) const {
#pragma unroll
        for (int ai = 0; ai < 2; ++ai)
#pragma unroll
            for (int m = 0; m < 4; ++m)
#pragma unroll
                for (int bj = 0; bj < 2; ++bj)
#pragma unroll
                    for (int n = 0; n < 2; ++n) asm volatile("" :: "v"(acc[ai][bj][m][n]));
    }
};
struct EpiM0F {
    static constexpr bool PERM = true, WIDE = false;
    unsigned char* ws;
    __device__ __forceinline__ void operator()(const f32x4 (&acc)[2][2][4][2], const Unit& u, int wr, int wc, int fr, int fq) const {
        const int row0 = u.pm * BM + wr * 64 + fr, col0 = u.pn * BM + wc * 32 + 8 * fq;
#pragma unroll
        for (int ai = 0; ai < 2; ++ai)
#pragma unroll
            for (int m = 0; m < 4; ++m) { const size_t r = (size_t)(row0 + ai * HALF + m * 16);
#pragma unroll
                for (int bj = 0; bj < 2; ++bj) { const int c = col0 + bj * HALF;
                    const u32x4 gg = *(const u32x4*)((const bf16*)(ws + WS_GATE) + r * 2048 + c);
                    const f32x4 v0 = acc[ai][bj][m][0], v1 = acc[ai][bj][m][1];
                    u32x4 w; w.x = cvt_pk_bf16(v0.x * bflo(gg.x), v0.y * bfhi(gg.x)); w.y = cvt_pk_bf16(v0.z * bflo(gg.y), v0.w * bfhi(gg.y));
                    w.z = cvt_pk_bf16(v1.x * bflo(gg.z), v1.y * bfhi(gg.z)); w.w = cvt_pk_bf16(v1.z * bflo(gg.w), v1.w * bfhi(gg.w));
                    *(u32x4*)((bf16*)(ws + WS_M0) + r * D + c) = w; } }
    }
};
struct EpiMergedF {
    static constexpr bool PERM = true, WIDE = false;
    unsigned char* ws;
    __device__ __forceinline__ void operator()(const f32x4 (&acc)[2][2][4][2], const Unit& u, int wr, int wc, int fr, int fq) const {
        const int row0 = u.pm * BM + wr * 64 + fr, col0 = u.pn * BM + wc * 32 + 8 * fq;
#pragma unroll
        for (int ai = 0; ai < 2; ++ai)
#pragma unroll
            for (int m = 0; m < 4; ++m) { const size_t r = (size_t)(row0 + ai * HALF + m * 16);
#pragma unroll
                for (int bj = 0; bj < 2; ++bj) { const int c = col0 + bj * HALF;
                    const u32x4 gg = *(const u32x4*)((const bf16*)(ws + WS_GATE) + r * 2048 + 1024 + c);
                    const u32x4 mm = *(const u32x4*)((const bf16*)(ws + WS_M0) + r * D + c);
                    const f32x4 m0 = (f32x4){bflo(mm.x), bfhi(mm.x), bflo(mm.y), bfhi(mm.y)}, m1 = (f32x4){bflo(mm.z), bfhi(mm.z), bflo(mm.w), bfhi(mm.w)};
                    const f32x4 v0 = acc[ai][bj][m][0], v1 = acc[ai][bj][m][1];
                    u32x4 w; w.x = cvt_pk_bf16(m0.x + v0.x * bflo(gg.x), m0.y + v0.y * bfhi(gg.x)); w.y = cvt_pk_bf16(m0.z + v0.z * bflo(gg.y), m0.w + v0.w * bfhi(gg.y));
                    w.z = cvt_pk_bf16(m1.x + v1.x * bflo(gg.z), m1.y + v1.y * bfhi(gg.z)); w.w = cvt_pk_bf16(m1.z + v1.z * bflo(gg.w), m1.w + v1.w * bfhi(gg.w));
                    *(u32x4*)((bf16*)(ws + WS_MERGED) + r * D + c) = w; } }
    }
};
struct EpiX1F {
    static constexpr bool PERM = false, WIDE = false;
    const float* x; float* out;
    __device__ __forceinline__ void operator()(const f32x4 (&acc)[2][2][4][2], const Unit& u, int wr, int wc, int fr, int fq) const {
        const int row0 = u.pm * BM + wr * 64 + fr, col0 = u.pn * BM + wc * 32 + 4 * fq;
#pragma unroll
        for (int ai = 0; ai < 2; ++ai)
#pragma unroll
            for (int m = 0; m < 4; ++m) { const size_t r = (size_t)(row0 + ai * HALF + m * 16);
#pragma unroll
                for (int bj = 0; bj < 2; ++bj)
#pragma unroll
                    for (int n = 0; n < 2; ++n) { const int c = col0 + bj * HALF + n * 16;
                        *(f32x4*)(out + r * D + c) = *(const f32x4*)(x + r * D + c) + acc[ai][bj][m][n]; } }
    }
};
struct EpiMoe1F {
    static constexpr bool PERM = true, WIDE = false;
    unsigned char* ws; const float* b1; const int* texp;
    __device__ __forceinline__ void operator()(const f32x4 (&acc)[2][2][4][2], const Unit& u, int wr, int wc, int fr, int fq) const {
        const int e = texp[u.pm];
        const int row0 = u.pm * BM + wr * 64 + fr, col0 = u.pn * BM + wc * 32 + 8 * fq;
        f32x4 bv[2][2];
#pragma unroll
        for (int bj = 0; bj < 2; ++bj)
#pragma unroll
            for (int n = 0; n < 2; ++n) bv[bj][n] = *(const f32x4*)(b1 + (size_t)e * 2048 + col0 + bj * HALF + 4 * n);
#pragma unroll
        for (int ai = 0; ai < 2; ++ai)
#pragma unroll
            for (int m = 0; m < 4; ++m) { const size_t r = (size_t)(row0 + ai * HALF + m * 16);
#pragma unroll
                for (int bj = 0; bj < 2; ++bj) { const f32x4 v0 = acc[ai][bj][m][0] + bv[bj][0], v1 = acc[ai][bj][m][1] + bv[bj][1];
                    u32x2 w; w.x = cvt_pk_bf16(swiglu_(v0.x, v0.y), swiglu_(v0.z, v0.w)); w.y = cvt_pk_bf16(swiglu_(v1.x, v1.y), swiglu_(v1.z, v1.w));
                    __builtin_nontemporal_store(w, (u32x2*)((bf16*)(ws + WS_ACT) + r * 1024 + ((col0 + bj * HALF) >> 1))); } }
    }
};
struct EpiMoe1Q {
    static constexpr bool PERM = true, WIDE = false;
    unsigned char* ws; const float* b1; const int* texp;
    __device__ __forceinline__ void operator()(const f32x4 (&acc)[2][2][4][2], const Unit& u, int wr, int wc, int fr, int fq) const {
        const int e = texp[u.pm];
        const int row0 = u.pm * BM + wr * 64 + fr, col0 = u.pn * BM + wc * 32 + 8 * fq;
        constexpr float DS = 1.f / (FP8_ASCALE * FP8_WSCALE);
        f32x4 bv[2][2];
#pragma unroll
        for (int bj = 0; bj < 2; ++bj)
#pragma unroll
            for (int n = 0; n < 2; ++n) bv[bj][n] = *(const f32x4*)(b1 + (size_t)e * 2048 + col0 + bj * HALF + 4 * n);
#pragma unroll
        for (int ai = 0; ai < 2; ++ai)
#pragma unroll
            for (int m = 0; m < 4; ++m) { const size_t r = (size_t)(row0 + ai * HALF + m * 16);
#pragma unroll
                for (int bj = 0; bj < 2; ++bj) { const f32x4 v0 = acc[ai][bj][m][0] * DS + bv[bj][0], v1 = acc[ai][bj][m][1] * DS + bv[bj][1];
                    const unsigned w = pk_fp8x4(FP8_ASCALE * swiglu_(v0.x, v0.y), FP8_ASCALE * swiglu_(v0.z, v0.w), FP8_ASCALE * swiglu_(v1.x, v1.y), FP8_ASCALE * swiglu_(v1.z, v1.w));
                    __builtin_nontemporal_store(w, (unsigned*)(ws + WS_ACT + r * 1024 + ((col0 + bj * HALF) >> 1))); } }
    }
};
struct EpiMoe2Q {
    static constexpr bool PERM = true, WIDE = false;
    unsigned char* ws; const float* b2; const int* texp;
    __device__ __forceinline__ void operator()(const f32x4 (&acc)[2][2][4][2], const Unit& u, int wr, int wc, int fr, int fq) const {
        const int e = texp[u.pm];
        const int row0 = u.pm * BM + wr * 64 + fr, col0 = u.pn * BM + wc * 32 + 8 * fq;
        constexpr float DS = 1.f / (FP8_ASCALE * FP8_WSCALE);
        f32x4 bv[2][2];
#pragma unroll
        for (int bj = 0; bj < 2; ++bj)
#pragma unroll
            for (int n = 0; n < 2; ++n) bv[bj][n] = *(const f32x4*)(b2 + (size_t)e * 1024 + col0 + bj * HALF + 4 * n);
#pragma unroll
        for (int ai = 0; ai < 2; ++ai)
#pragma unroll
            for (int m = 0; m < 4; ++m) { const size_t r = (size_t)(row0 + ai * HALF + m * 16);
#pragma unroll
                for (int bj = 0; bj < 2; ++bj) { const f32x4 v0 = acc[ai][bj][m][0] * DS + bv[bj][0], v1 = acc[ai][bj][m][1] * DS + bv[bj][1];
                    u32x4 w; w.x = cvt_pk_bf16(v0.x, v0.y); w.y = cvt_pk_bf16(v0.z, v0.w); w.z = cvt_pk_bf16(v1.x, v1.y); w.w = cvt_pk_bf16(v1.z, v1.w);
                    __builtin_nontemporal_store(w, (u32x4*)((bf16*)(ws + WS_YB) + r * 1024 + col0 + bj * HALF)); } }
    }
};
struct EpiMoe2F {
    static constexpr bool PERM = true, WIDE = false;
    unsigned char* ws; const float* b2; const int* texp;
    __device__ __forceinline__ void operator()(const f32x4 (&acc)[2][2][4][2], const Unit& u, int wr, int wc, int fr, int fq) const {
        const int e = texp[u.pm];
        const int row0 = u.pm * BM + wr * 64 + fr, col0 = u.pn * BM + wc * 32 + 8 * fq;
        f32x4 bv[2][2];
#pragma unroll
        for (int bj = 0; bj < 2; ++bj)
#pragma unroll
            for (int n = 0; n < 2; ++n) bv[bj][n] = *(const f32x4*)(b2 + (size_t)e * 1024 + col0 + bj * HALF + 4 * n);
#pragma unroll
        for (int ai = 0; ai < 2; ++ai)
#pragma unroll
            for (int m = 0; m < 4; ++m) { const size_t r = (size_t)(row0 + ai * HALF + m * 16);
#pragma unroll
                for (int bj = 0; bj < 2; ++bj) { const f32x4 v0 = acc[ai][bj][m][0] + bv[bj][0], v1 = acc[ai][bj][m][1] + bv[bj][1];
                    u32x4 w; w.x = cvt_pk_bf16(v0.x, v0.y); w.y = cvt_pk_bf16(v0.z, v0.w); w.z = cvt_pk_bf16(v1.x, v1.y); w.w = cvt_pk_bf16(v1.z, v1.w);
                    __builtin_nontemporal_store(w, (u32x4*)((bf16*)(ws + WS_YB) + r * 1024 + col0 + bj * HALF)); } }
    }
};
}

__device__ __forceinline__ int t5_bucket_dev(int dist) {
    if (dist < 16) return dist;
    int l = 16 + (int)(logf((float)dist / 16.f) / logf(128.f) * 16.f);
    return l < 31 ? l : 31;
}
__device__ __forceinline__ void transpose_item(const float* W, int K, int N, bf16* WT, int k0, int n0, int drow0, LAS float* scr, int lane) {
#pragma unroll 8
    for (int i = 0; i < 32; ++i) { const int kk = 2 * i + (lane >> 5); scr[kk * 33 + (lane & 31)] = __builtin_nontemporal_load(W + (size_t)(k0 + kk) * N + n0 + (lane & 31)); }
    asm volatile("s_waitcnt lgkmcnt(0)" ::: "memory");
    const int c = lane & 7;
#pragma unroll
    for (int j = 0; j < 4; ++j) { const int n = (lane >> 3) + 8 * j; const LAS float* s = scr + (8 * c) * 33 + n;
        u32x4 o; o.x = pk2(s[0 * 33], s[1 * 33]); o.y = pk2(s[2 * 33], s[3 * 33]); o.z = pk2(s[4 * 33], s[5 * 33]); o.w = pk2(s[6 * 33], s[7 * 33]);
        *(u32x4*)(WT + (size_t)(drow0 + n) * K + k0 + 8 * c) = o; }
    asm volatile("s_waitcnt lgkmcnt(0)" ::: "memory");
}
__device__ __forceinline__ void transpose_item_fp8(const float* W, int K, int N, unsigned char* WT, int k0, int n0, int drow0, float scale, LAS float* scr, int lane) {
#pragma unroll 8
    for (int i = 0; i < 64; ++i) { const int kk = 2 * i + (lane >> 5); scr[kk * 33 + (lane & 31)] = __builtin_nontemporal_load(W + (size_t)(k0 + kk) * N + n0 + (lane & 31)) * scale; }
    asm volatile("s_waitcnt lgkmcnt(0)" ::: "memory");
    const int c = lane & 7;
#pragma unroll
    for (int j = 0; j < 4; ++j) { const int n = (lane >> 3) + 8 * j; const LAS float* s = scr + (16 * c) * 33 + n;
        u32x4 o; o.x = pk_fp8x4(s[0 * 33], s[1 * 33], s[2 * 33], s[3 * 33]); o.y = pk_fp8x4(s[4 * 33], s[5 * 33], s[6 * 33], s[7 * 33]);
        o.z = pk_fp8x4(s[8 * 33], s[9 * 33], s[10 * 33], s[11 * 33]); o.w = pk_fp8x4(s[12 * 33], s[13 * 33], s[14 * 33], s[15 * 33]);
        *(u32x4*)(WT + (size_t)(drow0 + n) * K + k0 + 16 * c) = o; }
    asm volatile("s_waitcnt lgkmcnt(0)" ::: "memory");
}
__device__ __forceinline__ int inproj_row_of_col(int n0) { return n0 < C_DT ? n0 : (n0 < C_GATE ? n0 - C_DT + 11776 : n0 - 32); }
__device__ __forceinline__ void p_convert_small(Frame& F) {
    LAS float* scr = (LAS float*)(F.lds + F.wave * 16896);
    const int gw = F.blk * NWAVES + F.wave, NGW = F.nblk * NWAVES;
    constexpr int NBQ = QKV_FP8 ? C_Z / 32 : 0;
    constexpr int I_INQ = 8 * NBQ, I_IN = 16 * (NPROJ / 32 - NBQ), I_BA = 8 * 32, I_BS = 32 * 32, I_OUT = 16 * 32, NIT = I_INQ + I_IN + I_BA + I_BS + I_OUT;
    for (int it = gw; it < NIT; it += NGW) {
        int r = it;
        if (r < I_INQ) { const int nb = r % (NBQ ? NBQ : 1), kb = r / (NBQ ? NBQ : 1); transpose_item_fp8(F.w_in, D, NPROJ, F.ws + WS_WQKVQ, 128 * kb, 32 * nb, 32 * nb, FP8_WSCALE, scr, ((int)(threadIdx.x & 63u))); continue; } r -= I_INQ;
        if (r < I_IN) { const int nb = NBQ + r % (NPROJ / 32 - NBQ), kb = r / (NPROJ / 32 - NBQ); transpose_item(F.w_in, D, NPROJ, (bf16*)(F.ws + WS_WIN_T), 64 * kb, 32 * nb, inproj_row_of_col(32 * nb), scr, ((int)(threadIdx.x & 63u))); continue; } r -= I_IN;
        if (r < I_BA) { const int nb = r % 32, kb = r / 32; transpose_item(F.w_ba, 512, D, (bf16*)(F.ws + WS_WBA_T), 64 * kb, 32 * nb, 32 * nb, scr, ((int)(threadIdx.x & 63u))); continue; } r -= I_BA;
        if (r < I_BS) { const int nb = r % 32, kb = r / 32; transpose_item(F.w_bs, DI, D, (bf16*)(F.ws + WS_WBS_T), 64 * kb, 32 * nb, 32 * nb, scr, ((int)(threadIdx.x & 63u))); continue; } r -= I_BS;
        { const int nb = r % 32, kb = r / 32; transpose_item(F.w_out, D, D, (bf16*)(F.ws + WS_WOUT_T), 64 * kb, 32 * nb, 32 * nb, scr, ((int)(threadIdx.x & 63u))); }
    }
    for (int i = F.blk * NTHREADS + ((int)threadIdx.x); i < 24 * 192; i += F.nblk * NTHREADS) { const int head = i / 192, dl = i % 192 - 32, g = head >> 3, dil = g == 0 ? 1 : (g == 1 ? 4 : 16);
        ((float*)(F.ws + WS_BT))[i] = F.rel_bias[t5_bucket_dev((dl < 0 ? 0 : (dl > 128 ? 128 : dl)) * dil) * 24 + head] * 1.4426950408889634f; }
    for (int i = F.blk * NTHREADS + ((int)threadIdx.x); i < 32 * 1024; i += F.nblk * NTHREADS) ((float*)(F.ws + WS_WRT))[i] = F.norm_ffn[i >> 5] * F.router_w[i];
    u32x4* z = (u32x4*)((bf16*)(F.ws + WS_WIN_T) + (size_t)11808 * D);
    for (int i = F.blk * NTHREADS + ((int)threadIdx.x); i < 224 * D * 2 / 16; i += F.nblk * NTHREADS) z[i] = (u32x4){0u, 0u, 0u, 0u};
}
__device__ __forceinline__ void p_convert_moe_fp8(Frame& F) {
    LAS float* scr = (LAS float*)(F.lds + F.wave * 16896);
    const int gw = F.blk * NWAVES + F.wave, NGW = F.nblk * NWAVES;
    constexpr int I_1 = 8 * 64, I_2 = 8 * 32, NIT = NEXP * (I_1 + I_2);
    for (int it = gw; it < NIT; it += NGW) {
        const int e = it / (I_1 + I_2); int r = it % (I_1 + I_2);
        if (r < I_1) { const int nb = r % 64, kb = r / 64; transpose_item_fp8(F.w1 + (size_t)e * 1024 * 2048, 1024, 2048, F.ws + WS_W1T + (size_t)e * 2048 * 1024, 128 * kb, 32 * nb, 32 * nb, FP8_WSCALE, scr, ((int)(threadIdx.x & 63u))); }
        else { r -= I_1; const int nb = r % 32, kb = r / 32; transpose_item_fp8(F.w2 + (size_t)e * 1024 * 1024, 1024, 1024, F.ws + WS_W2T + (size_t)e * 1024 * 1024, 128 * kb, 32 * nb, 32 * nb, FP8_WSCALE, scr, ((int)(threadIdx.x & 63u))); }
    }
}
__device__ __forceinline__ void p_convert_moe(Frame& F) {
    LAS float* scr = (LAS float*)(F.lds + F.wave * 16384);
    const int gw = F.blk * NWAVES + F.wave, NGW = F.nblk * NWAVES;
    constexpr int I_1 = 16 * 64, I_2 = 16 * 32, NIT = NEXP * (I_1 + I_2);
    for (int it = gw; it < NIT; it += NGW) {
        const int e = it / (I_1 + I_2); int r = it % (I_1 + I_2);
        if (r < I_1) { const int nb = r % 64, kb = r / 64; transpose_item(F.w1 + (size_t)e * 1024 * 2048, 1024, 2048, (bf16*)(F.ws + WS_W1T) + (size_t)e * 2048 * 1024, 64 * kb, 32 * nb, 32 * nb, scr, ((int)(threadIdx.x & 63u))); }
        else { r -= I_1; const int nb = r % 32, kb = r / 32; transpose_item(F.w2 + (size_t)e * 1024 * 1024, 1024, 1024, (bf16*)(F.ws + WS_W2T) + (size_t)e * 1024 * 1024, 64 * kb, 32 * nb, 32 * nb, scr, ((int)(threadIdx.x & 63u))); }
    }
}

__device__ __forceinline__ void p_rmsnorm_in(Frame& F) {
    const int gw = F.blk * NWAVES + F.wave, NGW = F.nblk * NWAVES;
    bf16* XN = (bf16*)(F.ws + WS_XN);
    for (int m = gw; m < T; m += NGW) {
        const f32x4* xr = (const f32x4*)(F.x + (size_t)m * D) + ((int)(threadIdx.x & 63u));
        const f32x4* wr = (const f32x4*)F.norm_mix + ((int)(threadIdx.x & 63u));
        f32x4 v[4]; float s = 0.f;
#pragma unroll
        for (int j = 0; j < 4; ++j) { v[j] = __builtin_nontemporal_load(xr + 64 * j); s += (v[j].x * v[j].x + v[j].y * v[j].y) + (v[j].z * v[j].z + v[j].w * v[j].w); }
        const float rstd = __builtin_amdgcn_rsqf(wave_sum(s) * (1.f / D) + EPS);
#pragma unroll
        for (int j = 0; j < 4; ++j) { const f32x4 w = wr[64 * j]; const f32x4 o = v[j] * rstd * w; st_bf4(XN + (size_t)m * D + (((int)(threadIdx.x & 63u)) + 64 * j) * 4, o);
#if QKV_FP8
            *(unsigned*)(F.ws + WS_XNQ + (size_t)m * D + (((int)(threadIdx.x & 63u)) + 64 * j) * 4) = pk_fp8x4(FP8_ASCALE * o.x, FP8_ASCALE * o.y, FP8_ASCALE * o.z, FP8_ASCALE * o.w);
#endif
        }
    }
}

__device__ __forceinline__ void p_attn_naive(Frame& F) {
    LAS float* btab = (LAS float*)F.lds;
    for (int i = ((int)threadIdx.x); i < 3 * 129 * 8; i += NTHREADS) {
        const int g = i / (129 * 8), j = (i >> 3) % 129, hg = i & 7;
        const int dil = g == 0 ? 1 : (g == 1 ? 4 : 16);
        btab[i] = F.rel_bias[t5_bucket_dev(j * dil) * 24 + g * 8 + hg];
    }
    __syncthreads();
    const bf16* Qb = (const bf16*)(F.ws + WS_Q); const bf16* Kb = (const bf16*)(F.ws + WS_K); const bf16* Vb = (const bf16*)(F.ws + WS_V);
    bf16* AT = (bf16*)(F.ws + WS_ATTN);
    for (int idx = F.blk * NTHREADS + ((int)threadIdx.x); idx < T * 8; idx += F.nblk * NTHREADS) {
        const int hg = idx & 7, row = idx >> 3, t = row & (SEQ - 1);
        float m = -INFINITY, den = 0.f;
        float acc[64];
#pragma unroll
        for (int i = 0; i < 64; ++i) acc[i] = 0.f;
        for (int g = 0; g < 3; ++g) {
            const int dil = g == 0 ? 1 : (g == 1 ? 4 : 16);
            const int head = g * 8 + hg;
            float q[64];
            { const u32x4* qp = (const u32x4*)(Qb + (size_t)row * AW + head * 64);
#pragma unroll
              for (int c = 0; c < 8; ++c) { const u32x4 w = qp[c]; q[8 * c + 0] = bflo(w.x); q[8 * c + 1] = bfhi(w.x); q[8 * c + 2] = bflo(w.y); q[8 * c + 3] = bfhi(w.y);
                  q[8 * c + 4] = bflo(w.z); q[8 * c + 5] = bfhi(w.z); q[8 * c + 6] = bflo(w.w); q[8 * c + 7] = bfhi(w.w); } }
            for (int j = 0; j <= 128; ++j) {
                const int kt = t - j * dil; if (kt < 0) break;
                const size_t krow = (size_t)(row - j * dil);
                const u32x4* kp = (const u32x4*)(Kb + krow * AW + head * 64);
                float s = 0.f;
#pragma unroll
                for (int c = 0; c < 8; ++c) { const u32x4 w = kp[c];
                    s += q[8 * c + 0] * bflo(w.x) + q[8 * c + 1] * bfhi(w.x) + q[8 * c + 2] * bflo(w.y) + q[8 * c + 3] * bfhi(w.y)
                       + q[8 * c + 4] * bflo(w.z) + q[8 * c + 5] * bfhi(w.z) + q[8 * c + 6] * bflo(w.w) + q[8 * c + 7] * bfhi(w.w); }
                s = s * 0.125f + btab[(g * 129 + j) * 8 + hg];
                const float mn = fmaxf(m, s), sc = __expf(m - mn), p = __expf(s - mn);
                m = mn; den = den * sc + p;
                const u32x4* vp = (const u32x4*)(Vb + krow * AW + head * 64);
#pragma unroll
                for (int c = 0; c < 8; ++c) { const u32x4 w = vp[c];
                    acc[8 * c + 0] = acc[8 * c + 0] * sc + p * bflo(w.x); acc[8 * c + 1] = acc[8 * c + 1] * sc + p * bfhi(w.x);
                    acc[8 * c + 2] = acc[8 * c + 2] * sc + p * bflo(w.y); acc[8 * c + 3] = acc[8 * c + 3] * sc + p * bfhi(w.y);
                    acc[8 * c + 4] = acc[8 * c + 4] * sc + p * bflo(w.z); acc[8 * c + 5] = acc[8 * c + 5] * sc + p * bfhi(w.z);
                    acc[8 * c + 6] = acc[8 * c + 6] * sc + p * bflo(w.w); acc[8 * c + 7] = acc[8 * c + 7] * sc + p * bfhi(w.w); }
            }
        }
        const float inv = 1.f / den;
        u32x4* op = (u32x4*)(AT + (size_t)row * 512 + hg * 64);
#pragma unroll
        for (int c = 0; c < 8; ++c) { u32x4 w; w.x = pk2(acc[8 * c] * inv, acc[8 * c + 1] * inv); w.y = pk2(acc[8 * c + 2] * inv, acc[8 * c + 3] * inv);
            w.z = pk2(acc[8 * c + 4] * inv, acc[8 * c + 5] * inv); w.w = pk2(acc[8 * c + 6] * inv, acc[8 * c + 7] * inv); op[c] = w; }
    }
    __syncthreads();
}

typedef short bf16x8_t __attribute__((ext_vector_type(8)));
typedef short s16x4_t __attribute__((ext_vector_type(4)));
typedef float f32x16 __attribute__((ext_vector_type(16)));
__device__ __forceinline__ int crow_(int reg, int h) { return (reg & 3) + 8 * (reg >> 2) + 4 * h; }
__device__ __forceinline__ s16x4_t tr_read_(const LAS unsigned char* p) { return __builtin_bit_cast(s16x4_t, __builtin_amdgcn_ds_read_tr16_b64_v4i16((LAS s16x4_t*)p)); }
constexpr int ATT_HALF_BYTES = 66560;
template <bool LOADKV = true, bool DOSTORE = true, bool DOMATH = true>
__device__ __forceinline__ void p_attn_fast(Frame& F) {
    const int half = F.wave >> 2, qb = F.wave & 3;
    const bf16* Qb = (const bf16*)(F.ws + WS_Q); const bf16* Kb = (const bf16*)(F.ws + WS_K); const bf16* Vb = (const bf16*)(F.ws + WS_V);
    bf16* OUTG = (bf16*)(F.ws + WS_OUTG); float* LSE = (float*)(F.ws + WS_LSE); const float* BT = (const float*)(F.ws + WS_BT);
    constexpr int NUNIT = BATCH * 24 * 16;
    constexpr float LOG2E = 1.4426950408889634f;
    constexpr float QKS = QKV_STORE_FP8 ? 1.f / (FP8_ASCALE * FP8_ASCALE) : 1.f, VS = QKV_STORE_FP8 ? 1.f / FP8_ASCALE : 1.f;
    const int nhw = F.nblk * 2, per = (NUNIT + nhw - 1) / nhw, u0 = (F.blk * 2 + half) * per;
#if QKV_STORE_FP8
    const unsigned char* Q8 = F.ws + WS_Q; const unsigned char* K8 = F.ws + WS_K; const unsigned char* V8 = F.ws + WS_V; (void)Qb; (void)Kb; (void)Vb;
    u32x4 kreg[2], vreg[2]; float breg = 0.f;
#else
    u32x4 kreg[4], vreg[4]; float breg = 0.f;
#endif
#define ATT_DECODE(u_) const int zn = (u_) & 15, head = ((u_) >> 4) % 24, b = (u_) / (16 * 24); const int g = head >> 3, hg = head & 7; \
        const int dil = g == 0 ? 1 : (g == 1 ? 4 : 16), nb = 16 / dil; const int z = zn / nb, n = zn % nb; const size_t rowb = (size_t)b * SEQ; (void)hg; (void)rowb; (void)z; (void)n
#if QKV_STORE_FP8
#define ATT_LOADBLK(u_, blk_) do { ATT_DECODE(u_); const int th_ = ((int)threadIdx.x) & 255; \
        _Pragma("unroll") for (int i = 0; i < 2; ++i) { const int piece = th_ + 256 * i, kw = piece >> 2, c16 = piece & 3; const int p = (blk_) * 128 + kw; \
            kreg[i] = (u32x4){0u, 0u, 0u, 0u}; vreg[i] = (u32x4){0u, 0u, 0u, 0u}; \
            if (LOADKV && (u_) < NUNIT) { const size_t row = rowb + (size_t)p * dil + z; kreg[i] = *(const u32x4*)(K8 + row * AW + head * 64 + c16 * 16); vreg[i] = *(const u32x4*)(V8 + row * AW + head * 64 + c16 * 16); } } \
        if (th_ < 192 && (u_) < NUNIT) breg = BT[head * 192 + th_]; } while (0)
#define ATT_STOREBLK(slot_) do { _Pragma("unroll") for (int i = 0; i < 2; ++i) { const int piece = th + 256 * i, kw = piece >> 2, c16 = piece & 3; const int rb_ = ((slot_) * 128 + kw) * 128; \
            *(LAS u32x4*)(Kimg + rb_ + (((2 * c16) ^ (kw & 7)) << 4)) = fp8x8_to_bf16x8(kreg[i].x, kreg[i].y); *(LAS u32x4*)(Kimg + rb_ + (((2 * c16 + 1) ^ (kw & 7)) << 4)) = fp8x8_to_bf16x8(kreg[i].z, kreg[i].w); \
            *(LAS u32x4*)(Vimg + rb_ + (((2 * c16) ^ (kw & 7)) << 4)) = fp8x8_to_bf16x8(vreg[i].x, vreg[i].y); *(LAS u32x4*)(Vimg + rb_ + (((2 * c16 + 1) ^ (kw & 7)) << 4)) = fp8x8_to_bf16x8(vreg[i].z, vreg[i].w); } } while (0)
#else
#define ATT_LOADBLK(u_, blk_) do { ATT_DECODE(u_); const int th_ = ((int)threadIdx.x) & 255; \
        _Pragma("unroll") for (int i = 0; i < 4; ++i) { const int piece = th_ + 256 * i, kw = piece >> 3, ch = piece & 7; const int p = (blk_) * 128 + kw; \
            kreg[i] = (u32x4){0u, 0u, 0u, 0u}; vreg[i] = (u32x4){0u, 0u, 0u, 0u}; \
            if (LOADKV && (u_) < NUNIT) { const size_t row = rowb + (size_t)p * dil + z; kreg[i] = *(const u32x4*)(Kb + row * AW + head * 64 + ch * 8); vreg[i] = *(const u32x4*)(Vb + row * AW + head * 64 + ch * 8); } } \
        if (th_ < 192 && (u_) < NUNIT) breg = BT[head * 192 + th_]; } while (0)
#define ATT_STOREBLK(slot_) do { _Pragma("unroll") for (int i = 0; i < 4; ++i) { const int piece = th + 256 * i, kw = piece >> 3, ch = piece & 7; const int off = ((slot_) * 128 + kw) * 128 + ((ch ^ (kw & 7)) << 4); \
            *(LAS u32x4*)(Kimg + off) = kreg[i]; *(LAS u32x4*)(Vimg + off) = vreg[i]; } } while (0)
#endif
    {
        for (int i = ((int)threadIdx.x); i < 2 * ATT_HALF_BYTES / 16; i += NTHREADS) ((LAS u32x4*)F.lds)[i] = (u32x4){0u, 0u, 0u, 0u};
        __syncthreads();
        const int th = ((int)threadIdx.x) & 255;
        LAS unsigned char* base = F.lds + half * ATT_HALF_BYTES; LAS unsigned char* Kimg = base; LAS unsigned char* Vimg = base + 32768;
        if (u0 < NUNIT) { const int n0 = (u0 & 15) % (16 / ((((u0 >> 4) % 24) >> 3) == 0 ? 1 : ((((u0 >> 4) % 24) >> 3) == 1 ? 4 : 16)));
            if (n0 > 0) { ATT_LOADBLK(u0, n0 - 1); ATT_STOREBLK((n0 - 1) & 1); } }
        ATT_LOADBLK(u0, (u0 & 15) % (16 / ((((u0 >> 4) % 24) >> 3) == 0 ? 1 : ((((u0 >> 4) % 24) >> 3) == 1 ? 4 : 16))));
    }
    for (int it = 0; it < per; ++it) {
        const int u = u0 + it;
        const bool live = u < NUNIT;
        ATT_DECODE(live ? u : 0);
        unsigned opq_ = 0; asm volatile("" : "+s"(opq_));
        int tl_ = ((int)threadIdx.x); asm volatile("" : "+v"(tl_));
        const int th = tl_ & 255, lane = tl_ & 63, r = lane & 31, h = lane >> 5;
        LAS unsigned char* base = F.lds + half * ATT_HALF_BYTES + opq_;
        LAS unsigned char* Kimg = base; LAS unsigned char* Vimg = base + 32768; LAS float* btab = (LAS float*)(base + 65536);
        const int flip = ((n - 1) & 1) << 7;
        bf16x8_t qf[4];
        { const size_t qrow = rowb + (size_t)(n * 128 + 32 * qb + r) * dil + z;
#pragma unroll
#if QKV_STORE_FP8
          for (int dd = 0; dd < 4; ++dd) { const u32x2 q8 = *(const u32x2*)(Q8 + qrow * AW + head * 64 + 16 * dd + 8 * h); qf[dd] = __builtin_bit_cast(bf16x8_t, fp8x8_to_bf16x8(q8.x, q8.y)); } }
#else
          for (int dd = 0; dd < 4; ++dd) qf[dd] = *(const bf16x8_t*)(Qb + qrow * AW + head * 64 + 16 * dd + 8 * h); }
#endif
        LDS_BARRIER();
        ATT_STOREBLK(n & 1);
        if (th < 192) btab[th] = breg;
        LDS_BARRIER();
        if (it + 1 < per) { const int un = u + 1; ATT_LOADBLK(un, ((un) & 15) % (16 / ((((un >> 4) % 24) >> 3) == 0 ? 1 : ((((un >> 4) % 24) >> 3) == 1 ? 4 : 16)))); }
        if (!live) continue;
        f32x16 sc[5];
#pragma unroll
        for (int kb = 0; kb < 5; ++kb) {
            f32x16 a = {0.f, 0.f, 0.f, 0.f, 0.f, 0.f, 0.f, 0.f, 0.f, 0.f, 0.f, 0.f, 0.f, 0.f, 0.f, 0.f};
            const int krow0 = (32 * (qb + kb) + r) ^ flip;
            if (!(n == 0 && qb + kb <= 3))
#pragma unroll
            for (int dd = 0; dd < 4; ++dd) {
                const bf16x8_t kf = *(const LAS bf16x8_t*)(Kimg + krow0 * 128 + (((2 * dd + h) ^ (r & 7)) << 4));
                a = __builtin_amdgcn_mfma_f32_32x32x16_bf16(kf, qf[dd], a, 0, 0, 0);
            }
            sc[kb] = a;
        }
        float m = -INFINITY;
        const LAS float* const bl = btab + (r - 4 * h);
#pragma unroll
        for (int kb = 0; kb < 5; ++kb)
#pragma unroll
            for (int i = 0; i < 16; ++i) {
                const int cc = (i & 3) + 8 * (i >> 2);
                const float bias = bl[160 - 32 * kb - cc];
                float s = sc[kb][i] * (0.125f * LOG2E * QKS) + bias;
                const int c = cc + 4 * h;
                if (kb == 0) s = (r <= c && n != 0) ? s : -INFINITY;
                else if (kb == 4) s = (c <= r) ? s : -INFINITY;
                else s = (n == 0 && (32 * (qb + kb) + c) < 128) ? -INFINITY : s;
                sc[kb][i] = s; m = fmaxf(m, s);
            }
        m = fmaxf(m, __shfl_xor(m, 32));
        float den = 0.f;
#pragma unroll
        for (int kb = 0; kb < 5; ++kb) {
            if (n == 0 && qb + kb <= 3) continue;
#pragma unroll
            for (int i = 0; i < 16; ++i) { const float p = __builtin_amdgcn_exp2f(sc[kb][i] - m); sc[kb][i] = p; den += p; } }
        den += __shfl_xor(den, 32);
        const float inv = VS * __builtin_amdgcn_rcpf(den);
        if (DOSTORE && h == 0) LSE[((size_t)g * T + rowb + (size_t)(n * 128 + 32 * qb + r) * dil + z) * 8 + hg] = (m + __builtin_amdgcn_logf(den)) * (1.f / LOG2E);
        f32x16 o[2];
        o[0] = (f32x16){0.f, 0.f, 0.f, 0.f, 0.f, 0.f, 0.f, 0.f, 0.f, 0.f, 0.f, 0.f, 0.f, 0.f, 0.f, 0.f}; o[1] = o[0];
        const int q4 = (lane & 15) >> 2, blk16 = (lane >> 4) & 1, p4 = lane & 3;
#pragma unroll
        for (int kb = 0; kb < 5; ++kb) {
            if (n == 0 && qb + kb <= 3) continue;
#pragma unroll
            for (int s = 0; s < 2; ++s) {
                u32x4 pw;
                pw.x = cvtpk(sc[kb][8 * s + 0] * inv, sc[kb][8 * s + 1] * inv); pw.y = cvtpk(sc[kb][8 * s + 2] * inv, sc[kb][8 * s + 3] * inv);
                pw.z = cvtpk(sc[kb][8 * s + 4] * inv, sc[kb][8 * s + 5] * inv); pw.w = cvtpk(sc[kb][8 * s + 6] * inv, sc[kb][8 * s + 7] * inv);
                const bf16x8_t pa = __builtin_bit_cast(bf16x8_t, pw);
                const int row_lo = (32 * (qb + kb) + 16 * s + 4 * h + q4) ^ flip, row_hi = row_lo + 8;
#pragma unroll
                for (int db = 0; db < 2; ++db) {
                    const int chunk = 4 * db + 2 * blk16 + (p4 >> 1), sub = (p4 & 1) * 8;
                    const s16x4_t lo = tr_read_(Vimg + row_lo * 128 + ((chunk ^ (row_lo & 7)) << 4) + sub);
                    const s16x4_t hi = tr_read_(Vimg + row_hi * 128 + ((chunk ^ (row_hi & 7)) << 4) + sub);
                    const bf16x8_t vf = (bf16x8_t){lo[0], lo[1], lo[2], lo[3], hi[0], hi[1], hi[2], hi[3]};
                    o[db] = __builtin_amdgcn_mfma_f32_32x32x16_bf16(pa, vf, o[db], 0, 0, 0);
                }
            } }
#pragma unroll
        for (int i = 0; i < 16; ++i) {
            const size_t row = rowb + (size_t)(n * 128 + 32 * qb + crow_(i, h)) * dil + z;
            bf16* op = OUTG + ((size_t)g * T + row) * 512 + hg * 64 + r;
            const unsigned w = cvtpk(o[0][i], o[1][i]);
            if (DOSTORE) { op[0] = (bf16)(w & 0xffffu); op[32] = (bf16)(w >> 16); } else asm volatile("" :: "v"(w));
        }
    }
#undef ATT_DECODE
#undef ATT_LOADBLK
#undef ATT_STOREBLK
    __syncthreads();
}
__device__ __forceinline__ void p_attn_merge(Frame& F) {
    const bf16* OUTG = (const bf16*)(F.ws + WS_OUTG); const float* LSE = (const float*)(F.ws + WS_LSE); bf16* AT = (bf16*)(F.ws + WS_ATTN);
    for (int idx = F.blk * NTHREADS + ((int)threadIdx.x); idx < T * 64; idx += F.nblk * NTHREADS) {
        const int row = idx >> 6, c8 = (idx & 63) * 8, hg = c8 >> 6;
        const float l0 = LSE[((size_t)0 * T + row) * 8 + hg], l1 = LSE[((size_t)1 * T + row) * 8 + hg], l2 = LSE[((size_t)2 * T + row) * 8 + hg];
        const float mx = fmaxf(l0, fmaxf(l1, l2)), e0 = __expf(l0 - mx), e1 = __expf(l1 - mx), e2 = __expf(l2 - mx), inv = __builtin_amdgcn_rcpf(e0 + e1 + e2);
        const float w[3] = {e0 * inv, e1 * inv, e2 * inv};
        float a[8] = {0.f, 0.f, 0.f, 0.f, 0.f, 0.f, 0.f, 0.f};
#pragma unroll
        for (int g = 0; g < 3; ++g) { const u32x4 v = *(const u32x4*)(OUTG + ((size_t)g * T + row) * 512 + c8);
            a[0] += w[g] * bflo(v.x); a[1] += w[g] * bfhi(v.x); a[2] += w[g] * bflo(v.y); a[3] += w[g] * bfhi(v.y);
            a[4] += w[g] * bflo(v.z); a[5] += w[g] * bfhi(v.z); a[6] += w[g] * bflo(v.w); a[7] += w[g] * bfhi(v.w); }
        u32x4 o; o.x = pk2(a[0], a[1]); o.y = pk2(a[2], a[3]); o.z = pk2(a[4], a[5]); o.w = pk2(a[6], a[7]);
        *(u32x4*)(AT + (size_t)row * 512 + c8) = o;
    }
}

__device__ __forceinline__ void p_conv(Frame& F) {
    const bf16* X = (const bf16*)(F.ws + WS_XBC); bf16* O = (bf16*)(F.ws + WS_CONV);
    const int total = T * (CONVD / 8);
    for (int idx = F.blk * NTHREADS + ((int)threadIdx.x); idx < total; idx += F.nblk * NTHREADS) {
        const int row = idx / (CONVD / 8), c0 = (idx % (CONVD / 8)) * 8, t = row & (SEQ - 1);
        float a[8];
#pragma unroll
        for (int i = 0; i < 8; ++i) a[i] = F.conv_b[c0 + i];
#pragma unroll
        for (int w = 0; w < 4; ++w) {
            const int tt = t + w - 3; if (tt < 0) continue;
            const u32x4 u = *(const u32x4*)(X + (size_t)(row + w - 3) * CONVD + c0);
            const float* cw = F.conv_w + (size_t)w * CONVD + c0;
            a[0] += cw[0] * bflo(u.x); a[1] += cw[1] * bfhi(u.x); a[2] += cw[2] * bflo(u.y); a[3] += cw[3] * bfhi(u.y);
            a[4] += cw[4] * bflo(u.z); a[5] += cw[5] * bfhi(u.z); a[6] += cw[6] * bflo(u.w); a[7] += cw[7] * bfhi(u.w);
        }
        u32x4 o; o.x = pk2(siluf_(a[0]), siluf_(a[1])); o.y = pk2(siluf_(a[2]), siluf_(a[3])); o.z = pk2(siluf_(a[4]), siluf_(a[5])); o.w = pk2(siluf_(a[6]), siluf_(a[7]));
        *(u32x4*)(O + (size_t)row * CONVD + c0) = o;
    }
}

__device__ __forceinline__ void p_ssd_naive(Frame& F) {
    const bf16* CV = (const bf16*)(F.ws + WS_CONV); const float* DT = (const float*)(F.ws + WS_DT); const bf16* Z = (const bf16*)(F.ws + WS_Z);
    bf16* YZ = (bf16*)(F.ws + WS_YZ);
    const int t256 = ((int)threadIdx.x) & 255, p = t256 >> 2, q = t256 & 3;
    for (int unit = F.blk * 2 + (((int)threadIdx.x) >> 8); unit < BATCH * NH_SSM; unit += F.nblk * 2) {
        const int b = unit / NH_SSM, h = unit % NH_SSM, g = h / 8;
        const float a = -__expf(F.a_log[h]), dsk = F.d_skip[h];
        float st[32];
#pragma unroll
        for (int i = 0; i < 32; ++i) st[i] = 0.f;
        for (int t = 0; t < SEQ; ++t) {
            const size_t row = (size_t)b * SEQ + t;
            const float dt = DT[(size_t)h * T + row];
            const float dA = __expf(dt * a);
            const float xv = bf2f(CV[row * CONVD + h * 64 + p]);
            const float dtx = dt * xv;
            const u32x4* bp = (const u32x4*)(CV + row * CONVD + 2048 + g * 128 + q * 32);
            const u32x4* cp = (const u32x4*)(CV + row * CONVD + 2560 + g * 128 + q * 32);
            float yp = 0.f;
#pragma unroll
            for (int c = 0; c < 4; ++c) {
                const u32x4 bw = bp[c], cw = cp[c];
                const float bv[8] = {bflo(bw.x), bfhi(bw.x), bflo(bw.y), bfhi(bw.y), bflo(bw.z), bfhi(bw.z), bflo(bw.w), bfhi(bw.w)};
                const float cv[8] = {bflo(cw.x), bfhi(cw.x), bflo(cw.y), bfhi(cw.y), bflo(cw.z), bfhi(cw.z), bflo(cw.w), bfhi(cw.w)};
#pragma unroll
                for (int i = 0; i < 8; ++i) { st[8 * c + i] = st[8 * c + i] * dA + dtx * bv[i]; yp += cv[i] * st[8 * c + i]; }
            }
            yp += __shfl_xor(yp, 1); yp += __shfl_xor(yp, 2);
            if (q == 0) {
                const float y = yp + dsk * xv;
                const float z = bf2f(Z[row * DI + h * 64 + p]);
                YZ[row * DI + h * 64 + p] = (bf16)f2bf(y * siluf_(z));
            }
        }
    }
}

__device__ __forceinline__ int swz256(int row, int chunk) { return row * 272 + (chunk << 4); }
__device__ __forceinline__ int swz128(int row, int chunk) { return row * 144 + (chunk << 4); }
__device__ __forceinline__ void p_ssd_fast(Frame& F) {
    const int lane = ((int)(threadIdx.x & 63u)), r = lane & 31, hh = lane >> 5, lb = F.wave & 3, pb = F.wave >> 2, tid = ((int)threadIdx.x);
    LAS unsigned char* Bimg = F.lds; LAS unsigned char* Cimg = F.lds + 34816; LAS unsigned char* Ximg = F.lds + 69632; LAS unsigned char* Xwimg = F.lds + 88064;
    LAS unsigned char* Simg = F.lds + 106496; LAS float* acs = (LAS float*)(F.lds + 123904); LAS float* dtv = (LAS float*)(F.lds + 124416);
    const bf16* CV = (const bf16*)(F.ws + WS_CONV); const float* DT = (const float*)(F.ws + WS_DT); bf16* Y = (bf16*)(F.ws + WS_YZ);
    const int q4 = (lane & 15) >> 2, blk16 = (lane >> 4) & 1, p4 = lane & 3;
    const f32x16 zero16 = {0.f, 0.f, 0.f, 0.f, 0.f, 0.f, 0.f, 0.f, 0.f, 0.f, 0.f, 0.f, 0.f, 0.f, 0.f, 0.f};
    for (int unit = F.blk; unit < BATCH * NH_SSM; unit += F.nblk) {
        const int b = unit / NH_SSM, h = unit % NH_SSM, g = h >> 3;
        const float a = -__expf(F.a_log[h]);
        f32x16 st = zero16;
        u32x4 rb[4], rc[4], rx[2]; float d0, d1;
#define SSD_LOAD(c) do { const size_t row0_ = (size_t)b * SEQ + (size_t)(c) * 128; \
            _Pragma("unroll") for (int i = 0; i < 4; ++i) { const int piece = tid + 512 * i, row = piece >> 4, ch = piece & 15; \
                rb[i] = *(const u32x4*)(CV + (row0_ + row) * CONVD + 2048 + g * 128 + ch * 8); rc[i] = *(const u32x4*)(CV + (row0_ + row) * CONVD + 2560 + g * 128 + ch * 8); } \
            _Pragma("unroll") for (int i = 0; i < 2; ++i) { const int piece = tid + 512 * i, row = piece >> 3, ch = piece & 7; rx[i] = *(const u32x4*)(CV + (row0_ + row) * CONVD + h * 64 + ch * 8); } \
            d0 = DT[(size_t)h * T + row0_ + lane]; d1 = DT[(size_t)h * T + row0_ + 64 + lane]; } while (0)
        SSD_LOAD(0);
        for (int c = 0; c < 16; ++c) {
            const size_t row0 = (size_t)b * SEQ + (size_t)c * 128;
            float x0 = d0 * a, x1 = d1 * a;
#pragma unroll
            for (int o = 1; o < 64; o <<= 1) { const float t0 = __shfl_up(x0, o), t1 = __shfl_up(x1, o); if (lane >= o) { x0 += t0; x1 += t1; } }
            x1 += __shfl(x0, 63);
            const float total = __shfl(x1, 63);
            __syncthreads();
            acs[lane] = x0; acs[64 + lane] = x1; dtv[lane] = d0; dtv[64 + lane] = d1;
#pragma unroll
            for (int i = 0; i < 4; ++i) { const int piece = tid + 512 * i, row = piece >> 4, ch = piece & 15;
                *(LAS u32x4*)(Bimg + swz256(row, ch)) = rb[i]; *(LAS u32x4*)(Cimg + swz256(row, ch)) = rc[i]; }
#pragma unroll
            for (int i = 0; i < 2; ++i) { const int piece = tid + 512 * i, row = piece >> 3, ch = piece & 7;
                const float w = __expf(total - acs[row]) * dtv[row];
                const u32x4 v = rx[i]; u32x4 o;
                o.x = pk2(bflo(v.x) * w, bfhi(v.x) * w); o.y = pk2(bflo(v.y) * w, bfhi(v.y) * w); o.z = pk2(bflo(v.z) * w, bfhi(v.z) * w); o.w = pk2(bflo(v.w) * w, bfhi(v.w) * w);
                *(LAS u32x4*)(Ximg + swz128(row, ch)) = v; *(LAS u32x4*)(Xwimg + swz128(row, ch)) = o; }
#pragma unroll
            for (int g4 = 0; g4 < 4; ++g4) { u32x2 w2; w2.x = pk2(st[4 * g4], st[4 * g4 + 1]); w2.y = pk2(st[4 * g4 + 2], st[4 * g4 + 3]);
                *(LAS u32x2*)(Simg + swz256(32 * pb + r, 4 * lb + g4) + 8 * hh) = w2; }
            __syncthreads();
            bf16x8_t cf[8];
#pragma unroll
            for (int kk = 0; kk < 8; ++kk) cf[kk] = *(const LAS bf16x8_t*)(Cimg + swz256(32 * lb + r, 2 * kk + hh));
            const float acs_l = acs[32 * lb + r];
            f32x16 yd = zero16;
            for (int sb = 0; sb <= lb; ++sb) {
                f32x16 gt = zero16;
#pragma unroll
                for (int kk = 0; kk < 8; ++kk) { const bf16x8_t bfm = *(const LAS bf16x8_t*)(Bimg + swz256(32 * sb + r, 2 * kk + hh)); gt = __builtin_amdgcn_mfma_f32_32x32x16_bf16(bfm, cf[kk], gt, 0, 0, 0); }
#pragma unroll
                for (int i = 0; i < 16; ++i) { const int s = 32 * sb + crow_(i, hh), l = 32 * lb + r;
                    const float e = __expf(fminf(acs_l - acs[s], 0.f)) * dtv[s];
                    gt[i] = (s <= l) ? gt[i] * e : 0.f; }
#pragma unroll
                for (int q = 0; q < 2; ++q) {
                    u32x4 pw; pw.x = pk2(gt[8 * q], gt[8 * q + 1]); pw.y = pk2(gt[8 * q + 2], gt[8 * q + 3]); pw.z = pk2(gt[8 * q + 4], gt[8 * q + 5]); pw.w = pk2(gt[8 * q + 6], gt[8 * q + 7]);
                    const bf16x8_t pa = __builtin_bit_cast(bf16x8_t, pw);
                    const int row_lo = 32 * sb + 16 * q + 4 * hh + q4, row_hi = row_lo + 8, chunk = 4 * pb + 2 * blk16 + (p4 >> 1), sub = (p4 & 1) * 8;
                    const s16x4_t lo = tr_read_(Ximg + swz128(row_lo, chunk) + sub), hi = tr_read_(Ximg + swz128(row_hi, chunk) + sub);
                    const bf16x8_t xf = (bf16x8_t){lo[0], lo[1], lo[2], lo[3], hi[0], hi[1], hi[2], hi[3]};
                    yd = __builtin_amdgcn_mfma_f32_32x32x16_bf16(pa, xf, yd, 0, 0, 0);
                }
            }
            f32x16 yo = zero16;
#pragma unroll
            for (int kk = 0; kk < 8; ++kk) { const bf16x8_t sf = *(const LAS bf16x8_t*)(Simg + swz256(32 * pb + r, 2 * kk + hh)); yo = __builtin_amdgcn_mfma_f32_32x32x16_bf16(cf[kk], sf, yo, 0, 0, 0); }
#pragma unroll
            for (int i = 0; i < 16; ++i) { const int l = 32 * lb + crow_(i, hh);
                const float y = yd[i] + __expf(acs[l]) * yo[i];
                Y[(row0 + l) * DI + h * 64 + 32 * pb + r] = (bf16)f2bf(y); }
            if (c + 1 < 16) SSD_LOAD(c + 1);
            const float cd = __expf(total);
#pragma unroll
            for (int i = 0; i < 16; ++i) st[i] *= cd;
#pragma unroll
            for (int kk = 0; kk < 8; ++kk) {
                const int row_lo = 16 * kk + 4 * hh + q4, row_hi = row_lo + 8, sub = (p4 & 1) * 8;
                const int chb = 4 * lb + 2 * blk16 + (p4 >> 1), chx = 4 * pb + 2 * blk16 + (p4 >> 1);
                const s16x4_t blo = tr_read_(Bimg + swz256(row_lo, chb) + sub), bhi = tr_read_(Bimg + swz256(row_hi, chb) + sub);
                const s16x4_t xlo = tr_read_(Xwimg + swz128(row_lo, chx) + sub), xhi = tr_read_(Xwimg + swz128(row_hi, chx) + sub);
                const bf16x8_t af = (bf16x8_t){blo[0], blo[1], blo[2], blo[3], bhi[0], bhi[1], bhi[2], bhi[3]};
                const bf16x8_t xf = (bf16x8_t){xlo[0], xlo[1], xlo[2], xlo[3], xhi[0], xhi[1], xhi[2], xhi[3]};
                st = __builtin_amdgcn_mfma_f32_32x32x16_bf16(af, xf, st, 0, 0, 0);
            }
        }
#undef SSD_LOAD
    }
    __syncthreads();
}
__device__ __forceinline__ void p_ssd_fast2(Frame& F) {
    const int lane = ((int)(threadIdx.x & 63u)), r = lane & 31, hh = lane >> 5, pb = F.wave >> 2, nb = F.wave & 3, lb = pb ? 3 - nb : nb, tid = ((int)threadIdx.x);
#define SSD2_PTRS() unsigned opq_ = 0; asm volatile("" : "+s"(opq_)); \
    LAS unsigned char* const Bimg = F.lds + opq_; LAS unsigned char* const Cimg = Bimg + 34816; LAS unsigned char* const Ximg0 = Bimg + 69632; LAS unsigned char* const Simg0 = Bimg + 106496; \
    LAS float* const tab0 = (LAS float*)(Bimg + 141312); \
    const bf16* const CV = (const bf16*)(F.ws + WS_CONV + opq_); const float* const DT = (const float*)(F.ws + WS_DT + opq_); bf16* const Y = (bf16*)(F.ws + WS_YZ + opq_); \
    int tidl_ = ((int)threadIdx.x); asm volatile("" : "+v"(tidl_)); const int tid = tidl_, lane = tid & 63, r = lane & 31, hh = lane >> 5, q4 = (lane & 15) >> 2, blk16 = (lane >> 4) & 1, p4 = lane & 3; \
    (void)tid; (void)r; (void)hh; (void)q4; (void)blk16; (void)p4
    const int q4 = (lane & 15) >> 2, blk16 = (lane >> 4) & 1, p4 = lane & 3;
    const f32x16 zero16 = {0.f, 0.f, 0.f, 0.f, 0.f, 0.f, 0.f, 0.f, 0.f, 0.f, 0.f, 0.f, 0.f, 0.f, 0.f, 0.f};
    for (int unit = F.blk; unit < BATCH * NG_SSM * 4; unit += F.nblk) {
        const int b = unit >> 4, g = (unit >> 2) & 3, h0 = 8 * g + 2 * (unit & 3);
        const float a0 = -__expf(F.a_log[h0]), a1 = -__expf(F.a_log[h0 + 1]), dsk0 = F.d_skip[h0], dsk1 = F.d_skip[h0 + 1];
        f32x16 st[2]; st[0] = zero16; st[1] = zero16;
        u32x4 rb[4], rc[4], rx[2][2]; float dm0 = 0.f, dm1 = 0.f;
#define SSD2_LOAD(c) do { const size_t row0_ = (size_t)b * SEQ + (size_t)(c) * 128; \
            _Pragma("unroll") for (int i = 0; i < 4; ++i) { const int piece = tid + 512 * i, row = piece >> 4, ch = piece & 15; \
                rb[i] = *(const u32x4*)(CV + (row0_ + row) * CONVD + 2048 + g * 128 + ch * 8); rc[i] = *(const u32x4*)(CV + (row0_ + row) * CONVD + 2560 + g * 128 + ch * 8); } \
            _Pragma("unroll") for (int e = 0; e < 2; ++e) { \
                _Pragma("unroll") for (int i = 0; i < 2; ++i) { const int piece = tid + 512 * i, row = piece >> 3, ch = piece & 7; rx[e][i] = *(const u32x4*)(CV + (row0_ + row) * CONVD + (h0 + e) * 64 + ch * 8); } \
                } \
            if (F.wave < 2) { dm0 = DT[(size_t)(h0 + (F.wave & 1)) * T + row0_ + lane]; dm1 = DT[(size_t)(h0 + (F.wave & 1)) * T + row0_ + 64 + lane]; } } while (0)
        { SSD2_PTRS(); SSD2_LOAD(0); }
        for (int c = 0; c < 16; ++c) {
            const size_t row0 = (size_t)b * SEQ + (size_t)c * 128;
            float x0 = 0.f, x1 = 0.f, tot = 0.f; const int es = F.wave & 1;
            if (F.wave < 2) { const float a = es ? a1 : a0; x0 = dm0 * a; x1 = dm1 * a;
#pragma unroll
                for (int o = 1; o < 64; o <<= 1) { const float t0 = __shfl_up(x0, o), t1 = __shfl_up(x1, o); if (lane >= o) { x0 += t0; x1 += t1; } }
                x1 += __shfl(x0, 63); tot = __shfl(x1, 63); }
            LDS_BARRIER();
            for (int repw_ = 0; repw_ < SSD_REP_W; ++repw_) { SSD2_PTRS();
            if (F.wave < 2) { LAS float* const tb = tab0 + 704 * es;
                const float dd0 = dm0, dd1 = dm1;
                tb[lane] = x0; tb[64 + lane] = x1; tb[128 + lane] = dd0; tb[192 + lane] = dd1;
                tb[256 + lane] = __expf(tot - x0) * dd0; tb[320 + lane] = __expf(tot - x1) * dd1;
                tb[384 + lane] = __expf(x0); tb[448 + lane] = __expf(x1);
                const float a32 = __shfl(x0, 32), a64 = __shfl(x1, 0), a96 = __shfl(x1, 32);
                if (lane < 32) { tb[512 + lane] = __expf(a32 - x0) * dd0; tb[512 + 96 + 64 + lane] = __expf(a96 - x1) * dd1; }
                tb[512 + 32 + lane] = __expf(a64 - x0) * dd0; tb[512 + 96 + lane] = __expf(a96 - x0) * dd0; }
#pragma unroll
            for (int i = 0; i < 4; ++i) { const int piece = tid + 512 * i, row = piece >> 4, ch = piece & 15;
                *(LAS u32x4*)(Bimg + swz256(row, ch)) = rb[i]; *(LAS u32x4*)(Cimg + swz256(row, ch)) = rc[i]; }
#pragma unroll
            for (int e = 0; e < 2; ++e) {
#pragma unroll
                for (int i = 0; i < 2; ++i) { const int piece = tid + 512 * i, row = piece >> 3, ch = piece & 7; *(LAS u32x4*)(Ximg0 + 18432 * e + swz128(row, ch)) = rx[e][i]; }
#pragma unroll
                for (int g4 = 0; g4 < 4; ++g4) { u32x2 w2; w2.x = cvtpk(st[e][4 * g4], st[e][4 * g4 + 1]); w2.y = cvtpk(st[e][4 * g4 + 2], st[e][4 * g4 + 3]);
                    *(LAS u32x2*)(Simg0 + 17408 * e + swz256(32 * pb + r, 4 * nb + g4) + 8 * hh) = w2; }
            }
            }
            LDS_BARRIER();
            { SSD2_PTRS(); if (c + 1 < 16) SSD2_LOAD(c + 1); }
            for (int repa_ = 0; repa_ < SSD_REP_A; ++repa_) { SSD2_PTRS();
            bf16x8_t cf[8];
#pragma unroll
            for (int kk = 0; kk < 8; ++kk) cf[kk] = *(const LAS bf16x8_t*)(Cimg + swz256(32 * lb + r, 2 * kk + hh));
            const float acs_l0 = tab0[32 * lb + r], acs_l1 = tab0[704 + 32 * lb + r];
            const float e1_0 = __expf(acs_l0 - tab0[32 * lb]), e1_1 = __expf(acs_l1 - tab0[704 + 32 * lb]);
            const int e2off = lb == 1 ? 0 : (lb == 2 ? 32 : 96);
            f32x16 yd[2]; yd[0] = zero16; yd[1] = zero16;
            for (int sb = 0; sb <= lb; ++sb) {
                f32x16 gt = zero16;
#pragma unroll
                for (int kk = 0; kk < 8; ++kk) { const bf16x8_t bfm = *(const LAS bf16x8_t*)(Bimg + swz256(32 * sb + r, 2 * kk + hh)); gt = __builtin_amdgcn_mfma_f32_32x32x16_bf16(bfm, cf[kk], gt, 0, 0, 0); }
#pragma unroll
                for (int e = 0; e < 2; ++e) {
                    const LAS float* const tb = tab0 + 704 * e;
                    float gv[16];
                    if (sb < lb) {
                        const float e1 = e ? e1_1 : e1_0;
#pragma unroll
                        for (int g4 = 0; g4 < 4; ++g4) { const f32x4 t = *(const LAS f32x4*)(tb + 512 + e2off + 32 * sb + 8 * g4 + 4 * hh);
                            gv[4 * g4] = gt[4 * g4] * (t.x * e1); gv[4 * g4 + 1] = gt[4 * g4 + 1] * (t.y * e1); gv[4 * g4 + 2] = gt[4 * g4 + 2] * (t.z * e1); gv[4 * g4 + 3] = gt[4 * g4 + 3] * (t.w * e1); }
                    } else {
                        const float acs_l = e ? acs_l1 : acs_l0;
#pragma unroll
                        for (int g4 = 0; g4 < 4; ++g4) { const f32x4 ta = *(const LAS f32x4*)(tb + 32 * sb + 8 * g4 + 4 * hh), td = *(const LAS f32x4*)(tb + 128 + 32 * sb + 8 * g4 + 4 * hh);
                            const float av[4] = {ta.x, ta.y, ta.z, ta.w}, dv[4] = {td.x, td.y, td.z, td.w};
#pragma unroll
                            for (int j = 0; j < 4; ++j) { const int sl = 8 * g4 + 4 * hh + j;
                                gv[4 * g4 + j] = (sl <= r) ? gt[4 * g4 + j] * (__expf(fminf(acs_l - av[j], 0.f)) * dv[j]) : 0.f; } }
                    }
#pragma unroll
                    for (int q = 0; q < 2; ++q) {
                        u32x4 pw; pw.x = cvtpk(gv[8 * q], gv[8 * q + 1]); pw.y = cvtpk(gv[8 * q + 2], gv[8 * q + 3]); pw.z = cvtpk(gv[8 * q + 4], gv[8 * q + 5]); pw.w = cvtpk(gv[8 * q + 6], gv[8 * q + 7]);
                        const bf16x8_t pa = __builtin_bit_cast(bf16x8_t, pw);
                        const int row_lo = 32 * sb + 16 * q + 4 * hh + q4, row_hi = row_lo + 8, chunk = 4 * pb + 2 * blk16 + (p4 >> 1), sub = (p4 & 1) * 8;
                        const s16x4_t lo = tr_read_(Ximg0 + 18432 * e + swz128(row_lo, chunk) + sub), hi = tr_read_(Ximg0 + 18432 * e + swz128(row_hi, chunk) + sub);
                        const bf16x8_t xf = (bf16x8_t){lo[0], lo[1], lo[2], lo[3], hi[0], hi[1], hi[2], hi[3]};
                        yd[e] = __builtin_amdgcn_mfma_f32_32x32x16_bf16(pa, xf, yd[e], 0, 0, 0);
                    }
                }
            }
#pragma unroll
            for (int e = 0; e < 2; ++e) {
                f32x16 yo = zero16;
#pragma unroll
                for (int kk = 0; kk < 8; ++kk) { const bf16x8_t sf = *(const LAS bf16x8_t*)(Simg0 + 17408 * e + swz256(32 * pb + r, 2 * kk + hh)); yo = __builtin_amdgcn_mfma_f32_32x32x16_bf16(cf[kk], sf, yo, 0, 0, 0); }
#pragma unroll
                for (int g4 = 0; g4 < 4; ++g4) { const f32x4 ea = *(const LAS f32x4*)(tab0 + 704 * e + 384 + 32 * lb + 8 * g4 + 4 * hh); const float eav[4] = {ea.x, ea.y, ea.z, ea.w};
                    const s16x4_t xs4 = tr_read_(Ximg0 + 18432 * e + swz128(32 * lb + 8 * g4 + 4 * hh + q4, 4 * pb + 2 * blk16 + (p4 >> 1)) + (p4 & 1) * 8);
#pragma unroll
                    for (int j = 0; j < 4; ++j) { const int i = 4 * g4 + j, l = 32 * lb + 8 * g4 + 4 * hh + j;
                        const float y = yd[e][i] + eav[j] * yo[i] + (e ? dsk1 : dsk0) * bf2f((bf16)xs4[j]);
                        Y[(row0 + l) * DI + (h0 + e) * 64 + 32 * pb + r] = (bf16)(cvtpk(y, y) & 0xffffu); } }
            }
            }
            { SSD2_PTRS();
            { const float cd0 = __expf(tab0[127]), cd1 = __expf(tab0[704 + 127]);
#pragma unroll
              for (int i = 0; i < 16; ++i) { st[0][i] *= cd0; st[1][i] *= cd1; } }
#pragma unroll
            for (int kk = 0; kk < 8; ++kk) {
                const int row_lo = 16 * kk + 4 * hh + q4, row_hi = row_lo + 8, sub = (p4 & 1) * 8;
                const int chb = 4 * nb + 2 * blk16 + (p4 >> 1), chx = 4 * pb + 2 * blk16 + (p4 >> 1);
                const s16x4_t blo = tr_read_(Bimg + swz256(row_lo, chb) + sub), bhi = tr_read_(Bimg + swz256(row_hi, chb) + sub);
                const bf16x8_t af = (bf16x8_t){blo[0], blo[1], blo[2], blo[3], bhi[0], bhi[1], bhi[2], bhi[3]};
#pragma unroll
                for (int e = 0; e < 2; ++e) {
                    const s16x4_t xlo = tr_read_(Ximg0 + 18432 * e + swz128(row_lo, chx) + sub), xhi = tr_read_(Ximg0 + 18432 * e + swz128(row_hi, chx) + sub);
                    const f32x4 wl = *(const LAS f32x4*)(tab0 + 704 * e + 256 + 16 * kk + 4 * hh), wh = *(const LAS f32x4*)(tab0 + 704 * e + 256 + 16 * kk + 8 + 4 * hh);
                    u32x4 pw;
                    pw.x = cvtpk(bf2f((bf16)xlo[0]) * wl.x, bf2f((bf16)xlo[1]) * wl.y); pw.y = cvtpk(bf2f((bf16)xlo[2]) * wl.z, bf2f((bf16)xlo[3]) * wl.w);
                    pw.z = cvtpk(bf2f((bf16)xhi[0]) * wh.x, bf2f((bf16)xhi[1]) * wh.y); pw.w = cvtpk(bf2f((bf16)xhi[2]) * wh.z, bf2f((bf16)xhi[3]) * wh.w);
                    st[e] = __builtin_amdgcn_mfma_f32_32x32x16_bf16(af, __builtin_bit_cast(bf16x8_t, pw), st[e], 0, 0, 0);
                }
            }
            }
        }
#undef SSD2_LOAD
#undef SSD2_PTRS
    }
    __syncthreads();
}

__device__ __forceinline__ void p_ypost2(Frame& F) {
    const int gw = F.blk * NWAVES + F.wave, NGW = F.nblk * NWAVES;
    const bf16* Y = (const bf16*)(F.ws + WS_YZ); const bf16* CV = (const bf16*)(F.ws + WS_CONV); const bf16* Z = (const bf16*)(F.ws + WS_Z); bf16* YN = (bf16*)(F.ws + WS_YN);
    for (int m = gw; m < T; m += NGW) {
#pragma unroll
        for (int g = 0; g < 4; ++g) {
            const int c0 = g * 512 + ((int)(threadIdx.x & 63u)) * 8;
            const u32x4 yw = __builtin_nontemporal_load((const u32x4*)(Y + (size_t)m * DI + c0)), zw = __builtin_nontemporal_load((const u32x4*)(Z + (size_t)m * DI + c0));
            const float yv[8] = {bflo(yw.x), bfhi(yw.x), bflo(yw.y), bfhi(yw.y), bflo(yw.z), bfhi(yw.z), bflo(yw.w), bfhi(yw.w)};
            const float zv[8] = {bflo(zw.x), bfhi(zw.x), bflo(zw.y), bfhi(zw.y), bflo(zw.z), bfhi(zw.z), bflo(zw.w), bfhi(zw.w)};
            float v[8]; float s = 0.f;
#pragma unroll
            for (int i = 0; i < 8; ++i) { v[i] = yv[i] * siluf_(zv[i]); s += v[i] * v[i]; }
            const float rstd = __builtin_amdgcn_rsqf(wave_sum(s) * (1.f / 512.f) + EPS);
            const float* nw = F.ssm_norm_w + c0;
            u32x4 o; o.x = pk2(v[0] * rstd * nw[0], v[1] * rstd * nw[1]); o.y = pk2(v[2] * rstd * nw[2], v[3] * rstd * nw[3]);
            o.z = pk2(v[4] * rstd * nw[4], v[5] * rstd * nw[5]); o.w = pk2(v[6] * rstd * nw[6], v[7] * rstd * nw[7]);
            *(u32x4*)(YN + (size_t)m * DI + c0) = o;
        }
    }
}

__device__ __forceinline__ void p_ypost(Frame& F) {
    const int gw = F.blk * NWAVES + F.wave, NGW = F.nblk * NWAVES;
    const bf16* YZ = (const bf16*)(F.ws + WS_YZ); bf16* YN = (bf16*)(F.ws + WS_YN);
    for (int m = gw; m < T; m += NGW) {
#pragma unroll
        for (int g = 0; g < 4; ++g) {
            const int c0 = g * 512 + ((int)(threadIdx.x & 63u)) * 8;
            const u32x4 w = *(const u32x4*)(YZ + (size_t)m * DI + c0);
            float v[8] = {bflo(w.x), bfhi(w.x), bflo(w.y), bfhi(w.y), bflo(w.z), bfhi(w.z), bflo(w.w), bfhi(w.w)};
            float s = 0.f;
#pragma unroll
            for (int i = 0; i < 8; ++i) s += v[i] * v[i];
            const float rstd = __builtin_amdgcn_rsqf(wave_sum(s) * (1.f / 512.f) + EPS);
            const float* nw = F.ssm_norm_w + c0;
            u32x4 o; o.x = pk2(v[0] * rstd * nw[0], v[1] * rstd * nw[1]); o.y = pk2(v[2] * rstd * nw[2], v[3] * rstd * nw[3]);
            o.z = pk2(v[4] * rstd * nw[4], v[5] * rstd * nw[5]); o.w = pk2(v[6] * rstd * nw[6], v[7] * rstd * nw[7]);
            *(u32x4*)(YN + (size_t)m * DI + c0) = o;
        }
    }
}

__device__ __forceinline__ void p_router(Frame& F) {
    LAS int* hist = (LAS int*)F.lds;
    if (((int)threadIdx.x) < 32) hist[((int)threadIdx.x)] = 0;
    __syncthreads();
    int* ROWMAP = (int*)(F.ws + WS_ROWMAP);
    for (int i = F.blk * NTHREADS + ((int)threadIdx.x); i < CAP; i += F.nblk * NTHREADS) ROWMAP[i] = -1;
    const int gw = F.blk * NWAVES + F.wave, NGW = F.nblk * NWAVES;
    bf16* XN2 = (bf16*)(F.ws + WS_XN2); int* TOPI = (int*)(F.ws + WS_TOPI); float* TOPW = (float*)(F.ws + WS_TOPW);
    for (int m = gw; m < T; m += NGW) {
        const f32x4* xr = (const f32x4*)(F.out + (size_t)m * D) + ((int)(threadIdx.x & 63u));
        const f32x4* wr = (const f32x4*)F.norm_ffn + ((int)(threadIdx.x & 63u));
        f32x4 v[4]; float s = 0.f;
#pragma unroll
        for (int j = 0; j < 4; ++j) { v[j] = xr[64 * j]; s += (v[j].x * v[j].x + v[j].y * v[j].y) + (v[j].z * v[j].z + v[j].w * v[j].w); }
        const float rstd = __builtin_amdgcn_rsqf(wave_sum(s) * (1.f / D) + EPS);
        float lg[32];
#pragma unroll
        for (int e = 0; e < 32; ++e) lg[e] = 0.f;
#pragma unroll
        for (int j = 0; j < 4; ++j) {
            v[j] = v[j] * rstd * wr[64 * j];
            st_bf4(XN2 + (size_t)m * D + (((int)(threadIdx.x & 63u)) + 64 * j) * 4, v[j]);
            const float hv[4] = {v[j].x, v[j].y, v[j].z, v[j].w};
#pragma unroll
            for (int i = 0; i < 4; ++i) {
                const f32x4* rw = (const f32x4*)(F.router_w + (size_t)((((int)(threadIdx.x & 63u)) + 64 * j) * 4 + i) * 32);
#pragma unroll
                for (int c = 0; c < 8; ++c) { const f32x4 w = rw[c]; lg[4 * c] += hv[i] * w.x; lg[4 * c + 1] += hv[i] * w.y; lg[4 * c + 2] += hv[i] * w.z; lg[4 * c + 3] += hv[i] * w.w; }
            }
        }
#pragma unroll
        for (int e = 0; e < 32; ++e) lg[e] = wave_sum(lg[e]) + F.router_b[e];
        int bi[4]; float bv[4];
#pragma unroll
        for (int k = 0; k < 4; ++k) {
            float best = -INFINITY; int be = 0;
#pragma unroll
            for (int e = 0; e < 32; ++e) if (lg[e] > best) { best = lg[e]; be = e; }
            bi[k] = be; bv[k] = best;
#pragma unroll
            for (int e = 0; e < 32; ++e) if (e == be) lg[e] = -INFINITY;
        }
        const float e0 = 1.f, e1 = __expf(bv[1] - bv[0]), e2 = __expf(bv[2] - bv[0]), e3 = __expf(bv[3] - bv[0]);
        const float inv = 1.f / (e0 + e1 + e2 + e3);
        if (((int)(threadIdx.x & 63u)) == 0) {
            *(int4*)(TOPI + (size_t)m * 4) = make_int4(bi[0], bi[1], bi[2], bi[3]);
            *(f32x4*)(TOPW + (size_t)m * 4) = (f32x4){e0 * inv, e1 * inv, e2 * inv, e3 * inv};
            atomicAdd((int*)&hist[bi[0]], 1); atomicAdd((int*)&hist[bi[1]], 1); atomicAdd((int*)&hist[bi[2]], 1); atomicAdd((int*)&hist[bi[3]], 1);
        }
    }
    __syncthreads();
    if (((int)threadIdx.x) < 32) atomicAdd((unsigned*)(F.ctl + CW_CNT + 64 * ((int)threadIdx.x)), (unsigned)hist[((int)threadIdx.x)]);
    __syncthreads();
}

__device__ __forceinline__ void p_conv2(Frame& F) {
    const bf16* X = (const bf16*)(F.ws + WS_XBC); bf16* O = (bf16*)(F.ws + WS_CONV);
    constexpr int NCG = CONVD / 8, total = (T / 8) * NCG;
    for (int idx = F.blk * NTHREADS + ((int)threadIdx.x); idx < total; idx += F.nblk * NTHREADS) {
        const int cg = idx % NCG, tb = idx / NCG, c0 = cg * 8, row0 = tb * 8, t0 = row0 & (SEQ - 1);
        float cw[4][8], cb[8];
#pragma unroll
        for (int w = 0; w < 4; ++w) { const f32x4 a = *(const f32x4*)(F.conv_w + (size_t)w * CONVD + c0), b = *(const f32x4*)(F.conv_w + (size_t)w * CONVD + c0 + 4);
            cw[w][0] = a.x; cw[w][1] = a.y; cw[w][2] = a.z; cw[w][3] = a.w; cw[w][4] = b.x; cw[w][5] = b.y; cw[w][6] = b.z; cw[w][7] = b.w; }
        { const f32x4 a = *(const f32x4*)(F.conv_b + c0), b = *(const f32x4*)(F.conv_b + c0 + 4); cb[0] = a.x; cb[1] = a.y; cb[2] = a.z; cb[3] = a.w; cb[4] = b.x; cb[5] = b.y; cb[6] = b.z; cb[7] = b.w; }
        u32x4 raw[11];
#pragma unroll
        for (int i = 0; i < 11; ++i) { raw[i] = (u32x4){0u, 0u, 0u, 0u}; if (t0 + i - 3 >= 0) raw[i] = *(const u32x4*)(X + (size_t)(row0 + i - 3) * CONVD + c0); }
        float acc[8][8];
#pragma unroll
        for (int tt = 0; tt < 8; ++tt)
#pragma unroll
            for (int c = 0; c < 8; ++c) acc[tt][c] = cb[c];
#pragma unroll
        for (int i = 0; i < 11; ++i) {
            const float xv[8] = {bflo(raw[i].x), bfhi(raw[i].x), bflo(raw[i].y), bfhi(raw[i].y), bflo(raw[i].z), bfhi(raw[i].z), bflo(raw[i].w), bfhi(raw[i].w)};
#pragma unroll
            for (int w = 0; w < 4; ++w) { const int tt = i - w;
                if (tt >= 0 && tt < 8) {
#pragma unroll
                    for (int c = 0; c < 8; ++c) acc[tt][c] += cw[w][c] * xv[c]; } }
        }
#pragma unroll
        for (int tt = 0; tt < 8; ++tt) { u32x4 o; o.x = pk2(siluf_(acc[tt][0]), siluf_(acc[tt][1])); o.y = pk2(siluf_(acc[tt][2]), siluf_(acc[tt][3]));
            o.z = pk2(siluf_(acc[tt][4]), siluf_(acc[tt][5])); o.w = pk2(siluf_(acc[tt][6]), siluf_(acc[tt][7]));
            *(u32x4*)(O + (size_t)(row0 + tt) * CONVD + c0) = o; }
    }
}

__device__ __forceinline__ void p_router2(Frame& F) {
    LAS float* WrT = (LAS float*)F.lds;
    LAS int* hist = (LAS int*)(F.lds + 131072);
    if (((int)threadIdx.x) < 32) hist[((int)threadIdx.x)] = 0;
    for (int i = ((int)threadIdx.x); i < 1024 * 8; i += NTHREADS) { const int k = i >> 3, e4 = (i & 7) * 4; const f32x4 w = *(const f32x4*)(F.router_w + (size_t)k * 32 + e4);
        WrT[(e4 + 0) * 1024 + k] = w.x; WrT[(e4 + 1) * 1024 + k] = w.y; WrT[(e4 + 2) * 1024 + k] = w.z; WrT[(e4 + 3) * 1024 + k] = w.w; }
    int* ROWMAP = (int*)(F.ws + WS_ROWMAP);
    for (int i = F.blk * NTHREADS + ((int)threadIdx.x); i < CAP; i += F.nblk * NTHREADS) ROWMAP[i] = -1;
    __syncthreads();
    const int lane = ((int)(threadIdx.x & 63u)), gw = F.blk * NWAVES + F.wave, NGW = F.nblk * NWAVES;
    bf16* XN2 = (bf16*)(F.ws + WS_XN2); int* TOPI = (int*)(F.ws + WS_TOPI); float* TOPW = (float*)(F.ws + WS_TOPW);
    const float rb = F.router_b[lane >> 1];
    for (int mp = gw; mp < T / 2; mp += NGW) {
        f32x4 v[2][4];
#pragma unroll
        for (int j = 0; j < 2; ++j) {
            const int m = mp * 2 + j;
            const f32x4* xr = (const f32x4*)(F.out + (size_t)m * D) + lane; const f32x4* wr = (const f32x4*)F.norm_ffn + lane;
            float s = 0.f;
#pragma unroll
            for (int q = 0; q < 4; ++q) { v[j][q] = xr[64 * q]; s += (v[j][q].x * v[j][q].x + v[j][q].y * v[j][q].y) + (v[j][q].z * v[j][q].z + v[j][q].w * v[j][q].w); }
            const float rstd = __builtin_amdgcn_rsqf(wave_sum(s) * (1.f / D) + EPS);
#pragma unroll
            for (int q = 0; q < 4; ++q) { v[j][q] = v[j][q] * rstd * wr[64 * q];
#if MOE_FP8
                *(unsigned*)((unsigned char*)XN2 + (size_t)m * D + (lane + 64 * q) * 4) = pk_fp8x4(FP8_ASCALE * v[j][q].x, FP8_ASCALE * v[j][q].y, FP8_ASCALE * v[j][q].z, FP8_ASCALE * v[j][q].w);
#else
                st_bf4(XN2 + (size_t)m * D + (lane + 64 * q) * 4, v[j][q]);
#endif
            }
        }
        float p0[32], p1[32];
        f32x2_t tv[4][4];
#pragma unroll
        for (int q = 0; q < 4; ++q) { tv[q][0] = (f32x2_t){v[0][q].x, v[1][q].x}; tv[q][1] = (f32x2_t){v[0][q].y, v[1][q].y}; tv[q][2] = (f32x2_t){v[0][q].z, v[1][q].z}; tv[q][3] = (f32x2_t){v[0][q].w, v[1][q].w}; }
#pragma unroll
        for (int e = 0; e < 32; ++e) {
            f32x2_t a = {0.f, 0.f};
#pragma unroll
            for (int q = 0; q < 4; ++q) { const f32x4 w = *(const LAS f32x4*)(WrT + e * 1024 + (lane + 64 * q) * 4);
                a = __builtin_elementwise_fma(tv[q][0], (f32x2_t){w.x, w.x}, a); a = __builtin_elementwise_fma(tv[q][1], (f32x2_t){w.y, w.y}, a);
                a = __builtin_elementwise_fma(tv[q][2], (f32x2_t){w.z, w.z}, a); a = __builtin_elementwise_fma(tv[q][3], (f32x2_t){w.w, w.w}, a); }
            p0[e] = a.x; p1[e] = a.y;
        }
#define RS_STEP(P, N, MASK) do { const bool up = (lane & (MASK)) != 0; _Pragma("unroll") for (int i = 0; i < (N); ++i) { const float mine = up ? P[(N) + i] : P[i], other = up ? P[i] : P[(N) + i]; P[i] = mine + __shfl_xor(other, (MASK)); } } while (0)
        RS_STEP(p0, 16, 32); RS_STEP(p0, 8, 16); RS_STEP(p0, 4, 8); RS_STEP(p0, 2, 4); RS_STEP(p0, 1, 2);
        RS_STEP(p1, 16, 32); RS_STEP(p1, 8, 16); RS_STEP(p1, 4, 8); RS_STEP(p1, 2, 4); RS_STEP(p1, 1, 2);
#undef RS_STEP
        float lg[2] = {p0[0] + __shfl_xor(p0[0], 1) + rb, p1[0] + __shfl_xor(p1[0], 1) + rb};
#pragma unroll
        for (int j = 0; j < 2; ++j) {
            const int m = mp * 2 + j; float val = lg[j]; int bi[4]; float bv[4];
#pragma unroll
            for (int k = 0; k < 4; ++k) {
                float mx = val;
#pragma unroll
                for (int o = 1; o < 64; o <<= 1) mx = fmaxf(mx, __shfl_xor(mx, o));
                const unsigned long long bal = __ballot(val == mx);
                const int e = (int)(__ffsll((long long)bal) - 1) >> 1;
                bi[k] = e; bv[k] = mx;
                if ((lane >> 1) == e) val = -INFINITY;
            }
            const float e1 = __expf(bv[1] - bv[0]), e2 = __expf(bv[2] - bv[0]), e3 = __expf(bv[3] - bv[0]);
            const float inv = __builtin_amdgcn_rcpf(1.f + e1 + e2 + e3);
            if (lane == 0) {
                *(int4*)(TOPI + (size_t)m * 4) = make_int4(bi[0], bi[1], bi[2], bi[3]);
                *(f32x4*)(TOPW + (size_t)m * 4) = (f32x4){inv, e1 * inv, e2 * inv, e3 * inv};
                atomicAdd((int*)&hist[bi[0]], 1); atomicAdd((int*)&hist[bi[1]], 1); atomicAdd((int*)&hist[bi[2]], 1); atomicAdd((int*)&hist[bi[3]], 1);
            }
        }
    }
    __syncthreads();
    if (((int)threadIdx.x) < 32) atomicAdd((unsigned*)(F.ctl + CW_CNT + 64 * ((int)threadIdx.x)), (unsigned)hist[((int)threadIdx.x)]);
    __syncthreads();
}

__device__ __forceinline__ void p_router3(Frame& F) {
    LAS float* XS = (LAS float*)F.lds; LAS float* PW = (LAS float*)(F.lds + 66048); LAS float* P = (LAS float*)(F.lds + 66048 + 33792); LAS int* hist = (LAS int*)(F.lds + 66048 + 33792 + 4224);
    if (((int)threadIdx.x) < 32) hist[((int)threadIdx.x)] = 0;
    int* ROWMAP = (int*)(F.ws + WS_ROWMAP);
    for (int i = F.blk * NTHREADS + ((int)threadIdx.x); i < CAP; i += F.nblk * NTHREADS) ROWMAP[i] = -1;
    const int lane = ((int)(threadIdx.x & 63u)), tid = (int)threadIdx.x;
    bf16* XN2 = (bf16*)(F.ws + WS_XN2); int* TOPI = (int*)(F.ws + WS_TOPI); float* TOPW = (float*)(F.ws + WS_TOPW); const float* W2 = (const float*)(F.ws + WS_WRT);
    const float rb32 = F.router_b[lane & 31];
    const f32x4* wr = (const f32x4*)F.norm_ffn + lane;
    for (int tile = F.blk; tile < T / 32; tile += F.nblk) {
        const int m0 = tile * 32;
        f32x16 acc = {0.f, 0.f, 0.f, 0.f, 0.f, 0.f, 0.f, 0.f, 0.f, 0.f, 0.f, 0.f, 0.f, 0.f, 0.f, 0.f};
        const int i = lane & 31, kh = lane >> 5;
        for (int st = 0; st < 2; ++st) {
            __syncthreads();
#pragma unroll
            for (int j = 0; j < 8; ++j) { const int idx = tid + 512 * j, tk = idx >> 7, c4 = idx & 127;
                *(LAS f32x4*)(XS + tk * 516 + 4 * c4) = *(const f32x4*)(F.out + (size_t)(m0 + tk) * D + 512 * st + 4 * c4); }
            __syncthreads();
            const int kb = 64 * F.wave + 32 * kh;
            const float* bp = W2 + (size_t)(512 * st + kb) * 32 + i;
#pragma unroll
            for (int c = 0; c < 8; ++c) { const f32x4 a = *(const LAS f32x4*)(XS + i * 516 + kb + 4 * c);
                const float b0 = bp[(4 * c + 0) * 32], b1 = bp[(4 * c + 1) * 32], b2 = bp[(4 * c + 2) * 32], b3 = bp[(4 * c + 3) * 32];
                acc = __builtin_amdgcn_mfma_f32_32x32x2f32(a.x, b0, acc, 0, 0, 0); acc = __builtin_amdgcn_mfma_f32_32x32x2f32(a.y, b1, acc, 0, 0, 0);
                acc = __builtin_amdgcn_mfma_f32_32x32x2f32(a.z, b2, acc, 0, 0, 0); acc = __builtin_amdgcn_mfma_f32_32x32x2f32(a.w, b3, acc, 0, 0, 0); }
        }
#pragma unroll
        for (int rg = 0; rg < 16; ++rg) PW[(F.wave * 32 + crow_(rg, kh)) * 33 + i] = acc[rg];
        __syncthreads();
        for (int idx = tid; idx < 1024; idx += NTHREADS) { const int tk = idx >> 5, e = idx & 31; float s = 0.f;
#pragma unroll
            for (int w = 0; w < 8; ++w) s += PW[(w * 32 + tk) * 33 + e];
            P[tk * 33 + e] = s; }
        __syncthreads();
        for (int pp = 0; pp < 2; ++pp) {
            f32x4 v[2][4]; float rstd[2];
#pragma unroll
            for (int j = 0; j < 2; ++j) {
                const int m = m0 + 4 * F.wave + 2 * pp + j;
                float s = 0.f;
#pragma unroll
                for (int q = 0; q < 4; ++q) { v[j][q] = ((const f32x4*)(F.out + (size_t)m * D) + lane)[64 * q]; s += (v[j][q].x * v[j][q].x + v[j][q].y * v[j][q].y) + (v[j][q].z * v[j][q].z + v[j][q].w * v[j][q].w); }
                rstd[j] = __builtin_amdgcn_rsqf(wave_sum(s) * (1.f / D) + EPS);
#pragma unroll
                for (int q = 0; q < 4; ++q) { const f32x4 hv = v[j][q] * rstd[j] * wr[64 * q];
#if MOE_FP8
                    *(unsigned*)((unsigned char*)XN2 + (size_t)m * D + (lane + 64 * q) * 4) = pk_fp8x4(FP8_ASCALE * hv.x, FP8_ASCALE * hv.y, FP8_ASCALE * hv.z, FP8_ASCALE * hv.w);
#else
                    st_bf4(XN2 + (size_t)m * D + (lane + 64 * q) * 4, hv);
#endif
                }
            }
            const int jt = lane >> 5, e32 = lane & 31, t = 4 * F.wave + 2 * pp + jt;
            float val = P[t * 33 + e32] * (jt ? rstd[1] : rstd[0]) + rb32;
            int bi[4]; float bv[4];
#pragma unroll
            for (int k = 0; k < 4; ++k) {
                float mx = val;
#pragma unroll
                for (int o = 1; o < 32; o <<= 1) mx = fmaxf(mx, __shfl_xor(mx, o));
                const unsigned long long bal = __ballot(val == mx);
                const unsigned lo32 = (unsigned)bal, hi32 = (unsigned)(bal >> 32);
                const int e = jt ? (__ffs((int)hi32) - 1) : (__ffs((int)lo32) - 1);
                bi[k] = e; bv[k] = mx;
                if (e32 == e) val = -INFINITY;
            }
            const float e1 = __expf(bv[1] - bv[0]), e2 = __expf(bv[2] - bv[0]), e3 = __expf(bv[3] - bv[0]);
            const float inv = __builtin_amdgcn_rcpf(1.f + e1 + e2 + e3);
            if (e32 == 0) { const int m = m0 + t;
                *(int4*)(TOPI + (size_t)m * 4) = make_int4(bi[0], bi[1], bi[2], bi[3]);
                *(f32x4*)(TOPW + (size_t)m * 4) = (f32x4){inv, e1 * inv, e2 * inv, e3 * inv};
                atomicAdd((int*)&hist[bi[0]], 1); atomicAdd((int*)&hist[bi[1]], 1); atomicAdd((int*)&hist[bi[2]], 1); atomicAdd((int*)&hist[bi[3]], 1);
            }
        }
    }
    __syncthreads();
    if (((int)threadIdx.x) < 32) atomicAdd((unsigned*)(F.ctl + CW_CNT + 64 * ((int)threadIdx.x)), (unsigned)hist[((int)threadIdx.x)]);
    __syncthreads();
}

__device__ __forceinline__ void p_slots(Frame& F) {
    LAS int* hist = (LAS int*)F.lds;
    LAS int* base = hist + 32;
    LAS int* pst = hist + 64;
    if (((int)threadIdx.x) == 0) {
        int acc = 0;
        for (int e = 0; e < 32; ++e) { const int c = (int)__hip_atomic_load((unsigned*)(F.ctl + CW_CNT + 64 * e), __ATOMIC_RELAXED, __HIP_MEMORY_SCOPE_AGENT); pst[e] = acc; acc += (c + MOE_PAD - 1) / MOE_PAD * MOE_PAD; }
        pst[32] = acc;
    }
    __syncthreads();
    if (F.blk == 0) {
        int* TEXP = (int*)(F.ws + WS_SMALL);
        for (int i = ((int)threadIdx.x); i < NT256; i += NTHREADS) { const int r = i * 256; int e = -1;
            for (int k = 0; k < 32; ++k) if (r >= pst[k] && r < pst[k + 1]) e = k;
            TEXP[i] = e; }
        if (((int)threadIdx.x) == 0) TEXP[1024] = pst[32] / 256;
    }
    const int* TOPI = (const int*)(F.ws + WS_TOPI); int* SLOT = (int*)(F.ws + WS_SLOT); int* ROWMAP = (int*)(F.ws + WS_ROWMAP);
    for (int c = F.blk; c < T / 128; c += F.nblk) {
        if (((int)threadIdx.x) < 32) hist[((int)threadIdx.x)] = 0;
        __syncthreads();
        const int ai = c * 512 + ((int)threadIdx.x);
        const int e = TOPI[ai];
        const int lr = atomicAdd((int*)&hist[e], 1);
        __syncthreads();
        if (((int)threadIdx.x) < 32) base[((int)threadIdx.x)] = (int)atomicAdd((unsigned*)(F.ctl + CW_CUR + 64 * ((int)threadIdx.x)), (unsigned)hist[((int)threadIdx.x)]);
        __syncthreads();
        const int slot = pst[e] + base[e] + lr;
        SLOT[ai] = slot; ROWMAP[slot] = ai >> 2;
        __syncthreads();
    }
}

__device__ __forceinline__ void p_final(Frame& F) {
    const int gw = F.blk * NWAVES + F.wave, NGW = F.nblk * NWAVES;
    const int* SLOT = (const int*)(F.ws + WS_SLOT); const float* TOPW = (const float*)(F.ws + WS_TOPW); const bf16* YB = (const bf16*)(F.ws + WS_YB);
    for (int m = gw; m < T; m += NGW) {
        f32x4* xr = (f32x4*)(F.out + (size_t)m * D) + ((int)(threadIdx.x & 63u));
        const f32x4* wr = (const f32x4*)F.norm_final + ((int)(threadIdx.x & 63u));
        f32x4 v[4];
#pragma unroll
        for (int j = 0; j < 4; ++j) v[j] = xr[64 * j];
#pragma unroll
        for (int k = 0; k < 4; ++k) {
            const int sl = SLOT[m * 4 + k]; const float w = TOPW[m * 4 + k];
#pragma unroll
            for (int j = 0; j < 4; ++j) { const u32x2 y = __builtin_nontemporal_load((const u32x2*)(YB + (size_t)sl * 1024 + (((int)(threadIdx.x & 63u)) + 64 * j) * 4));
                v[j].x += w * bflo(y.x); v[j].y += w * bfhi(y.x); v[j].z += w * bflo(y.y); v[j].w += w * bfhi(y.y); }
        }
        float s = 0.f;
#pragma unroll
        for (int j = 0; j < 4; ++j) s += (v[j].x * v[j].x + v[j].y * v[j].y) + (v[j].z * v[j].z + v[j].w * v[j].w);
        const float rstd = __builtin_amdgcn_rsqf(wave_sum(s) * (1.f / D) + EPS);
#pragma unroll
        for (int j = 0; j < 4; ++j) __builtin_nontemporal_store(v[j] * rstd * wr[64 * j], xr + 64 * j);
    }
}


__device__ __forceinline__ void stagger_start(int blk, int nblk, unsigned span_ticks  ) {
    const unsigned long long t0 = __builtin_amdgcn_s_memrealtime();
    const unsigned long long want = (unsigned long long)((blk * 37u) % (unsigned)nblk) * span_ticks / (unsigned)nblk;
    while (__builtin_amdgcn_s_memrealtime() - t0 < want) __builtin_amdgcn_s_sleep(8);
}
__global__ void __launch_bounds__(NTHREADS, 2) fwd(Args args) {
    extern __shared__ __attribute__((aligned(16))) unsigned char lds_raw[];
    Frame F;
    F.lds = (LAS unsigned char*)lds_raw;
    F.tid = threadIdx.x; F.lane = F.tid & 63; F.wave = __builtin_amdgcn_readfirstlane(F.tid >> 6);
    F.blk = blockIdx.x; F.nblk = gridDim.x;
    F.x = args.in[0]; F.w_in = args.in[1]; F.rel_bias = args.in[2]; F.w_ba = args.in[3]; F.conv_w = args.in[4]; F.conv_b = args.in[5];
    F.dt_bias = args.in[6]; F.a_log = args.in[7]; F.d_skip = args.in[8]; F.ssm_norm_w = args.in[9]; F.w_bs = args.in[10]; F.gate_bias = args.in[11];
    F.w_out = args.in[12]; F.norm_mix = args.in[13]; F.norm_ffn = args.in[14]; F.router_w = args.in[15]; F.router_b = args.in[16];
    F.w1 = args.in[17]; F.b1 = args.in[18]; F.w2 = args.in[19]; F.b2 = args.in[20]; F.norm_final = args.in[21];
    F.out = args.out; F.ws = args.ws; F.ctl = (gu32*)(args.ws + WS_CTL);
    volatile LAS unsigned* MISC = (volatile LAS unsigned*)(F.lds + MISC_OFF);
    if (((int)threadIdx.x) < 32) MISC[((int)threadIdx.x)] = 0u;
    __syncthreads();
    XcdBarrier bar; bar.bar = (unsigned*)(F.ctl + CW_BAR); bar.x = 0; bar.st = nullptr;
#if MK_FUSED
    bar = xcd_barrier_post((unsigned*)(F.ctl + CW_BAR), MISC + 8);
#define GRID_BAR() xcd_barrier(bar)
#else
#define GRID_BAR() do { } while (0)
#endif
    const int lo = args.ph_lo, hi = args.ph_hi;
#define IN(k) (lo <= (k) && (k) < hi)
#define SEAM(k) do { if ((k) != 5 && IN(k) && IN((k) + 1)) GRID_BAR();     \
        if (PROBE_TIME == (k) && F.blk == 0 && ((int)threadIdx.x) == 0) { const unsigned long long d_ = __builtin_amdgcn_s_memrealtime() - pt_; const unsigned long long s_ = __builtin_amdgcn_s_memrealtime(); \
            while (__builtin_amdgcn_s_memrealtime() - s_ < d_) __builtin_amdgcn_s_sleep(8); } \
        if (PROBE_TIME == (k) + 1) pt_ = __builtin_amdgcn_s_memrealtime(); } while (0)
    unsigned long long pt_ = 0; if (PROBE_TIME == 0) pt_ = __builtin_amdgcn_s_memrealtime();
    unsigned char* ws = F.ws;

    if (IN(0)) { p_rmsnorm_in(F); p_convert_small(F); if (PROBE_DUP == 0) { p_rmsnorm_in(F); p_convert_small(F); } } SEAM(0);
    if (IN(1)) {
#if FG_INPROJ
#if QKV_FP8
        {
            pg8::Gemm gq{(const bf16*)(ws + WS_XNQ), (const bf16*)(ws + WS_WQKVQ), T, C_Z, D / 2}; pg8::StaticOrder SQ; SQ.init(T, C_Z, F.nblk, F.blk);
            pg8::EpiInProjF EQ{ws, F.dt_bias, F.gate_bias, -1, 1.f / (FP8_ASCALE * FP8_WSCALE), 0};
            pg8::gemm_phase<pg8::EpiInProjF, pg8::StaticOrder, true, false, false, true>(F.lds, gq, SQ, EQ, nullptr, nullptr, 0);
        }
        constexpr int PN0 = C_Z / 256;
#else
        constexpr int PN0 = 0;
#endif
        pg8::Gemm g{(const bf16*)(ws + WS_XN), (const bf16*)(ws + WS_WIN_T) + (size_t)PN0 * 256 * D, T, NPROJ_PAD - PN0 * 256, D}; pg8::StaticOrder S; S.init(T, NPROJ_PAD - PN0 * 256, F.nblk, F.blk);
        pg8::EpiInProjF E{ws, F.dt_bias, F.gate_bias, -1, 1.f, PN0};
        if (STAGGER_TICKS) stagger_start(F.blk, F.nblk, STAGGER_TICKS);
        unsigned long long pc0_ = 0, pt0_ = 0;
        if (PROBE_DUP == 300) { pc0_ = clock64(); pt0_ = __builtin_amdgcn_s_memrealtime(); }
        pg8::gemm_phase<pg8::EpiInProjF, pg8::StaticOrder, true, false, false>(F.lds, g, S, E, nullptr, nullptr, 0);
        if (PROBE_DUP == 300 && F.blk == 0 && ((int)threadIdx.x) == 0) {
            const unsigned long long dc = clock64() - pc0_, dt = __builtin_amdgcn_s_memrealtime() - pt0_;
            const unsigned long long want = dc * 5000ull / (dt ? dt : 1ull);
            const unsigned long long s0 = __builtin_amdgcn_s_memrealtime();
            while (__builtin_amdgcn_s_memrealtime() - s0 < want) __builtin_amdgcn_s_sleep(8);
        }
        if (PROBE_DUP == 301 && F.blk == 0 && ((int)threadIdx.x) == 0) {
            const unsigned long long s0 = __builtin_amdgcn_s_memrealtime();
            while (__builtin_amdgcn_s_memrealtime() - s0 < 50000ull) __builtin_amdgcn_s_sleep(8);
        }
        if (PROBE_DUP == 103) { pg8::EpiNullF EN; pg8::Gemm g2{(const bf16*)(ws + WS_XN), (const bf16*)(ws + WS_WIN_T), 16384, 3072, D}; pg8::StaticOrder S2; S2.init(16384, 3072, F.nblk, F.blk);
            pg8::gemm_phase<pg8::EpiNullF, pg8::StaticOrder, true, false, false>(F.lds, g2, S2, EN, nullptr, nullptr, 0); }
        if (PROBE_DUP == 105) { pg8::EpiNullF EN; pg8::Gemm g2{(const bf16*)(ws + WS_XN), (const bf16*)(ws + WS_WIN_T), 16384, 3072, 512}; pg8::StaticOrder S2; S2.init(16384, 3072, F.nblk, F.blk);
            for (int rr = 0; rr < 4; ++rr) pg8::gemm_phase<pg8::EpiNullF, pg8::StaticOrder, true, false, false, true>(F.lds, g2, S2, EN, nullptr, nullptr, 0); }
        if (PROBE_DUP == 104) { pg8::EpiNullF EN; pg8::Gemm g2{(const bf16*)(ws + WS_XN), (const bf16*)(ws + WS_WIN_T), 16384, 3072, D}; pg8::StaticOrder S2; S2.init(16384, 3072, F.nblk, F.blk);
            for (int rr = 0; rr < 4; ++rr) pg8::gemm_phase<pg8::EpiNullF, pg8::StaticOrder, true, false, false>(F.lds, g2, S2, EN, nullptr, nullptr, 0); }
        if (PROBE_DUP == 101) { pg8::EpiNullF EN; pg8::gemm_phase<pg8::EpiNullF, pg8::StaticOrder, true, false, false>(F.lds, g, S, EN, nullptr, nullptr, 0); }
        if (PROBE_DUP == 1) { pg8::gemm_phase<pg8::EpiInProjF, pg8::StaticOrder, true, false, false>(F.lds, g, S, E, nullptr, nullptr, 0); }
#else
        EpiInProj E{ws, F.dt_bias, F.gate_bias}; gemm_naive(F, T / 128, NPROJ, D, (const bf16*)(ws + WS_XN), D, nullptr, F.w_in, NPROJ, nullptr, 0, E);
#endif
    } SEAM(1);
#if FA_ATTN
    if (IN(2)) {
        if (PROBE_DUP == 201) { p_attn_fast<false, true>(F); GRID_BAR(); }
        if (PROBE_DUP == 202) { p_attn_fast<true, false>(F); GRID_BAR(); }
        if (PROBE_DUP == 203) { p_attn_fast<false, false>(F); GRID_BAR(); }
        p_attn_fast(F); if (PROBE_DUP == 2) p_attn_fast(F); } SEAM(2);
    if (IN(3)) { p_attn_merge(F); p_conv2(F); if (PROBE_DUP == 3) { p_attn_merge(F); p_conv2(F); } } SEAM(3);
#else
    if (IN(2)) { p_attn_naive(F); } SEAM(2);
    if (IN(3)) { p_conv(F); } SEAM(3);
#endif
#if FS_SSD
    if (IN(4)) { p_ssd_fast2(F); if (PROBE_DUP == 4) p_ssd_fast2(F); } SEAM(4);
#if MOE_FP8
    if (IN(5)) { p_ypost2(F); p_convert_moe_fp8(F); if (PROBE_DUP == 5) { p_convert_moe_fp8(F); } } SEAM(5);
#else
    if (IN(5)) { p_ypost2(F); p_convert_moe(F); if (PROBE_DUP == 5) { p_convert_moe(F); } } SEAM(5);
#endif
#else
    if (IN(4)) { p_ssd_naive(F); } SEAM(4);
    if (IN(5)) { p_ypost(F); p_convert_moe(F); } SEAM(5);
#endif
    if (IN(6)) {
        __syncthreads();
#if FG_MIX
        pg8::Gemm g{(const bf16*)(ws + WS_ATTN), (const bf16*)(ws + WS_WBA_T), T, D, 512}; pg8::StaticOrder S; S.init(T, D, F.nblk, F.blk);
        pg8::EpiM0F E{ws};
        pg8::gemm_phase<pg8::EpiM0F, pg8::StaticOrder, true, false, false>(F.lds, g, S, E, nullptr, nullptr, 0);
        if (PROBE_DUP == 6) { pg8::gemm_phase<pg8::EpiM0F, pg8::StaticOrder, true, false, false>(F.lds, g, S, E, nullptr, nullptr, 0); }
#else
        EpiM0 E{ws}; gemm_naive(F, T / 128, D, 512, (const bf16*)(ws + WS_ATTN), 512, nullptr, F.w_ba, D, nullptr, 0, E);
#endif
    } SEAM(6);
    if (IN(7)) {
#if FG_MIX
        pg8::Gemm g{(const bf16*)(ws + WS_YN), (const bf16*)(ws + WS_WBS_T), T, D, DI}; pg8::StaticOrder S; S.init(T, D, F.nblk, F.blk);
        pg8::EpiMergedF E{ws};
        pg8::gemm_phase<pg8::EpiMergedF, pg8::StaticOrder, true, false, false>(F.lds, g, S, E, nullptr, nullptr, 0);
        if (PROBE_DUP == 7) { pg8::gemm_phase<pg8::EpiMergedF, pg8::StaticOrder, true, false, false>(F.lds, g, S, E, nullptr, nullptr, 0); }
#else
        EpiMerged E{ws}; gemm_naive(F, T / 128, D, DI, (const bf16*)(ws + WS_YN), DI, nullptr, F.w_bs, D, nullptr, 0, E);
#endif
    } SEAM(7);
    if (IN(8)) {
#if FG_MIX
        pg8::Gemm g{(const bf16*)(ws + WS_MERGED), (const bf16*)(ws + WS_WOUT_T), T, D, D}; pg8::StaticOrder S; S.init(T, D, F.nblk, F.blk);
        pg8::EpiX1F E{F.x, F.out};
        pg8::gemm_phase<pg8::EpiX1F, pg8::StaticOrder, true, false, false>(F.lds, g, S, E, nullptr, nullptr, 0);
        if (PROBE_DUP == 8) { pg8::gemm_phase<pg8::EpiX1F, pg8::StaticOrder, true, false, false>(F.lds, g, S, E, nullptr, nullptr, 0); }
#else
        EpiX1 E{F.x, F.out}; gemm_naive(F, T / 128, D, D, (const bf16*)(ws + WS_MERGED), D, nullptr, F.w_out, D, nullptr, 0, E);
#endif
    } SEAM(8);
    if (IN(9)) { p_router3(F); } SEAM(9);
    if (IN(10)) { p_slots(F); } SEAM(10);
    if (IN(11)) {
#if FG_MOE && MOE_FP8
        const int* texp = (const int*)(ws + WS_SMALL); const int ntile = texp[1024];
        pg8::Gemm g{(const bf16*)(ws + WS_XN2), (const bf16*)(ws + WS_W1T), CAP, 2048, 512}; pg8::MoeOrder S; S.init(ntile, 8, F.nblk, F.blk);
        pg8::EpiMoe1Q E{ws, F.b1, texp};
        pg8::gemm_phase<pg8::EpiMoe1Q, pg8::MoeOrder, true, true, true, true>(F.lds, g, S, E, (const int*)(ws + WS_ROWMAP), texp, (size_t)2048 * 1024);
        if (PROBE_DUP == 11) { pg8::gemm_phase<pg8::EpiMoe1Q, pg8::MoeOrder, true, true, true, true>(F.lds, g, S, E, (const int*)(ws + WS_ROWMAP), texp, (size_t)2048 * 1024); }
#elif FG_MOE
        const int* texp = (const int*)(ws + WS_SMALL); const int ntile = texp[1024];
        pg8::Gemm g{(const bf16*)(ws + WS_XN2), (const bf16*)(ws + WS_W1T), CAP, 2048, D}; pg8::MoeOrder S; S.init(ntile, 8, F.nblk, F.blk);
        pg8::EpiMoe1F E{ws, F.b1, texp};
        pg8::gemm_phase<pg8::EpiMoe1F, pg8::MoeOrder, true, true, true>(F.lds, g, S, E, (const int*)(ws + WS_ROWMAP), texp, (size_t)2048 * 1024 * 2);
#else
        EpiMoe1 E{ws, F.b1}; gemm_naive(F, CAP / 128, 2048, D, (const bf16*)(ws + WS_XN2), D, (const int*)(ws + WS_ROWMAP), F.w1, 2048, (const int*)(ws + WS_SMALL), (size_t)1024 * 2048, E);
#endif
    } SEAM(11);
    if (IN(12)) {
#if FG_MOE && MOE_FP8
        const int* texp = (const int*)(ws + WS_SMALL); const int ntile = texp[1024];
        pg8::Gemm g{(const bf16*)(ws + WS_ACT), (const bf16*)(ws + WS_W2T), CAP, 1024, 512}; pg8::MoeOrder S; S.init(ntile, 4, F.nblk, F.blk);
        pg8::EpiMoe2Q E{ws, F.b2, texp};
        pg8::gemm_phase<pg8::EpiMoe2Q, pg8::MoeOrder, true, false, true, true>(F.lds, g, S, E, nullptr, texp, (size_t)1024 * 1024);
        if (PROBE_DUP == 12) { pg8::gemm_phase<pg8::EpiMoe2Q, pg8::MoeOrder, true, false, true, true>(F.lds, g, S, E, nullptr, texp, (size_t)1024 * 1024); }
#elif FG_MOE
        const int* texp = (const int*)(ws + WS_SMALL); const int ntile = texp[1024];
        pg8::Gemm g{(const bf16*)(ws + WS_ACT), (const bf16*)(ws + WS_W2T), CAP, 1024, 1024}; pg8::MoeOrder S; S.init(ntile, 4, F.nblk, F.blk);
        pg8::EpiMoe2F E{ws, F.b2, texp};
        pg8::gemm_phase<pg8::EpiMoe2F, pg8::MoeOrder, true, false, true>(F.lds, g, S, E, nullptr, texp, (size_t)1024 * 1024 * 2);
#else
        EpiMoe2 E{ws, F.b2}; gemm_naive(F, CAP / 128, 1024, 1024, (const bf16*)(ws + WS_ACT), 1024, nullptr, F.w2, 1024, (const int*)(ws + WS_SMALL), (size_t)1024 * 1024, E);
#endif
    } SEAM(12);
    if (IN(13)) { p_final(F); } SEAM(13);
#undef IN
#undef SEAM
}

extern "C" void kernel_launch(void* const* d_in, const int* in_sizes, int n_in, void* d_out, int out_size, void* d_ws, size_t ws_size, hipStream_t stream) {
    static int grid = 0;
    if (grid == 0) {
        if (n_in != 22 || out_size != T * D || ws_size < WS_END) { fprintf(stderr, "kernel_launch: unexpected shapes: n_in %d out %d ws %zu\n", n_in, out_size, ws_size); grid = -1; return; }
        int dev = 0, cus = 0, per_cu = 0;
        if (hipGetDevice(&dev) != hipSuccess || hipDeviceGetAttribute(&cus, hipDeviceAttributeMultiprocessorCount, dev) != hipSuccess) { grid = -1; return; }
        if (hipFuncSetAttribute((const void*)fwd, hipFuncAttributeMaxDynamicSharedMemorySize, LDS_BYTES) != hipSuccess) { fprintf(stderr, "kernel_launch: hipFuncSetAttribute failed\n"); grid = -1; return; }
        if (hipOccupancyMaxActiveBlocksPerMultiprocessor(&per_cu, (const void*)fwd, NTHREADS, LDS_BYTES) != hipSuccess || per_cu < 1) fprintf(stderr, "kernel_launch: occupancy query says %d\n", per_cu);
        (void)hipGetLastError();
        grid = cus;
    }
    if (grid < 0) return;
    (void)hipMemsetAsync((char*)d_ws + WS_CTL, 0, CTL_ZERO_BYTES, stream);
    Args a{};
    for (int i = 0; i < 22; ++i) a.in[i] = (const float*)d_in[i];
    a.out = (float*)d_out; a.ws = (unsigned char*)d_ws;
#if MK_FUSED
    a.ph_lo = 0; a.ph_hi = NPHASE; a.li = 0;
    hipLaunchKernelGGL(fwd, dim3(grid), dim3(NTHREADS), LDS_BYTES, stream, a);
#else
    for (int p = 0; p < NPHASE; ++p) { a.ph_lo = p; a.ph_hi = p + 1; a.li = p; hipLaunchKernelGGL(fwd, dim3(grid), dim3(NTHREADS), LDS_BYTES, stream, a); }
#endif
}
```

```cpp
#include <hip/hip_runtime.h>
#include <cstdio>
#include <cstdint>

#ifndef MK_FUSED
#define MK_FUSED 1
#endif

#ifndef FG_INPROJ
#define FG_INPROJ 1
#endif
#ifndef PROBE_DUP
#define PROBE_DUP (-1)
#endif
#ifndef STAGGER_TICKS
#define STAGGER_TICKS 0
#endif
#ifndef SSD_REP_A
#define SSD_REP_A 1
#endif
#ifndef SSD_REP_W
#define SSD_REP_W 1
#endif
#ifndef PROBE_TIME
#define PROBE_TIME (-1)
#endif
#ifndef PROBE_SEC
#define PROBE_SEC (-1)
#endif
#ifndef FA_ATTN
#define FA_ATTN 1
#endif
#ifndef FS_SSD
#define FS_SSD 1
#endif
#ifndef MOE_FP8
#define MOE_FP8 1
#endif
#ifndef FP8_X128
#define FP8_X128 1
#endif
#ifndef QKV_FP8
#define QKV_FP8 1
#endif
#ifndef QKV_STORE_FP8
#define QKV_STORE_FP8 1
#endif
#ifndef GATE_FP8
#define GATE_FP8 1
#endif
#ifndef FG_MIX
#define FG_MIX 1
#endif
#ifndef FG_MOE
#define FG_MOE 1
#endif
#define GAS __attribute__((address_space(1)))
#define LAS __attribute__((address_space(3)))
typedef unsigned short bf16;
typedef float f32x4 __attribute__((ext_vector_type(4)));
typedef unsigned u32x4 __attribute__((ext_vector_type(4)));
typedef unsigned u32x2 __attribute__((ext_vector_type(2)));
typedef GAS unsigned gu32;

constexpr int BATCH = 16, SEQ = 2048, D = 1024, T = BATCH * SEQ;
constexpr int NPROJ = 11808;
constexpr int AW = 1536;
constexpr int DI = 2048;
constexpr int CONVD = 3072;
constexpr int NH_SSM = 32, NG_SSM = 4, DSTATE = 128;
constexpr int NEXP = 32, TOPK = 4, NASSIGN = T * TOPK;
constexpr int MOE_PAD = 256;
constexpr int CAP = NASSIGN + NEXP * MOE_PAD;
constexpr int NT256 = CAP / 256;
constexpr float EPS = 1e-5f;
constexpr int C_Q = 0, C_K = 1536, C_V = 3072, C_Z = 4608, C_XBC = 6656, C_DT = 9728, C_GATE = 9760;

constexpr size_t MiB = 1u << 20;
constexpr size_t WS_CTL = 0, CTL_ZERO_BYTES = 128 * 1024;
constexpr size_t WS_SMALL = 1 * MiB;
constexpr size_t WS_XN = 34 * MiB;
constexpr size_t WS_Q = 98 * MiB, WS_K = 194 * MiB, WS_V = 290 * MiB;
constexpr size_t WS_Z = 386 * MiB;
constexpr size_t WS_XBC = 514 * MiB;
constexpr size_t WS_GATE = 706 * MiB;
constexpr size_t WS_DT = 834 * MiB;
constexpr size_t WS_ATTN = 838 * MiB;
constexpr size_t WS_M0 = 870 * MiB;
constexpr size_t WS_CONV = WS_K;
constexpr size_t WS_YZ = WS_XBC;
constexpr size_t WS_YN = WS_Z;
constexpr size_t WS_MERGED = WS_XN;
constexpr size_t WS_XN2 = WS_Q;
constexpr size_t WS_TOPI = 162 * MiB;
constexpr size_t WS_TOPW = 163 * MiB;
constexpr size_t WS_SLOT = 164 * MiB;
constexpr size_t WS_ROWMAP = 165 * MiB;
constexpr size_t WS_ACT = 386 * MiB;
constexpr size_t WS_YB = 658 * MiB;
constexpr size_t WS_WIN_T = 2 * MiB;
constexpr size_t WS_WBA_T = 26 * MiB;
constexpr size_t WS_WBS_T = 27 * MiB;
constexpr size_t WS_WOUT_T = 31 * MiB;
constexpr size_t WS_W1T = 194 * MiB;
constexpr size_t WS_W2T = 322 * MiB;
constexpr int NPROJ_PAD = 12032;
constexpr int TQ_GATE = 18, TQ_Z = 26, TQ_XBC = 34, TQ_DT = 46;
constexpr int NFP8_ROWS = 256 * 26;
constexpr size_t WS_OUTG = 870 * MiB;
constexpr size_t WS_LSE = 966 * MiB;
constexpr size_t WS_BT = 1 * MiB + 65536;
constexpr float FP8_ASCALE = 4.f, FP8_WSCALE = 64.f;
constexpr size_t WS_WRT = 1 * MiB + 131072;
constexpr size_t WS_XNQ = 870 * MiB;
constexpr size_t WS_WQKVQ = 998 * MiB;
constexpr size_t WS_END = 1024 * MiB;
constexpr int CW_TMO = 0;
constexpr int CW_BAR = 4096;
constexpr int CW_CNT = 16384;
constexpr int CW_CUR = 16384 + 64 * 32;

constexpr int NWAVES = 8, NTHREADS = 512;
constexpr int LDS_BYTES = 147456;
constexpr int MISC_OFF = LDS_BYTES - 256;

constexpr int NPHASE = 14;

__device__ __forceinline__ unsigned f2bf(float f) { unsigned u = __builtin_bit_cast(unsigned, f); return (u + 0x7fffu + ((u >> 16) & 1u)) >> 16; }

typedef float f32x2_t __attribute__((ext_vector_type(2))); typedef __bf16 bf16x2_t __attribute__((ext_vector_type(2)));
__device__ __forceinline__ unsigned cvtpk(float lo, float hi) { const f32x2_t v = {lo, hi}; const bf16x2_t b = __builtin_convertvector(v, bf16x2_t); return __builtin_bit_cast(unsigned, b); }
__device__ __forceinline__ unsigned pk2(float lo, float hi) { return cvtpk(lo, hi); }
__device__ __forceinline__ unsigned pk_fp8x4(float a, float b, float c, float d) { int w = __builtin_amdgcn_cvt_pk_fp8_f32(a, b, 0, false); w = __builtin_amdgcn_cvt_pk_fp8_f32(c, d, w, true); return (unsigned)w; }
__device__ __forceinline__ unsigned fp8x2_to_bf16x2(unsigned w, bool hi) { const f32x2_t f = hi ? __builtin_amdgcn_cvt_pk_f32_fp8((int)w, true) : __builtin_amdgcn_cvt_pk_f32_fp8((int)w, false); return cvtpk(f.x, f.y); }
__device__ __forceinline__ u32x4 fp8x8_to_bf16x8(unsigned lo, unsigned hi) { u32x4 o; o.x = fp8x2_to_bf16x2(lo, false); o.y = fp8x2_to_bf16x2(lo, true); o.z = fp8x2_to_bf16x2(hi, false); o.w = fp8x2_to_bf16x2(hi, true); return o; }
__device__ __forceinline__ float bflo(unsigned u) { return __builtin_bit_cast(float, u << 16); }
__device__ __forceinline__ float bfhi(unsigned u) { return __builtin_bit_cast(float, u & 0xffff0000u); }
__device__ __forceinline__ float bf2f(bf16 b) { return __builtin_bit_cast(float, (unsigned)b << 16); }
__device__ __forceinline__ float wave_sum(float v) {
#pragma unroll
    for (int o = 1; o < 64; o <<= 1) v += __shfl_xor(v, o);
    return v;
}
#define LDS_BARRIER() do { asm volatile("s_waitcnt lgkmcnt(0)" ::: "memory"); __builtin_amdgcn_s_barrier(); asm volatile("" ::: "memory"); } while (0)
__device__ __forceinline__ float sigmoidf_(float x) { return __builtin_amdgcn_rcpf(1.f + __expf(-x)); }
__device__ __forceinline__ float siluf_(float x) { return x * __builtin_amdgcn_rcpf(1.f + __expf(-x)); }
__device__ __forceinline__ float softplusf_(float x) { return fmaxf(x, 0.f) + __logf(1.f + __expf(-fabsf(x))); }

#define XB_TMO      128
#define XB_XCNT(j)  (256  + 64 * (j))
#define XB_XSUB(j)  (1280 + 64 * (j))
#define XB_XGEN(j)  (2304 + 64 * (j))
#define XB_TOP      3328
#define XB_TOPGEN   3392
#define XCD_BAR_WORDS 3456
#define XB_SPIN_CAP (1u << 18)
__device__ __forceinline__ unsigned xb_ld(unsigned* p)              { return __hip_atomic_load(p, __ATOMIC_RELAXED, __HIP_MEMORY_SCOPE_AGENT); }
__device__ __forceinline__ unsigned xb_add(unsigned* p, unsigned v) { return __hip_atomic_fetch_add(p, v, __ATOMIC_RELAXED, __HIP_MEMORY_SCOPE_AGENT); }
__device__ __forceinline__ unsigned xb_xcc_id() { return (unsigned)__builtin_amdgcn_s_getreg((3 << 11) | 20) & 0xFu; }
#define XB_SPIN(cond, bar) do { unsigned _sp = 0; while (cond) { __builtin_amdgcn_s_sleep(1); \
    if ((++_sp & 255u) == 0u) { if (xb_ld(&(bar)[XB_TMO])) break; if (_sp > XB_SPIN_CAP) { atomicAdd(&(bar)[XB_TMO], 1u); break; } } } } while (0)
struct XcdBarrier { unsigned* bar; unsigned x; volatile LAS unsigned* st; };
__device__ __forceinline__ XcdBarrier xcd_barrier_post(unsigned* bar, volatile LAS unsigned* st) {
    XcdBarrier b; b.bar = bar; b.x = xb_xcc_id(); b.st = st;
    if (threadIdx.x == 0) (void)xb_add(&bar[XB_XCNT(b.x)], 1u);
    return b;
}
__device__ __forceinline__ void xcd_barrier_complete(unsigned* bar, unsigned x, unsigned& nloc, unsigned& nx) {
    const unsigned G = gridDim.x * gridDim.y * gridDim.z;
    unsigned sum, cnt, mine, sp = 0u;
    for (;;) {
        sum = 0u; cnt = 0u; mine = 0u;
#pragma unroll
        for (unsigned j = 0; j < 16; ++j) { const unsigned c = xb_ld(&bar[XB_XCNT(j)]); sum += c; cnt += (c > 0u) ? 1u : 0u; mine = (j == x) ? c : mine; }
        if (sum == G) break;
        __builtin_amdgcn_s_sleep(1);
        if ((++sp & 255u) == 0u) { if (xb_ld(&bar[XB_TMO])) break; if (sp > XB_SPIN_CAP) { atomicAdd(&bar[XB_TMO], 1u); break; } }
    }
    nloc = mine > 0u ? mine : 1u; nx = cnt > 0u ? cnt : 1u;
}
__device__ __forceinline__ void xcd_barrier(const XcdBarrier& b) {
    asm volatile("s_waitcnt vmcnt(0)" ::: "memory");
    __syncthreads();
    if (threadIdx.x == 0) {
        unsigned* bar = b.bar;
        __builtin_amdgcn_s_waitcnt(0);
        unsigned nloc = b.st[0], nx = b.st[1];
        if (nloc == 0u) { xcd_barrier_complete(bar, b.x, nloc, nx); b.st[0] = nloc; b.st[1] = nx; }
        const unsigned old = xb_add(&bar[XB_XSUB(b.x)], 1u);
        const unsigned gen = old / nloc;
        if (old + 1u == (gen + 1u) * nloc) {
            __builtin_amdgcn_fence(__ATOMIC_RELEASE, "agent");
            asm volatile("s_waitcnt vmcnt(0)" ::: "memory");
            const unsigned og = xb_add(&bar[XB_TOP], 1u);
            const unsigned tg = og / nx;
            if (og + 1u == (tg + 1u) * nx) xb_add(&bar[XB_TOPGEN], 1u);
            else XB_SPIN(xb_ld(&bar[XB_TOPGEN]) == tg, bar);
            __builtin_amdgcn_fence(__ATOMIC_ACQUIRE, "agent");
            xb_add(&bar[XB_XGEN(b.x)], 1u);
            asm volatile("s_waitcnt vmcnt(0)" ::: "memory");
        } else {
            XB_SPIN(xb_ld(&bar[XB_XGEN(b.x)]) == gen, bar);
            __builtin_amdgcn_fence(__ATOMIC_ACQUIRE, "agent");
            asm volatile("s_waitcnt vmcnt(0)" ::: "memory");
        }
    }
    __syncthreads();
}

struct Args { const float* in[22]; float* out; unsigned char* ws; int ph_lo, ph_hi, li, pad; };

struct Frame {
    LAS unsigned char* lds;
    int tid, lane, wave, blk, nblk;
    const float *x, *w_in, *rel_bias, *w_ba, *conv_w, *conv_b, *dt_bias, *a_log, *d_skip, *ssm_norm_w, *w_bs, *gate_bias, *w_out,
                *norm_mix, *norm_ffn, *router_w, *router_b, *w1, *b1, *w2, *b2, *norm_final;
    float* out; unsigned char* ws; gu32* ctl;
};

template <class Epi>
__device__ __forceinline__ void gemm_naive(Frame& F, int nMt, int N, int K, const bf16* A, int lda, const int* rowmap,
                                           const float* B, int ldb, const int* texp, size_t estride, const Epi& epi) {
    LAS float* As = (LAS float*)F.lds;
    LAS float* Bs = As + 16 * 132;
    const int tid = ((int)threadIdx.x), tx = tid & 31, ty = tid >> 5;
    const int nNt = (N + 127) / 128;
    const int ar = tid >> 2, ak = (tid & 3) * 4;
    const int bk = tid >> 5, bn = (tid & 31) * 4;
    for (int tile = F.blk; tile < nMt * nNt; tile += F.nblk) {
        const int mt = tile / nNt, nt = tile % nNt;
        int e = 0;
        if (texp) { e = texp[mt >> 1]; if (e < 0) continue; }
        const float* Bp = B + (size_t)e * estride;
        float acc[8][4];
#pragma unroll
        for (int i = 0; i < 8; ++i)
#pragma unroll
            for (int j = 0; j < 4; ++j) acc[i][j] = 0.f;
        int grow = mt * 128 + ar; if (rowmap) grow = rowmap[grow];
        const bf16* ap = A + (size_t)(grow < 0 ? 0 : grow) * lda + ak;
        const bool aok = grow >= 0;
        const int gcol = nt * 128 + bn;
        const bool bok = gcol < N;
        for (int k0 = 0; k0 < K; k0 += 16) {
            u32x2 av = (u32x2){0u, 0u};
            if (aok) av = *(const u32x2*)(ap + k0);
            f32x4 bv = (f32x4){0.f, 0.f, 0.f, 0.f};
            if (bok) bv = *(const f32x4*)(Bp + (size_t)(k0 + bk) * ldb + gcol);
            __syncthreads();
            As[(ak + 0) * 132 + ar] = bflo(av.x); As[(ak + 1) * 132 + ar] = bfhi(av.x);
            As[(ak + 2) * 132 + ar] = bflo(av.y); As[(ak + 3) * 132 + ar] = bfhi(av.y);
            *(LAS f32x4*)&Bs[bk * 132 + bn] = bv;
            __syncthreads();
#pragma unroll
            for (int k = 0; k < 16; ++k) {
                const f32x4 a0 = *(const LAS f32x4*)&As[k * 132 + ty * 8], a1 = *(const LAS f32x4*)&As[k * 132 + ty * 8 + 4];
                const f32x4 b = *(const LAS f32x4*)&Bs[k * 132 + tx * 4];
                const float a[8] = {a0.x, a0.y, a0.z, a0.w, a1.x, a1.y, a1.z, a1.w};
                const float bb[4] = {b.x, b.y, b.z, b.w};
#pragma unroll
                for (int i = 0; i < 8; ++i)
#pragma unroll
                    for (int j = 0; j < 4; ++j) acc[i][j] = fmaf(a[i], bb[j], acc[i][j]);
            }
        }
        const int col0 = nt * 128 + tx * 4;
        if (col0 < N) {
#pragma unroll
            for (int i = 0; i < 8; ++i) epi(mt * 128 + ty * 8 + i, col0, (f32x4){acc[i][0], acc[i][1], acc[i][2], acc[i][3]}, e);
        }
    }
    __syncthreads();
}

__device__ __forceinline__ void st_bf4(bf16* p, f32x4 v) { u32x2 w; w.x = pk2(v.x, v.y); w.y = pk2(v.z, v.w); *(u32x2*)p = w; }

struct EpiInProj {
    unsigned char* ws; const float* dt_bias; const float* gate_bias;
    __device__ __forceinline__ void operator()(int row, int col, f32x4 v, int) const {
        if (col < C_K)        st_bf4((bf16*)(ws + WS_Q) + (size_t)row * AW + (col - C_Q), v);
        else if (col < C_V)   st_bf4((bf16*)(ws + WS_K) + (size_t)row * AW + (col - C_K), v);
        else if (col < C_Z)   st_bf4((bf16*)(ws + WS_V) + (size_t)row * AW + (col - C_V), v);
        else if (col < C_XBC) st_bf4((bf16*)(ws + WS_Z) + (size_t)row * DI + (col - C_Z), v);
        else if (col < C_DT)  st_bf4((bf16*)(ws + WS_XBC) + (size_t)row * CONVD + (col - C_XBC), v);
        else if (col < C_GATE) { const int c = col - C_DT; f32x4 o;
            o.x = softplusf_(v.x + dt_bias[c]); o.y = softplusf_(v.y + dt_bias[c + 1]); o.z = softplusf_(v.z + dt_bias[c + 2]); o.w = softplusf_(v.w + dt_bias[c + 3]);
            float* dp = (float*)(ws + WS_DT) + row; dp[(size_t)c * T] = o.x; dp[(size_t)(c + 1) * T] = o.y; dp[(size_t)(c + 2) * T] = o.z; dp[(size_t)(c + 3) * T] = o.w; }
        else { const int c = col - C_GATE; f32x4 o;
            o.x = sigmoidf_(v.x + gate_bias[c]); o.y = sigmoidf_(v.y + gate_bias[c + 1]); o.z = sigmoidf_(v.z + gate_bias[c + 2]); o.w = sigmoidf_(v.w + gate_bias[c + 3]);
            st_bf4((bf16*)(ws + WS_GATE) + (size_t)row * 2048 + c, o); }
    }
};
struct EpiM0 {
    unsigned char* ws;
    __device__ __forceinline__ void operator()(int row, int col, f32x4 v, int) const {
        const u32x2 g = *(const u32x2*)((const bf16*)(ws + WS_GATE) + (size_t)row * 2048 + col);
        f32x4 o; o.x = v.x * bflo(g.x); o.y = v.y * bfhi(g.x); o.z = v.z * bflo(g.y); o.w = v.w * bfhi(g.y);
        st_bf4((bf16*)(ws + WS_M0) + (size_t)row * D + col, o);
    }
};
struct EpiMerged {
    unsigned char* ws;
    __device__ __forceinline__ void operator()(int row, int col, f32x4 v, int) const {
        const u32x2 g = *(const u32x2*)((const bf16*)(ws + WS_GATE) + (size_t)row * 2048 + 1024 + col);
        const u32x2 mw = *(const u32x2*)((const bf16*)(ws + WS_M0) + (size_t)row * D + col); const f32x4 m = (f32x4){bflo(mw.x), bfhi(mw.x), bflo(mw.y), bfhi(mw.y)};
        f32x4 o; o.x = m.x + v.x * bflo(g.x); o.y = m.y + v.y * bfhi(g.x); o.z = m.z + v.z * bflo(g.y); o.w = m.w + v.w * bfhi(g.y);
        st_bf4((bf16*)(ws + WS_MERGED) + (size_t)row * D + col, o);
    }
};
struct EpiX1 {
    const float* x; float* out;
    __device__ __forceinline__ void operator()(int row, int col, f32x4 v, int) const {
        const f32x4 xv = *(const f32x4*)(x + (size_t)row * D + col);
        *(f32x4*)(out + (size_t)row * D + col) = xv + v;
    }
};
__device__ __forceinline__ float swiglu_(float g, float l) {
    g = fminf(g, 7.f); l = fminf(fmaxf(l, -7.f), 7.f);
    return g * sigmoidf_(1.702f * g) * (l + 1.f);
}
struct EpiMoe1 {
    unsigned char* ws; const float* b1;
    __device__ __forceinline__ void operator()(int row, int col, f32x4 v, int e) const {
        const f32x4 b = *(const f32x4*)(b1 + (size_t)e * 2048 + col);
        const float o0 = swiglu_(v.x + b.x, v.y + b.y), o1 = swiglu_(v.z + b.z, v.w + b.w);
        *(unsigned*)((bf16*)(ws + WS_ACT) + (size_t)row * 1024 + (col >> 1)) = pk2(o0, o1);
    }
};
struct EpiMoe2 {
    unsigned char* ws; const float* b2;
    __device__ __forceinline__ void operator()(int row, int col, f32x4 v, int e) const {
        const f32x4 b = *(const f32x4*)(b2 + (size_t)e * 1024 + col);
        st_bf4((bf16*)(ws + WS_YB) + (size_t)row * 1024 + col, v + b);
    }
};

namespace pg8 {
typedef short bf16x8 __attribute__((ext_vector_type(8)));
typedef long i64x2 __attribute__((ext_vector_type(2)));
typedef int i32x4 __attribute__((ext_vector_type(4)));
typedef int i32x8 __attribute__((ext_vector_type(8)));
constexpr int BM = 256, BK = 64, HALF = 128, HTB = HALF * BK * 2, STAGE_BYTES = 8 * HTB, NXCD = 8, WGM = 8;
__host__ __device__ __forceinline__ int lds_byte(int r, int c) { const int st = (r >> 4) * 2 + (c >> 5), rr = r & 15, cc = c & 31, ob = rr * 64 + cc * 2; return st * 1024 + (ob ^ (((ob >> 9) & 1) << 5)); }
__host__ __device__ __forceinline__ void stage_rc(int b, int& R, int& C) { const int st = b / 1024, sb = b % 1024, swz = sb ^ (((sb >> 9) & 1) << 5); R = (st >> 1) * 16 + swz / 64; C = (st & 1) * 32 + (swz % 64) / 2; }
__host__ __device__ __forceinline__ int perm32(int rho) { const int n = rho >> 4, i = rho & 15; return 8 * (i >> 2) + 4 * n + (i & 3); }
struct Unit { int pm, pn; };
struct Gemm { const bf16* A; const bf16* Bt; int M, N, K; };
struct StaticOrder {
    int nM, nN, nwg, G, c;
    __host__ __device__ void init(int M, int N, int G_, int c_) { nM = M / BM; nN = N / BM; nwg = nM * nN; G = G_; c = c_; }
    __host__ __device__ bool next(int i, Unit& u) const {
        const long L = (long)i * G + c; if (L >= nwg) return false;
        int wgid = (int)L; { const int q = nwg / NXCD, r = nwg % NXCD, xcd = wgid % NXCD, off = wgid / NXCD; wgid = (xcd < r ? xcd * (q + 1) : r * (q + 1) + (xcd - r) * q) + off; }
        const int nig = WGM * nN, gid = wgid / nig, fm = gid * WGM, gsz = (nM - fm) < WGM ? (nM - fm) : WGM;
        u.pm = fm + ((wgid % nig) % gsz); u.pn = (wgid % nig) / gsz; return true;
    }
    __device__ __forceinline__ void a_ready(const Unit&) const {}
    __device__ __forceinline__ void done(const Unit&) const {}
};
struct MoeOrder {
    int nwg, nN, G, c;
    __device__ void init(int ntile, int nN_, int G_, int c_) { nN = nN_; nwg = ntile * nN_; G = G_; c = c_; }
    __device__ bool next(int i, Unit& u) const { const long L = (long)i * G + c; if (L >= nwg) return false; u.pm = (int)L / nN; u.pn = (int)L % nN; return true; }
    __device__ __forceinline__ void a_ready(const Unit&) const {}
    __device__ __forceinline__ void done(const Unit&) const {}
};
__device__ __forceinline__ unsigned cvt_pk_bf16(float lo, float hi) { unsigned r; asm volatile("v_cvt_pk_bf16_f32 %0, %1, %2" : "=v"(r) : "v"(lo), "v"(hi)); return r; }

template <class Epi, class Sched, bool ALIGN_EPI, bool GATHER, bool EXPERT, bool FP8 = false>
__device__ __forceinline__ void gemm_phase(LAS unsigned char* lds, const Gemm g, const Sched& S, const Epi& E, const int* rowmap, const int* texp, size_t bstride) {
    int tid_ = threadIdx.x; asm volatile("" : "+v"(tid_));
    const int tid = tid_, wid = __builtin_amdgcn_readfirstlane(tid >> 6), lane = tid & 63, wr = wid >> 2, wc = wid & 3, fr = lane & 15, fq = lane >> 4;
    const int K = g.K, nt = K / BK;
    unsigned voffA[2], voffB[2], voffB1[2]; int RA[2]; unsigned CAb[2];
#pragma unroll
    for (int i = 0; i < 2; ++i) { int R, C; stage_rc(tid * 16 + i * 8192, R, C); const int Rb = Epi::PERM ? ((R & ~31) + perm32(R & 31)) : R;
        voffA[i] = (unsigned)(R * K + C) * 2u; voffB[i] = (unsigned)(Rb * K + C) * 2u; voffB1[i] = voffB[i] + (unsigned)(HALF * K * 2); RA[i] = R; CAb[i] = (unsigned)C * 2u;
        if constexpr (Epi::WIDE) {
            voffB[i] = (unsigned)((64 * (R >> 5) + perm32(R & 31)) * K + C) * 2u; voffB1[i] = (unsigned)((64 * (R >> 5) + 32 + perm32(R & 31)) * K + C) * 2u; } }
    const size_t kstep = (size_t)(BK * 2);
    const size_t hstep = (size_t)HALF * K * 2;
    const size_t tstep = 2 * hstep;
    const size_t ahs = GATHER ? 0 : hstep;
    const unsigned ldsw = (unsigned)wid * 1024u;
    const int aoff = lds_byte(wr * 64 + fr, fq * 8), boff = lds_byte(wc * 32 + fr, fq * 8);
#define PG8_SA(b, h) (((b) * 2 + (h)) * HTB)
#define PG8_SB(b, h) ((4 + (b) * 2 + (h)) * HTB)
#define PG8_STAGE(bufoff, gbase, voff) do { _Pragma("unroll") for (int _i = 0; _i < 2; ++_i) { unsigned _v = (voff)[_i]; const char* _g = (const char*)(gbase); asm volatile("" : "+v"(_v), "+s"(_g));     \
        __builtin_amdgcn_global_load_lds((const unsigned*)(_g + _v), (LAS unsigned*)(lds + (bufoff) + ldsw + _i * 8192), 16, 0, 0); } } while (0)
#define PG8_LDA(dst, b, h) do { _Pragma("unroll") for (int m = 0; m < 4; ++m) _Pragma("unroll") for (int k = 0; k < 2; ++k) dst[m][k] = *(const LAS bf16x8*)(lds + PG8_SA(b, h) + aoff + m * 2048 + k * 1024); } while (0)
#define PG8_LDB(dst, b, h) do { _Pragma("unroll") for (int n = 0; n < 2; ++n) _Pragma("unroll") for (int k = 0; k < 2; ++k) dst[n][k] = *(const LAS bf16x8*)(lds + PG8_SB(b, h) + boff + n * 2048 + k * 1024); } while (0)
#define PG8_MMA(ai, bj, At, Bt) do { __builtin_amdgcn_s_setprio(1); if constexpr (FP8 && FP8_X128) asm volatile("s_nop 1"); _Pragma("unroll") for (int m = 0; m < 4; ++m) _Pragma("unroll") for (int n = 0; n < 2; ++n) _Pragma("unroll") for (int k = 0; k < 2; ++k) { \
        if constexpr (FP8 && FP8_X128) { if (k == 0) {     \
            const i32x8 b_ = __builtin_shufflevector(__builtin_bit_cast(i32x4, Bt[n][0]), __builtin_bit_cast(i32x4, Bt[n][1]), 0, 1, 2, 3, 4, 5, 6, 7), a_ = __builtin_shufflevector(__builtin_bit_cast(i32x4, At[m][0]), __builtin_bit_cast(i32x4, At[m][1]), 0, 1, 2, 3, 4, 5, 6, 7); \
            asm volatile("v_mfma_f32_16x16x128_f8f6f4 %0, %1, %2, %0" : "+v"(acc[ai][bj][m][n]) : "v"(b_), "v"(a_)); } }     \
        else if constexpr (FP8) { const i64x2 b_ = __builtin_bit_cast(i64x2, Bt[n][k]), a_ = __builtin_bit_cast(i64x2, At[m][k]);     \
            acc[ai][bj][m][n] = __builtin_amdgcn_mfma_f32_16x16x32_fp8_fp8(b_[0], a_[0], acc[ai][bj][m][n], 0, 0, 0); acc[ai][bj][m][n] = __builtin_amdgcn_mfma_f32_16x16x32_fp8_fp8(b_[1], a_[1], acc[ai][bj][m][n], 0, 0, 0); } \
        else acc[ai][bj][m][n] = __builtin_amdgcn_mfma_f32_16x16x32_bf16(Bt[n][k], At[m][k], acc[ai][bj][m][n], 0, 0, 0); } __builtin_amdgcn_s_setprio(0); } while (0)
#define PG8_WAIT_V(n) asm volatile("s_waitcnt vmcnt(" #n ")" ::: "memory")
#define PG8_WAIT_L(n) asm volatile("s_waitcnt lgkmcnt(" #n ")" ::: "memory")
#define PG8_BAR __builtin_amdgcn_s_barrier()
#define PG8_SCHED __builtin_amdgcn_sched_barrier(0)
#define PG8_ROWS(u, v) do { _Pragma("unroll") for (int _h = 0; _h < 2; ++_h) _Pragma("unroll") for (int _i = 0; _i < 2; ++_i) { int _r = rowmap[(u).pm * BM + _h * HALF + RA[_i]]; _r = _r < 0 ? 0 : _r; \
        v[_h][_i] = (unsigned)_r * (unsigned)(K * 2) + CAb[_i]; } } while (0)
#define PG8_BPTR(u) ((const char*)g.Bt + (EXPERT ? (size_t)texp[(u).pm] * bstride : (size_t)0) + (size_t)(u).pn * tstep)
#define PG8_APTR(u) ((const char*)g.A + (GATHER ? (size_t)0 : (size_t)(u).pm * tstep))
    Unit cur, nxt; int ui = 0;
    if (!S.next(0, cur)) return;
    f32x4 acc[2][2][4][2];
#pragma unroll
    for (int a = 0; a < 2; ++a)
#pragma unroll
        for (int b = 0; b < 2; ++b)
#pragma unroll
            for (int m = 0; m < 4; ++m)
#pragma unroll
                for (int n = 0; n < 2; ++n) acc[a][b][m][n] = (f32x4){0.f, 0.f, 0.f, 0.f};
    bf16x8 At[4][2], B0[2][2], B1[2][2];
    unsigned cv[2][2], nv[2][2];
    if constexpr (GATHER) { PG8_ROWS(cur, cv); } else { cv[0][0] = voffA[0]; cv[0][1] = voffA[1]; cv[1][0] = voffA[0]; cv[1][1] = voffA[1]; }
#pragma unroll
    for (int h = 0; h < 2; ++h) { nv[h][0] = cv[h][0]; nv[h][1] = cv[h][1]; }
    const char* cA = PG8_APTR(cur); const char* cB = PG8_BPTR(cur);
    S.a_ready(cur);
    PG8_STAGE(PG8_SB(0, 0), cB, voffB); PG8_STAGE(PG8_SB(0, 1), cB, voffB1); PG8_STAGE(PG8_SA(0, 0), cA, cv[0]); PG8_STAGE(PG8_SA(0, 1), cA + ahs, cv[1]);
    if (wr == 1) PG8_BAR;
    PG8_WAIT_V(2); PG8_BAR;
    PG8_STAGE(PG8_SB(1, 0), cB + kstep, voffB); PG8_STAGE(PG8_SA(1, 0), cA + kstep, cv[0]); PG8_STAGE(PG8_SB(1, 1), cB + kstep, voffB1);
    PG8_WAIT_V(6); PG8_BAR;
    for (;;) {
        const bool has_next = S.next(ui + 1, nxt);
        const char* nA = has_next ? PG8_APTR(nxt) : cA; const char* nB = has_next ? PG8_BPTR(nxt) : cB;
        if constexpr (GATHER) { if (has_next) { PG8_ROWS(nxt, nv); } }
        for (int t = 0; t < nt; t += 2) {
            const bool last = (t == nt - 2);
            const char* a1 = cA + (size_t)(t + 1) * kstep;
            const char* a2 = last ? nA : cA + (size_t)(t + 2) * kstep; const char* b2 = last ? nB : cB + (size_t)(t + 2) * kstep;
            const char* a3 = a2 + kstep; const char* b3 = b2 + kstep;
            unsigned s0[2], s1[2];
            s0[0] = last ? nv[0][0] : cv[0][0]; s0[1] = last ? nv[0][1] : cv[0][1]; s1[0] = last ? nv[1][0] : cv[1][0]; s1[1] = last ? nv[1][1] : cv[1][1];
            if (last && has_next) S.a_ready(nxt);
            PG8_LDB(B0, 0, 0); PG8_LDB(B1, 0, 1); PG8_SCHED; PG8_LDA(At, 0, 0); PG8_STAGE(PG8_SA(1, 1), a1 + ahs, cv[1]);
            PG8_WAIT_V(8); PG8_WAIT_L(0); PG8_BAR; PG8_MMA(0, 0, At, B0); PG8_MMA(0, 1, At, B1); PG8_BAR; PG8_SCHED;
            PG8_LDA(At, 0, 1); PG8_STAGE(PG8_SB(0, 0), b2, voffB); PG8_STAGE(PG8_SB(0, 1), b2, voffB1); PG8_STAGE(PG8_SA(0, 0), a2, s0);
            PG8_WAIT_V(8); PG8_WAIT_L(0); PG8_BAR; PG8_MMA(1, 0, At, B0); PG8_MMA(1, 1, At, B1); PG8_BAR; PG8_SCHED;
            PG8_LDB(B0, 1, 0); PG8_LDB(B1, 1, 1); PG8_SCHED; PG8_LDA(At, 1, 0); PG8_STAGE(PG8_SA(0, 1), a2 + ahs, s1);
            PG8_WAIT_V(8); PG8_WAIT_L(0); PG8_BAR; PG8_MMA(0, 0, At, B0); PG8_MMA(0, 1, At, B1); PG8_BAR; PG8_SCHED;
            PG8_LDA(At, 1, 1); PG8_STAGE(PG8_SB(1, 0), b3, voffB); PG8_STAGE(PG8_SB(1, 1), b3, voffB1); PG8_STAGE(PG8_SA(1, 0), a3, s0);
            PG8_WAIT_V(8); PG8_WAIT_L(0); PG8_BAR; PG8_MMA(1, 0, At, B0); PG8_MMA(1, 1, At, B1); PG8_BAR; PG8_SCHED;
        }
        if constexpr (FP8 && FP8_X128) { asm volatile("s_nop 15\n\ts_nop 7" ::: "memory"); PG8_SCHED; }
        if constexpr (ALIGN_EPI) { if (wr == 0) PG8_BAR; }
        { int ln_ = threadIdx.x; asm volatile("" : "+v"(ln_));
          E(acc, cur, wr, wc, ln_ & 15, (ln_ & 63) >> 4); } S.done(cur);
        if (!has_next) break;
#pragma unroll
        for (int a = 0; a < 2; ++a)
#pragma unroll
            for (int b = 0; b < 2; ++b)
#pragma unroll
                for (int m = 0; m < 4; ++m)
#pragma unroll
                    for (int n = 0; n < 2; ++n) acc[a][b][m][n] = (f32x4){0.f, 0.f, 0.f, 0.f};
        cur = nxt; cA = nA; cB = nB; ++ui;
#pragma unroll
        for (int h = 0; h < 2; ++h) { cv[h][0] = nv[h][0]; cv[h][1] = nv[h][1]; }
        if constexpr (ALIGN_EPI) { if (wr == 1) PG8_BAR; }
    }
    PG8_WAIT_V(0);
    if constexpr (!ALIGN_EPI) { if (wr == 0) PG8_BAR; }
    PG8_BAR;
#undef PG8_SA
#undef PG8_SB
#undef PG8_STAGE
#undef PG8_LDA
#undef PG8_LDB
#undef PG8_MMA
#undef PG8_WAIT_V
#undef PG8_WAIT_L
#undef PG8_BAR
#undef PG8_SCHED
#undef PG8_ROWS
#undef PG8_BPTR
#undef PG8_APTR
}

struct EpiInProjF {
    static constexpr bool PERM = true, WIDE = true;
    unsigned char* ws; const float* dt_bias; const float* gate_bias; int pm_mask; float ds; int pn_off;
    __device__ __forceinline__ void operator()(const f32x4 (&acc)[2][2][4][2], const Unit& u, int wr, int wc, int fr, int fq) const {
        const int pn = u.pn + pn_off, row0 = (u.pm & pm_mask) * BM + wr * 64 + fr, c8 = wc * 64 + 8 * fq;
        if (pn < 46) {
            constexpr int T_GATE = GATE_FP8 ? TQ_GATE : 38, T_Z = GATE_FP8 ? TQ_Z : 18, T_XBC = GATE_FP8 ? TQ_XBC : 26;
            bf16* base; int ldc, ct; const bool gate = pn >= T_GATE && pn < T_GATE + 8;
            if (pn < 6) { base = (bf16*)(ws + WS_Q); ldc = AW; ct = pn * 256; }
            else if (pn < 12) { base = (bf16*)(ws + WS_K); ldc = AW; ct = (pn - 6) * 256; }
            else if (pn < 18) { base = (bf16*)(ws + WS_V); ldc = AW; ct = (pn - 12) * 256; }
            else if (gate) { base = (bf16*)(ws + WS_GATE); ldc = 2048; ct = (pn - T_GATE) * 256; }
            else if (pn >= T_Z && pn < T_Z + 8) { base = (bf16*)(ws + WS_Z); ldc = DI; ct = (pn - T_Z) * 256; }
            else { base = (bf16*)(ws + WS_XBC); ldc = CONVD; ct = (pn - T_XBC) * 256; }
#if QKV_STORE_FP8
            if (pn < 18) {
                unsigned char* qb8 = ws + (pn < 6 ? WS_Q : (pn < 12 ? WS_K : WS_V));
#pragma unroll
                for (int ai = 0; ai < 2; ++ai)
#pragma unroll
                    for (int m = 0; m < 4; ++m) { unsigned char* rowp = qb8 + (size_t)(row0 + ai * HALF + m * 16) * AW + ct + c8;
#pragma unroll
                        for (int bj = 0; bj < 2; ++bj) { const f32x4 v0 = acc[ai][bj][m][0] * (ds * FP8_ASCALE), v1 = acc[ai][bj][m][1] * (ds * FP8_ASCALE);
                            u32x2 w; w.x = pk_fp8x4(v0.x, v0.y, v0.z, v0.w); w.y = pk_fp8x4(v1.x, v1.y, v1.z, v1.w);
                            __builtin_nontemporal_store(w, (u32x2*)(rowp + bj * 32)); } }
                return;
            }
#endif
            f32x4 gb[2][2];
#pragma unroll
            for (int bj = 0; bj < 2; ++bj)
#pragma unroll
                for (int n = 0; n < 2; ++n) gb[bj][n] = gate ? *(const f32x4*)(gate_bias + ct + c8 + bj * 32 + 4 * n) : (f32x4){0.f, 0.f, 0.f, 0.f};
            const int hi8 = fr >> 3;
#pragma unroll
            for (int ai = 0; ai < 2; ++ai)
#pragma unroll
                for (int m = 0; m < 4; ++m) { bf16* rowp = base + (size_t)(row0 - fr + (fr & 7) + ai * HALF + m * 16) * ldc + ct + wc * 64 + 32 * hi8 + 8 * fq;
                    u32x4 w[2];
#pragma unroll
                    for (int bj = 0; bj < 2; ++bj) { f32x4 v0 = acc[ai][bj][m][0] * ds, v1 = acc[ai][bj][m][1] * ds;
                        if (gate) { v0 = v0 + gb[bj][0]; v1 = v1 + gb[bj][1];
                            v0 = (f32x4){sigmoidf_(v0.x), sigmoidf_(v0.y), sigmoidf_(v0.z), sigmoidf_(v0.w)}; v1 = (f32x4){sigmoidf_(v1.x), sigmoidf_(v1.y), sigmoidf_(v1.z), sigmoidf_(v1.w)}; }
                        w[bj].x = cvt_pk_bf16(v0.x, v0.y); w[bj].y = cvt_pk_bf16(v0.z, v0.w); w[bj].z = cvt_pk_bf16(v1.x, v1.y); w[bj].w = cvt_pk_bf16(v1.z, v1.w); }
                    const u32x4 snd = hi8 ? w[0] : w[1]; u32x4 rcv;
                    rcv.x = (unsigned)__builtin_amdgcn_update_dpp(0, (int)snd.x, 0x128, 0xf, 0xf, false); rcv.y = (unsigned)__builtin_amdgcn_update_dpp(0, (int)snd.y, 0x128, 0xf, 0xf, false);
                    rcv.z = (unsigned)__builtin_amdgcn_update_dpp(0, (int)snd.z, 0x128, 0xf, 0xf, false); rcv.w = (unsigned)__builtin_amdgcn_update_dpp(0, (int)snd.w, 0x128, 0xf, 0xf, false);
                    const u32x4 p0 = hi8 ? rcv : w[0], p1 = hi8 ? w[1] : rcv;
                    __builtin_nontemporal_store(p0, (u32x4*)rowp); __builtin_nontemporal_store(p1, (u32x4*)(rowp + (size_t)8 * ldc)); }
        } else if (wc == 0) {
            const f32x4 b0 = *(const f32x4*)(dt_bias + c8), b1 = *(const f32x4*)(dt_bias + c8 + 4);
#pragma unroll
            for (int ai = 0; ai < 2; ++ai)
#pragma unroll
                for (int m = 0; m < 4; ++m) { float* dp = (float*)(ws + WS_DT) + (size_t)c8 * T + (row0 + ai * HALF + m * 16);
                    const f32x4 v0 = acc[ai][0][m][0] * ds + b0, v1 = acc[ai][0][m][1] * ds + b1;
                    dp[0] = softplusf_(v0.x); dp[(size_t)T] = softplusf_(v0.y); dp[(size_t)2 * T] = softplusf_(v0.z); dp[(size_t)3 * T] = softplusf_(v0.w);
                    dp[(size_t)4 * T] = softplusf_(v1.x); dp[(size_t)5 * T] = softplusf_(v1.y); dp[(size_t)6 * T] = softplusf_(v1.z); dp[(size_t)7 * T] = softplusf_(v1.w); }
        }
    }
};
struct EpiNullF {
    static constexpr bool PERM = true, WIDE = false;
    __device__ __forceinline__ void operator()(const f32x4 (&acc)[2][2][4][2], const Unit&, int, int, int, int) const {
#pragma unroll
        for (int ai = 0; ai < 2; ++ai)
#pragma unroll
            for (int m = 0; m < 4; ++m)
#pragma unroll
                for (int bj = 0; bj < 2; ++bj)
#pragma unroll
                    for (int n = 0; n < 2; ++n) asm volatile("" :: "v"(acc[ai][bj][m][n]));
    }
};
struct EpiM0F {
    static constexpr bool PERM = true, WIDE = false;
    unsigned char* ws;
    __device__ __forceinline__ void operator()(const f32x4 (&acc)[2][2][4][2], const Unit& u, int wr, int wc, int fr, int fq) const {
        const int row0 = u.pm * BM + wr * 64 + fr, col0 = u.pn * BM + wc * 32 + 8 * fq;
#pragma unroll
        for (int ai = 0; ai < 2; ++ai)
#pragma unroll
            for (int m = 0; m < 4; ++m) { const size_t r = (size_t)(row0 + ai * HALF + m * 16);
#pragma unroll
                for (int bj = 0; bj < 2; ++bj) { const int c = col0 + bj * HALF;
                    const u32x4 gg = *(const u32x4*)((const bf16*)(ws + WS_GATE) + r * 2048 + c);
                    const f32x4 v0 = acc[ai][bj][m][0], v1 = acc[ai][bj][m][1];
                    u32x4 w; w.x = cvt_pk_bf16(v0.x * bflo(gg.x), v0.y * bfhi(gg.x)); w.y = cvt_pk_bf16(v0.z * bflo(gg.y), v0.w * bfhi(gg.y));
                    w.z = cvt_pk_bf16(v1.x * bflo(gg.z), v1.y * bfhi(gg.z)); w.w = cvt_pk_bf16(v1.z * bflo(gg.w), v1.w * bfhi(gg.w));
                    *(u32x4*)((bf16*)(ws + WS_M0) + r * D + c) = w; } }
    }
};
struct EpiMergedF {
    static constexpr bool PERM = true, WIDE = false;
    unsigned char* ws;
    __device__ __forceinline__ void operator()(const f32x4 (&acc)[2][2][4][2], const Unit& u, int wr, int wc, int fr, int fq) const {
        const int row0 = u.pm * BM + wr * 64 + fr, col0 = u.pn * BM + wc * 32 + 8 * fq;
#pragma unroll
        for (int ai = 0; ai < 2; ++ai)
#pragma unroll
            for (int m = 0; m < 4; ++m) { const size_t r = (size_t)(row0 + ai * HALF + m * 16);
#pragma unroll
                for (int bj = 0; bj < 2; ++bj) { const int c = col0 + bj * HALF;
                    const u32x4 gg = *(const u32x4*)((const bf16*)(ws + WS_GATE) + r * 2048 + 1024 + c);
                    const u32x4 mm = *(const u32x4*)((const bf16*)(ws + WS_M0) + r * D + c);
                    const f32x4 m0 = (f32x4){bflo(mm.x), bfhi(mm.x), bflo(mm.y), bfhi(mm.y)}, m1 = (f32x4){bflo(mm.z), bfhi(mm.z), bflo(mm.w), bfhi(mm.w)};
                    const f32x4 v0 = acc[ai][bj][m][0], v1 = acc[ai][bj][m][1];
                    u32x4 w; w.x = cvt_pk_bf16(m0.x + v0.x * bflo(gg.x), m0.y + v0.y * bfhi(gg.x)); w.y = cvt_pk_bf16(m0.z + v0.z * bflo(gg.y), m0.w + v0.w * bfhi(gg.y));
                    w.z = cvt_pk_bf16(m1.x + v1.x * bflo(gg.z), m1.y + v1.y * bfhi(gg.z)); w.w = cvt_pk_bf16(m1.z + v1.z * bflo(gg.w), m1.w + v1.w * bfhi(gg.w));
                    *(u32x4*)((bf16*)(ws + WS_MERGED) + r * D + c) = w; } }
    }
};
struct EpiX1F {
    static constexpr bool PERM = false, WIDE = false;
    const float* x; float* out;
    __device__ __forceinline__ void operator()(const f32x4 (&acc)[2][2][4][2], const Unit& u, int wr, int wc, int fr, int fq) const {
        const int row0 = u.pm * BM + wr * 64 + fr, col0 = u.pn * BM + wc * 32 + 4 * fq;
#pragma unroll
        for (int ai = 0; ai < 2; ++ai)
#pragma unroll
            for (int m = 0; m < 4; ++m) { const size_t r = (size_t)(row0 + ai * HALF + m * 16);
#pragma unroll
                for (int bj = 0; bj < 2; ++bj)
#pragma unroll
                    for (int n = 0; n < 2; ++n) { const int c = col0 + bj * HALF + n * 16;
                        *(f32x4*)(out + r * D + c) = *(const f32x4*)(x + r * D + c) + acc[ai][bj][m][n]; } }
    }
};
struct EpiMoe1F {
    static constexpr bool PERM = true, WIDE = false;
    unsigned char* ws; const float* b1; const int* texp;
    __device__ __forceinline__ void operator()(const f32x4 (&acc)[2][2][4][2], const Unit& u, int wr, int wc, int fr, int fq) const {
        const int e = texp[u.pm];
        const int row0 = u.pm * BM + wr * 64 + fr, col0 = u.pn * BM + wc * 32 + 8 * fq;
        f32x4 bv[2][2];
#pragma unroll
        for (int bj = 0; bj < 2; ++bj)
#pragma unroll
            for (int n = 0; n < 2; ++n) bv[bj][n] = *(const f32x4*)(b1 + (size_t)e * 2048 + col0 + bj * HALF + 4 * n);
#pragma unroll
        for (int ai = 0; ai < 2; ++ai)
#pragma unroll
            for (int m = 0; m < 4; ++m) { const size_t r = (size_t)(row0 + ai * HALF + m * 16);
#pragma unroll
                for (int bj = 0; bj < 2; ++bj) { const f32x4 v0 = acc[ai][bj][m][0] + bv[bj][0], v1 = acc[ai][bj][m][1] + bv[bj][1];
                    u32x2 w; w.x = cvt_pk_bf16(swiglu_(v0.x, v0.y), swiglu_(v0.z, v0.w)); w.y = cvt_pk_bf16(swiglu_(v1.x, v1.y), swiglu_(v1.z, v1.w));
                    __builtin_nontemporal_store(w, (u32x2*)((bf16*)(ws + WS_ACT) + r * 1024 + ((col0 + bj * HALF) >> 1))); } }
    }
};
struct EpiMoe1Q {
    static constexpr bool PERM = true, WIDE = false;
    unsigned char* ws; const float* b1; const int* texp;
    __device__ __forceinline__ void operator()(const f32x4 (&acc)[2][2][4][2], const Unit& u, int wr, int wc, int fr, int fq) const {
        const int e = texp[u.pm];
        const int row0 = u.pm * BM + wr * 64 + fr, col0 = u.pn * BM + wc * 32 + 8 * fq;
        constexpr float DS = 1.f / (FP8_ASCALE * FP8_WSCALE);
        f32x4 bv[2][2];
#pragma unroll
        for (int bj = 0; bj < 2; ++bj)
#pragma unroll
            for (int n = 0; n < 2; ++n) bv[bj][n] = *(const f32x4*)(b1 + (size_t)e * 2048 + col0 + bj * HALF + 4 * n);
#pragma unroll
        for (int ai = 0; ai < 2; ++ai)
#pragma unroll
            for (int m = 0; m < 4; ++m) { const size_t r = (size_t)(row0 + ai * HALF + m * 16);
#pragma unroll
                for (int bj = 0; bj < 2; ++bj) { const f32x4 v0 = acc[ai][bj][m][0] * DS + bv[bj][0], v1 = acc[ai][bj][m][1] * DS + bv[bj][1];
                    const unsigned w = pk_fp8x4(FP8_ASCALE * swiglu_(v0.x, v0.y), FP8_ASCALE * swiglu_(v0.z, v0.w), FP8_ASCALE * swiglu_(v1.x, v1.y), FP8_ASCALE * swiglu_(v1.z, v1.w));
                    __builtin_nontemporal_store(w, (unsigned*)(ws + WS_ACT + r * 1024 + ((col0 + bj * HALF) >> 1))); } }
    }
};
struct EpiMoe2Q {
    static constexpr bool PERM = true, WIDE = false;
    unsigned char* ws; const float* b2; const int* texp;
    __device__ __forceinline__ void operator()(const f32x4 (&acc)[2][2][4][2], const Unit& u, int wr, int wc, int fr, int fq) const {
        const int e = texp[u.pm];
        const int row0 = u.pm * BM + wr * 64 + fr, col0 = u.pn * BM + wc * 32 + 8 * fq;
        constexpr float DS = 1.f / (FP8_ASCALE * FP8_WSCALE);
        f32x4 bv[2][2];
#pragma unroll
        for (int bj = 0; bj < 2; ++bj)
#pragma unroll
            for (int n = 0; n < 2; ++n) bv[bj][n] = *(const f32x4*)(b2 + (size_t)e * 1024 + col0 + bj * HALF + 4 * n);
#pragma unroll
        for (int ai = 0; ai < 2; ++ai)
#pragma unroll
            for (int m = 0; m < 4; ++m) { const size_t r = (size_t)(row0 + ai * HALF + m * 16);
#pragma unroll
                for (int bj = 0; bj < 2; ++bj) { const f32x4 v0 = acc[ai][bj][m][0] * DS + bv[bj][0], v1 = acc[ai][bj][m][1] * DS + bv[bj][1];
                    u32x4 w; w.x = cvt_pk_bf16(v0.x, v0.y); w.y = cvt_pk_bf16(v0.z, v0.w); w.z = cvt_pk_bf16(v1.x, v1.y); w.w = cvt_pk_bf16(v1.z, v1.w);
                    __builtin_nontemporal_store(w, (u32x4*)((bf16*)(ws + WS_YB) + r * 1024 + col0 + bj * HALF)); } }
    }
};
struct EpiMoe2F {
    static constexpr bool PERM = true, WIDE = false;
    unsigned char* ws; const float* b2; const int* texp;
    __device__ __forceinline__ void operator()(const f32x4 (&acc)[2][2][4][2], const Unit& u, int wr, int wc, int fr, int fq) const {
        const int e = texp[u.pm];
        const int row0 = u.pm * BM + wr * 64 + fr, col0 = u.pn * BM + wc * 32 + 8 * fq;
        f32x4 bv[2][2];
#pragma unroll
        for (int bj = 0; bj < 2; ++bj)
#pragma unroll
            for (int n = 0; n < 2; ++n) bv[bj][n] = *(const f32x4*)(b2 + (size_t)e * 1024 + col0 + bj * HALF + 4 * n);
#pragma unroll
        for (int ai = 0; ai < 2; ++ai)
#pragma unroll
            for (int m = 0; m < 4; ++m) { const size_t r = (size_t)(row0 + ai * HALF + m * 16);
#pragma unroll
                for (int bj = 0; bj < 2; ++bj) { const f32x4 v0 = acc[ai][bj][m][0] + bv[bj][0], v1 = acc[ai][bj][m][1] + bv[bj][1];
                    u32x4 w; w.x = cvt_pk_bf16(v0.x, v0.y); w.y = cvt_pk_bf16(v0.z, v0.w); w.z = cvt_pk_bf16(v1.x, v1.y); w.w = cvt_pk_bf16(v1.z, v1.w);
                    __builtin_nontemporal_store(w, (u32x4*)((bf16*)(ws + WS_YB) + r * 1024 + col0 + bj * HALF)); } }
    }
};
}

__device__ __forceinline__ int t5_bucket_dev(int dist) {
    if (dist < 16) return dist;
    int l = 16 + (int)(logf((float)dist / 16.f) / logf(128.f) * 16.f);
    return l < 31 ? l : 31;
}
__device__ __forceinline__ void transpose_item(const float* W, int K, int N, bf16* WT, int k0, int n0, int drow0, LAS float* scr, int lane) {
#pragma unroll 8
    for (int i = 0; i < 32; ++i) { const int kk = 2 * i + (lane >> 5); scr[kk * 33 + (lane & 31)] = __builtin_nontemporal_load(W + (size_t)(k0 + kk) * N + n0 + (lane & 31)); }
    asm volatile("s_waitcnt lgkmcnt(0)" ::: "memory");
    const int c = lane & 7;
#pragma unroll
    for (int j = 0; j < 4; ++j) { const int n = (lane >> 3) + 8 * j; const LAS float* s = scr + (8 * c) * 33 + n;
        u32x4 o; o.x = pk2(s[0 * 33], s[1 * 33]); o.y = pk2(s[2 * 33], s[3 * 33]); o.z = pk2(s[4 * 33], s[5 * 33]); o.w = pk2(s[6 * 33], s[7 * 33]);
        *(u32x4*)(WT + (size_t)(drow0 + n) * K + k0 + 8 * c) = o; }
    asm volatile("s_waitcnt lgkmcnt(0)" ::: "memory");
}
__device__ __forceinline__ void transpose_item_fp8(const float* W, int K, int N, unsigned char* WT, int k0, int n0, int drow0, float scale, LAS float* scr, int lane) {
#pragma unroll 8
    for (int i = 0; i < 64; ++i) { const int kk = 2 * i + (lane >> 5); scr[kk * 33 + (lane & 31)] = __builtin_nontemporal_load(W + (size_t)(k0 + kk) * N + n0 + (lane & 31)) * scale; }
    asm volatile("s_waitcnt lgkmcnt(0)" ::: "memory");
    const int c = lane & 7;
#pragma unroll
    for (int j = 0; j < 4; ++j) { const int n = (lane >> 3) + 8 * j; const LAS float* s = scr + (16 * c) * 33 + n;
        u32x4 o; o.x = pk_fp8x4(s[0 * 33], s[1 * 33], s[2 * 33], s[3 * 33]); o.y = pk_fp8x4(s[4 * 33], s[5 * 33], s[6 * 33], s[7 * 33]);
        o.z = pk_fp8x4(s[8 * 33], s[9 * 33], s[10 * 33], s[11 * 33]); o.w = pk_fp8x4(s[12 * 33], s[13 * 33], s[14 * 33], s[15 * 33]);
        *(u32x4*)(WT + (size_t)(drow0 + n) * K + k0 + 16 * c) = o; }
    asm volatile("s_waitcnt lgkmcnt(0)" ::: "memory");
}
#if GATE_FP8
__device__ __forceinline__ int inproj_row_of_col(int n0) {
    return n0 < C_Z ? n0 : (n0 < C_XBC ? n0 - C_Z + 256 * TQ_Z : (n0 < C_DT ? n0 - C_XBC + 256 * TQ_XBC : (n0 < C_GATE ? n0 - C_DT + 256 * TQ_DT : n0 - C_GATE + 256 * TQ_GATE))); }
__device__ __forceinline__ bool inproj_col_is_fp8(int n0) { return n0 < C_Z || n0 >= C_GATE; }
#else
__device__ __forceinline__ int inproj_row_of_col(int n0) { return n0 < C_DT ? n0 : (n0 < C_GATE ? n0 - C_DT + 11776 : n0 - 32); }
__device__ __forceinline__ bool inproj_col_is_fp8(int n0) { return QKV_FP8 && n0 < C_Z; }
#endif
__device__ __forceinline__ void p_convert_small(Frame& F) {
    LAS float* scr = (LAS float*)(F.lds + F.wave * 16896);
    const int gw = F.blk * NWAVES + F.wave, NGW = F.nblk * NWAVES;
    constexpr int I_INQ = 8 * (NPROJ / 32), I_IN = 16 * (NPROJ / 32), I_BA = 8 * 32, I_BS = 32 * 32, I_OUT = 16 * 32, NIT = I_INQ + I_IN + I_BA + I_BS + I_OUT;
    for (int it = gw; it < NIT; it += NGW) {
        int r = it;
        if (r < I_INQ) { const int nb = r % (NPROJ / 32), kb = r / (NPROJ / 32); if (inproj_col_is_fp8(32 * nb)) transpose_item_fp8(F.w_in, D, NPROJ, F.ws + WS_WQKVQ, 128 * kb, 32 * nb, inproj_row_of_col(32 * nb), FP8_WSCALE, scr, ((int)(threadIdx.x & 63u))); continue; } r -= I_INQ;
        if (r < I_IN) { const int nb = r % (NPROJ / 32), kb = r / (NPROJ / 32); if (!inproj_col_is_fp8(32 * nb)) transpose_item(F.w_in, D, NPROJ, (bf16*)(F.ws + WS_WIN_T), 64 * kb, 32 * nb, inproj_row_of_col(32 * nb), scr, ((int)(threadIdx.x & 63u))); continue; } r -= I_IN;
        if (r < I_BA) { const int nb = r % 32, kb = r / 32; transpose_item(F.w_ba, 512, D, (bf16*)(F.ws + WS_WBA_T), 64 * kb, 32 * nb, 32 * nb, scr, ((int)(threadIdx.x & 63u))); continue; } r -= I_BA;
        if (r < I_BS) { const int nb = r % 32, kb = r / 32; transpose_item(F.w_bs, DI, D, (bf16*)(F.ws + WS_WBS_T), 64 * kb, 32 * nb, 32 * nb, scr, ((int)(threadIdx.x & 63u))); continue; } r -= I_BS;
        { const int nb = r % 32, kb = r / 32; transpose_item(F.w_out, D, D, (bf16*)(F.ws + WS_WOUT_T), 64 * kb, 32 * nb, 32 * nb, scr, ((int)(threadIdx.x & 63u))); }
    }
    for (int i = F.blk * NTHREADS + ((int)threadIdx.x); i < 24 * 192; i += F.nblk * NTHREADS) { const int head = i / 192, dl = i % 192 - 32, g = head >> 3, dil = g == 0 ? 1 : (g == 1 ? 4 : 16);
        ((float*)(F.ws + WS_BT))[i] = F.rel_bias[t5_bucket_dev((dl < 0 ? 0 : (dl > 128 ? 128 : dl)) * dil) * 24 + head] * 1.4426950408889634f; }
    for (int i = F.blk * NTHREADS + ((int)threadIdx.x); i < 32 * 1024; i += F.nblk * NTHREADS) ((float*)(F.ws + WS_WRT))[i] = F.norm_ffn[i >> 5] * F.router_w[i];
    u32x4* z = (u32x4*)((bf16*)(F.ws + WS_WIN_T) + (size_t)11808 * D);
    for (int i = F.blk * NTHREADS + ((int)threadIdx.x); i < 224 * D * 2 / 16; i += F.nblk * NTHREADS) z[i] = (u32x4){0u, 0u, 0u, 0u};
}
__device__ __forceinline__ void p_convert_moe_fp8(Frame& F) {
    LAS float* scr = (LAS float*)(F.lds + F.wave * 16896);
    const int gw = F.blk * NWAVES + F.wave, NGW = F.nblk * NWAVES;
    constexpr int I_1 = 8 * 64, I_2 = 8 * 32, NIT = NEXP * (I_1 + I_2);
    for (int it = gw; it < NIT; it += NGW) {
        const int e = it / (I_1 + I_2); int r = it % (I_1 + I_2);
        if (r < I_1) { const int nb = r % 64, kb = r / 64; transpose_item_fp8(F.w1 + (size_t)e * 1024 * 2048, 1024, 2048, F.ws + WS_W1T + (size_t)e * 2048 * 1024, 128 * kb, 32 * nb, 32 * nb, FP8_WSCALE, scr, ((int)(threadIdx.x & 63u))); }
        else { r -= I_1; const int nb = r % 32, kb = r / 32; transpose_item_fp8(F.w2 + (size_t)e * 1024 * 1024, 1024, 1024, F.ws + WS_W2T + (size_t)e * 1024 * 1024, 128 * kb, 32 * nb, 32 * nb, FP8_WSCALE, scr, ((int)(threadIdx.x & 63u))); }
    }
}
__device__ __forceinline__ void p_convert_moe(Frame& F) {
    LAS float* scr = (LAS float*)(F.lds + F.wave * 16384);
    const int gw = F.blk * NWAVES + F.wave, NGW = F.nblk * NWAVES;
    constexpr int I_1 = 16 * 64, I_2 = 16 * 32, NIT = NEXP * (I_1 + I_2);
    for (int it = gw; it < NIT; it += NGW) {
        const int e = it / (I_1 + I_2); int r = it % (I_1 + I_2);
        if (r < I_1) { const int nb = r % 64, kb = r / 64; transpose_item(F.w1 + (size_t)e * 1024 * 2048, 1024, 2048, (bf16*)(F.ws + WS_W1T) + (size_t)e * 2048 * 1024, 64 * kb, 32 * nb, 32 * nb, scr, ((int)(threadIdx.x & 63u))); }
        else { r -= I_1; const int nb = r % 32, kb = r / 32; transpose_item(F.w2 + (size_t)e * 1024 * 1024, 1024, 1024, (bf16*)(F.ws + WS_W2T) + (size_t)e * 1024 * 1024, 64 * kb, 32 * nb, 32 * nb, scr, ((int)(threadIdx.x & 63u))); }
    }
}

__device__ __forceinline__ void p_rmsnorm_in(Frame& F) {
    const int gw = F.blk * NWAVES + F.wave, NGW = F.nblk * NWAVES;
    bf16* XN = (bf16*)(F.ws + WS_XN);
    for (int m = gw; m < T; m += NGW) {
        const f32x4* xr = (const f32x4*)(F.x + (size_t)m * D) + ((int)(threadIdx.x & 63u));
        const f32x4* wr = (const f32x4*)F.norm_mix + ((int)(threadIdx.x & 63u));
        f32x4 v[4]; float s = 0.f;
#pragma unroll
        for (int j = 0; j < 4; ++j) { v[j] = __builtin_nontemporal_load(xr + 64 * j); s += (v[j].x * v[j].x + v[j].y * v[j].y) + (v[j].z * v[j].z + v[j].w * v[j].w); }
        const float rstd = __builtin_amdgcn_rsqf(wave_sum(s) * (1.f / D) + EPS);
#pragma unroll
        for (int j = 0; j < 4; ++j) { const f32x4 w = wr[64 * j]; const f32x4 o = v[j] * rstd * w; st_bf4(XN + (size_t)m * D + (((int)(threadIdx.x & 63u)) + 64 * j) * 4, o);
#if QKV_FP8
            *(unsigned*)(F.ws + WS_XNQ + (size_t)m * D + (((int)(threadIdx.x & 63u)) + 64 * j) * 4) = pk_fp8x4(FP8_ASCALE * o.x, FP8_ASCALE * o.y, FP8_ASCALE * o.z, FP8_ASCALE * o.w);
#endif
        }
    }
}

__device__ __forceinline__ void p_attn_naive(Frame& F) {
    LAS float* btab = (LAS float*)F.lds;
    for (int i = ((int)threadIdx.x); i < 3 * 129 * 8; i += NTHREADS) {
        const int g = i / (129 * 8), j = (i >> 3) % 129, hg = i & 7;
        const int dil = g == 0 ? 1 : (g == 1 ? 4 : 16);
        btab[i] = F.rel_bias[t5_bucket_dev(j * dil) * 24 + g * 8 + hg];
    }
    __syncthreads();
    const bf16* Qb = (const bf16*)(F.ws + WS_Q); const bf16* Kb = (const bf16*)(F.ws + WS_K); const bf16* Vb = (const bf16*)(F.ws + WS_V);
    bf16* AT = (bf16*)(F.ws + WS_ATTN);
    for (int idx = F.blk * NTHREADS + ((int)threadIdx.x); idx < T * 8; idx += F.nblk * NTHREADS) {
        const int hg = idx & 7, row = idx >> 3, t = row & (SEQ - 1);
        float m = -INFINITY, den = 0.f;
        float acc[64];
#pragma unroll
        for (int i = 0; i < 64; ++i) acc[i] = 0.f;
        for (int g = 0; g < 3; ++g) {
            const int dil = g == 0 ? 1 : (g == 1 ? 4 : 16);
            const int head = g * 8 + hg;
            float q[64];
            { const u32x4* qp = (const u32x4*)(Qb + (size_t)row * AW + head * 64);
#pragma unroll
              for (int c = 0; c < 8; ++c) { const u32x4 w = qp[c]; q[8 * c + 0] = bflo(w.x); q[8 * c + 1] = bfhi(w.x); q[8 * c + 2] = bflo(w.y); q[8 * c + 3] = bfhi(w.y);
                  q[8 * c + 4] = bflo(w.z); q[8 * c + 5] = bfhi(w.z); q[8 * c + 6] = bflo(w.w); q[8 * c + 7] = bfhi(w.w); } }
            for (int j = 0; j <= 128; ++j) {
                const int kt = t - j * dil; if (kt < 0) break;
                const size_t krow = (size_t)(row - j * dil);
                const u32x4* kp = (const u32x4*)(Kb + krow * AW + head * 64);
                float s = 0.f;
#pragma unroll
                for (int c = 0; c < 8; ++c) { const u32x4 w = kp[c];
                    s += q[8 * c + 0] * bflo(w.x) + q[8 * c + 1] * bfhi(w.x) + q[8 * c + 2] * bflo(w.y) + q[8 * c + 3] * bfhi(w.y)
                       + q[8 * c + 4] * bflo(w.z) + q[8 * c + 5] * bfhi(w.z) + q[8 * c + 6] * bflo(w.w) + q[8 * c + 7] * bfhi(w.w); }
                s = s * 0.125f + btab[(g * 129 + j) * 8 + hg];
                const float mn = fmaxf(m, s), sc = __expf(m - mn), p = __expf(s - mn);
                m = mn; den = den * sc + p;
                const u32x4* vp = (const u32x4*)(Vb + krow * AW + head * 64);
#pragma unroll
                for (int c = 0; c < 8; ++c) { const u32x4 w = vp[c];
                    acc[8 * c + 0] = acc[8 * c + 0] * sc + p * bflo(w.x); acc[8 * c + 1] = acc[8 * c + 1] * sc + p * bfhi(w.x);
                    acc[8 * c + 2] = acc[8 * c + 2] * sc + p * bflo(w.y); acc[8 * c + 3] = acc[8 * c + 3] * sc + p * bfhi(w.y);
                    acc[8 * c + 4] = acc[8 * c + 4] * sc + p * bflo(w.z); acc[8 * c + 5] = acc[8 * c + 5] * sc + p * bfhi(w.z);
                    acc[8 * c + 6] = acc[8 * c + 6] * sc + p * bflo(w.w); acc[8 * c + 7] = acc[8 * c + 7] * sc + p * bfhi(w.w); }
            }
        }
        const float inv = 1.f / den;
        u32x4* op = (u32x4*)(AT + (size_t)row * 512 + hg * 64);
#pragma unroll
        for (int c = 0; c < 8; ++c) { u32x4 w; w.x = pk2(acc[8 * c] * inv, acc[8 * c + 1] * inv); w.y = pk2(acc[8 * c + 2] * inv, acc[8 * c + 3] * inv);
            w.z = pk2(acc[8 * c + 4] * inv, acc[8 * c + 5] * inv); w.w = pk2(acc[8 * c + 6] * inv, acc[8 * c + 7] * inv); op[c] = w; }
    }
    __syncthreads();
}

typedef short bf16x8_t __attribute__((ext_vector_type(8)));
typedef short s16x4_t __attribute__((ext_vector_type(4)));
typedef float f32x16 __attribute__((ext_vector_type(16)));
__device__ __forceinline__ int crow_(int reg, int h) { return (reg & 3) + 8 * (reg >> 2) + 4 * h; }
__device__ __forceinline__ s16x4_t tr_read_(const LAS unsigned char* p) { return __builtin_bit_cast(s16x4_t, __builtin_amdgcn_ds_read_tr16_b64_v4i16((LAS s16x4_t*)p)); }
constexpr int ATT_HALF_BYTES = 66560;
template <bool LOADKV = true, bool DOSTORE = true, bool DOMATH = true>
__device__ __forceinline__ void p_attn_fast(Frame& F) {
    const int half = F.wave >> 2, qb = F.wave & 3;
    const bf16* Qb = (const bf16*)(F.ws + WS_Q); const bf16* Kb = (const bf16*)(F.ws + WS_K); const bf16* Vb = (const bf16*)(F.ws + WS_V);
    bf16* OUTG = (bf16*)(F.ws + WS_OUTG); float* LSE = (float*)(F.ws + WS_LSE); const float* BT = (const float*)(F.ws + WS_BT);
    constexpr int NUNIT = BATCH * 24 * 16;
    constexpr float LOG2E = 1.4426950408889634f;
    constexpr float QKS = QKV_STORE_FP8 ? 1.f / (FP8_ASCALE * FP8_ASCALE) : 1.f, VS = QKV_STORE_FP8 ? 1.f / FP8_ASCALE : 1.f;
    const int nhw = F.nblk * 2, per = (NUNIT + nhw - 1) / nhw, u0 = (F.blk * 2 + half) * per;
#if QKV_STORE_FP8
    const unsigned char* Q8 = F.ws + WS_Q; const unsigned char* K8 = F.ws + WS_K; const unsigned char* V8 = F.ws + WS_V; (void)Qb; (void)Kb; (void)Vb;
    u32x4 kreg[2], vreg[2]; float breg = 0.f;
#else
    u32x4 kreg[4], vreg[4]; float breg = 0.f;
#endif
#define ATT_DECODE(u_) const int zn = (u_) & 15, head = ((u_) >> 4) % 24, b = (u_) / (16 * 24); const int g = head >> 3, hg = head & 7; \
        const int dil = g == 0 ? 1 : (g == 1 ? 4 : 16), nb = 16 / dil; const int z = zn / nb, n = zn % nb; const size_t rowb = (size_t)b * SEQ; (void)hg; (void)rowb; (void)z; (void)n
#if QKV_STORE_FP8
#define ATT_LOADBLK(u_, blk_) do { ATT_DECODE(u_); const int th_ = ((int)threadIdx.x) & 255; \
        _Pragma("unroll") for (int i = 0; i < 2; ++i) { const int piece = th_ + 256 * i, kw = piece >> 2, c16 = piece & 3; const int p = (blk_) * 128 + kw; \
            kreg[i] = (u32x4){0u, 0u, 0u, 0u}; vreg[i] = (u32x4){0u, 0u, 0u, 0u}; \
            if (LOADKV && (u_) < NUNIT) { const size_t row = rowb + (size_t)p * dil + z; kreg[i] = *(const u32x4*)(K8 + row * AW + head * 64 + c16 * 16); vreg[i] = *(const u32x4*)(V8 + row * AW + head * 64 + c16 * 16); } } \
        if (th_ < 192 && (u_) < NUNIT) breg = BT[head * 192 + th_]; } while (0)
#define ATT_STOREBLK(slot_) do { _Pragma("unroll") for (int i = 0; i < 2; ++i) { const int piece = th + 256 * i, kw = piece >> 2, c16 = piece & 3; const int rb_ = ((slot_) * 128 + kw) * 128; \
            *(LAS u32x4*)(Kimg + rb_ + (((2 * c16) ^ (kw & 7)) << 4)) = fp8x8_to_bf16x8(kreg[i].x, kreg[i].y); *(LAS u32x4*)(Kimg + rb_ + (((2 * c16 + 1) ^ (kw & 7)) << 4)) = fp8x8_to_bf16x8(kreg[i].z, kreg[i].w); \
            *(LAS u32x4*)(Vimg + rb_ + (((2 * c16) ^ (kw & 7)) << 4)) = fp8x8_to_bf16x8(vreg[i].x, vreg[i].y); *(LAS u32x4*)(Vimg + rb_ + (((2 * c16 + 1) ^ (kw & 7)) << 4)) = fp8x8_to_bf16x8(vreg[i].z, vreg[i].w); } } while (0)
#else
#define ATT_LOADBLK(u_, blk_) do { ATT_DECODE(u_); const int th_ = ((int)threadIdx.x) & 255; \
        _Pragma("unroll") for (int i = 0; i < 4; ++i) { const int piece = th_ + 256 * i, kw = piece >> 3, ch = piece & 7; const int p = (blk_) * 128 + kw; \
            kreg[i] = (u32x4){0u, 0u, 0u, 0u}; vreg[i] = (u32x4){0u, 0u, 0u, 0u}; \
            if (LOADKV && (u_) < NUNIT) { const size_t row = rowb + (size_t)p * dil + z; kreg[i] = *(const u32x4*)(Kb + row * AW + head * 64 + ch * 8); vreg[i] = *(const u32x4*)(Vb + row * AW + head * 64 + ch * 8); } } \
        if (th_ < 192 && (u_) < NUNIT) breg = BT[head * 192 + th_]; } while (0)
#define ATT_STOREBLK(slot_) do { _Pragma("unroll") for (int i = 0; i < 4; ++i) { const int piece = th + 256 * i, kw = piece >> 3, ch = piece & 7; const int off = ((slot_) * 128 + kw) * 128 + ((ch ^ (kw & 7)) << 4); \
            *(LAS u32x4*)(Kimg + off) = kreg[i]; *(LAS u32x4*)(Vimg + off) = vreg[i]; } } while (0)
#endif
    {
        for (int i = ((int)threadIdx.x); i < 2 * ATT_HALF_BYTES / 16; i += NTHREADS) ((LAS u32x4*)F.lds)[i] = (u32x4){0u, 0u, 0u, 0u};
        __syncthreads();
        const int th = ((int)threadIdx.x) & 255;
        LAS unsigned char* base = F.lds + half * ATT_HALF_BYTES; LAS unsigned char* Kimg = base; LAS unsigned char* Vimg = base + 32768;
        if (u0 < NUNIT) { const int n0 = (u0 & 15) % (16 / ((((u0 >> 4) % 24) >> 3) == 0 ? 1 : ((((u0 >> 4) % 24) >> 3) == 1 ? 4 : 16)));
            if (n0 > 0) { ATT_LOADBLK(u0, n0 - 1); ATT_STOREBLK((n0 - 1) & 1); } }
        ATT_LOADBLK(u0, (u0 & 15) % (16 / ((((u0 >> 4) % 24) >> 3) == 0 ? 1 : ((((u0 >> 4) % 24) >> 3) == 1 ? 4 : 16))));
    }
    for (int it = 0; it < per; ++it) {
        const int u = u0 + it;
        const bool live = u < NUNIT;
        ATT_DECODE(live ? u : 0);
        unsigned opq_ = 0; asm volatile("" : "+s"(opq_));
        int tl_ = ((int)threadIdx.x); asm volatile("" : "+v"(tl_));
        const int th = tl_ & 255, lane = tl_ & 63, r = lane & 31, h = lane >> 5;
        LAS unsigned char* base = F.lds + half * ATT_HALF_BYTES + opq_;
        LAS unsigned char* Kimg = base; LAS unsigned char* Vimg = base + 32768; LAS float* btab = (LAS float*)(base + 65536);
        const int flip = ((n - 1) & 1) << 7;
        bf16x8_t qf[4];
        { const size_t qrow = rowb + (size_t)(n * 128 + 32 * qb + r) * dil + z;
#pragma unroll
#if QKV_STORE_FP8
          for (int dd = 0; dd < 4; ++dd) { const u32x2 q8 = *(const u32x2*)(Q8 + qrow * AW + head * 64 + 16 * dd + 8 * h); qf[dd] = __builtin_bit_cast(bf16x8_t, fp8x8_to_bf16x8(q8.x, q8.y)); } }
#else
          for (int dd = 0; dd < 4; ++dd) qf[dd] = *(const bf16x8_t*)(Qb + qrow * AW + head * 64 + 16 * dd + 8 * h); }
#endif
        LDS_BARRIER();
        ATT_STOREBLK(n & 1);
        if (th < 192) btab[th] = breg;
        LDS_BARRIER();
        if (it + 1 < per) { const int un = u + 1; ATT_LOADBLK(un, ((un) & 15) % (16 / ((((un >> 4) % 24) >> 3) == 0 ? 1 : ((((un >> 4) % 24) >> 3) == 1 ? 4 : 16)))); }
        if (!live) continue;
        f32x16 sc[5];
#pragma unroll
        for (int kb = 0; kb < 5; ++kb) {
            f32x16 a = {0.f, 0.f, 0.f, 0.f, 0.f, 0.f, 0.f, 0.f, 0.f, 0.f, 0.f, 0.f, 0.f, 0.f, 0.f, 0.f};
            const int krow0 = (32 * (qb + kb) + r) ^ flip;
            if (!(n == 0 && qb + kb <= 3))
#pragma unroll
            for (int dd = 0; dd < 4; ++dd) {
                const bf16x8_t kf = *(const LAS bf16x8_t*)(Kimg + krow0 * 128 + (((2 * dd + h) ^ (r & 7)) << 4));
                a = __builtin_amdgcn_mfma_f32_32x32x16_bf16(kf, qf[dd], a, 0, 0, 0);
            }
            sc[kb] = a;
        }
        float m = -INFINITY;
        const LAS float* const bl = btab + (r - 4 * h);
#pragma unroll
        for (int kb = 0; kb < 5; ++kb)
#pragma unroll
            for (int i = 0; i < 16; ++i) {
                const int cc = (i & 3) + 8 * (i >> 2);
                const float bias = bl[160 - 32 * kb - cc];
                float s = sc[kb][i] * (0.125f * LOG2E * QKS) + bias;
                const int c = cc + 4 * h;
                if (kb == 0) s = (r <= c && n != 0) ? s : -INFINITY;
                else if (kb == 4) s = (c <= r) ? s : -INFINITY;
                else s = (n == 0 && (32 * (qb + kb) + c) < 128) ? -INFINITY : s;
                sc[kb][i] = s; m = fmaxf(m, s);
            }
        m = fmaxf(m, __shfl_xor(m, 32));
        float den = 0.f;
#pragma unroll
        for (int kb = 0; kb < 5; ++kb) {
            if (n == 0 && qb + kb <= 3) continue;
#pragma unroll
            for (int i = 0; i < 16; ++i) { const float p = __builtin_amdgcn_exp2f(sc[kb][i] - m); sc[kb][i] = p; den += p; } }
        den += __shfl_xor(den, 32);
        const float inv = VS * __builtin_amdgcn_rcpf(den);
        if (DOSTORE && h == 0) LSE[((size_t)g * T + rowb + (size_t)(n * 128 + 32 * qb + r) * dil + z) * 8 + hg] = (m + __builtin_amdgcn_logf(den)) * (1.f / LOG2E);
        f32x16 o[2];
        o[0] = (f32x16){0.f, 0.f, 0.f, 0.f, 0.f, 0.f, 0.f, 0.f, 0.f, 0.f, 0.f, 0.f, 0.f, 0.f, 0.f, 0.f}; o[1] = o[0];
        const int q4 = (lane & 15) >> 2, blk16 = (lane >> 4) & 1, p4 = lane & 3;
#pragma unroll
        for (int kb = 0; kb < 5; ++kb) {
            if (n == 0 && qb + kb <= 3) continue;
#pragma unroll
            for (int s = 0; s < 2; ++s) {
                u32x4 pw;
                pw.x = cvtpk(sc[kb][8 * s + 0] * inv, sc[kb][8 * s + 1] * inv); pw.y = cvtpk(sc[kb][8 * s + 2] * inv, sc[kb][8 * s + 3] * inv);
                pw.z = cvtpk(sc[kb][8 * s + 4] * inv, sc[kb][8 * s + 5] * inv); pw.w = cvtpk(sc[kb][8 * s + 6] * inv, sc[kb][8 * s + 7] * inv);
                const bf16x8_t pa = __builtin_bit_cast(bf16x8_t, pw);
                const int row_lo = (32 * (qb + kb) + 16 * s + 4 * h + q4) ^ flip, row_hi = row_lo + 8;
#pragma unroll
                for (int db = 0; db < 2; ++db) {
                    const int chunk = 4 * db + 2 * blk16 + (p4 >> 1), sub = (p4 & 1) * 8;
                    const s16x4_t lo = tr_read_(Vimg + row_lo * 128 + ((chunk ^ (row_lo & 7)) << 4) + sub);
                    const s16x4_t hi = tr_read_(Vimg + row_hi * 128 + ((chunk ^ (row_hi & 7)) << 4) + sub);
                    const bf16x8_t vf = (bf16x8_t){lo[0], lo[1], lo[2], lo[3], hi[0], hi[1], hi[2], hi[3]};
                    o[db] = __builtin_amdgcn_mfma_f32_32x32x16_bf16(pa, vf, o[db], 0, 0, 0);
                }
            } }
#pragma unroll
        for (int i = 0; i < 16; ++i) {
            const size_t row = rowb + (size_t)(n * 128 + 32 * qb + crow_(i, h)) * dil + z;
            bf16* op = OUTG + ((size_t)g * T + row) * 512 + hg * 64 + r;
            const unsigned w = cvtpk(o[0][i], o[1][i]);
            if (DOSTORE) { op[0] = (bf16)(w & 0xffffu); op[32] = (bf16)(w >> 16); } else asm volatile("" :: "v"(w));
        }
    }
#undef ATT_DECODE
#undef ATT_LOADBLK
#undef ATT_STOREBLK
    __syncthreads();
}
__device__ __forceinline__ void p_attn_merge(Frame& F) {
    const bf16* OUTG = (const bf16*)(F.ws + WS_OUTG); const float* LSE = (const float*)(F.ws + WS_LSE); bf16* AT = (bf16*)(F.ws + WS_ATTN);
    for (int idx = F.blk * NTHREADS + ((int)threadIdx.x); idx < T * 64; idx += F.nblk * NTHREADS) {
        const int row = idx >> 6, c8 = (idx & 63) * 8, hg = c8 >> 6;
        const float l0 = LSE[((size_t)0 * T + row) * 8 + hg], l1 = LSE[((size_t)1 * T + row) * 8 + hg], l2 = LSE[((size_t)2 * T + row) * 8 + hg];
        const float mx = fmaxf(l0, fmaxf(l1, l2)), e0 = __expf(l0 - mx), e1 = __expf(l1 - mx), e2 = __expf(l2 - mx), inv = __builtin_amdgcn_rcpf(e0 + e1 + e2);
        const float w[3] = {e0 * inv, e1 * inv, e2 * inv};
        float a[8] = {0.f, 0.f, 0.f, 0.f, 0.f, 0.f, 0.f, 0.f};
#pragma unroll
        for (int g = 0; g < 3; ++g) { const u32x4 v = *(const u32x4*)(OUTG + ((size_t)g * T + row) * 512 + c8);
            a[0] += w[g] * bflo(v.x); a[1] += w[g] * bfhi(v.x); a[2] += w[g] * bflo(v.y); a[3] += w[g] * bfhi(v.y);
            a[4] += w[g] * bflo(v.z); a[5] += w[g] * bfhi(v.z); a[6] += w[g] * bflo(v.w); a[7] += w[g] * bfhi(v.w); }
        u32x4 o; o.x = pk2(a[0], a[1]); o.y = pk2(a[2], a[3]); o.z = pk2(a[4], a[5]); o.w = pk2(a[6], a[7]);
        *(u32x4*)(AT + (size_t)row * 512 + c8) = o;
    }
}

__device__ __forceinline__ void p_conv(Frame& F) {
    const bf16* X = (const bf16*)(F.ws + WS_XBC); bf16* O = (bf16*)(F.ws + WS_CONV);
    const int total = T * (CONVD / 8);
    for (int idx = F.blk * NTHREADS + ((int)threadIdx.x); idx < total; idx += F.nblk * NTHREADS) {
        const int row = idx / (CONVD / 8), c0 = (idx % (CONVD / 8)) * 8, t = row & (SEQ - 1);
        float a[8];
#pragma unroll
        for (int i = 0; i < 8; ++i) a[i] = F.conv_b[c0 + i];
#pragma unroll
        for (int w = 0; w < 4; ++w) {
            const int tt = t + w - 3; if (tt < 0) continue;
            const u32x4 u = *(const u32x4*)(X + (size_t)(row + w - 3) * CONVD + c0);
            const float* cw = F.conv_w + (size_t)w * CONVD + c0;
            a[0] += cw[0] * bflo(u.x); a[1] += cw[1] * bfhi(u.x); a[2] += cw[2] * bflo(u.y); a[3] += cw[3] * bfhi(u.y);
            a[4] += cw[4] * bflo(u.z); a[5] += cw[5] * bfhi(u.z); a[6] += cw[6] * bflo(u.w); a[7] += cw[7] * bfhi(u.w);
        }
        u32x4 o; o.x = pk2(siluf_(a[0]), siluf_(a[1])); o.y = pk2(siluf_(a[2]), siluf_(a[3])); o.z = pk2(siluf_(a[4]), siluf_(a[5])); o.w = pk2(siluf_(a[6]), siluf_(a[7]));
        *(u32x4*)(O + (size_t)row * CONVD + c0) = o;
    }
}

__device__ __forceinline__ void p_ssd_naive(Frame& F) {
    const bf16* CV = (const bf16*)(F.ws + WS_CONV); const float* DT = (const float*)(F.ws + WS_DT); const bf16* Z = (const bf16*)(F.ws + WS_Z);
    bf16* YZ = (bf16*)(F.ws + WS_YZ);
    const int t256 = ((int)threadIdx.x) & 255, p = t256 >> 2, q = t256 & 3;
    for (int unit = F.blk * 2 + (((int)threadIdx.x) >> 8); unit < BATCH * NH_SSM; unit += F.nblk * 2) {
        const int b = unit / NH_SSM, h = unit % NH_SSM, g = h / 8;
        const float a = -__expf(F.a_log[h]), dsk = F.d_skip[h];
        float st[32];
#pragma unroll
        for (int i = 0; i < 32; ++i) st[i] = 0.f;
        for (int t = 0; t < SEQ; ++t) {
            const size_t row = (size_t)b * SEQ + t;
            const float dt = DT[(size_t)h * T + row];
            const float dA = __expf(dt * a);
            const float xv = bf2f(CV[row * CONVD + h * 64 + p]);
            const float dtx = dt * xv;
            const u32x4* bp = (const u32x4*)(CV + row * CONVD + 2048 + g * 128 + q * 32);
            const u32x4* cp = (const u32x4*)(CV + row * CONVD + 2560 + g * 128 + q * 32);
            float yp = 0.f;
#pragma unroll
            for (int c = 0; c < 4; ++c) {
                const u32x4 bw = bp[c], cw = cp[c];
                const float bv[8] = {bflo(bw.x), bfhi(bw.x), bflo(bw.y), bfhi(bw.y), bflo(bw.z), bfhi(bw.z), bflo(bw.w), bfhi(bw.w)};
                const float cv[8] = {bflo(cw.x), bfhi(cw.x), bflo(cw.y), bfhi(cw.y), bflo(cw.z), bfhi(cw.z), bflo(cw.w), bfhi(cw.w)};
#pragma unroll
                for (int i = 0; i < 8; ++i) { st[8 * c + i] = st[8 * c + i] * dA + dtx * bv[i]; yp += cv[i] * st[8 * c + i]; }
            }
            yp += __shfl_xor(yp, 1); yp += __shfl_xor(yp, 2);
            if (q == 0) {
                const float y = yp + dsk * xv;
                const float z = bf2f(Z[row * DI + h * 64 + p]);
                YZ[row * DI + h * 64 + p] = (bf16)f2bf(y * siluf_(z));
            }
        }
    }
}

__device__ __forceinline__ int swz256(int row, int chunk) { return row * 272 + (chunk << 4); }
__device__ __forceinline__ int swz128(int row, int chunk) { return row * 144 + (chunk << 4); }
__device__ __forceinline__ void p_ssd_fast(Frame& F) {
    const int lane = ((int)(threadIdx.x & 63u)), r = lane & 31, hh = lane >> 5, lb = F.wave & 3, pb = F.wave >> 2, tid = ((int)threadIdx.x);
    LAS unsigned char* Bimg = F.lds; LAS unsigned char* Cimg = F.lds + 34816; LAS unsigned char* Ximg = F.lds + 69632; LAS unsigned char* Xwimg = F.lds + 88064;
    LAS unsigned char* Simg = F.lds + 106496; LAS float* acs = (LAS float*)(F.lds + 123904); LAS float* dtv = (LAS float*)(F.lds + 124416);
    const bf16* CV = (const bf16*)(F.ws + WS_CONV); const float* DT = (const float*)(F.ws + WS_DT); bf16* Y = (bf16*)(F.ws + WS_YZ);
    const int q4 = (lane & 15) >> 2, blk16 = (lane >> 4) & 1, p4 = lane & 3;
    const f32x16 zero16 = {0.f, 0.f, 0.f, 0.f, 0.f, 0.f, 0.f, 0.f, 0.f, 0.f, 0.f, 0.f, 0.f, 0.f, 0.f, 0.f};
    for (int unit = F.blk; unit < BATCH * NH_SSM; unit += F.nblk) {
        const int b = unit / NH_SSM, h = unit % NH_SSM, g = h >> 3;
        const float a = -__expf(F.a_log[h]);
        f32x16 st = zero16;
        u32x4 rb[4], rc[4], rx[2]; float d0, d1;
#define SSD_LOAD(c) do { const size_t row0_ = (size_t)b * SEQ + (size_t)(c) * 128; \
            _Pragma("unroll") for (int i = 0; i < 4; ++i) { const int piece = tid + 512 * i, row = piece >> 4, ch = piece & 15; \
                rb[i] = *(const u32x4*)(CV + (row0_ + row) * CONVD + 2048 + g * 128 + ch * 8); rc[i] = *(const u32x4*)(CV + (row0_ + row) * CONVD + 2560 + g * 128 + ch * 8); } \
            _Pragma("unroll") for (int i = 0; i < 2; ++i) { const int piece = tid + 512 * i, row = piece >> 3, ch = piece & 7; rx[i] = *(const u32x4*)(CV + (row0_ + row) * CONVD + h * 64 + ch * 8); } \
            d0 = DT[(size_t)h * T + row0_ + lane]; d1 = DT[(size_t)h * T + row0_ + 64 + lane]; } while (0)
        SSD_LOAD(0);
        for (int c = 0; c < 16; ++c) {
            const size_t row0 = (size_t)b * SEQ + (size_t)c * 128;
            float x0 = d0 * a, x1 = d1 * a;
#pragma unroll
            for (int o = 1; o < 64; o <<= 1) { const float t0 = __shfl_up(x0, o), t1 = __shfl_up(x1, o); if (lane >= o) { x0 += t0; x1 += t1; } }
            x1 += __shfl(x0, 63);
            const float total = __shfl(x1, 63);
            __syncthreads();
            acs[lane] = x0; acs[64 + lane] = x1; dtv[lane] = d0; dtv[64 + lane] = d1;
#pragma unroll
            for (int i = 0; i < 4; ++i) { const int piece = tid + 512 * i, row = piece >> 4, ch = piece & 15;
                *(LAS u32x4*)(Bimg + swz256(row, ch)) = rb[i]; *(LAS u32x4*)(Cimg + swz256(row, ch)) = rc[i]; }
#pragma unroll
            for (int i = 0; i < 2; ++i) { const int piece = tid + 512 * i, row = piece >> 3, ch = piece & 7;
                const float w = __expf(total - acs[row]) * dtv[row];
                const u32x4 v = rx[i]; u32x4 o;
                o.x = pk2(bflo(v.x) * w, bfhi(v.x) * w); o.y = pk2(bflo(v.y) * w, bfhi(v.y) * w); o.z = pk2(bflo(v.z) * w, bfhi(v.z) * w); o.w = pk2(bflo(v.w) * w, bfhi(v.w) * w);
                *(LAS u32x4*)(Ximg + swz128(row, ch)) = v; *(LAS u32x4*)(Xwimg + swz128(row, ch)) = o; }
#pragma unroll
            for (int g4 = 0; g4 < 4; ++g4) { u32x2 w2; w2.x = pk2(st[4 * g4], st[4 * g4 + 1]); w2.y = pk2(st[4 * g4 + 2], st[4 * g4 + 3]);
                *(LAS u32x2*)(Simg + swz256(32 * pb + r, 4 * lb + g4) + 8 * hh) = w2; }
            __syncthreads();
            bf16x8_t cf[8];
#pragma unroll
            for (int kk = 0; kk < 8; ++kk) cf[kk] = *(const LAS bf16x8_t*)(Cimg + swz256(32 * lb + r, 2 * kk + hh));
            const float acs_l = acs[32 * lb + r];
            f32x16 yd = zero16;
            for (int sb = 0; sb <= lb; ++sb) {
                f32x16 gt = zero16;
#pragma unroll
                for (int kk = 0; kk < 8; ++kk) { const bf16x8_t bfm = *(const LAS bf16x8_t*)(Bimg + swz256(32 * sb + r, 2 * kk + hh)); gt = __builtin_amdgcn_mfma_f32_32x32x16_bf16(bfm, cf[kk], gt, 0, 0, 0); }
#pragma unroll
                for (int i = 0; i < 16; ++i) { const int s = 32 * sb + crow_(i, hh), l = 32 * lb + r;
                    const float e = __expf(fminf(acs_l - acs[s], 0.f)) * dtv[s];
                    gt[i] = (s <= l) ? gt[i] * e : 0.f; }
#pragma unroll
                for (int q = 0; q < 2; ++q) {
                    u32x4 pw; pw.x = pk2(gt[8 * q], gt[8 * q + 1]); pw.y = pk2(gt[8 * q + 2], gt[8 * q + 3]); pw.z = pk2(gt[8 * q + 4], gt[8 * q + 5]); pw.w = pk2(gt[8 * q + 6], gt[8 * q + 7]);
                    const bf16x8_t pa = __builtin_bit_cast(bf16x8_t, pw);
                    const int row_lo = 32 * sb + 16 * q + 4 * hh + q4, row_hi = row_lo + 8, chunk = 4 * pb + 2 * blk16 + (p4 >> 1), sub = (p4 & 1) * 8;
                    const s16x4_t lo = tr_read_(Ximg + swz128(row_lo, chunk) + sub), hi = tr_read_(Ximg + swz128(row_hi, chunk) + sub);
                    const bf16x8_t xf = (bf16x8_t){lo[0], lo[1], lo[2], lo[3], hi[0], hi[1], hi[2], hi[3]};
                    yd = __builtin_amdgcn_mfma_f32_32x32x16_bf16(pa, xf, yd, 0, 0, 0);
                }
            }
            f32x16 yo = zero16;
#pragma unroll
            for (int kk = 0; kk < 8; ++kk) { const bf16x8_t sf = *(const LAS bf16x8_t*)(Simg + swz256(32 * pb + r, 2 * kk + hh)); yo = __builtin_amdgcn_mfma_f32_32x32x16_bf16(cf[kk], sf, yo, 0, 0, 0); }
#pragma unroll
            for (int i = 0; i < 16; ++i) { const int l = 32 * lb + crow_(i, hh);
                const float y = yd[i] + __expf(acs[l]) * yo[i];
                Y[(row0 + l) * DI + h * 64 + 32 * pb + r] = (bf16)f2bf(y); }
            if (c + 1 < 16) SSD_LOAD(c + 1);
            const float cd = __expf(total);
#pragma unroll
            for (int i = 0; i < 16; ++i) st[i] *= cd;
#pragma unroll
            for (int kk = 0; kk < 8; ++kk) {
                const int row_lo = 16 * kk + 4 * hh + q4, row_hi = row_lo + 8, sub = (p4 & 1) * 8;
                const int chb = 4 * lb + 2 * blk16 + (p4 >> 1), chx = 4 * pb + 2 * blk16 + (p4 >> 1);
                const s16x4_t blo = tr_read_(Bimg + swz256(row_lo, chb) + sub), bhi = tr_read_(Bimg + swz256(row_hi, chb) + sub);
                const s16x4_t xlo = tr_read_(Xwimg + swz128(row_lo, chx) + sub), xhi = tr_read_(Xwimg + swz128(row_hi, chx) + sub);
                const bf16x8_t af = (bf16x8_t){blo[0], blo[1], blo[2], blo[3], bhi[0], bhi[1], bhi[2], bhi[3]};
                const bf16x8_t xf = (bf16x8_t){xlo[0], xlo[1], xlo[2], xlo[3], xhi[0], xhi[1], xhi[2], xhi[3]};
                st = __builtin_amdgcn_mfma_f32_32x32x16_bf16(af, xf, st, 0, 0, 0);
            }
        }
#undef SSD_LOAD
    }
    __syncthreads();
}
__device__ __forceinline__ void p_ssd_fast2(Frame& F) {
    const int lane = ((int)(threadIdx.x & 63u)), r = lane & 31, hh = lane >> 5, pb = F.wave >> 2, nb = F.wave & 3, lb = pb ? 3 - nb : nb, tid = ((int)threadIdx.x);
#define SSD2_PTRS() unsigned opq_ = 0; asm volatile("" : "+s"(opq_)); \
    LAS unsigned char* const Bimg = F.lds + opq_; LAS unsigned char* const Cimg = Bimg + 34816; LAS unsigned char* const Ximg0 = Bimg + 69632; LAS unsigned char* const Simg0 = Bimg + 106496; \
    LAS float* const tab0 = (LAS float*)(Bimg + 141312); \
    const bf16* const CV = (const bf16*)(F.ws + WS_CONV + opq_); const float* const DT = (const float*)(F.ws + WS_DT + opq_); bf16* const Y = (bf16*)(F.ws + WS_YZ + opq_); \
    int tidl_ = ((int)threadIdx.x); asm volatile("" : "+v"(tidl_)); const int tid = tidl_, lane = tid & 63, r = lane & 31, hh = lane >> 5, q4 = (lane & 15) >> 2, blk16 = (lane >> 4) & 1, p4 = lane & 3; \
    (void)tid; (void)r; (void)hh; (void)q4; (void)blk16; (void)p4
    const int q4 = (lane & 15) >> 2, blk16 = (lane >> 4) & 1, p4 = lane & 3;
    const f32x16 zero16 = {0.f, 0.f, 0.f, 0.f, 0.f, 0.f, 0.f, 0.f, 0.f, 0.f, 0.f, 0.f, 0.f, 0.f, 0.f, 0.f};
    for (int unit = F.blk; unit < BATCH * NG_SSM * 4; unit += F.nblk) {
        const int b = unit >> 4, g = (unit >> 2) & 3, h0 = 8 * g + 2 * (unit & 3);
        const float a0 = -__expf(F.a_log[h0]), a1 = -__expf(F.a_log[h0 + 1]), dsk0 = F.d_skip[h0], dsk1 = F.d_skip[h0 + 1];
        f32x16 st[2]; st[0] = zero16; st[1] = zero16;
        u32x4 rb[4], rc[4], rx[2][2]; float dm0 = 0.f, dm1 = 0.f;
#define SSD2_LOAD(c) do { const size_t row0_ = (size_t)b * SEQ + (size_t)(c) * 128; \
            _Pragma("unroll") for (int i = 0; i < 4; ++i) { const int piece = tid + 512 * i, row = piece >> 4, ch = piece & 15; \
                rb[i] = *(const u32x4*)(CV + (row0_ + row) * CONVD + 2048 + g * 128 + ch * 8); rc[i] = *(const u32x4*)(CV + (row0_ + row) * CONVD + 2560 + g * 128 + ch * 8); } \
            _Pragma("unroll") for (int e = 0; e < 2; ++e) { \
                _Pragma("unroll") for (int i = 0; i < 2; ++i) { const int piece = tid + 512 * i, row = piece >> 3, ch = piece & 7; rx[e][i] = *(const u32x4*)(CV + (row0_ + row) * CONVD + (h0 + e) * 64 + ch * 8); } \
                } \
            if (F.wave < 2) { dm0 = DT[(size_t)(h0 + (F.wave & 1)) * T + row0_ + lane]; dm1 = DT[(size_t)(h0 + (F.wave & 1)) * T + row0_ + 64 + lane]; } } while (0)
        { SSD2_PTRS(); SSD2_LOAD(0); }
        for (int c = 0; c < 16; ++c) {
            const size_t row0 = (size_t)b * SEQ + (size_t)c * 128;
            float x0 = 0.f, x1 = 0.f, tot = 0.f; const int es = F.wave & 1;
            if (F.wave < 2) { const float a = es ? a1 : a0; x0 = dm0 * a; x1 = dm1 * a;
#pragma unroll
                for (int o = 1; o < 64; o <<= 1) { const float t0 = __shfl_up(x0, o), t1 = __shfl_up(x1, o); if (lane >= o) { x0 += t0; x1 += t1; } }
                x1 += __shfl(x0, 63); tot = __shfl(x1, 63); }
            LDS_BARRIER();
            for (int repw_ = 0; repw_ < SSD_REP_W; ++repw_) { SSD2_PTRS();
            if (F.wave < 2) { LAS float* const tb = tab0 + 704 * es;
                const float dd0 = dm0, dd1 = dm1;
                tb[lane] = x0; tb[64 + lane] = x1; tb[128 + lane] = dd0; tb[192 + lane] = dd1;
                tb[256 + lane] = __expf(tot - x0) * dd0; tb[320 + lane] = __expf(tot - x1) * dd1;
                tb[384 + lane] = __expf(x0); tb[448 + lane] = __expf(x1);
                const float a32 = __shfl(x0, 32), a64 = __shfl(x1, 0), a96 = __shfl(x1, 32);
                if (lane < 32) { tb[512 + lane] = __expf(a32 - x0) * dd0; tb[512 + 96 + 64 + lane] = __expf(a96 - x1) * dd1; }
                tb[512 + 32 + lane] = __expf(a64 - x0) * dd0; tb[512 + 96 + lane] = __expf(a96 - x0) * dd0; }
#pragma unroll
            for (int i = 0; i < 4; ++i) { const int piece = tid + 512 * i, row = piece >> 4, ch = piece & 15;
                *(LAS u32x4*)(Bimg + swz256(row, ch)) = rb[i]; *(LAS u32x4*)(Cimg + swz256(row, ch)) = rc[i]; }
#pragma unroll
            for (int e = 0; e < 2; ++e) {
#pragma unroll
                for (int i = 0; i < 2; ++i) { const int piece = tid + 512 * i, row = piece >> 3, ch = piece & 7; *(LAS u32x4*)(Ximg0 + 18432 * e + swz128(row, ch)) = rx[e][i]; }
#pragma unroll
                for (int g4 = 0; g4 < 4; ++g4) { u32x2 w2; w2.x = cvtpk(st[e][4 * g4], st[e][4 * g4 + 1]); w2.y = cvtpk(st[e][4 * g4 + 2], st[e][4 * g4 + 3]);
                    *(LAS u32x2*)(Simg0 + 17408 * e + swz256(32 * pb + r, 4 * nb + g4) + 8 * hh) = w2; }
            }
            }
            LDS_BARRIER();
            { SSD2_PTRS(); if (c + 1 < 16) SSD2_LOAD(c + 1); }
            for (int repa_ = 0; repa_ < SSD_REP_A; ++repa_) { SSD2_PTRS();
            bf16x8_t cf[8];
#pragma unroll
            for (int kk = 0; kk < 8; ++kk) cf[kk] = *(const LAS bf16x8_t*)(Cimg + swz256(32 * lb + r, 2 * kk + hh));
            const float acs_l0 = tab0[32 * lb + r], acs_l1 = tab0[704 + 32 * lb + r];
            const float e1_0 = __expf(acs_l0 - tab0[32 * lb]), e1_1 = __expf(acs_l1 - tab0[704 + 32 * lb]);
            const int e2off = lb == 1 ? 0 : (lb == 2 ? 32 : 96);
            f32x16 yd[2]; yd[0] = zero16; yd[1] = zero16;
            for (int sb = 0; sb <= lb; ++sb) {
                f32x16 gt = zero16;
#pragma unroll
                for (int kk = 0; kk < 8; ++kk) { const bf16x8_t bfm = *(const LAS bf16x8_t*)(Bimg + swz256(32 * sb + r, 2 * kk + hh)); gt = __builtin_amdgcn_mfma_f32_32x32x16_bf16(bfm, cf[kk], gt, 0, 0, 0); }
#pragma unroll
                for (int e = 0; e < 2; ++e) {
                    const LAS float* const tb = tab0 + 704 * e;
                    float gv[16];
                    if (sb < lb) {
                        const float e1 = e ? e1_1 : e1_0;
#pragma unroll
                        for (int g4 = 0; g4 < 4; ++g4) { const f32x4 t = *(const LAS f32x4*)(tb + 512 + e2off + 32 * sb + 8 * g4 + 4 * hh);
                            gv[4 * g4] = gt[4 * g4] * (t.x * e1); gv[4 * g4 + 1] = gt[4 * g4 + 1] * (t.y * e1); gv[4 * g4 + 2] = gt[4 * g4 + 2] * (t.z * e1); gv[4 * g4 + 3] = gt[4 * g4 + 3] * (t.w * e1); }
                    } else {
                        const float acs_l = e ? acs_l1 : acs_l0;
#pragma unroll
                        for (int g4 = 0; g4 < 4; ++g4) { const f32x4 ta = *(const LAS f32x4*)(tb + 32 * sb + 8 * g4 + 4 * hh), td = *(const LAS f32x4*)(tb + 128 + 32 * sb + 8 * g4 + 4 * hh);
                            const float av[4] = {ta.x, ta.y, ta.z, ta.w}, dv[4] = {td.x, td.y, td.z, td.w};
#pragma unroll
                            for (int j = 0; j < 4; ++j) { const int sl = 8 * g4 + 4 * hh + j;
                                gv[4 * g4 + j] = (sl <= r) ? gt[4 * g4 + j] * (__expf(fminf(acs_l - av[j], 0.f)) * dv[j]) : 0.f; } }
                    }
#pragma unroll
                    for (int q = 0; q < 2; ++q) {
                        u32x4 pw; pw.x = cvtpk(gv[8 * q], gv[8 * q + 1]); pw.y = cvtpk(gv[8 * q + 2], gv[8 * q + 3]); pw.z = cvtpk(gv[8 * q + 4], gv[8 * q + 5]); pw.w = cvtpk(gv[8 * q + 6], gv[8 * q + 7]);
                        const bf16x8_t pa = __builtin_bit_cast(bf16x8_t, pw);
                        const int row_lo = 32 * sb + 16 * q + 4 * hh + q4, row_hi = row_lo + 8, chunk = 4 * pb + 2 * blk16 + (p4 >> 1), sub = (p4 & 1) * 8;
                        const s16x4_t lo = tr_read_(Ximg0 + 18432 * e + swz128(row_lo, chunk) + sub), hi = tr_read_(Ximg0 + 18432 * e + swz128(row_hi, chunk) + sub);
                        const bf16x8_t xf = (bf16x8_t){lo[0], lo[1], lo[2], lo[3], hi[0], hi[1], hi[2], hi[3]};
                        yd[e] = __builtin_amdgcn_mfma_f32_32x32x16_bf16(pa, xf, yd[e], 0, 0, 0);
                    }
                }
            }
#pragma unroll
            for (int e = 0; e < 2; ++e) {
                f32x16 yo = zero16;
#pragma unroll
                for (int kk = 0; kk < 8; ++kk) { const bf16x8_t sf = *(const LAS bf16x8_t*)(Simg0 + 17408 * e + swz256(32 * pb + r, 2 * kk + hh)); yo = __builtin_amdgcn_mfma_f32_32x32x16_bf16(cf[kk], sf, yo, 0, 0, 0); }
#pragma unroll
                for (int g4 = 0; g4 < 4; ++g4) { const f32x4 ea = *(const LAS f32x4*)(tab0 + 704 * e + 384 + 32 * lb + 8 * g4 + 4 * hh); const float eav[4] = {ea.x, ea.y, ea.z, ea.w};
                    const s16x4_t xs4 = tr_read_(Ximg0 + 18432 * e + swz128(32 * lb + 8 * g4 + 4 * hh + q4, 4 * pb + 2 * blk16 + (p4 >> 1)) + (p4 & 1) * 8);
#pragma unroll
                    for (int j = 0; j < 4; ++j) { const int i = 4 * g4 + j, l = 32 * lb + 8 * g4 + 4 * hh + j;
                        const float y = yd[e][i] + eav[j] * yo[i] + (e ? dsk1 : dsk0) * bf2f((bf16)xs4[j]);
                        Y[(row0 + l) * DI + (h0 + e) * 64 + 32 * pb + r] = (bf16)(cvtpk(y, y) & 0xffffu); } }
            }
            }
            { SSD2_PTRS();
            { const float cd0 = __expf(tab0[127]), cd1 = __expf(tab0[704 + 127]);
#pragma unroll
              for (int i = 0; i < 16; ++i) { st[0][i] *= cd0; st[1][i] *= cd1; } }
#pragma unroll
            for (int kk = 0; kk < 8; ++kk) {
                const int row_lo = 16 * kk + 4 * hh + q4, row_hi = row_lo + 8, sub = (p4 & 1) * 8;
                const int chb = 4 * nb + 2 * blk16 + (p4 >> 1), chx = 4 * pb + 2 * blk16 + (p4 >> 1);
                const s16x4_t blo = tr_read_(Bimg + swz256(row_lo, chb) + sub), bhi = tr_read_(Bimg + swz256(row_hi, chb) + sub);
                const bf16x8_t af = (bf16x8_t){blo[0], blo[1], blo[2], blo[3], bhi[0], bhi[1], bhi[2], bhi[3]};
#pragma unroll
                for (int e = 0; e < 2; ++e) {
                    const s16x4_t xlo = tr_read_(Ximg0 + 18432 * e + swz128(row_lo, chx) + sub), xhi = tr_read_(Ximg0 + 18432 * e + swz128(row_hi, chx) + sub);
                    const f32x4 wl = *(const LAS f32x4*)(tab0 + 704 * e + 256 + 16 * kk + 4 * hh), wh = *(const LAS f32x4*)(tab0 + 704 * e + 256 + 16 * kk + 8 + 4 * hh);
                    u32x4 pw;
                    pw.x = cvtpk(bf2f((bf16)xlo[0]) * wl.x, bf2f((bf16)xlo[1]) * wl.y); pw.y = cvtpk(bf2f((bf16)xlo[2]) * wl.z, bf2f((bf16)xlo[3]) * wl.w);
                    pw.z = cvtpk(bf2f((bf16)xhi[0]) * wh.x, bf2f((bf16)xhi[1]) * wh.y); pw.w = cvtpk(bf2f((bf16)xhi[2]) * wh.z, bf2f((bf16)xhi[3]) * wh.w);
                    st[e] = __builtin_amdgcn_mfma_f32_32x32x16_bf16(af, __builtin_bit_cast(bf16x8_t, pw), st[e], 0, 0, 0);
                }
            }
            }
        }
#undef SSD2_LOAD
#undef SSD2_PTRS
    }
    __syncthreads();
}

__device__ __forceinline__ void p_ypost2(Frame& F) {
    const int gw = F.blk * NWAVES + F.wave, NGW = F.nblk * NWAVES;
    const bf16* Y = (const bf16*)(F.ws + WS_YZ); const bf16* CV = (const bf16*)(F.ws + WS_CONV); const bf16* Z = (const bf16*)(F.ws + WS_Z); bf16* YN = (bf16*)(F.ws + WS_YN);
    for (int m = gw; m < T; m += NGW) {
#pragma unroll
        for (int g = 0; g < 4; ++g) {
            const int c0 = g * 512 + ((int)(threadIdx.x & 63u)) * 8;
            const u32x4 yw = __builtin_nontemporal_load((const u32x4*)(Y + (size_t)m * DI + c0)), zw = __builtin_nontemporal_load((const u32x4*)(Z + (size_t)m * DI + c0));
            const float yv[8] = {bflo(yw.x), bfhi(yw.x), bflo(yw.y), bfhi(yw.y), bflo(yw.z), bfhi(yw.z), bflo(yw.w), bfhi(yw.w)};
            const float zv[8] = {bflo(zw.x), bfhi(zw.x), bflo(zw.y), bfhi(zw.y), bflo(zw.z), bfhi(zw.z), bflo(zw.w), bfhi(zw.w)};
            float v[8]; float s = 0.f;
#pragma unroll
            for (int i = 0; i < 8; ++i) { v[i] = yv[i] * siluf_(zv[i]); s += v[i] * v[i]; }
            const float rstd = __builtin_amdgcn_rsqf(wave_sum(s) * (1.f / 512.f) + EPS);
            const float* nw = F.ssm_norm_w + c0;
            u32x4 o; o.x = pk2(v[0] * rstd * nw[0], v[1] * rstd * nw[1]); o.y = pk2(v[2] * rstd * nw[2], v[3] * rstd * nw[3]);
            o.z = pk2(v[4] * rstd * nw[4], v[5] * rstd * nw[5]); o.w = pk2(v[6] * rstd * nw[6], v[7] * rstd * nw[7]);
            *(u32x4*)(YN + (size_t)m * DI + c0) = o;
        }
    }
}

__device__ __forceinline__ void p_ypost(Frame& F) {
    const int gw = F.blk * NWAVES + F.wave, NGW = F.nblk * NWAVES;
    const bf16* YZ = (const bf16*)(F.ws + WS_YZ); bf16* YN = (bf16*)(F.ws + WS_YN);
    for (int m = gw; m < T; m += NGW) {
#pragma unroll
        for (int g = 0; g < 4; ++g) {
            const int c0 = g * 512 + ((int)(threadIdx.x & 63u)) * 8;
            const u32x4 w = *(const u32x4*)(YZ + (size_t)m * DI + c0);
            float v[8] = {bflo(w.x), bfhi(w.x), bflo(w.y), bfhi(w.y), bflo(w.z), bfhi(w.z), bflo(w.w), bfhi(w.w)};
            float s = 0.f;
#pragma unroll
            for (int i = 0; i < 8; ++i) s += v[i] * v[i];
            const float rstd = __builtin_amdgcn_rsqf(wave_sum(s) * (1.f / 512.f) + EPS);
            const float* nw = F.ssm_norm_w + c0;
            u32x4 o; o.x = pk2(v[0] * rstd * nw[0], v[1] * rstd * nw[1]); o.y = pk2(v[2] * rstd * nw[2], v[3] * rstd * nw[3]);
            o.z = pk2(v[4] * rstd * nw[4], v[5] * rstd * nw[5]); o.w = pk2(v[6] * rstd * nw[6], v[7] * rstd * nw[7]);
            *(u32x4*)(YN + (size_t)m * DI + c0) = o;
        }
    }
}

__device__ __forceinline__ void p_router(Frame& F) {
    LAS int* hist = (LAS int*)F.lds;
    if (((int)threadIdx.x) < 32) hist[((int)threadIdx.x)] = 0;
    __syncthreads();
    int* ROWMAP = (int*)(F.ws + WS_ROWMAP);
    for (int i = F.blk * NTHREADS + ((int)threadIdx.x); i < CAP; i += F.nblk * NTHREADS) ROWMAP[i] = -1;
    const int gw = F.blk * NWAVES + F.wave, NGW = F.nblk * NWAVES;
    bf16* XN2 = (bf16*)(F.ws + WS_XN2); int* TOPI = (int*)(F.ws + WS_TOPI); float* TOPW = (float*)(F.ws + WS_TOPW);
    for (int m = gw; m < T; m += NGW) {
        const f32x4* xr = (const f32x4*)(F.out + (size_t)m * D) + ((int)(threadIdx.x & 63u));
        const f32x4* wr = (const f32x4*)F.norm_ffn + ((int)(threadIdx.x & 63u));
        f32x4 v[4]; float s = 0.f;
#pragma unroll
        for (int j = 0; j < 4; ++j) { v[j] = xr[64 * j]; s += (v[j].x * v[j].x + v[j].y * v[j].y) + (v[j].z * v[j].z + v[j].w * v[j].w); }
        const float rstd = __builtin_amdgcn_rsqf(wave_sum(s) * (1.f / D) + EPS);
        float lg[32];
#pragma unroll
        for (int e = 0; e < 32; ++e) lg[e] = 0.f;
#pragma unroll
        for (int j = 0; j < 4; ++j) {
            v[j] = v[j] * rstd * wr[64 * j];
            st_bf4(XN2 + (size_t)m * D + (((int)(threadIdx.x & 63u)) + 64 * j) * 4, v[j]);
            const float hv[4] = {v[j].x, v[j].y, v[j].z, v[j].w};
#pragma unroll
            for (int i = 0; i < 4; ++i) {
                const f32x4* rw = (const f32x4*)(F.router_w + (size_t)((((int)(threadIdx.x & 63u)) + 64 * j) * 4 + i) * 32);
#pragma unroll
                for (int c = 0; c < 8; ++c) { const f32x4 w = rw[c]; lg[4 * c] += hv[i] * w.x; lg[4 * c + 1] += hv[i] * w.y; lg[4 * c + 2] += hv[i] * w.z; lg[4 * c + 3] += hv[i] * w.w; }
            }
        }
#pragma unroll
        for (int e = 0; e < 32; ++e) lg[e] = wave_sum(lg[e]) + F.router_b[e];
        int bi[4]; float bv[4];
#pragma unroll
        for (int k = 0; k < 4; ++k) {
            float best = -INFINITY; int be = 0;
#pragma unroll
            for (int e = 0; e < 32; ++e) if (lg[e] > best) { best = lg[e]; be = e; }
            bi[k] = be; bv[k] = best;
#pragma unroll
            for (int e = 0; e < 32; ++e) if (e == be) lg[e] = -INFINITY;
        }
        const float e0 = 1.f, e1 = __expf(bv[1] - bv[0]), e2 = __expf(bv[2] - bv[0]), e3 = __expf(bv[3] - bv[0]);
        const float inv = 1.f / (e0 + e1 + e2 + e3);
        if (((int)(threadIdx.x & 63u)) == 0) {
            *(int4*)(TOPI + (size_t)m * 4) = make_int4(bi[0], bi[1], bi[2], bi[3]);
            *(f32x4*)(TOPW + (size_t)m * 4) = (f32x4){e0 * inv, e1 * inv, e2 * inv, e3 * inv};
            atomicAdd((int*)&hist[bi[0]], 1); atomicAdd((int*)&hist[bi[1]], 1); atomicAdd((int*)&hist[bi[2]], 1); atomicAdd((int*)&hist[bi[3]], 1);
        }
    }
    __syncthreads();
    if (((int)threadIdx.x) < 32) atomicAdd((unsigned*)(F.ctl + CW_CNT + 64 * ((int)threadIdx.x)), (unsigned)hist[((int)threadIdx.x)]);
    __syncthreads();
}

__device__ __forceinline__ void p_conv2(Frame& F) {
    const bf16* X = (const bf16*)(F.ws + WS_XBC); bf16* O = (bf16*)(F.ws + WS_CONV);
    constexpr int NCG = CONVD / 8, total = (T / 8) * NCG;
    for (int idx = F.blk * NTHREADS + ((int)threadIdx.x); idx < total; idx += F.nblk * NTHREADS) {
        const int cg = idx % NCG, tb = idx / NCG, c0 = cg * 8, row0 = tb * 8, t0 = row0 & (SEQ - 1);
        float cw[4][8], cb[8];
#pragma unroll
        for (int w = 0; w < 4; ++w) { const f32x4 a = *(const f32x4*)(F.conv_w + (size_t)w * CONVD + c0), b = *(const f32x4*)(F.conv_w + (size_t)w * CONVD + c0 + 4);
            cw[w][0] = a.x; cw[w][1] = a.y; cw[w][2] = a.z; cw[w][3] = a.w; cw[w][4] = b.x; cw[w][5] = b.y; cw[w][6] = b.z; cw[w][7] = b.w; }
        { const f32x4 a = *(const f32x4*)(F.conv_b + c0), b = *(const f32x4*)(F.conv_b + c0 + 4); cb[0] = a.x; cb[1] = a.y; cb[2] = a.z; cb[3] = a.w; cb[4] = b.x; cb[5] = b.y; cb[6] = b.z; cb[7] = b.w; }
        u32x4 raw[11];
#pragma unroll
        for (int i = 0; i < 11; ++i) { raw[i] = (u32x4){0u, 0u, 0u, 0u}; if (t0 + i - 3 >= 0) raw[i] = *(const u32x4*)(X + (size_t)(row0 + i - 3) * CONVD + c0); }
        float acc[8][8];
#pragma unroll
        for (int tt = 0; tt < 8; ++tt)
#pragma unroll
            for (int c = 0; c < 8; ++c) acc[tt][c] = cb[c];
#pragma unroll
        for (int i = 0; i < 11; ++i) {
            const float xv[8] = {bflo(raw[i].x), bfhi(raw[i].x), bflo(raw[i].y), bfhi(raw[i].y), bflo(raw[i].z), bfhi(raw[i].z), bflo(raw[i].w), bfhi(raw[i].w)};
#pragma unroll
            for (int w = 0; w < 4; ++w) { const int tt = i - w;
                if (tt >= 0 && tt < 8) {
#pragma unroll
                    for (int c = 0; c < 8; ++c) acc[tt][c] += cw[w][c] * xv[c]; } }
        }
#pragma unroll
        for (int tt = 0; tt < 8; ++tt) { u32x4 o; o.x = pk2(siluf_(acc[tt][0]), siluf_(acc[tt][1])); o.y = pk2(siluf_(acc[tt][2]), siluf_(acc[tt][3]));
            o.z = pk2(siluf_(acc[tt][4]), siluf_(acc[tt][5])); o.w = pk2(siluf_(acc[tt][6]), siluf_(acc[tt][7]));
            *(u32x4*)(O + (size_t)(row0 + tt) * CONVD + c0) = o; }
    }
}

__device__ __forceinline__ void p_router2(Frame& F) {
    LAS float* WrT = (LAS float*)F.lds;
    LAS int* hist = (LAS int*)(F.lds + 131072);
    if (((int)threadIdx.x) < 32) hist[((int)threadIdx.x)] = 0;
    for (int i = ((int)threadIdx.x); i < 1024 * 8; i += NTHREADS) { const int k = i >> 3, e4 = (i & 7) * 4; const f32x4 w = *(const f32x4*)(F.router_w + (size_t)k * 32 + e4);
        WrT[(e4 + 0) * 1024 + k] = w.x; WrT[(e4 + 1) * 1024 + k] = w.y; WrT[(e4 + 2) * 1024 + k] = w.z; WrT[(e4 + 3) * 1024 + k] = w.w; }
    int* ROWMAP = (int*)(F.ws + WS_ROWMAP);
    for (int i = F.blk * NTHREADS + ((int)threadIdx.x); i < CAP; i += F.nblk * NTHREADS) ROWMAP[i] = -1;
    __syncthreads();
    const int lane = ((int)(threadIdx.x & 63u)), gw = F.blk * NWAVES + F.wave, NGW = F.nblk * NWAVES;
    bf16* XN2 = (bf16*)(F.ws + WS_XN2); int* TOPI = (int*)(F.ws + WS_TOPI); float* TOPW = (float*)(F.ws + WS_TOPW);
    const float rb = F.router_b[lane >> 1];
    for (int mp = gw; mp < T / 2; mp += NGW) {
        f32x4 v[2][4];
#pragma unroll
        for (int j = 0; j < 2; ++j) {
            const int m = mp * 2 + j;
            const f32x4* xr = (const f32x4*)(F.out + (size_t)m * D) + lane; const f32x4* wr = (const f32x4*)F.norm_ffn + lane;
            float s = 0.f;
#pragma unroll
            for (int q = 0; q < 4; ++q) { v[j][q] = xr[64 * q]; s += (v[j][q].x * v[j][q].x + v[j][q].y * v[j][q].y) + (v[j][q].z * v[j][q].z + v[j][q].w * v[j][q].w); }
            const float rstd = __builtin_amdgcn_rsqf(wave_sum(s) * (1.f / D) + EPS);
#pragma unroll
            for (int q = 0; q < 4; ++q) { v[j][q] = v[j][q] * rstd * wr[64 * q];
#if MOE_FP8
                *(unsigned*)((unsigned char*)XN2 + (size_t)m * D + (lane + 64 * q) * 4) = pk_fp8x4(FP8_ASCALE * v[j][q].x, FP8_ASCALE * v[j][q].y, FP8_ASCALE * v[j][q].z, FP8_ASCALE * v[j][q].w);
#else
                st_bf4(XN2 + (size_t)m * D + (lane + 64 * q) * 4, v[j][q]);
#endif
            }
        }
        float p0[32], p1[32];
        f32x2_t tv[4][4];
#pragma unroll
        for (int q = 0; q < 4; ++q) { tv[q][0] = (f32x2_t){v[0][q].x, v[1][q].x}; tv[q][1] = (f32x2_t){v[0][q].y, v[1][q].y}; tv[q][2] = (f32x2_t){v[0][q].z, v[1][q].z}; tv[q][3] = (f32x2_t){v[0][q].w, v[1][q].w}; }
#pragma unroll
        for (int e = 0; e < 32; ++e) {
            f32x2_t a = {0.f, 0.f};
#pragma unroll
            for (int q = 0; q < 4; ++q) { const f32x4 w = *(const LAS f32x4*)(WrT + e * 1024 + (lane + 64 * q) * 4);
                a = __builtin_elementwise_fma(tv[q][0], (f32x2_t){w.x, w.x}, a); a = __builtin_elementwise_fma(tv[q][1], (f32x2_t){w.y, w.y}, a);
                a = __builtin_elementwise_fma(tv[q][2], (f32x2_t){w.z, w.z}, a); a = __builtin_elementwise_fma(tv[q][3], (f32x2_t){w.w, w.w}, a); }
            p0[e] = a.x; p1[e] = a.y;
        }
#define RS_STEP(P, N, MASK) do { const bool up = (lane & (MASK)) != 0; _Pragma("unroll") for (int i = 0; i < (N); ++i) { const float mine = up ? P[(N) + i] : P[i], other = up ? P[i] : P[(N) + i]; P[i] = mine + __shfl_xor(other, (MASK)); } } while (0)
        RS_STEP(p0, 16, 32); RS_STEP(p0, 8, 16); RS_STEP(p0, 4, 8); RS_STEP(p0, 2, 4); RS_STEP(p0, 1, 2);
        RS_STEP(p1, 16, 32); RS_STEP(p1, 8, 16); RS_STEP(p1, 4, 8); RS_STEP(p1, 2, 4); RS_STEP(p1, 1, 2);
#undef RS_STEP
        float lg[2] = {p0[0] + __shfl_xor(p0[0], 1) + rb, p1[0] + __shfl_xor(p1[0], 1) + rb};
#pragma unroll
        for (int j = 0; j < 2; ++j) {
            const int m = mp * 2 + j; float val = lg[j]; int bi[4]; float bv[4];
#pragma unroll
            for (int k = 0; k < 4; ++k) {
                float mx = val;
#pragma unroll
                for (int o = 1; o < 64; o <<= 1) mx = fmaxf(mx, __shfl_xor(mx, o));
                const unsigned long long bal = __ballot(val == mx);
                const int e = (int)(__ffsll((long long)bal) - 1) >> 1;
                bi[k] = e; bv[k] = mx;
                if ((lane >> 1) == e) val = -INFINITY;
            }
            const float e1 = __expf(bv[1] - bv[0]), e2 = __expf(bv[2] - bv[0]), e3 = __expf(bv[3] - bv[0]);
            const float inv = __builtin_amdgcn_rcpf(1.f + e1 + e2 + e3);
            if (lane == 0) {
                *(int4*)(TOPI + (size_t)m * 4) = make_int4(bi[0], bi[1], bi[2], bi[3]);
                *(f32x4*)(TOPW + (size_t)m * 4) = (f32x4){inv, e1 * inv, e2 * inv, e3 * inv};
                atomicAdd((int*)&hist[bi[0]], 1); atomicAdd((int*)&hist[bi[1]], 1); atomicAdd((int*)&hist[bi[2]], 1); atomicAdd((int*)&hist[bi[3]], 1);
            }
        }
    }
    __syncthreads();
    if (((int)threadIdx.x) < 32) atomicAdd((unsigned*)(F.ctl + CW_CNT + 64 * ((int)threadIdx.x)), (unsigned)hist[((int)threadIdx.x)]);
    __syncthreads();
}

__device__ __forceinline__ void p_router3(Frame& F) {
    LAS float* XS = (LAS float*)F.lds; LAS float* PW = (LAS float*)(F.lds + 66048); LAS float* P = (LAS float*)(F.lds + 66048 + 33792); LAS int* hist = (LAS int*)(F.lds + 66048 + 33792 + 4224);
    if (((int)threadIdx.x) < 32) hist[((int)threadIdx.x)] = 0;
    int* ROWMAP = (int*)(F.ws + WS_ROWMAP);
    for (int i = F.blk * NTHREADS + ((int)threadIdx.x); i < CAP; i += F.nblk * NTHREADS) ROWMAP[i] = -1;
    const int lane = ((int)(threadIdx.x & 63u)), tid = (int)threadIdx.x;
    bf16* XN2 = (bf16*)(F.ws + WS_XN2); int* TOPI = (int*)(F.ws + WS_TOPI); float* TOPW = (float*)(F.ws + WS_TOPW); const float* W2 = (const float*)(F.ws + WS_WRT);
    const float rb32 = F.router_b[lane & 31];
    const f32x4* wr = (const f32x4*)F.norm_ffn + lane;
    for (int tile = F.blk; tile < T / 32; tile += F.nblk) {
        const int m0 = tile * 32;
        f32x16 acc = {0.f, 0.f, 0.f, 0.f, 0.f, 0.f, 0.f, 0.f, 0.f, 0.f, 0.f, 0.f, 0.f, 0.f, 0.f, 0.f};
        const int i = lane & 31, kh = lane >> 5;
        for (int st = 0; st < 2; ++st) {
            __syncthreads();
#pragma unroll
            for (int j = 0; j < 8; ++j) { const int idx = tid + 512 * j, tk = idx >> 7, c4 = idx & 127;
                *(LAS f32x4*)(XS + tk * 516 + 4 * c4) = *(const f32x4*)(F.out + (size_t)(m0 + tk) * D + 512 * st + 4 * c4); }
            __syncthreads();
            const int kb = 64 * F.wave + 32 * kh;
            const float* bp = W2 + (size_t)(512 * st + kb) * 32 + i;
#pragma unroll
            for (int c = 0; c < 8; ++c) { const f32x4 a = *(const LAS f32x4*)(XS + i * 516 + kb + 4 * c);
                const float b0 = bp[(4 * c + 0) * 32], b1 = bp[(4 * c + 1) * 32], b2 = bp[(4 * c + 2) * 32], b3 = bp[(4 * c + 3) * 32];
                acc = __builtin_amdgcn_mfma_f32_32x32x2f32(a.x, b0, acc, 0, 0, 0); acc = __builtin_amdgcn_mfma_f32_32x32x2f32(a.y, b1, acc, 0, 0, 0);
                acc = __builtin_amdgcn_mfma_f32_32x32x2f32(a.z, b2, acc, 0, 0, 0); acc = __builtin_amdgcn_mfma_f32_32x32x2f32(a.w, b3, acc, 0, 0, 0); }
        }
#pragma unroll
        for (int rg = 0; rg < 16; ++rg) PW[(F.wave * 32 + crow_(rg, kh)) * 33 + i] = acc[rg];
        __syncthreads();
        for (int idx = tid; idx < 1024; idx += NTHREADS) { const int tk = idx >> 5, e = idx & 31; float s = 0.f;
#pragma unroll
            for (int w = 0; w < 8; ++w) s += PW[(w * 32 + tk) * 33 + e];
            P[tk * 33 + e] = s; }
        __syncthreads();
        for (int pp = 0; pp < 2; ++pp) {
            f32x4 v[2][4]; float rstd[2];
#pragma unroll
            for (int j = 0; j < 2; ++j) {
                const int m = m0 + 4 * F.wave + 2 * pp + j;
                float s = 0.f;
#pragma unroll
                for (int q = 0; q < 4; ++q) { v[j][q] = ((const f32x4*)(F.out + (size_t)m * D) + lane)[64 * q]; s += (v[j][q].x * v[j][q].x + v[j][q].y * v[j][q].y) + (v[j][q].z * v[j][q].z + v[j][q].w * v[j][q].w); }
                rstd[j] = __builtin_amdgcn_rsqf(wave_sum(s) * (1.f / D) + EPS);
#pragma unroll
                for (int q = 0; q < 4; ++q) { const f32x4 hv = v[j][q] * rstd[j] * wr[64 * q];
#if MOE_FP8
                    *(unsigned*)((unsigned char*)XN2 + (size_t)m * D + (lane + 64 * q) * 4) = pk_fp8x4(FP8_ASCALE * hv.x, FP8_ASCALE * hv.y, FP8_ASCALE * hv.z, FP8_ASCALE * hv.w);
#else
                    st_bf4(XN2 + (size_t)m * D + (lane + 64 * q) * 4, hv);
#endif
                }
            }
            const int jt = lane >> 5, e32 = lane & 31, t = 4 * F.wave + 2 * pp + jt;
            float val = P[t * 33 + e32] * (jt ? rstd[1] : rstd[0]) + rb32;
            int bi[4]; float bv[4];
#pragma unroll
            for (int k = 0; k < 4; ++k) {
                float mx = val;
#pragma unroll
                for (int o = 1; o < 32; o <<= 1) mx = fmaxf(mx, __shfl_xor(mx, o));
                const unsigned long long bal = __ballot(val == mx);
                const unsigned lo32 = (unsigned)bal, hi32 = (unsigned)(bal >> 32);
                const int e = jt ? (__ffs((int)hi32) - 1) : (__ffs((int)lo32) - 1);
                bi[k] = e; bv[k] = mx;
                if (e32 == e) val = -INFINITY;
            }
            const float e1 = __expf(bv[1] - bv[0]), e2 = __expf(bv[2] - bv[0]), e3 = __expf(bv[3] - bv[0]);
            const float inv = __builtin_amdgcn_rcpf(1.f + e1 + e2 + e3);
            if (e32 == 0) { const int m = m0 + t;
                *(int4*)(TOPI + (size_t)m * 4) = make_int4(bi[0], bi[1], bi[2], bi[3]);
                *(f32x4*)(TOPW + (size_t)m * 4) = (f32x4){inv, e1 * inv, e2 * inv, e3 * inv};
                atomicAdd((int*)&hist[bi[0]], 1); atomicAdd((int*)&hist[bi[1]], 1); atomicAdd((int*)&hist[bi[2]], 1); atomicAdd((int*)&hist[bi[3]], 1);
            }
        }
    }
    __syncthreads();
    if (((int)threadIdx.x) < 32) atomicAdd((unsigned*)(F.ctl + CW_CNT + 64 * ((int)threadIdx.x)), (unsigned)hist[((int)threadIdx.x)]);
    __syncthreads();
}

__device__ __forceinline__ void p_slots(Frame& F) {
    LAS int* hist = (LAS int*)F.lds;
    LAS int* base = hist + 32;
    LAS int* pst = hist + 64;
    if (((int)threadIdx.x) == 0) {
        int acc = 0;
        for (int e = 0; e < 32; ++e) { const int c = (int)__hip_atomic_load((unsigned*)(F.ctl + CW_CNT + 64 * e), __ATOMIC_RELAXED, __HIP_MEMORY_SCOPE_AGENT); pst[e] = acc; acc += (c + MOE_PAD - 1) / MOE_PAD * MOE_PAD; }
        pst[32] = acc;
    }
    __syncthreads();
    if (F.blk == 0) {
        int* TEXP = (int*)(F.ws + WS_SMALL);
        for (int i = ((int)threadIdx.x); i < NT256; i += NTHREADS) { const int r = i * 256; int e = -1;
            for (int k = 0; k < 32; ++k) if (r >= pst[k] && r < pst[k + 1]) e = k;
            TEXP[i] = e; }
        if (((int)threadIdx.x) == 0) TEXP[1024] = pst[32] / 256;
    }
    const int* TOPI = (const int*)(F.ws + WS_TOPI); int* SLOT = (int*)(F.ws + WS_SLOT); int* ROWMAP = (int*)(F.ws + WS_ROWMAP);
    for (int c = F.blk; c < T / 128; c += F.nblk) {
        if (((int)threadIdx.x) < 32) hist[((int)threadIdx.x)] = 0;
        __syncthreads();
        const int ai = c * 512 + ((int)threadIdx.x);
        const int e = TOPI[ai];
        const int lr = atomicAdd((int*)&hist[e], 1);
        __syncthreads();
        if (((int)threadIdx.x) < 32) base[((int)threadIdx.x)] = (int)atomicAdd((unsigned*)(F.ctl + CW_CUR + 64 * ((int)threadIdx.x)), (unsigned)hist[((int)threadIdx.x)]);
        __syncthreads();
        const int slot = pst[e] + base[e] + lr;
        SLOT[ai] = slot; ROWMAP[slot] = ai >> 2;
        __syncthreads();
    }
}

__device__ __forceinline__ void p_final(Frame& F) {
    const int gw = F.blk * NWAVES + F.wave, NGW = F.nblk * NWAVES;
    const int* SLOT = (const int*)(F.ws + WS_SLOT); const float* TOPW = (const float*)(F.ws + WS_TOPW); const bf16* YB = (const bf16*)(F.ws + WS_YB);
    for (int m = gw; m < T; m += NGW) {
        f32x4* xr = (f32x4*)(F.out + (size_t)m * D) + ((int)(threadIdx.x & 63u));
        const f32x4* wr = (const f32x4*)F.norm_final + ((int)(threadIdx.x & 63u));
        f32x4 v[4];
#pragma unroll
        for (int j = 0; j < 4; ++j) v[j] = xr[64 * j];
#pragma unroll
        for (int k = 0; k < 4; ++k) {
            const int sl = SLOT[m * 4 + k]; const float w = TOPW[m * 4 + k];
#pragma unroll
            for (int j = 0; j < 4; ++j) { const u32x2 y = __builtin_nontemporal_load((const u32x2*)(YB + (size_t)sl * 1024 + (((int)(threadIdx.x & 63u)) + 64 * j) * 4));
                v[j].x += w * bflo(y.x); v[j].y += w * bfhi(y.x); v[j].z += w * bflo(y.y); v[j].w += w * bfhi(y.y); }
        }
        float s = 0.f;
#pragma unroll
        for (int j = 0; j < 4; ++j) s += (v[j].x * v[j].x + v[j].y * v[j].y) + (v[j].z * v[j].z + v[j].w * v[j].w);
        const float rstd = __builtin_amdgcn_rsqf(wave_sum(s) * (1.f / D) + EPS);
#pragma unroll
        for (int j = 0; j < 4; ++j) __builtin_nontemporal_store(v[j] * rstd * wr[64 * j], xr + 64 * j);
    }
}


__device__ __forceinline__ void stagger_start(int blk, int nblk, unsigned span_ticks  ) {
    const unsigned long long t0 = __builtin_amdgcn_s_memrealtime();
    const unsigned long long want = (unsigned long long)((blk * 37u) % (unsigned)nblk) * span_ticks / (unsigned)nblk;
    while (__builtin_amdgcn_s_memrealtime() - t0 < want) __builtin_amdgcn_s_sleep(8);
}
__global__ void __launch_bounds__(NTHREADS, 2) fwd(Args args) {
    extern __shared__ __attribute__((aligned(16))) unsigned char lds_raw[];
    Frame F;
    F.lds = (LAS unsigned char*)lds_raw;
    F.tid = threadIdx.x; F.lane = F.tid & 63; F.wave = __builtin_amdgcn_readfirstlane(F.tid >> 6);
    F.blk = blockIdx.x; F.nblk = gridDim.x;
    F.x = args.in[0]; F.w_in = args.in[1]; F.rel_bias = args.in[2]; F.w_ba = args.in[3]; F.conv_w = args.in[4]; F.conv_b = args.in[5];
    F.dt_bias = args.in[6]; F.a_log = args.in[7]; F.d_skip = args.in[8]; F.ssm_norm_w = args.in[9]; F.w_bs = args.in[10]; F.gate_bias = args.in[11];
    F.w_out = args.in[12]; F.norm_mix = args.in[13]; F.norm_ffn = args.in[14]; F.router_w = args.in[15]; F.router_b = args.in[16];
    F.w1 = args.in[17]; F.b1 = args.in[18]; F.w2 = args.in[19]; F.b2 = args.in[20]; F.norm_final = args.in[21];
    F.out = args.out; F.ws = args.ws; F.ctl = (gu32*)(args.ws + WS_CTL);
    volatile LAS unsigned* MISC = (volatile LAS unsigned*)(F.lds + MISC_OFF);
    if (((int)threadIdx.x) < 32) MISC[((int)threadIdx.x)] = 0u;
    __syncthreads();
    XcdBarrier bar; bar.bar = (unsigned*)(F.ctl + CW_BAR); bar.x = 0; bar.st = nullptr;
#if MK_FUSED
    bar = xcd_barrier_post((unsigned*)(F.ctl + CW_BAR), MISC + 8);
#define GRID_BAR() xcd_barrier(bar)
#else
#define GRID_BAR() do { } while (0)
#endif
    const int lo = args.ph_lo, hi = args.ph_hi;
#define IN(k) (lo <= (k) && (k) < hi)
#define SEAM(k) do { if ((k) != 5 && IN(k) && IN((k) + 1)) GRID_BAR();     \
        if (PROBE_TIME == (k) && F.blk == 0 && ((int)threadIdx.x) == 0) { const unsigned long long d_ = __builtin_amdgcn_s_memrealtime() - pt_; const unsigned long long s_ = __builtin_amdgcn_s_memrealtime(); \
            while (__builtin_amdgcn_s_memrealtime() - s_ < d_) __builtin_amdgcn_s_sleep(8); } \
        if (PROBE_TIME == (k) + 1) pt_ = __builtin_amdgcn_s_memrealtime(); } while (0)
    unsigned long long pt_ = 0; if (PROBE_TIME == 0) pt_ = __builtin_amdgcn_s_memrealtime();
    unsigned char* ws = F.ws;

    if (IN(0)) { p_rmsnorm_in(F); p_convert_small(F); if (PROBE_DUP == 0) { p_rmsnorm_in(F); p_convert_small(F); } } SEAM(0);
    if (IN(1)) {
#if FG_INPROJ
#if QKV_FP8
        {
            constexpr int NQ = GATE_FP8 ? NFP8_ROWS : C_Z;
            pg8::Gemm gq{(const bf16*)(ws + WS_XNQ), (const bf16*)(ws + WS_WQKVQ), T, NQ, D / 2}; pg8::StaticOrder SQ; SQ.init(T, NQ, F.nblk, F.blk);
            pg8::EpiInProjF EQ{ws, F.dt_bias, F.gate_bias, -1, 1.f / (FP8_ASCALE * FP8_WSCALE), 0};
            pg8::gemm_phase<pg8::EpiInProjF, pg8::StaticOrder, true, false, false, true>(F.lds, gq, SQ, EQ, nullptr, nullptr, 0);
        }
        constexpr int PN0 = (GATE_FP8 ? NFP8_ROWS : C_Z) / 256;
#else
        constexpr int PN0 = 0;
#endif
        pg8::Gemm g{(const bf16*)(ws + WS_XN), (const bf16*)(ws + WS_WIN_T) + (size_t)PN0 * 256 * D, T, NPROJ_PAD - PN0 * 256, D}; pg8::StaticOrder S; S.init(T, NPROJ_PAD - PN0 * 256, F.nblk, F.blk);
        pg8::EpiInProjF E{ws, F.dt_bias, F.gate_bias, -1, 1.f, PN0};
        if (STAGGER_TICKS) stagger_start(F.blk, F.nblk, STAGGER_TICKS);
        unsigned long long pc0_ = 0, pt0_ = 0;
        if (PROBE_DUP == 300) { pc0_ = clock64(); pt0_ = __builtin_amdgcn_s_memrealtime(); }
        pg8::gemm_phase<pg8::EpiInProjF, pg8::StaticOrder, true, false, false>(F.lds, g, S, E, nullptr, nullptr, 0);
        if (PROBE_DUP == 300 && F.blk == 0 && ((int)threadIdx.x) == 0) {
            const unsigned long long dc = clock64() - pc0_, dt = __builtin_amdgcn_s_memrealtime() - pt0_;
            const unsigned long long want = dc * 5000ull / (dt ? dt : 1ull);
            const unsigned long long s0 = __builtin_amdgcn_s_memrealtime();
            while (__builtin_amdgcn_s_memrealtime() - s0 < want) __builtin_amdgcn_s_sleep(8);
        }
        if (PROBE_DUP == 301 && F.blk == 0 && ((int)threadIdx.x) == 0) {
            const unsigned long long s0 = __builtin_amdgcn_s_memrealtime();
            while (__builtin_amdgcn_s_memrealtime() - s0 < 50000ull) __builtin_amdgcn_s_sleep(8);
        }
        if (PROBE_DUP == 103) { pg8::EpiNullF EN; pg8::Gemm g2{(const bf16*)(ws + WS_XN), (const bf16*)(ws + WS_WIN_T), 16384, 3072, D}; pg8::StaticOrder S2; S2.init(16384, 3072, F.nblk, F.blk);
            pg8::gemm_phase<pg8::EpiNullF, pg8::StaticOrder, true, false, false>(F.lds, g2, S2, EN, nullptr, nullptr, 0); }
        if (PROBE_DUP == 105) { pg8::EpiNullF EN; pg8::Gemm g2{(const bf16*)(ws + WS_XN), (const bf16*)(ws + WS_WIN_T), 16384, 3072, 512}; pg8::StaticOrder S2; S2.init(16384, 3072, F.nblk, F.blk);
            for (int rr = 0; rr < 4; ++rr) pg8::gemm_phase<pg8::EpiNullF, pg8::StaticOrder, true, false, false, true>(F.lds, g2, S2, EN, nullptr, nullptr, 0); }
        if (PROBE_DUP == 104) { pg8::EpiNullF EN; pg8::Gemm g2{(const bf16*)(ws + WS_XN), (const bf16*)(ws + WS_WIN_T), 16384, 3072, D}; pg8::StaticOrder S2; S2.init(16384, 3072, F.nblk, F.blk);
            for (int rr = 0; rr < 4; ++rr) pg8::gemm_phase<pg8::EpiNullF, pg8::StaticOrder, true, false, false>(F.lds, g2, S2, EN, nullptr, nullptr, 0); }
        if (PROBE_DUP == 101) { pg8::EpiNullF EN; pg8::gemm_phase<pg8::EpiNullF, pg8::StaticOrder, true, false, false>(F.lds, g, S, EN, nullptr, nullptr, 0); }
        if (PROBE_DUP == 1) { pg8::gemm_phase<pg8::EpiInProjF, pg8::StaticOrder, true, false, false>(F.lds, g, S, E, nullptr, nullptr, 0); }
#else
        EpiInProj E{ws, F.dt_bias, F.gate_bias}; gemm_naive(F, T / 128, NPROJ, D, (const bf16*)(ws + WS_XN), D, nullptr, F.w_in, NPROJ, nullptr, 0, E);
#endif
    } SEAM(1);
#if FA_ATTN
    if (IN(2)) {
        if (PROBE_DUP == 201) { p_attn_fast<false, true>(F); GRID_BAR(); }
        if (PROBE_DUP == 202) { p_attn_fast<true, false>(F); GRID_BAR(); }
        if (PROBE_DUP == 203) { p_attn_fast<false, false>(F); GRID_BAR(); }
        p_attn_fast(F); if (PROBE_DUP == 2) p_attn_fast(F); } SEAM(2);
    if (IN(3)) { p_attn_merge(F); p_conv2(F); if (PROBE_DUP == 3) { p_attn_merge(F); p_conv2(F); } } SEAM(3);
#else
    if (IN(2)) { p_attn_naive(F); } SEAM(2);
    if (IN(3)) { p_conv(F); } SEAM(3);
#endif
#if FS_SSD
    if (IN(4)) { p_ssd_fast2(F); if (PROBE_DUP == 4) p_ssd_fast2(F); } SEAM(4);
#if MOE_FP8
    if (IN(5)) { p_ypost2(F); p_convert_moe_fp8(F); if (PROBE_DUP == 5) { p_convert_moe_fp8(F); } } SEAM(5);
#else
    if (IN(5)) { p_ypost2(F); p_convert_moe(F); if (PROBE_DUP == 5) { p_convert_moe(F); } } SEAM(5);
#endif
#else
    if (IN(4)) { p_ssd_naive(F); } SEAM(4);
    if (IN(5)) { p_ypost(F); p_convert_moe(F); } SEAM(5);
#endif
    if (IN(6)) {
        __syncthreads();
#if FG_MIX
        pg8::Gemm g{(const bf16*)(ws + WS_ATTN), (const bf16*)(ws + WS_WBA_T), T, D, 512}; pg8::StaticOrder S; S.init(T, D, F.nblk, F.blk);
        pg8::EpiM0F E{ws};
        pg8::gemm_phase<pg8::EpiM0F, pg8::StaticOrder, true, false, false>(F.lds, g, S, E, nullptr, nullptr, 0);
        if (PROBE_DUP == 6) { pg8::gemm_phase<pg8::EpiM0F, pg8::StaticOrder, true, false, false>(F.lds, g, S, E, nullptr, nullptr, 0); }
#else
        EpiM0 E{ws}; gemm_naive(F, T / 128, D, 512, (const bf16*)(ws + WS_ATTN), 512, nullptr, F.w_ba, D, nullptr, 0, E);
#endif
    } SEAM(6);
    if (IN(7)) {
#if FG_MIX
        pg8::Gemm g{(const bf16*)(ws + WS_YN), (const bf16*)(ws + WS_WBS_T), T, D, DI}; pg8::StaticOrder S; S.init(T, D, F.nblk, F.blk);
        pg8::EpiMergedF E{ws};
        pg8::gemm_phase<pg8::EpiMergedF, pg8::StaticOrder, true, false, false>(F.lds, g, S, E, nullptr, nullptr, 0);
        if (PROBE_DUP == 7) { pg8::gemm_phase<pg8::EpiMergedF, pg8::StaticOrder, true, false, false>(F.lds, g, S, E, nullptr, nullptr, 0); }
#else
        EpiMerged E{ws}; gemm_naive(F, T / 128, D, DI, (const bf16*)(ws + WS_YN), DI, nullptr, F.w_bs, D, nullptr, 0, E);
#endif
    } SEAM(7);
    if (IN(8)) {
#if FG_MIX
        pg8::Gemm g{(const bf16*)(ws + WS_MERGED), (const bf16*)(ws + WS_WOUT_T), T, D, D}; pg8::StaticOrder S; S.init(T, D, F.nblk, F.blk);
        pg8::EpiX1F E{F.x, F.out};
        pg8::gemm_phase<pg8::EpiX1F, pg8::StaticOrder, true, false, false>(F.lds, g, S, E, nullptr, nullptr, 0);
        if (PROBE_DUP == 8) { pg8::gemm_phase<pg8::EpiX1F, pg8::StaticOrder, true, false, false>(F.lds, g, S, E, nullptr, nullptr, 0); }
#else
        EpiX1 E{F.x, F.out}; gemm_naive(F, T / 128, D, D, (const bf16*)(ws + WS_MERGED), D, nullptr, F.w_out, D, nullptr, 0, E);
#endif
    } SEAM(8);
    if (IN(9)) { p_router3(F); } SEAM(9);
    if (IN(10)) { p_slots(F); } SEAM(10);
    if (IN(11)) {
#if FG_MOE && MOE_FP8
        const int* texp = (const int*)(ws + WS_SMALL); const int ntile = texp[1024];
        pg8::Gemm g{(const bf16*)(ws + WS_XN2), (const bf16*)(ws + WS_W1T), CAP, 2048, 512}; pg8::MoeOrder S; S.init(ntile, 8, F.nblk, F.blk);
        pg8::EpiMoe1Q E{ws, F.b1, texp};
        pg8::gemm_phase<pg8::EpiMoe1Q, pg8::MoeOrder, true, true, true, true>(F.lds, g, S, E, (const int*)(ws + WS_ROWMAP), texp, (size_t)2048 * 1024);
        if (PROBE_DUP == 11) { pg8::gemm_phase<pg8::EpiMoe1Q, pg8::MoeOrder, true, true, true, true>(F.lds, g, S, E, (const int*)(ws + WS_ROWMAP), texp, (size_t)2048 * 1024); }
#elif FG_MOE
        const int* texp = (const int*)(ws + WS_SMALL); const int ntile = texp[1024];
        pg8::Gemm g{(const bf16*)(ws + WS_XN2), (const bf16*)(ws + WS_W1T), CAP, 2048, D}; pg8::MoeOrder S; S.init(ntile, 8, F.nblk, F.blk);
        pg8::EpiMoe1F E{ws, F.b1, texp};
        pg8::gemm_phase<pg8::EpiMoe1F, pg8::MoeOrder, true, true, true>(F.lds, g, S, E, (const int*)(ws + WS_ROWMAP), texp, (size_t)2048 * 1024 * 2);
#else
        EpiMoe1 E{ws, F.b1}; gemm_naive(F, CAP / 128, 2048, D, (const bf16*)(ws + WS_XN2), D, (const int*)(ws + WS_ROWMAP), F.w1, 2048, (const int*)(ws + WS_SMALL), (size_t)1024 * 2048, E);
#endif
    } SEAM(11);
    if (IN(12)) {
#if FG_MOE && MOE_FP8
        const int* texp = (const int*)(ws + WS_SMALL); const int ntile = texp[1024];
        pg8::Gemm g{(const bf16*)(ws + WS_ACT), (const bf16*)(ws + WS_W2T), CAP, 1024, 512}; pg8::MoeOrder S; S.init(ntile, 4, F.nblk, F.blk);
        pg8::EpiMoe2Q E{ws, F.b2, texp};
        pg8::gemm_phase<pg8::EpiMoe2Q, pg8::MoeOrder, true, false, true, true>(F.lds, g, S, E, nullptr, texp, (size_t)1024 * 1024);
        if (PROBE_DUP == 12) { pg8::gemm_phase<pg8::EpiMoe2Q, pg8::MoeOrder, true, false, true, true>(F.lds, g, S, E, nullptr, texp, (size_t)1024 * 1024); }
#elif FG_MOE
        const int* texp = (const int*)(ws + WS_SMALL); const int ntile = texp[1024];
        pg8::Gemm g{(const bf16*)(ws + WS_ACT), (const bf16*)(ws + WS_W2T), CAP, 1024, 1024}; pg8::MoeOrder S; S.init(ntile, 4, F.nblk, F.blk);
        pg8::EpiMoe2F E{ws, F.b2, texp};
        pg8::gemm_phase<pg8::EpiMoe2F, pg8::MoeOrder, true, false, true>(F.lds, g, S, E, nullptr, texp, (size_t)1024 * 1024 * 2);
#else
        EpiMoe2 E{ws, F.b2}; gemm_naive(F, CAP / 128, 1024, 1024, (const bf16*)(ws + WS_ACT), 1024, nullptr, F.w2, 1024, (const int*)(ws + WS_SMALL), (size_t)1024 * 1024, E);
#endif
    } SEAM(12);
    if (IN(13)) { p_final(F); } SEAM(13);
#undef IN
#undef SEAM
}

extern "C" void kernel_launch(void* const* d_in, const int* in_sizes, int n_in, void* d_out, int out_size, void* d_ws, size_t ws_size, hipStream_t stream) {
    static int grid = 0;
    if (grid == 0) {
        if (n_in != 22 || out_size != T * D || ws_size < WS_END) { fprintf(stderr, "kernel_launch: unexpected shapes: n_in %d out %d ws %zu\n", n_in, out_size, ws_size); grid = -1; return; }
        int dev = 0, cus = 0, per_cu = 0;
        if (hipGetDevice(&dev) != hipSuccess || hipDeviceGetAttribute(&cus, hipDeviceAttributeMultiprocessorCount, dev) != hipSuccess) { grid = -1; return; }
        if (hipFuncSetAttribute((const void*)fwd, hipFuncAttributeMaxDynamicSharedMemorySize, LDS_BYTES) != hipSuccess) { fprintf(stderr, "kernel_launch: hipFuncSetAttribute failed\n"); grid = -1; return; }
        if (hipOccupancyMaxActiveBlocksPerMultiprocessor(&per_cu, (const void*)fwd, NTHREADS, LDS_BYTES) != hipSuccess || per_cu < 1) fprintf(stderr, "kernel_launch: occupancy query says %d\n", per_cu);
        (void)hipGetLastError();
        grid = cus;
    }
    if (grid < 0) return;
    (void)hipMemsetAsync((char*)d_ws + WS_CTL, 0, CTL_ZERO_BYTES, stream);
    Args a{};
    for (int i = 0; i < 22; ++i) a.in[i] = (const float*)d_in[i];
    a.out = (float*)d_out; a.ws = (unsigned char*)d_ws;
#if MK_FUSED
    a.ph_lo = 0; a.ph_hi = NPHASE; a.li = 0;
    hipLaunchKernelGGL(fwd, dim3(grid), dim3(NTHREADS), LDS_BYTES, stream, a);
#else
    for (int p = 0; p < NPHASE; ++p) { a.ph_lo = p; a.ph_hi = p + 1; a.li = p; hipLaunchKernelGGL(fwd, dim3(grid), dim3(NTHREADS), LDS_BYTES, stream, a); }
#endif
}
```
